# Optimizing an MI355X kernel written in HIP

```python
import jax, jax.numpy as jnp
from jax import lax
import numpy as np

D_MODEL = 1024
BATCH = 4
SEQ = 8192
DEPTH = 2

MLA_HEADS = 6
MLA_NOPE = 64
MLA_ROPE = 32
MLA_V = 64
MLA_Q_RANK = 256
MLA_KV_RANK = 128
MLA_WIDTH = MLA_HEADS * MLA_V

LRU_WIDTH = 384
LRU_BLOCKS = 6
LRU_BLOCK = LRU_WIDTH // LRU_BLOCKS
LRU_C = 8.0
CONV_WIDTH = 4
CONV_PAD = (1, 2)

SWA_Q_HEADS = 4
SWA_KV_HEADS = 2
SWA_HEAD_DIM = 64
SWA_WINDOW = 128
SWA_WIDTH = SWA_Q_HEADS * SWA_HEAD_DIM

MIX_WIDTH = MLA_WIDTH + LRU_WIDTH + SWA_WIDTH
BLOCK_Q = 128
ROPE_THETA = 10000.0
EPS = 1e-6
NEG_BIG = -1e30

IN_SPLITS = (MLA_Q_RANK, MLA_KV_RANK, MLA_ROPE,
             SWA_WIDTH, SWA_KV_HEADS * SWA_HEAD_DIM, SWA_KV_HEADS * SWA_HEAD_DIM,
             LRU_WIDTH, LRU_WIDTH)
IN_WIDTH = 1696

PEER_HEADS = 8
PEER_NKEYS = 128
PEER_EXPERTS = PEER_NKEYS * PEER_NKEYS
PEER_DKEY = 256
PEER_TOPK = 16
PEER_CHUNK = 128

kernel_name = 'hybrid_mla_rglru_swa_peer_encoder'


def rmsnorm(x, g):
    xf = x.astype(jnp.float32)
    y = xf * lax.rsqrt(jnp.mean(xf * xf, axis=-1, keepdims=True) + EPS)
    return (y * g.astype(jnp.float32)).astype(x.dtype)


def rope(x, positions):
    d = x.shape[-1]
    inv = ROPE_THETA ** (-jnp.arange(0, d, 2, dtype=jnp.float32) / d)
    ang = positions.astype(jnp.float32)[..., None] * inv
    cos = jnp.cos(ang)[:, :, None, :]
    sin = jnp.sin(ang)[:, :, None, :]
    xf = x.astype(jnp.float32)
    x1, x2 = xf[..., : d // 2], xf[..., d // 2:]
    return jnp.concatenate([x1 * cos - x2 * sin, x2 * cos + x1 * sin], axis=-1).astype(x.dtype)


def mla_mixer(c_q, c_kv, k_rope, positions, q_norm, w_uq, kv_norm, w_ukv):
    B, S, _ = c_q.shape
    q = (rmsnorm(c_q, q_norm) @ w_uq).reshape(B, S, MLA_HEADS, MLA_NOPE + MLA_ROPE)
    q_nope = q[..., :MLA_NOPE]
    q_rope = rope(q[..., MLA_NOPE:], positions)
    kv = (rmsnorm(c_kv, kv_norm) @ w_ukv).reshape(B, S, MLA_HEADS, MLA_NOPE + MLA_V)
    k_nope, v = kv[..., :MLA_NOPE], kv[..., MLA_NOPE:]
    k_r = rope(k_rope[:, :, None, :], positions)[:, :, 0]
    scale = (MLA_NOPE + MLA_ROPE) ** -0.5
    nb = S // BLOCK_Q

    def to_blocks(t):
        return jnp.moveaxis(t.reshape(B, nb, BLOCK_Q, *t.shape[2:]), 1, 0)

    def attend(qb):
        qn, qr = qb
        s = (jnp.einsum('bqhd,bkhd->bhqk', qn, k_nope, preferred_element_type=jnp.float32)
             + jnp.einsum('bqhr,bkr->bhqk', qr, k_r, preferred_element_type=jnp.float32))
        p = jax.nn.softmax(s * scale, axis=-1)
        return jnp.einsum('bhqk,bkhd->bqhd', p.astype(v.dtype), v)

    o = lax.map(attend, (to_blocks(q_nope), to_blocks(q_rope)))
    return jnp.moveaxis(o, 0, 1).reshape(B, S, MLA_WIDTH)


def _lin_combine(left, right):
    a_l, b_l = left
    a_r, b_r = right
    return a_l * a_r, a_r * b_l + b_r


def rglru_mixer(x_branch, gate_branch, conv_w, conv_b, wa, ba, wx, bx, lam):
    B, S, _ = x_branch.shape
    xc = lax.conv_general_dilated(
        x_branch, conv_w[:, None, :].astype(x_branch.dtype), window_strides=(1,),
        padding=[CONV_PAD], dimension_numbers=('NWC', 'WIO', 'NWC'),
        feature_group_count=LRU_WIDTH) + conv_b
    xf = xc.astype(jnp.float32)
    xb = xf.reshape(B, S, LRU_BLOCKS, LRU_BLOCK)

    def direction(d, reverse):
        r = jax.nn.sigmoid(jnp.einsum('bsni,nij->bsnj', xb, wa[d].astype(jnp.float32))
                           + ba[d].astype(jnp.float32)).reshape(B, S, LRU_WIDTH)
        i = jax.nn.sigmoid(jnp.einsum('bsni,nij->bsnj', xb, wx[d].astype(jnp.float32))
                           + bx[d].astype(jnp.float32)).reshape(B, S, LRU_WIDTH)
        log_a = -LRU_C * r * jax.nn.softplus(-lam[d].astype(jnp.float32))
        a = jnp.exp(log_a)
        b = jnp.sqrt(-jnp.expm1(2.0 * log_a)) * (i * xf)
        _, h = lax.associative_scan(_lin_combine, (a, b), axis=1, reverse=reverse)
        return h

    h = direction(0, False) + direction(1, True)
    return (h * jax.nn.gelu(gate_branch.astype(jnp.float32), approximate=False)).astype(x_branch.dtype)


def swa_mixer(q, k, v, positions, sink):
    B, S, _ = q.shape
    G = SWA_Q_HEADS // SWA_KV_HEADS
    nb = S // BLOCK_Q
    q = rope(q.reshape(B, S, SWA_Q_HEADS, SWA_HEAD_DIM), positions)
    q = q.reshape(B, nb, BLOCK_Q, SWA_KV_HEADS, G, SWA_HEAD_DIM)
    k = rope(k.reshape(B, S, SWA_KV_HEADS, SWA_HEAD_DIM), positions)
    v = v.reshape(B, S, SWA_KV_HEADS, SWA_HEAD_DIM)
    pad = ((0, 0), (SWA_WINDOW, SWA_WINDOW), (0, 0), (0, 0))

    def band(t):
        tp = jnp.pad(t, pad)
        views = [tp[:, j * BLOCK_Q: j * BLOCK_Q + S].reshape(B, nb, BLOCK_Q, SWA_KV_HEADS, SWA_HEAD_DIM)
                 for j in range(3)]
        return jnp.concatenate(views, axis=2)

    kb, vb = band(k), band(v)
    s = jnp.einsum('bnqkgd,bnjkd->bnkgqj', q, kb, preferred_element_type=jnp.float32) * SWA_HEAD_DIM ** -0.5
    qi = jnp.arange(BLOCK_Q)[None, :, None]
    kj = jnp.arange(3 * BLOCK_Q)[None, None, :]
    kglob = jnp.arange(nb)[:, None, None] * BLOCK_Q - SWA_WINDOW + kj
    valid = (jnp.abs(kj - SWA_WINDOW - qi) <= SWA_WINDOW) & (kglob >= 0) & (kglob < S)
    s = jnp.where(valid[None, :, None, None], s, NEG_BIG)
    sink_logit = jnp.broadcast_to(sink.astype(jnp.float32).reshape(1, 1, SWA_KV_HEADS, G, 1, 1),
                                  s.shape[:-1] + (1,))
    p = jax.nn.softmax(jnp.concatenate([s, sink_logit], axis=-1), axis=-1)[..., :-1]
    o = jnp.einsum('bnkgqj,bnjkd->bnqkgd', p.astype(vb.dtype), vb)
    return o.reshape(B, S, SWA_WIDTH)


def peer_ffn(x, wq, subkeys, u, v):
    B, S, D = x.shape
    T = B * S
    xt = x.reshape(T, D)
    q = (xt @ wq).reshape(T, PEER_HEADS, 2, PEER_DKEY // 2)
    s1 = jnp.einsum('thd,nd->thn', q[:, :, 0], subkeys[0], preferred_element_type=jnp.float32)
    s2 = jnp.einsum('thd,nd->thn', q[:, :, 1], subkeys[1], preferred_element_type=jnp.float32)
    v1, i1 = lax.top_k(s1, PEER_TOPK)
    v2, i2 = lax.top_k(s2, PEER_TOPK)
    cand = (v1[..., :, None] + v2[..., None, :]).reshape(T, PEER_HEADS, PEER_TOPK * PEER_TOPK)
    sc, ci = lax.top_k(cand, PEER_TOPK)
    e1 = jnp.take_along_axis(i1, ci // PEER_TOPK, axis=-1)
    e2 = jnp.take_along_axis(i2, ci % PEER_TOPK, axis=-1)
    nc = T // PEER_CHUNK
    expert = (e1 * PEER_NKEYS + e2).reshape(nc, PEER_CHUNK, PEER_HEADS * PEER_TOPK)
    gate = jax.nn.softmax(sc, axis=-1).astype(x.dtype).reshape(nc, PEER_CHUNK, PEER_HEADS * PEER_TOPK)

    def chunk(args):
        xc, ec, gc = args
        hid = jax.nn.gelu(jnp.einsum('cd,ced->ce', xc, u[ec]), approximate=False)
        return jnp.einsum('ce,ced->cd', gc * hid, v[ec])

    y = lax.map(chunk, (xt.reshape(nc, PEER_CHUNK, D), expert, gate))
    return y.reshape(B, S, D)


def setup_inputs(seed: int = 0) -> dict:
    key = jax.random.key(seed)
    ks = jax.random.split(key, 32)
    f32 = jnp.float32

    def nrm(k, shape, scale):
        return jax.random.normal(k, shape, f32) * scale

    def gain(k, shape):
        return 1.0 + 0.02 * jax.random.normal(k, shape, f32)

    x = nrm(ks[0], (BATCH, SEQ, D_MODEL), 1.0)
    offs = jax.random.randint(ks[1], (BATCH, 1), 0, 1024, dtype=jnp.int32)
    positions = offs + jnp.arange(SEQ, dtype=jnp.int32)[None, :]
    a_c = jax.random.uniform(ks[14], (DEPTH, 2, LRU_WIDTH), f32, minval=0.9, maxval=0.999)
    p_a = a_c ** (1.0 / LRU_C)
    lru_lambda = jnp.log(p_a) - jnp.log1p(-p_a)
    return {
        'x': x,
        'positions': positions,
        'norm_mix': gain(ks[2], (DEPTH, D_MODEL)),
        'w_in': nrm(ks[3], (DEPTH, D_MODEL, IN_WIDTH), D_MODEL ** -0.5),
        'q_norm': gain(ks[4], (DEPTH, MLA_Q_RANK)),
        'w_uq': nrm(ks[5], (DEPTH, MLA_Q_RANK, MLA_HEADS * (MLA_NOPE + MLA_ROPE)), MLA_Q_RANK ** -0.5),
        'kv_norm': gain(ks[6], (DEPTH, MLA_KV_RANK)),
        'w_ukv': nrm(ks[7], (DEPTH, MLA_KV_RANK, MLA_HEADS * (MLA_NOPE + MLA_V)), MLA_KV_RANK ** -0.5),
        'conv_w': nrm(ks[8], (DEPTH, CONV_WIDTH, LRU_WIDTH), CONV_WIDTH ** -0.5),
        'conv_b': nrm(ks[9], (DEPTH, LRU_WIDTH), 0.01),
        'lru_wa': nrm(ks[10], (DEPTH, 2, LRU_BLOCKS, LRU_BLOCK, LRU_BLOCK), LRU_BLOCK ** -0.5),
        'lru_ba': nrm(ks[11], (DEPTH, 2, LRU_BLOCKS, LRU_BLOCK), 0.01),
        'lru_wx': nrm(ks[12], (DEPTH, 2, LRU_BLOCKS, LRU_BLOCK, LRU_BLOCK), LRU_BLOCK ** -0.5),
        'lru_bx': nrm(ks[13], (DEPTH, 2, LRU_BLOCKS, LRU_BLOCK), 0.01),
        'lru_lambda': lru_lambda,
        'swa_sink': nrm(ks[15], (DEPTH, SWA_Q_HEADS), 1.0),
        'grp_norm': gain(ks[16], (DEPTH, MIX_WIDTH)),
        'w_out': nrm(ks[17], (DEPTH, MIX_WIDTH, D_MODEL), MIX_WIDTH ** -0.5),
        'norm_ffn': gain(ks[18], (DEPTH, D_MODEL)),
        'peer_wq': nrm(ks[19], (DEPTH, D_MODEL, PEER_HEADS * PEER_DKEY), D_MODEL ** -0.5),
        'peer_subkeys': nrm(ks[20], (DEPTH, 2, PEER_NKEYS, PEER_DKEY // 2), (PEER_DKEY // 2) ** -0.5),
        'peer_u': nrm(ks[21], (DEPTH, PEER_EXPERTS, D_MODEL), D_MODEL ** -0.5),
        'peer_v': nrm(ks[22], (DEPTH, PEER_EXPERTS, D_MODEL), 0.5),
        'norm_final': gain(ks[23], (D_MODEL,)),
    }


def reference(x, positions, norm_mix, w_in, q_norm, w_uq, kv_norm, w_ukv, conv_w, conv_b,
              lru_wa, lru_ba, lru_wx, lru_bx, lru_lambda, swa_sink, grp_norm, w_out,
              norm_ffn, peer_wq, peer_subkeys, peer_u, peer_v, norm_final):
    split_points = np.cumsum(IN_SPLITS)[:-1].tolist()
    g_a, g_b = MLA_WIDTH, MLA_WIDTH + LRU_WIDTH
    for l in range(DEPTH):
        xn = rmsnorm(x, norm_mix[l])
        proj = xn @ w_in[l]
        c_q, c_kv, k_r, s_q, s_k, s_v, l_x, l_g = jnp.split(proj, split_points, axis=-1)
        o_mla = mla_mixer(c_q, c_kv, k_r, positions, q_norm[l], w_uq[l], kv_norm[l], w_ukv[l])
        o_lru = rglru_mixer(l_x, l_g, conv_w[l], conv_b[l], lru_wa[l], lru_ba[l],
                            lru_wx[l], lru_bx[l], lru_lambda[l])
        o_swa = swa_mixer(s_q, s_k, s_v, positions, swa_sink[l])
        g = grp_norm[l]
        mixed = jnp.concatenate([rmsnorm(o_mla, g[:g_a]),
                                 rmsnorm(o_lru, g[g_a:g_b]),
                                 rmsnorm(o_swa, g[g_b:])], axis=-1)
        x = x + mixed @ w_out[l]
        x = x + peer_ffn(rmsnorm(x, norm_ffn[l]), peer_wq[l], peer_subkeys[l], peer_u[l], peer_v[l])
    return rmsnorm(x, norm_final)
```

```cpp
#include <hip/hip_runtime.h>
#include <hip/hip_cooperative_groups.h>
#include <cstdio>
#include <cstdint>
namespace cg = cooperative_groups;

#define DEVI __device__ __forceinline__
typedef unsigned short u16;
typedef short bf16x8 __attribute__((ext_vector_type(8)));
typedef short s16x4 __attribute__((ext_vector_type(4)));
typedef float f32x2 __attribute__((ext_vector_type(2)));
typedef float f32x4 __attribute__((ext_vector_type(4)));
typedef float f32x16 __attribute__((ext_vector_type(16)));
typedef unsigned u32x4 __attribute__((ext_vector_type(4)));
typedef unsigned u32x2 __attribute__((ext_vector_type(2)));
typedef __bf16 bf16x2_t __attribute__((ext_vector_type(2)));

constexpr int NB = 4, SEQ = 8192, T = NB * SEQ, DM = 1024, DEPTH = 2;
constexpr int MLA_H = 6, MLA_QK = 96, MLA_V = 64;
constexpr int LRU_W = 384;
constexpr int INW = 1696, INWP = 1792;
constexpr int PC_CQ = 0, PC_CKV = 256, PC_SQ = 384, PC_SK = 640, PC_SV = 768, PC_LX = 896, PC_LG = 1280, PC_KR = 1664;
constexpr int OC_CQ = 0, OC_CKV = 256, OC_KR = 384, OC_SQ = 416, OC_SK = 672, OC_SV = 800, OC_LX = 928, OC_LG = 1312;
constexpr int NEXP = 16384;
constexpr float EPS = 1e-6f;
constexpr int NTHREADS = 512;
constexpr int LDS_BYTES = 160 * 1024;

constexpr size_t MiB = 1u << 20;
constexpr size_t WS_CTL = 0;
constexpr size_t WS_WIN = 4 * MiB;
constexpr size_t WS_WQ = 11 * MiB;
constexpr size_t WS_WOUT = 19 * MiB;
constexpr size_t WS_WUQ = 23 * MiB;
constexpr size_t WS_WUKV = WS_WUQ + 2 * 640 * 256 * 2;
constexpr size_t WS_WLRU = WS_WUKV + 2 * 768 * 128 * 2;
constexpr size_t WS_SUBK = WS_WLRU + 2 * 6 * 2 * 128 * 64 * 2;
constexpr size_t WS_XG = 25 * MiB;
constexpr size_t WS_R1 = 89 * MiB;
constexpr size_t WS_QM = 217 * MiB;
constexpr size_t WS_KM = 253 * MiB;
constexpr size_t WS_VM = 289 * MiB;
constexpr size_t WS_LE = 313 * MiB;
constexpr size_t WS_LB = 361 * MiB;
constexpr size_t WS_MIX = 409 * MiB;
constexpr size_t WS_UB = 217 * MiB;
constexpr size_t WS_VB = 249 * MiB;
constexpr size_t WS_TOP = 281 * MiB;
constexpr size_t WS_EIDX = 313 * MiB;
constexpr size_t WS_EGATE = 329 * MiB;
constexpr size_t WS_END = 473 * MiB;

__device__ const float ROPE_HI[32] = {1.591549367e-01f, 1.193493679e-01f, 8.949939907e-02f, 6.711508334e-02f, 5.032921210e-02f, 3.774158657e-02f, 2.830219641e-02f, 2.122365311e-02f, 1.591549441e-02f, 1.193493698e-02f, 8.949940093e-03f, 6.711508147e-03f, 5.032921210e-03f, 3.774158424e-03f, 2.830219688e-03f, 2.122365171e-03f, 1.591549488e-03f, 1.193493721e-03f, 8.949940093e-04f, 6.711508031e-04f, 5.032921326e-04f, 3.774158540e-04f, 2.830219455e-04f, 2.122365258e-04f, 1.591549371e-04f, 1.193493736e-04f, 8.949940093e-05f, 6.711508468e-05f, 5.032921035e-05f, 3.774158540e-05f, 2.830219637e-05f, 2.122365186e-05f};
__device__ const float ROPE_LO[32] = {6.420638243e-09f, 2.294664903e-09f, 2.542919653e-09f, -3.316028840e-10f, 5.173299289e-12f, -1.848551645e-09f, -5.826552019e-10f, -3.431038786e-10f, -1.029942243e-10f, 4.320196978e-11f, 6.802744479e-11f, 1.531042237e-10f, 5.173301024e-13f, 4.797548470e-11f, -1.048316434e-10f, 1.053879969e-10f, -5.686555046e-11f, -1.896286773e-11f, 6.802744999e-12f, 2.695195456e-11f, -1.158979943e-11f, -6.843983713e-12f, 1.279990003e-11f, 1.807650600e-12f, 5.954976963e-12f, -3.351478166e-12f, 6.802744674e-13f, -1.670379113e-12f, 1.751403167e-12f, -6.843983930e-13f, -5.389994549e-13f, 9.083608431e-13f};

DEVI int tidx() { int t = __builtin_amdgcn_workitem_id_x(); asm volatile("" : "+v"(t)); return t; }
DEVI float bf2f(unsigned h) { return __uint_as_float(h << 16); }
DEVI float bflo(unsigned w) { return __uint_as_float(w << 16); }
DEVI float bfhi(unsigned w) { return __uint_as_float(w & 0xffff0000u); }
DEVI unsigned pk2(float lo, float hi) { f32x2 v = {lo, hi}; bf16x2_t b = __builtin_convertvector(v, bf16x2_t); return __builtin_bit_cast(unsigned, b); }
DEVI u16 f2bf(float f) { return (u16)(pk2(f, 0.f) & 0xffffu); }
DEVI u32x4 pk8(const float* v) { u32x4 w; w.x = pk2(v[0], v[1]); w.y = pk2(v[2], v[3]); w.z = pk2(v[4], v[5]); w.w = pk2(v[6], v[7]); return w; }
DEVI void unpk8(u32x4 w, float* v) { v[0] = bflo(w.x); v[1] = bfhi(w.x); v[2] = bflo(w.y); v[3] = bfhi(w.y); v[4] = bflo(w.z); v[5] = bfhi(w.z); v[6] = bflo(w.w); v[7] = bfhi(w.w); }
DEVI int crow(int r, int hi) { return (r & 3) + 8 * (r >> 2) + 4 * hi; }
DEVI float wave_sum(float v) {
#pragma unroll
  for (int o = 1; o < 64; o <<= 1) v += __shfl_xor(v, o);
  return v;
}
DEVI void rope_sc(float pos, int fidx, float& sn, float& cs) {
  const float chi = ROPE_HI[fidx], clo = ROPE_LO[fidx];
  const float t = pos * chi, e = fmaf(pos, chi, -t);
  float fr = t - rintf(t);
  fr = fr + (e + pos * clo);
  sn = __builtin_amdgcn_sinf(fr); cs = __builtin_amdgcn_cosf(fr);
}
DEVI float sigmoidf_(float x) { return 1.f / (1.f + __expf(-x)); }
DEVI float gelu_erf(float x) { return 0.5f * x * (1.f + erff(x * 0.70710678118654752f)); }

struct Params {
  const float* x; const int* pos; const float* norm_mix; const float* w_in; const float* q_norm; const float* w_uq; const float* kv_norm; const float* w_ukv;
  const float* conv_w; const float* conv_b; const float* lru_wa; const float* lru_ba; const float* lru_wx; const float* lru_bx; const float* lru_lambda;
  const float* swa_sink; const float* grp_norm; const float* w_out; const float* norm_ffn; const float* peer_wq; const float* peer_subkeys;
  const float* peer_u; const float* peer_v; const float* norm_final;
  float* out; unsigned char* ws;
  int ph_lo, ph_hi;
};

DEVI void tconv_item(const float* W, int ldw, int src_c0, u16* WT, int K, int dst_r0, const float* gain, float* scr, int kb, int nb, int lane) {
  const int k0 = 64 * kb, n0 = 32 * nb;
#pragma unroll 8
  for (int i = 0; i < 32; ++i) { const int kk = 2 * i + (lane >> 5); float g = gain ? gain[k0 + kk] : 1.f; scr[kk * 33 + (lane & 31)] = g * W[(size_t)(k0 + kk) * ldw + src_c0 + n0 + (lane & 31)]; }
  __builtin_amdgcn_s_waitcnt(0xc07f); asm volatile("" ::: "memory");
  const int c = lane & 7;
#pragma unroll
  for (int j = 0; j < 4; ++j) { const int n = (lane >> 3) + 8 * j; const float* s = scr + (8 * c) * 33 + n;
    u32x4 o; o.x = pk2(s[0 * 33], s[1 * 33]); o.y = pk2(s[2 * 33], s[3 * 33]); o.z = pk2(s[4 * 33], s[5 * 33]); o.w = pk2(s[6 * 33], s[7 * 33]);
    *(u32x4*)(WT + (size_t)(dst_r0 + n0 + n) * K + k0 + 8 * c) = o; }
  __builtin_amdgcn_s_waitcnt(0xc07f); asm volatile("" ::: "memory");
}

DEVI void tseg(const float* W, int ldw, int src_c0, int ncols, u16* WT, int K, int dst_r0, const float* gain, float* scr, int gw, int ngw, int lane) {
  const int nkb = K / 64, nnb = ncols / 32, ni = nkb * nnb;
  for (int it = gw; it < ni; it += ngw) tconv_item(W, ldw, src_c0, WT, K, dst_r0, gain, scr, it / nnb, it % nnb, lane);
}

DEVI void phase0(const Params& p, int vb, int nb, char* lds) {
  const int tid = tidx(), lane = tid & 63, wid = tid >> 6;
  float* scr = (float*)(lds + wid * 16384);
  const int gw = vb * 8 + wid, ngw = nb * 8;
#pragma unroll 1
  for (int l = 0; l < DEPTH; ++l) {
    const float* win = p.w_in + (size_t)l * DM * INW; u16* wint = (u16*)(p.ws + WS_WIN) + (size_t)l * INWP * DM; const float* gm = p.norm_mix + l * DM;
    tseg(win, INW, OC_CQ, 256, wint, DM, PC_CQ, gm, scr, gw, ngw, lane);
    tseg(win, INW, OC_CKV, 128, wint, DM, PC_CKV, gm, scr, gw, ngw, lane);
    tseg(win, INW, OC_SQ, 256, wint, DM, PC_SQ, gm, scr, gw, ngw, lane);
    tseg(win, INW, OC_SK, 128, wint, DM, PC_SK, gm, scr, gw, ngw, lane);
    tseg(win, INW, OC_SV, 128, wint, DM, PC_SV, gm, scr, gw, ngw, lane);
    tseg(win, INW, OC_LX, 384, wint, DM, PC_LX, gm, scr, gw, ngw, lane);
    tseg(win, INW, OC_LG, 384, wint, DM, PC_LG, gm, scr, gw, ngw, lane);
    tseg(win, INW, OC_KR, 32, wint, DM, PC_KR, gm, scr, gw, ngw, lane);
    tseg(p.peer_wq + (size_t)l * DM * 2048, 2048, 0, 2048, (u16*)(p.ws + WS_WQ) + (size_t)l * 2048 * DM, DM, 0, p.norm_ffn + l * DM, scr, gw, ngw, lane);
    tseg(p.w_out + (size_t)l * DM * DM, DM, 0, DM, (u16*)(p.ws + WS_WOUT) + (size_t)l * DM * DM, DM, 0, p.grp_norm + l * DM, scr, gw, ngw, lane);
    tseg(p.w_uq + (size_t)l * 256 * 576, 576, 0, 576, (u16*)(p.ws + WS_WUQ) + (size_t)l * 640 * 256, 256, 0, p.q_norm + l * 256, scr, gw, ngw, lane);
    tseg(p.w_ukv + (size_t)l * 128 * 768, 768, 0, 768, (u16*)(p.ws + WS_WUKV) + (size_t)l * 768 * 128, 128, 0, p.kv_norm + l * 128, scr, gw, ngw, lane);
    for (int it = gw; it < 2 * 6 * 2 * 2; it += ngw) {
      const int nbk = it & 1, ax = (it >> 1) & 1, n = (it >> 2) % 6, d = (it >> 2) / 6;
      const float* W = (ax ? p.lru_wx : p.lru_wa) + ((size_t)(l * 2 + d) * 6 + n) * 4096;
      u16* WT = (u16*)(p.ws + WS_WLRU) + ((size_t)((l * 6 + n) * 2 + d)) * 128 * 64;
      tconv_item(W, 64, 0, WT, 64, ax * 64, nullptr, scr, 0, nbk, lane);
    }
  }
  for (int i = vb * NTHREADS + tid; i < DEPTH * 96 * DM / 8; i += nb * NTHREADS) { const int l = i / (96 * DM / 8), r = i % (96 * DM / 8);
    *(u32x4*)((u16*)(p.ws + WS_WIN) + ((size_t)l * INWP + INW) * DM + (size_t)r * 8) = (u32x4){0, 0, 0, 0}; }
  for (int i = vb * NTHREADS + tid; i < DEPTH * 64 * 256 / 8; i += nb * NTHREADS) { const int l = i / (64 * 256 / 8), r = i % (64 * 256 / 8);
    *(u32x4*)((u16*)(p.ws + WS_WUQ) + ((size_t)l * 640 + 576) * 256 + (size_t)r * 8) = (u32x4){0, 0, 0, 0}; }
  for (int i = vb * NTHREADS + tid; i < DEPTH * 2 * 128 * 128 / 8; i += nb * NTHREADS) {
    const f32x4 a = *(const f32x4*)(p.peer_subkeys + (size_t)i * 8), b = *(const f32x4*)(p.peer_subkeys + (size_t)i * 8 + 4);
    u32x4 o; o.x = pk2(a.x, a.y); o.y = pk2(a.z, a.w); o.z = pk2(b.x, b.y); o.w = pk2(b.z, b.w);
    *(u32x4*)((u16*)(p.ws + WS_SUBK) + (size_t)i * 8) = o; }
  for (size_t i = (size_t)vb * NTHREADS + tid; i < (size_t)T * DM / 8; i += (size_t)nb * NTHREADS) {
    const f32x4 a = *(const f32x4*)(p.x + i * 8), b = *(const f32x4*)(p.x + i * 8 + 4);
    u32x4 o; o.x = pk2(a.x, a.y); o.y = pk2(a.z, a.w); o.z = pk2(b.x, b.y); o.w = pk2(b.z, b.w);
    *(u32x4*)((u16*)(p.ws + WS_XG) + i * 8) = o; }
}

DEVI int swz(int row, int c) { return row * 128 + ((c ^ ((row >> 1) & 7)) << 4); }
constexpr int CLD = 132;
constexpr int LDS_RS = 135168;

struct GemmDesc {
  const u16* A; int lda; const u16* Bt; int ldb; int KT;
  float inv0;
  const u16* proj; const float* cw; const float* cb; int ch0;
};

template <int AMODE> DEVI bf16x8 load_a(const GemmDesc& g, int row, int kcol) {
  if constexpr (AMODE == 0) {
    return *(const bf16x8*)(g.A + (size_t)row * g.lda + kcol);
  } else {
    const int s = row & (SEQ - 1), ch = g.ch0 + kcol;
    float a[8];
    { const f32x4 b0 = *(const f32x4*)(g.cb + ch), b1 = *(const f32x4*)(g.cb + ch + 4); a[0] = b0.x; a[1] = b0.y; a[2] = b0.z; a[3] = b0.w; a[4] = b1.x; a[5] = b1.y; a[6] = b1.z; a[7] = b1.w; }
#pragma unroll
    for (int tap = 0; tap < 4; ++tap) {
      const int ss = s - 1 + tap;
      if (ss >= 0 && ss < SEQ) {
        const u32x4 v = *(const u32x4*)(g.proj + (size_t)(row - 1 + tap) * INWP + PC_LX + ch);
        float x[8]; unpk8(v, x);
        const f32x4 w0 = *(const f32x4*)(g.cw + tap * LRU_W + ch), w1 = *(const f32x4*)(g.cw + tap * LRU_W + ch + 4);
        a[0] += w0.x * x[0]; a[1] += w0.y * x[1]; a[2] += w0.z * x[2]; a[3] += w0.w * x[3];
        a[4] += w1.x * x[4]; a[5] += w1.y * x[5]; a[6] += w1.z * x[6]; a[7] += w1.w * x[7];
      }
    }
    const u32x4 o = pk8(a);
    return __builtin_bit_cast(bf16x8, o);
  }
}

template <int AMODE> DEVI void g_load(const GemmDesc& g, bf16x8 (&ar)[4], bf16x8 (&br)[2], int m0, int n0, int srow, int sc, int kt) {
#pragma unroll
  for (int i = 0; i < 4; ++i) ar[i] = load_a<AMODE>(g, m0 + srow + 64 * i, kt * 64 + sc * 8);
#pragma unroll
  for (int i = 0; i < 2; ++i) br[i] = *(const bf16x8*)(g.Bt + (size_t)(n0 + srow + 64 * i) * g.ldb + kt * 64 + sc * 8);
}
template <bool NORM> DEVI void g_write(char* Ab, const bf16x8 (&ar)[4], const bf16x8 (&br)[2], float (&ssq)[4], int srow, int sc) {
  char* Bb = Ab + 32768;
#pragma unroll
  for (int i = 0; i < 4; ++i) { *(bf16x8*)(Ab + swz(srow + 64 * i, sc)) = ar[i];
    if (NORM) { float x[8]; unpk8(__builtin_bit_cast(u32x4, ar[i]), x); float s = ssq[i];
#pragma unroll
      for (int q = 0; q < 8; ++q) s = fmaf(x[q], x[q], s);
      ssq[i] = s; } }
#pragma unroll
  for (int i = 0; i < 2; ++i) *(bf16x8*)(Bb + swz(srow + 64 * i, sc)) = br[i];
}

template <int AMODE, int SEG, class Epi>
DEVI void gemm_tile(const GemmDesc& g, int m0, int n0, char* lds, const Epi& epi) {
  const int tid = tidx(), lane = tid & 63, wid = tid >> 6;
  const int wm = wid >> 1, wn = wid & 1, r32 = lane & 31, hi = lane >> 5;
  const int srow = tid >> 3, sc = tid & 7;
  constexpr bool NORM = SEG != 0;
  float* rs = (float*)(lds + LDS_RS);
  f32x16 acc[2][2], acc2[2][2];
#pragma unroll
  for (int i = 0; i < 2; ++i)
#pragma unroll
    for (int j = 0; j < 2; ++j) { acc[i][j] = f32x16{}; acc2[i][j] = f32x16{}; }
  float ssq[4] = {0.f, 0.f, 0.f, 0.f};
  bf16x8 ar[4], br[2];
  g_load<AMODE>(g, ar, br, m0, n0, srow, sc, 0); g_write<NORM>(lds, ar, br, ssq, srow, sc); __syncthreads();
  int seg = 0;
#pragma unroll 1
  for (int kt = 0; kt < g.KT; ++kt) {
    const int cur = kt & 1;
    if (kt + 1 < g.KT) g_load<AMODE>(g, ar, br, m0, n0, srow, sc, kt + 1);
    { const char* Ab = lds + cur * 49152; const char* Bb = Ab + 32768;
#pragma unroll
      for (int k16 = 0; k16 < 4; ++k16) {
        bf16x8 a[2], b[2];
#pragma unroll
        for (int mt = 0; mt < 2; ++mt) a[mt] = *(const bf16x8*)(Ab + swz(wm * 64 + mt * 32 + r32, k16 * 2 + hi));
#pragma unroll
        for (int nt = 0; nt < 2; ++nt) b[nt] = *(const bf16x8*)(Bb + swz(wn * 64 + nt * 32 + r32, k16 * 2 + hi));
#pragma unroll
        for (int mt = 0; mt < 2; ++mt)
#pragma unroll
          for (int nt = 0; nt < 2; ++nt) {
            if (NORM) acc2[mt][nt] = __builtin_amdgcn_mfma_f32_32x32x16_bf16(a[mt], b[nt], acc2[mt][nt], 0, 0, 0);
            else acc[mt][nt] = __builtin_amdgcn_mfma_f32_32x32x16_bf16(a[mt], b[nt], acc[mt][nt], 0, 0, 0);
          }
      } }
    if (NORM) {
      int se; float inv;
      if (SEG == 1) { se = g.KT; inv = g.inv0; }
      else { se = seg == 0 ? 6 : (seg == 1 ? 12 : 16); inv = seg == 2 ? (1.f / 256.f) : (1.f / 384.f); }
      if (kt + 1 == se) {
#pragma unroll
        for (int i = 0; i < 4; ++i) { float s = ssq[i]; s += __shfl_xor(s, 1); s += __shfl_xor(s, 2); s += __shfl_xor(s, 4); if (sc == 0) rs[srow + 64 * i] = rsqrtf(s * inv + EPS); }
        __syncthreads();
#pragma unroll
        for (int mt = 0; mt < 2; ++mt)
#pragma unroll
          for (int r = 0; r < 16; ++r) { const float f = rs[wm * 64 + mt * 32 + crow(r, hi)];
#pragma unroll
            for (int nt = 0; nt < 2; ++nt) { acc[mt][nt][r] = fmaf(f, acc2[mt][nt][r], acc[mt][nt][r]); acc2[mt][nt][r] = 0.f; } }
        ssq[0] = ssq[1] = ssq[2] = ssq[3] = 0.f;
        ++seg;
      }
    }
    if (kt + 1 < g.KT) g_write<NORM>(lds + (cur ^ 1) * 49152, ar, br, ssq, srow, sc);
    __syncthreads();
  }
  float* C = (float*)lds;
#pragma unroll
  for (int mt = 0; mt < 2; ++mt)
#pragma unroll
    for (int nt = 0; nt < 2; ++nt)
#pragma unroll
      for (int r = 0; r < 16; ++r) C[(wm * 64 + mt * 32 + crow(r, hi)) * CLD + wn * 64 + nt * 32 + r32] = acc[mt][nt][r];
  __syncthreads();
  epi(C, m0, n0);
  __syncthreads();
}

DEVI GemmDesc gemm_desc(const u16* A, int lda, const u16* Bt, int ldb, int K) {
  GemmDesc g{}; g.A = A; g.lda = lda; g.Bt = Bt; g.ldb = ldb; g.KT = K / 64; g.inv0 = 1.f / (float)K; return g;
}

DEVI void ld8(const float* p, float* v) { const f32x4 a = *(const f32x4*)p, b = *(const f32x4*)(p + 4); v[0] = a.x; v[1] = a.y; v[2] = a.z; v[3] = a.w; v[4] = b.x; v[5] = b.y; v[6] = b.z; v[7] = b.w; }

template <int HW> DEVI void rope8(float* v, const float* pp, int i0, float posf) {
  const bool first = i0 < HW; const int f0 = i0 & (HW - 1);
#pragma unroll
  for (int j = 0; j < 8; ++j) { float sn, cs; rope_sc(posf, HW == 32 ? (f0 + j) : 2 * (f0 + j), sn, cs); const float pv = pp[j]; v[j] = first ? v[j] * cs - pv * sn : v[j] * cs + pv * sn; }
}

struct EpiP1 { u16* proj; const int* pos;
  DEVI void operator()(const float* C, int m0, int n0) const {
    const int tid = tidx();
#pragma unroll 1
    for (int it = 0; it < 8; ++it) { const int item = it * NTHREADS + tid, row = item >> 4, c8 = (item & 15) * 8, gcol = n0 + c8, grow = m0 + row;
      float v[8]; ld8(C + row * CLD + c8, v);
      const bool r64 = gcol >= PC_SQ && gcol < PC_SV, r32g = gcol >= PC_KR && gcol < PC_KR + 32;
      if (r64) { const int i0 = gcol & 63; float pp[8]; ld8(C + row * CLD + c8 + (i0 < 32 ? 32 : -32), pp); rope8<32>(v, pp, i0, (float)pos[grow]); }
      else if (r32g) { const int i0 = gcol & 31; float pp[8]; ld8(C + row * CLD + c8 + (i0 < 16 ? 16 : -16), pp); rope8<16>(v, pp, i0, (float)pos[grow]); }
      *(u32x4*)(proj + (size_t)grow * INWP + gcol) = pk8(v);
    }
  }
};

struct EpiQ { u16* qm; const int* pos;
  DEVI void operator()(const float* C, int m0, int n0) const {
    const int tid = tidx();
#pragma unroll 1
    for (int it = 0; it < 8; ++it) { const int item = it * NTHREADS + tid, row = item >> 4, c8 = (item & 15) * 8, gcol = n0 + c8, grow = m0 + row;
      if (gcol >= 576) continue;
      const int head = gcol / 96, j0 = gcol - head * 96, b = grow >> 13, s = grow & (SEQ - 1);
      float v[8]; ld8(C + row * CLD + c8, v);
      if (j0 >= 64) { const int i0 = j0 - 64; float pp[8]; ld8(C + row * CLD + c8 + (i0 < 16 ? 16 : -16), pp); rope8<16>(v, pp, i0, (float)pos[grow]); }
      *(u32x4*)(qm + ((size_t)(b * MLA_H + head) * SEQ + s) * MLA_QK + j0) = pk8(v);
    }
  }
};

struct EpiKV { u16* km; u16* vm; const u16* proj;
  DEVI void operator()(const float* C, int m0, int n0) const {
    const int tid = tidx(), head = n0 >> 7;
#pragma unroll 1
    for (int it = 0; it < 8; ++it) { const int item = it * NTHREADS + tid, row = item >> 4, c8 = (item & 15) * 8, grow = m0 + row;
      const int b = grow >> 13, s = grow & (SEQ - 1);
      float v[8]; ld8(C + row * CLD + c8, v);
      const size_t tok = (size_t)(b * MLA_H + head) * SEQ + s;
      if (c8 < 64) *(u32x4*)(km + tok * MLA_QK + c8) = pk8(v);
      else *(u32x4*)(vm + tok * MLA_V + (c8 - 64)) = pk8(v);
    }
#pragma unroll 1
    for (int it = 0; it < 2; ++it) { const int item = it * NTHREADS + tid, row = item >> 2, c = (item & 3) * 8, grow = m0 + row;
      const int b = grow >> 13, s = grow & (SEQ - 1);
      *(u32x4*)(km + ((size_t)(b * MLA_H + head) * SEQ + s) * MLA_QK + 64 + c) = *(const u32x4*)(proj + (size_t)grow * INWP + PC_KR + c);
    }
  }
};

struct EpiLRU { const u16* proj; const float* cw; const float* cb; const float* ba; const float* bx; const float* lam; u16* le; u16* lb; int n, d;
  DEVI void operator()(const float* C, int m0, int) const {
    const int tid = tidx();
#pragma unroll 1
    for (int it = 0; it < 4; ++it) { const int item = it * NTHREADS + tid, j = item & 63, g8 = item >> 6;
      const int ch = n * 64 + j, grow0 = m0 + g8 * 8, s0 = grow0 & (SEQ - 1), b = grow0 >> 13;
      const float bav = ba[(d * 6 + n) * 64 + j], bxv = bx[(d * 6 + n) * 64 + j];
      const float cdec = -8.f * log1pf(__expf(-lam[d * LRU_W + ch]));
      float xin[11];
#pragma unroll
      for (int q = 0; q < 11; ++q) { const int ss = s0 - 1 + q; xin[q] = (ss >= 0 && ss < SEQ) ? bf2f(proj[(size_t)(grow0 - 1 + q) * INWP + PC_LX + ch]) : 0.f; }
      const float w0 = cw[ch], w1 = cw[LRU_W + ch], w2 = cw[2 * LRU_W + ch], w3 = cw[3 * LRU_W + ch], cbv = cb[ch];
      float ev[8], bv[8];
#pragma unroll
      for (int rr = 0; rr < 8; ++rr) {
        const float xf = cbv + w0 * xin[rr] + w1 * xin[rr + 1] + w2 * xin[rr + 2] + w3 * xin[rr + 3];
        const float r = sigmoidf_(C[(g8 * 8 + rr) * CLD + j] + bav), ig = sigmoidf_(C[(g8 * 8 + rr) * CLD + 64 + j] + bxv);
        const float a = __expf(cdec * r), e = 1.f - a;
        ev[rr] = e; bv[rr] = sqrtf(e * (2.f - e)) * ig * xf;
      }
      const size_t o = (((size_t)(d * NB + b) * (SEQ / 8) + (s0 >> 3)) * LRU_W + ch) * 8;
      *(u32x4*)(le + o) = pk8(ev); *(u32x4*)(lb + o) = pk8(bv);
    }
  }
};

struct EpiP4 { const float* xres; float* xout; u16* xg;
  DEVI void operator()(const float* C, int m0, int n0) const {
    const int tid = tidx();
#pragma unroll 1
    for (int it = 0; it < 8; ++it) { const int item = it * NTHREADS + tid, row = item >> 4, c8 = (item & 15) * 8, gcol = n0 + c8, grow = m0 + row;
      float v[8], x[8]; ld8(C + row * CLD + c8, v); ld8(xres + (size_t)grow * DM + gcol, x);
#pragma unroll
      for (int j = 0; j < 8; ++j) v[j] += x[j];
      *(f32x4*)(xout + (size_t)grow * DM + gcol) = (f32x4){v[0], v[1], v[2], v[3]}; *(f32x4*)(xout + (size_t)grow * DM + gcol + 4) = (f32x4){v[4], v[5], v[6], v[7]};
      *(u32x4*)(xg + (size_t)grow * DM + gcol) = pk8(v);
    }
  }
};

struct EpiBf16 { u16* o; int ldo;
  DEVI void operator()(const float* C, int m0, int n0) const {
    const int tid = tidx();
#pragma unroll 1
    for (int it = 0; it < 8; ++it) { const int item = it * NTHREADS + tid, row = item >> 4, c8 = (item & 15) * 8;
      float v[8]; ld8(C + row * CLD + c8, v);
      *(u32x4*)(o + (size_t)(m0 + row) * ldo + n0 + c8) = pk8(v);
    }
  }
};

DEVI void ce_desc(float& a, float& b) { const float mx = fmaxf(a, b), mn = fminf(a, b); a = mx; b = mn; }
struct EpiTop { float* top; int hj;
  DEVI void operator()(const float* C, int m0, int) const {
    const int tid = tidx(), row = tid >> 1, part = tid & 1;
    float l[16];
#pragma unroll
    for (int i = 0; i < 16; ++i) l[i] = -3.0e38f;
#pragma unroll 4
    for (int c = 0; c < 64; ++c) { const int col = part * 64 + ((c + row) & 63);
      float v = __uint_as_float((__float_as_uint(C[row * CLD + col]) & ~127u) | (unsigned)(127 - col));
#pragma unroll
      for (int i = 0; i < 16; ++i) { const float t = fmaxf(l[i], v); v = fminf(l[i], v); l[i] = t; } }
    float m[16];
#pragma unroll
    for (int i = 0; i < 16; ++i) m[i] = __shfl_xor(l[15 - i], 1);
#pragma unroll
    for (int i = 0; i < 16; ++i) m[i] = fmaxf(m[i], l[i]);
#pragma unroll
    for (int st = 8; st >= 1; st >>= 1)
#pragma unroll
      for (int i = 0; i < 16; ++i) if ((i & st) == 0) ce_desc(m[i], m[i + st]);
    if (part == 0) { float* o = top + ((size_t)(m0 + row) * 16 + hj) * 16;
#pragma unroll
      for (int i = 0; i < 4; ++i) *(f32x4*)(o + 4 * i) = (f32x4){m[4 * i], m[4 * i + 1], m[4 * i + 2], m[4 * i + 3]}; }
  }
};

#define KSWZ(row, colB) ((row) * 256 + ((colB) ^ (((row) & 7) << 4)))
#define SBAR() __builtin_amdgcn_sched_barrier(0)
constexpr int AT_SHM_V = 64 * 64 * 2, AT_SHM_K = 64 * 128 * 2;
constexpr int AT_LDS = 2 * AT_SHM_V + 2 * AT_SHM_K + 8 * 64 * 4;
constexpr float ATT_THR = 8.f;
DEVI unsigned cvtpk(float lo, float hi) { unsigned r; asm volatile("v_cvt_pk_bf16_f32 %0, %1, %2" : "=v"(r) : "v"(lo), "v"(hi)); return r; }
DEVI int v_st(int k, int c) { const int kk = (k & ~0xC) | ((k & 4) << 1) | ((k & 8) >> 1); return ((kk >> 3) * 2 + (c >> 5)) * 512 + ((kk & 7) * 32 + (c & 31)) * 2; }
DEVI int v_rd_base(int lane) { return ((lane & 3) << 3) | (((lane >> 2) & 3) << 6) | (((lane >> 4) & 1) << 5) | (((lane >> 5) & 1) << 8); }
constexpr int v_rd_off(int d0, int ks, int half) { return d0 * 512 + ks * 2048 + half * 1024; }
template <int OFF> DEVI s16x4 tr_read(int vb) { s16x4 r; asm volatile("ds_read_b64_tr_b16 %0, %1 offset:%2" : "=&v"(r) : "v"(vb), "i"(OFF) : "memory"); return r; }

template <bool MASK>
DEVI void partialSM(f32x16& p0, f32x16& p1, float& m_reg, float& mn, float& alpha, float SCALE, int kpos0, int qpos, int hi) {
  const float C = SCALE * 1.4426950408889634f;
  if (MASK) {
#pragma unroll
    for (int r = 0; r < 16; ++r) { const int k0 = kpos0 + crow(r, hi) - qpos; const int k1 = k0 + 32;
      if (k0 > 128 || k0 < -128) p0[r] = -1e30f;
      if (k1 > 128 || k1 < -128) p1[r] = -1e30f; }
  }
  float pmax = p0[0];
#pragma unroll
  for (int r = 1; r < 16; ++r) pmax = fmaxf(pmax, p0[r]);
#pragma unroll
  for (int r = 0; r < 16; ++r) pmax = fmaxf(pmax, p1[r]);
  { auto rr = __builtin_amdgcn_permlane32_swap(__float_as_uint(pmax), __float_as_uint(pmax), false, false);
    pmax = fmaxf(__uint_as_float(rr[0]), __uint_as_float(rr[1])); }
  if (__builtin_expect(__all(pmax - m_reg <= ATT_THR / SCALE), 1)) { mn = m_reg; alpha = 1.f; }
  else { mn = fmaxf(m_reg, pmax); alpha = __builtin_amdgcn_exp2f((m_reg - mn) * C); m_reg = mn; }
  const float mnC = -mn * C;
#pragma unroll
  for (int r = 0; r < 16; ++r) p0[r] = fmaf(p0[r], C, mnC);
#pragma unroll
  for (int r = 0; r < 16; ++r) p1[r] = fmaf(p1[r], C, mnC);
#pragma unroll
  for (int r = 0; r < 16; ++r) p0[r] = __builtin_amdgcn_exp2f(p0[r]);
}
DEVI void finishSM(f32x16& p0, f32x16& p1, float alpha, float& l_reg, bf16x8& pa0, bf16x8& pa1, bf16x8& pa2, bf16x8& pa3) {
#pragma unroll
  for (int r = 0; r < 16; ++r) p1[r] = __builtin_amdgcn_exp2f(p1[r]);
  float ps = 0;
#pragma unroll
  for (int r = 0; r < 16; ++r) ps += p0[r];
#pragma unroll
  for (int r = 0; r < 16; ++r) ps += p1[r];
  { auto rr = __builtin_amdgcn_permlane32_swap(__float_as_uint(ps), __float_as_uint(ps), false, false);
    ps = __uint_as_float(rr[0]) + __uint_as_float(rr[1]); }
  l_reg = l_reg * alpha + ps;
#define PK4(P, BASE, OUT) do { unsigned a0 = cvtpk(P[BASE + 0], P[BASE + 1]), a1 = cvtpk(P[BASE + 2], P[BASE + 3]);   \
    unsigned b0 = cvtpk(P[BASE + 4], P[BASE + 5]), b1 = cvtpk(P[BASE + 6], P[BASE + 7]);                              \
    auto r0 = __builtin_amdgcn_permlane32_swap(a0, b0, false, false); auto r1 = __builtin_amdgcn_permlane32_swap(a1, b1, false, false); \
    u32x4 w = {r0[0], r1[0], r0[1], r1[1]}; OUT = __builtin_bit_cast(bf16x8, w); } while (0)
  PK4(p0, 0, pa0); PK4(p0, 8, pa1); PK4(p1, 0, pa2); PK4(p1, 8, pa3);
#undef PK4
}
template <int ND0>
DEVI void qkt(f32x16& p0, f32x16& p1, const char* Ks, const bf16x8* qr, int r32, int hi) {
  p0 = f32x16{}; p1 = f32x16{};
#pragma unroll
  for (int d0 = 0; d0 < ND0; ++d0) { const int cb = (d0 * 16 + hi * 8) * 2;
    const bf16x8 b0 = *(const bf16x8*)(Ks + KSWZ(r32, cb));
    const bf16x8 b1 = *(const bf16x8*)(Ks + KSWZ(32 + r32, cb));
    p0 = __builtin_amdgcn_mfma_f32_32x32x16_bf16(b0, qr[d0], p0, 0, 0, 0);
    p1 = __builtin_amdgcn_mfma_f32_32x32x16_bf16(b1, qr[d0], p1, 0, 0, 0); }
}
template <int D0> DEVI void pv_one(f32x16& od, int vb, bf16x8 pa0, bf16x8 pa1, bf16x8 pa2, bf16x8 pa3) {
  const s16x4 l0 = tr_read<v_rd_off(D0, 0, 0)>(vb), h0 = tr_read<v_rd_off(D0, 0, 1)>(vb), l1 = tr_read<v_rd_off(D0, 1, 0)>(vb), h1 = tr_read<v_rd_off(D0, 1, 1)>(vb);
  const s16x4 l2 = tr_read<v_rd_off(D0, 2, 0)>(vb), h2 = tr_read<v_rd_off(D0, 2, 1)>(vb), l3 = tr_read<v_rd_off(D0, 3, 0)>(vb), h3 = tr_read<v_rd_off(D0, 3, 1)>(vb);
  asm volatile("s_waitcnt lgkmcnt(0)" ::: "memory"); SBAR();
#define PK(L, H) (bf16x8){L[0], L[1], L[2], L[3], H[0], H[1], H[2], H[3]}
  od = __builtin_amdgcn_mfma_f32_32x32x16_bf16(pa0, PK(l0, h0), od, 0, 0, 0);
  od = __builtin_amdgcn_mfma_f32_32x32x16_bf16(pa1, PK(l1, h1), od, 0, 0, 0);
  od = __builtin_amdgcn_mfma_f32_32x32x16_bf16(pa2, PK(l2, h2), od, 0, 0, 0);
  od = __builtin_amdgcn_mfma_f32_32x32x16_bf16(pa3, PK(l3, h3), od, 0, 0, 0);
#undef PK
}
DEVI void pv_d0(f32x16* o, int vb, bf16x8 pa0, bf16x8 pa1, bf16x8 pa2, bf16x8 pa3) {
  pv_one<0>(o[0], vb, pa0, pa1, pa2, pa3); pv_one<1>(o[1], vb, pa0, pa1, pa2, pa3);
}

template <int DQK, bool MASK>
DEVI void attn_body(const u16* Qw, const u16* Kh, int ldk, const u16* Vh, int ldv, int kt0, int NT, float SCALE, float m_init, float l_init,
                    int qpos, u16* Ow, char* lds) {
  constexpr int ND0 = DQK / 16, NCK = DQK / 8, NK2 = 64 * NCK - NTHREADS;
  const int tid = tidx(), wid = tid >> 6, lane = tid & 63, r32 = lane & 31, hi = lane >> 5;
  char* V_lds = lds; char* K_lds = lds + 2 * AT_SHM_V;
  float* wsx = (float*)(lds + 2 * AT_SHM_V + 2 * AT_SHM_K) + wid * 64; float* li_l = wsx; float* al_l = wsx + 32;
  float m_reg = m_init, l_reg = l_init; f32x16 o[2] = {f32x16{}, f32x16{}}; bf16x8 qr[ND0];
#pragma unroll
  for (int d0 = 0; d0 < ND0; ++d0) qr[d0] = *(const bf16x8*)(Qw + d0 * 16);
  const int vr = tid >> 3, vc = (tid & 7) * 8, vst0 = v_st(vr, vc);
  const int k0r = tid / NCK, k0c = tid - k0r * NCK;
  const int k1id = tid + NTHREADS, k1r = k1id / NCK, k1c = k1id - k1r * NCK; const bool has2 = tid < NK2;
  const int vb0 = (int)(uintptr_t)V_lds + v_rd_base(lane);
  bf16x8 sv[2], sk0[2], sk1[2];
#define SLOAD(i, t_) do { const size_t kk0 = (size_t)(t_) * 64; sv[i] = *(const bf16x8*)(Vh + (kk0 + vr) * ldv + vc); \
    sk0[i] = *(const bf16x8*)(Kh + (kk0 + k0r) * ldk + k0c * 8); if (NK2 > 0) { if (has2) sk1[i] = *(const bf16x8*)(Kh + (kk0 + k1r) * ldk + k1c * 8); } } while (0)
#define SWRITE(b, i) do { *(bf16x8*)(V_lds + (b) * AT_SHM_V + vst0) = sv[i]; *(bf16x8*)(K_lds + (b) * AT_SHM_K + KSWZ(k0r, k0c * 16)) = sk0[i]; \
    if (NK2 > 0) { if (has2) *(bf16x8*)(K_lds + (b) * AT_SHM_K + KSWZ(k1r, k1c * 16)) = sk1[i]; } } while (0)
#define RESC(a) do { if (__any((a) < 1.f)) { if (hi == 0) al_l[r32] = (a); asm volatile("s_waitcnt lgkmcnt(0)" ::: "memory"); \
    _Pragma("unroll") for (int d = 0; d < 2; ++d) _Pragma("unroll") for (int r = 0; r < 16; ++r) o[d][r] *= al_l[crow(r, hi)]; } } while (0)
  f32x16 pA0, pA1, pB0, pB1; float mnA, mnB, alA, alB; bf16x8 pa0, pa1, pa2, pa3;
  constexpr int SE = 0, SO = 1;
  SLOAD(SE, kt0); asm volatile("s_waitcnt vmcnt(0)" ::: "memory"); SWRITE(0, SE); __syncthreads();
  qkt<ND0>(pA0, pA1, K_lds, qr, r32, hi); partialSM<MASK>(pA0, pA1, m_reg, mnA, alA, SCALE, kt0 * 64, qpos, hi);
  SLOAD(SO, kt0 + 1); if (2 < NT) SLOAD(SE, kt0 + 2);
  SWRITE(1, SO); __syncthreads();
  for (int j = 1; j + 1 < NT; j += 2) {
    SBAR(); qkt<ND0>(pB0, pB1, K_lds + AT_SHM_K, qr, r32, hi);
    finishSM(pA0, pA1, alA, l_reg, pa0, pa1, pa2, pa3); SBAR();
    SLOAD(SO, kt0 + j + 2); SBAR();
    pv_d0(o, vb0, pa0, pa1, pa2, pa3); partialSM<MASK>(pB0, pB1, m_reg, mnB, alB, SCALE, (kt0 + j) * 64, qpos, hi);
    __syncthreads(); SWRITE(0, SE);
    RESC(alB); __syncthreads();
    SBAR(); qkt<ND0>(pA0, pA1, K_lds, qr, r32, hi);
    finishSM(pB0, pB1, alB, l_reg, pa0, pa1, pa2, pa3); SBAR();
    if (j + 3 < NT) SLOAD(SE, kt0 + j + 3); SBAR();
    pv_d0(o, vb0 + AT_SHM_V, pa0, pa1, pa2, pa3); partialSM<MASK>(pA0, pA1, m_reg, mnA, alA, SCALE, (kt0 + j + 1) * 64, qpos, hi);
    __syncthreads(); SWRITE(1, SO);
    RESC(alA); __syncthreads();
  }
  SBAR(); qkt<ND0>(pB0, pB1, K_lds + AT_SHM_K, qr, r32, hi);
  finishSM(pA0, pA1, alA, l_reg, pa0, pa1, pa2, pa3); SBAR();
  pv_d0(o, vb0, pa0, pa1, pa2, pa3); partialSM<MASK>(pB0, pB1, m_reg, mnB, alB, SCALE, (kt0 + NT - 1) * 64, qpos, hi);
  __syncthreads(); RESC(alB);
  finishSM(pB0, pB1, alB, l_reg, pa0, pa1, pa2, pa3); SBAR();
  pv_d0(o, vb0 + AT_SHM_V, pa0, pa1, pa2, pa3);
  if (hi == 0) li_l[r32] = l_reg; asm volatile("s_waitcnt lgkmcnt(0)" ::: "memory");
  float rli[16];
#pragma unroll
  for (int r = 0; r < 16; ++r) rli[r] = __builtin_amdgcn_rcpf(li_l[crow(r, hi)]);
#pragma unroll
  for (int r = 0; r < 16; ++r) { const int orow = crow(r, hi);
#pragma unroll
    for (int d0 = 0; d0 < 2; ++d0) Ow[(size_t)orow * DM + d0 * 32 + r32] = f2bf(o[d0][r] * rli[r]); }
  __syncthreads();
#undef SLOAD
#undef SWRITE
#undef RESC
}

constexpr int LCH = 64, NLCH = SEQ / LCH;
constexpr size_t WS_LP = 1 * MiB, WS_LH = 2560 * 1024;
constexpr size_t WS_LC = 473 * MiB;
constexpr size_t WS_NEED = 475 * MiB;
DEVI void lru_passA(const Params& p, int item, int lane) {
  const int cg = item % 6, c = (item / 6) % NLCH, b = (item / (6 * NLCH)) % NB, d = item / (6 * NLCH * NB);
  const size_t base = (((size_t)(d * NB + b) * (SEQ / 8) + c * 8) * LRU_W + cg * 64 + lane) * 8;
  const u16* E = (const u16*)(p.ws + WS_LE) + base; const u16* Bp = (const u16*)(p.ws + WS_LB) + base;
  u32x4 ev[8], bv[8];
#pragma unroll
  for (int g = 0; g < 8; ++g) { ev[g] = *(const u32x4*)(E + (size_t)g * LRU_W * 8); bv[g] = *(const u32x4*)(Bp + (size_t)g * LRU_W * 8); }
  float h = 0.f, P = 1.f;
#pragma unroll
  for (int gg = 0; gg < 8; ++gg) { const int g = d ? 7 - gg : gg; float e[8], bb[8]; unpk8(ev[g], e); unpk8(bv[g], bb);
#pragma unroll
    for (int rr = 0; rr < 8; ++rr) { const int r = d ? 7 - rr : rr; const float a = 1.f - e[r]; h = fmaf(a, h, bb[r]); P *= a; } }
  const size_t o = ((size_t)(d * NB + b) * NLCH + c) * LRU_W + cg * 64 + lane;
  ((float*)(p.ws + WS_LP))[o] = P; ((float*)(p.ws + WS_LH))[o] = h;
}

DEVI void lru_final(const Params& p, int item, char* lds) {
  const int tid = tidx(), wid = tid >> 6, lane = tid & 63;
  const int c = item % NLCH, b = item / NLCH;
  float* obuf = (float*)lds;
  if (wid < 6) {
    const int ch = wid * 64 + lane;
#pragma unroll
    for (int d = 0; d < 2; ++d) {
      const size_t co = ((size_t)(d * NB + b) * NLCH + c) * LRU_W + ch;
      float h = ((const float*)(p.ws + WS_LC))[co];
      const size_t base = (((size_t)(d * NB + b) * (SEQ / 8) + c * 8) * LRU_W + ch) * 8;
      const u16* E = (const u16*)(p.ws + WS_LE) + base; const u16* Bp = (const u16*)(p.ws + WS_LB) + base;
      u32x4 ev[8], bv[8];
#pragma unroll
      for (int g = 0; g < 8; ++g) { ev[g] = *(const u32x4*)(E + (size_t)g * LRU_W * 8); bv[g] = *(const u32x4*)(Bp + (size_t)g * LRU_W * 8); }
      if (d == 0) {
#pragma unroll
        for (int g = 0; g < 8; ++g) { float e[8], bb[8]; unpk8(ev[g], e); unpk8(bv[g], bb);
#pragma unroll
          for (int r = 0; r < 8; ++r) { h = fmaf(1.f - e[r], h, bb[r]); obuf[(g * 8 + r) * LRU_W + ch] = h; } }
      } else {
        const u16* gp = (const u16*)(p.ws + WS_R1) + ((size_t)b * SEQ + c * LCH) * INWP + PC_LG + ch;
#pragma unroll
        for (int g = 7; g >= 0; --g) { float e[8], bb[8]; unpk8(ev[g], e); unpk8(bv[g], bb);
#pragma unroll
          for (int r = 7; r >= 0; --r) { h = fmaf(1.f - e[r], h, bb[r]); const int tk = g * 8 + r;
            const float gt = bf2f(gp[(size_t)tk * INWP]); obuf[tk * LRU_W + ch] = (obuf[tk * LRU_W + ch] + h) * gelu_erf(gt); } }
      }
    }
  }
  __syncthreads();
  u16* mp = (u16*)(p.ws + WS_MIX) + ((size_t)b * SEQ + c * LCH) * DM + 384;
#pragma unroll 1
  for (int i = 0; i < 8; ++i) { const int tk = wid * 8 + i;
    float v[6]; float s = 0.f;
#pragma unroll
    for (int q = 0; q < 3; ++q) { const f32x2 t2 = *(const f32x2*)(obuf + tk * LRU_W + q * 128 + lane * 2); v[2 * q] = t2.x; v[2 * q + 1] = t2.y; s = fmaf(t2.x, t2.x, s); s = fmaf(t2.y, t2.y, s); }
    s = wave_sum(s);
    const float rs = rsqrtf(s * (1.f / 384.f) + EPS);
#pragma unroll
    for (int q = 0; q < 3; ++q) *(unsigned*)(mp + (size_t)tk * DM + q * 128 + lane * 2) = pk2(v[2 * q] * rs, v[2 * q + 1] * rs);
  }
  __syncthreads();
}

DEVI void peer_cand(const Params& p, int vb, int nb, char* lds) {
  const int tid = tidx();
  unsigned char* my = (unsigned char*)lds + tid * 32;
  const float* top = (const float*)(p.ws + WS_TOP);
  int* eidx = (int*)(p.ws + WS_EIDX); float* egate = (float*)(p.ws + WS_EGATE);
  for (int it = vb * NTHREADS + tid; it < T * 8; it += nb * NTHREADS) {
    float v1[16], v2[16];
    const float* tp = top + (size_t)it * 32;
#pragma unroll
    for (int i = 0; i < 4; ++i) { const f32x4 a = *(const f32x4*)(tp + 4 * i), b = *(const f32x4*)(tp + 16 + 4 * i);
      v1[4 * i] = a.x; v1[4 * i + 1] = a.y; v1[4 * i + 2] = a.z; v1[4 * i + 3] = a.w; v2[4 * i] = b.x; v2[4 * i + 1] = b.y; v2[4 * i + 2] = b.z; v2[4 * i + 3] = b.w; }
#pragma unroll
    for (int i = 0; i < 16; ++i) { my[i] = (unsigned char)(127u - (__float_as_uint(v1[i]) & 127u)); my[16 + i] = (unsigned char)(127u - (__float_as_uint(v2[i]) & 127u)); }
    float l[16];
#pragma unroll
    for (int i = 0; i < 16; ++i) l[i] = -3.0e38f;
#pragma unroll
    for (int a = 0; a < 16; ++a)
#pragma unroll
      for (int b = 0; b < 16; ++b) if ((a + 1) * (b + 1) <= 16) {
        float v = __uint_as_float((__float_as_uint(v1[a] + v2[b]) & ~255u) | (unsigned)(255 - (a * 16 + b)));
#pragma unroll
        for (int i = 0; i < 16; ++i) { const float t = fmaxf(l[i], v); v = fminf(l[i], v); l[i] = t; } }
    const float mx = __uint_as_float(__float_as_uint(l[0]) & ~255u);
    float w[16], sum = 0.f;
#pragma unroll
    for (int i = 0; i < 16; ++i) { w[i] = __expf(__uint_as_float(__float_as_uint(l[i]) & ~255u) - mx); sum += w[i]; }
    const float inv = 1.f / sum;
    int ev[16];
#pragma unroll
    for (int i = 0; i < 16; ++i) { const unsigned code = 255u - (__float_as_uint(l[i]) & 255u); ev[i] = (int)my[code >> 4] * 128 + (int)my[16 + (code & 15)]; w[i] *= inv; }
#pragma unroll
    for (int i = 0; i < 4; ++i) { *(int4*)(eidx + (size_t)it * 16 + 4 * i) = make_int4(ev[4 * i], ev[4 * i + 1], ev[4 * i + 2], ev[4 * i + 3]);
      *(f32x4*)(egate + (size_t)it * 16 + 4 * i) = (f32x4){w[4 * i], w[4 * i + 1], w[4 * i + 2], w[4 * i + 3]}; }
  }
}

DEVI float dot2bf(unsigned w, unsigned x, float acc) { return __builtin_amdgcn_fdot2_f32_bf16(__builtin_bit_cast(bf16x2_t, w), __builtin_bit_cast(bf16x2_t, x), acc, false); }
DEVI void peer_token(const Params& p, int layer, int t, const float* xin, float* xout, bool last, char* wl  ) {
  const int lane = tidx() & 63, q = lane >> 4, j = lane & 15;
  int* s_idx = (int*)wl; float* s_gate = (float*)(wl + 512); float* s_c = (float*)(wl + 1024);
  const u16* UB = (const u16*)(p.ws + WS_UB); const u16* VB = (const u16*)(p.ws + WS_VB);
  const float* gf = p.norm_ffn + layer * DM;
  s_idx[lane] = ((const int*)(p.ws + WS_EIDX))[(size_t)t * 128 + lane]; s_idx[64 + lane] = ((const int*)(p.ws + WS_EIDX))[(size_t)t * 128 + 64 + lane];
  s_gate[lane] = ((const float*)(p.ws + WS_EGATE))[(size_t)t * 128 + lane]; s_gate[64 + lane] = ((const float*)(p.ws + WS_EGATE))[(size_t)t * 128 + 64 + lane];
  unsigned xp[32];
  { float xv[64]; float ss = 0.f;
#pragma unroll
    for (int k = 0; k < 8; ++k) { ld8(xin + (size_t)t * DM + (j + 16 * k) * 8, xv + 8 * k);
#pragma unroll
      for (int i = 0; i < 8; ++i) ss = fmaf(xv[8 * k + i], xv[8 * k + i], ss); }
    ss += __shfl_xor(ss, 1); ss += __shfl_xor(ss, 2); ss += __shfl_xor(ss, 4); ss += __shfl_xor(ss, 8);
    const float rsx = rsqrtf(ss * (1.f / DM) + EPS);
#pragma unroll
    for (int k = 0; k < 8; ++k) { float g8[8]; ld8(gf + (j + 16 * k) * 8, g8);
#pragma unroll
      for (int i = 0; i < 4; ++i) xp[4 * k + i] = pk2(xv[8 * k + 2 * i] * rsx * g8[2 * i], xv[8 * k + 2 * i + 1] * rsx * g8[2 * i + 1]); } }
  asm volatile("s_waitcnt lgkmcnt(0)" ::: "memory");
  u32x4 cu[8], nu[8];
  { const u16* r0 = UB + (size_t)s_idx[q] * DM + j * 8;
#pragma unroll
    for (int k = 0; k < 8; ++k) cu[k] = *(const u32x4*)(r0 + 128 * k); }
#pragma unroll 1
  for (int i = 0; i < 32; ++i) {
    if (i + 1 < 32) { const u16* r1 = UB + (size_t)s_idx[4 * (i + 1) + q] * DM + j * 8;
#pragma unroll
      for (int k = 0; k < 8; ++k) nu[k] = *(const u32x4*)(r1 + 128 * k); }
    float a0 = 0.f, a1 = 0.f, a2 = 0.f, a3 = 0.f;
#pragma unroll
    for (int k = 0; k < 8; ++k) { a0 = dot2bf(cu[k].x, xp[4 * k], a0); a1 = dot2bf(cu[k].y, xp[4 * k + 1], a1); a2 = dot2bf(cu[k].z, xp[4 * k + 2], a2); a3 = dot2bf(cu[k].w, xp[4 * k + 3], a3); }
    float dsum = (a0 + a1) + (a2 + a3);
    dsum += __shfl_xor(dsum, 1); dsum += __shfl_xor(dsum, 2); dsum += __shfl_xor(dsum, 4); dsum += __shfl_xor(dsum, 8);
    if (j == 0) s_c[4 * i + q] = gelu_erf(dsum) * s_gate[4 * i + q];
#pragma unroll
    for (int k = 0; k < 8; ++k) cu[k] = nu[k];
  }
  asm volatile("s_waitcnt lgkmcnt(0)" ::: "memory");
  float y[64];
#pragma unroll
  for (int i = 0; i < 64; ++i) y[i] = 0.f;
  { const u16* r0 = VB + (size_t)s_idx[q] * DM + j * 8;
#pragma unroll
    for (int k = 0; k < 8; ++k) cu[k] = *(const u32x4*)(r0 + 128 * k); }
#pragma unroll 1
  for (int i = 0; i < 32; ++i) {
    if (i + 1 < 32) { const u16* r1 = VB + (size_t)s_idx[4 * (i + 1) + q] * DM + j * 8;
#pragma unroll
      for (int k = 0; k < 8; ++k) nu[k] = *(const u32x4*)(r1 + 128 * k); }
    const float c = s_c[4 * i + q];
#pragma unroll
    for (int k = 0; k < 8; ++k) { float v[8]; unpk8(cu[k], v);
#pragma unroll
      for (int e = 0; e < 8; ++e) y[8 * k + e] = fmaf(c, v[e], y[8 * k + e]); }
#pragma unroll
    for (int k = 0; k < 8; ++k) cu[k] = nu[k];
  }
#pragma unroll
  for (int i = 0; i < 64; ++i) { y[i] += __shfl_xor(y[i], 16); y[i] += __shfl_xor(y[i], 32); }
  float ss2 = 0.f;
#pragma unroll
  for (int k = 0; k < 8; ++k) { float xv[8]; ld8(xin + (size_t)t * DM + (j + 16 * k) * 8, xv);
#pragma unroll
    for (int e = 0; e < 8; ++e) { y[8 * k + e] += xv[e]; ss2 = fmaf(y[8 * k + e], y[8 * k + e], ss2); } }
  ss2 += __shfl_xor(ss2, 1); ss2 += __shfl_xor(ss2, 2); ss2 += __shfl_xor(ss2, 4); ss2 += __shfl_xor(ss2, 8);
  const float rs2 = rsqrtf(ss2 * (1.f / DM) + EPS);
  u16* xg = (u16*)(p.ws + WS_XG);
#pragma unroll
  for (int k = 0; k < 8; ++k) if ((k >> 1) == q) {
    const int col = (j + 16 * k) * 8;
    if (last) { float g8[8]; ld8(p.norm_final + col, g8); float ov[8];
#pragma unroll
      for (int e = 0; e < 8; ++e) ov[e] = y[8 * k + e] * rs2 * g8[e];
      *(f32x4*)(xout + (size_t)t * DM + col) = (f32x4){ov[0], ov[1], ov[2], ov[3]}; *(f32x4*)(xout + (size_t)t * DM + col + 4) = (f32x4){ov[4], ov[5], ov[6], ov[7]}; }
    else { *(f32x4*)(xout + (size_t)t * DM + col) = (f32x4){y[8 * k], y[8 * k + 1], y[8 * k + 2], y[8 * k + 3]};
      *(f32x4*)(xout + (size_t)t * DM + col + 4) = (f32x4){y[8 * k + 4], y[8 * k + 5], y[8 * k + 6], y[8 * k + 7]};
      *(u32x4*)(xg + (size_t)t * DM + col) = pk8(&y[8 * k]); }
  }
}

DEVI void lru_passB(const Params& p, int item, int lane) {
  const int cg = item % 6, b = (item / 6) % NB, d = item / (6 * NB);
  const size_t o = (size_t)(d * NB + b) * NLCH * LRU_W + cg * 64 + lane;
  const float* Pp = (const float*)(p.ws + WS_LP) + o; const float* Hp = (const float*)(p.ws + WS_LH) + o; float* Cp = (float*)(p.ws + WS_LC) + o;
  float h = 0.f;
#pragma unroll 1
  for (int c0 = 0; c0 < NLCH; c0 += 32) {
    float pv[32], hv[32];
#pragma unroll
    for (int i = 0; i < 32; ++i) { const int cc = d ? NLCH - 1 - (c0 + i) : c0 + i; pv[i] = Pp[(size_t)cc * LRU_W]; hv[i] = Hp[(size_t)cc * LRU_W]; }
#pragma unroll
    for (int i = 0; i < 32; ++i) { const int cc = d ? NLCH - 1 - (c0 + i) : c0 + i; Cp[(size_t)cc * LRU_W] = h; h = fmaf(pv[i], h, hv[i]); }
  }
}

DEVI void swa_item(const Params& p, int layer, int item, char* lds) {
  const int tid = tidx(), wid = tid >> 6, lane = tid & 63, r32 = lane & 31, hi = lane >> 5;
  const int g = item & 1, n = (item >> 1) & 63, b = item >> 7;
  const int hq = 2 * g + (wid >> 2), qrow = n * 128 + (wid & 3) * 32;
  const u16* proj = (const u16*)(p.ws + WS_R1);
  const u16* Qw = proj + (size_t)(b * SEQ + qrow + r32) * INWP + PC_SQ + hq * 64 + hi * 8;
  const u16* Kh = proj + (size_t)(b * SEQ) * INWP + PC_SK + g * 64;
  const u16* Vh = proj + (size_t)(b * SEQ) * INWP + PC_SV + g * 64;
  const int kt0 = (2 * n - 2) < 0 ? 0 : (2 * n - 2), kt1 = (2 * n + 4) > SEQ / 64 ? SEQ / 64 : (2 * n + 4);
  const float sink = p.swa_sink[layer * 4 + hq];
  u16* Ow = (u16*)(p.ws + WS_MIX) + (size_t)(b * SEQ + qrow) * DM + 768 + hq * 64;
  attn_body<64, true>(Qw, Kh, INWP, Vh, INWP, kt0, kt1 - kt0, 0.125f, sink * 8.f, 1.f, qrow + r32, Ow, lds);
}
DEVI void mla_item(const Params& p, int pair, int qb, char* lds) {
  const int tid = tidx(), wid = tid >> 6, lane = tid & 63, r32 = lane & 31, hi = lane >> 5;
  const int b = pair / MLA_H, h = pair - b * MLA_H;
  const u16* Qw = (const u16*)(p.ws + WS_QM) + ((size_t)pair * SEQ + qb * 256 + wid * 32 + r32) * MLA_QK + hi * 8;
  const u16* Kh = (const u16*)(p.ws + WS_KM) + (size_t)pair * SEQ * MLA_QK;
  const u16* Vh = (const u16*)(p.ws + WS_VM) + (size_t)pair * SEQ * MLA_V;
  u16* Ow = (u16*)(p.ws + WS_MIX) + (size_t)(b * SEQ + qb * 256 + wid * 32) * DM + h * 64;
  attn_body<96, false>(Qw, Kh, MLA_QK, Vh, MLA_V, 0, SEQ / 64, 0.10206207261596575f, -1e30f, 0.f, 0, Ow, lds);
}

constexpr int PH_PER_LAYER = 10, N_PHASES = 1 + DEPTH * PH_PER_LAYER;
DEVI void run_phase(const Params& pin, int ph, int vb, int nb, char* lds) {
  Params p = pin; asm volatile("" : "+s"(p.ws)); asm volatile("" : "+s"(p.out)); asm volatile("" : "+s"(vb));
  const int tid = tidx(), wid = tid >> 6, lane = tid & 63;
#ifdef ONLY_SP
  if (ONLY_SP >= 0 && ph == 0) return;
#endif
  if (ph == 0) { phase0(p, vb, nb, lds); return; }
  const int l = (ph - 1) / PH_PER_LAYER, sp = (ph - 1) % PH_PER_LAYER;
  u16* const XG = (u16*)(p.ws + WS_XG); u16* const PROJ = (u16*)(p.ws + WS_R1); u16* const MIX = (u16*)(p.ws + WS_MIX);
  constexpr int NMT = T / 256;
#ifdef ONLY_SP
  if (sp != ONLY_SP) return;
#endif
  switch (sp) {
  case 0: {
    GemmDesc g = gemm_desc(XG, DM, (const u16*)(p.ws + WS_WIN) + (size_t)l * INWP * DM, DM, DM);
    EpiP1 e{PROJ, p.pos};
    for (int it = vb; it < NMT * 14; it += nb) gemm_tile<0, 1>(g, (it / 14) * 256, (it % 14) * 128, lds, e);
  } break;
  case 1: {
    constexpr int N_C = NMT * 12, N_A = NMT * 5, N_B = NMT * 6;
    for (int it = vb; it < N_C + N_A + N_B; it += nb) {
      if (it < N_C) { const int mt = it / 12, nd = it % 12, n = nd >> 1, d = nd & 1;
        GemmDesc g{}; g.Bt = (const u16*)(p.ws + WS_WLRU) + (size_t)((l * 6 + n) * 2 + d) * 128 * 64; g.ldb = 64; g.KT = 1;
        g.proj = PROJ; g.cw = p.conv_w + l * 4 * LRU_W; g.cb = p.conv_b + l * LRU_W; g.ch0 = n * 64;
        EpiLRU e{PROJ, g.cw, g.cb, p.lru_ba + l * 2 * 384, p.lru_bx + l * 2 * 384, p.lru_lambda + l * 2 * 384, (u16*)(p.ws + WS_LE), (u16*)(p.ws + WS_LB), n, d};
        gemm_tile<1, 0>(g, mt * 256, 0, lds, e);
      } else if (it < N_C + N_A) { const int i2 = it - N_C;
        GemmDesc g = gemm_desc(PROJ + PC_CQ, INWP, (const u16*)(p.ws + WS_WUQ) + (size_t)l * 640 * 256, 256, 256);
        EpiQ e{(u16*)(p.ws + WS_QM), p.pos};
        gemm_tile<0, 1>(g, (i2 / 5) * 256, (i2 % 5) * 128, lds, e);
      } else { const int i2 = it - N_C - N_A;
        GemmDesc g = gemm_desc(PROJ + PC_CKV, INWP, (const u16*)(p.ws + WS_WUKV) + (size_t)l * 768 * 128, 128, 128);
        EpiKV e{(u16*)(p.ws + WS_KM), (u16*)(p.ws + WS_VM), PROJ};
        gemm_tile<0, 1>(g, (i2 / 6) * 256, (i2 % 6) * 128, lds, e);
      }
    }
  } break;
  case 2: {
    for (int it = vb * 8 + wid; it < 2 * NB * NLCH * 6; it += nb * 8) lru_passA(p, it, lane);
  } break;
  case 3: {
    const int wi = vb * 8 + wid;
    if (wi < 48) lru_passB(p, wi, lane);
    __syncthreads();
    for (int it = vb; it < NB * 64 * 2; it += nb) swa_item(p, l, it, lds);
  } break;
  case 4: {
    for (int k = 0; k * nb + vb < NB * MLA_H * 32; ++k) {
      int pair, qb;
      if (nb == 256) { pair = k * 8 + (vb & 7); qb = vb >> 3; } else { const int it = k * nb + vb; pair = it >> 5; qb = it & 31; }
      mla_item(p, pair, qb, lds);
    }
#ifndef NO_LRUF
    for (int it = vb; it < NB * NLCH; it += nb) lru_final(p, it, lds);
#endif
  } break;
  case 5: {
    GemmDesc g = gemm_desc(MIX, DM, (const u16*)(p.ws + WS_WOUT) + (size_t)l * DM * DM, DM, DM);
    EpiP4 e{l == 0 ? p.x : p.out, p.out, XG};
    for (int it = vb; it < NMT * 8; it += nb) gemm_tile<0, 2>(g, (it / 8) * 256, (it % 8) * 128, lds, e);
    const float* us = p.peer_u + (size_t)l * NEXP * DM; const float* vs = p.peer_v + (size_t)l * NEXP * DM;
    u16* ub = (u16*)(p.ws + WS_UB); u16* vbf = (u16*)(p.ws + WS_VB);
    for (size_t i = (size_t)vb * NTHREADS + tid; i < (size_t)NEXP * DM / 8; i += (size_t)nb * NTHREADS) {
      float a[8], b[8]; ld8(us + i * 8, a); ld8(vs + i * 8, b);
      *(u32x4*)(ub + i * 8) = pk8(a); *(u32x4*)(vbf + i * 8) = pk8(b); }
  } break;
  case 6: {
    GemmDesc g = gemm_desc(XG, DM, (const u16*)(p.ws + WS_WQ) + (size_t)l * 2048 * DM, DM, DM);
    EpiBf16 e{PROJ, 2048};
    for (int it = vb; it < NMT * 16; it += nb) gemm_tile<0, 1>(g, (it / 16) * 256, (it % 16) * 128, lds, e);
  } break;
  case 7: {
    for (int it = vb; it < NMT * 16; it += nb) { const int mt = it / 16, hj = it % 16, j = hj & 1;
      GemmDesc g{}; g.A = PROJ + hj * 128; g.lda = 2048; g.Bt = (const u16*)(p.ws + WS_SUBK) + (size_t)(l * 2 + j) * 128 * 128; g.ldb = 128; g.KT = 2;
      EpiTop e{(float*)(p.ws + WS_TOP), hj};
      gemm_tile<0, 0>(g, mt * 256, 0, lds, e); }
  } break;
  case 8: peer_cand(p, vb, nb, lds); break;
  case 9: {
    char* wl = lds + wid * 2048;
    for (int t = vb * 8 + wid; t < T; t += nb * 8) peer_token(p, l, t, p.out, p.out, l == DEPTH - 1, wl);
  } break;
  }
}

__global__ void __launch_bounds__(NTHREADS, 2) mega(Params p) {
  extern __shared__ __attribute__((aligned(16))) char smem[];
  cg::grid_group grid = cg::this_grid();
  const int nb = gridDim.x, vb = blockIdx.x;
  for (int ph = p.ph_lo; ph < p.ph_hi; ++ph) {
    run_phase(p, ph, vb, nb, smem);
    if (ph + 1 < p.ph_hi) grid.sync();
  }
}

#ifndef N_LAUNCH_SPLIT
#define N_LAUNCH_SPLIT 1
#endif
extern "C" void kernel_launch(void* const* d_in, const int* in_sizes, int n_in, void* d_out, int out_size, void* d_ws, size_t ws_size, hipStream_t stream) {
  static int grid_blocks = 0;
  if (grid_blocks == 0) {
    if (n_in != 24 || out_size != T * DM || ws_size < WS_NEED) { fprintf(stderr, "kernel_launch: unexpected shapes n_in %d out %d ws %zu\n", n_in, out_size, ws_size); grid_blocks = -1; return; }
    int dev = 0, cus = 0, per_cu = 0;
    (void)hipGetDevice(&dev); (void)hipDeviceGetAttribute(&cus, hipDeviceAttributeMultiprocessorCount, dev);
    if (hipFuncSetAttribute((const void*)mega, hipFuncAttributeMaxDynamicSharedMemorySize, LDS_BYTES) != hipSuccess) { fprintf(stderr, "kernel_launch: hipFuncSetAttribute failed\n"); grid_blocks = -1; return; }
    if (hipOccupancyMaxActiveBlocksPerMultiprocessor(&per_cu, (const void*)mega, NTHREADS, LDS_BYTES) != hipSuccess || per_cu < 1) { fprintf(stderr, "kernel_launch: occupancy query failed (%d)\n", per_cu); grid_blocks = -1; return; }
    grid_blocks = cus * 1;
    fprintf(stderr, "kernel_launch: cus %d per_cu %d grid %d\n", cus, per_cu, grid_blocks);
  }
  if (grid_blocks < 0) return;
  Params p{};
  p.x = (const float*)d_in[0]; p.pos = (const int*)d_in[1]; p.norm_mix = (const float*)d_in[2]; p.w_in = (const float*)d_in[3]; p.q_norm = (const float*)d_in[4];
  p.w_uq = (const float*)d_in[5]; p.kv_norm = (const float*)d_in[6]; p.w_ukv = (const float*)d_in[7]; p.conv_w = (const float*)d_in[8]; p.conv_b = (const float*)d_in[9];
  p.lru_wa = (const float*)d_in[10]; p.lru_ba = (const float*)d_in[11]; p.lru_wx = (const float*)d_in[12]; p.lru_bx = (const float*)d_in[13]; p.lru_lambda = (const float*)d_in[14];
  p.swa_sink = (const float*)d_in[15]; p.grp_norm = (const float*)d_in[16]; p.w_out = (const float*)d_in[17]; p.norm_ffn = (const float*)d_in[18]; p.peer_wq = (const float*)d_in[19];
  p.peer_subkeys = (const float*)d_in[20]; p.peer_u = (const float*)d_in[21]; p.peer_v = (const float*)d_in[22]; p.norm_final = (const float*)d_in[23];
  p.out = (float*)d_out; p.ws = (unsigned char*)d_ws;
#if N_LAUNCH_SPLIT
  for (int ph = 0; ph < N_PHASES; ++ph) {
    p.ph_lo = ph; p.ph_hi = ph + 1;
    void* args[] = {&p};
    hipError_t e = hipLaunchCooperativeKernel((const void*)mega, dim3(grid_blocks), dim3(NTHREADS), args, LDS_BYTES, stream);
    if (e != hipSuccess) { fprintf(stderr, "kernel_launch: launch of phase %d failed: %s\n", ph, hipGetErrorString(e)); break; }
  }
#else
  p.ph_lo = 0; p.ph_hi = N_PHASES;
  void* args[] = {&p};
  hipError_t e = hipLaunchCooperativeKernel((const void*)mega, dim3(grid_blocks), dim3(NTHREADS), args, LDS_BYTES, stream);
  if (e != hipSuccess) fprintf(stderr, "kernel_launch: cooperative launch failed: %s (grid %d)\n", hipGetErrorString(e), grid_blocks);
#endif
}
```

```cpp
#include <hip/hip_runtime.h>
#include <hip/hip_cooperative_groups.h>
#include <cstdio>
#include <cstdint>
namespace cg = cooperative_groups;

#define DEVI __device__ __forceinline__
typedef unsigned short u16;
typedef short bf16x8 __attribute__((ext_vector_type(8)));
typedef short s16x4 __attribute__((ext_vector_type(4)));
typedef float f32x2 __attribute__((ext_vector_type(2)));
typedef float f32x4 __attribute__((ext_vector_type(4)));
typedef float f32x16 __attribute__((ext_vector_type(16)));
typedef unsigned u32x4 __attribute__((ext_vector_type(4)));
typedef unsigned u32x2 __attribute__((ext_vector_type(2)));
typedef __bf16 bf16x2_t __attribute__((ext_vector_type(2)));

constexpr int NB = 4, SEQ = 8192, T = NB * SEQ, DM = 1024, DEPTH = 2;
constexpr int MLA_H = 6, MLA_QK = 96, MLA_V = 64;
constexpr int LRU_W = 384;
constexpr int INW = 1696, INWP = 1792;
constexpr int PC_CQ = 0, PC_CKV = 256, PC_SQ = 384, PC_SK = 640, PC_SV = 768, PC_LX = 896, PC_LG = 1280, PC_KR = 1664;
constexpr int OC_CQ = 0, OC_CKV = 256, OC_KR = 384, OC_SQ = 416, OC_SK = 672, OC_SV = 800, OC_LX = 928, OC_LG = 1312;
constexpr int NEXP = 16384;
constexpr float EPS = 1e-6f;
constexpr int NTHREADS = 512;
constexpr int LDS_BYTES = 160 * 1024;

constexpr size_t MiB = 1u << 20;
constexpr size_t WS_CTL = 0;
constexpr size_t WS_WIN = 4 * MiB;
constexpr size_t WS_WQ = 11 * MiB;
constexpr size_t WS_WOUT = 19 * MiB;
constexpr size_t WS_WUQ = 23 * MiB;
constexpr size_t WS_WUKV = WS_WUQ + 2 * 640 * 256 * 2;
constexpr size_t WS_WLRU = WS_WUKV + 2 * 768 * 128 * 2;
constexpr size_t WS_SUBK = WS_WLRU + 2 * 6 * 2 * 128 * 64 * 2;
constexpr size_t WS_XG = 25 * MiB;
constexpr size_t WS_R1 = 89 * MiB;
constexpr size_t WS_QM = 217 * MiB;
constexpr size_t WS_KM = 253 * MiB;
constexpr size_t WS_VM = 289 * MiB;
constexpr size_t WS_LE = 313 * MiB;
constexpr size_t WS_LB = 361 * MiB;
constexpr size_t WS_MIX = 409 * MiB;
constexpr size_t WS_UB = 217 * MiB;
constexpr size_t WS_VB = 249 * MiB;
constexpr size_t WS_TOP = 281 * MiB;
constexpr size_t WS_EIDX = 313 * MiB;
constexpr size_t WS_EGATE = 329 * MiB;
constexpr size_t WS_END = 473 * MiB;

__device__ const float ROPE_HI[32] = {1.591549367e-01f, 1.193493679e-01f, 8.949939907e-02f, 6.711508334e-02f, 5.032921210e-02f, 3.774158657e-02f, 2.830219641e-02f, 2.122365311e-02f, 1.591549441e-02f, 1.193493698e-02f, 8.949940093e-03f, 6.711508147e-03f, 5.032921210e-03f, 3.774158424e-03f, 2.830219688e-03f, 2.122365171e-03f, 1.591549488e-03f, 1.193493721e-03f, 8.949940093e-04f, 6.711508031e-04f, 5.032921326e-04f, 3.774158540e-04f, 2.830219455e-04f, 2.122365258e-04f, 1.591549371e-04f, 1.193493736e-04f, 8.949940093e-05f, 6.711508468e-05f, 5.032921035e-05f, 3.774158540e-05f, 2.830219637e-05f, 2.122365186e-05f};
__device__ const float ROPE_LO[32] = {6.420638243e-09f, 2.294664903e-09f, 2.542919653e-09f, -3.316028840e-10f, 5.173299289e-12f, -1.848551645e-09f, -5.826552019e-10f, -3.431038786e-10f, -1.029942243e-10f, 4.320196978e-11f, 6.802744479e-11f, 1.531042237e-10f, 5.173301024e-13f, 4.797548470e-11f, -1.048316434e-10f, 1.053879969e-10f, -5.686555046e-11f, -1.896286773e-11f, 6.802744999e-12f, 2.695195456e-11f, -1.158979943e-11f, -6.843983713e-12f, 1.279990003e-11f, 1.807650600e-12f, 5.954976963e-12f, -3.351478166e-12f, 6.802744674e-13f, -1.670379113e-12f, 1.751403167e-12f, -6.843983930e-13f, -5.389994549e-13f, 9.083608431e-13f};

DEVI int tidx() { int t = __builtin_amdgcn_workitem_id_x(); asm volatile("" : "+v"(t)); return t; }
DEVI float bf2f(unsigned h) { return __uint_as_float(h << 16); }
DEVI float bflo(unsigned w) { return __uint_as_float(w << 16); }
DEVI float bfhi(unsigned w) { return __uint_as_float(w & 0xffff0000u); }
DEVI unsigned pk2(float lo, float hi) { f32x2 v = {lo, hi}; bf16x2_t b = __builtin_convertvector(v, bf16x2_t); return __builtin_bit_cast(unsigned, b); }
DEVI u16 f2bf(float f) { return (u16)(pk2(f, 0.f) & 0xffffu); }
DEVI u32x4 pk8(const float* v) { u32x4 w; w.x = pk2(v[0], v[1]); w.y = pk2(v[2], v[3]); w.z = pk2(v[4], v[5]); w.w = pk2(v[6], v[7]); return w; }
DEVI void unpk8(u32x4 w, float* v) { v[0] = bflo(w.x); v[1] = bfhi(w.x); v[2] = bflo(w.y); v[3] = bfhi(w.y); v[4] = bflo(w.z); v[5] = bfhi(w.z); v[6] = bflo(w.w); v[7] = bfhi(w.w); }
DEVI int crow(int r, int hi) { return (r & 3) + 8 * (r >> 2) + 4 * hi; }
DEVI float wave_sum(float v) {
#pragma unroll
  for (int o = 1; o < 64; o <<= 1) v += __shfl_xor(v, o);
  return v;
}
DEVI void rope_sc(float pos, int fidx, float& sn, float& cs) {
  const float chi = ROPE_HI[fidx], clo = ROPE_LO[fidx];
  const float t = pos * chi, e = fmaf(pos, chi, -t);
  float fr = t - rintf(t);
  fr = fr + (e + pos * clo);
  sn = __builtin_amdgcn_sinf(fr); cs = __builtin_amdgcn_cosf(fr);
}
DEVI float sigmoidf_(float x) { return 1.f / (1.f + __expf(-x)); }
DEVI float gelu_erf(float x) { return 0.5f * x * (1.f + erff(x * 0.70710678118654752f)); }

struct Params {
  const float* x; const int* pos; const float* norm_mix; const float* w_in; const float* q_norm; const float* w_uq; const float* kv_norm; const float* w_ukv;
  const float* conv_w; const float* conv_b; const float* lru_wa; const float* lru_ba; const float* lru_wx; const float* lru_bx; const float* lru_lambda;
  const float* swa_sink; const float* grp_norm; const float* w_out; const float* norm_ffn; const float* peer_wq; const float* peer_subkeys;
  const float* peer_u; const float* peer_v; const float* norm_final;
  float* out; unsigned char* ws;
  int ph_lo, ph_hi;
};

DEVI void tconv_item(const float* W, int ldw, int src_c0, u16* WT, int K, int dst_r0, const float* gain, float* scr, int kb, int nb, int lane) {
  const int k0 = 64 * kb, n0 = 32 * nb;
#pragma unroll 8
  for (int i = 0; i < 32; ++i) { const int kk = 2 * i + (lane >> 5); float g = gain ? gain[k0 + kk] : 1.f; scr[kk * 33 + (lane & 31)] = g * W[(size_t)(k0 + kk) * ldw + src_c0 + n0 + (lane & 31)]; }
  __builtin_amdgcn_s_waitcnt(0xc07f); asm volatile("" ::: "memory");
  const int c = lane & 7;
#pragma unroll
  for (int j = 0; j < 4; ++j) { const int n = (lane >> 3) + 8 * j; const float* s = scr + (8 * c) * 33 + n;
    u32x4 o; o.x = pk2(s[0 * 33], s[1 * 33]); o.y = pk2(s[2 * 33], s[3 * 33]); o.z = pk2(s[4 * 33], s[5 * 33]); o.w = pk2(s[6 * 33], s[7 * 33]);
    *(u32x4*)(WT + (size_t)(dst_r0 + n0 + n) * K + k0 + 8 * c) = o; }
  __builtin_amdgcn_s_waitcnt(0xc07f); asm volatile("" ::: "memory");
}

DEVI void tseg(const float* W, int ldw, int src_c0, int ncols, u16* WT, int K, int dst_r0, const float* gain, float* scr, int gw, int ngw, int lane) {
  const int nkb = K / 64, nnb = ncols / 32, ni = nkb * nnb;
  for (int it = gw; it < ni; it += ngw) tconv_item(W, ldw, src_c0, WT, K, dst_r0, gain, scr, it / nnb, it % nnb, lane);
}

DEVI void phase0(const Params& p, int vb, int nb, char* lds) {
  const int tid = tidx(), lane = tid & 63, wid = tid >> 6;
  float* scr = (float*)(lds + wid * 16384);
  const int gw = vb * 8 + wid, ngw = nb * 8;
#pragma unroll 1
  for (int l = 0; l < DEPTH; ++l) {
    const float* win = p.w_in + (size_t)l * DM * INW; u16* wint = (u16*)(p.ws + WS_WIN) + (size_t)l * INWP * DM; const float* gm = p.norm_mix + l * DM;
    tseg(win, INW, OC_CQ, 256, wint, DM, PC_CQ, gm, scr, gw, ngw, lane);
    tseg(win, INW, OC_CKV, 128, wint, DM, PC_CKV, gm, scr, gw, ngw, lane);
    tseg(win, INW, OC_SQ, 256, wint, DM, PC_SQ, gm, scr, gw, ngw, lane);
    tseg(win, INW, OC_SK, 128, wint, DM, PC_SK, gm, scr, gw, ngw, lane);
    tseg(win, INW, OC_SV, 128, wint, DM, PC_SV, gm, scr, gw, ngw, lane);
    tseg(win, INW, OC_LX, 384, wint, DM, PC_LX, gm, scr, gw, ngw, lane);
    tseg(win, INW, OC_LG, 384, wint, DM, PC_LG, gm, scr, gw, ngw, lane);
    tseg(win, INW, OC_KR, 32, wint, DM, PC_KR, gm, scr, gw, ngw, lane);
    tseg(p.peer_wq + (size_t)l * DM * 2048, 2048, 0, 2048, (u16*)(p.ws + WS_WQ) + (size_t)l * 2048 * DM, DM, 0, p.norm_ffn + l * DM, scr, gw, ngw, lane);
    tseg(p.w_out + (size_t)l * DM * DM, DM, 0, DM, (u16*)(p.ws + WS_WOUT) + (size_t)l * DM * DM, DM, 0, p.grp_norm + l * DM, scr, gw, ngw, lane);
    tseg(p.w_uq + (size_t)l * 256 * 576, 576, 0, 576, (u16*)(p.ws + WS_WUQ) + (size_t)l * 640 * 256, 256, 0, p.q_norm + l * 256, scr, gw, ngw, lane);
    tseg(p.w_ukv + (size_t)l * 128 * 768, 768, 0, 768, (u16*)(p.ws + WS_WUKV) + (size_t)l * 768 * 128, 128, 0, p.kv_norm + l * 128, scr, gw, ngw, lane);
    for (int it = gw; it < 2 * 6 * 2 * 2; it += ngw) {
      const int nbk = it & 1, ax = (it >> 1) & 1, n = (it >> 2) % 6, d = (it >> 2) / 6;
      const float* W = (ax ? p.lru_wx : p.lru_wa) + ((size_t)(l * 2 + d) * 6 + n) * 4096;
      u16* WT = (u16*)(p.ws + WS_WLRU) + ((size_t)((l * 6 + n) * 2 + d)) * 128 * 64;
      tconv_item(W, 64, 0, WT, 64, ax * 64, nullptr, scr, 0, nbk, lane);
    }
  }
  for (int i = vb * NTHREADS + tid; i < DEPTH * 96 * DM / 8; i += nb * NTHREADS) { const int l = i / (96 * DM / 8), r = i % (96 * DM / 8);
    *(u32x4*)((u16*)(p.ws + WS_WIN) + ((size_t)l * INWP + INW) * DM + (size_t)r * 8) = (u32x4){0, 0, 0, 0}; }
  for (int i = vb * NTHREADS + tid; i < DEPTH * 64 * 256 / 8; i += nb * NTHREADS) { const int l = i / (64 * 256 / 8), r = i % (64 * 256 / 8);
    *(u32x4*)((u16*)(p.ws + WS_WUQ) + ((size_t)l * 640 + 576) * 256 + (size_t)r * 8) = (u32x4){0, 0, 0, 0}; }
  for (int i = vb * NTHREADS + tid; i < DEPTH * 2 * 128 * 128 / 8; i += nb * NTHREADS) {
    const f32x4 a = *(const f32x4*)(p.peer_subkeys + (size_t)i * 8), b = *(const f32x4*)(p.peer_subkeys + (size_t)i * 8 + 4);
    u32x4 o; o.x = pk2(a.x, a.y); o.y = pk2(a.z, a.w); o.z = pk2(b.x, b.y); o.w = pk2(b.z, b.w);
    *(u32x4*)((u16*)(p.ws + WS_SUBK) + (size_t)i * 8) = o; }
  for (size_t i = (size_t)vb * NTHREADS + tid; i < (size_t)T * DM / 8; i += (size_t)nb * NTHREADS) {
    const f32x4 a = *(const f32x4*)(p.x + i * 8), b = *(const f32x4*)(p.x + i * 8 + 4);
    u32x4 o; o.x = pk2(a.x, a.y); o.y = pk2(a.z, a.w); o.z = pk2(b.x, b.y); o.w = pk2(b.z, b.w);
    *(u32x4*)((u16*)(p.ws + WS_XG) + i * 8) = o; }
}

DEVI int swz(int row, int c) { return row * 128 + ((c ^ ((row >> 1) & 7)) << 4); }
constexpr int CLD = 132;
constexpr int LDS_RS = 135168;

struct GemmDesc {
  const u16* A; int lda; const u16* Bt; int ldb; int KT;
  float inv0;
  const u16* proj; const float* cw; const float* cb; int ch0;
};

template <int AMODE> DEVI bf16x8 load_a(const GemmDesc& g, int row, int kcol) {
  if constexpr (AMODE == 0) {
    return *(const bf16x8*)(g.A + (size_t)row * g.lda + kcol);
  } else {
    const int s = row & (SEQ - 1), ch = g.ch0 + kcol;
    float a[8];
    { const f32x4 b0 = *(const f32x4*)(g.cb + ch), b1 = *(const f32x4*)(g.cb + ch + 4); a[0] = b0.x; a[1] = b0.y; a[2] = b0.z; a[3] = b0.w; a[4] = b1.x; a[5] = b1.y; a[6] = b1.z; a[7] = b1.w; }
#pragma unroll
    for (int tap = 0; tap < 4; ++tap) {
      const int ss = s - 1 + tap;
      if (ss >= 0 && ss < SEQ) {
        const u32x4 v = *(const u32x4*)(g.proj + (size_t)(row - 1 + tap) * INWP + PC_LX + ch);
        float x[8]; unpk8(v, x);
        const f32x4 w0 = *(const f32x4*)(g.cw + tap * LRU_W + ch), w1 = *(const f32x4*)(g.cw + tap * LRU_W + ch + 4);
        a[0] += w0.x * x[0]; a[1] += w0.y * x[1]; a[2] += w0.z * x[2]; a[3] += w0.w * x[3];
        a[4] += w1.x * x[4]; a[5] += w1.y * x[5]; a[6] += w1.z * x[6]; a[7] += w1.w * x[7];
      }
    }
    const u32x4 o = pk8(a);
    return __builtin_bit_cast(bf16x8, o);
  }
}

template <int AMODE> DEVI void g_load(const GemmDesc& g, bf16x8 (&ar)[4], bf16x8 (&br)[2], int m0, int n0, int srow, int sc, int kt) {
#pragma unroll
  for (int i = 0; i < 4; ++i) ar[i] = load_a<AMODE>(g, m0 + srow + 64 * i, kt * 64 + sc * 8);
#pragma unroll
  for (int i = 0; i < 2; ++i) br[i] = *(const bf16x8*)(g.Bt + (size_t)(n0 + srow + 64 * i) * g.ldb + kt * 64 + sc * 8);
}
template <bool NORM> DEVI void g_write(char* Ab, const bf16x8 (&ar)[4], const bf16x8 (&br)[2], float (&ssq)[4], int srow, int sc) {
  char* Bb = Ab + 32768;
#pragma unroll
  for (int i = 0; i < 4; ++i) { *(bf16x8*)(Ab + swz(srow + 64 * i, sc)) = ar[i];
    if (NORM) { float x[8]; unpk8(__builtin_bit_cast(u32x4, ar[i]), x); float s = ssq[i];
#pragma unroll
      for (int q = 0; q < 8; ++q) s = fmaf(x[q], x[q], s);
      ssq[i] = s; } }
#pragma unroll
  for (int i = 0; i < 2; ++i) *(bf16x8*)(Bb + swz(srow + 64 * i, sc)) = br[i];
}

template <int AMODE, int SEG, class Epi>
DEVI void gemm_tile(const GemmDesc& g, int m0, int n0, char* lds, const Epi& epi) {
  const int tid = tidx(), lane = tid & 63, wid = tid >> 6;
  const int wm = wid >> 1, wn = wid & 1, r32 = lane & 31, hi = lane >> 5;
  const int srow = tid >> 3, sc = tid & 7;
  constexpr bool NORM = SEG != 0;
  float* rs = (float*)(lds + LDS_RS);
  f32x16 acc[2][2], acc2[2][2];
#pragma unroll
  for (int i = 0; i < 2; ++i)
#pragma unroll
    for (int j = 0; j < 2; ++j) { acc[i][j] = f32x16{}; acc2[i][j] = f32x16{}; }
  float ssq[4] = {0.f, 0.f, 0.f, 0.f};
  bf16x8 ar[4], br[2];
  g_load<AMODE>(g, ar, br, m0, n0, srow, sc, 0); g_write<NORM>(lds, ar, br, ssq, srow, sc); __syncthreads();
  int seg = 0;
#pragma unroll 1
  for (int kt = 0; kt < g.KT; ++kt) {
    const int cur = kt & 1;
    if (kt + 1 < g.KT) g_load<AMODE>(g, ar, br, m0, n0, srow, sc, kt + 1);
    { const char* Ab = lds + cur * 49152; const char* Bb = Ab + 32768;
#pragma unroll
      for (int k16 = 0; k16 < 4; ++k16) {
        bf16x8 a[2], b[2];
#pragma unroll
        for (int mt = 0; mt < 2; ++mt) a[mt] = *(const bf16x8*)(Ab + swz(wm * 64 + mt * 32 + r32, k16 * 2 + hi));
#pragma unroll
        for (int nt = 0; nt < 2; ++nt) b[nt] = *(const bf16x8*)(Bb + swz(wn * 64 + nt * 32 + r32, k16 * 2 + hi));
#pragma unroll
        for (int mt = 0; mt < 2; ++mt)
#pragma unroll
          for (int nt = 0; nt < 2; ++nt) {
            if (NORM) acc2[mt][nt] = __builtin_amdgcn_mfma_f32_32x32x16_bf16(a[mt], b[nt], acc2[mt][nt], 0, 0, 0);
            else acc[mt][nt] = __builtin_amdgcn_mfma_f32_32x32x16_bf16(a[mt], b[nt], acc[mt][nt], 0, 0, 0);
          }
      } }
    if (NORM) {
      int se; float inv;
      if (SEG == 1) { se = g.KT; inv = g.inv0; }
      else { se = seg == 0 ? 6 : (seg == 1 ? 12 : 16); inv = seg == 2 ? (1.f / 256.f) : (1.f / 384.f); }
      if (kt + 1 == se) {
#pragma unroll
        for (int i = 0; i < 4; ++i) { float s = ssq[i]; s += __shfl_xor(s, 1); s += __shfl_xor(s, 2); s += __shfl_xor(s, 4); if (sc == 0) rs[srow + 64 * i] = rsqrtf(s * inv + EPS); }
        __syncthreads();
#pragma unroll
        for (int mt = 0; mt < 2; ++mt)
#pragma unroll
          for (int r = 0; r < 16; ++r) { const float f = rs[wm * 64 + mt * 32 + crow(r, hi)];
#pragma unroll
            for (int nt = 0; nt < 2; ++nt) { acc[mt][nt][r] = fmaf(f, acc2[mt][nt][r], acc[mt][nt][r]); acc2[mt][nt][r] = 0.f; } }
        ssq[0] = ssq[1] = ssq[2] = ssq[3] = 0.f;
        ++seg;
      }
    }
    if (kt + 1 < g.KT) g_write<NORM>(lds + (cur ^ 1) * 49152, ar, br, ssq, srow, sc);
    __syncthreads();
  }
  float* C = (float*)lds;
#pragma unroll
  for (int mt = 0; mt < 2; ++mt)
#pragma unroll
    for (int nt = 0; nt < 2; ++nt)
#pragma unroll
      for (int r = 0; r < 16; ++r) C[(wm * 64 + mt * 32 + crow(r, hi)) * CLD + wn * 64 + nt * 32 + r32] = acc[mt][nt][r];
  __syncthreads();
  epi(C, m0, n0);
  __syncthreads();
}

DEVI GemmDesc gemm_desc(const u16* A, int lda, const u16* Bt, int ldb, int K) {
  GemmDesc g{}; g.A = A; g.lda = lda; g.Bt = Bt; g.ldb = ldb; g.KT = K / 64; g.inv0 = 1.f / (float)K; return g;
}

DEVI void ld8(const float* p, float* v) { const f32x4 a = *(const f32x4*)p, b = *(const f32x4*)(p + 4); v[0] = a.x; v[1] = a.y; v[2] = a.z; v[3] = a.w; v[4] = b.x; v[5] = b.y; v[6] = b.z; v[7] = b.w; }

template <int HW> DEVI void rope8(float* v, const float* pp, int i0, float posf) {
  const bool first = i0 < HW; const int f0 = i0 & (HW - 1);
#pragma unroll
  for (int j = 0; j < 8; ++j) { float sn, cs; rope_sc(posf, HW == 32 ? (f0 + j) : 2 * (f0 + j), sn, cs); const float pv = pp[j]; v[j] = first ? v[j] * cs - pv * sn : v[j] * cs + pv * sn; }
}

struct EpiP1 { u16* proj; const int* pos;
  DEVI void operator()(const float* C, int m0, int n0) const {
    const int tid = tidx();
#pragma unroll 1
    for (int it = 0; it < 8; ++it) { const int item = it * NTHREADS + tid, row = item >> 4, c8 = (item & 15) * 8, gcol = n0 + c8, grow = m0 + row;
      float v[8]; ld8(C + row * CLD + c8, v);
      const bool r64 = gcol >= PC_SQ && gcol < PC_SV, r32g = gcol >= PC_KR && gcol < PC_KR + 32;
      if (r64) { const int i0 = gcol & 63; float pp[8]; ld8(C + row * CLD + c8 + (i0 < 32 ? 32 : -32), pp); rope8<32>(v, pp, i0, (float)pos[grow]); }
      else if (r32g) { const int i0 = gcol & 31; float pp[8]; ld8(C + row * CLD + c8 + (i0 < 16 ? 16 : -16), pp); rope8<16>(v, pp, i0, (float)pos[grow]); }
      *(u32x4*)(proj + (size_t)grow * INWP + gcol) = pk8(v);
    }
  }
};

struct EpiQ { u16* qm; const int* pos;
  DEVI void operator()(const float* C, int m0, int n0) const {
    const int tid = tidx();
#pragma unroll 1
    for (int it = 0; it < 8; ++it) { const int item = it * NTHREADS + tid, row = item >> 4, c8 = (item & 15) * 8, gcol = n0 + c8, grow = m0 + row;
      if (gcol >= 576) continue;
      const int head = gcol / 96, j0 = gcol - head * 96, b = grow >> 13, s = grow & (SEQ - 1);
      float v[8]; ld8(C + row * CLD + c8, v);
      if (j0 >= 64) { const int i0 = j0 - 64; float pp[8]; ld8(C + row * CLD + c8 + (i0 < 16 ? 16 : -16), pp); rope8<16>(v, pp, i0, (float)pos[grow]); }
      *(u32x4*)(qm + ((size_t)(b * MLA_H + head) * SEQ + s) * MLA_QK + j0) = pk8(v);
    }
  }
};

struct EpiKV { u16* km; u16* vm; const u16* proj;
  DEVI void operator()(const float* C, int m0, int n0) const {
    const int tid = tidx(), head = n0 >> 7;
#pragma unroll 1
    for (int it = 0; it < 8; ++it) { const int item = it * NTHREADS + tid, row = item >> 4, c8 = (item & 15) * 8, grow = m0 + row;
      const int b = grow >> 13, s = grow & (SEQ - 1);
      float v[8]; ld8(C + row * CLD + c8, v);
      const size_t tok = (size_t)(b * MLA_H + head) * SEQ + s;
      if (c8 < 64) *(u32x4*)(km + tok * MLA_QK + c8) = pk8(v);
      else *(u32x4*)(vm + tok * MLA_V + (c8 - 64)) = pk8(v);
    }
#pragma unroll 1
    for (int it = 0; it < 2; ++it) { const int item = it * NTHREADS + tid, row = item >> 2, c = (item & 3) * 8, grow = m0 + row;
      const int b = grow >> 13, s = grow & (SEQ - 1);
      *(u32x4*)(km + ((size_t)(b * MLA_H + head) * SEQ + s) * MLA_QK + 64 + c) = *(const u32x4*)(proj + (size_t)grow * INWP + PC_KR + c);
    }
  }
};

struct EpiLRU { const u16* proj; const float* cw; const float* cb; const float* ba; const float* bx; const float* lam; u16* le; u16* lb; int n, d;
  DEVI void operator()(const float* C, int m0, int) const {
    const int tid = tidx();
#pragma unroll 1
    for (int it = 0; it < 4; ++it) { const int item = it * NTHREADS + tid, j = item & 63, g8 = item >> 6;
      const int ch = n * 64 + j, grow0 = m0 + g8 * 8, s0 = grow0 & (SEQ - 1), b = grow0 >> 13;
      const float bav = ba[(d * 6 + n) * 64 + j], bxv = bx[(d * 6 + n) * 64 + j];
      const float cdec = -8.f * log1pf(__expf(-lam[d * LRU_W + ch]));
      float xin[11];
#pragma unroll
      for (int q = 0; q < 11; ++q) { const int ss = s0 - 1 + q; xin[q] = (ss >= 0 && ss < SEQ) ? bf2f(proj[(size_t)(grow0 - 1 + q) * INWP + PC_LX + ch]) : 0.f; }
      const float w0 = cw[ch], w1 = cw[LRU_W + ch], w2 = cw[2 * LRU_W + ch], w3 = cw[3 * LRU_W + ch], cbv = cb[ch];
      float ev[8], bv[8];
#pragma unroll
      for (int rr = 0; rr < 8; ++rr) {
        const float xf = cbv + w0 * xin[rr] + w1 * xin[rr + 1] + w2 * xin[rr + 2] + w3 * xin[rr + 3];
        const float r = sigmoidf_(C[(g8 * 8 + rr) * CLD + j] + bav), ig = sigmoidf_(C[(g8 * 8 + rr) * CLD + 64 + j] + bxv);
        const float a = __expf(cdec * r), e = 1.f - a;
        ev[rr] = e; bv[rr] = sqrtf(e * (2.f - e)) * ig * xf;
      }
      const size_t o = (((size_t)(d * NB + b) * (SEQ / 8) + (s0 >> 3)) * LRU_W + ch) * 8;
      *(u32x4*)(le + o) = pk8(ev); *(u32x4*)(lb + o) = pk8(bv);
    }
  }
};

struct EpiP4 { const float* xres; float* xout; u16* xg;
  DEVI void operator()(const float* C, int m0, int n0) const {
    const int tid = tidx();
#pragma unroll 1
    for (int it = 0; it < 8; ++it) { const int item = it * NTHREADS + tid, row = item >> 4, c8 = (item & 15) * 8, gcol = n0 + c8, grow = m0 + row;
      float v[8], x[8]; ld8(C + row * CLD + c8, v); ld8(xres + (size_t)grow * DM + gcol, x);
#pragma unroll
      for (int j = 0; j < 8; ++j) v[j] += x[j];
      *(f32x4*)(xout + (size_t)grow * DM + gcol) = (f32x4){v[0], v[1], v[2], v[3]}; *(f32x4*)(xout + (size_t)grow * DM + gcol + 4) = (f32x4){v[4], v[5], v[6], v[7]};
      *(u32x4*)(xg + (size_t)grow * DM + gcol) = pk8(v);
    }
  }
};

struct EpiBf16 { u16* o; int ldo;
  DEVI void operator()(const float* C, int m0, int n0) const {
    const int tid = tidx();
#pragma unroll 1
    for (int it = 0; it < 8; ++it) { const int item = it * NTHREADS + tid, row = item >> 4, c8 = (item & 15) * 8;
      float v[8]; ld8(C + row * CLD + c8, v);
      *(u32x4*)(o + (size_t)(m0 + row) * ldo + n0 + c8) = pk8(v);
    }
  }
};

DEVI void ce_desc(float& a, float& b) { const float mx = fmaxf(a, b), mn = fminf(a, b); a = mx; b = mn; }
struct EpiTop { float* top; int hj;
  DEVI void operator()(const float* C, int m0, int) const {
    const int tid = tidx(), row = tid >> 1, part = tid & 1;
    float l[16];
#pragma unroll
    for (int i = 0; i < 16; ++i) l[i] = -3.0e38f;
#pragma unroll 4
    for (int c = 0; c < 64; ++c) { const int col = part * 64 + ((c + row) & 63);
      float v = __uint_as_float((__float_as_uint(C[row * CLD + col]) & ~127u) | (unsigned)(127 - col));
#pragma unroll
      for (int i = 0; i < 16; ++i) { const float t = fmaxf(l[i], v); v = fminf(l[i], v); l[i] = t; } }
    float m[16];
#pragma unroll
    for (int i = 0; i < 16; ++i) m[i] = __shfl_xor(l[15 - i], 1);
#pragma unroll
    for (int i = 0; i < 16; ++i) m[i] = fmaxf(m[i], l[i]);
#pragma unroll
    for (int st = 8; st >= 1; st >>= 1)
#pragma unroll
      for (int i = 0; i < 16; ++i) if ((i & st) == 0) ce_desc(m[i], m[i + st]);
    if (part == 0) { float* o = top + ((size_t)(m0 + row) * 16 + hj) * 16;
#pragma unroll
      for (int i = 0; i < 4; ++i) *(f32x4*)(o + 4 * i) = (f32x4){m[4 * i], m[4 * i + 1], m[4 * i + 2], m[4 * i + 3]}; }
  }
};

#define KSWZ(row, colB) ((row) * 256 + ((colB) ^ (((row) & 7) << 4)))
#define SBAR() __builtin_amdgcn_sched_barrier(0)
constexpr int AT_SHM_V = 64 * 64 * 2, AT_SHM_K = 64 * 128 * 2;
constexpr int AT_LDS = 2 * AT_SHM_V + 2 * AT_SHM_K + 8 * 64 * 4;
constexpr float ATT_THR = 8.f;
DEVI unsigned cvtpk(float lo, float hi) { unsigned r; asm volatile("v_cvt_pk_bf16_f32 %0, %1, %2" : "=v"(r) : "v"(lo), "v"(hi)); return r; }
DEVI int v_st(int k, int c) { const int kk = (k & ~0xC) | ((k & 4) << 1) | ((k & 8) >> 1); return ((kk >> 3) * 2 + (c >> 5)) * 512 + ((kk & 7) * 32 + (c & 31)) * 2; }
DEVI int v_rd_base(int lane) { return ((lane & 3) << 3) | (((lane >> 2) & 3) << 6) | (((lane >> 4) & 1) << 5) | (((lane >> 5) & 1) << 8); }
constexpr int v_rd_off(int d0, int ks, int half) { return d0 * 512 + ks * 2048 + half * 1024; }
template <int OFF> DEVI s16x4 tr_read(int vb) { s16x4 r; asm volatile("ds_read_b64_tr_b16 %0, %1 offset:%2" : "=&v"(r) : "v"(vb), "i"(OFF) : "memory"); return r; }

template <bool MASK>
DEVI void partialSM(f32x16& p0, f32x16& p1, float& m_reg, float& mn, float& alpha, float SCALE, int kpos0, int qpos, int hi) {
  const float C = SCALE * 1.4426950408889634f;
  if (MASK) {
#pragma unroll
    for (int r = 0; r < 16; ++r) { const int k0 = kpos0 + crow(r, hi) - qpos; const int k1 = k0 + 32;
      if (k0 > 128 || k0 < -128) p0[r] = -1e30f;
      if (k1 > 128 || k1 < -128) p1[r] = -1e30f; }
  }
  float pmax = p0[0];
#pragma unroll
  for (int r = 1; r < 16; ++r) pmax = fmaxf(pmax, p0[r]);
#pragma unroll
  for (int r = 0; r < 16; ++r) pmax = fmaxf(pmax, p1[r]);
  { auto rr = __builtin_amdgcn_permlane32_swap(__float_as_uint(pmax), __float_as_uint(pmax), false, false);
    pmax = fmaxf(__uint_as_float(rr[0]), __uint_as_float(rr[1])); }
  if (__builtin_expect(__all(pmax - m_reg <= ATT_THR / SCALE), 1)) { mn = m_reg; alpha = 1.f; }
  else { mn = fmaxf(m_reg, pmax); alpha = __builtin_amdgcn_exp2f((m_reg - mn) * C); m_reg = mn; }
  const float mnC = -mn * C;
#pragma unroll
  for (int r = 0; r < 16; ++r) p0[r] = fmaf(p0[r], C, mnC);
#pragma unroll
  for (int r = 0; r < 16; ++r) p1[r] = fmaf(p1[r], C, mnC);
#pragma unroll
  for (int r = 0; r < 16; ++r) p0[r] = __builtin_amdgcn_exp2f(p0[r]);
}
DEVI void finishSM(f32x16& p0, f32x16& p1, float alpha, float& l_reg, bf16x8& pa0, bf16x8& pa1, bf16x8& pa2, bf16x8& pa3) {
#pragma unroll
  for (int r = 0; r < 16; ++r) p1[r] = __builtin_amdgcn_exp2f(p1[r]);
  float ps = 0;
#pragma unroll
  for (int r = 0; r < 16; ++r) ps += p0[r];
#pragma unroll
  for (int r = 0; r < 16; ++r) ps += p1[r];
  { auto rr = __builtin_amdgcn_permlane32_swap(__float_as_uint(ps), __float_as_uint(ps), false, false);
    ps = __uint_as_float(rr[0]) + __uint_as_float(rr[1]); }
  l_reg = l_reg * alpha + ps;
#define PK4(P, BASE, OUT) do { unsigned a0 = cvtpk(P[BASE + 0], P[BASE + 1]), a1 = cvtpk(P[BASE + 2], P[BASE + 3]);   \
    unsigned b0 = cvtpk(P[BASE + 4], P[BASE + 5]), b1 = cvtpk(P[BASE + 6], P[BASE + 7]);                              \
    auto r0 = __builtin_amdgcn_permlane32_swap(a0, b0, false, false); auto r1 = __builtin_amdgcn_permlane32_swap(a1, b1, false, false); \
    u32x4 w = {r0[0], r1[0], r0[1], r1[1]}; OUT = __builtin_bit_cast(bf16x8, w); } while (0)
  PK4(p0, 0, pa0); PK4(p0, 8, pa1); PK4(p1, 0, pa2); PK4(p1, 8, pa3);
#undef PK4
}
template <int ND0>
DEVI void qkt(f32x16& p0, f32x16& p1, const char* Ks, const bf16x8* qr, int r32, int hi) {
  p0 = f32x16{}; p1 = f32x16{};
#pragma unroll
  for (int d0 = 0; d0 < ND0; ++d0) { const int cb = (d0 * 16 + hi * 8) * 2;
    const bf16x8 b0 = *(const bf16x8*)(Ks + KSWZ(r32, cb));
    const bf16x8 b1 = *(const bf16x8*)(Ks + KSWZ(32 + r32, cb));
    p0 = __builtin_amdgcn_mfma_f32_32x32x16_bf16(b0, qr[d0], p0, 0, 0, 0);
    p1 = __builtin_amdgcn_mfma_f32_32x32x16_bf16(b1, qr[d0], p1, 0, 0, 0); }
}
template <int D0> DEVI void pv_one(f32x16& od, int vb, bf16x8 pa0, bf16x8 pa1, bf16x8 pa2, bf16x8 pa3) {
  const s16x4 l0 = tr_read<v_rd_off(D0, 0, 0)>(vb), h0 = tr_read<v_rd_off(D0, 0, 1)>(vb), l1 = tr_read<v_rd_off(D0, 1, 0)>(vb), h1 = tr_read<v_rd_off(D0, 1, 1)>(vb);
  const s16x4 l2 = tr_read<v_rd_off(D0, 2, 0)>(vb), h2 = tr_read<v_rd_off(D0, 2, 1)>(vb), l3 = tr_read<v_rd_off(D0, 3, 0)>(vb), h3 = tr_read<v_rd_off(D0, 3, 1)>(vb);
  asm volatile("s_waitcnt lgkmcnt(0)" ::: "memory"); SBAR();
#define PK(L, H) (bf16x8){L[0], L[1], L[2], L[3], H[0], H[1], H[2], H[3]}
  od = __builtin_amdgcn_mfma_f32_32x32x16_bf16(pa0, PK(l0, h0), od, 0, 0, 0);
  od = __builtin_amdgcn_mfma_f32_32x32x16_bf16(pa1, PK(l1, h1), od, 0, 0, 0);
  od = __builtin_amdgcn_mfma_f32_32x32x16_bf16(pa2, PK(l2, h2), od, 0, 0, 0);
  od = __builtin_amdgcn_mfma_f32_32x32x16_bf16(pa3, PK(l3, h3), od, 0, 0, 0);
#undef PK
}
DEVI void pv_d0(f32x16* o, int vb, bf16x8 pa0, bf16x8 pa1, bf16x8 pa2, bf16x8 pa3) {
  pv_one<0>(o[0], vb, pa0, pa1, pa2, pa3); pv_one<1>(o[1], vb, pa0, pa1, pa2, pa3);
}

template <int DQK, bool MASK>
DEVI void attn_body(const u16* Qw, const u16* Kh, int ldk, const u16* Vh, int ldv, int kt0, int NT, float SCALE, float m_init, float l_init,
                    int qpos, u16* Ow, char* lds) {
  constexpr int ND0 = DQK / 16, NCK = DQK / 8, NK2 = 64 * NCK - NTHREADS;
  const int tid = tidx(), wid = tid >> 6, lane = tid & 63, r32 = lane & 31, hi = lane >> 5;
  char* V_lds = lds; char* K_lds = lds + 2 * AT_SHM_V;
  float* wsx = (float*)(lds + 2 * AT_SHM_V + 2 * AT_SHM_K) + wid * 64; float* li_l = wsx; float* al_l = wsx + 32;
  float m_reg = m_init, l_reg = l_init; f32x16 o[2] = {f32x16{}, f32x16{}}; bf16x8 qr[ND0];
#pragma unroll
  for (int d0 = 0; d0 < ND0; ++d0) qr[d0] = *(const bf16x8*)(Qw + d0 * 16);
  const int vr = tid >> 3, vc = (tid & 7) * 8, vst0 = v_st(vr, vc);
  const int k0r = tid / NCK, k0c = tid - k0r * NCK;
  const int k1id = tid + NTHREADS, k1r = k1id / NCK, k1c = k1id - k1r * NCK; const bool has2 = tid < NK2;
  const int vb0 = (int)(uintptr_t)V_lds + v_rd_base(lane);
  bf16x8 sv[2], sk0[2], sk1[2];
#define SLOAD(i, t_) do { const size_t kk0 = (size_t)(t_) * 64; sv[i] = *(const bf16x8*)(Vh + (kk0 + vr) * ldv + vc); \
    sk0[i] = *(const bf16x8*)(Kh + (kk0 + k0r) * ldk + k0c * 8); if (NK2 > 0) { if (has2) sk1[i] = *(const bf16x8*)(Kh + (kk0 + k1r) * ldk + k1c * 8); } } while (0)
#define SWRITE(b, i) do { *(bf16x8*)(V_lds + (b) * AT_SHM_V + vst0) = sv[i]; *(bf16x8*)(K_lds + (b) * AT_SHM_K + KSWZ(k0r, k0c * 16)) = sk0[i]; \
    if (NK2 > 0) { if (has2) *(bf16x8*)(K_lds + (b) * AT_SHM_K + KSWZ(k1r, k1c * 16)) = sk1[i]; } } while (0)
#define RESC(a) do { if (__any((a) < 1.f)) { if (hi == 0) al_l[r32] = (a); asm volatile("s_waitcnt lgkmcnt(0)" ::: "memory"); \
    _Pragma("unroll") for (int d = 0; d < 2; ++d) _Pragma("unroll") for (int r = 0; r < 16; ++r) o[d][r] *= al_l[crow(r, hi)]; } } while (0)
  f32x16 pA0, pA1, pB0, pB1; float mnA, mnB, alA, alB; bf16x8 pa0, pa1, pa2, pa3;
  constexpr int SE = 0, SO = 1;
  SLOAD(SE, kt0); asm volatile("s_waitcnt vmcnt(0)" ::: "memory"); SWRITE(0, SE); __syncthreads();
  qkt<ND0>(pA0, pA1, K_lds, qr, r32, hi); partialSM<MASK>(pA0, pA1, m_reg, mnA, alA, SCALE, kt0 * 64, qpos, hi);
  SLOAD(SO, kt0 + 1); if (2 < NT) SLOAD(SE, kt0 + 2);
  SWRITE(1, SO); __syncthreads();
  for (int j = 1; j + 1 < NT; j += 2) {
    SBAR(); qkt<ND0>(pB0, pB1, K_lds + AT_SHM_K, qr, r32, hi);
    finishSM(pA0, pA1, alA, l_reg, pa0, pa1, pa2, pa3); SBAR();
    SLOAD(SO, kt0 + j + 2); SBAR();
    pv_d0(o, vb0, pa0, pa1, pa2, pa3); partialSM<MASK>(pB0, pB1, m_reg, mnB, alB, SCALE, (kt0 + j) * 64, qpos, hi);
    __syncthreads(); SWRITE(0, SE);
    RESC(alB); __syncthreads();
    SBAR(); qkt<ND0>(pA0, pA1, K_lds, qr, r32, hi);
    finishSM(pB0, pB1, alB, l_reg, pa0, pa1, pa2, pa3); SBAR();
    if (j + 3 < NT) SLOAD(SE, kt0 + j + 3); SBAR();
    pv_d0(o, vb0 + AT_SHM_V, pa0, pa1, pa2, pa3); partialSM<MASK>(pA0, pA1, m_reg, mnA, alA, SCALE, (kt0 + j + 1) * 64, qpos, hi);
    __syncthreads(); SWRITE(1, SO);
    RESC(alA); __syncthreads();
  }
  SBAR(); qkt<ND0>(pB0, pB1, K_lds + AT_SHM_K, qr, r32, hi);
  finishSM(pA0, pA1, alA, l_reg, pa0, pa1, pa2, pa3); SBAR();
  pv_d0(o, vb0, pa0, pa1, pa2, pa3); partialSM<MASK>(pB0, pB1, m_reg, mnB, alB, SCALE, (kt0 + NT - 1) * 64, qpos, hi);
  __syncthreads(); RESC(alB);
  finishSM(pB0, pB1, alB, l_reg, pa0, pa1, pa2, pa3); SBAR();
  pv_d0(o, vb0 + AT_SHM_V, pa0, pa1, pa2, pa3);
  if (hi == 0) li_l[r32] = l_reg; asm volatile("s_waitcnt lgkmcnt(0)" ::: "memory");
  float rli[16];
#pragma unroll
  for (int r = 0; r < 16; ++r) rli[r] = __builtin_amdgcn_rcpf(li_l[crow(r, hi)]);
#pragma unroll
  for (int r = 0; r < 16; ++r) { const int orow = crow(r, hi);
#pragma unroll
    for (int d0 = 0; d0 < 2; ++d0) Ow[(size_t)orow * DM + d0 * 32 + r32] = f2bf(o[d0][r] * rli[r]); }
  __syncthreads();
#undef SLOAD
#undef SWRITE
#undef RESC
}

constexpr int LCH = 64, NLCH = SEQ / LCH;
constexpr size_t WS_LP = 1 * MiB, WS_LH = 2560 * 1024;
constexpr size_t WS_LC = 473 * MiB;
constexpr size_t WS_NEED = 475 * MiB;
DEVI void lru_passA(const Params& p, int item, int lane) {
  const int cg = item % 6, c = (item / 6) % NLCH, b = (item / (6 * NLCH)) % NB, d = item / (6 * NLCH * NB);
  const size_t base = (((size_t)(d * NB + b) * (SEQ / 8) + c * 8) * LRU_W + cg * 64 + lane) * 8;
  const u16* E = (const u16*)(p.ws + WS_LE) + base; const u16* Bp = (const u16*)(p.ws + WS_LB) + base;
  u32x4 ev[8], bv[8];
#pragma unroll
  for (int g = 0; g < 8; ++g) { ev[g] = *(const u32x4*)(E + (size_t)g * LRU_W * 8); bv[g] = *(const u32x4*)(Bp + (size_t)g * LRU_W * 8); }
  float h = 0.f, P = 1.f;
#pragma unroll
  for (int gg = 0; gg < 8; ++gg) { const int g = d ? 7 - gg : gg; float e[8], bb[8]; unpk8(ev[g], e); unpk8(bv[g], bb);
#pragma unroll
    for (int rr = 0; rr < 8; ++rr) { const int r = d ? 7 - rr : rr; const float a = 1.f - e[r]; h = fmaf(a, h, bb[r]); P *= a; } }
  const size_t o = ((size_t)(d * NB + b) * NLCH + c) * LRU_W + cg * 64 + lane;
  ((float*)(p.ws + WS_LP))[o] = P; ((float*)(p.ws + WS_LH))[o] = h;
}

DEVI void lru_final(const Params& p, int item, char* lds) {
  const int tid = tidx(), wid = tid >> 6, lane = tid & 63;
  const int c = item % NLCH, b = item / NLCH;
  float* obuf = (float*)lds;
  if (wid < 6) {
    const int ch = wid * 64 + lane;
#pragma unroll
    for (int d = 0; d < 2; ++d) {
      const size_t co = ((size_t)(d * NB + b) * NLCH + c) * LRU_W + ch;
      float h = ((const float*)(p.ws + WS_LC))[co];
      const size_t base = (((size_t)(d * NB + b) * (SEQ / 8) + c * 8) * LRU_W + ch) * 8;
      const u16* E = (const u16*)(p.ws + WS_LE) + base; const u16* Bp = (const u16*)(p.ws + WS_LB) + base;
      u32x4 ev[8], bv[8];
#pragma unroll
      for (int g = 0; g < 8; ++g) { ev[g] = *(const u32x4*)(E + (size_t)g * LRU_W * 8); bv[g] = *(const u32x4*)(Bp + (size_t)g * LRU_W * 8); }
      if (d == 0) {
#pragma unroll
        for (int g = 0; g < 8; ++g) { float e[8], bb[8]; unpk8(ev[g], e); unpk8(bv[g], bb);
#pragma unroll
          for (int r = 0; r < 8; ++r) { h = fmaf(1.f - e[r], h, bb[r]); obuf[(g * 8 + r) * LRU_W + ch] = h; } }
      } else {
        const u16* gp = (const u16*)(p.ws + WS_R1) + ((size_t)b * SEQ + c * LCH) * INWP + PC_LG + ch;
#pragma unroll
        for (int g = 7; g >= 0; --g) { float e[8], bb[8]; unpk8(ev[g], e); unpk8(bv[g], bb);
#pragma unroll
          for (int r = 7; r >= 0; --r) { h = fmaf(1.f - e[r], h, bb[r]); const int tk = g * 8 + r;
            const float gt = bf2f(gp[(size_t)tk * INWP]); obuf[tk * LRU_W + ch] = (obuf[tk * LRU_W + ch] + h) * gelu_erf(gt); } }
      }
    }
  }
  __syncthreads();
  u16* mp = (u16*)(p.ws + WS_MIX) + ((size_t)b * SEQ + c * LCH) * DM + 384;
#pragma unroll 1
  for (int i = 0; i < 8; ++i) { const int tk = wid * 8 + i;
    float v[6]; float s = 0.f;
#pragma unroll
    for (int q = 0; q < 3; ++q) { const f32x2 t2 = *(const f32x2*)(obuf + tk * LRU_W + q * 128 + lane * 2); v[2 * q] = t2.x; v[2 * q + 1] = t2.y; s = fmaf(t2.x, t2.x, s); s = fmaf(t2.y, t2.y, s); }
    s = wave_sum(s);
    const float rs = rsqrtf(s * (1.f / 384.f) + EPS);
#pragma unroll
    for (int q = 0; q < 3; ++q) *(unsigned*)(mp + (size_t)tk * DM + q * 128 + lane * 2) = pk2(v[2 * q] * rs, v[2 * q + 1] * rs);
  }
  __syncthreads();
}

DEVI void peer_cand(const Params& p, int vb, int nb, char* lds) {
  const int tid = tidx();
  unsigned char* my = (unsigned char*)lds + tid * 32;
  const float* top = (const float*)(p.ws + WS_TOP);
  int* eidx = (int*)(p.ws + WS_EIDX); float* egate = (float*)(p.ws + WS_EGATE);
  for (int it = vb * NTHREADS + tid; it < T * 8; it += nb * NTHREADS) {
    float v1[16], v2[16];
    const float* tp = top + (size_t)it * 32;
#pragma unroll
    for (int i = 0; i < 4; ++i) { const f32x4 a = *(const f32x4*)(tp + 4 * i), b = *(const f32x4*)(tp + 16 + 4 * i);
      v1[4 * i] = a.x; v1[4 * i + 1] = a.y; v1[4 * i + 2] = a.z; v1[4 * i + 3] = a.w; v2[4 * i] = b.x; v2[4 * i + 1] = b.y; v2[4 * i + 2] = b.z; v2[4 * i + 3] = b.w; }
#pragma unroll
    for (int i = 0; i < 16; ++i) { my[i] = (unsigned char)(127u - (__float_as_uint(v1[i]) & 127u)); my[16 + i] = (unsigned char)(127u - (__float_as_uint(v2[i]) & 127u)); }
    float l[16];
#pragma unroll
    for (int i = 0; i < 16; ++i) l[i] = -3.0e38f;
#pragma unroll
    for (int a = 0; a < 16; ++a)
#pragma unroll
      for (int b = 0; b < 16; ++b) if ((a + 1) * (b + 1) <= 16) {
        float v = __uint_as_float((__float_as_uint(v1[a] + v2[b]) & ~255u) | (unsigned)(255 - (a * 16 + b)));
#pragma unroll
        for (int i = 0; i < 16; ++i) { const float t = fmaxf(l[i], v); v = fminf(l[i], v); l[i] = t; } }
    const float mx = __uint_as_float(__float_as_uint(l[0]) & ~255u);
    float w[16], sum = 0.f;
#pragma unroll
    for (int i = 0; i < 16; ++i) { w[i] = __expf(__uint_as_float(__float_as_uint(l[i]) & ~255u) - mx); sum += w[i]; }
    const float inv = 1.f / sum;
    int ev[16];
#pragma unroll
    for (int i = 0; i < 16; ++i) { const unsigned code = 255u - (__float_as_uint(l[i]) & 255u); ev[i] = (int)my[code >> 4] * 128 + (int)my[16 + (code & 15)]; w[i] *= inv; }
#pragma unroll
    for (int i = 0; i < 4; ++i) { *(int4*)(eidx + (size_t)it * 16 + 4 * i) = make_int4(ev[4 * i], ev[4 * i + 1], ev[4 * i + 2], ev[4 * i + 3]);
      *(f32x4*)(egate + (size_t)it * 16 + 4 * i) = (f32x4){w[4 * i], w[4 * i + 1], w[4 * i + 2], w[4 * i + 3]}; }
  }
}

DEVI float dot2bf(unsigned w, unsigned x, float acc) { return __builtin_amdgcn_fdot2_f32_bf16(__builtin_bit_cast(bf16x2_t, w), __builtin_bit_cast(bf16x2_t, x), acc, false); }
DEVI void peer_token(const Params& p, int layer, int t, const float* xin, float* xout, bool last, char* wl  ) {
  const int lane = tidx() & 63, q = lane >> 4, j = lane & 15;
  int* s_idx = (int*)wl; float* s_gate = (float*)(wl + 512); float* s_c = (float*)(wl + 1024);
  const u16* UB = (const u16*)(p.ws + WS_UB); const u16* VB = (const u16*)(p.ws + WS_VB);
  const float* gf = p.norm_ffn + layer * DM;
  s_idx[lane] = ((const int*)(p.ws + WS_EIDX))[(size_t)t * 128 + lane]; s_idx[64 + lane] = ((const int*)(p.ws + WS_EIDX))[(size_t)t * 128 + 64 + lane];
  s_gate[lane] = ((const float*)(p.ws + WS_EGATE))[(size_t)t * 128 + lane]; s_gate[64 + lane] = ((const float*)(p.ws + WS_EGATE))[(size_t)t * 128 + 64 + lane];
  unsigned xp[32];
  { float xv[64]; float ss = 0.f;
#pragma unroll
    for (int k = 0; k < 8; ++k) { ld8(xin + (size_t)t * DM + (j + 16 * k) * 8, xv + 8 * k);
#pragma unroll
      for (int i = 0; i < 8; ++i) ss = fmaf(xv[8 * k + i], xv[8 * k + i], ss); }
    ss += __shfl_xor(ss, 1); ss += __shfl_xor(ss, 2); ss += __shfl_xor(ss, 4); ss += __shfl_xor(ss, 8);
    const float rsx = rsqrtf(ss * (1.f / DM) + EPS);
#pragma unroll
    for (int k = 0; k < 8; ++k) { float g8[8]; ld8(gf + (j + 16 * k) * 8, g8);
#pragma unroll
      for (int i = 0; i < 4; ++i) xp[4 * k + i] = pk2(xv[8 * k + 2 * i] * rsx * g8[2 * i], xv[8 * k + 2 * i + 1] * rsx * g8[2 * i + 1]); } }
  asm volatile("s_waitcnt lgkmcnt(0)" ::: "memory");
  u32x4 cu[8], nu[8];
  { const u16* r0 = UB + (size_t)s_idx[q] * DM + j * 8;
#pragma unroll
    for (int k = 0; k < 8; ++k) cu[k] = *(const u32x4*)(r0 + 128 * k); }
#pragma unroll 1
  for (int i = 0; i < 32; ++i) {
    if (i + 1 < 32) { const u16* r1 = UB + (size_t)s_idx[4 * (i + 1) + q] * DM + j * 8;
#pragma unroll
      for (int k = 0; k < 8; ++k) nu[k] = *(const u32x4*)(r1 + 128 * k); }
    float a0 = 0.f, a1 = 0.f, a2 = 0.f, a3 = 0.f;
#pragma unroll
    for (int k = 0; k < 8; ++k) { a0 = dot2bf(cu[k].x, xp[4 * k], a0); a1 = dot2bf(cu[k].y, xp[4 * k + 1], a1); a2 = dot2bf(cu[k].z, xp[4 * k + 2], a2); a3 = dot2bf(cu[k].w, xp[4 * k + 3], a3); }
    float dsum = (a0 + a1) + (a2 + a3);
    dsum += __shfl_xor(dsum, 1); dsum += __shfl_xor(dsum, 2); dsum += __shfl_xor(dsum, 4); dsum += __shfl_xor(dsum, 8);
    if (j == 0) s_c[4 * i + q] = gelu_erf(dsum) * s_gate[4 * i + q];
#pragma unroll
    for (int k = 0; k < 8; ++k) cu[k] = nu[k];
  }
  asm volatile("s_waitcnt lgkmcnt(0)" ::: "memory");
  float y[64];
#pragma unroll
  for (int i = 0; i < 64; ++i) y[i] = 0.f;
  { const u16* r0 = VB + (size_t)s_idx[q] * DM + j * 8;
#pragma unroll
    for (int k = 0; k < 8; ++k) cu[k] = *(const u32x4*)(r0 + 128 * k); }
#pragma unroll 1
  for (int i = 0; i < 32; ++i) {
    if (i + 1 < 32) { const u16* r1 = VB + (size_t)s_idx[4 * (i + 1) + q] * DM + j * 8;
#pragma unroll
      for (int k = 0; k < 8; ++k) nu[k] = *(const u32x4*)(r1 + 128 * k); }
    const float c = s_c[4 * i + q];
#pragma unroll
    for (int k = 0; k < 8; ++k) { float v[8]; unpk8(cu[k], v);
#pragma unroll
      for (int e = 0; e < 8; ++e) y[8 * k + e] = fmaf(c, v[e], y[8 * k + e]); }
#pragma unroll
    for (int k = 0; k < 8; ++k) cu[k] = nu[k];
  }
#pragma unroll
  for (int i = 0; i < 64; ++i) { y[i] += __shfl_xor(y[i], 16); y[i] += __shfl_xor(y[i], 32); }
  float ss2 = 0.f;
#pragma unroll
  for (int k = 0; k < 8; ++k) { float xv[8]; ld8(xin + (size_t)t * DM + (j + 16 * k) * 8, xv);
#pragma unroll
    for (int e = 0; e < 8; ++e) { y[8 * k + e] += xv[e]; ss2 = fmaf(y[8 * k + e], y[8 * k + e], ss2); } }
  ss2 += __shfl_xor(ss2, 1); ss2 += __shfl_xor(ss2, 2); ss2 += __shfl_xor(ss2, 4); ss2 += __shfl_xor(ss2, 8);
  const float rs2 = rsqrtf(ss2 * (1.f / DM) + EPS);
  u16* xg = (u16*)(p.ws + WS_XG);
#pragma unroll
  for (int k = 0; k < 8; ++k) if ((k >> 1) == q) {
    const int col = (j + 16 * k) * 8;
    if (last) { float g8[8]; ld8(p.norm_final + col, g8); float ov[8];
#pragma unroll
      for (int e = 0; e < 8; ++e) ov[e] = y[8 * k + e] * rs2 * g8[e];
      *(f32x4*)(xout + (size_t)t * DM + col) = (f32x4){ov[0], ov[1], ov[2], ov[3]}; *(f32x4*)(xout + (size_t)t * DM + col + 4) = (f32x4){ov[4], ov[5], ov[6], ov[7]}; }
    else { *(f32x4*)(xout + (size_t)t * DM + col) = (f32x4){y[8 * k], y[8 * k + 1], y[8 * k + 2], y[8 * k + 3]};
      *(f32x4*)(xout + (size_t)t * DM + col + 4) = (f32x4){y[8 * k + 4], y[8 * k + 5], y[8 * k + 6], y[8 * k + 7]};
      *(u32x4*)(xg + (size_t)t * DM + col) = pk8(&y[8 * k]); }
  }
}

DEVI void lru_passB(const Params& p, int item, int lane) {
  const int cg = item % 6, b = (item / 6) % NB, d = item / (6 * NB);
  const size_t o = (size_t)(d * NB + b) * NLCH * LRU_W + cg * 64 + lane;
  const float* Pp = (const float*)(p.ws + WS_LP) + o; const float* Hp = (const float*)(p.ws + WS_LH) + o; float* Cp = (float*)(p.ws + WS_LC) + o;
  float h = 0.f;
#pragma unroll 1
  for (int c0 = 0; c0 < NLCH; c0 += 32) {
    float pv[32], hv[32];
#pragma unroll
    for (int i = 0; i < 32; ++i) { const int cc = d ? NLCH - 1 - (c0 + i) : c0 + i; pv[i] = Pp[(size_t)cc * LRU_W]; hv[i] = Hp[(size_t)cc * LRU_W]; }
#pragma unroll
    for (int i = 0; i < 32; ++i) { const int cc = d ? NLCH - 1 - (c0 + i) : c0 + i; Cp[(size_t)cc * LRU_W] = h; h = fmaf(pv[i], h, hv[i]); }
  }
}

DEVI void swa_item(const Params& p, int layer, int item, char* lds) {
  const int tid = tidx(), wid = tid >> 6, lane = tid & 63, r32 = lane & 31, hi = lane >> 5;
  const int g = item & 1, n = (item >> 1) & 63, b = item >> 7;
  const int hq = 2 * g + (wid >> 2), qrow = n * 128 + (wid & 3) * 32;
  const u16* proj = (const u16*)(p.ws + WS_R1);
  const u16* Qw = proj + (size_t)(b * SEQ + qrow + r32) * INWP + PC_SQ + hq * 64 + hi * 8;
  const u16* Kh = proj + (size_t)(b * SEQ) * INWP + PC_SK + g * 64;
  const u16* Vh = proj + (size_t)(b * SEQ) * INWP + PC_SV + g * 64;
  const int kt0 = (2 * n - 2) < 0 ? 0 : (2 * n - 2), kt1 = (2 * n + 4) > SEQ / 64 ? SEQ / 64 : (2 * n + 4);
  const float sink = p.swa_sink[layer * 4 + hq];
  u16* Ow = (u16*)(p.ws + WS_MIX) + (size_t)(b * SEQ + qrow) * DM + 768 + hq * 64;
  attn_body<64, true>(Qw, Kh, INWP, Vh, INWP, kt0, kt1 - kt0, 0.125f, sink * 8.f, 1.f, qrow + r32, Ow, lds);
}
DEVI void mla_item(const Params& p, int pair, int qb, char* lds) {
  const int tid = tidx(), wid = tid >> 6, lane = tid & 63, r32 = lane & 31, hi = lane >> 5;
  const int b = pair / MLA_H, h = pair - b * MLA_H;
  const u16* Qw = (const u16*)(p.ws + WS_QM) + ((size_t)pair * SEQ + qb * 256 + wid * 32 + r32) * MLA_QK + hi * 8;
  const u16* Kh = (const u16*)(p.ws + WS_KM) + (size_t)pair * SEQ * MLA_QK;
  const u16* Vh = (const u16*)(p.ws + WS_VM) + (size_t)pair * SEQ * MLA_V;
  u16* Ow = (u16*)(p.ws + WS_MIX) + (size_t)(b * SEQ + qb * 256 + wid * 32) * DM + h * 64;
  attn_body<96, false>(Qw, Kh, MLA_QK, Vh, MLA_V, 0, SEQ / 64, 0.10206207261596575f, -1e30f, 0.f, 0, Ow, lds);
}

constexpr int PH_PER_LAYER = 10, N_PHASES = 1 + DEPTH * PH_PER_LAYER;
DEVI void run_phase(const Params& pin, int ph, int vb, int nb, char* lds) {
  Params p = pin; asm volatile("" : "+s"(p.ws)); asm volatile("" : "+s"(p.out)); asm volatile("" : "+s"(vb));
  const int tid = tidx(), wid = tid >> 6, lane = tid & 63;
#ifdef ONLY_SP
  if (ONLY_SP >= 0 && ph == 0) return;
#endif
  if (ph == 0) { phase0(p, vb, nb, lds); return; }
  const int l = (ph - 1) / PH_PER_LAYER, sp = (ph - 1) % PH_PER_LAYER;
  u16* const XG = (u16*)(p.ws + WS_XG); u16* const PROJ = (u16*)(p.ws + WS_R1); u16* const MIX = (u16*)(p.ws + WS_MIX);
  constexpr int NMT = T / 256;
#ifdef ONLY_SP
  if (sp != ONLY_SP) return;
#endif
  switch (sp) {
  case 0: {
    GemmDesc g = gemm_desc(XG, DM, (const u16*)(p.ws + WS_WIN) + (size_t)l * INWP * DM, DM, DM);
    EpiP1 e{PROJ, p.pos};
    for (int it = vb; it < NMT * 14; it += nb) gemm_tile<0, 1>(g, (it / 14) * 256, (it % 14) * 128, lds, e);
  } break;
  case 1: {
    constexpr int N_C = NMT * 12, N_A = NMT * 5, N_B = NMT * 6;
    for (int it = vb; it < N_C + N_A + N_B; it += nb) {
      if (it < N_C) { const int mt = it / 12, nd = it % 12, n = nd >> 1, d = nd & 1;
        GemmDesc g{}; g.Bt = (const u16*)(p.ws + WS_WLRU) + (size_t)((l * 6 + n) * 2 + d) * 128 * 64; g.ldb = 64; g.KT = 1;
        g.proj = PROJ; g.cw = p.conv_w + l * 4 * LRU_W; g.cb = p.conv_b + l * LRU_W; g.ch0 = n * 64;
        EpiLRU e{PROJ, g.cw, g.cb, p.lru_ba + l * 2 * 384, p.lru_bx + l * 2 * 384, p.lru_lambda + l * 2 * 384, (u16*)(p.ws + WS_LE), (u16*)(p.ws + WS_LB), n, d};
        gemm_tile<1, 0>(g, mt * 256, 0, lds, e);
      } else if (it < N_C + N_A) { const int i2 = it - N_C;
        GemmDesc g = gemm_desc(PROJ + PC_CQ, INWP, (const u16*)(p.ws + WS_WUQ) + (size_t)l * 640 * 256, 256, 256);
        EpiQ e{(u16*)(p.ws + WS_QM), p.pos};
        gemm_tile<0, 1>(g, (i2 / 5) * 256, (i2 % 5) * 128, lds, e);
      } else { const int i2 = it - N_C - N_A;
        GemmDesc g = gemm_desc(PROJ + PC_CKV, INWP, (const u16*)(p.ws + WS_WUKV) + (size_t)l * 768 * 128, 128, 128);
        EpiKV e{(u16*)(p.ws + WS_KM), (u16*)(p.ws + WS_VM), PROJ};
        gemm_tile<0, 1>(g, (i2 / 6) * 256, (i2 % 6) * 128, lds, e);
      }
    }
  } break;
  case 2: {
    for (int it = vb * 8 + wid; it < 2 * NB * NLCH * 6; it += nb * 8) lru_passA(p, it, lane);
  } break;
  case 3: {
    const int wi = vb * 8 + wid;
    if (wi < 48) lru_passB(p, wi, lane);
    __syncthreads();
    for (int it = vb; it < NB * 64 * 2; it += nb) swa_item(p, l, it, lds);
  } break;
  case 4: {
    for (int k = 0; k * nb + vb < NB * MLA_H * 32; ++k) {
      int pair, qb;
      if (nb == 256) { pair = k * 8 + (vb & 7); qb = vb >> 3; } else { const int it = k * nb + vb; pair = it >> 5; qb = it & 31; }
      mla_item(p, pair, qb, lds);
    }
#ifndef NO_LRUF
    for (int it = vb; it < NB * NLCH; it += nb) lru_final(p, it, lds);
#endif
  } break;
  case 5: {
    GemmDesc g = gemm_desc(MIX, DM, (const u16*)(p.ws + WS_WOUT) + (size_t)l * DM * DM, DM, DM);
    EpiP4 e{l == 0 ? p.x : p.out, p.out, XG};
    for (int it = vb; it < NMT * 8; it += nb) gemm_tile<0, 2>(g, (it / 8) * 256, (it % 8) * 128, lds, e);
    const float* us = p.peer_u + (size_t)l * NEXP * DM; const float* vs = p.peer_v + (size_t)l * NEXP * DM;
    u16* ub = (u16*)(p.ws + WS_UB); u16* vbf = (u16*)(p.ws + WS_VB);
    for (size_t i = (size_t)vb * NTHREADS + tid; i < (size_t)NEXP * DM / 8; i += (size_t)nb * NTHREADS) {
      float a[8], b[8]; ld8(us + i * 8, a); ld8(vs + i * 8, b);
      *(u32x4*)(ub + i * 8) = pk8(a); *(u32x4*)(vbf + i * 8) = pk8(b); }
  } break;
  case 6: {
    GemmDesc g = gemm_desc(XG, DM, (const u16*)(p.ws + WS_WQ) + (size_t)l * 2048 * DM, DM, DM);
    EpiBf16 e{PROJ, 2048};
    for (int it = vb; it < NMT * 16; it += nb) gemm_tile<0, 1>(g, (it / 16) * 256, (it % 16) * 128, lds, e);
  } break;
  case 7: {
    for (int it = vb; it < NMT * 16; it += nb) { const int mt = it / 16, hj = it % 16, j = hj & 1;
      GemmDesc g{}; g.A = PROJ + hj * 128; g.lda = 2048; g.Bt = (const u16*)(p.ws + WS_SUBK) + (size_t)(l * 2 + j) * 128 * 128; g.ldb = 128; g.KT = 2;
      EpiTop e{(float*)(p.ws + WS_TOP), hj};
      gemm_tile<0, 0>(g, mt * 256, 0, lds, e); }
  } break;
  case 8: peer_cand(p, vb, nb, lds); break;
  case 9: {
    char* wl = lds + wid * 2048;
    for (int t = vb * 8 + wid; t < T; t += nb * 8) peer_token(p, l, t, p.out, p.out, l == DEPTH - 1, wl);
  } break;
  }
}

__global__ void __launch_bounds__(NTHREADS, 2) mega(Params p) {
  extern __shared__ __attribute__((aligned(16))) char smem[];
  cg::grid_group grid = cg::this_grid();
  const int nb = gridDim.x, vb = blockIdx.x;
  for (int ph = p.ph_lo; ph < p.ph_hi; ++ph) {
    run_phase(p, ph, vb, nb, smem);
    if (ph + 1 < p.ph_hi) grid.sync();
  }
}

#ifndef N_LAUNCH_SPLIT
#define N_LAUNCH_SPLIT 0
#endif
extern "C" void kernel_launch(void* const* d_in, const int* in_sizes, int n_in, void* d_out, int out_size, void* d_ws, size_t ws_size, hipStream_t stream) {
  static int grid_blocks = 0;
  if (grid_blocks == 0) {
    if (n_in != 24 || out_size != T * DM || ws_size < WS_NEED) { fprintf(stderr, "kernel_launch: unexpected shapes n_in %d out %d ws %zu\n", n_in, out_size, ws_size); grid_blocks = -1; return; }
    int dev = 0, cus = 0, per_cu = 0;
    (void)hipGetDevice(&dev); (void)hipDeviceGetAttribute(&cus, hipDeviceAttributeMultiprocessorCount, dev);
    if (hipFuncSetAttribute((const void*)mega, hipFuncAttributeMaxDynamicSharedMemorySize, LDS_BYTES) != hipSuccess) { fprintf(stderr, "kernel_launch: hipFuncSetAttribute failed\n"); grid_blocks = -1; return; }
    if (hipOccupancyMaxActiveBlocksPerMultiprocessor(&per_cu, (const void*)mega, NTHREADS, LDS_BYTES) != hipSuccess || per_cu < 1) { fprintf(stderr, "kernel_launch: occupancy query failed (%d)\n", per_cu); grid_blocks = -1; return; }
    grid_blocks = cus * 1;
    fprintf(stderr, "kernel_launch: cus %d per_cu %d grid %d\n", cus, per_cu, grid_blocks);
  }
  if (grid_blocks < 0) return;
  Params p{};
  p.x = (const float*)d_in[0]; p.pos = (const int*)d_in[1]; p.norm_mix = (const float*)d_in[2]; p.w_in = (const float*)d_in[3]; p.q_norm = (const float*)d_in[4];
  p.w_uq = (const float*)d_in[5]; p.kv_norm = (const float*)d_in[6]; p.w_ukv = (const float*)d_in[7]; p.conv_w = (const float*)d_in[8]; p.conv_b = (const float*)d_in[9];
  p.lru_wa = (const float*)d_in[10]; p.lru_ba = (const float*)d_in[11]; p.lru_wx = (const float*)d_in[12]; p.lru_bx = (const float*)d_in[13]; p.lru_lambda = (const float*)d_in[14];
  p.swa_sink = (const float*)d_in[15]; p.grp_norm = (const float*)d_in[16]; p.w_out = (const float*)d_in[17]; p.norm_ffn = (const float*)d_in[18]; p.peer_wq = (const float*)d_in[19];
  p.peer_subkeys = (const float*)d_in[20]; p.peer_u = (const float*)d_in[21]; p.peer_v = (const float*)d_in[22]; p.norm_final = (const float*)d_in[23];
  p.out = (float*)d_out; p.ws = (unsigned char*)d_ws;
#if N_LAUNCH_SPLIT
  for (int ph = 0; ph < N_PHASES; ++ph) {
    p.ph_lo = ph; p.ph_hi = ph + 1;
    void* args[] = {&p};
    hipError_t e = hipLaunchCooperativeKernel((const void*)mega, dim3(grid_blocks), dim3(NTHREADS), args, LDS_BYTES, stream);
    if (e != hipSuccess) { fprintf(stderr, "kernel_launch: launch of phase %d failed: %s\n", ph, hipGetErrorString(e)); break; }
  }
#else
  p.ph_lo = 0; p.ph_hi = N_PHASES;
  void* args[] = {&p};
  hipError_t e = hipLaunchCooperativeKernel((const void*)mega, dim3(grid_blocks), dim3(NTHREADS), args, LDS_BYTES, stream);
  if (e != hipSuccess) fprintf(stderr, "kernel_launch: cooperative launch failed: %s (grid %d)\n", hipGetErrorString(e), grid_blocks);
#endif
}
```

```cpp
#include <hip/hip_runtime.h>
#include <hip/hip_cooperative_groups.h>
#include <cstdio>
#include <cstdint>
namespace cg = cooperative_groups;

#define DEVI __device__ __forceinline__
typedef unsigned short u16;
typedef short bf16x8 __attribute__((ext_vector_type(8)));
typedef short s16x4 __attribute__((ext_vector_type(4)));
typedef float f32x2 __attribute__((ext_vector_type(2)));
typedef float f32x4 __attribute__((ext_vector_type(4)));
typedef float f32x16 __attribute__((ext_vector_type(16)));
typedef unsigned u32x4 __attribute__((ext_vector_type(4)));
typedef unsigned u32x2 __attribute__((ext_vector_type(2)));
typedef __bf16 bf16x2_t __attribute__((ext_vector_type(2)));

constexpr int NB = 4, SEQ = 8192, T = NB * SEQ, DM = 1024, DEPTH = 2;
constexpr int MLA_H = 6, MLA_QK = 96, MLA_V = 64;
constexpr int LRU_W = 384;
constexpr int INW = 1696, INWP = 1792;
constexpr int PC_CQ = 0, PC_CKV = 256, PC_SQ = 384, PC_SK = 640, PC_SV = 768, PC_LX = 896, PC_LG = 1280, PC_KR = 1664;
constexpr int OC_CQ = 0, OC_CKV = 256, OC_KR = 384, OC_SQ = 416, OC_SK = 672, OC_SV = 800, OC_LX = 928, OC_LG = 1312;
constexpr int NEXP = 16384;
constexpr float EPS = 1e-6f;
constexpr int NTHREADS = 512;
constexpr int LDS_BYTES = 160 * 1024;

constexpr size_t MiB = 1u << 20;
constexpr size_t WS_CTL = 0;
constexpr size_t WS_WIN = 4 * MiB;
constexpr size_t WS_WQ = 11 * MiB;
constexpr size_t WS_WOUT = 19 * MiB;
constexpr size_t WS_WUQ = 23 * MiB;
constexpr size_t WS_WUKV = WS_WUQ + 2 * 640 * 256 * 2;
constexpr size_t WS_WLRU = WS_WUKV + 2 * 768 * 128 * 2;
constexpr size_t WS_SUBK = WS_WLRU + 2 * 6 * 2 * 128 * 64 * 2;
constexpr size_t WS_XG = 25 * MiB;
constexpr size_t WS_R1 = 89 * MiB;
constexpr size_t WS_QM = 217 * MiB;
constexpr size_t WS_KM = 253 * MiB;
constexpr size_t WS_VM = 289 * MiB;
constexpr size_t WS_LE = 313 * MiB;
constexpr size_t WS_LB = 361 * MiB;
constexpr size_t WS_MIX = 409 * MiB;
constexpr size_t WS_UB = 217 * MiB;
constexpr size_t WS_VB = 249 * MiB;
constexpr size_t WS_TOP = 281 * MiB;
constexpr size_t WS_EIDX = 313 * MiB;
constexpr size_t WS_EGATE = 329 * MiB;
constexpr size_t WS_END = 473 * MiB;

__device__ const float ROPE_HI[32] = {1.591549367e-01f, 1.193493679e-01f, 8.949939907e-02f, 6.711508334e-02f, 5.032921210e-02f, 3.774158657e-02f, 2.830219641e-02f, 2.122365311e-02f, 1.591549441e-02f, 1.193493698e-02f, 8.949940093e-03f, 6.711508147e-03f, 5.032921210e-03f, 3.774158424e-03f, 2.830219688e-03f, 2.122365171e-03f, 1.591549488e-03f, 1.193493721e-03f, 8.949940093e-04f, 6.711508031e-04f, 5.032921326e-04f, 3.774158540e-04f, 2.830219455e-04f, 2.122365258e-04f, 1.591549371e-04f, 1.193493736e-04f, 8.949940093e-05f, 6.711508468e-05f, 5.032921035e-05f, 3.774158540e-05f, 2.830219637e-05f, 2.122365186e-05f};
__device__ const float ROPE_LO[32] = {6.420638243e-09f, 2.294664903e-09f, 2.542919653e-09f, -3.316028840e-10f, 5.173299289e-12f, -1.848551645e-09f, -5.826552019e-10f, -3.431038786e-10f, -1.029942243e-10f, 4.320196978e-11f, 6.802744479e-11f, 1.531042237e-10f, 5.173301024e-13f, 4.797548470e-11f, -1.048316434e-10f, 1.053879969e-10f, -5.686555046e-11f, -1.896286773e-11f, 6.802744999e-12f, 2.695195456e-11f, -1.158979943e-11f, -6.843983713e-12f, 1.279990003e-11f, 1.807650600e-12f, 5.954976963e-12f, -3.351478166e-12f, 6.802744674e-13f, -1.670379113e-12f, 1.751403167e-12f, -6.843983930e-13f, -5.389994549e-13f, 9.083608431e-13f};

DEVI int tidx() { int t = __builtin_amdgcn_workitem_id_x(); asm volatile("" : "+v"(t)); return t; }
DEVI float bf2f(unsigned h) { return __uint_as_float(h << 16); }
DEVI float bflo(unsigned w) { return __uint_as_float(w << 16); }
DEVI float bfhi(unsigned w) { return __uint_as_float(w & 0xffff0000u); }
DEVI unsigned pk2(float lo, float hi) { f32x2 v = {lo, hi}; bf16x2_t b = __builtin_convertvector(v, bf16x2_t); return __builtin_bit_cast(unsigned, b); }
DEVI u16 f2bf(float f) { return (u16)(pk2(f, 0.f) & 0xffffu); }
DEVI u32x4 pk8(const float* v) { u32x4 w; w.x = pk2(v[0], v[1]); w.y = pk2(v[2], v[3]); w.z = pk2(v[4], v[5]); w.w = pk2(v[6], v[7]); return w; }
DEVI void unpk8(u32x4 w, float* v) { v[0] = bflo(w.x); v[1] = bfhi(w.x); v[2] = bflo(w.y); v[3] = bfhi(w.y); v[4] = bflo(w.z); v[5] = bfhi(w.z); v[6] = bflo(w.w); v[7] = bfhi(w.w); }
DEVI int crow(int r, int hi) { return (r & 3) + 8 * (r >> 2) + 4 * hi; }
DEVI float wave_sum(float v) {
#pragma unroll
  for (int o = 1; o < 64; o <<= 1) v += __shfl_xor(v, o);
  return v;
}
DEVI void rope_sc(float pos, int fidx, float& sn, float& cs) {
  const float chi = ROPE_HI[fidx], clo = ROPE_LO[fidx];
  const float t = pos * chi, e = fmaf(pos, chi, -t);
  float fr = t - rintf(t);
  fr = fr + (e + pos * clo);
  sn = __builtin_amdgcn_sinf(fr); cs = __builtin_amdgcn_cosf(fr);
}
DEVI float sigmoidf_(float x) { return 1.f / (1.f + __expf(-x)); }
DEVI float gelu_erf(float x) { return 0.5f * x * (1.f + erff(x * 0.70710678118654752f)); }

struct Params {
  const float* x; const int* pos; const float* norm_mix; const float* w_in; const float* q_norm; const float* w_uq; const float* kv_norm; const float* w_ukv;
  const float* conv_w; const float* conv_b; const float* lru_wa; const float* lru_ba; const float* lru_wx; const float* lru_bx; const float* lru_lambda;
  const float* swa_sink; const float* grp_norm; const float* w_out; const float* norm_ffn; const float* peer_wq; const float* peer_subkeys;
  const float* peer_u; const float* peer_v; const float* norm_final;
  float* out; unsigned char* ws;
  int ph_lo, ph_hi;
};

DEVI void tconv_item(const float* W, int ldw, int src_c0, u16* WT, int K, int dst_r0, const float* gain, float* scr, int kb, int nb, int lane) {
  const int k0 = 64 * kb, n0 = 32 * nb;
#pragma unroll 8
  for (int i = 0; i < 32; ++i) { const int kk = 2 * i + (lane >> 5); float g = gain ? gain[k0 + kk] : 1.f; scr[kk * 33 + (lane & 31)] = g * W[(size_t)(k0 + kk) * ldw + src_c0 + n0 + (lane & 31)]; }
  __builtin_amdgcn_s_waitcnt(0xc07f); asm volatile("" ::: "memory");
  const int c = lane & 7;
#pragma unroll
  for (int j = 0; j < 4; ++j) { const int n = (lane >> 3) + 8 * j; const float* s = scr + (8 * c) * 33 + n;
    u32x4 o; o.x = pk2(s[0 * 33], s[1 * 33]); o.y = pk2(s[2 * 33], s[3 * 33]); o.z = pk2(s[4 * 33], s[5 * 33]); o.w = pk2(s[6 * 33], s[7 * 33]);
    *(u32x4*)(WT + (size_t)(dst_r0 + n0 + n) * K + k0 + 8 * c) = o; }
  __builtin_amdgcn_s_waitcnt(0xc07f); asm volatile("" ::: "memory");
}

DEVI void tseg(const float* W, int ldw, int src_c0, int ncols, u16* WT, int K, int dst_r0, const float* gain, float* scr, int gw, int ngw, int lane) {
  const int nkb = K / 64, nnb = ncols / 32, ni = nkb * nnb;
  for (int it = gw; it < ni; it += ngw) tconv_item(W, ldw, src_c0, WT, K, dst_r0, gain, scr, it / nnb, it % nnb, lane);
}

DEVI void phase0(const Params& p, int vb, int nb, char* lds) {
  const int tid = tidx(), lane = tid & 63, wid = tid >> 6;
  float* scr = (float*)(lds + wid * 16384);
  const int gw = vb * 8 + wid, ngw = nb * 8;
#pragma unroll 1
  for (int l = 0; l < DEPTH; ++l) {
    const float* win = p.w_in + (size_t)l * DM * INW; u16* wint = (u16*)(p.ws + WS_WIN) + (size_t)l * INWP * DM; const float* gm = p.norm_mix + l * DM;
    tseg(win, INW, OC_CQ, 256, wint, DM, PC_CQ, gm, scr, gw, ngw, lane);
    tseg(win, INW, OC_CKV, 128, wint, DM, PC_CKV, gm, scr, gw, ngw, lane);
    tseg(win, INW, OC_SQ, 256, wint, DM, PC_SQ, gm, scr, gw, ngw, lane);
    tseg(win, INW, OC_SK, 128, wint, DM, PC_SK, gm, scr, gw, ngw, lane);
    tseg(win, INW, OC_SV, 128, wint, DM, PC_SV, gm, scr, gw, ngw, lane);
    tseg(win, INW, OC_LX, 384, wint, DM, PC_LX, gm, scr, gw, ngw, lane);
    tseg(win, INW, OC_LG, 384, wint, DM, PC_LG, gm, scr, gw, ngw, lane);
    tseg(win, INW, OC_KR, 32, wint, DM, PC_KR, gm, scr, gw, ngw, lane);
    tseg(p.peer_wq + (size_t)l * DM * 2048, 2048, 0, 2048, (u16*)(p.ws + WS_WQ) + (size_t)l * 2048 * DM, DM, 0, p.norm_ffn + l * DM, scr, gw, ngw, lane);
    tseg(p.w_out + (size_t)l * DM * DM, DM, 0, DM, (u16*)(p.ws + WS_WOUT) + (size_t)l * DM * DM, DM, 0, p.grp_norm + l * DM, scr, gw, ngw, lane);
    tseg(p.w_uq + (size_t)l * 256 * 576, 576, 0, 576, (u16*)(p.ws + WS_WUQ) + (size_t)l * 640 * 256, 256, 0, p.q_norm + l * 256, scr, gw, ngw, lane);
    tseg(p.w_ukv + (size_t)l * 128 * 768, 768, 0, 768, (u16*)(p.ws + WS_WUKV) + (size_t)l * 768 * 128, 128, 0, p.kv_norm + l * 128, scr, gw, ngw, lane);
    for (int it = gw; it < 2 * 6 * 2 * 2; it += ngw) {
      const int nbk = it & 1, ax = (it >> 1) & 1, n = (it >> 2) % 6, d = (it >> 2) / 6;
      const float* W = (ax ? p.lru_wx : p.lru_wa) + ((size_t)(l * 2 + d) * 6 + n) * 4096;
      u16* WT = (u16*)(p.ws + WS_WLRU) + ((size_t)((l * 6 + n) * 2 + d)) * 128 * 64;
      tconv_item(W, 64, 0, WT, 64, ax * 64, nullptr, scr, 0, nbk, lane);
    }
  }
  for (int i = vb * NTHREADS + tid; i < DEPTH * 96 * DM / 8; i += nb * NTHREADS) { const int l = i / (96 * DM / 8), r = i % (96 * DM / 8);
    *(u32x4*)((u16*)(p.ws + WS_WIN) + ((size_t)l * INWP + INW) * DM + (size_t)r * 8) = (u32x4){0, 0, 0, 0}; }
  for (int i = vb * NTHREADS + tid; i < DEPTH * 64 * 256 / 8; i += nb * NTHREADS) { const int l = i / (64 * 256 / 8), r = i % (64 * 256 / 8);
    *(u32x4*)((u16*)(p.ws + WS_WUQ) + ((size_t)l * 640 + 576) * 256 + (size_t)r * 8) = (u32x4){0, 0, 0, 0}; }
  for (int i = vb * NTHREADS + tid; i < DEPTH * 2 * 128 * 128 / 8; i += nb * NTHREADS) {
    const f32x4 a = *(const f32x4*)(p.peer_subkeys + (size_t)i * 8), b = *(const f32x4*)(p.peer_subkeys + (size_t)i * 8 + 4);
    u32x4 o; o.x = pk2(a.x, a.y); o.y = pk2(a.z, a.w); o.z = pk2(b.x, b.y); o.w = pk2(b.z, b.w);
    *(u32x4*)((u16*)(p.ws + WS_SUBK) + (size_t)i * 8) = o; }
  for (size_t i = (size_t)vb * NTHREADS + tid; i < (size_t)T * DM / 8; i += (size_t)nb * NTHREADS) {
    const f32x4 a = *(const f32x4*)(p.x + i * 8), b = *(const f32x4*)(p.x + i * 8 + 4);
    u32x4 o; o.x = pk2(a.x, a.y); o.y = pk2(a.z, a.w); o.z = pk2(b.x, b.y); o.w = pk2(b.z, b.w);
    *(u32x4*)((u16*)(p.ws + WS_XG) + i * 8) = o; }
}

DEVI int swz(int row, int c) { return row * 128 + ((c ^ ((row >> 1) & 7)) << 4); }
constexpr int CLD = 132;
constexpr int LDS_RS = 135168;

struct GemmDesc {
  const u16* A; int lda; const u16* Bt; int ldb; int KT;
  float inv0;
  const u16* proj; const float* cw; const float* cb; int ch0;
};

template <int AMODE> DEVI bf16x8 load_a(const GemmDesc& g, int row, int kcol) {
  if constexpr (AMODE == 0) {
    return *(const bf16x8*)(g.A + (size_t)row * g.lda + kcol);
  } else {
    const int s = row & (SEQ - 1), ch = g.ch0 + kcol;
    float a[8];
    { const f32x4 b0 = *(const f32x4*)(g.cb + ch), b1 = *(const f32x4*)(g.cb + ch + 4); a[0] = b0.x; a[1] = b0.y; a[2] = b0.z; a[3] = b0.w; a[4] = b1.x; a[5] = b1.y; a[6] = b1.z; a[7] = b1.w; }
#pragma unroll
    for (int tap = 0; tap < 4; ++tap) {
      const int ss = s - 1 + tap;
      if (ss >= 0 && ss < SEQ) {
        const u32x4 v = *(const u32x4*)(g.proj + (size_t)(row - 1 + tap) * INWP + PC_LX + ch);
        float x[8]; unpk8(v, x);
        const f32x4 w0 = *(const f32x4*)(g.cw + tap * LRU_W + ch), w1 = *(const f32x4*)(g.cw + tap * LRU_W + ch + 4);
        a[0] += w0.x * x[0]; a[1] += w0.y * x[1]; a[2] += w0.z * x[2]; a[3] += w0.w * x[3];
        a[4] += w1.x * x[4]; a[5] += w1.y * x[5]; a[6] += w1.z * x[6]; a[7] += w1.w * x[7];
      }
    }
    const u32x4 o = pk8(a);
    return __builtin_bit_cast(bf16x8, o);
  }
}

template <int AMODE> DEVI void g_load(const GemmDesc& g, bf16x8 (&ar)[4], bf16x8 (&br)[2], int m0, int n0, int srow, int sc, int kt) {
#pragma unroll
  for (int i = 0; i < 4; ++i) ar[i] = load_a<AMODE>(g, m0 + srow + 64 * i, kt * 64 + sc * 8);
#pragma unroll
  for (int i = 0; i < 2; ++i) br[i] = *(const bf16x8*)(g.Bt + (size_t)(n0 + srow + 64 * i) * g.ldb + kt * 64 + sc * 8);
}
template <bool NORM> DEVI void g_write(char* Ab, const bf16x8 (&ar)[4], const bf16x8 (&br)[2], float (&ssq)[4], int srow, int sc) {
  char* Bb = Ab + 32768;
#pragma unroll
  for (int i = 0; i < 4; ++i) { *(bf16x8*)(Ab + swz(srow + 64 * i, sc)) = ar[i];
    if (NORM) { float x[8]; unpk8(__builtin_bit_cast(u32x4, ar[i]), x); float s = ssq[i];
#pragma unroll
      for (int q = 0; q < 8; ++q) s = fmaf(x[q], x[q], s);
      ssq[i] = s; } }
#pragma unroll
  for (int i = 0; i < 2; ++i) *(bf16x8*)(Bb + swz(srow + 64 * i, sc)) = br[i];
}

template <int AMODE, int SEG, class Epi>
DEVI void gemm_tile(const GemmDesc& g, int m0, int n0, char* lds, const Epi& epi) {
  const int tid = tidx(), lane = tid & 63, wid = tid >> 6;
  const int wm = wid >> 1, wn = wid & 1, r32 = lane & 31, hi = lane >> 5;
  const int srow = tid >> 3, sc = tid & 7;
  constexpr bool NORM = SEG != 0;
  float* rs = (float*)(lds + LDS_RS);
  f32x16 acc[2][2], acc2[2][2];
#pragma unroll
  for (int i = 0; i < 2; ++i)
#pragma unroll
    for (int j = 0; j < 2; ++j) { acc[i][j] = f32x16{}; acc2[i][j] = f32x16{}; }
  float ssq[4] = {0.f, 0.f, 0.f, 0.f};
  bf16x8 ar[4], br[2];
  g_load<AMODE>(g, ar, br, m0, n0, srow, sc, 0); g_write<NORM>(lds, ar, br, ssq, srow, sc); __syncthreads();
  int seg = 0;
#pragma unroll 1
  for (int kt = 0; kt < g.KT; ++kt) {
    const int cur = kt & 1;
    if (kt + 1 < g.KT) g_load<AMODE>(g, ar, br, m0, n0, srow, sc, kt + 1);
    { const char* Ab = lds + cur * 49152; const char* Bb = Ab + 32768;
#pragma unroll
      for (int k16 = 0; k16 < 4; ++k16) {
        bf16x8 a[2], b[2];
#pragma unroll
        for (int mt = 0; mt < 2; ++mt) a[mt] = *(const bf16x8*)(Ab + swz(wm * 64 + mt * 32 + r32, k16 * 2 + hi));
#pragma unroll
        for (int nt = 0; nt < 2; ++nt) b[nt] = *(const bf16x8*)(Bb + swz(wn * 64 + nt * 32 + r32, k16 * 2 + hi));
#pragma unroll
        for (int mt = 0; mt < 2; ++mt)
#pragma unroll
          for (int nt = 0; nt < 2; ++nt) {
            if (NORM) acc2[mt][nt] = __builtin_amdgcn_mfma_f32_32x32x16_bf16(a[mt], b[nt], acc2[mt][nt], 0, 0, 0);
            else acc[mt][nt] = __builtin_amdgcn_mfma_f32_32x32x16_bf16(a[mt], b[nt], acc[mt][nt], 0, 0, 0);
          }
      } }
    if (NORM) {
      int se; float inv;
      if (SEG == 1) { se = g.KT; inv = g.inv0; }
      else { se = seg == 0 ? 6 : (seg == 1 ? 12 : 16); inv = seg == 2 ? (1.f / 256.f) : (1.f / 384.f); }
      if (kt + 1 == se) {
#pragma unroll
        for (int i = 0; i < 4; ++i) { float s = ssq[i]; s += __shfl_xor(s, 1); s += __shfl_xor(s, 2); s += __shfl_xor(s, 4); if (sc == 0) rs[srow + 64 * i] = rsqrtf(s * inv + EPS); }
        __syncthreads();
#pragma unroll
        for (int mt = 0; mt < 2; ++mt)
#pragma unroll
          for (int r = 0; r < 16; ++r) { const float f = rs[wm * 64 + mt * 32 + crow(r, hi)];
#pragma unroll
            for (int nt = 0; nt < 2; ++nt) { acc[mt][nt][r] = fmaf(f, acc2[mt][nt][r], acc[mt][nt][r]); acc2[mt][nt][r] = 0.f; } }
        ssq[0] = ssq[1] = ssq[2] = ssq[3] = 0.f;
        ++seg;
      }
    }
    if (kt + 1 < g.KT) g_write<NORM>(lds + (cur ^ 1) * 49152, ar, br, ssq, srow, sc);
    __syncthreads();
  }
  float* C = (float*)lds;
#pragma unroll
  for (int mt = 0; mt < 2; ++mt)
#pragma unroll
    for (int nt = 0; nt < 2; ++nt)
#pragma unroll
      for (int r = 0; r < 16; ++r) C[(wm * 64 + mt * 32 + crow(r, hi)) * CLD + wn * 64 + nt * 32 + r32] = acc[mt][nt][r];
  __syncthreads();
  epi(C, m0, n0);
  __syncthreads();
}

DEVI GemmDesc gemm_desc(const u16* A, int lda, const u16* Bt, int ldb, int K) {
  GemmDesc g{}; g.A = A; g.lda = lda; g.Bt = Bt; g.ldb = ldb; g.KT = K / 64; g.inv0 = 1.f / (float)K; return g;
}

DEVI void ld8(const float* p, float* v) { const f32x4 a = *(const f32x4*)p, b = *(const f32x4*)(p + 4); v[0] = a.x; v[1] = a.y; v[2] = a.z; v[3] = a.w; v[4] = b.x; v[5] = b.y; v[6] = b.z; v[7] = b.w; }

template <int HW> DEVI void rope8(float* v, const float* pp, int i0, float posf) {
  const bool first = i0 < HW; const int f0 = i0 & (HW - 1);
#pragma unroll
  for (int j = 0; j < 8; ++j) { float sn, cs; rope_sc(posf, HW == 32 ? (f0 + j) : 2 * (f0 + j), sn, cs); const float pv = pp[j]; v[j] = first ? v[j] * cs - pv * sn : v[j] * cs + pv * sn; }
}

struct EpiP1 { u16* proj; const int* pos;
  DEVI void operator()(const float* C, int m0, int n0) const {
    const int tid = tidx();
#pragma unroll 1
    for (int it = 0; it < 8; ++it) { const int item = it * NTHREADS + tid, row = item >> 4, c8 = (item & 15) * 8, gcol = n0 + c8, grow = m0 + row;
      float v[8]; ld8(C + row * CLD + c8, v);
      const bool r64 = gcol >= PC_SQ && gcol < PC_SV, r32g = gcol >= PC_KR && gcol < PC_KR + 32;
      if (r64) { const int i0 = gcol & 63; float pp[8]; ld8(C + row * CLD + c8 + (i0 < 32 ? 32 : -32), pp); rope8<32>(v, pp, i0, (float)pos[grow]); }
      else if (r32g) { const int i0 = gcol & 31; float pp[8]; ld8(C + row * CLD + c8 + (i0 < 16 ? 16 : -16), pp); rope8<16>(v, pp, i0, (float)pos[grow]); }
      *(u32x4*)(proj + (size_t)grow * INWP + gcol) = pk8(v);
    }
  }
};

struct EpiQ { u16* qm; const int* pos;
  DEVI void operator()(const float* C, int m0, int n0) const {
    const int tid = tidx();
#pragma unroll 1
    for (int it = 0; it < 8; ++it) { const int item = it * NTHREADS + tid, row = item >> 4, c8 = (item & 15) * 8, gcol = n0 + c8, grow = m0 + row;
      if (gcol >= 576) continue;
      const int head = gcol / 96, j0 = gcol - head * 96, b = grow >> 13, s = grow & (SEQ - 1);
      float v[8]; ld8(C + row * CLD + c8, v);
      if (j0 >= 64) { const int i0 = j0 - 64; float pp[8]; ld8(C + row * CLD + c8 + (i0 < 16 ? 16 : -16), pp); rope8<16>(v, pp, i0, (float)pos[grow]); }
      *(u32x4*)(qm + ((size_t)(b * MLA_H + head) * SEQ + s) * MLA_QK + j0) = pk8(v);
    }
  }
};

struct EpiKV { u16* km; u16* vm; const u16* proj;
  DEVI void operator()(const float* C, int m0, int n0) const {
    const int tid = tidx(), head = n0 >> 7;
#pragma unroll 1
    for (int it = 0; it < 8; ++it) { const int item = it * NTHREADS + tid, row = item >> 4, c8 = (item & 15) * 8, grow = m0 + row;
      const int b = grow >> 13, s = grow & (SEQ - 1);
      float v[8]; ld8(C + row * CLD + c8, v);
      const size_t tok = (size_t)(b * MLA_H + head) * SEQ + s;
      if (c8 < 64) *(u32x4*)(km + tok * MLA_QK + c8) = pk8(v);
      else *(u32x4*)(vm + tok * MLA_V + (c8 - 64)) = pk8(v);
    }
#pragma unroll 1
    for (int it = 0; it < 2; ++it) { const int item = it * NTHREADS + tid, row = item >> 2, c = (item & 3) * 8, grow = m0 + row;
      const int b = grow >> 13, s = grow & (SEQ - 1);
      *(u32x4*)(km + ((size_t)(b * MLA_H + head) * SEQ + s) * MLA_QK + 64 + c) = *(const u32x4*)(proj + (size_t)grow * INWP + PC_KR + c);
    }
  }
};

struct EpiLRU { const u16* proj; const float* cw; const float* cb; const float* ba; const float* bx; const float* lam; u16* le; u16* lb; int n, d;
  DEVI void operator()(const float* C, int m0, int) const {
    const int tid = tidx();
#pragma unroll 1
    for (int it = 0; it < 4; ++it) { const int item = it * NTHREADS + tid, j = item & 63, g8 = item >> 6;
      const int ch = n * 64 + j, grow0 = m0 + g8 * 8, s0 = grow0 & (SEQ - 1), b = grow0 >> 13;
      const float bav = ba[(d * 6 + n) * 64 + j], bxv = bx[(d * 6 + n) * 64 + j];
      const float cdec = -8.f * log1pf(__expf(-lam[d * LRU_W + ch]));
      float xin[11];
#pragma unroll
      for (int q = 0; q < 11; ++q) { const int ss = s0 - 1 + q; xin[q] = (ss >= 0 && ss < SEQ) ? bf2f(proj[(size_t)(grow0 - 1 + q) * INWP + PC_LX + ch]) : 0.f; }
      const float w0 = cw[ch], w1 = cw[LRU_W + ch], w2 = cw[2 * LRU_W + ch], w3 = cw[3 * LRU_W + ch], cbv = cb[ch];
      float ev[8], bv[8];
#pragma unroll
      for (int rr = 0; rr < 8; ++rr) {
        const float xf = cbv + w0 * xin[rr] + w1 * xin[rr + 1] + w2 * xin[rr + 2] + w3 * xin[rr + 3];
        const float r = sigmoidf_(C[(g8 * 8 + rr) * CLD + j] + bav), ig = sigmoidf_(C[(g8 * 8 + rr) * CLD + 64 + j] + bxv);
        const float a = __expf(cdec * r), e = 1.f - a;
        ev[rr] = e; bv[rr] = sqrtf(e * (2.f - e)) * ig * xf;
      }
      const size_t o = (((size_t)(d * NB + b) * (SEQ / 8) + (s0 >> 3)) * LRU_W + ch) * 8;
      *(u32x4*)(le + o) = pk8(ev); *(u32x4*)(lb + o) = pk8(bv);
    }
  }
};

struct EpiP4 { const float* xres; float* xout; u16* xg;
  DEVI void operator()(const float* C, int m0, int n0) const {
    const int tid = tidx();
#pragma unroll 1
    for (int it = 0; it < 8; ++it) { const int item = it * NTHREADS + tid, row = item >> 4, c8 = (item & 15) * 8, gcol = n0 + c8, grow = m0 + row;
      float v[8], x[8]; ld8(C + row * CLD + c8, v); ld8(xres + (size_t)grow * DM + gcol, x);
#pragma unroll
      for (int j = 0; j < 8; ++j) v[j] += x[j];
      *(f32x4*)(xout + (size_t)grow * DM + gcol) = (f32x4){v[0], v[1], v[2], v[3]}; *(f32x4*)(xout + (size_t)grow * DM + gcol + 4) = (f32x4){v[4], v[5], v[6], v[7]};
      *(u32x4*)(xg + (size_t)grow * DM + gcol) = pk8(v);
    }
  }
};

struct EpiBf16 { u16* o; int ldo;
  DEVI void operator()(const float* C, int m0, int n0) const {
    const int tid = tidx();
#pragma unroll 1
    for (int it = 0; it < 8; ++it) { const int item = it * NTHREADS + tid, row = item >> 4, c8 = (item & 15) * 8;
      float v[8]; ld8(C + row * CLD + c8, v);
      *(u32x4*)(o + (size_t)(m0 + row) * ldo + n0 + c8) = pk8(v);
    }
  }
};

DEVI void ce_desc(float& a, float& b) { const float mx = fmaxf(a, b), mn = fminf(a, b); a = mx; b = mn; }
struct EpiTop { float* top; int hj;
  DEVI void operator()(const float* C, int m0, int) const {
    const int tid = tidx(), row = tid >> 1, part = tid & 1;
    float l[16];
#pragma unroll
    for (int i = 0; i < 16; ++i) l[i] = -3.0e38f;
#pragma unroll 4
    for (int c = 0; c < 64; ++c) { const int col = part * 64 + ((c + row) & 63);
      float v = __uint_as_float((__float_as_uint(C[row * CLD + col]) & ~127u) | (unsigned)(127 - col));
#pragma unroll
      for (int i = 0; i < 16; ++i) { const float t = fmaxf(l[i], v); v = fminf(l[i], v); l[i] = t; } }
    float m[16];
#pragma unroll
    for (int i = 0; i < 16; ++i) m[i] = __shfl_xor(l[15 - i], 1);
#pragma unroll
    for (int i = 0; i < 16; ++i) m[i] = fmaxf(m[i], l[i]);
#pragma unroll
    for (int st = 8; st >= 1; st >>= 1)
#pragma unroll
      for (int i = 0; i < 16; ++i) if ((i & st) == 0) ce_desc(m[i], m[i + st]);
    if (part == 0) { float* o = top + ((size_t)(m0 + row) * 16 + hj) * 16;
#pragma unroll
      for (int i = 0; i < 4; ++i) *(f32x4*)(o + 4 * i) = (f32x4){m[4 * i], m[4 * i + 1], m[4 * i + 2], m[4 * i + 3]}; }
  }
};

#define KSWZ(row, colB) ((row) * 256 + ((colB) ^ (((row) & 7) << 4)))
#define SBAR() __builtin_amdgcn_sched_barrier(0)
constexpr int AT_SHM_V = 64 * 64 * 2, AT_SHM_K = 64 * 128 * 2;
constexpr int AT_LDS = 2 * AT_SHM_V + 2 * AT_SHM_K + 8 * 64 * 4;
constexpr float ATT_THR = 8.f;
DEVI unsigned cvtpk(float lo, float hi) { unsigned r; asm volatile("v_cvt_pk_bf16_f32 %0, %1, %2" : "=v"(r) : "v"(lo), "v"(hi)); return r; }
DEVI int v_st(int k, int c) { const int kk = (k & ~0xC) | ((k & 4) << 1) | ((k & 8) >> 1); return ((kk >> 3) * 2 + (c >> 5)) * 512 + ((kk & 7) * 32 + (c & 31)) * 2; }
DEVI int v_rd_base(int lane) { return ((lane & 3) << 3) | (((lane >> 2) & 3) << 6) | (((lane >> 4) & 1) << 5) | (((lane >> 5) & 1) << 8); }
constexpr int v_rd_off(int d0, int ks, int half) { return d0 * 512 + ks * 2048 + half * 1024; }
template <int OFF> DEVI s16x4 tr_read(int vb) { s16x4 r; asm volatile("ds_read_b64_tr_b16 %0, %1 offset:%2" : "=&v"(r) : "v"(vb), "i"(OFF) : "memory"); return r; }

template <bool MASK>
DEVI void partialSM(f32x16& p0, f32x16& p1, float& m_reg, float& mn, float& alpha, float SCALE, int kpos0, int qpos, int hi) {
  const float C = SCALE * 1.4426950408889634f;
  if (MASK) {
#pragma unroll
    for (int r = 0; r < 16; ++r) { const int k0 = kpos0 + crow(r, hi) - qpos; const int k1 = k0 + 32;
      if (k0 > 128 || k0 < -128) p0[r] = -1e30f;
      if (k1 > 128 || k1 < -128) p1[r] = -1e30f; }
  }
  float pmax = p0[0];
#pragma unroll
  for (int r = 1; r < 16; ++r) pmax = fmaxf(pmax, p0[r]);
#pragma unroll
  for (int r = 0; r < 16; ++r) pmax = fmaxf(pmax, p1[r]);
  { auto rr = __builtin_amdgcn_permlane32_swap(__float_as_uint(pmax), __float_as_uint(pmax), false, false);
    pmax = fmaxf(__uint_as_float(rr[0]), __uint_as_float(rr[1])); }
  if (__builtin_expect(__all(pmax - m_reg <= ATT_THR / SCALE), 1)) { mn = m_reg; alpha = 1.f; }
  else { mn = fmaxf(m_reg, pmax); alpha = __builtin_amdgcn_exp2f((m_reg - mn) * C); m_reg = mn; }
  const float mnC = -mn * C;
#pragma unroll
  for (int r = 0; r < 16; ++r) p0[r] = fmaf(p0[r], C, mnC);
#pragma unroll
  for (int r = 0; r < 16; ++r) p1[r] = fmaf(p1[r], C, mnC);
#pragma unroll
  for (int r = 0; r < 16; ++r) p0[r] = __builtin_amdgcn_exp2f(p0[r]);
}
DEVI void finishSM(f32x16& p0, f32x16& p1, float alpha, float& l_reg, bf16x8& pa0, bf16x8& pa1, bf16x8& pa2, bf16x8& pa3) {
#pragma unroll
  for (int r = 0; r < 16; ++r) p1[r] = __builtin_amdgcn_exp2f(p1[r]);
  float ps = 0;
#pragma unroll
  for (int r = 0; r < 16; ++r) ps += p0[r];
#pragma unroll
  for (int r = 0; r < 16; ++r) ps += p1[r];
  { auto rr = __builtin_amdgcn_permlane32_swap(__float_as_uint(ps), __float_as_uint(ps), false, false);
    ps = __uint_as_float(rr[0]) + __uint_as_float(rr[1]); }
  l_reg = l_reg * alpha + ps;
#define PK4(P, BASE, OUT) do { unsigned a0 = cvtpk(P[BASE + 0], P[BASE + 1]), a1 = cvtpk(P[BASE + 2], P[BASE + 3]);   \
    unsigned b0 = cvtpk(P[BASE + 4], P[BASE + 5]), b1 = cvtpk(P[BASE + 6], P[BASE + 7]);                              \
    auto r0 = __builtin_amdgcn_permlane32_swap(a0, b0, false, false); auto r1 = __builtin_amdgcn_permlane32_swap(a1, b1, false, false); \
    u32x4 w = {r0[0], r1[0], r0[1], r1[1]}; OUT = __builtin_bit_cast(bf16x8, w); } while (0)
  PK4(p0, 0, pa0); PK4(p0, 8, pa1); PK4(p1, 0, pa2); PK4(p1, 8, pa3);
#undef PK4
}
template <int ND0>
DEVI void qkt(f32x16& p0, f32x16& p1, const char* Ks, const bf16x8* qr, int r32, int hi) {
  p0 = f32x16{}; p1 = f32x16{};
#pragma unroll
  for (int d0 = 0; d0 < ND0; ++d0) { const int cb = (d0 * 16 + hi * 8) * 2;
    const bf16x8 b0 = *(const bf16x8*)(Ks + KSWZ(r32, cb));
    const bf16x8 b1 = *(const bf16x8*)(Ks + KSWZ(32 + r32, cb));
    p0 = __builtin_amdgcn_mfma_f32_32x32x16_bf16(b0, qr[d0], p0, 0, 0, 0);
    p1 = __builtin_amdgcn_mfma_f32_32x32x16_bf16(b1, qr[d0], p1, 0, 0, 0); }
}
template <int D0> DEVI void pv_one(f32x16& od, int vb, bf16x8 pa0, bf16x8 pa1, bf16x8 pa2, bf16x8 pa3) {
  const s16x4 l0 = tr_read<v_rd_off(D0, 0, 0)>(vb), h0 = tr_read<v_rd_off(D0, 0, 1)>(vb), l1 = tr_read<v_rd_off(D0, 1, 0)>(vb), h1 = tr_read<v_rd_off(D0, 1, 1)>(vb);
  const s16x4 l2 = tr_read<v_rd_off(D0, 2, 0)>(vb), h2 = tr_read<v_rd_off(D0, 2, 1)>(vb), l3 = tr_read<v_rd_off(D0, 3, 0)>(vb), h3 = tr_read<v_rd_off(D0, 3, 1)>(vb);
  asm volatile("s_waitcnt lgkmcnt(0)" ::: "memory"); SBAR();
#define PK(L, H) (bf16x8){L[0], L[1], L[2], L[3], H[0], H[1], H[2], H[3]}
  od = __builtin_amdgcn_mfma_f32_32x32x16_bf16(pa0, PK(l0, h0), od, 0, 0, 0);
  od = __builtin_amdgcn_mfma_f32_32x32x16_bf16(pa1, PK(l1, h1), od, 0, 0, 0);
  od = __builtin_amdgcn_mfma_f32_32x32x16_bf16(pa2, PK(l2, h2), od, 0, 0, 0);
  od = __builtin_amdgcn_mfma_f32_32x32x16_bf16(pa3, PK(l3, h3), od, 0, 0, 0);
#undef PK
}
DEVI void pv_d0(f32x16* o, int vb, bf16x8 pa0, bf16x8 pa1, bf16x8 pa2, bf16x8 pa3) {
  pv_one<0>(o[0], vb, pa0, pa1, pa2, pa3); pv_one<1>(o[1], vb, pa0, pa1, pa2, pa3);
}

template <int DQK, bool MASK>
DEVI void attn_body(const u16* Qw, const u16* Kh, int ldk, const u16* Vh, int ldv, int kt0, int NT, float SCALE, float m_init, float l_init,
                    int qpos, u16* Ow, char* lds) {
  constexpr int ND0 = DQK / 16, NCK = DQK / 8, NK2 = 64 * NCK - NTHREADS;
  const int tid = tidx(), wid = tid >> 6, lane = tid & 63, r32 = lane & 31, hi = lane >> 5;
  char* V_lds = lds; char* K_lds = lds + 2 * AT_SHM_V;
  float* wsx = (float*)(lds + 2 * AT_SHM_V + 2 * AT_SHM_K) + wid * 64; float* li_l = wsx; float* al_l = wsx + 32;
  float m_reg = m_init, l_reg = l_init; f32x16 o[2] = {f32x16{}, f32x16{}}; bf16x8 qr[ND0];
#pragma unroll
  for (int d0 = 0; d0 < ND0; ++d0) qr[d0] = *(const bf16x8*)(Qw + d0 * 16);
  const int vr = tid >> 3, vc = (tid & 7) * 8, vst0 = v_st(vr, vc);
  const int k0r = tid / NCK, k0c = tid - k0r * NCK;
  const int k1id = tid + NTHREADS, k1r = k1id / NCK, k1c = k1id - k1r * NCK; const bool has2 = tid < NK2;
  const int vb0 = (int)(uintptr_t)V_lds + v_rd_base(lane);
  bf16x8 sv[2], sk0[2], sk1[2];
#define SLOAD(i, t_) do { const size_t kk0 = (size_t)(t_) * 64; sv[i] = *(const bf16x8*)(Vh + (kk0 + vr) * ldv + vc); \
    sk0[i] = *(const bf16x8*)(Kh + (kk0 + k0r) * ldk + k0c * 8); if (NK2 > 0) { if (has2) sk1[i] = *(const bf16x8*)(Kh + (kk0 + k1r) * ldk + k1c * 8); } } while (0)
#define SWRITE(b, i) do { *(bf16x8*)(V_lds + (b) * AT_SHM_V + vst0) = sv[i]; *(bf16x8*)(K_lds + (b) * AT_SHM_K + KSWZ(k0r, k0c * 16)) = sk0[i]; \
    if (NK2 > 0) { if (has2) *(bf16x8*)(K_lds + (b) * AT_SHM_K + KSWZ(k1r, k1c * 16)) = sk1[i]; } } while (0)
#define RESC(a) do { if (__any((a) < 1.f)) { if (hi == 0) al_l[r32] = (a); asm volatile("s_waitcnt lgkmcnt(0)" ::: "memory"); \
    _Pragma("unroll") for (int d = 0; d < 2; ++d) _Pragma("unroll") for (int r = 0; r < 16; ++r) o[d][r] *= al_l[crow(r, hi)]; } } while (0)
  f32x16 pA0, pA1, pB0, pB1; float mnA, mnB, alA, alB; bf16x8 pa0, pa1, pa2, pa3;
  constexpr int SE = 0, SO = 1;
  SLOAD(SE, kt0); asm volatile("s_waitcnt vmcnt(0)" ::: "memory"); SWRITE(0, SE); __syncthreads();
  qkt<ND0>(pA0, pA1, K_lds, qr, r32, hi); partialSM<MASK>(pA0, pA1, m_reg, mnA, alA, SCALE, kt0 * 64, qpos, hi);
  SLOAD(SO, kt0 + 1); if (2 < NT) SLOAD(SE, kt0 + 2);
  SWRITE(1, SO); __syncthreads();
  for (int j = 1; j + 1 < NT; j += 2) {
    SBAR(); qkt<ND0>(pB0, pB1, K_lds + AT_SHM_K, qr, r32, hi);
    finishSM(pA0, pA1, alA, l_reg, pa0, pa1, pa2, pa3); SBAR();
    SLOAD(SO, kt0 + j + 2); SBAR();
    pv_d0(o, vb0, pa0, pa1, pa2, pa3); partialSM<MASK>(pB0, pB1, m_reg, mnB, alB, SCALE, (kt0 + j) * 64, qpos, hi);
    __syncthreads(); SWRITE(0, SE);
    RESC(alB); __syncthreads();
    SBAR(); qkt<ND0>(pA0, pA1, K_lds, qr, r32, hi);
    finishSM(pB0, pB1, alB, l_reg, pa0, pa1, pa2, pa3); SBAR();
    if (j + 3 < NT) SLOAD(SE, kt0 + j + 3); SBAR();
    pv_d0(o, vb0 + AT_SHM_V, pa0, pa1, pa2, pa3); partialSM<MASK>(pA0, pA1, m_reg, mnA, alA, SCALE, (kt0 + j + 1) * 64, qpos, hi);
    __syncthreads(); SWRITE(1, SO);
    RESC(alA); __syncthreads();
  }
  SBAR(); qkt<ND0>(pB0, pB1, K_lds + AT_SHM_K, qr, r32, hi);
  finishSM(pA0, pA1, alA, l_reg, pa0, pa1, pa2, pa3); SBAR();
  pv_d0(o, vb0, pa0, pa1, pa2, pa3); partialSM<MASK>(pB0, pB1, m_reg, mnB, alB, SCALE, (kt0 + NT - 1) * 64, qpos, hi);
  __syncthreads(); RESC(alB);
  finishSM(pB0, pB1, alB, l_reg, pa0, pa1, pa2, pa3); SBAR();
  pv_d0(o, vb0 + AT_SHM_V, pa0, pa1, pa2, pa3);
  if (hi == 0) li_l[r32] = l_reg; asm volatile("s_waitcnt lgkmcnt(0)" ::: "memory");
  float rli[16];
#pragma unroll
  for (int r = 0; r < 16; ++r) rli[r] = __builtin_amdgcn_rcpf(li_l[crow(r, hi)]);
#pragma unroll
  for (int r = 0; r < 16; ++r) { const int orow = crow(r, hi);
#pragma unroll
    for (int d0 = 0; d0 < 2; ++d0) Ow[(size_t)orow * DM + d0 * 32 + r32] = f2bf(o[d0][r] * rli[r]); }
  __syncthreads();
#undef SLOAD
#undef SWRITE
#undef RESC
}

constexpr int LCH = 64, NLCH = SEQ / LCH;
constexpr size_t WS_LP = 1 * MiB, WS_LH = 2560 * 1024;
constexpr size_t WS_LC = 473 * MiB;
constexpr size_t WS_NEED = 475 * MiB;
DEVI void lru_passA(const Params& p, int item, int lane) {
  const int cg = item % 6, c = (item / 6) % NLCH, b = (item / (6 * NLCH)) % NB, d = item / (6 * NLCH * NB);
  const size_t base = (((size_t)(d * NB + b) * (SEQ / 8) + c * 8) * LRU_W + cg * 64 + lane) * 8;
  const u16* E = (const u16*)(p.ws + WS_LE) + base; const u16* Bp = (const u16*)(p.ws + WS_LB) + base;
  u32x4 ev[8], bv[8];
#pragma unroll
  for (int g = 0; g < 8; ++g) { ev[g] = *(const u32x4*)(E + (size_t)g * LRU_W * 8); bv[g] = *(const u32x4*)(Bp + (size_t)g * LRU_W * 8); }
  float h = 0.f, P = 1.f;
#pragma unroll
  for (int gg = 0; gg < 8; ++gg) { const int g = d ? 7 - gg : gg; float e[8], bb[8]; unpk8(ev[g], e); unpk8(bv[g], bb);
#pragma unroll
    for (int rr = 0; rr < 8; ++rr) { const int r = d ? 7 - rr : rr; const float a = 1.f - e[r]; h = fmaf(a, h, bb[r]); P *= a; } }
  const size_t o = ((size_t)(d * NB + b) * NLCH + c) * LRU_W + cg * 64 + lane;
  ((float*)(p.ws + WS_LP))[o] = P; ((float*)(p.ws + WS_LH))[o] = h;
}

DEVI void lru_final(const Params& p, int item, char* lds) {
  const int tid = tidx(), wid = tid >> 6, lane = tid & 63;
  const int c = item % NLCH, b = item / NLCH;
  float* obuf = (float*)lds;
  if (wid < 6) {
    const int ch = wid * 64 + lane;
#pragma unroll
    for (int d = 0; d < 2; ++d) {
      const size_t co = ((size_t)(d * NB + b) * NLCH + c) * LRU_W + ch;
      float h = ((const float*)(p.ws + WS_LC))[co];
      const size_t base = (((size_t)(d * NB + b) * (SEQ / 8) + c * 8) * LRU_W + ch) * 8;
      const u16* E = (const u16*)(p.ws + WS_LE) + base; const u16* Bp = (const u16*)(p.ws + WS_LB) + base;
      u32x4 ev[8], bv[8];
#pragma unroll
      for (int g = 0; g < 8; ++g) { ev[g] = *(const u32x4*)(E + (size_t)g * LRU_W * 8); bv[g] = *(const u32x4*)(Bp + (size_t)g * LRU_W * 8); }
      if (d == 0) {
#pragma unroll
        for (int g = 0; g < 8; ++g) { float e[8], bb[8]; unpk8(ev[g], e); unpk8(bv[g], bb);
#pragma unroll
          for (int r = 0; r < 8; ++r) { h = fmaf(1.f - e[r], h, bb[r]); obuf[(g * 8 + r) * LRU_W + ch] = h; } }
      } else {
        const u16* gp = (const u16*)(p.ws + WS_R1) + ((size_t)b * SEQ + c * LCH) * INWP + PC_LG + ch;
#pragma unroll
        for (int g = 7; g >= 0; --g) { float e[8], bb[8]; unpk8(ev[g], e); unpk8(bv[g], bb);
#pragma unroll
          for (int r = 7; r >= 0; --r) { h = fmaf(1.f - e[r], h, bb[r]); const int tk = g * 8 + r;
            const float gt = bf2f(gp[(size_t)tk * INWP]); obuf[tk * LRU_W + ch] = (obuf[tk * LRU_W + ch] + h) * gelu_erf(gt); } }
      }
    }
  }
  __syncthreads();
  u16* mp = (u16*)(p.ws + WS_MIX) + ((size_t)b * SEQ + c * LCH) * DM + 384;
#pragma unroll 1
  for (int i = 0; i < 8; ++i) { const int tk = wid * 8 + i;
    float v[6]; float s = 0.f;
#pragma unroll
    for (int q = 0; q < 3; ++q) { const f32x2 t2 = *(const f32x2*)(obuf + tk * LRU_W + q * 128 + lane * 2); v[2 * q] = t2.x; v[2 * q + 1] = t2.y; s = fmaf(t2.x, t2.x, s); s = fmaf(t2.y, t2.y, s); }
    s = wave_sum(s);
    const float rs = rsqrtf(s * (1.f / 384.f) + EPS);
#pragma unroll
    for (int q = 0; q < 3; ++q) *(unsigned*)(mp + (size_t)tk * DM + q * 128 + lane * 2) = pk2(v[2 * q] * rs, v[2 * q + 1] * rs);
  }
  __syncthreads();
}

DEVI void peer_cand(const Params& p, int vb, int nb, char* lds) {
  const int tid = tidx();
  unsigned char* my = (unsigned char*)lds + tid * 32;
  const float* top = (const float*)(p.ws + WS_TOP);
  int* eidx = (int*)(p.ws + WS_EIDX); float* egate = (float*)(p.ws + WS_EGATE);
  for (int it = vb * NTHREADS + tid; it < T * 8; it += nb * NTHREADS) {
    float v1[16], v2[16];
    const float* tp = top + (size_t)it * 32;
#pragma unroll
    for (int i = 0; i < 4; ++i) { const f32x4 a = *(const f32x4*)(tp + 4 * i), b = *(const f32x4*)(tp + 16 + 4 * i);
      v1[4 * i] = a.x; v1[4 * i + 1] = a.y; v1[4 * i + 2] = a.z; v1[4 * i + 3] = a.w; v2[4 * i] = b.x; v2[4 * i + 1] = b.y; v2[4 * i + 2] = b.z; v2[4 * i + 3] = b.w; }
#pragma unroll
    for (int i = 0; i < 16; ++i) { my[i] = (unsigned char)(127u - (__float_as_uint(v1[i]) & 127u)); my[16 + i] = (unsigned char)(127u - (__float_as_uint(v2[i]) & 127u)); }
    float l[16];
#pragma unroll
    for (int i = 0; i < 16; ++i) l[i] = -3.0e38f;
#pragma unroll
    for (int a = 0; a < 16; ++a)
#pragma unroll
      for (int b = 0; b < 16; ++b) if ((a + 1) * (b + 1) <= 16) {
        float v = __uint_as_float((__float_as_uint(v1[a] + v2[b]) & ~255u) | (unsigned)(255 - (a * 16 + b)));
#pragma unroll
        for (int i = 0; i < 16; ++i) { const float t = fmaxf(l[i], v); v = fminf(l[i], v); l[i] = t; } }
    const float mx = __uint_as_float(__float_as_uint(l[0]) & ~255u);
    float w[16], sum = 0.f;
#pragma unroll
    for (int i = 0; i < 16; ++i) { w[i] = __expf(__uint_as_float(__float_as_uint(l[i]) & ~255u) - mx); sum += w[i]; }
    const float inv = 1.f / sum;
    int ev[16];
#pragma unroll
    for (int i = 0; i < 16; ++i) { const unsigned code = 255u - (__float_as_uint(l[i]) & 255u); ev[i] = (int)my[code >> 4] * 128 + (int)my[16 + (code & 15)]; w[i] *= inv; }
#pragma unroll
    for (int i = 0; i < 4; ++i) { *(int4*)(eidx + (size_t)it * 16 + 4 * i) = make_int4(ev[4 * i], ev[4 * i + 1], ev[4 * i + 2], ev[4 * i + 3]);
      *(f32x4*)(egate + (size_t)it * 16 + 4 * i) = (f32x4){w[4 * i], w[4 * i + 1], w[4 * i + 2], w[4 * i + 3]}; }
  }
}

DEVI float dot2bf(unsigned w, unsigned x, float acc) { return __builtin_amdgcn_fdot2_f32_bf16(__builtin_bit_cast(bf16x2_t, w), __builtin_bit_cast(bf16x2_t, x), acc, false); }
DEVI void peer_token(const Params& p, int layer, int t, const float* xin, float* xout, bool last, char* wl  ) {
  const int lane = tidx() & 63, q = lane >> 4, j = lane & 15;
  int* s_idx = (int*)wl; float* s_gate = (float*)(wl + 512); float* s_c = (float*)(wl + 1024);
  const u16* UB = (const u16*)(p.ws + WS_UB); const u16* VB = (const u16*)(p.ws + WS_VB);
  const float* gf = p.norm_ffn + layer * DM;
  s_idx[lane] = ((const int*)(p.ws + WS_EIDX))[(size_t)t * 128 + lane]; s_idx[64 + lane] = ((const int*)(p.ws + WS_EIDX))[(size_t)t * 128 + 64 + lane];
  s_gate[lane] = ((const float*)(p.ws + WS_EGATE))[(size_t)t * 128 + lane]; s_gate[64 + lane] = ((const float*)(p.ws + WS_EGATE))[(size_t)t * 128 + 64 + lane];
  unsigned xp[32];
  { float xv[64]; float ss = 0.f;
#pragma unroll
    for (int k = 0; k < 8; ++k) { ld8(xin + (size_t)t * DM + (j + 16 * k) * 8, xv + 8 * k);
#pragma unroll
      for (int i = 0; i < 8; ++i) ss = fmaf(xv[8 * k + i], xv[8 * k + i], ss); }
    ss += __shfl_xor(ss, 1); ss += __shfl_xor(ss, 2); ss += __shfl_xor(ss, 4); ss += __shfl_xor(ss, 8);
    const float rsx = rsqrtf(ss * (1.f / DM) + EPS);
#pragma unroll
    for (int k = 0; k < 8; ++k) { float g8[8]; ld8(gf + (j + 16 * k) * 8, g8);
#pragma unroll
      for (int i = 0; i < 4; ++i) xp[4 * k + i] = pk2(xv[8 * k + 2 * i] * rsx * g8[2 * i], xv[8 * k + 2 * i + 1] * rsx * g8[2 * i + 1]); } }
  asm volatile("s_waitcnt lgkmcnt(0)" ::: "memory");
  u32x4 cu[8], nu[8];
  { const u16* r0 = UB + (size_t)s_idx[q] * DM + j * 8;
#pragma unroll
    for (int k = 0; k < 8; ++k) cu[k] = *(const u32x4*)(r0 + 128 * k); }
#pragma unroll 1
  for (int i = 0; i < 32; ++i) {
    if (i + 1 < 32) { const u16* r1 = UB + (size_t)s_idx[4 * (i + 1) + q] * DM + j * 8;
#pragma unroll
      for (int k = 0; k < 8; ++k) nu[k] = *(const u32x4*)(r1 + 128 * k); }
    float a0 = 0.f, a1 = 0.f, a2 = 0.f, a3 = 0.f;
#pragma unroll
    for (int k = 0; k < 8; ++k) { a0 = dot2bf(cu[k].x, xp[4 * k], a0); a1 = dot2bf(cu[k].y, xp[4 * k + 1], a1); a2 = dot2bf(cu[k].z, xp[4 * k + 2], a2); a3 = dot2bf(cu[k].w, xp[4 * k + 3], a3); }
    float dsum = (a0 + a1) + (a2 + a3);
    dsum += __shfl_xor(dsum, 1); dsum += __shfl_xor(dsum, 2); dsum += __shfl_xor(dsum, 4); dsum += __shfl_xor(dsum, 8);
    if (j == 0) s_c[4 * i + q] = gelu_erf(dsum) * s_gate[4 * i + q];
#pragma unroll
    for (int k = 0; k < 8; ++k) cu[k] = nu[k];
  }
  asm volatile("s_waitcnt lgkmcnt(0)" ::: "memory");
  float y[64];
#pragma unroll
  for (int i = 0; i < 64; ++i) y[i] = 0.f;
  { const u16* r0 = VB + (size_t)s_idx[q] * DM + j * 8;
#pragma unroll
    for (int k = 0; k < 8; ++k) cu[k] = *(const u32x4*)(r0 + 128 * k); }
#pragma unroll 1
  for (int i = 0; i < 32; ++i) {
    if (i + 1 < 32) { const u16* r1 = VB + (size_t)s_idx[4 * (i + 1) + q] * DM + j * 8;
#pragma unroll
      for (int k = 0; k < 8; ++k) nu[k] = *(const u32x4*)(r1 + 128 * k); }
    const float c = s_c[4 * i + q];
#pragma unroll
    for (int k = 0; k < 8; ++k) { float v[8]; unpk8(cu[k], v);
#pragma unroll
      for (int e = 0; e < 8; ++e) y[8 * k + e] = fmaf(c, v[e], y[8 * k + e]); }
#pragma unroll
    for (int k = 0; k < 8; ++k) cu[k] = nu[k];
  }
#pragma unroll
  for (int i = 0; i < 64; ++i) { y[i] += __shfl_xor(y[i], 16); y[i] += __shfl_xor(y[i], 32); }
  float ss2 = 0.f;
#pragma unroll
  for (int k = 0; k < 8; ++k) { float xv[8]; ld8(xin + (size_t)t * DM + (j + 16 * k) * 8, xv);
#pragma unroll
    for (int e = 0; e < 8; ++e) { y[8 * k + e] += xv[e]; ss2 = fmaf(y[8 * k + e], y[8 * k + e], ss2); } }
  ss2 += __shfl_xor(ss2, 1); ss2 += __shfl_xor(ss2, 2); ss2 += __shfl_xor(ss2, 4); ss2 += __shfl_xor(ss2, 8);
  const float rs2 = rsqrtf(ss2 * (1.f / DM) + EPS);
  u16* xg = (u16*)(p.ws + WS_XG);
#pragma unroll
  for (int k = 0; k < 8; ++k) if ((k >> 1) == q) {
    const int col = (j + 16 * k) * 8;
    if (last) { float g8[8]; ld8(p.norm_final + col, g8); float ov[8];
#pragma unroll
      for (int e = 0; e < 8; ++e) ov[e] = y[8 * k + e] * rs2 * g8[e];
      *(f32x4*)(xout + (size_t)t * DM + col) = (f32x4){ov[0], ov[1], ov[2], ov[3]}; *(f32x4*)(xout + (size_t)t * DM + col + 4) = (f32x4){ov[4], ov[5], ov[6], ov[7]}; }
    else { *(f32x4*)(xout + (size_t)t * DM + col) = (f32x4){y[8 * k], y[8 * k + 1], y[8 * k + 2], y[8 * k + 3]};
      *(f32x4*)(xout + (size_t)t * DM + col + 4) = (f32x4){y[8 * k + 4], y[8 * k + 5], y[8 * k + 6], y[8 * k + 7]};
      *(u32x4*)(xg + (size_t)t * DM + col) = pk8(&y[8 * k]); }
  }
}

DEVI void lru_passB(const Params& p, int item, int lane) {
  const int cg = item % 6, b = (item / 6) % NB, d = item / (6 * NB);
  const size_t o = (size_t)(d * NB + b) * NLCH * LRU_W + cg * 64 + lane;
  const float* Pp = (const float*)(p.ws + WS_LP) + o; const float* Hp = (const float*)(p.ws + WS_LH) + o; float* Cp = (float*)(p.ws + WS_LC) + o;
  float h = 0.f;
#pragma unroll 1
  for (int c0 = 0; c0 < NLCH; c0 += 32) {
    float pv[32], hv[32];
#pragma unroll
    for (int i = 0; i < 32; ++i) { const int cc = d ? NLCH - 1 - (c0 + i) : c0 + i; pv[i] = Pp[(size_t)cc * LRU_W]; hv[i] = Hp[(size_t)cc * LRU_W]; }
#pragma unroll
    for (int i = 0; i < 32; ++i) { const int cc = d ? NLCH - 1 - (c0 + i) : c0 + i; Cp[(size_t)cc * LRU_W] = h; h = fmaf(pv[i], h, hv[i]); }
  }
}

DEVI void swa_item(const Params& p, int layer, int item, char* lds) {
  const int tid = tidx(), wid = tid >> 6, lane = tid & 63, r32 = lane & 31, hi = lane >> 5;
  const int g = item & 1, n = (item >> 1) & 63, b = item >> 7;
  const int hq = 2 * g + (wid >> 2), qrow = n * 128 + (wid & 3) * 32;
  const u16* proj = (const u16*)(p.ws + WS_R1);
  const u16* Qw = proj + (size_t)(b * SEQ + qrow + r32) * INWP + PC_SQ + hq * 64 + hi * 8;
  const u16* Kh = proj + (size_t)(b * SEQ) * INWP + PC_SK + g * 64;
  const u16* Vh = proj + (size_t)(b * SEQ) * INWP + PC_SV + g * 64;
  const int kt0 = (2 * n - 2) < 0 ? 0 : (2 * n - 2), kt1 = (2 * n + 4) > SEQ / 64 ? SEQ / 64 : (2 * n + 4);
  const float sink = p.swa_sink[layer * 4 + hq];
  u16* Ow = (u16*)(p.ws + WS_MIX) + (size_t)(b * SEQ + qrow) * DM + 768 + hq * 64;
  attn_body<64, true>(Qw, Kh, INWP, Vh, INWP, kt0, kt1 - kt0, 0.125f, sink * 8.f, 1.f, qrow + r32, Ow, lds);
}
DEVI void mla_item(const Params& p, int pair, int qb, char* lds) {
  const int tid = tidx(), wid = tid >> 6, lane = tid & 63, r32 = lane & 31, hi = lane >> 5;
  const int b = pair / MLA_H, h = pair - b * MLA_H;
  const u16* Qw = (const u16*)(p.ws + WS_QM) + ((size_t)pair * SEQ + qb * 256 + wid * 32 + r32) * MLA_QK + hi * 8;
  const u16* Kh = (const u16*)(p.ws + WS_KM) + (size_t)pair * SEQ * MLA_QK;
  const u16* Vh = (const u16*)(p.ws + WS_VM) + (size_t)pair * SEQ * MLA_V;
  u16* Ow = (u16*)(p.ws + WS_MIX) + (size_t)(b * SEQ + qb * 256 + wid * 32) * DM + h * 64;
  attn_body<96, false>(Qw, Kh, MLA_QK, Vh, MLA_V, 0, SEQ / 64, 0.10206207261596575f, -1e30f, 0.f, 0, Ow, lds);
}

constexpr int PH_PER_LAYER = 10, N_PHASES = 1 + DEPTH * PH_PER_LAYER;
DEVI void run_phase(const Params& pin, int ph, int vb, int nb, char* lds) {
  const bool dry = ph >= 100; if (dry) ph -= 100;
  Params p = pin; asm volatile("" : "+s"(p.ws)); asm volatile("" : "+s"(p.out)); asm volatile("" : "+s"(vb));
  const int tid = tidx(), wid = tid >> 6, lane = tid & 63;
#ifdef ONLY_SP
  if (ONLY_SP >= 0 && ph == 0) return;
#endif
  if (ph == 0) { phase0(p, vb, nb, lds); return; }
  const int l = (ph - 1) / PH_PER_LAYER, sp = (ph - 1) % PH_PER_LAYER;
  u16* const XG = (u16*)(p.ws + WS_XG); u16* const PROJ = (u16*)(p.ws + WS_R1); u16* const MIX = (u16*)(p.ws + WS_MIX);
  constexpr int NMT = T / 256;
#ifdef ONLY_SP
  if (sp != ONLY_SP) return;
#endif
  switch (sp) {
  case 0: {
    GemmDesc g = gemm_desc(XG, DM, (const u16*)(p.ws + WS_WIN) + (size_t)l * INWP * DM, DM, DM);
    EpiP1 e{PROJ, p.pos};
    for (int it = vb; it < NMT * 14; it += nb) gemm_tile<0, 1>(g, (it / 14) * 256, (it % 14) * 128, lds, e);
  } break;
  case 1: {
    constexpr int N_C = NMT * 12, N_A = NMT * 5, N_B = NMT * 6;
    for (int it = vb; it < N_C + N_A + N_B; it += nb) {
      if (it < N_C) { const int mt = it / 12, nd = it % 12, n = nd >> 1, d = nd & 1;
        GemmDesc g{}; g.Bt = (const u16*)(p.ws + WS_WLRU) + (size_t)((l * 6 + n) * 2 + d) * 128 * 64; g.ldb = 64; g.KT = 1;
        g.proj = PROJ; g.cw = p.conv_w + l * 4 * LRU_W; g.cb = p.conv_b + l * LRU_W; g.ch0 = n * 64;
        EpiLRU e{PROJ, g.cw, g.cb, p.lru_ba + l * 2 * 384, p.lru_bx + l * 2 * 384, p.lru_lambda + l * 2 * 384, (u16*)(p.ws + WS_LE), (u16*)(p.ws + WS_LB), n, d};
        gemm_tile<1, 0>(g, mt * 256, 0, lds, e);
      } else if (it < N_C + N_A) { const int i2 = it - N_C;
        GemmDesc g = gemm_desc(PROJ + PC_CQ, INWP, (const u16*)(p.ws + WS_WUQ) + (size_t)l * 640 * 256, 256, 256);
        EpiQ e{(u16*)(p.ws + WS_QM), p.pos};
        gemm_tile<0, 1>(g, (i2 / 5) * 256, (i2 % 5) * 128, lds, e);
      } else { const int i2 = it - N_C - N_A;
        GemmDesc g = gemm_desc(PROJ + PC_CKV, INWP, (const u16*)(p.ws + WS_WUKV) + (size_t)l * 768 * 128, 128, 128);
        EpiKV e{(u16*)(p.ws + WS_KM), (u16*)(p.ws + WS_VM), PROJ};
        gemm_tile<0, 1>(g, (i2 / 6) * 256, (i2 % 6) * 128, lds, e);
      }
    }
  } break;
  case 2: {
    for (int it = vb * 8 + wid; it < 2 * NB * NLCH * 6; it += nb * 8) lru_passA(p, it, lane);
  } break;
  case 3: {
    const int wi = vb * 8 + wid;
    if (wi < 48) lru_passB(p, wi, lane);
    __syncthreads();
    for (int it = vb; it < NB * 64 * 2; it += nb) swa_item(p, l, it, lds);
  } break;
  case 4: {
    for (int k = 0; k * nb + vb < NB * MLA_H * 32; ++k) {
      int pair, qb;
      if (nb == 256) { pair = k * 8 + (vb & 7); qb = vb >> 3; } else { const int it = k * nb + vb; pair = it >> 5; qb = it & 31; }
      mla_item(p, pair, qb, lds);
    }
#ifndef NO_LRUF
    for (int it = vb; it < NB * NLCH; it += nb) lru_final(p, it, lds);
#endif
  } break;
  case 5: {
    GemmDesc g = gemm_desc(MIX, DM, (const u16*)(p.ws + WS_WOUT) + (size_t)l * DM * DM, DM, DM);
    EpiP4 e{l == 0 ? p.x : p.out, dry ? (float*)(p.ws + 89 * MiB) : p.out, dry ? (u16*)(p.ws + 25 * MiB + 0) : XG};
    for (int it = vb; it < NMT * 8; it += nb) gemm_tile<0, 2>(g, (it / 8) * 256, (it % 8) * 128, lds, e);
    const float* us = p.peer_u + (size_t)l * NEXP * DM; const float* vs = p.peer_v + (size_t)l * NEXP * DM;
    u16* ub = (u16*)(p.ws + WS_UB); u16* vbf = (u16*)(p.ws + WS_VB);
    for (size_t i = (size_t)vb * NTHREADS + tid; i < (size_t)NEXP * DM / 8; i += (size_t)nb * NTHREADS) {
      float a[8], b[8]; ld8(us + i * 8, a); ld8(vs + i * 8, b);
      *(u32x4*)(ub + i * 8) = pk8(a); *(u32x4*)(vbf + i * 8) = pk8(b); }
  } break;
  case 6: {
    GemmDesc g = gemm_desc(XG, DM, (const u16*)(p.ws + WS_WQ) + (size_t)l * 2048 * DM, DM, DM);
    EpiBf16 e{PROJ, 2048};
    for (int it = vb; it < NMT * 16; it += nb) gemm_tile<0, 1>(g, (it / 16) * 256, (it % 16) * 128, lds, e);
  } break;
  case 7: {
    for (int it = vb; it < NMT * 16; it += nb) { const int mt = it / 16, hj = it % 16, j = hj & 1;
      GemmDesc g{}; g.A = PROJ + hj * 128; g.lda = 2048; g.Bt = (const u16*)(p.ws + WS_SUBK) + (size_t)(l * 2 + j) * 128 * 128; g.ldb = 128; g.KT = 2;
      EpiTop e{(float*)(p.ws + WS_TOP), hj};
      gemm_tile<0, 0>(g, mt * 256, 0, lds, e); }
  } break;
  case 8: peer_cand(p, vb, nb, lds); break;
  case 9: {
    char* wl = lds + wid * 2048;
    float* xo = dry ? (float*)(p.ws + 345 * MiB) : p.out;
    for (int t = vb * 8 + wid; t < T; t += nb * 8) peer_token(p, l, t, p.out, xo, l == DEPTH - 1, wl);
  } break;
  }
}


#define XB_TMO      128
#define XB_XCNT(j)  (256  + 64 * (j))
#define XB_XSUB(j)  (1280 + 64 * (j))
#define XB_XGEN(j)  (2304 + 64 * (j))
#define XB_TOP      3328
#define XB_TOPGEN   3392
#define XCD_BAR_WORDS 3456
#define XB_SPIN_CAP (1u << 23)
DEVI unsigned xb_ld(unsigned* p) { return __hip_atomic_load(p, __ATOMIC_RELAXED, __HIP_MEMORY_SCOPE_AGENT); }
DEVI unsigned xb_add(unsigned* p, unsigned v) { return __hip_atomic_fetch_add(p, v, __ATOMIC_RELAXED, __HIP_MEMORY_SCOPE_AGENT); }
DEVI unsigned xb_xcc_id() { return (unsigned)__builtin_amdgcn_s_getreg((3 << 11) | 20) & 0xFu; }
#define XB_SPIN(cond, bar) do { unsigned _sp = 0; while (cond) { __builtin_amdgcn_s_sleep(1); \
    if ((++_sp & 255u) == 0u) { if (xb_ld(&(bar)[XB_TMO])) break; if (_sp > XB_SPIN_CAP) { atomicAdd(&(bar)[XB_TMO], 1u); break; } } } } while (0)
struct XcdBarrier { unsigned* bar; unsigned x; volatile unsigned* st; };
DEVI XcdBarrier xcd_barrier_post(unsigned* bar, volatile unsigned* st) {
  XcdBarrier b; b.bar = bar; b.x = xb_xcc_id(); b.st = st;
  if (threadIdx.x == 0) (void)xb_add(&bar[XB_XCNT(b.x)], 1u);
  return b;
}
DEVI void xcd_barrier_complete(unsigned* bar, unsigned x, unsigned& nloc, unsigned& nx) {
  const unsigned G = gridDim.x * gridDim.y * gridDim.z;
  unsigned sum, cnt, mine, sp = 0u;
  for (;;) {
    sum = 0u; cnt = 0u; mine = 0u;
#pragma unroll
    for (unsigned j = 0; j < 16; ++j) { const unsigned c = xb_ld(&bar[XB_XCNT(j)]); sum += c; cnt += (c > 0u) ? 1u : 0u; mine = (j == x) ? c : mine; }
    if (sum == G) break;
    __builtin_amdgcn_s_sleep(1);
    if ((++sp & 255u) == 0u) { if (xb_ld(&bar[XB_TMO])) break; if (sp > XB_SPIN_CAP) { atomicAdd(&bar[XB_TMO], 1u); break; } }
  }
  nloc = mine > 0u ? mine : 1u; nx = cnt > 0u ? cnt : 1u;
}
DEVI void xcd_barrier(const XcdBarrier& b) {
  asm volatile("s_waitcnt vmcnt(0)" ::: "memory");
  __syncthreads();
  if (threadIdx.x == 0) {
    unsigned* bar = b.bar;
    __builtin_amdgcn_s_waitcnt(0);
    unsigned nloc = b.st[0], nx = b.st[1];
    if (nloc == 0u) { xcd_barrier_complete(bar, b.x, nloc, nx); b.st[0] = nloc; b.st[1] = nx; }
    const unsigned old = xb_add(&bar[XB_XSUB(b.x)], 1u);
    const unsigned gen = old / nloc;
    if (old + 1u == (gen + 1u) * nloc) {
      __builtin_amdgcn_fence(__ATOMIC_RELEASE, "agent");
      asm volatile("s_waitcnt vmcnt(0)" ::: "memory");
      const unsigned og = xb_add(&bar[XB_TOP], 1u);
      const unsigned tg = og / nx;
      if (og + 1u == (tg + 1u) * nx) xb_add(&bar[XB_TOPGEN], 1u);
      else XB_SPIN(xb_ld(&bar[XB_TOPGEN]) == tg, bar);
      __builtin_amdgcn_fence(__ATOMIC_ACQUIRE, "agent");
      xb_add(&bar[XB_XGEN(b.x)], 1u);
      asm volatile("s_waitcnt vmcnt(0)" ::: "memory");
    } else {
      XB_SPIN(xb_ld(&bar[XB_XGEN(b.x)]) == gen, bar);
      __builtin_amdgcn_fence(__ATOMIC_ACQUIRE, "agent");
      asm volatile("s_waitcnt vmcnt(0)" ::: "memory");
    }
  }
  __syncthreads();
}

__global__ void __launch_bounds__(NTHREADS, 2) mega(Params p) {
  extern __shared__ __attribute__((aligned(16))) char smem[];
  cg::grid_group grid = cg::this_grid();
  const int nb = gridDim.x, vb = blockIdx.x;
  volatile unsigned* st = (volatile unsigned*)(smem + LDS_BYTES - 16);
  if (threadIdx.x == 0) { st[0] = 0u; st[1] = 0u; }
  __syncthreads();
  const XcdBarrier bar = xcd_barrier_post((unsigned*)p.ws, st);
#define GRID_BAR(first) do { if (first) grid.sync(); else xcd_barrier(bar); } while (0)
  for (int ph = p.ph_lo; ph < p.ph_hi; ++ph) {
#ifdef PROBE_DUP
    if (ph > 0 && ((PROBE_DUP >> ((ph - 1) % PH_PER_LAYER)) & 1)) { run_phase(p, ph + 100, vb, nb, smem); GRID_BAR(false); }
#endif
    run_phase(p, ph, vb, nb, smem);
    if (ph + 1 < p.ph_hi) GRID_BAR(ph == p.ph_lo);
  }
}

#ifndef N_LAUNCH_SPLIT
#define N_LAUNCH_SPLIT 0
#endif
extern "C" void kernel_launch(void* const* d_in, const int* in_sizes, int n_in, void* d_out, int out_size, void* d_ws, size_t ws_size, hipStream_t stream) {
  static int grid_blocks = 0;
  if (grid_blocks == 0) {
    if (n_in != 24 || out_size != T * DM || ws_size < WS_NEED) { fprintf(stderr, "kernel_launch: unexpected shapes n_in %d out %d ws %zu\n", n_in, out_size, ws_size); grid_blocks = -1; return; }
    int dev = 0, cus = 0, per_cu = 0;
    (void)hipGetDevice(&dev); (void)hipDeviceGetAttribute(&cus, hipDeviceAttributeMultiprocessorCount, dev);
    if (hipFuncSetAttribute((const void*)mega, hipFuncAttributeMaxDynamicSharedMemorySize, LDS_BYTES) != hipSuccess) { fprintf(stderr, "kernel_launch: hipFuncSetAttribute failed\n"); grid_blocks = -1; return; }
    if (hipOccupancyMaxActiveBlocksPerMultiprocessor(&per_cu, (const void*)mega, NTHREADS, LDS_BYTES) != hipSuccess || per_cu < 1) { fprintf(stderr, "kernel_launch: occupancy query failed (%d)\n", per_cu); grid_blocks = -1; return; }
    grid_blocks = cus * 1;
    fprintf(stderr, "kernel_launch: cus %d per_cu %d grid %d\n", cus, per_cu, grid_blocks);
  }
  if (grid_blocks < 0) return;
  if (hipMemsetAsync(d_ws, 0, 65536, stream) != hipSuccess) { fprintf(stderr, "kernel_launch: memset failed\n"); return; }
  Params p{};
  p.x = (const float*)d_in[0]; p.pos = (const int*)d_in[1]; p.norm_mix = (const float*)d_in[2]; p.w_in = (const float*)d_in[3]; p.q_norm = (const float*)d_in[4];
  p.w_uq = (const float*)d_in[5]; p.kv_norm = (const float*)d_in[6]; p.w_ukv = (const float*)d_in[7]; p.conv_w = (const float*)d_in[8]; p.conv_b = (const float*)d_in[9];
  p.lru_wa = (const float*)d_in[10]; p.lru_ba = (const float*)d_in[11]; p.lru_wx = (const float*)d_in[12]; p.lru_bx = (const float*)d_in[13]; p.lru_lambda = (const float*)d_in[14];
  p.swa_sink = (const float*)d_in[15]; p.grp_norm = (const float*)d_in[16]; p.w_out = (const float*)d_in[17]; p.norm_ffn = (const float*)d_in[18]; p.peer_wq = (const float*)d_in[19];
  p.peer_subkeys = (const float*)d_in[20]; p.peer_u = (const float*)d_in[21]; p.peer_v = (const float*)d_in[22]; p.norm_final = (const float*)d_in[23];
  p.out = (float*)d_out; p.ws = (unsigned char*)d_ws;
#if N_LAUNCH_SPLIT
  for (int ph = 0; ph < N_PHASES; ++ph) {
    p.ph_lo = ph; p.ph_hi = ph + 1;
    void* args[] = {&p};
    hipError_t e = hipLaunchCooperativeKernel((const void*)mega, dim3(grid_blocks), dim3(NTHREADS), args, LDS_BYTES, stream);
    if (e != hipSuccess) { fprintf(stderr, "kernel_launch: launch of phase %d failed: %s\n", ph, hipGetErrorString(e)); break; }
  }
#else
  p.ph_lo = 0; p.ph_hi = N_PHASES;
  void* args[] = {&p};
  hipError_t e = hipLaunchCooperativeKernel((const void*)mega, dim3(grid_blocks), dim3(NTHREADS), args, LDS_BYTES, stream);
  if (e != hipSuccess) fprintf(stderr, "kernel_launch: cooperative launch failed: %s (grid %d)\n", hipGetErrorString(e), grid_blocks);
#endif
}
```

```cpp
#include <hip/hip_runtime.h>
#include <hip/hip_cooperative_groups.h>
#include <cstdio>
#include <cstdint>
namespace cg = cooperative_groups;

#define DEVI __device__ __forceinline__
typedef unsigned short u16;
typedef short bf16x8 __attribute__((ext_vector_type(8)));
typedef short s16x4 __attribute__((ext_vector_type(4)));
typedef float f32x2 __attribute__((ext_vector_type(2)));
typedef float f32x4 __attribute__((ext_vector_type(4)));
typedef float f32x16 __attribute__((ext_vector_type(16)));
typedef unsigned u32x4 __attribute__((ext_vector_type(4)));
typedef unsigned u32x2 __attribute__((ext_vector_type(2)));
typedef __bf16 bf16x2_t __attribute__((ext_vector_type(2)));

constexpr int NB = 4, SEQ = 8192, T = NB * SEQ, DM = 1024, DEPTH = 2;
constexpr int MLA_H = 6, MLA_QK = 96, MLA_V = 64;
constexpr int LRU_W = 384;
constexpr int INW = 1696, INWP = 1792;
constexpr int PC_CQ = 0, PC_CKV = 256, PC_SQ = 384, PC_SK = 640, PC_SV = 768, PC_LX = 896, PC_LG = 1280, PC_KR = 1664;
constexpr int OC_CQ = 0, OC_CKV = 256, OC_KR = 384, OC_SQ = 416, OC_SK = 672, OC_SV = 800, OC_LX = 928, OC_LG = 1312;
constexpr int NEXP = 16384;
constexpr float EPS = 1e-6f;
constexpr int NTHREADS = 512;
constexpr int LDS_BYTES = 160 * 1024;

constexpr size_t MiB = 1u << 20;
constexpr size_t WS_CTL = 0;
constexpr size_t WS_WIN = 4 * MiB;
constexpr size_t WS_WQ = 11 * MiB;
constexpr size_t WS_WOUT = 19 * MiB;
constexpr size_t WS_WUQ = 23 * MiB;
constexpr size_t WS_WUKV = WS_WUQ + 2 * 640 * 256 * 2;
constexpr size_t WS_WLRU = WS_WUKV + 2 * 768 * 128 * 2;
constexpr size_t WS_SUBK = WS_WLRU + 2 * 6 * 2 * 128 * 64 * 2;
constexpr size_t WS_XG = 25 * MiB;
constexpr size_t WS_R1 = 89 * MiB;
constexpr size_t WS_QM = 217 * MiB;
constexpr size_t WS_KM = 253 * MiB;
constexpr size_t WS_VM = 289 * MiB;
constexpr size_t WS_LE = 313 * MiB;
constexpr size_t WS_LB = 361 * MiB;
constexpr size_t WS_MIX = 409 * MiB;
constexpr size_t WS_UB = 217 * MiB;
constexpr size_t WS_VB = 233 * MiB;
constexpr size_t WS_TOP = 281 * MiB;
constexpr size_t WS_EIDX = 313 * MiB;
constexpr size_t WS_EGATE = 329 * MiB;
constexpr size_t WS_CC = 345 * MiB;
constexpr size_t WS_SSQ = 361 * MiB;
constexpr size_t WS_PD = 89 * MiB;
constexpr float PEER_SU = 256.f, PEER_SV = 16.f;
constexpr size_t WS_END = 473 * MiB;

__device__ const float ROPE_HI[32] = {1.591549367e-01f, 1.193493679e-01f, 8.949939907e-02f, 6.711508334e-02f, 5.032921210e-02f, 3.774158657e-02f, 2.830219641e-02f, 2.122365311e-02f, 1.591549441e-02f, 1.193493698e-02f, 8.949940093e-03f, 6.711508147e-03f, 5.032921210e-03f, 3.774158424e-03f, 2.830219688e-03f, 2.122365171e-03f, 1.591549488e-03f, 1.193493721e-03f, 8.949940093e-04f, 6.711508031e-04f, 5.032921326e-04f, 3.774158540e-04f, 2.830219455e-04f, 2.122365258e-04f, 1.591549371e-04f, 1.193493736e-04f, 8.949940093e-05f, 6.711508468e-05f, 5.032921035e-05f, 3.774158540e-05f, 2.830219637e-05f, 2.122365186e-05f};
__device__ const float ROPE_LO[32] = {6.420638243e-09f, 2.294664903e-09f, 2.542919653e-09f, -3.316028840e-10f, 5.173299289e-12f, -1.848551645e-09f, -5.826552019e-10f, -3.431038786e-10f, -1.029942243e-10f, 4.320196978e-11f, 6.802744479e-11f, 1.531042237e-10f, 5.173301024e-13f, 4.797548470e-11f, -1.048316434e-10f, 1.053879969e-10f, -5.686555046e-11f, -1.896286773e-11f, 6.802744999e-12f, 2.695195456e-11f, -1.158979943e-11f, -6.843983713e-12f, 1.279990003e-11f, 1.807650600e-12f, 5.954976963e-12f, -3.351478166e-12f, 6.802744674e-13f, -1.670379113e-12f, 1.751403167e-12f, -6.843983930e-13f, -5.389994549e-13f, 9.083608431e-13f};

DEVI int tidx() { int t = __builtin_amdgcn_workitem_id_x(); asm volatile("" : "+v"(t)); return t; }
DEVI float bf2f(unsigned h) { return __uint_as_float(h << 16); }
DEVI float bflo(unsigned w) { return __uint_as_float(w << 16); }
DEVI float bfhi(unsigned w) { return __uint_as_float(w & 0xffff0000u); }
DEVI unsigned pk2(float lo, float hi) { f32x2 v = {lo, hi}; bf16x2_t b = __builtin_convertvector(v, bf16x2_t); return __builtin_bit_cast(unsigned, b); }
DEVI u16 f2bf(float f) { return (u16)(pk2(f, 0.f) & 0xffffu); }
DEVI u32x4 pk8(const float* v) { u32x4 w; w.x = pk2(v[0], v[1]); w.y = pk2(v[2], v[3]); w.z = pk2(v[4], v[5]); w.w = pk2(v[6], v[7]); return w; }
DEVI void unpk8(u32x4 w, float* v) { v[0] = bflo(w.x); v[1] = bfhi(w.x); v[2] = bflo(w.y); v[3] = bfhi(w.y); v[4] = bflo(w.z); v[5] = bfhi(w.z); v[6] = bflo(w.w); v[7] = bfhi(w.w); }
DEVI int crow(int r, int hi) { return (r & 3) + 8 * (r >> 2) + 4 * hi; }
DEVI float wave_sum(float v) {
#pragma unroll
  for (int o = 1; o < 64; o <<= 1) v += __shfl_xor(v, o);
  return v;
}
DEVI void rope_sc(float pos, int fidx, float& sn, float& cs) {
  const float chi = ROPE_HI[fidx], clo = ROPE_LO[fidx];
  const float t = pos * chi, e = fmaf(pos, chi, -t);
  float fr = t - rintf(t);
  fr = fr + (e + pos * clo);
  sn = __builtin_amdgcn_sinf(fr); cs = __builtin_amdgcn_cosf(fr);
}
DEVI float sigmoidf_(float x) { return 1.f / (1.f + __expf(-x)); }
DEVI float gelu_erf(float x) { return 0.5f * x * (1.f + erff(x * 0.70710678118654752f)); }

struct Params {
  const float* x; const int* pos; const float* norm_mix; const float* w_in; const float* q_norm; const float* w_uq; const float* kv_norm; const float* w_ukv;
  const float* conv_w; const float* conv_b; const float* lru_wa; const float* lru_ba; const float* lru_wx; const float* lru_bx; const float* lru_lambda;
  const float* swa_sink; const float* grp_norm; const float* w_out; const float* norm_ffn; const float* peer_wq; const float* peer_subkeys;
  const float* peer_u; const float* peer_v; const float* norm_final;
  float* out; unsigned char* ws;
  int ph_lo, ph_hi;
};

DEVI void tconv_item(const float* W, int ldw, int src_c0, u16* WT, int K, int dst_r0, const float* gain, float* scr, int kb, int nb, int lane) {
  const int k0 = 64 * kb, n0 = 32 * nb;
#pragma unroll 8
  for (int i = 0; i < 32; ++i) { const int kk = 2 * i + (lane >> 5); float g = gain ? gain[k0 + kk] : 1.f; scr[kk * 33 + (lane & 31)] = g * W[(size_t)(k0 + kk) * ldw + src_c0 + n0 + (lane & 31)]; }
  __builtin_amdgcn_s_waitcnt(0xc07f); asm volatile("" ::: "memory");
  const int c = lane & 7;
#pragma unroll
  for (int j = 0; j < 4; ++j) { const int n = (lane >> 3) + 8 * j; const float* s = scr + (8 * c) * 33 + n;
    u32x4 o; o.x = pk2(s[0 * 33], s[1 * 33]); o.y = pk2(s[2 * 33], s[3 * 33]); o.z = pk2(s[4 * 33], s[5 * 33]); o.w = pk2(s[6 * 33], s[7 * 33]);
    *(u32x4*)(WT + (size_t)(dst_r0 + n0 + n) * K + k0 + 8 * c) = o; }
  __builtin_amdgcn_s_waitcnt(0xc07f); asm volatile("" ::: "memory");
}

DEVI void tseg(const float* W, int ldw, int src_c0, int ncols, u16* WT, int K, int dst_r0, const float* gain, float* scr, int gw, int ngw, int lane) {
  const int nkb = K / 64, nnb = ncols / 32, ni = nkb * nnb;
  for (int it = gw; it < ni; it += ngw) tconv_item(W, ldw, src_c0, WT, K, dst_r0, gain, scr, it / nnb, it % nnb, lane);
}

DEVI void phase0(const Params& p, int vb, int nb, char* lds) {
  const int tid = tidx(), lane = tid & 63, wid = tid >> 6;
  float* scr = (float*)(lds + wid * 16384);
  const int gw = vb * 8 + wid, ngw = nb * 8;
#pragma unroll 1
  for (int l = 0; l < DEPTH; ++l) {
    const float* win = p.w_in + (size_t)l * DM * INW; u16* wint = (u16*)(p.ws + WS_WIN) + (size_t)l * INWP * DM; const float* gm = p.norm_mix + l * DM;
    tseg(win, INW, OC_CQ, 256, wint, DM, PC_CQ, gm, scr, gw, ngw, lane);
    tseg(win, INW, OC_CKV, 128, wint, DM, PC_CKV, gm, scr, gw, ngw, lane);
    tseg(win, INW, OC_SQ, 256, wint, DM, PC_SQ, gm, scr, gw, ngw, lane);
    tseg(win, INW, OC_SK, 128, wint, DM, PC_SK, gm, scr, gw, ngw, lane);
    tseg(win, INW, OC_SV, 128, wint, DM, PC_SV, gm, scr, gw, ngw, lane);
    tseg(win, INW, OC_LX, 384, wint, DM, PC_LX, gm, scr, gw, ngw, lane);
    tseg(win, INW, OC_LG, 384, wint, DM, PC_LG, gm, scr, gw, ngw, lane);
    tseg(win, INW, OC_KR, 32, wint, DM, PC_KR, gm, scr, gw, ngw, lane);
    tseg(p.peer_wq + (size_t)l * DM * 2048, 2048, 0, 2048, (u16*)(p.ws + WS_WQ) + (size_t)l * 2048 * DM, DM, 0, p.norm_ffn + l * DM, scr, gw, ngw, lane);
    tseg(p.w_out + (size_t)l * DM * DM, DM, 0, DM, (u16*)(p.ws + WS_WOUT) + (size_t)l * DM * DM, DM, 0, p.grp_norm + l * DM, scr, gw, ngw, lane);
    tseg(p.w_uq + (size_t)l * 256 * 576, 576, 0, 576, (u16*)(p.ws + WS_WUQ) + (size_t)l * 640 * 256, 256, 0, p.q_norm + l * 256, scr, gw, ngw, lane);
    tseg(p.w_ukv + (size_t)l * 128 * 768, 768, 0, 768, (u16*)(p.ws + WS_WUKV) + (size_t)l * 768 * 128, 128, 0, p.kv_norm + l * 128, scr, gw, ngw, lane);
    for (int it = gw; it < 2 * 6 * 2 * 2; it += ngw) {
      const int nbk = it & 1, ax = (it >> 1) & 1, n = (it >> 2) % 6, d = (it >> 2) / 6;
      const float* W = (ax ? p.lru_wx : p.lru_wa) + ((size_t)(l * 2 + d) * 6 + n) * 4096;
      u16* WT = (u16*)(p.ws + WS_WLRU) + ((size_t)((l * 6 + n) * 2 + d)) * 128 * 64;
      tconv_item(W, 64, 0, WT, 64, ax * 64, nullptr, scr, 0, nbk, lane);
    }
  }
  for (int i = vb * NTHREADS + tid; i < DEPTH * 96 * DM / 8; i += nb * NTHREADS) { const int l = i / (96 * DM / 8), r = i % (96 * DM / 8);
    *(u32x4*)((u16*)(p.ws + WS_WIN) + ((size_t)l * INWP + INW) * DM + (size_t)r * 8) = (u32x4){0, 0, 0, 0}; }
  for (int i = vb * NTHREADS + tid; i < DEPTH * 64 * 256 / 8; i += nb * NTHREADS) { const int l = i / (64 * 256 / 8), r = i % (64 * 256 / 8);
    *(u32x4*)((u16*)(p.ws + WS_WUQ) + ((size_t)l * 640 + 576) * 256 + (size_t)r * 8) = (u32x4){0, 0, 0, 0}; }
  for (int i = vb * NTHREADS + tid; i < DEPTH * 2 * 128 * 128 / 8; i += nb * NTHREADS) {
    const f32x4 a = *(const f32x4*)(p.peer_subkeys + (size_t)i * 8), b = *(const f32x4*)(p.peer_subkeys + (size_t)i * 8 + 4);
    u32x4 o; o.x = pk2(a.x, a.y); o.y = pk2(a.z, a.w); o.z = pk2(b.x, b.y); o.w = pk2(b.z, b.w);
    *(u32x4*)((u16*)(p.ws + WS_SUBK) + (size_t)i * 8) = o; }
  for (size_t i = (size_t)vb * NTHREADS + tid; i < (size_t)T * DM / 8; i += (size_t)nb * NTHREADS) {
    const f32x4 a = *(const f32x4*)(p.x + i * 8), b = *(const f32x4*)(p.x + i * 8 + 4);
    u32x4 o; o.x = pk2(a.x, a.y); o.y = pk2(a.z, a.w); o.z = pk2(b.x, b.y); o.w = pk2(b.z, b.w);
    *(u32x4*)((u16*)(p.ws + WS_XG) + i * 8) = o; }
}

DEVI int swz(int row, int c) { return row * 128 + ((c ^ ((row >> 1) & 7)) << 4); }
constexpr int CLD = 132;
constexpr int LDS_RS = 135168;

struct GemmDesc {
  const u16* A; int lda; const u16* Bt; int ldb; int KT;
  float inv0;
  const u16* proj; const float* cw; const float* cb; int ch0;
};

template <int AMODE> DEVI bf16x8 load_a(const GemmDesc& g, int row, int kcol) {
  if constexpr (AMODE == 0) {
    return *(const bf16x8*)(g.A + (size_t)row * g.lda + kcol);
  } else {
    const int s = row & (SEQ - 1), ch = g.ch0 + kcol;
    float a[8];
    { const f32x4 b0 = *(const f32x4*)(g.cb + ch), b1 = *(const f32x4*)(g.cb + ch + 4); a[0] = b0.x; a[1] = b0.y; a[2] = b0.z; a[3] = b0.w; a[4] = b1.x; a[5] = b1.y; a[6] = b1.z; a[7] = b1.w; }
#pragma unroll
    for (int tap = 0; tap < 4; ++tap) {
      const int ss = s - 1 + tap;
      if (ss >= 0 && ss < SEQ) {
        const u32x4 v = *(const u32x4*)(g.proj + (size_t)(row - 1 + tap) * INWP + PC_LX + ch);
        float x[8]; unpk8(v, x);
        const f32x4 w0 = *(const f32x4*)(g.cw + tap * LRU_W + ch), w1 = *(const f32x4*)(g.cw + tap * LRU_W + ch + 4);
        a[0] += w0.x * x[0]; a[1] += w0.y * x[1]; a[2] += w0.z * x[2]; a[3] += w0.w * x[3];
        a[4] += w1.x * x[4]; a[5] += w1.y * x[5]; a[6] += w1.z * x[6]; a[7] += w1.w * x[7];
      }
    }
    const u32x4 o = pk8(a);
    return __builtin_bit_cast(bf16x8, o);
  }
}

template <int AMODE> DEVI void g_load(const GemmDesc& g, bf16x8 (&ar)[4], bf16x8 (&br)[2], int m0, int n0, int srow, int sc, int kt) {
#pragma unroll
  for (int i = 0; i < 4; ++i) ar[i] = load_a<AMODE>(g, m0 + srow + 64 * i, kt * 64 + sc * 8);
#pragma unroll
  for (int i = 0; i < 2; ++i) br[i] = *(const bf16x8*)(g.Bt + (size_t)(n0 + srow + 64 * i) * g.ldb + kt * 64 + sc * 8);
}
template <bool NORM> DEVI void g_write(char* Ab, const bf16x8 (&ar)[4], const bf16x8 (&br)[2], float (&ssq)[4], int srow, int sc) {
  char* Bb = Ab + 32768;
#pragma unroll
  for (int i = 0; i < 4; ++i) { *(bf16x8*)(Ab + swz(srow + 64 * i, sc)) = ar[i];
    if (NORM) { float x[8]; unpk8(__builtin_bit_cast(u32x4, ar[i]), x); float s = ssq[i];
#pragma unroll
      for (int q = 0; q < 8; ++q) s = fmaf(x[q], x[q], s);
      ssq[i] = s; } }
#pragma unroll
  for (int i = 0; i < 2; ++i) *(bf16x8*)(Bb + swz(srow + 64 * i, sc)) = br[i];
}

template <int AMODE, int SEG, class Epi>
DEVI void gemm_tile(const GemmDesc& g, int m0, int n0, char* lds, const Epi& epi) {
  const int tid = tidx(), lane = tid & 63, wid = tid >> 6;
  const int wm = wid >> 1, wn = wid & 1, r32 = lane & 31, hi = lane >> 5;
  const int srow = tid >> 3, sc = tid & 7;
  constexpr bool NORM = SEG != 0;
  float* rs = (float*)(lds + LDS_RS);
  f32x16 acc[2][2], acc2[2][2];
#pragma unroll
  for (int i = 0; i < 2; ++i)
#pragma unroll
    for (int j = 0; j < 2; ++j) { acc[i][j] = f32x16{}; acc2[i][j] = f32x16{}; }
  float ssq[4] = {0.f, 0.f, 0.f, 0.f};
  bf16x8 ar[4], br[2];
  g_load<AMODE>(g, ar, br, m0, n0, srow, sc, 0); g_write<NORM>(lds, ar, br, ssq, srow, sc); __syncthreads();
  int seg = 0;
#pragma unroll 1
  for (int kt = 0; kt < g.KT; ++kt) {
    const int cur = kt & 1;
    if (kt + 1 < g.KT) g_load<AMODE>(g, ar, br, m0, n0, srow, sc, kt + 1);
    { const char* Ab = lds + cur * 49152; const char* Bb = Ab + 32768;
#pragma unroll
      for (int k16 = 0; k16 < 4; ++k16) {
        bf16x8 a[2], b[2];
#pragma unroll
        for (int mt = 0; mt < 2; ++mt) a[mt] = *(const bf16x8*)(Ab + swz(wm * 64 + mt * 32 + r32, k16 * 2 + hi));
#pragma unroll
        for (int nt = 0; nt < 2; ++nt) b[nt] = *(const bf16x8*)(Bb + swz(wn * 64 + nt * 32 + r32, k16 * 2 + hi));
#pragma unroll
        for (int mt = 0; mt < 2; ++mt)
#pragma unroll
          for (int nt = 0; nt < 2; ++nt) {
            if (NORM) acc2[mt][nt] = __builtin_amdgcn_mfma_f32_32x32x16_bf16(a[mt], b[nt], acc2[mt][nt], 0, 0, 0);
            else acc[mt][nt] = __builtin_amdgcn_mfma_f32_32x32x16_bf16(a[mt], b[nt], acc[mt][nt], 0, 0, 0);
          }
      } }
    if (NORM) {
      int se; float inv;
      if (SEG == 1) { se = g.KT; inv = g.inv0; }
      else { se = seg == 0 ? 6 : (seg == 1 ? 12 : 16); inv = seg == 2 ? (1.f / 256.f) : (1.f / 384.f); }
      if (kt + 1 == se) {
#pragma unroll
        for (int i = 0; i < 4; ++i) { float s = ssq[i]; s += __shfl_xor(s, 1); s += __shfl_xor(s, 2); s += __shfl_xor(s, 4); if (sc == 0) rs[srow + 64 * i] = rsqrtf(s * inv + EPS); }
        __syncthreads();
#pragma unroll
        for (int mt = 0; mt < 2; ++mt)
#pragma unroll
          for (int r = 0; r < 16; ++r) { const float f = rs[wm * 64 + mt * 32 + crow(r, hi)];
#pragma unroll
            for (int nt = 0; nt < 2; ++nt) { acc[mt][nt][r] = fmaf(f, acc2[mt][nt][r], acc[mt][nt][r]); acc2[mt][nt][r] = 0.f; } }
        ssq[0] = ssq[1] = ssq[2] = ssq[3] = 0.f;
        ++seg;
      }
    }
    if (kt + 1 < g.KT) g_write<NORM>(lds + (cur ^ 1) * 49152, ar, br, ssq, srow, sc);
    __syncthreads();
  }
  float* C = (float*)lds;
#pragma unroll
  for (int mt = 0; mt < 2; ++mt)
#pragma unroll
    for (int nt = 0; nt < 2; ++nt)
#pragma unroll
      for (int r = 0; r < 16; ++r) C[(wm * 64 + mt * 32 + crow(r, hi)) * CLD + wn * 64 + nt * 32 + r32] = acc[mt][nt][r];
  __syncthreads();
  epi(C, m0, n0);
  __syncthreads();
}

DEVI GemmDesc gemm_desc(const u16* A, int lda, const u16* Bt, int ldb, int K) {
  GemmDesc g{}; g.A = A; g.lda = lda; g.Bt = Bt; g.ldb = ldb; g.KT = K / 64; g.inv0 = 1.f / (float)K; return g;
}

DEVI void ld8(const float* p, float* v) { const f32x4 a = *(const f32x4*)p, b = *(const f32x4*)(p + 4); v[0] = a.x; v[1] = a.y; v[2] = a.z; v[3] = a.w; v[4] = b.x; v[5] = b.y; v[6] = b.z; v[7] = b.w; }

template <int HW> DEVI void rope8(float* v, const float* pp, int i0, float posf) {
  const bool first = i0 < HW; const int f0 = i0 & (HW - 1);
#pragma unroll
  for (int j = 0; j < 8; ++j) { float sn, cs; rope_sc(posf, HW == 32 ? (f0 + j) : 2 * (f0 + j), sn, cs); const float pv = pp[j]; v[j] = first ? v[j] * cs - pv * sn : v[j] * cs + pv * sn; }
}

struct EpiP1 { u16* proj; const int* pos;
  DEVI void operator()(const float* C, int m0, int n0) const {
    const int tid = tidx();
#pragma unroll 1
    for (int it = 0; it < 8; ++it) { const int item = it * NTHREADS + tid, row = item >> 4, c8 = (item & 15) * 8, gcol = n0 + c8, grow = m0 + row;
      float v[8]; ld8(C + row * CLD + c8, v);
      const bool r64 = gcol >= PC_SQ && gcol < PC_SV, r32g = gcol >= PC_KR && gcol < PC_KR + 32;
      if (r64) { const int i0 = gcol & 63; float pp[8]; ld8(C + row * CLD + c8 + (i0 < 32 ? 32 : -32), pp); rope8<32>(v, pp, i0, (float)pos[grow]); }
      else if (r32g) { const int i0 = gcol & 31; float pp[8]; ld8(C + row * CLD + c8 + (i0 < 16 ? 16 : -16), pp); rope8<16>(v, pp, i0, (float)pos[grow]); }
      *(u32x4*)(proj + (size_t)grow * INWP + gcol) = pk8(v);
    }
  }
};

struct EpiQ { u16* qm; const int* pos;
  DEVI void operator()(const float* C, int m0, int n0) const {
    const int tid = tidx();
#pragma unroll 1
    for (int it = 0; it < 8; ++it) { const int item = it * NTHREADS + tid, row = item >> 4, c8 = (item & 15) * 8, gcol = n0 + c8, grow = m0 + row;
      if (gcol >= 576) continue;
      const int head = gcol / 96, j0 = gcol - head * 96, b = grow >> 13, s = grow & (SEQ - 1);
      float v[8]; ld8(C + row * CLD + c8, v);
      if (j0 >= 64) { const int i0 = j0 - 64; float pp[8]; ld8(C + row * CLD + c8 + (i0 < 16 ? 16 : -16), pp); rope8<16>(v, pp, i0, (float)pos[grow]); }
      *(u32x4*)(qm + ((size_t)(b * MLA_H + head) * SEQ + s) * MLA_QK + j0) = pk8(v);
    }
  }
};

struct EpiKV { u16* km; u16* vm; const u16* proj;
  DEVI void operator()(const float* C, int m0, int n0) const {
    const int tid = tidx(), head = n0 >> 7;
#pragma unroll 1
    for (int it = 0; it < 8; ++it) { const int item = it * NTHREADS + tid, row = item >> 4, c8 = (item & 15) * 8, grow = m0 + row;
      const int b = grow >> 13, s = grow & (SEQ - 1);
      float v[8]; ld8(C + row * CLD + c8, v);
      const size_t tok = (size_t)(b * MLA_H + head) * SEQ + s;
      if (c8 < 64) *(u32x4*)(km + tok * MLA_QK + c8) = pk8(v);
      else *(u32x4*)(vm + tok * MLA_V + (c8 - 64)) = pk8(v);
    }
#pragma unroll 1
    for (int it = 0; it < 2; ++it) { const int item = it * NTHREADS + tid, row = item >> 2, c = (item & 3) * 8, grow = m0 + row;
      const int b = grow >> 13, s = grow & (SEQ - 1);
      *(u32x4*)(km + ((size_t)(b * MLA_H + head) * SEQ + s) * MLA_QK + 64 + c) = *(const u32x4*)(proj + (size_t)grow * INWP + PC_KR + c);
    }
  }
};

struct EpiLRU { const u16* proj; const float* cw; const float* cb; const float* ba; const float* bx; const float* lam; u16* le; u16* lb; int n, d;
  DEVI void operator()(const float* C, int m0, int) const {
    const int tid = tidx();
#pragma unroll 1
    for (int it = 0; it < 4; ++it) { const int item = it * NTHREADS + tid, j = item & 63, g8 = item >> 6;
      const int ch = n * 64 + j, grow0 = m0 + g8 * 8, s0 = grow0 & (SEQ - 1), b = grow0 >> 13;
      const float bav = ba[(d * 6 + n) * 64 + j], bxv = bx[(d * 6 + n) * 64 + j];
      const float cdec = -8.f * log1pf(__expf(-lam[d * LRU_W + ch]));
      float xin[11];
#pragma unroll
      for (int q = 0; q < 11; ++q) { const int ss = s0 - 1 + q; xin[q] = (ss >= 0 && ss < SEQ) ? bf2f(proj[(size_t)(grow0 - 1 + q) * INWP + PC_LX + ch]) : 0.f; }
      const float w0 = cw[ch], w1 = cw[LRU_W + ch], w2 = cw[2 * LRU_W + ch], w3 = cw[3 * LRU_W + ch], cbv = cb[ch];
      float ev[8], bv[8];
#pragma unroll
      for (int rr = 0; rr < 8; ++rr) {
        const float xf = cbv + w0 * xin[rr] + w1 * xin[rr + 1] + w2 * xin[rr + 2] + w3 * xin[rr + 3];
        const float r = sigmoidf_(C[(g8 * 8 + rr) * CLD + j] + bav), ig = sigmoidf_(C[(g8 * 8 + rr) * CLD + 64 + j] + bxv);
        const float a = __expf(cdec * r), e = 1.f - a;
        ev[rr] = e; bv[rr] = sqrtf(e * (2.f - e)) * ig * xf;
      }
      const size_t o = (((size_t)(d * NB + b) * (SEQ / 8) + (s0 >> 3)) * LRU_W + ch) * 8;
      *(u32x4*)(le + o) = pk8(ev); *(u32x4*)(lb + o) = pk8(bv);
    }
  }
};

struct EpiP4 { const float* xres; float* xout; u16* xg;
  DEVI void operator()(const float* C, int m0, int n0) const {
    const int tid = tidx();
#pragma unroll 1
    for (int it = 0; it < 8; ++it) { const int item = it * NTHREADS + tid, row = item >> 4, c8 = (item & 15) * 8, gcol = n0 + c8, grow = m0 + row;
      float v[8], x[8]; ld8(C + row * CLD + c8, v); ld8(xres + (size_t)grow * DM + gcol, x);
#pragma unroll
      for (int j = 0; j < 8; ++j) v[j] += x[j];
      *(f32x4*)(xout + (size_t)grow * DM + gcol) = (f32x4){v[0], v[1], v[2], v[3]}; *(f32x4*)(xout + (size_t)grow * DM + gcol + 4) = (f32x4){v[4], v[5], v[6], v[7]};
      *(u32x4*)(xg + (size_t)grow * DM + gcol) = pk8(v);
    }
  }
};

struct EpiBf16 { u16* o; int ldo;
  DEVI void operator()(const float* C, int m0, int n0) const {
    const int tid = tidx();
#pragma unroll 1
    for (int it = 0; it < 8; ++it) { const int item = it * NTHREADS + tid, row = item >> 4, c8 = (item & 15) * 8;
      float v[8]; ld8(C + row * CLD + c8, v);
      *(u32x4*)(o + (size_t)(m0 + row) * ldo + n0 + c8) = pk8(v);
    }
  }
};

DEVI void ce_desc(float& a, float& b) { const float mx = fmaxf(a, b), mn = fminf(a, b); a = mx; b = mn; }
struct EpiTop { float* top; int hj;
  DEVI void operator()(const float* C, int m0, int) const {
    const int tid = tidx(), row = tid >> 1, part = tid & 1;
    float l[16];
#pragma unroll
    for (int i = 0; i < 16; ++i) l[i] = -3.0e38f;
#pragma unroll 4
    for (int c = 0; c < 64; ++c) { const int col = part * 64 + ((c + row) & 63);
      float v = __uint_as_float((__float_as_uint(C[row * CLD + col]) & ~127u) | (unsigned)(127 - col));
#pragma unroll
      for (int i = 0; i < 16; ++i) { const float t = fmaxf(l[i], v); v = fminf(l[i], v); l[i] = t; } }
    float m[16];
#pragma unroll
    for (int i = 0; i < 16; ++i) m[i] = __shfl_xor(l[15 - i], 1);
#pragma unroll
    for (int i = 0; i < 16; ++i) m[i] = fmaxf(m[i], l[i]);
#pragma unroll
    for (int st = 8; st >= 1; st >>= 1)
#pragma unroll
      for (int i = 0; i < 16; ++i) if ((i & st) == 0) ce_desc(m[i], m[i + st]);
    if (part == 0) { float* o = top + ((size_t)(m0 + row) * 16 + hj) * 16;
#pragma unroll
      for (int i = 0; i < 4; ++i) *(f32x4*)(o + 4 * i) = (f32x4){m[4 * i], m[4 * i + 1], m[4 * i + 2], m[4 * i + 3]}; }
  }
};

#define KSWZ(row, colB) ((row) * 256 + ((colB) ^ (((row) & 7) << 4)))
#define SBAR() __builtin_amdgcn_sched_barrier(0)
constexpr int AT_SHM_V = 64 * 64 * 2, AT_SHM_K = 64 * 128 * 2;
constexpr int AT_LDS = 2 * AT_SHM_V + 2 * AT_SHM_K + 8 * 64 * 4;
constexpr float ATT_THR = 8.f;
DEVI unsigned cvtpk(float lo, float hi) { unsigned r; asm volatile("v_cvt_pk_bf16_f32 %0, %1, %2" : "=v"(r) : "v"(lo), "v"(hi)); return r; }
DEVI int v_st(int k, int c) { const int kk = (k & ~0xC) | ((k & 4) << 1) | ((k & 8) >> 1); return ((kk >> 3) * 2 + (c >> 5)) * 512 + ((kk & 7) * 32 + (c & 31)) * 2; }
DEVI int v_rd_base(int lane) { return ((lane & 3) << 3) | (((lane >> 2) & 3) << 6) | (((lane >> 4) & 1) << 5) | (((lane >> 5) & 1) << 8); }
constexpr int v_rd_off(int d0, int ks, int half) { return d0 * 512 + ks * 2048 + half * 1024; }
template <int OFF> DEVI s16x4 tr_read(int vb) { s16x4 r; asm volatile("ds_read_b64_tr_b16 %0, %1 offset:%2" : "=&v"(r) : "v"(vb), "i"(OFF) : "memory"); return r; }

template <bool MASK>
DEVI void partialSM(f32x16& p0, f32x16& p1, float& m_reg, float& mn, float& alpha, float SCALE, int kpos0, int qpos, int hi) {
  const float C = SCALE * 1.4426950408889634f;
  if (MASK) {
#pragma unroll
    for (int r = 0; r < 16; ++r) { const int k0 = kpos0 + crow(r, hi) - qpos; const int k1 = k0 + 32;
      if (k0 > 128 || k0 < -128) p0[r] = -1e30f;
      if (k1 > 128 || k1 < -128) p1[r] = -1e30f; }
  }
  float pmax = p0[0];
#pragma unroll
  for (int r = 1; r < 16; ++r) pmax = fmaxf(pmax, p0[r]);
#pragma unroll
  for (int r = 0; r < 16; ++r) pmax = fmaxf(pmax, p1[r]);
  { auto rr = __builtin_amdgcn_permlane32_swap(__float_as_uint(pmax), __float_as_uint(pmax), false, false);
    pmax = fmaxf(__uint_as_float(rr[0]), __uint_as_float(rr[1])); }
  if (__builtin_expect(__all(pmax - m_reg <= ATT_THR / SCALE), 1)) { mn = m_reg; alpha = 1.f; }
  else { mn = fmaxf(m_reg, pmax); alpha = __builtin_amdgcn_exp2f((m_reg - mn) * C); m_reg = mn; }
  const float mnC = -mn * C;
#pragma unroll
  for (int r = 0; r < 16; ++r) p0[r] = fmaf(p0[r], C, mnC);
#pragma unroll
  for (int r = 0; r < 16; ++r) p1[r] = fmaf(p1[r], C, mnC);
#pragma unroll
  for (int r = 0; r < 16; ++r) p0[r] = __builtin_amdgcn_exp2f(p0[r]);
}
DEVI void finishSM(f32x16& p0, f32x16& p1, float alpha, float& l_reg, bf16x8& pa0, bf16x8& pa1, bf16x8& pa2, bf16x8& pa3) {
#pragma unroll
  for (int r = 0; r < 16; ++r) p1[r] = __builtin_amdgcn_exp2f(p1[r]);
  float ps = 0;
#pragma unroll
  for (int r = 0; r < 16; ++r) ps += p0[r];
#pragma unroll
  for (int r = 0; r < 16; ++r) ps += p1[r];
  { auto rr = __builtin_amdgcn_permlane32_swap(__float_as_uint(ps), __float_as_uint(ps), false, false);
    ps = __uint_as_float(rr[0]) + __uint_as_float(rr[1]); }
  l_reg = l_reg * alpha + ps;
#define PK4(P, BASE, OUT) do { unsigned a0 = cvtpk(P[BASE + 0], P[BASE + 1]), a1 = cvtpk(P[BASE + 2], P[BASE + 3]);   \
    unsigned b0 = cvtpk(P[BASE + 4], P[BASE + 5]), b1 = cvtpk(P[BASE + 6], P[BASE + 7]);                              \
    auto r0 = __builtin_amdgcn_permlane32_swap(a0, b0, false, false); auto r1 = __builtin_amdgcn_permlane32_swap(a1, b1, false, false); \
    u32x4 w = {r0[0], r1[0], r0[1], r1[1]}; OUT = __builtin_bit_cast(bf16x8, w); } while (0)
  PK4(p0, 0, pa0); PK4(p0, 8, pa1); PK4(p1, 0, pa2); PK4(p1, 8, pa3);
#undef PK4
}
template <int ND0>
DEVI void qkt(f32x16& p0, f32x16& p1, const char* Ks, const bf16x8* qr, int r32, int hi) {
  p0 = f32x16{}; p1 = f32x16{};
#pragma unroll
  for (int d0 = 0; d0 < ND0; ++d0) { const int cb = (d0 * 16 + hi * 8) * 2;
    const bf16x8 b0 = *(const bf16x8*)(Ks + KSWZ(r32, cb));
    const bf16x8 b1 = *(const bf16x8*)(Ks + KSWZ(32 + r32, cb));
    p0 = __builtin_amdgcn_mfma_f32_32x32x16_bf16(b0, qr[d0], p0, 0, 0, 0);
    p1 = __builtin_amdgcn_mfma_f32_32x32x16_bf16(b1, qr[d0], p1, 0, 0, 0); }
}
template <int D0> DEVI void pv_one(f32x16& od, int vb, bf16x8 pa0, bf16x8 pa1, bf16x8 pa2, bf16x8 pa3) {
  const s16x4 l0 = tr_read<v_rd_off(D0, 0, 0)>(vb), h0 = tr_read<v_rd_off(D0, 0, 1)>(vb), l1 = tr_read<v_rd_off(D0, 1, 0)>(vb), h1 = tr_read<v_rd_off(D0, 1, 1)>(vb);
  const s16x4 l2 = tr_read<v_rd_off(D0, 2, 0)>(vb), h2 = tr_read<v_rd_off(D0, 2, 1)>(vb), l3 = tr_read<v_rd_off(D0, 3, 0)>(vb), h3 = tr_read<v_rd_off(D0, 3, 1)>(vb);
  asm volatile("s_waitcnt lgkmcnt(0)" ::: "memory"); SBAR();
#define PK(L, H) (bf16x8){L[0], L[1], L[2], L[3], H[0], H[1], H[2], H[3]}
  od = __builtin_amdgcn_mfma_f32_32x32x16_bf16(pa0, PK(l0, h0), od, 0, 0, 0);
  od = __builtin_amdgcn_mfma_f32_32x32x16_bf16(pa1, PK(l1, h1), od, 0, 0, 0);
  od = __builtin_amdgcn_mfma_f32_32x32x16_bf16(pa2, PK(l2, h2), od, 0, 0, 0);
  od = __builtin_amdgcn_mfma_f32_32x32x16_bf16(pa3, PK(l3, h3), od, 0, 0, 0);
#undef PK
}
DEVI void pv_d0(f32x16* o, int vb, bf16x8 pa0, bf16x8 pa1, bf16x8 pa2, bf16x8 pa3) {
  pv_one<0>(o[0], vb, pa0, pa1, pa2, pa3); pv_one<1>(o[1], vb, pa0, pa1, pa2, pa3);
}

template <int DQK, bool MASK>
DEVI void attn_body(const u16* Qw, const u16* Kh, int ldk, const u16* Vh, int ldv, int kt0, int NT, float SCALE, float m_init, float l_init,
                    int qpos, u16* Ow, char* lds) {
  constexpr int ND0 = DQK / 16, NCK = DQK / 8, NK2 = 64 * NCK - NTHREADS;
  const int tid = tidx(), wid = tid >> 6, lane = tid & 63, r32 = lane & 31, hi = lane >> 5;
  char* V_lds = lds; char* K_lds = lds + 2 * AT_SHM_V;
  float* wsx = (float*)(lds + 2 * AT_SHM_V + 2 * AT_SHM_K) + wid * 64; float* li_l = wsx; float* al_l = wsx + 32;
  float m_reg = m_init, l_reg = l_init; f32x16 o[2] = {f32x16{}, f32x16{}}; bf16x8 qr[ND0];
#pragma unroll
  for (int d0 = 0; d0 < ND0; ++d0) qr[d0] = *(const bf16x8*)(Qw + d0 * 16);
  const int vr = tid >> 3, vc = (tid & 7) * 8, vst0 = v_st(vr, vc);
  const int k0r = tid / NCK, k0c = tid - k0r * NCK;
  const int k1id = tid + NTHREADS, k1r = k1id / NCK, k1c = k1id - k1r * NCK; const bool has2 = tid < NK2;
  const int vb0 = (int)(uintptr_t)V_lds + v_rd_base(lane);
  bf16x8 sv[2], sk0[2], sk1[2];
#define SLOAD(i, t_) do { const size_t kk0 = (size_t)(t_) * 64; sv[i] = *(const bf16x8*)(Vh + (kk0 + vr) * ldv + vc); \
    sk0[i] = *(const bf16x8*)(Kh + (kk0 + k0r) * ldk + k0c * 8); if (NK2 > 0) { if (has2) sk1[i] = *(const bf16x8*)(Kh + (kk0 + k1r) * ldk + k1c * 8); } } while (0)
#define SWRITE(b, i) do { *(bf16x8*)(V_lds + (b) * AT_SHM_V + vst0) = sv[i]; *(bf16x8*)(K_lds + (b) * AT_SHM_K + KSWZ(k0r, k0c * 16)) = sk0[i]; \
    if (NK2 > 0) { if (has2) *(bf16x8*)(K_lds + (b) * AT_SHM_K + KSWZ(k1r, k1c * 16)) = sk1[i]; } } while (0)
#define RESC(a) do { if (__any((a) < 1.f)) { if (hi == 0) al_l[r32] = (a); asm volatile("s_waitcnt lgkmcnt(0)" ::: "memory"); \
    _Pragma("unroll") for (int d = 0; d < 2; ++d) _Pragma("unroll") for (int r = 0; r < 16; ++r) o[d][r] *= al_l[crow(r, hi)]; } } while (0)
  f32x16 pA0, pA1, pB0, pB1; float mnA, mnB, alA, alB; bf16x8 pa0, pa1, pa2, pa3;
  constexpr int SE = 0, SO = 1;
  SLOAD(SE, kt0); asm volatile("s_waitcnt vmcnt(0)" ::: "memory"); SWRITE(0, SE); __syncthreads();
  qkt<ND0>(pA0, pA1, K_lds, qr, r32, hi); partialSM<MASK>(pA0, pA1, m_reg, mnA, alA, SCALE, kt0 * 64, qpos, hi);
  SLOAD(SO, kt0 + 1); if (2 < NT) SLOAD(SE, kt0 + 2);
  SWRITE(1, SO); __syncthreads();
  for (int j = 1; j + 1 < NT; j += 2) {
    SBAR(); qkt<ND0>(pB0, pB1, K_lds + AT_SHM_K, qr, r32, hi);
    finishSM(pA0, pA1, alA, l_reg, pa0, pa1, pa2, pa3); SBAR();
    SLOAD(SO, kt0 + j + 2); SBAR();
    pv_d0(o, vb0, pa0, pa1, pa2, pa3); partialSM<MASK>(pB0, pB1, m_reg, mnB, alB, SCALE, (kt0 + j) * 64, qpos, hi);
    __syncthreads(); SWRITE(0, SE);
    RESC(alB); __syncthreads();
    SBAR(); qkt<ND0>(pA0, pA1, K_lds, qr, r32, hi);
    finishSM(pB0, pB1, alB, l_reg, pa0, pa1, pa2, pa3); SBAR();
    if (j + 3 < NT) SLOAD(SE, kt0 + j + 3); SBAR();
    pv_d0(o, vb0 + AT_SHM_V, pa0, pa1, pa2, pa3); partialSM<MASK>(pA0, pA1, m_reg, mnA, alA, SCALE, (kt0 + j + 1) * 64, qpos, hi);
    __syncthreads(); SWRITE(1, SO);
    RESC(alA); __syncthreads();
  }
  SBAR(); qkt<ND0>(pB0, pB1, K_lds + AT_SHM_K, qr, r32, hi);
  finishSM(pA0, pA1, alA, l_reg, pa0, pa1, pa2, pa3); SBAR();
  pv_d0(o, vb0, pa0, pa1, pa2, pa3); partialSM<MASK>(pB0, pB1, m_reg, mnB, alB, SCALE, (kt0 + NT - 1) * 64, qpos, hi);
  __syncthreads(); RESC(alB);
  finishSM(pB0, pB1, alB, l_reg, pa0, pa1, pa2, pa3); SBAR();
  pv_d0(o, vb0 + AT_SHM_V, pa0, pa1, pa2, pa3);
  if (hi == 0) li_l[r32] = l_reg; asm volatile("s_waitcnt lgkmcnt(0)" ::: "memory");
  float rli[16];
#pragma unroll
  for (int r = 0; r < 16; ++r) rli[r] = __builtin_amdgcn_rcpf(li_l[crow(r, hi)]);
#pragma unroll
  for (int r = 0; r < 16; ++r) { const int orow = crow(r, hi);
#pragma unroll
    for (int d0 = 0; d0 < 2; ++d0) Ow[(size_t)orow * DM + d0 * 32 + r32] = f2bf(o[d0][r] * rli[r]); }
  __syncthreads();
#undef SLOAD
#undef SWRITE
#undef RESC
}

constexpr int LCH = 64, NLCH = SEQ / LCH;
constexpr size_t WS_LP = 1 * MiB, WS_LH = 2560 * 1024;
constexpr size_t WS_LC = 473 * MiB;
constexpr size_t WS_NEED = 475 * MiB;
DEVI void lru_passA(const Params& p, int item, int lane) {
  const int cg = item % 6, c = (item / 6) % NLCH, b = (item / (6 * NLCH)) % NB, d = item / (6 * NLCH * NB);
  const size_t base = (((size_t)(d * NB + b) * (SEQ / 8) + c * 8) * LRU_W + cg * 64 + lane) * 8;
  const u16* E = (const u16*)(p.ws + WS_LE) + base; const u16* Bp = (const u16*)(p.ws + WS_LB) + base;
  u32x4 ev[8], bv[8];
#pragma unroll
  for (int g = 0; g < 8; ++g) { ev[g] = *(const u32x4*)(E + (size_t)g * LRU_W * 8); bv[g] = *(const u32x4*)(Bp + (size_t)g * LRU_W * 8); }
  float h = 0.f, P = 1.f;
#pragma unroll
  for (int gg = 0; gg < 8; ++gg) { const int g = d ? 7 - gg : gg; float e[8], bb[8]; unpk8(ev[g], e); unpk8(bv[g], bb);
#pragma unroll
    for (int rr = 0; rr < 8; ++rr) { const int r = d ? 7 - rr : rr; const float a = 1.f - e[r]; h = fmaf(a, h, bb[r]); P *= a; } }
  const size_t o = ((size_t)(d * NB + b) * NLCH + c) * LRU_W + cg * 64 + lane;
  ((float*)(p.ws + WS_LP))[o] = P; ((float*)(p.ws + WS_LH))[o] = h;
}

DEVI void lru_final(const Params& p, int item, char* lds) {
  const int tid = tidx(), wid = tid >> 6, lane = tid & 63;
  const int c = item % NLCH, b = item / NLCH;
  float* obuf = (float*)lds;
  if (wid < 6) {
    const int ch = wid * 64 + lane;
#pragma unroll
    for (int d = 0; d < 2; ++d) {
      const size_t co = ((size_t)(d * NB + b) * NLCH + c) * LRU_W + ch;
      float h = ((const float*)(p.ws + WS_LC))[co];
      const size_t base = (((size_t)(d * NB + b) * (SEQ / 8) + c * 8) * LRU_W + ch) * 8;
      const u16* E = (const u16*)(p.ws + WS_LE) + base; const u16* Bp = (const u16*)(p.ws + WS_LB) + base;
      u32x4 ev[8], bv[8];
#pragma unroll
      for (int g = 0; g < 8; ++g) { ev[g] = *(const u32x4*)(E + (size_t)g * LRU_W * 8); bv[g] = *(const u32x4*)(Bp + (size_t)g * LRU_W * 8); }
      if (d == 0) {
#pragma unroll
        for (int g = 0; g < 8; ++g) { float e[8], bb[8]; unpk8(ev[g], e); unpk8(bv[g], bb);
#pragma unroll
          for (int r = 0; r < 8; ++r) { h = fmaf(1.f - e[r], h, bb[r]); obuf[(g * 8 + r) * LRU_W + ch] = h; } }
      } else {
        const u16* gp = (const u16*)(p.ws + WS_R1) + ((size_t)b * SEQ + c * LCH) * INWP + PC_LG + ch;
#pragma unroll
        for (int g = 7; g >= 0; --g) { float e[8], bb[8]; unpk8(ev[g], e); unpk8(bv[g], bb);
#pragma unroll
          for (int r = 7; r >= 0; --r) { h = fmaf(1.f - e[r], h, bb[r]); const int tk = g * 8 + r;
            const float gt = bf2f(gp[(size_t)tk * INWP]); obuf[tk * LRU_W + ch] = (obuf[tk * LRU_W + ch] + h) * gelu_erf(gt); } }
      }
    }
  }
  __syncthreads();
  u16* mp = (u16*)(p.ws + WS_MIX) + ((size_t)b * SEQ + c * LCH) * DM + 384;
#pragma unroll 1
  for (int i = 0; i < 8; ++i) { const int tk = wid * 8 + i;
    float v[6]; float s = 0.f;
#pragma unroll
    for (int q = 0; q < 3; ++q) { const f32x2 t2 = *(const f32x2*)(obuf + tk * LRU_W + q * 128 + lane * 2); v[2 * q] = t2.x; v[2 * q + 1] = t2.y; s = fmaf(t2.x, t2.x, s); s = fmaf(t2.y, t2.y, s); }
    s = wave_sum(s);
    const float rs = rsqrtf(s * (1.f / 384.f) + EPS);
#pragma unroll
    for (int q = 0; q < 3; ++q) *(unsigned*)(mp + (size_t)tk * DM + q * 128 + lane * 2) = pk2(v[2 * q] * rs, v[2 * q + 1] * rs);
  }
  __syncthreads();
}

DEVI void peer_cand(const Params& p, int layer, int vb, int nb, char* lds) {
  const int tid = tidx();
  unsigned char* my = (unsigned char*)lds + tid * 32;
  const float* top = (const float*)(p.ws + WS_TOP);
  float* egate = (float*)(p.ws + WS_EGATE);
  for (int it = vb * NTHREADS + tid; it < T * 8; it += nb * NTHREADS) {
    float v1[16], v2[16];
    const float* tp = top + (size_t)it * 32;
#pragma unroll
    for (int i = 0; i < 4; ++i) { const f32x4 a = *(const f32x4*)(tp + 4 * i), b = *(const f32x4*)(tp + 16 + 4 * i);
      v1[4 * i] = a.x; v1[4 * i + 1] = a.y; v1[4 * i + 2] = a.z; v1[4 * i + 3] = a.w; v2[4 * i] = b.x; v2[4 * i + 1] = b.y; v2[4 * i + 2] = b.z; v2[4 * i + 3] = b.w; }
#pragma unroll
    for (int i = 0; i < 16; ++i) { my[i] = (unsigned char)(127u - (__float_as_uint(v1[i]) & 127u)); my[16 + i] = (unsigned char)(127u - (__float_as_uint(v2[i]) & 127u)); }
    float l[16];
#pragma unroll
    for (int i = 0; i < 16; ++i) l[i] = -3.0e38f;
#pragma unroll
    for (int a = 0; a < 16; ++a)
#pragma unroll
      for (int b = 0; b < 16; ++b) if ((a + 1) * (b + 1) <= 16) {
        float v = __uint_as_float((__float_as_uint(v1[a] + v2[b]) & ~255u) | (unsigned)(255 - (a * 16 + b)));
#pragma unroll
        for (int i = 0; i < 16; ++i) { const float t = fmaxf(l[i], v); v = fminf(l[i], v); l[i] = t; } }
    const float mx = __uint_as_float(__float_as_uint(l[0]) & ~255u);
    float w[16], sum = 0.f;
#pragma unroll
    for (int i = 0; i < 16; ++i) { w[i] = __expf(__uint_as_float(__float_as_uint(l[i]) & ~255u) - mx); sum += w[i]; }
    const float inv = 1.f / sum;
    unsigned ev[16];
#pragma unroll
    for (int i = 0; i < 16; ++i) { const unsigned code = 255u - (__float_as_uint(l[i]) & 255u); ev[i] = (unsigned)my[code >> 4] * 128u + (unsigned)my[16 + (code & 15)]; w[i] *= inv; }
    u16* eo = (u16*)(p.ws + WS_EIDX) + (size_t)it * 16;
    *(u32x4*)(eo) = (u32x4){ev[0] | (ev[1] << 16), ev[2] | (ev[3] << 16), ev[4] | (ev[5] << 16), ev[6] | (ev[7] << 16)};
    *(u32x4*)(eo + 8) = (u32x4){ev[8] | (ev[9] << 16), ev[10] | (ev[11] << 16), ev[12] | (ev[13] << 16), ev[14] | (ev[15] << 16)};
#pragma unroll
    for (int i = 0; i < 4; ++i) *(f32x4*)(egate + (size_t)it * 16 + 4 * i) = (f32x4){w[4 * i], w[4 * i + 1], w[4 * i + 2], w[4 * i + 3]};
  }
  { const int wid = tid >> 6, lane = tid & 63; u16* xg = (u16*)(p.ws + WS_XG); const float* gf = p.norm_ffn + layer * DM;
    for (int t = vb * 8 + wid; t < T; t += nb * 8) {
      u32x4* rp = (u32x4*)(xg + (size_t)t * DM + lane * 16);
      float v[16]; unpk8(rp[0], v); unpk8(rp[1], v + 8);
      float s = 0.f;
#pragma unroll
      for (int i = 0; i < 16; ++i) s = fmaf(v[i], v[i], s);
      s = wave_sum(s);
      const float rs = rsqrtf(s * (1.f / DM) + EPS);
      float g[16]; ld8(gf + lane * 16, g); ld8(gf + lane * 16 + 8, g + 8);
#pragma unroll
      for (int i = 0; i < 16; ++i) v[i] *= rs * g[i];
      rp[0] = pk8(v); rp[1] = pk8(v + 8);
    } }
}

typedef unsigned char u8;
DEVI void cvt16(u32x4 w, float* f) {
  f32x2 t;
  t = __builtin_amdgcn_cvt_pk_f32_fp8((int)w.x, false); f[0] = t.x; f[1] = t.y; t = __builtin_amdgcn_cvt_pk_f32_fp8((int)w.x, true); f[2] = t.x; f[3] = t.y;
  t = __builtin_amdgcn_cvt_pk_f32_fp8((int)w.y, false); f[4] = t.x; f[5] = t.y; t = __builtin_amdgcn_cvt_pk_f32_fp8((int)w.y, true); f[6] = t.x; f[7] = t.y;
  t = __builtin_amdgcn_cvt_pk_f32_fp8((int)w.z, false); f[8] = t.x; f[9] = t.y; t = __builtin_amdgcn_cvt_pk_f32_fp8((int)w.z, true); f[10] = t.x; f[11] = t.y;
  t = __builtin_amdgcn_cvt_pk_f32_fp8((int)w.w, false); f[12] = t.x; f[13] = t.y; t = __builtin_amdgcn_cvt_pk_f32_fp8((int)w.w, true); f[14] = t.x; f[15] = t.y;
}
DEVI unsigned enc4(float a, float b, float c, float d) { int w = 0; w = __builtin_amdgcn_cvt_pk_fp8_f32(a, b, w, false); w = __builtin_amdgcn_cvt_pk_fp8_f32(c, d, w, true); return (unsigned)w; }
#define EIDX_AT(i0, i1, i) ((((i) < 8 ? (i0) : (i1))[((i) & 7) >> 1] >> (((i) & 1) * 16)) & 0xffffu)
template <int CTRL> DEVI float dppf(float v) { return __uint_as_float((unsigned)__builtin_amdgcn_mov_dpp((int)__float_as_uint(v), CTRL, 0xF, 0xF, true)); }
DEVI f32x2 fma2(f32x2 a, f32x2 b, f32x2 c) { return __builtin_elementwise_fma(a, b, c); }
DEVI f32x2 cvt8lo(unsigned w) { return __builtin_amdgcn_cvt_pk_f32_fp8((int)w, false); }
DEVI f32x2 cvt8hi(unsigned w) { return __builtin_amdgcn_cvt_pk_f32_fp8((int)w, true); }
struct PeerIdx { u32x4 i0, i1; };
template <bool AXPY>
DEVI void peer_slice_phase(const Params& p, int s, int tbeg, int tstep, int lane, const float* xin, float* xout, bool last) {
  const int r = lane >> 3, j = lane & 7;
  const u8* eidxB = (const u8*)(p.ws + WS_EIDX); const unsigned eoff = (unsigned)r * 32u;
  const u8* TBs = (const u8*)(p.ws + (AXPY ? WS_VB : WS_UB)) + (size_t)s * NEXP * 128; const unsigned toff = 16u * (unsigned)j;
  const u8* xnB = (const u8*)(p.ws + WS_XG) + s * 256; const unsigned xoff = 32u * (unsigned)j;
  const u8* ccB = (const u8*)(p.ws + WS_CC); const unsigned coff = (unsigned)r * 32u;
  float* pdB = (float*)(p.ws + WS_PD) + (size_t)s * T * 128;
  const int ntok = (T - tbeg + tstep - 1) / tstep;
  if (ntok <= 0) return;
#define TOK(k) (tbeg + ((k) < ntok ? (k) : ntok - 1) * tstep)
#define LD_IDX(dst, k) do { const u8* b_ = eidxB + (size_t)TOK(k) * 256; dst.i0 = *(const u32x4*)(b_ + eoff); dst.i1 = *(const u32x4*)(b_ + eoff + 16u); } while (0)
#define LD_HALF(H, ix, h) do { _Pragma("unroll") for (int i = 0; i < 8; ++i) H[i] = *(const u32x4*)(TBs + (EIDX_AT(ix.i0, ix.i1, 8 * (h) + i) * 128u + toff)); } while (0)
#define LD_AUX(a, k) do { if (AXPY) { const u8* b_ = ccB + (size_t)TOK(k) * 256; a[0] = *(const u32x4*)(b_ + coff); a[1] = *(const u32x4*)(b_ + coff + 16u); } \
    else { const u8* b_ = xnB + (size_t)TOK(k) * (DM * 2); a[0] = *(const u32x4*)(b_ + xoff); a[1] = *(const u32x4*)(b_ + xoff + 16u); } } while (0)
  PeerIdx I0, I1, I2; u32x4 H0[8], H1[8], H2[8], X0[2], X1[2], X2[2];
  float av[16];
  f32x2 acc[8];
#define T_BEGIN(X) do { unpk8(X[0], av); unpk8(X[1], av + 8); if (AXPY) { _Pragma("unroll") for (int q = 0; q < 8; ++q) acc[q] = (f32x2){0.f, 0.f}; } } while (0)
#define COMP(H, h, k) do { if ((k) < ntok) { \
    if (!AXPY) { float* o_ = pdB + (size_t)(tbeg + (k) * tstep) * 128 + r * 16 + 8 * (h); \
      _Pragma("unroll") for (int g = 0; g < 2; ++g) { float res[4]; \
        _Pragma("unroll") for (int ii = 0; ii < 4; ++ii) { const u32x4 w_ = H[4 * g + ii]; f32x2 a = {0.f, 0.f}; \
          a = fma2(cvt8lo(w_.x), (f32x2){av[0], av[1]}, a); a = fma2(cvt8hi(w_.x), (f32x2){av[2], av[3]}, a); a = fma2(cvt8lo(w_.y), (f32x2){av[4], av[5]}, a); a = fma2(cvt8hi(w_.y), (f32x2){av[6], av[7]}, a); \
          a = fma2(cvt8lo(w_.z), (f32x2){av[8], av[9]}, a); a = fma2(cvt8hi(w_.z), (f32x2){av[10], av[11]}, a); a = fma2(cvt8lo(w_.w), (f32x2){av[12], av[13]}, a); a = fma2(cvt8hi(w_.w), (f32x2){av[14], av[15]}, a); \
          float v = a.x + a.y; v += dppf<0xB1>(v); v += dppf<0x4E>(v); v += dppf<0x141>(v); res[ii] = v; } \
        if (j == 0) *(f32x4*)(o_ + 4 * g) = (f32x4){res[0], res[1], res[2], res[3]}; } } \
    else { _Pragma("unroll") for (int i = 0; i < 8; ++i) { const u32x4 w_ = H[i]; const float ci = av[8 * (h) + i]; const f32x2 c2 = {ci, ci}; \
        acc[0] = fma2(cvt8lo(w_.x), c2, acc[0]); acc[1] = fma2(cvt8hi(w_.x), c2, acc[1]); acc[2] = fma2(cvt8lo(w_.y), c2, acc[2]); acc[3] = fma2(cvt8hi(w_.y), c2, acc[3]); \
        acc[4] = fma2(cvt8lo(w_.z), c2, acc[4]); acc[5] = fma2(cvt8hi(w_.z), c2, acc[5]); acc[6] = fma2(cvt8lo(w_.w), c2, acc[6]); acc[7] = fma2(cvt8hi(w_.w), c2, acc[7]); } } } } while (0)
  auto finalize = [&](int k) {
    if (!AXPY || k >= ntok) return;
    const int t = tbeg + k * tstep;
    float S[8];
#pragma unroll
    for (int q = 0; q < 8; ++q) { const float A = acc[q >> 1][q & 1], B = acc[(q + 8) >> 1][q & 1];
      auto rr = __builtin_amdgcn_permlane32_swap(__float_as_uint(A), __float_as_uint(B), false, false); S[q] = __uint_as_float(rr[0]) + __uint_as_float(rr[1]); }
    float Tq[4];
#pragma unroll
    for (int q = 0; q < 4; ++q) { auto rr = __builtin_amdgcn_permlane16_swap(__float_as_uint(S[q]), __float_as_uint(S[q + 4]), false, false); Tq[q] = __uint_as_float(rr[0]) + __uint_as_float(rr[1]); }
#pragma unroll
    for (int q = 0; q < 4; ++q) Tq[q] += dppf<0x128>(Tq[q]);
    float ss = 0.f;
    if ((lane & 8) == 0) {
      const size_t o = (size_t)t * DM + s * 128 + 16 * j + ((lane >> 5) & 1) * 8 + ((lane >> 4) & 1) * 4;
      const f32x4 x = *(const f32x4*)(xin + o);
      const f32x4 y = {x.x + Tq[0], x.y + Tq[1], x.z + Tq[2], x.w + Tq[3]};
      *(f32x4*)(xout + o) = y;
      if (!last) *(u32x2*)((u16*)(p.ws + WS_XG) + o) = (u32x2){pk2(y.x, y.y), pk2(y.z, y.w)};
      ss = (y.x * y.x + y.y * y.y) + (y.z * y.z + y.w * y.w);
    }
    if (last) { ss = wave_sum(ss); if (lane == 0) ((float*)(p.ws + WS_SSQ))[(size_t)t * 8 + s] = ss; }
  };
  LD_IDX(I0, 0); LD_IDX(I1, 1); LD_HALF(H0, I0, 0); LD_HALF(H1, I0, 1); LD_AUX(X0, 0);
#pragma unroll 1
  for (int k = 0; k < ntok; k += 3) {
    LD_HALF(H2, I1, 0); LD_IDX(I2, k + 2); LD_AUX(X1, k + 1);
    T_BEGIN(X0); COMP(H0, 0, k);
    LD_HALF(H0, I1, 1);
    COMP(H1, 1, k); finalize(k);
    LD_HALF(H1, I2, 0); LD_IDX(I0, k + 3); LD_AUX(X2, k + 2);
    T_BEGIN(X1); COMP(H2, 0, k + 1);
    LD_HALF(H2, I2, 1);
    COMP(H0, 1, k + 1); finalize(k + 1);
    LD_HALF(H0, I0, 0); LD_IDX(I1, k + 4); LD_AUX(X0, k + 3);
    T_BEGIN(X2); COMP(H1, 0, k + 2);
    LD_HALF(H1, I0, 1);
    COMP(H2, 1, k + 2); finalize(k + 2);
  }
#undef TOK
#undef LD_IDX
#undef LD_HALF
#undef LD_AUX
#undef T_BEGIN
#undef COMP
}

DEVI void lru_passB(const Params& p, int item, int lane) {
  const int cg = item % 6, b = (item / 6) % NB, d = item / (6 * NB);
  const size_t o = (size_t)(d * NB + b) * NLCH * LRU_W + cg * 64 + lane;
  const float* Pp = (const float*)(p.ws + WS_LP) + o; const float* Hp = (const float*)(p.ws + WS_LH) + o; float* Cp = (float*)(p.ws + WS_LC) + o;
  float h = 0.f;
#pragma unroll 1
  for (int c0 = 0; c0 < NLCH; c0 += 32) {
    float pv[32], hv[32];
#pragma unroll
    for (int i = 0; i < 32; ++i) { const int cc = d ? NLCH - 1 - (c0 + i) : c0 + i; pv[i] = Pp[(size_t)cc * LRU_W]; hv[i] = Hp[(size_t)cc * LRU_W]; }
#pragma unroll
    for (int i = 0; i < 32; ++i) { const int cc = d ? NLCH - 1 - (c0 + i) : c0 + i; Cp[(size_t)cc * LRU_W] = h; h = fmaf(pv[i], h, hv[i]); }
  }
}

DEVI void swa_item(const Params& p, int layer, int item, char* lds) {
  const int tid = tidx(), wid = tid >> 6, lane = tid & 63, r32 = lane & 31, hi = lane >> 5;
  const int g = item & 1, n = (item >> 1) & 63, b = item >> 7;
  const int hq = 2 * g + (wid >> 2), qrow = n * 128 + (wid & 3) * 32;
  const u16* proj = (const u16*)(p.ws + WS_R1);
  const u16* Qw = proj + (size_t)(b * SEQ + qrow + r32) * INWP + PC_SQ + hq * 64 + hi * 8;
  const u16* Kh = proj + (size_t)(b * SEQ) * INWP + PC_SK + g * 64;
  const u16* Vh = proj + (size_t)(b * SEQ) * INWP + PC_SV + g * 64;
  const int kt0 = (2 * n - 2) < 0 ? 0 : (2 * n - 2), kt1 = (2 * n + 4) > SEQ / 64 ? SEQ / 64 : (2 * n + 4);
  const float sink = p.swa_sink[layer * 4 + hq];
  u16* Ow = (u16*)(p.ws + WS_MIX) + (size_t)(b * SEQ + qrow) * DM + 768 + hq * 64;
  attn_body<64, true>(Qw, Kh, INWP, Vh, INWP, kt0, kt1 - kt0, 0.125f, sink * 8.f, 1.f, qrow + r32, Ow, lds);
}
DEVI void mla_item(const Params& p, int pair, int qb, char* lds) {
  const int tid = tidx(), wid = tid >> 6, lane = tid & 63, r32 = lane & 31, hi = lane >> 5;
  const int b = pair / MLA_H, h = pair - b * MLA_H;
  const u16* Qw = (const u16*)(p.ws + WS_QM) + ((size_t)pair * SEQ + qb * 256 + wid * 32 + r32) * MLA_QK + hi * 8;
  const u16* Kh = (const u16*)(p.ws + WS_KM) + (size_t)pair * SEQ * MLA_QK;
  const u16* Vh = (const u16*)(p.ws + WS_VM) + (size_t)pair * SEQ * MLA_V;
  u16* Ow = (u16*)(p.ws + WS_MIX) + (size_t)(b * SEQ + qb * 256 + wid * 32) * DM + h * 64;
  attn_body<96, false>(Qw, Kh, MLA_QK, Vh, MLA_V, 0, SEQ / 64, 0.10206207261596575f, -1e30f, 0.f, 0, Ow, lds);
}

constexpr int PH_PER_LAYER = 12, N_PHASES = 2 + DEPTH * PH_PER_LAYER;
DEVI void run_phase(const Params& pin, int ph, int vb, int nb, char* lds) {
  const bool dry = ph >= 100; if (dry) ph -= 100;
  Params p = pin; { size_t z = 0; asm volatile("" : "+s"(z)); p.ws = pin.ws + z; p.out = pin.out + z; } asm volatile("" : "+s"(vb));
  const int tid = tidx(), wid = tid >> 6, lane = tid & 63;
#ifdef ONLY_SP
  if (ONLY_SP >= 0 && ph == 0) return;
#endif
  if (ph == 0) { phase0(p, vb, nb, lds); return; }
  if (ph == N_PHASES - 1) {
    const float* ssq = (const float*)(p.ws + WS_SSQ);
    for (size_t i = (size_t)vb * NTHREADS + tid; i < (size_t)T * DM / 8; i += (size_t)nb * NTHREADS) {
      const size_t t = i >> 7; const int c = (int)(i & 127) * 8;
      float s8[8]; ld8(ssq + t * 8, s8); const float rs = rsqrtf((((s8[0] + s8[1]) + (s8[2] + s8[3])) + ((s8[4] + s8[5]) + (s8[6] + s8[7]))) * (1.f / DM) + EPS);
      float x[8], g[8]; ld8(p.out + i * 8, x); ld8(p.norm_final + c, g);
#pragma unroll
      for (int q = 0; q < 8; ++q) x[q] *= rs * g[q];
      *(f32x4*)(p.out + i * 8) = (f32x4){x[0], x[1], x[2], x[3]}; *(f32x4*)(p.out + i * 8 + 4) = (f32x4){x[4], x[5], x[6], x[7]}; }
    return; }
  const int l = (ph - 1) / PH_PER_LAYER, sp = (ph - 1) % PH_PER_LAYER;
  u16* const XG = (u16*)(p.ws + WS_XG); u16* const PROJ = (u16*)(p.ws + WS_R1); u16* const MIX = (u16*)(p.ws + WS_MIX);
  constexpr int NMT = T / 256;
#ifdef ONLY_SP
  if (sp != ONLY_SP) return;
#endif
  switch (sp) {
  case 0: {
    GemmDesc g = gemm_desc(XG, DM, (const u16*)(p.ws + WS_WIN) + (size_t)l * INWP * DM, DM, DM);
    EpiP1 e{PROJ, p.pos};
    for (int it = vb; it < NMT * 14; it += nb) gemm_tile<0, 1>(g, (it / 14) * 256, (it % 14) * 128, lds, e);
  } break;
  case 1: {
    constexpr int N_C = NMT * 12, N_A = NMT * 5, N_B = NMT * 6;
    for (int it = vb; it < N_C + N_A + N_B; it += nb) {
      if (it < N_C) { const int mt = it / 12, nd = it % 12, n = nd >> 1, d = nd & 1;
        GemmDesc g{}; g.Bt = (const u16*)(p.ws + WS_WLRU) + (size_t)((l * 6 + n) * 2 + d) * 128 * 64; g.ldb = 64; g.KT = 1;
        g.proj = PROJ; g.cw = p.conv_w + l * 4 * LRU_W; g.cb = p.conv_b + l * LRU_W; g.ch0 = n * 64;
        EpiLRU e{PROJ, g.cw, g.cb, p.lru_ba + l * 2 * 384, p.lru_bx + l * 2 * 384, p.lru_lambda + l * 2 * 384, (u16*)(p.ws + WS_LE), (u16*)(p.ws + WS_LB), n, d};
        gemm_tile<1, 0>(g, mt * 256, 0, lds, e);
      } else if (it < N_C + N_A) { const int i2 = it - N_C;
        GemmDesc g = gemm_desc(PROJ + PC_CQ, INWP, (const u16*)(p.ws + WS_WUQ) + (size_t)l * 640 * 256, 256, 256);
        EpiQ e{(u16*)(p.ws + WS_QM), p.pos};
        gemm_tile<0, 1>(g, (i2 / 5) * 256, (i2 % 5) * 128, lds, e);
      } else { const int i2 = it - N_C - N_A;
        GemmDesc g = gemm_desc(PROJ + PC_CKV, INWP, (const u16*)(p.ws + WS_WUKV) + (size_t)l * 768 * 128, 128, 128);
        EpiKV e{(u16*)(p.ws + WS_KM), (u16*)(p.ws + WS_VM), PROJ};
        gemm_tile<0, 1>(g, (i2 / 6) * 256, (i2 % 6) * 128, lds, e);
      }
    }
  } break;
  case 2: {
    for (int it = vb * 8 + wid; it < 2 * NB * NLCH * 6; it += nb * 8) lru_passA(p, it, lane);
  } break;
  case 3: {
    const int wi = vb * 8 + wid;
    if (wi < 48) lru_passB(p, wi, lane);
    __syncthreads();
    for (int it = vb; it < NB * 64 * 2; it += nb) swa_item(p, l, it, lds);
  } break;
  case 4: {
    for (int k = 0; k * nb + vb < NB * MLA_H * 32; ++k) {
      int pair, qb;
      if (nb == 256) { pair = k * 8 + (vb & 7); qb = vb >> 3; } else { const int it = k * nb + vb; pair = it >> 5; qb = it & 31; }
      mla_item(p, pair, qb, lds);
    }
#ifndef NO_LRUF
    for (int it = vb; it < NB * NLCH; it += nb) lru_final(p, it, lds);
#endif
  } break;
  case 5: {
    GemmDesc g = gemm_desc(MIX, DM, (const u16*)(p.ws + WS_WOUT) + (size_t)l * DM * DM, DM, DM);
    EpiP4 e{l == 0 ? p.x : p.out, dry ? (float*)(p.ws + 89 * MiB) : p.out, dry ? (u16*)(p.ws + 25 * MiB + 0) : XG};
    for (int it = vb; it < NMT * 8; it += nb) gemm_tile<0, 2>(g, (it / 8) * 256, (it % 8) * 128, lds, e);
    const float* us = p.peer_u + (size_t)l * NEXP * DM; const float* vs = p.peer_v + (size_t)l * NEXP * DM;
    u8* ub = (u8*)(p.ws + WS_UB); u8* vbf = (u8*)(p.ws + WS_VB);
    for (size_t i = (size_t)vb * NTHREADS + tid; i < (size_t)NEXP * 64; i += (size_t)nb * NTHREADS) {
      const size_t e = i >> 6; const int c16 = (int)(i & 63), s = c16 >> 3, cc = (c16 & 7) * 16;
      float a[16], b[16]; ld8(us + i * 16, a); ld8(us + i * 16 + 8, a + 8); ld8(vs + i * 16, b); ld8(vs + i * 16 + 8, b + 8);
#pragma unroll
      for (int q = 0; q < 16; ++q) { a[q] *= PEER_SU; b[q] *= PEER_SV; }
      const size_t o = ((size_t)s * NEXP + e) * 128 + cc;
      *(u32x4*)(ub + o) = (u32x4){enc4(a[0], a[1], a[2], a[3]), enc4(a[4], a[5], a[6], a[7]), enc4(a[8], a[9], a[10], a[11]), enc4(a[12], a[13], a[14], a[15])};
      *(u32x4*)(vbf + o) = (u32x4){enc4(b[0], b[1], b[2], b[3]), enc4(b[4], b[5], b[6], b[7]), enc4(b[8], b[9], b[10], b[11]), enc4(b[12], b[13], b[14], b[15])}; }
  } break;
  case 6: {
    GemmDesc g = gemm_desc(XG, DM, (const u16*)(p.ws + WS_WQ) + (size_t)l * 2048 * DM, DM, DM);
    EpiBf16 e{PROJ, 2048};
    for (int it = vb; it < NMT * 16; it += nb) gemm_tile<0, 1>(g, (it / 16) * 256, (it % 16) * 128, lds, e);
  } break;
  case 7: {
    for (int it = vb; it < NMT * 16; it += nb) { const int mt = it / 16, hj = it % 16, j = hj & 1;
      GemmDesc g{}; g.A = PROJ + hj * 128; g.lda = 2048; g.Bt = (const u16*)(p.ws + WS_SUBK) + (size_t)(l * 2 + j) * 128 * 128; g.ldb = 128; g.KT = 2;
      EpiTop e{(float*)(p.ws + WS_TOP), hj};
      gemm_tile<0, 0>(g, mt * 256, 0, lds, e); }
  } break;
  case 8: peer_cand(p, l, vb, nb, lds); break;
  case 9: case 11: {
    const bool last = l == DEPTH - 1;
    float* xo = dry ? (float*)(p.ws + WS_PD) : p.out;
    int s0, s1, tb, ts;
    if ((nb & 7) == 0) { s0 = vb & 7; s1 = s0 + 1; tb = (vb >> 3) * 8 + wid; ts = (nb >> 3) * 8; } else { s0 = 0; s1 = 8; tb = vb * 8 + wid; ts = nb * 8; }
#pragma unroll 1
    for (int s = s0; s < s1; ++s) { if (sp == 9) peer_slice_phase<false>(p, s, tb, ts, lane, p.out, xo, last); else peer_slice_phase<true>(p, s, tb, ts, lane, p.out, xo, last); }
  } break;
  case 10: {
    const float* pd = (const float*)(p.ws + WS_PD); const float* eg = (const float*)(p.ws + WS_EGATE); u16* cc = (u16*)(p.ws + WS_CC);
    for (size_t i = (size_t)vb * NTHREADS + tid; i < (size_t)T * 128 / 4; i += (size_t)nb * NTHREADS) {
      f32x4 a = *(const f32x4*)(pd + i * 4);
#pragma unroll
      for (int s = 1; s < 8; ++s) a += *(const f32x4*)(pd + (size_t)s * T * 128 + i * 4);
      const f32x4 g = *(const f32x4*)(eg + i * 4);
      f32x4 o; o.x = gelu_erf(a.x * (1.f / PEER_SU)) * g.x * (1.f / PEER_SV); o.y = gelu_erf(a.y * (1.f / PEER_SU)) * g.y * (1.f / PEER_SV);
      o.z = gelu_erf(a.z * (1.f / PEER_SU)) * g.z * (1.f / PEER_SV); o.w = gelu_erf(a.w * (1.f / PEER_SU)) * g.w * (1.f / PEER_SV);
      *(u32x2*)(cc + i * 4) = (u32x2){pk2(o.x, o.y), pk2(o.z, o.w)}; }
  } break;
  }
}

#define XB_TMO      128
#define XB_XCNT(j)  (256  + 64 * (j))
#define XB_XSUB(j)  (1280 + 64 * (j))
#define XB_XGEN(j)  (2304 + 64 * (j))
#define XB_TOP      3328
#define XB_TOPGEN   3392
#define XCD_BAR_WORDS 3456
#define XB_SPIN_CAP (1u << 23)
DEVI unsigned xb_ld(unsigned* p) { return __hip_atomic_load(p, __ATOMIC_RELAXED, __HIP_MEMORY_SCOPE_AGENT); }
DEVI unsigned xb_add(unsigned* p, unsigned v) { return __hip_atomic_fetch_add(p, v, __ATOMIC_RELAXED, __HIP_MEMORY_SCOPE_AGENT); }
DEVI unsigned xb_xcc_id() { return (unsigned)__builtin_amdgcn_s_getreg((3 << 11) | 20) & 0xFu; }
#define XB_SPIN(cond, bar) do { unsigned _sp = 0; while (cond) { __builtin_amdgcn_s_sleep(1); \
    if ((++_sp & 255u) == 0u) { if (xb_ld(&(bar)[XB_TMO])) break; if (_sp > XB_SPIN_CAP) { atomicAdd(&(bar)[XB_TMO], 1u); break; } } } } while (0)
struct XcdBarrier { unsigned* bar; unsigned x; volatile unsigned* st; };
DEVI XcdBarrier xcd_barrier_post(unsigned* bar, volatile unsigned* st) {
  XcdBarrier b; b.bar = bar; b.x = xb_xcc_id(); b.st = st;
  if (threadIdx.x == 0) (void)xb_add(&bar[XB_XCNT(b.x)], 1u);
  return b;
}
DEVI void xcd_barrier_complete(unsigned* bar, unsigned x, unsigned& nloc, unsigned& nx) {
  const unsigned G = gridDim.x * gridDim.y * gridDim.z;
  unsigned sum, cnt, mine, sp = 0u;
  for (;;) {
    sum = 0u; cnt = 0u; mine = 0u;
#pragma unroll
    for (unsigned j = 0; j < 16; ++j) { const unsigned c = xb_ld(&bar[XB_XCNT(j)]); sum += c; cnt += (c > 0u) ? 1u : 0u; mine = (j == x) ? c : mine; }
    if (sum == G) break;
    __builtin_amdgcn_s_sleep(1);
    if ((++sp & 255u) == 0u) { if (xb_ld(&bar[XB_TMO])) break; if (sp > XB_SPIN_CAP) { atomicAdd(&bar[XB_TMO], 1u); break; } }
  }
  nloc = mine > 0u ? mine : 1u; nx = cnt > 0u ? cnt : 1u;
}
DEVI void xcd_barrier(const XcdBarrier& b) {
  asm volatile("s_waitcnt vmcnt(0)" ::: "memory");
  __syncthreads();
  if (threadIdx.x == 0) {
    unsigned* bar = b.bar;
    __builtin_amdgcn_s_waitcnt(0);
    unsigned nloc = b.st[0], nx = b.st[1];
    if (nloc == 0u) { xcd_barrier_complete(bar, b.x, nloc, nx); b.st[0] = nloc; b.st[1] = nx; }
    const unsigned old = xb_add(&bar[XB_XSUB(b.x)], 1u);
    const unsigned gen = old / nloc;
    if (old + 1u == (gen + 1u) * nloc) {
      __builtin_amdgcn_fence(__ATOMIC_RELEASE, "agent");
      asm volatile("s_waitcnt vmcnt(0)" ::: "memory");
      const unsigned og = xb_add(&bar[XB_TOP], 1u);
      const unsigned tg = og / nx;
      if (og + 1u == (tg + 1u) * nx) xb_add(&bar[XB_TOPGEN], 1u);
      else XB_SPIN(xb_ld(&bar[XB_TOPGEN]) == tg, bar);
      __builtin_amdgcn_fence(__ATOMIC_ACQUIRE, "agent");
      xb_add(&bar[XB_XGEN(b.x)], 1u);
      asm volatile("s_waitcnt vmcnt(0)" ::: "memory");
    } else {
      XB_SPIN(xb_ld(&bar[XB_XGEN(b.x)]) == gen, bar);
      __builtin_amdgcn_fence(__ATOMIC_ACQUIRE, "agent");
      asm volatile("s_waitcnt vmcnt(0)" ::: "memory");
    }
  }
  __syncthreads();
}

__global__ void __launch_bounds__(NTHREADS, 2) mega(Params p) {
  extern __shared__ __attribute__((aligned(16))) char smem[];
  cg::grid_group grid = cg::this_grid();
  const int nb = gridDim.x, vb = blockIdx.x;
  volatile unsigned* st = (volatile unsigned*)(smem + LDS_BYTES - 16);
  if (threadIdx.x == 0) { st[0] = 0u; st[1] = 0u; }
  __syncthreads();
  const XcdBarrier bar = xcd_barrier_post((unsigned*)p.ws, st);
#define GRID_BAR(first) do { if (first) grid.sync(); else xcd_barrier(bar); } while (0)
  for (int ph = p.ph_lo; ph < p.ph_hi; ++ph) {
#ifdef PROBE_DUP
    if (ph > 0 && ph < N_PHASES - 1 && ((PROBE_DUP >> ((ph - 1) % PH_PER_LAYER)) & 1)) { run_phase(p, ph + 100, vb, nb, smem); GRID_BAR(false); }
#endif
    run_phase(p, ph, vb, nb, smem);
    if (ph + 1 < p.ph_hi) GRID_BAR(ph == p.ph_lo);
  }
}

#ifndef N_LAUNCH_SPLIT
#define N_LAUNCH_SPLIT 0
#endif
extern "C" void kernel_launch(void* const* d_in, const int* in_sizes, int n_in, void* d_out, int out_size, void* d_ws, size_t ws_size, hipStream_t stream) {
  static int grid_blocks = 0;
  if (grid_blocks == 0) {
    if (n_in != 24 || out_size != T * DM || ws_size < WS_NEED) { fprintf(stderr, "kernel_launch: unexpected shapes n_in %d out %d ws %zu\n", n_in, out_size, ws_size); grid_blocks = -1; return; }
    int dev = 0, cus = 0, per_cu = 0;
    (void)hipGetDevice(&dev); (void)hipDeviceGetAttribute(&cus, hipDeviceAttributeMultiprocessorCount, dev);
    if (hipFuncSetAttribute((const void*)mega, hipFuncAttributeMaxDynamicSharedMemorySize, LDS_BYTES) != hipSuccess) { fprintf(stderr, "kernel_launch: hipFuncSetAttribute failed\n"); grid_blocks = -1; return; }
    if (hipOccupancyMaxActiveBlocksPerMultiprocessor(&per_cu, (const void*)mega, NTHREADS, LDS_BYTES) != hipSuccess || per_cu < 1) { fprintf(stderr, "kernel_launch: occupancy query failed (%d)\n", per_cu); grid_blocks = -1; return; }
    grid_blocks = cus * 1;
    fprintf(stderr, "kernel_launch: cus %d per_cu %d grid %d\n", cus, per_cu, grid_blocks);
  }
  if (grid_blocks < 0) return;
  if (hipMemsetAsync(d_ws, 0, 65536, stream) != hipSuccess) { fprintf(stderr, "kernel_launch: memset failed\n"); return; }
  Params p{};
  p.x = (const float*)d_in[0]; p.pos = (const int*)d_in[1]; p.norm_mix = (const float*)d_in[2]; p.w_in = (const float*)d_in[3]; p.q_norm = (const float*)d_in[4];
  p.w_uq = (const float*)d_in[5]; p.kv_norm = (const float*)d_in[6]; p.w_ukv = (const float*)d_in[7]; p.conv_w = (const float*)d_in[8]; p.conv_b = (const float*)d_in[9];
  p.lru_wa = (const float*)d_in[10]; p.lru_ba = (const float*)d_in[11]; p.lru_wx = (const float*)d_in[12]; p.lru_bx = (const float*)d_in[13]; p.lru_lambda = (const float*)d_in[14];
  p.swa_sink = (const float*)d_in[15]; p.grp_norm = (const float*)d_in[16]; p.w_out = (const float*)d_in[17]; p.norm_ffn = (const float*)d_in[18]; p.peer_wq = (const float*)d_in[19];
  p.peer_subkeys = (const float*)d_in[20]; p.peer_u = (const float*)d_in[21]; p.peer_v = (const float*)d_in[22]; p.norm_final = (const float*)d_in[23];
  p.out = (float*)d_out; p.ws = (unsigned char*)d_ws;
#if N_LAUNCH_SPLIT
  for (int ph = 0; ph < N_PHASES; ++ph) {
    p.ph_lo = ph; p.ph_hi = ph + 1;
    void* args[] = {&p};
    hipError_t e = hipLaunchCooperativeKernel((const void*)mega, dim3(grid_blocks), dim3(NTHREADS), args, LDS_BYTES, stream);
    if (e != hipSuccess) { fprintf(stderr, "kernel_launch: launch of phase %d failed: %s\n", ph, hipGetErrorString(e)); break; }
  }
#else
  p.ph_lo = 0; p.ph_hi = N_PHASES;
  void* args[] = {&p};
  hipError_t e = hipLaunchCooperativeKernel((const void*)mega, dim3(grid_blocks), dim3(NTHREADS), args, LDS_BYTES, stream);
  if (e != hipSuccess) fprintf(stderr, "kernel_launch: cooperative launch failed: %s (grid %d)\n", hipGetErrorString(e), grid_blocks);
#endif
}
```

```cpp
#include <hip/hip_runtime.h>
#include <hip/hip_cooperative_groups.h>
#include <cstdio>
#include <cstdint>
namespace cg = cooperative_groups;

#define DEVI __device__ __forceinline__
typedef unsigned short u16;
typedef short bf16x8 __attribute__((ext_vector_type(8)));
typedef short s16x4 __attribute__((ext_vector_type(4)));
typedef float f32x2 __attribute__((ext_vector_type(2)));
typedef float f32x4 __attribute__((ext_vector_type(4)));
typedef float f32x16 __attribute__((ext_vector_type(16)));
typedef unsigned u32x4 __attribute__((ext_vector_type(4)));
typedef unsigned u32x2 __attribute__((ext_vector_type(2)));
typedef __bf16 bf16x2_t __attribute__((ext_vector_type(2)));

constexpr int NB = 4, SEQ = 8192, T = NB * SEQ, DM = 1024, DEPTH = 2;
constexpr int MLA_H = 6, MLA_QK = 96, MLA_V = 64;
constexpr int LRU_W = 384;
constexpr int INW = 1696, INWP = 1792;
constexpr int PC_CQ = 0, PC_CKV = 256, PC_SQ = 384, PC_SK = 640, PC_SV = 768, PC_LX = 896, PC_LG = 1280, PC_KR = 1664;
constexpr int OC_CQ = 0, OC_CKV = 256, OC_KR = 384, OC_SQ = 416, OC_SK = 672, OC_SV = 800, OC_LX = 928, OC_LG = 1312;
constexpr int NEXP = 16384;
constexpr float EPS = 1e-6f;
constexpr int NTHREADS = 512;
constexpr int LDS_BYTES = 160 * 1024;

constexpr size_t MiB = 1u << 20;
constexpr size_t WS_CTL = 0;
constexpr size_t WS_WIN = 4 * MiB;
constexpr size_t WS_WQ = 11 * MiB;
constexpr size_t WS_WOUT = 19 * MiB;
constexpr size_t WS_WUQ = 23 * MiB;
constexpr size_t WS_WUKV = WS_WUQ + 2 * 640 * 256 * 2;
constexpr size_t WS_WLRU = WS_WUKV + 2 * 768 * 128 * 2;
constexpr size_t WS_SUBK = WS_WLRU + 2 * 6 * 2 * 128 * 64 * 2;
constexpr size_t WS_XG = 25 * MiB;
constexpr size_t WS_R1 = 89 * MiB;
constexpr size_t WS_QM = 217 * MiB;
constexpr size_t WS_KM = 253 * MiB;
constexpr size_t WS_VM = 289 * MiB;
constexpr size_t WS_LE = 313 * MiB;
constexpr size_t WS_LB = 361 * MiB;
constexpr size_t WS_MIX = 409 * MiB;
constexpr size_t WS_UB = 217 * MiB;
constexpr size_t WS_VB = 233 * MiB;
constexpr size_t WS_TOP = 281 * MiB;
constexpr size_t WS_EIDX = 313 * MiB;
constexpr size_t WS_EGATE = 329 * MiB;
constexpr size_t WS_CC = 345 * MiB;
constexpr size_t WS_SSQ = 361 * MiB;
constexpr size_t WS_SSQ16 = 363 * MiB;
constexpr size_t WS_PD = 89 * MiB;
constexpr float PEER_SU = 256.f, PEER_SV = 16.f;
constexpr size_t WS_END = 473 * MiB;

__device__ const float ROPE_HI[32] = {1.591549367e-01f, 1.193493679e-01f, 8.949939907e-02f, 6.711508334e-02f, 5.032921210e-02f, 3.774158657e-02f, 2.830219641e-02f, 2.122365311e-02f, 1.591549441e-02f, 1.193493698e-02f, 8.949940093e-03f, 6.711508147e-03f, 5.032921210e-03f, 3.774158424e-03f, 2.830219688e-03f, 2.122365171e-03f, 1.591549488e-03f, 1.193493721e-03f, 8.949940093e-04f, 6.711508031e-04f, 5.032921326e-04f, 3.774158540e-04f, 2.830219455e-04f, 2.122365258e-04f, 1.591549371e-04f, 1.193493736e-04f, 8.949940093e-05f, 6.711508468e-05f, 5.032921035e-05f, 3.774158540e-05f, 2.830219637e-05f, 2.122365186e-05f};
__device__ const float ROPE_LO[32] = {6.420638243e-09f, 2.294664903e-09f, 2.542919653e-09f, -3.316028840e-10f, 5.173299289e-12f, -1.848551645e-09f, -5.826552019e-10f, -3.431038786e-10f, -1.029942243e-10f, 4.320196978e-11f, 6.802744479e-11f, 1.531042237e-10f, 5.173301024e-13f, 4.797548470e-11f, -1.048316434e-10f, 1.053879969e-10f, -5.686555046e-11f, -1.896286773e-11f, 6.802744999e-12f, 2.695195456e-11f, -1.158979943e-11f, -6.843983713e-12f, 1.279990003e-11f, 1.807650600e-12f, 5.954976963e-12f, -3.351478166e-12f, 6.802744674e-13f, -1.670379113e-12f, 1.751403167e-12f, -6.843983930e-13f, -5.389994549e-13f, 9.083608431e-13f};

DEVI int tidx() { int t = __builtin_amdgcn_workitem_id_x(); asm volatile("" : "+v"(t)); return t; }
DEVI float bf2f(unsigned h) { return __uint_as_float(h << 16); }
DEVI float bflo(unsigned w) { return __uint_as_float(w << 16); }
DEVI float bfhi(unsigned w) { return __uint_as_float(w & 0xffff0000u); }
DEVI unsigned pk2(float lo, float hi) { f32x2 v = {lo, hi}; bf16x2_t b = __builtin_convertvector(v, bf16x2_t); return __builtin_bit_cast(unsigned, b); }
DEVI u16 f2bf(float f) { return (u16)(pk2(f, 0.f) & 0xffffu); }
DEVI u32x4 pk8(const float* v) { u32x4 w; w.x = pk2(v[0], v[1]); w.y = pk2(v[2], v[3]); w.z = pk2(v[4], v[5]); w.w = pk2(v[6], v[7]); return w; }
DEVI void unpk8(u32x4 w, float* v) { v[0] = bflo(w.x); v[1] = bfhi(w.x); v[2] = bflo(w.y); v[3] = bfhi(w.y); v[4] = bflo(w.z); v[5] = bfhi(w.z); v[6] = bflo(w.w); v[7] = bfhi(w.w); }
DEVI void ld8(const float* p, float* v) { const f32x4 a = *(const f32x4*)p, b = *(const f32x4*)(p + 4); v[0] = a.x; v[1] = a.y; v[2] = a.z; v[3] = a.w; v[4] = b.x; v[5] = b.y; v[6] = b.z; v[7] = b.w; }
DEVI int crow(int r, int hi) { return (r & 3) + 8 * (r >> 2) + 4 * hi; }
DEVI float wave_sum(float v) {
#pragma unroll
  for (int o = 1; o < 64; o <<= 1) v += __shfl_xor(v, o);
  return v;
}
DEVI void rope_sc(float pos, int fidx, float& sn, float& cs) {
  const float chi = ROPE_HI[fidx], clo = ROPE_LO[fidx];
  const float t = pos * chi, e = fmaf(pos, chi, -t);
  float fr = t - rintf(t);
  fr = fr + (e + pos * clo);
  sn = __builtin_amdgcn_sinf(fr); cs = __builtin_amdgcn_cosf(fr);
}
DEVI float sigmoidf_(float x) { return 1.f / (1.f + __expf(-x)); }
DEVI float gelu_erf(float x) { return 0.5f * x * (1.f + erff(x * 0.70710678118654752f)); }

struct Params {
  const float* x; const int* pos; const float* norm_mix; const float* w_in; const float* q_norm; const float* w_uq; const float* kv_norm; const float* w_ukv;
  const float* conv_w; const float* conv_b; const float* lru_wa; const float* lru_ba; const float* lru_wx; const float* lru_bx; const float* lru_lambda;
  const float* swa_sink; const float* grp_norm; const float* w_out; const float* norm_ffn; const float* peer_wq; const float* peer_subkeys;
  const float* peer_u; const float* peer_v; const float* norm_final;
  float* out; unsigned char* ws;
  int ph_lo, ph_hi;
};

DEVI void tconv_item(const float* W, int ldw, int src_c0, u16* WT, int K, int dst_r0, const float* gain, float* scr, int kb, int nb, int lane, int pg = 0) {
  const int k0 = 64 * kb, n0 = 32 * nb;
#pragma unroll 8
  for (int i = 0; i < 32; ++i) { const int kk = 2 * i + (lane >> 5); float g = gain ? gain[k0 + kk] : 1.f; scr[kk * 33 + (lane & 31)] = g * W[(size_t)(k0 + kk) * ldw + src_c0 + n0 + (lane & 31)]; }
  __builtin_amdgcn_s_waitcnt(0xc07f); asm volatile("" ::: "memory");
  const int c = lane & 7;
#pragma unroll
  for (int j = 0; j < 4; ++j) { const int n = (lane >> 3) + 8 * j; const float* s = scr + (8 * c) * 33 + n;
    u32x4 o; o.x = pk2(s[0 * 33], s[1 * 33]); o.y = pk2(s[2 * 33], s[3 * 33]); o.z = pk2(s[4 * 33], s[5 * 33]); o.w = pk2(s[6 * 33], s[7 * 33]);
    int nn = n0 + n; if (pg) { const int g = nn & ~(pg - 1), i = nn & (pg - 1), hw = pg >> 1; nn = g + (i < hw ? 2 * i : 2 * (i - hw) + 1); }
    *(u32x4*)(WT + (size_t)(dst_r0 + nn) * K + k0 + 8 * c) = o; }
  __builtin_amdgcn_s_waitcnt(0xc07f); asm volatile("" ::: "memory");
}

DEVI void p0_item(const Params& p, int it, float* scr, int lane) {
  const int l = it / 2552; int r = it - l * 2552;
  const float* win = p.w_in + (size_t)l * DM * INW; u16* wint = (u16*)(p.ws + WS_WIN) + (size_t)l * INWP * DM; const float* gm = p.norm_mix + l * DM;
#define SEG(W, ldw, sc0, ncols, WT, K, dr0, gain, pg) { const int nnb_ = (ncols) / 32, ni_ = ((K) / 64) * nnb_; if (r < ni_) { tconv_item(W, ldw, sc0, WT, K, dr0, gain, scr, r / nnb_, r % nnb_, lane, pg); return; } r -= ni_; }
  SEG(win, INW, OC_CQ, 256, wint, DM, PC_CQ, gm, 0)
  SEG(win, INW, OC_CKV, 128, wint, DM, PC_CKV, gm, 0)
  SEG(win, INW, OC_SQ, 256, wint, DM, PC_SQ, gm, 64)
  SEG(win, INW, OC_SK, 128, wint, DM, PC_SK, gm, 64)
  SEG(win, INW, OC_SV, 128, wint, DM, PC_SV, gm, 0)
  SEG(win, INW, OC_LX, 384, wint, DM, PC_LX, gm, 0)
  SEG(win, INW, OC_LG, 384, wint, DM, PC_LG, gm, 0)
  SEG(win, INW, OC_KR, 32, wint, DM, PC_KR, gm, 32)
  SEG(p.peer_wq + (size_t)l * DM * 2048, 2048, 0, 2048, (u16*)(p.ws + WS_WQ) + (size_t)l * 2048 * DM, DM, 0, p.norm_ffn + l * DM, 0)
  SEG(p.w_out + (size_t)l * DM * DM, DM, 0, DM, (u16*)(p.ws + WS_WOUT) + (size_t)l * DM * DM, DM, 0, p.grp_norm + l * DM, 0)
  SEG(p.w_uq + (size_t)l * 256 * 576, 576, 0, 576, (u16*)(p.ws + WS_WUQ) + (size_t)l * 640 * 256, 256, 0, p.q_norm + l * 256, 0)
  SEG(p.w_ukv + (size_t)l * 128 * 768, 768, 0, 768, (u16*)(p.ws + WS_WUKV) + (size_t)l * 768 * 128, 128, 0, p.kv_norm + l * 128, 0)
#undef SEG
  { const int nbk = r & 1, ax = (r >> 1) & 1, n = (r >> 2) % 6, d = (r >> 2) / 6;
    const float* W = (ax ? p.lru_wx : p.lru_wa) + ((size_t)(l * 2 + d) * 6 + n) * 4096;
    u16* WT = (u16*)(p.ws + WS_WLRU) + ((size_t)((l * 6 + n) * 2 + d)) * 128 * 64;
    tconv_item(W, 64, 0, WT, 64, ax * 64, nullptr, scr, 0, nbk, lane); }
}

DEVI void phase0(const Params& p, int vb, int nb, char* lds) {
  const int tid = tidx(), lane = tid & 63, wid = tid >> 6;
  float* scr = (float*)(lds + wid * 16384);
  const int gw = vb * 8 + wid, ngw = nb * 8;
  for (int it = gw; it < DEPTH * 2552; it += ngw) p0_item(p, it, scr, lane);
  for (int i = vb * NTHREADS + tid; i < DEPTH * 96 * DM / 8; i += nb * NTHREADS) { const int l = i / (96 * DM / 8), r = i % (96 * DM / 8);
    *(u32x4*)((u16*)(p.ws + WS_WIN) + ((size_t)l * INWP + INW) * DM + (size_t)r * 8) = (u32x4){0, 0, 0, 0}; }
  for (int i = vb * NTHREADS + tid; i < DEPTH * 64 * 256 / 8; i += nb * NTHREADS) { const int l = i / (64 * 256 / 8), r = i % (64 * 256 / 8);
    *(u32x4*)((u16*)(p.ws + WS_WUQ) + ((size_t)l * 640 + 576) * 256 + (size_t)r * 8) = (u32x4){0, 0, 0, 0}; }
  for (int i = vb * NTHREADS + tid; i < DEPTH * 2 * 128 * 128 / 8; i += nb * NTHREADS) {
    float a[8]; ld8(p.peer_subkeys + (size_t)i * 8, a);
    *(u32x4*)((u16*)(p.ws + WS_SUBK) + (size_t)i * 8) = pk8(a); }
  { float* ssq = (float*)(p.ws + WS_SSQ); u16* xg = (u16*)(p.ws + WS_XG);
    for (int t = gw * 2; t < T; t += ngw * 2) {
      float a[2][16];
#pragma unroll
      for (int u = 0; u < 2; ++u) { ld8(p.x + (size_t)(t + u) * DM + lane * 16, a[u]); ld8(p.x + (size_t)(t + u) * DM + lane * 16 + 8, a[u] + 8); }
#pragma unroll
      for (int u = 0; u < 2; ++u) { float s = 0.f;
#pragma unroll
        for (int q = 0; q < 16; ++q) s = fmaf(a[u][q], a[u][q], s);
        s += __shfl_xor(s, 1); s += __shfl_xor(s, 2); s += __shfl_xor(s, 4);
        if ((lane & 7) == 0) ssq[(size_t)(t + u) * 8 + (lane >> 3)] = s;
        u32x4* o = (u32x4*)(xg + (size_t)(t + u) * DM + lane * 16); o[0] = pk8(a[u]); o[1] = pk8(a[u] + 8); } } }
}

DEVI int swz(int row, int c) { return row * 128 + ((c ^ ((row >> 1) & 7)) << 4); }
constexpr int CLD = 132;
constexpr int LDS_RS = 135168;

struct GemmDesc {
  const u16* A; int lda; const u16* Bt; int ldb; int KT;
  float inv0;
  const u16* proj; const float* cw; const float* cb; int ch0;
};

template <int AMODE> DEVI bf16x8 load_a(const GemmDesc& g, int row, int kcol) {
  if constexpr (AMODE == 0) {
    return *(const bf16x8*)(g.A + (size_t)row * g.lda + kcol);
  } else {
    const int s = row & (SEQ - 1), ch = g.ch0 + kcol;
    float a[8];
    { const f32x4 b0 = *(const f32x4*)(g.cb + ch), b1 = *(const f32x4*)(g.cb + ch + 4); a[0] = b0.x; a[1] = b0.y; a[2] = b0.z; a[3] = b0.w; a[4] = b1.x; a[5] = b1.y; a[6] = b1.z; a[7] = b1.w; }
#pragma unroll
    for (int tap = 0; tap < 4; ++tap) {
      const int ss = s - 1 + tap;
      if (ss >= 0 && ss < SEQ) {
        const u32x4 v = *(const u32x4*)(g.proj + (size_t)(row - 1 + tap) * INWP + PC_LX + ch);
        float x[8]; unpk8(v, x);
        const f32x4 w0 = *(const f32x4*)(g.cw + tap * LRU_W + ch), w1 = *(const f32x4*)(g.cw + tap * LRU_W + ch + 4);
        a[0] += w0.x * x[0]; a[1] += w0.y * x[1]; a[2] += w0.z * x[2]; a[3] += w0.w * x[3];
        a[4] += w1.x * x[4]; a[5] += w1.y * x[5]; a[6] += w1.z * x[6]; a[7] += w1.w * x[7];
      }
    }
    const u32x4 o = pk8(a);
    return __builtin_bit_cast(bf16x8, o);
  }
}

template <int AMODE> DEVI void g_load(const GemmDesc& g, bf16x8 (&ar)[4], bf16x8 (&br)[2], int m0, int n0, int srow, int sc, int kt) {
#pragma unroll
  for (int i = 0; i < 4; ++i) ar[i] = load_a<AMODE>(g, m0 + srow + 64 * i, kt * 64 + sc * 8);
#pragma unroll
  for (int i = 0; i < 2; ++i) br[i] = *(const bf16x8*)(g.Bt + (size_t)(n0 + srow + 64 * i) * g.ldb + kt * 64 + sc * 8);
}
template <bool NORM> DEVI void g_write(char* Ab, const bf16x8 (&ar)[4], const bf16x8 (&br)[2], float (&ssq)[4], int srow, int sc) {
  char* Bb = Ab + 32768;
#pragma unroll
  for (int i = 0; i < 4; ++i) { *(bf16x8*)(Ab + swz(srow + 64 * i, sc)) = ar[i];
    if (NORM) { float x[8]; unpk8(__builtin_bit_cast(u32x4, ar[i]), x); float s = ssq[i];
#pragma unroll
      for (int q = 0; q < 8; ++q) s = fmaf(x[q], x[q], s);
      ssq[i] = s; } }
#pragma unroll
  for (int i = 0; i < 2; ++i) *(bf16x8*)(Bb + swz(srow + 64 * i, sc)) = br[i];
}

template <int AMODE, int SEG, class Epi>
DEVI void gemm_tile(const GemmDesc& g, int m0, int n0, char* lds, const Epi& epi) {
  const int tid = tidx(), lane = tid & 63, wid = tid >> 6;
  const int wm = wid >> 1, wn = wid & 1, r32 = lane & 31, hi = lane >> 5;
  const int srow = tid >> 3, sc = tid & 7;
  constexpr bool NORM = SEG != 0;
  float* rs = (float*)(lds + LDS_RS);
  f32x16 acc[2][2], acc2[2][2];
#pragma unroll
  for (int i = 0; i < 2; ++i)
#pragma unroll
    for (int j = 0; j < 2; ++j) { acc[i][j] = f32x16{}; acc2[i][j] = f32x16{}; }
  float ssq[4] = {0.f, 0.f, 0.f, 0.f};
  bf16x8 ar[4], br[2];
  g_load<AMODE>(g, ar, br, m0, n0, srow, sc, 0); g_write<NORM>(lds, ar, br, ssq, srow, sc); __syncthreads();
  int seg = 0;
#pragma unroll 1
  for (int kt = 0; kt < g.KT; ++kt) {
    const int cur = kt & 1;
    if (kt + 1 < g.KT) g_load<AMODE>(g, ar, br, m0, n0, srow, sc, kt + 1);
    { const char* Ab = lds + cur * 49152; const char* Bb = Ab + 32768;
#pragma unroll
      for (int k16 = 0; k16 < 4; ++k16) {
        bf16x8 a[2], b[2];
#pragma unroll
        for (int mt = 0; mt < 2; ++mt) a[mt] = *(const bf16x8*)(Ab + swz(wm * 64 + mt * 32 + r32, k16 * 2 + hi));
#pragma unroll
        for (int nt = 0; nt < 2; ++nt) b[nt] = *(const bf16x8*)(Bb + swz(wn * 64 + nt * 32 + r32, k16 * 2 + hi));
#pragma unroll
        for (int mt = 0; mt < 2; ++mt)
#pragma unroll
          for (int nt = 0; nt < 2; ++nt) {
            if (NORM) acc2[mt][nt] = __builtin_amdgcn_mfma_f32_32x32x16_bf16(a[mt], b[nt], acc2[mt][nt], 0, 0, 0);
            else acc[mt][nt] = __builtin_amdgcn_mfma_f32_32x32x16_bf16(a[mt], b[nt], acc[mt][nt], 0, 0, 0);
          }
      } }
    if (NORM) {
      int se; float inv;
      if (SEG == 1) { se = g.KT; inv = g.inv0; }
      else { se = seg == 0 ? 6 : (seg == 1 ? 12 : 16); inv = seg == 2 ? (1.f / 256.f) : (1.f / 384.f); }
      if (kt + 1 == se) {
#pragma unroll
        for (int i = 0; i < 4; ++i) { float s = ssq[i]; s += __shfl_xor(s, 1); s += __shfl_xor(s, 2); s += __shfl_xor(s, 4); if (sc == 0) rs[srow + 64 * i] = rsqrtf(s * inv + EPS); }
        __syncthreads();
#pragma unroll
        for (int mt = 0; mt < 2; ++mt)
#pragma unroll
          for (int r = 0; r < 16; ++r) { const float f = rs[wm * 64 + mt * 32 + crow(r, hi)];
#pragma unroll
            for (int nt = 0; nt < 2; ++nt) { acc[mt][nt][r] = fmaf(f, acc2[mt][nt][r], acc[mt][nt][r]); acc2[mt][nt][r] = 0.f; } }
        ssq[0] = ssq[1] = ssq[2] = ssq[3] = 0.f;
        ++seg;
      }
    }
    if (kt + 1 < g.KT) g_write<NORM>(lds + (cur ^ 1) * 49152, ar, br, ssq, srow, sc);
    __syncthreads();
  }
  float* C = (float*)lds;
#pragma unroll
  for (int mt = 0; mt < 2; ++mt)
#pragma unroll
    for (int nt = 0; nt < 2; ++nt)
#pragma unroll
      for (int r = 0; r < 16; ++r) C[(wm * 64 + mt * 32 + crow(r, hi)) * CLD + wn * 64 + nt * 32 + r32] = acc[mt][nt][r];
  __syncthreads();
  epi(C, m0, n0);
  __syncthreads();
}

DEVI GemmDesc gemm_desc(const u16* A, int lda, const u16* Bt, int ldb, int K) {
  GemmDesc g{}; g.A = A; g.lda = lda; g.Bt = Bt; g.ldb = ldb; g.KT = K / 64; g.inv0 = 1.f / (float)K; return g;
}


template <int HW> DEVI void rope8(float* v, const float* pp, int i0, float posf) {
  const bool first = i0 < HW; const int f0 = i0 & (HW - 1);
#pragma unroll
  for (int j = 0; j < 8; ++j) { float sn, cs; rope_sc(posf, HW == 32 ? (f0 + j) : 2 * (f0 + j), sn, cs); const float pv = pp[j]; v[j] = first ? v[j] * cs - pv * sn : v[j] * cs + pv * sn; }
}

struct EpiP1 { u16* proj; const int* pos;
  DEVI void operator()(const float* C, int m0, int n0) const {
    const int tid = tidx();
#pragma unroll 1
    for (int it = 0; it < 8; ++it) { const int item = it * NTHREADS + tid, row = item >> 4, c8 = (item & 15) * 8, gcol = n0 + c8, grow = m0 + row;
      float v[8]; ld8(C + row * CLD + c8, v);
      const bool r64 = gcol >= PC_SQ && gcol < PC_SV, r32g = gcol >= PC_KR && gcol < PC_KR + 32;
      if (r64) { const int i0 = gcol & 63; float pp[8]; ld8(C + row * CLD + c8 + (i0 < 32 ? 32 : -32), pp); rope8<32>(v, pp, i0, (float)pos[grow]); }
      else if (r32g) { const int i0 = gcol & 31; float pp[8]; ld8(C + row * CLD + c8 + (i0 < 16 ? 16 : -16), pp); rope8<16>(v, pp, i0, (float)pos[grow]); }
      *(u32x4*)(proj + (size_t)grow * INWP + gcol) = pk8(v);
    }
  }
};

struct EpiQ { u16* qm; const int* pos;
  DEVI void operator()(const float* C, int m0, int n0) const {
    const int tid = tidx();
#pragma unroll 1
    for (int it = 0; it < 8; ++it) { const int item = it * NTHREADS + tid, row = item >> 4, c8 = (item & 15) * 8, gcol = n0 + c8, grow = m0 + row;
      if (gcol >= 576) continue;
      const int head = gcol / 96, j0 = gcol - head * 96, b = grow >> 13, s = grow & (SEQ - 1);
      float v[8]; ld8(C + row * CLD + c8, v);
      u16* qrow = qm + ((size_t)(b * MLA_H + head) * SEQ + s) * MLA_QK;
      if (j0 >= 64) { const int i0 = j0 - 64; float pp[8]; ld8(C + row * CLD + c8 + (i0 < 16 ? 16 : -16), pp); rope8<16>(v, pp, i0, (float)pos[grow]);
#pragma unroll
        for (int j = 0; j < 8; ++j) { const int i = i0 + j; qrow[64 + (i < 16 ? 2 * i : 2 * (i - 16) + 1)] = f2bf(v[j]); } }
      else *(u32x4*)(qrow + j0) = pk8(v);
    }
  }
};

struct EpiKV { u16* km; u16* vm; const u16* proj;
  DEVI void operator()(const float* C, int m0, int n0) const {
    const int tid = tidx(), head = n0 >> 7;
#pragma unroll 1
    for (int it = 0; it < 8; ++it) { const int item = it * NTHREADS + tid, row = item >> 4, c8 = (item & 15) * 8, grow = m0 + row;
      const int b = grow >> 13, s = grow & (SEQ - 1);
      float v[8]; ld8(C + row * CLD + c8, v);
      const size_t tok = (size_t)(b * MLA_H + head) * SEQ + s;
      if (c8 < 64) *(u32x4*)(km + tok * MLA_QK + c8) = pk8(v);
      else *(u32x4*)(vm + tok * MLA_V + (c8 - 64)) = pk8(v);
    }
#pragma unroll 1
    for (int it = 0; it < 2; ++it) { const int item = it * NTHREADS + tid, row = item >> 2, c = (item & 3) * 8, grow = m0 + row;
      const int b = grow >> 13, s = grow & (SEQ - 1);
      *(u32x4*)(km + ((size_t)(b * MLA_H + head) * SEQ + s) * MLA_QK + 64 + c) = *(const u32x4*)(proj + (size_t)grow * INWP + PC_KR + c);
    }
  }
};

struct EpiLRU { const u16* proj; const float* cw; const float* cb; const float* ba; const float* bx; const float* lam; u16* le; u16* lb; int n, d;
  DEVI void operator()(const float* C, int m0, int) const {
    const int tid = tidx();
#pragma unroll 1
    for (int it = 0; it < 4; ++it) { const int item = it * NTHREADS + tid, j = item & 63, g8 = item >> 6;
      const int ch = n * 64 + j, grow0 = m0 + g8 * 8, s0 = grow0 & (SEQ - 1), b = grow0 >> 13;
      const float bav = ba[(d * 6 + n) * 64 + j], bxv = bx[(d * 6 + n) * 64 + j];
      const float cdec = -8.f * log1pf(__expf(-lam[d * LRU_W + ch]));
      float xin[11];
#pragma unroll
      for (int q = 0; q < 11; ++q) { const int ss = s0 - 1 + q; xin[q] = (ss >= 0 && ss < SEQ) ? bf2f(proj[(size_t)(grow0 - 1 + q) * INWP + PC_LX + ch]) : 0.f; }
      const float w0 = cw[ch], w1 = cw[LRU_W + ch], w2 = cw[2 * LRU_W + ch], w3 = cw[3 * LRU_W + ch], cbv = cb[ch];
      float ev[8], bv[8];
#pragma unroll
      for (int rr = 0; rr < 8; ++rr) {
        const float xf = cbv + w0 * xin[rr] + w1 * xin[rr + 1] + w2 * xin[rr + 2] + w3 * xin[rr + 3];
        const float r = sigmoidf_(C[(g8 * 8 + rr) * CLD + j] + bav), ig = sigmoidf_(C[(g8 * 8 + rr) * CLD + 64 + j] + bxv);
        const float a = __expf(cdec * r), e = 1.f - a;
        ev[rr] = e; bv[rr] = sqrtf(e * (2.f - e)) * ig * xf;
      }
      const size_t o = (((size_t)(d * NB + b) * (SEQ / 8) + (s0 >> 3)) * LRU_W + ch) * 8;
      *(u32x4*)(le + o) = pk8(ev); *(u32x4*)(lb + o) = pk8(bv);
    }
  }
};

struct EpiP4 { const float* xres; float* xout; u16* xg;
  DEVI void operator()(const float* C, int m0, int n0) const {
    const int tid = tidx();
#pragma unroll 1
    for (int it = 0; it < 8; ++it) { const int item = it * NTHREADS + tid, row = item >> 4, c8 = (item & 15) * 8, gcol = n0 + c8, grow = m0 + row;
      float v[8], x[8]; ld8(C + row * CLD + c8, v); ld8(xres + (size_t)grow * DM + gcol, x);
#pragma unroll
      for (int j = 0; j < 8; ++j) v[j] += x[j];
      *(f32x4*)(xout + (size_t)grow * DM + gcol) = (f32x4){v[0], v[1], v[2], v[3]}; *(f32x4*)(xout + (size_t)grow * DM + gcol + 4) = (f32x4){v[4], v[5], v[6], v[7]};
      *(u32x4*)(xg + (size_t)grow * DM + gcol) = pk8(v);
    }
  }
};

struct EpiBf16 { u16* o; int ldo;
  DEVI void operator()(const float* C, int m0, int n0) const {
    const int tid = tidx();
#pragma unroll 1
    for (int it = 0; it < 8; ++it) { const int item = it * NTHREADS + tid, row = item >> 4, c8 = (item & 15) * 8;
      float v[8]; ld8(C + row * CLD + c8, v);
      *(u32x4*)(o + (size_t)(m0 + row) * ldo + n0 + c8) = pk8(v);
    }
  }
};

DEVI void ce_desc(float& a, float& b) { const float mx = fmaxf(a, b), mn = fminf(a, b); a = mx; b = mn; }
struct EpiTop { float* top; int hj;
  DEVI void operator()(const float* C, int m0, int) const {
    const int tid = tidx(), row = tid >> 1, part = tid & 1;
    float l[16];
#pragma unroll
    for (int i = 0; i < 16; ++i) l[i] = -3.0e38f;
#pragma unroll 4
    for (int c = 0; c < 64; ++c) { const int col = part * 64 + ((c + row) & 63);
      float v = __uint_as_float((__float_as_uint(C[row * CLD + col]) & ~127u) | (unsigned)(127 - col));
#pragma unroll
      for (int i = 0; i < 16; ++i) { const float t = fmaxf(l[i], v); v = fminf(l[i], v); l[i] = t; } }
    float m[16];
#pragma unroll
    for (int i = 0; i < 16; ++i) m[i] = __shfl_xor(l[15 - i], 1);
#pragma unroll
    for (int i = 0; i < 16; ++i) m[i] = fmaxf(m[i], l[i]);
#pragma unroll
    for (int st = 8; st >= 1; st >>= 1)
#pragma unroll
      for (int i = 0; i < 16; ++i) if ((i & st) == 0) ce_desc(m[i], m[i + st]);
    if (part == 0) { float* o = top + ((size_t)(m0 + row) * 16 + hj) * 16;
#pragma unroll
      for (int i = 0; i < 4; ++i) *(f32x4*)(o + 4 * i) = (f32x4){m[4 * i], m[4 * i + 1], m[4 * i + 2], m[4 * i + 3]}; }
  }
};

#define KSWZ(row, colB) ((row) * 256 + ((colB) ^ (((row) & 7) << 4)))
#define SBAR() __builtin_amdgcn_sched_barrier(0)
constexpr int AT_SHM_V = 64 * 64 * 2, AT_SHM_K = 64 * 128 * 2;
constexpr int AT_LDS = 2 * AT_SHM_V + 2 * AT_SHM_K + 8 * 64 * 4;
constexpr float ATT_THR = 8.f;
DEVI unsigned cvtpk(float lo, float hi) { unsigned r; asm volatile("v_cvt_pk_bf16_f32 %0, %1, %2" : "=v"(r) : "v"(lo), "v"(hi)); return r; }
DEVI int v_st(int k, int c) { const int kk = (k & ~0xC) | ((k & 4) << 1) | ((k & 8) >> 1); return ((kk >> 3) * 2 + (c >> 5)) * 512 + ((kk & 7) * 32 + (c & 31)) * 2; }
DEVI int v_rd_base(int lane) { return ((lane & 3) << 3) | (((lane >> 2) & 3) << 6) | (((lane >> 4) & 1) << 5) | (((lane >> 5) & 1) << 8); }
constexpr int v_rd_off(int d0, int ks, int half) { return d0 * 512 + ks * 2048 + half * 1024; }
template <int OFF> DEVI s16x4 tr_read(int vb) { s16x4 r; asm volatile("ds_read_b64_tr_b16 %0, %1 offset:%2" : "=&v"(r) : "v"(vb), "i"(OFF) : "memory"); return r; }

template <bool MASK>
DEVI void partialSM(f32x16& p0, f32x16& p1, float& m_reg, float& mn, float& alpha, float SCALE, int kpos0, int qpos, int hi) {
  const float C = SCALE * 1.4426950408889634f;
  if (MASK) {
#pragma unroll
    for (int r = 0; r < 16; ++r) { const int k0 = kpos0 + crow(r, hi) - qpos; const int k1 = k0 + 32;
      if (k0 > 128 || k0 < -128) p0[r] = -1e30f;
      if (k1 > 128 || k1 < -128) p1[r] = -1e30f; }
  }
  float pmax = p0[0];
#pragma unroll
  for (int r = 1; r < 16; ++r) pmax = fmaxf(pmax, p0[r]);
#pragma unroll
  for (int r = 0; r < 16; ++r) pmax = fmaxf(pmax, p1[r]);
  { auto rr = __builtin_amdgcn_permlane32_swap(__float_as_uint(pmax), __float_as_uint(pmax), false, false);
    pmax = fmaxf(__uint_as_float(rr[0]), __uint_as_float(rr[1])); }
  if (__builtin_expect(__all(pmax - m_reg <= ATT_THR / SCALE), 1)) { mn = m_reg; alpha = 1.f; }
  else { mn = fmaxf(m_reg, pmax); alpha = __builtin_amdgcn_exp2f((m_reg - mn) * C); m_reg = mn; }
  const float mnC = -mn * C;
#pragma unroll
  for (int r = 0; r < 16; ++r) p0[r] = fmaf(p0[r], C, mnC);
#pragma unroll
  for (int r = 0; r < 16; ++r) p1[r] = fmaf(p1[r], C, mnC);
#pragma unroll
  for (int r = 0; r < 16; ++r) p0[r] = __builtin_amdgcn_exp2f(p0[r]);
}
DEVI void finishSM(f32x16& p0, f32x16& p1, float alpha, float& l_reg, bf16x8& pa0, bf16x8& pa1, bf16x8& pa2, bf16x8& pa3) {
#pragma unroll
  for (int r = 0; r < 16; ++r) p1[r] = __builtin_amdgcn_exp2f(p1[r]);
  float ps = 0;
#pragma unroll
  for (int r = 0; r < 16; ++r) ps += p0[r];
#pragma unroll
  for (int r = 0; r < 16; ++r) ps += p1[r];
  { auto rr = __builtin_amdgcn_permlane32_swap(__float_as_uint(ps), __float_as_uint(ps), false, false);
    ps = __uint_as_float(rr[0]) + __uint_as_float(rr[1]); }
  l_reg = l_reg * alpha + ps;
#define PK4(P, BASE, OUT) do { unsigned a0 = cvtpk(P[BASE + 0], P[BASE + 1]), a1 = cvtpk(P[BASE + 2], P[BASE + 3]);   \
    unsigned b0 = cvtpk(P[BASE + 4], P[BASE + 5]), b1 = cvtpk(P[BASE + 6], P[BASE + 7]);                              \
    auto r0 = __builtin_amdgcn_permlane32_swap(a0, b0, false, false); auto r1 = __builtin_amdgcn_permlane32_swap(a1, b1, false, false); \
    u32x4 w = {r0[0], r1[0], r0[1], r1[1]}; OUT = __builtin_bit_cast(bf16x8, w); } while (0)
  PK4(p0, 0, pa0); PK4(p0, 8, pa1); PK4(p1, 0, pa2); PK4(p1, 8, pa3);
#undef PK4
}
template <int ND0>
DEVI void qkt(f32x16& p0, f32x16& p1, const char* Ks, const bf16x8* qr, int r32, int hi) {
  p0 = f32x16{}; p1 = f32x16{};
#pragma unroll
  for (int d0 = 0; d0 < ND0; ++d0) { const int cb = (d0 * 16 + hi * 8) * 2;
    const bf16x8 b0 = *(const bf16x8*)(Ks + KSWZ(r32, cb));
    const bf16x8 b1 = *(const bf16x8*)(Ks + KSWZ(32 + r32, cb));
    p0 = __builtin_amdgcn_mfma_f32_32x32x16_bf16(b0, qr[d0], p0, 0, 0, 0);
    p1 = __builtin_amdgcn_mfma_f32_32x32x16_bf16(b1, qr[d0], p1, 0, 0, 0); }
}
template <int D0> DEVI void pv_one(f32x16& od, int vb, bf16x8 pa0, bf16x8 pa1, bf16x8 pa2, bf16x8 pa3) {
  const s16x4 l0 = tr_read<v_rd_off(D0, 0, 0)>(vb), h0 = tr_read<v_rd_off(D0, 0, 1)>(vb), l1 = tr_read<v_rd_off(D0, 1, 0)>(vb), h1 = tr_read<v_rd_off(D0, 1, 1)>(vb);
  const s16x4 l2 = tr_read<v_rd_off(D0, 2, 0)>(vb), h2 = tr_read<v_rd_off(D0, 2, 1)>(vb), l3 = tr_read<v_rd_off(D0, 3, 0)>(vb), h3 = tr_read<v_rd_off(D0, 3, 1)>(vb);
  asm volatile("s_waitcnt lgkmcnt(0)" ::: "memory"); SBAR();
#define PK(L, H) (bf16x8){L[0], L[1], L[2], L[3], H[0], H[1], H[2], H[3]}
  od = __builtin_amdgcn_mfma_f32_32x32x16_bf16(pa0, PK(l0, h0), od, 0, 0, 0);
  od = __builtin_amdgcn_mfma_f32_32x32x16_bf16(pa1, PK(l1, h1), od, 0, 0, 0);
  od = __builtin_amdgcn_mfma_f32_32x32x16_bf16(pa2, PK(l2, h2), od, 0, 0, 0);
  od = __builtin_amdgcn_mfma_f32_32x32x16_bf16(pa3, PK(l3, h3), od, 0, 0, 0);
#undef PK
}
DEVI void pv_d0(f32x16* o, int vb, bf16x8 pa0, bf16x8 pa1, bf16x8 pa2, bf16x8 pa3) {
  pv_one<0>(o[0], vb, pa0, pa1, pa2, pa3); pv_one<1>(o[1], vb, pa0, pa1, pa2, pa3);
}

template <int DQK, bool MASK>
DEVI void attn_body(const u16* Qw, const u16* Kh, int ldk, const u16* Vh, int ldv, int kt0, int NT, float SCALE, float m_init, float l_init,
                    int qpos, u16* Ow, char* lds) {
  constexpr int ND0 = DQK / 16, NCK = DQK / 8, NK2 = 64 * NCK - NTHREADS;
  const int tid = tidx(), wid = tid >> 6, lane = tid & 63, r32 = lane & 31, hi = lane >> 5;
  char* V_lds = lds; char* K_lds = lds + 2 * AT_SHM_V;
  float* wsx = (float*)(lds + 2 * AT_SHM_V + 2 * AT_SHM_K) + wid * 64; float* li_l = wsx; float* al_l = wsx + 32;
  float m_reg = m_init, l_reg = l_init; f32x16 o[2] = {f32x16{}, f32x16{}}; bf16x8 qr[ND0];
#pragma unroll
  for (int d0 = 0; d0 < ND0; ++d0) qr[d0] = *(const bf16x8*)(Qw + d0 * 16);
  const int vr = tid >> 3, vc = (tid & 7) * 8, vst0 = v_st(vr, vc);
  const int k0r = tid / NCK, k0c = tid - k0r * NCK;
  const int k1id = tid + NTHREADS, k1r = k1id / NCK, k1c = k1id - k1r * NCK; const bool has2 = tid < NK2;
  const int vb0 = (int)(uintptr_t)V_lds + v_rd_base(lane);
  bf16x8 sv[2], sk0[2], sk1[2];
#define SLOAD(i, t_) do { const size_t kk0 = (size_t)(t_) * 64; sv[i] = *(const bf16x8*)(Vh + (kk0 + vr) * ldv + vc); \
    sk0[i] = *(const bf16x8*)(Kh + (kk0 + k0r) * ldk + k0c * 8); if (NK2 > 0) { if (has2) sk1[i] = *(const bf16x8*)(Kh + (kk0 + k1r) * ldk + k1c * 8); } } while (0)
#define SWRITE(b, i) do { *(bf16x8*)(V_lds + (b) * AT_SHM_V + vst0) = sv[i]; *(bf16x8*)(K_lds + (b) * AT_SHM_K + KSWZ(k0r, k0c * 16)) = sk0[i]; \
    if (NK2 > 0) { if (has2) *(bf16x8*)(K_lds + (b) * AT_SHM_K + KSWZ(k1r, k1c * 16)) = sk1[i]; } } while (0)
#define RESC(a) do { if (__any((a) < 1.f)) { if (hi == 0) al_l[r32] = (a); asm volatile("s_waitcnt lgkmcnt(0)" ::: "memory"); \
    _Pragma("unroll") for (int d = 0; d < 2; ++d) _Pragma("unroll") for (int r = 0; r < 16; ++r) o[d][r] *= al_l[crow(r, hi)]; } } while (0)
  f32x16 pA0, pA1, pB0, pB1; float mnA, mnB, alA, alB; bf16x8 pa0, pa1, pa2, pa3;
  constexpr int SE = 0, SO = 1;
  SLOAD(SE, kt0); asm volatile("s_waitcnt vmcnt(0)" ::: "memory"); SWRITE(0, SE); __syncthreads();
  qkt<ND0>(pA0, pA1, K_lds, qr, r32, hi); partialSM<MASK>(pA0, pA1, m_reg, mnA, alA, SCALE, kt0 * 64, qpos, hi);
  SLOAD(SO, kt0 + 1); if (2 < NT) SLOAD(SE, kt0 + 2);
  SWRITE(1, SO); __syncthreads();
  for (int j = 1; j + 1 < NT; j += 2) {
    SBAR(); qkt<ND0>(pB0, pB1, K_lds + AT_SHM_K, qr, r32, hi);
    finishSM(pA0, pA1, alA, l_reg, pa0, pa1, pa2, pa3); SBAR();
    SLOAD(SO, kt0 + j + 2); SBAR();
    pv_d0(o, vb0, pa0, pa1, pa2, pa3); partialSM<MASK>(pB0, pB1, m_reg, mnB, alB, SCALE, (kt0 + j) * 64, qpos, hi);
    __syncthreads(); SWRITE(0, SE);
    RESC(alB); __syncthreads();
    SBAR(); qkt<ND0>(pA0, pA1, K_lds, qr, r32, hi);
    finishSM(pB0, pB1, alB, l_reg, pa0, pa1, pa2, pa3); SBAR();
    if (j + 3 < NT) SLOAD(SE, kt0 + j + 3); SBAR();
    pv_d0(o, vb0 + AT_SHM_V, pa0, pa1, pa2, pa3); partialSM<MASK>(pA0, pA1, m_reg, mnA, alA, SCALE, (kt0 + j + 1) * 64, qpos, hi);
    __syncthreads(); SWRITE(1, SO);
    RESC(alA); __syncthreads();
  }
  SBAR(); qkt<ND0>(pB0, pB1, K_lds + AT_SHM_K, qr, r32, hi);
  finishSM(pA0, pA1, alA, l_reg, pa0, pa1, pa2, pa3); SBAR();
  pv_d0(o, vb0, pa0, pa1, pa2, pa3); partialSM<MASK>(pB0, pB1, m_reg, mnB, alB, SCALE, (kt0 + NT - 1) * 64, qpos, hi);
  __syncthreads(); RESC(alB);
  finishSM(pB0, pB1, alB, l_reg, pa0, pa1, pa2, pa3); SBAR();
  pv_d0(o, vb0 + AT_SHM_V, pa0, pa1, pa2, pa3);
  if (hi == 0) li_l[r32] = l_reg; asm volatile("s_waitcnt lgkmcnt(0)" ::: "memory");
  float rli[16];
#pragma unroll
  for (int r = 0; r < 16; ++r) rli[r] = __builtin_amdgcn_rcpf(li_l[crow(r, hi)]);
#pragma unroll
  for (int r = 0; r < 16; ++r) { const int orow = crow(r, hi);
#pragma unroll
    for (int d0 = 0; d0 < 2; ++d0) Ow[(size_t)orow * DM + d0 * 32 + r32] = f2bf(o[d0][r] * rli[r]); }
  __syncthreads();
#undef SLOAD
#undef SWRITE
#undef RESC
}

constexpr int LCH = 64, NLCH = SEQ / LCH;
constexpr size_t WS_LP = 1 * MiB, WS_LH = 2560 * 1024;
constexpr size_t WS_LC = 473 * MiB;
constexpr size_t WS_NEED = 475 * MiB;
DEVI void lru_passA(const Params& p, int item, int lane) {
  const int cg = item % 6, c = (item / 6) % NLCH, b = (item / (6 * NLCH)) % NB, d = item / (6 * NLCH * NB);
  const size_t base = (((size_t)(d * NB + b) * (SEQ / 8) + c * 8) * LRU_W + cg * 64 + lane) * 8;
  const u16* E = (const u16*)(p.ws + WS_LE) + base; const u16* Bp = (const u16*)(p.ws + WS_LB) + base;
  u32x4 ev[8], bv[8];
#pragma unroll
  for (int g = 0; g < 8; ++g) { ev[g] = *(const u32x4*)(E + (size_t)g * LRU_W * 8); bv[g] = *(const u32x4*)(Bp + (size_t)g * LRU_W * 8); }
  float h = 0.f, P = 1.f;
#pragma unroll
  for (int gg = 0; gg < 8; ++gg) { const int g = d ? 7 - gg : gg; float e[8], bb[8]; unpk8(ev[g], e); unpk8(bv[g], bb);
#pragma unroll
    for (int rr = 0; rr < 8; ++rr) { const int r = d ? 7 - rr : rr; const float a = 1.f - e[r]; h = fmaf(a, h, bb[r]); P *= a; } }
  const size_t o = ((size_t)(d * NB + b) * NLCH + c) * LRU_W + cg * 64 + lane;
  ((float*)(p.ws + WS_LP))[o] = P; ((float*)(p.ws + WS_LH))[o] = h;
}

DEVI void lru_final(const Params& p, int item, char* lds) {
  const int tid = tidx(), wid = tid >> 6, lane = tid & 63;
  const int c = item % NLCH, b = item / NLCH;
  float* obuf = (float*)lds;
  if (wid < 6) {
    const int ch = wid * 64 + lane;
#pragma unroll
    for (int d = 0; d < 2; ++d) {
      const size_t co = ((size_t)(d * NB + b) * NLCH + c) * LRU_W + ch;
      float h = ((const float*)(p.ws + WS_LC))[co];
      const size_t base = (((size_t)(d * NB + b) * (SEQ / 8) + c * 8) * LRU_W + ch) * 8;
      const u16* E = (const u16*)(p.ws + WS_LE) + base; const u16* Bp = (const u16*)(p.ws + WS_LB) + base;
      u32x4 ev[8], bv[8];
#pragma unroll
      for (int g = 0; g < 8; ++g) { ev[g] = *(const u32x4*)(E + (size_t)g * LRU_W * 8); bv[g] = *(const u32x4*)(Bp + (size_t)g * LRU_W * 8); }
      if (d == 0) {
#pragma unroll
        for (int g = 0; g < 8; ++g) { float e[8], bb[8]; unpk8(ev[g], e); unpk8(bv[g], bb);
#pragma unroll
          for (int r = 0; r < 8; ++r) { h = fmaf(1.f - e[r], h, bb[r]); obuf[(g * 8 + r) * LRU_W + ch] = h; } }
      } else {
        const u16* gp = (const u16*)(p.ws + WS_R1) + ((size_t)b * SEQ + c * LCH) * INWP + PC_LG + ch;
#pragma unroll
        for (int g = 7; g >= 0; --g) { float e[8], bb[8]; unpk8(ev[g], e); unpk8(bv[g], bb);
#pragma unroll
          for (int r = 7; r >= 0; --r) { h = fmaf(1.f - e[r], h, bb[r]); const int tk = g * 8 + r;
            const float gt = bf2f(gp[(size_t)tk * INWP]); obuf[tk * LRU_W + ch] = (obuf[tk * LRU_W + ch] + h) * gelu_erf(gt); } }
      }
    }
  }
  __syncthreads();
  u16* mp = (u16*)(p.ws + WS_MIX) + ((size_t)b * SEQ + c * LCH) * DM + 384;
#pragma unroll 1
  for (int i = 0; i < 8; ++i) { const int tk = wid * 8 + i;
    float v[6]; float s = 0.f;
#pragma unroll
    for (int q = 0; q < 3; ++q) { const f32x2 t2 = *(const f32x2*)(obuf + tk * LRU_W + q * 128 + lane * 2); v[2 * q] = t2.x; v[2 * q + 1] = t2.y; s = fmaf(t2.x, t2.x, s); s = fmaf(t2.y, t2.y, s); }
    s = wave_sum(s);
    const float rs = rsqrtf(s * (1.f / 384.f) + EPS);
#pragma unroll
    for (int q = 0; q < 3; ++q) *(unsigned*)(mp + (size_t)tk * DM + q * 128 + lane * 2) = pk2(v[2 * q] * rs, v[2 * q + 1] * rs);
  }
  __syncthreads();
}

DEVI void peer_cand(const Params& p, int layer, int vb, int nb, char* lds) {
  const int tid = tidx();
  unsigned char* my = (unsigned char*)lds + tid * 32;
  const float* top = (const float*)(p.ws + WS_TOP);
  float* egate = (float*)(p.ws + WS_EGATE);
  for (int it = vb * NTHREADS + tid; it < T * 8; it += nb * NTHREADS) {
    float v1[16], v2[16];
    const float* tp = top + (size_t)it * 32;
#pragma unroll
    for (int i = 0; i < 4; ++i) { const f32x4 a = *(const f32x4*)(tp + 4 * i), b = *(const f32x4*)(tp + 16 + 4 * i);
      v1[4 * i] = a.x; v1[4 * i + 1] = a.y; v1[4 * i + 2] = a.z; v1[4 * i + 3] = a.w; v2[4 * i] = b.x; v2[4 * i + 1] = b.y; v2[4 * i + 2] = b.z; v2[4 * i + 3] = b.w; }
#pragma unroll
    for (int i = 0; i < 16; ++i) { my[i] = (unsigned char)(127u - (__float_as_uint(v1[i]) & 127u)); my[16 + i] = (unsigned char)(127u - (__float_as_uint(v2[i]) & 127u)); }
    float l[16];
#pragma unroll
    for (int i = 0; i < 16; ++i) l[i] = -3.0e38f;
#pragma unroll
    for (int a = 0; a < 16; ++a)
#pragma unroll
      for (int b = 0; b < 16; ++b) if ((a + 1) * (b + 1) <= 16) {
        float v = __uint_as_float((__float_as_uint(v1[a] + v2[b]) & ~255u) | (unsigned)(255 - (a * 16 + b)));
#pragma unroll
        for (int i = 0; i < 16; ++i) { const float t = fmaxf(l[i], v); v = fminf(l[i], v); l[i] = t; } }
    const float mx = __uint_as_float(__float_as_uint(l[0]) & ~255u);
    float w[16], sum = 0.f;
#pragma unroll
    for (int i = 0; i < 16; ++i) { w[i] = __expf(__uint_as_float(__float_as_uint(l[i]) & ~255u) - mx); sum += w[i]; }
    const float inv = 1.f / sum;
    unsigned ev[16];
#pragma unroll
    for (int i = 0; i < 16; ++i) { const unsigned code = 255u - (__float_as_uint(l[i]) & 255u); ev[i] = (unsigned)my[code >> 4] * 128u + (unsigned)my[16 + (code & 15)]; w[i] *= inv; }
    u16* eo = (u16*)(p.ws + WS_EIDX) + (size_t)it * 16;
    *(u32x4*)(eo) = (u32x4){ev[0] | (ev[1] << 16), ev[2] | (ev[3] << 16), ev[4] | (ev[5] << 16), ev[6] | (ev[7] << 16)};
    *(u32x4*)(eo + 8) = (u32x4){ev[8] | (ev[9] << 16), ev[10] | (ev[11] << 16), ev[12] | (ev[13] << 16), ev[14] | (ev[15] << 16)};
#pragma unroll
    for (int i = 0; i < 4; ++i) *(f32x4*)(egate + (size_t)it * 16 + 4 * i) = (f32x4){w[4 * i], w[4 * i + 1], w[4 * i + 2], w[4 * i + 3]};
  }
  { const int wid = tid >> 6, lane = tid & 63; u16* xg = (u16*)(p.ws + WS_XG); const float* gf = p.norm_ffn + layer * DM;
    for (int t = vb * 8 + wid; t < T; t += nb * 8) {
      u32x4* rp = (u32x4*)(xg + (size_t)t * DM + lane * 16);
      float v[16]; unpk8(rp[0], v); unpk8(rp[1], v + 8);
      float s = 0.f;
#pragma unroll
      for (int i = 0; i < 16; ++i) s = fmaf(v[i], v[i], s);
      s = wave_sum(s);
      const float rs = rsqrtf(s * (1.f / DM) + EPS);
      float g[16]; ld8(gf + lane * 16, g); ld8(gf + lane * 16 + 8, g + 8);
#pragma unroll
      for (int i = 0; i < 16; ++i) v[i] *= rs * g[i];
      rp[0] = pk8(v); rp[1] = pk8(v + 8);
    } }
}

typedef unsigned char u8;
DEVI void cvt16(u32x4 w, float* f) {
  f32x2 t;
  t = __builtin_amdgcn_cvt_pk_f32_fp8((int)w.x, false); f[0] = t.x; f[1] = t.y; t = __builtin_amdgcn_cvt_pk_f32_fp8((int)w.x, true); f[2] = t.x; f[3] = t.y;
  t = __builtin_amdgcn_cvt_pk_f32_fp8((int)w.y, false); f[4] = t.x; f[5] = t.y; t = __builtin_amdgcn_cvt_pk_f32_fp8((int)w.y, true); f[6] = t.x; f[7] = t.y;
  t = __builtin_amdgcn_cvt_pk_f32_fp8((int)w.z, false); f[8] = t.x; f[9] = t.y; t = __builtin_amdgcn_cvt_pk_f32_fp8((int)w.z, true); f[10] = t.x; f[11] = t.y;
  t = __builtin_amdgcn_cvt_pk_f32_fp8((int)w.w, false); f[12] = t.x; f[13] = t.y; t = __builtin_amdgcn_cvt_pk_f32_fp8((int)w.w, true); f[14] = t.x; f[15] = t.y;
}
DEVI unsigned enc4(float a, float b, float c, float d) { int w = 0; w = __builtin_amdgcn_cvt_pk_fp8_f32(a, b, w, false); w = __builtin_amdgcn_cvt_pk_fp8_f32(c, d, w, true); return (unsigned)w; }
#define EIDX_AT(i0, i1, i) ((((i) < 8 ? (i0) : (i1))[((i) & 7) >> 1] >> (((i) & 1) * 16)) & 0xffffu)
template <int CTRL> DEVI float dppf(float v) { return __uint_as_float((unsigned)__builtin_amdgcn_mov_dpp((int)__float_as_uint(v), CTRL, 0xF, 0xF, true)); }
DEVI f32x2 fma2(f32x2 a, f32x2 b, f32x2 c) { return __builtin_elementwise_fma(a, b, c); }
DEVI f32x2 cvt8lo(unsigned w) { return __builtin_amdgcn_cvt_pk_f32_fp8((int)w, false); }
DEVI f32x2 cvt8hi(unsigned w) { return __builtin_amdgcn_cvt_pk_f32_fp8((int)w, true); }
struct PeerIdx { u32x4 i0, i1; };
template <bool AXPY>
DEVI void peer_slice_phase(const Params& p, int s, int tbeg, int tstep, int lane, const float* xin, float* xout, bool last) {
  const int r = lane >> 3, j = lane & 7;
  const u8* eidxB = (const u8*)(p.ws + WS_EIDX); const unsigned eoff = (unsigned)r * 32u;
  const u8* TBs = (const u8*)(p.ws + (AXPY ? WS_VB : WS_UB)) + (size_t)s * NEXP * 128; const unsigned toff = 16u * (unsigned)j;
  const u8* xnB = (const u8*)(p.ws + WS_XG) + s * 256; const unsigned xoff = 32u * (unsigned)j;
  const u8* ccB = (const u8*)(p.ws + WS_CC); const unsigned coff = (unsigned)r * 32u;
  float* pdB = (float*)(p.ws + WS_PD) + (size_t)s * T * 128;
  const int ntok = (T - tbeg + tstep - 1) / tstep;
  if (ntok <= 0) return;
#define TOK(k) (tbeg + ((k) < ntok ? (k) : ntok - 1) * tstep)
#define LD_IDX(dst, k) do { const u8* b_ = eidxB + (size_t)TOK(k) * 256; dst.i0 = *(const u32x4*)(b_ + eoff); dst.i1 = *(const u32x4*)(b_ + eoff + 16u); } while (0)
#define LD_HALF(H, ix, h) do { _Pragma("unroll") for (int i = 0; i < 8; ++i) H[i] = *(const u32x4*)(TBs + (EIDX_AT(ix.i0, ix.i1, 8 * (h) + i) * 128u + toff)); } while (0)
#define LD_AUX(a, k) do { if (AXPY) { const u8* b_ = ccB + (size_t)TOK(k) * 256; a[0] = *(const u32x4*)(b_ + coff); a[1] = *(const u32x4*)(b_ + coff + 16u); } \
    else { const u8* b_ = xnB + (size_t)TOK(k) * (DM * 2); a[0] = *(const u32x4*)(b_ + xoff); a[1] = *(const u32x4*)(b_ + xoff + 16u); } } while (0)
  PeerIdx I0, I1, I2; u32x4 H0[8], H1[8], H2[8], X0[2], X1[2], X2[2];
  float av[16];
  f32x2 acc[8];
#define T_BEGIN(X) do { unpk8(X[0], av); unpk8(X[1], av + 8); if (AXPY) { _Pragma("unroll") for (int q = 0; q < 8; ++q) acc[q] = (f32x2){0.f, 0.f}; } } while (0)
#define COMP(H, h, k) do { if ((k) < ntok) { \
    if (!AXPY) { float* o_ = pdB + (size_t)(tbeg + (k) * tstep) * 128 + r * 16 + 8 * (h); \
      _Pragma("unroll") for (int g = 0; g < 2; ++g) { float res[4]; \
        _Pragma("unroll") for (int ii = 0; ii < 4; ++ii) { const u32x4 w_ = H[4 * g + ii]; f32x2 a = {0.f, 0.f}; \
          a = fma2(cvt8lo(w_.x), (f32x2){av[0], av[1]}, a); a = fma2(cvt8hi(w_.x), (f32x2){av[2], av[3]}, a); a = fma2(cvt8lo(w_.y), (f32x2){av[4], av[5]}, a); a = fma2(cvt8hi(w_.y), (f32x2){av[6], av[7]}, a); \
          a = fma2(cvt8lo(w_.z), (f32x2){av[8], av[9]}, a); a = fma2(cvt8hi(w_.z), (f32x2){av[10], av[11]}, a); a = fma2(cvt8lo(w_.w), (f32x2){av[12], av[13]}, a); a = fma2(cvt8hi(w_.w), (f32x2){av[14], av[15]}, a); \
          float v = a.x + a.y; v += dppf<0xB1>(v); v += dppf<0x4E>(v); v += dppf<0x141>(v); res[ii] = v; } \
        if (j == 0) *(f32x4*)(o_ + 4 * g) = (f32x4){res[0], res[1], res[2], res[3]}; } } \
    else { _Pragma("unroll") for (int i = 0; i < 8; ++i) { const u32x4 w_ = H[i]; const float ci = av[8 * (h) + i]; const f32x2 c2 = {ci, ci}; \
        acc[0] = fma2(cvt8lo(w_.x), c2, acc[0]); acc[1] = fma2(cvt8hi(w_.x), c2, acc[1]); acc[2] = fma2(cvt8lo(w_.y), c2, acc[2]); acc[3] = fma2(cvt8hi(w_.y), c2, acc[3]); \
        acc[4] = fma2(cvt8lo(w_.z), c2, acc[4]); acc[5] = fma2(cvt8hi(w_.z), c2, acc[5]); acc[6] = fma2(cvt8lo(w_.w), c2, acc[6]); acc[7] = fma2(cvt8hi(w_.w), c2, acc[7]); } } } } while (0)
  auto finalize = [&](int k) {
    if (!AXPY || k >= ntok) return;
    const int t = tbeg + k * tstep;
    float S[8];
#pragma unroll
    for (int q = 0; q < 8; ++q) { const float A = acc[q >> 1][q & 1], B = acc[(q + 8) >> 1][q & 1];
      auto rr = __builtin_amdgcn_permlane32_swap(__float_as_uint(A), __float_as_uint(B), false, false); S[q] = __uint_as_float(rr[0]) + __uint_as_float(rr[1]); }
    float Tq[4];
#pragma unroll
    for (int q = 0; q < 4; ++q) { auto rr = __builtin_amdgcn_permlane16_swap(__float_as_uint(S[q]), __float_as_uint(S[q + 4]), false, false); Tq[q] = __uint_as_float(rr[0]) + __uint_as_float(rr[1]); }
#pragma unroll
    for (int q = 0; q < 4; ++q) Tq[q] += dppf<0x128>(Tq[q]);
    float ss = 0.f;
    if ((lane & 8) == 0) {
      const size_t o = (size_t)t * DM + s * 128 + 16 * j + ((lane >> 5) & 1) * 8 + ((lane >> 4) & 1) * 4;
      const f32x4 x = *(const f32x4*)(xin + o);
      const f32x4 y = {x.x + Tq[0], x.y + Tq[1], x.z + Tq[2], x.w + Tq[3]};
      *(f32x4*)(xout + o) = y;
      if (!last) *(u32x2*)((u16*)(p.ws + WS_XG) + o) = (u32x2){pk2(y.x, y.y), pk2(y.z, y.w)};
      ss = (y.x * y.x + y.y * y.y) + (y.z * y.z + y.w * y.w);
    }
    ss = wave_sum(ss); if (lane == 0) ((float*)(p.ws + WS_SSQ))[(size_t)t * 8 + s] = ss;
  };
  LD_IDX(I0, 0); LD_IDX(I1, 1); LD_HALF(H0, I0, 0); LD_HALF(H1, I0, 1); LD_AUX(X0, 0);
#pragma unroll 1
  for (int k = 0; k < ntok; k += 3) {
    LD_HALF(H2, I1, 0); LD_IDX(I2, k + 2); LD_AUX(X1, k + 1);
    T_BEGIN(X0); COMP(H0, 0, k);
    LD_HALF(H0, I1, 1);
    COMP(H1, 1, k); finalize(k);
    LD_HALF(H1, I2, 0); LD_IDX(I0, k + 3); LD_AUX(X2, k + 2);
    T_BEGIN(X1); COMP(H2, 0, k + 1);
    LD_HALF(H2, I2, 1);
    COMP(H0, 1, k + 1); finalize(k + 1);
    LD_HALF(H0, I0, 0); LD_IDX(I1, k + 4); LD_AUX(X0, k + 3);
    T_BEGIN(X2); COMP(H1, 0, k + 2);
    LD_HALF(H1, I0, 1);
    COMP(H2, 1, k + 2); finalize(k + 2);
  }
#undef TOK
#undef LD_IDX
#undef LD_HALF
#undef LD_AUX
#undef T_BEGIN
#undef COMP
}

DEVI void lru_passB(const Params& p, int item, int lane) {
  const int cg = item % 6, b = (item / 6) % NB, d = item / (6 * NB);
  const size_t o = (size_t)(d * NB + b) * NLCH * LRU_W + cg * 64 + lane;
  const float* Pp = (const float*)(p.ws + WS_LP) + o; const float* Hp = (const float*)(p.ws + WS_LH) + o; float* Cp = (float*)(p.ws + WS_LC) + o;
  float h = 0.f;
#pragma unroll 1
  for (int c0 = 0; c0 < NLCH; c0 += 32) {
    float pv[32], hv[32];
#pragma unroll
    for (int i = 0; i < 32; ++i) { const int cc = d ? NLCH - 1 - (c0 + i) : c0 + i; pv[i] = Pp[(size_t)cc * LRU_W]; hv[i] = Hp[(size_t)cc * LRU_W]; }
#pragma unroll
    for (int i = 0; i < 32; ++i) { const int cc = d ? NLCH - 1 - (c0 + i) : c0 + i; Cp[(size_t)cc * LRU_W] = h; h = fmaf(pv[i], h, hv[i]); }
  }
}

DEVI void swa_item(const Params& p, int layer, int item, char* lds) {
  const int tid = tidx(), wid = tid >> 6, lane = tid & 63, r32 = lane & 31, hi = lane >> 5;
  const int g = item & 1, n = (item >> 1) & 63, b = item >> 7;
  const int hq = 2 * g + (wid >> 2), qrow = n * 128 + (wid & 3) * 32;
  const u16* proj = (const u16*)(p.ws + WS_R1);
  const u16* Qw = proj + (size_t)(b * SEQ + qrow + r32) * INWP + PC_SQ + hq * 64 + hi * 8;
  const u16* Kh = proj + (size_t)(b * SEQ) * INWP + PC_SK + g * 64;
  const u16* Vh = proj + (size_t)(b * SEQ) * INWP + PC_SV + g * 64;
  const int kt0 = (2 * n - 2) < 0 ? 0 : (2 * n - 2), kt1 = (2 * n + 4) > SEQ / 64 ? SEQ / 64 : (2 * n + 4);
  const float sink = p.swa_sink[layer * 4 + hq];
  u16* Ow = (u16*)(p.ws + WS_MIX) + (size_t)(b * SEQ + qrow) * DM + 768 + hq * 64;
  attn_body<64, true>(Qw, Kh, INWP, Vh, INWP, kt0, kt1 - kt0, 0.125f, sink * 8.f, 1.f, qrow + r32, Ow, lds);
}
DEVI void mla_item(const Params& p, int pair, int qb, char* lds) {
  const int tid = tidx(), wid = tid >> 6, lane = tid & 63, r32 = lane & 31, hi = lane >> 5;
  const int b = pair / MLA_H, h = pair - b * MLA_H;
  const u16* Qw = (const u16*)(p.ws + WS_QM) + ((size_t)pair * SEQ + qb * 256 + wid * 32 + r32) * MLA_QK + hi * 8;
  const u16* Kh = (const u16*)(p.ws + WS_KM) + (size_t)pair * SEQ * MLA_QK;
  const u16* Vh = (const u16*)(p.ws + WS_VM) + (size_t)pair * SEQ * MLA_V;
  u16* Ow = (u16*)(p.ws + WS_MIX) + (size_t)(b * SEQ + qb * 256 + wid * 32) * DM + h * 64;
  attn_body<96, false>(Qw, Kh, MLA_QK, Vh, MLA_V, 0, SEQ / 64, 0.10206207261596575f, -1e30f, 0.f, 0, Ow, lds);
}


namespace pg8 {
#define PG8_LAS __attribute__((address_space(3)))
constexpr int BM = 256, BK = 64, HALF = 128, HTB = HALF * BK * 2, NXCD = 8, WGM = 8;
DEVI int lds_byte(int r, int c) { const int st = (r >> 4) * 2 + (c >> 5), rr = r & 15, cc = c & 31, ob = rr * 64 + cc * 2; return st * 1024 + (ob ^ (((ob >> 9) & 1) << 5)); }
DEVI void stage_rc(int b, int& R, int& C) { const int st = b / 1024, sb = b % 1024, swz = sb ^ (((sb >> 9) & 1) << 5); R = (st >> 1) * 16 + swz / 64; C = (st & 1) * 32 + (swz % 64) / 2; }
DEVI int perm32(int rho) { const int n = rho >> 4, i = rho & 15; return 8 * (i >> 2) + 4 * n + (i & 3); }
struct Unit { int pm, pn; };
struct Gemm { const u16* A; const u16* Bt; int M, N, K; };
struct StaticOrder {
  int nM, nN, nwg, G, c;
  DEVI void init(int M, int N, int G_, int c_) { nM = M / BM; nN = N / BM; nwg = nM * nN; G = G_; c = c_; }
  DEVI bool next(int i, Unit& u) const {
    const long L = (long)i * G + c; if (L >= nwg) return false;
    int wgid = (int)L; { const int q = nwg / NXCD, r = nwg % NXCD, xcd = wgid % NXCD, off = wgid / NXCD; wgid = (xcd < r ? xcd * (q + 1) : r * (q + 1) + (xcd - r) * q) + off; }
    const int nig = WGM * nN, gid = wgid / nig, fm = gid * WGM, gsz = (nM - fm) < WGM ? (nM - fm) : WGM;
    u.pm = fm + ((wgid % nig) % gsz); u.pn = (wgid % nig) / gsz; return true;
  }
};
template <class Epi>
DEVI void gemm_phase(PG8_LAS unsigned char* lds, const Gemm g, const StaticOrder& S, const Epi& E) {
  const int tid = tidx(), wid = __builtin_amdgcn_readfirstlane(tid >> 6), lane = tid & 63, wr = wid >> 2, wc = wid & 3, fr = lane & 15, fq = lane >> 4;
  const int K = g.K, nt = K / BK;
  unsigned voffA[2], voffB[2];
#pragma unroll
  for (int i = 0; i < 2; ++i) { int R, C; stage_rc(tid * 16 + i * 8192, R, C); const int Rb = (R & ~31) + perm32(R & 31);
    voffA[i] = (unsigned)(R * K + C) * 2u; voffB[i] = (unsigned)(Rb * K + C) * 2u; }
  const size_t kstep = (size_t)(BK * 2), hstep = (size_t)HALF * K * 2, tstep = 2 * hstep;
  const unsigned ldsw = (unsigned)wid * 1024u;
  const int aoff = lds_byte(wr * 64 + fr, fq * 8), boff = lds_byte(wc * 32 + fr, fq * 8);
#define PG8_SA(b, h) (((b) * 2 + (h)) * HTB)
#define PG8_SB(b, h) ((4 + (b) * 2 + (h)) * HTB)
#define PG8_STAGE(bufoff, gbase, voff) do { _Pragma("unroll") for (int _i = 0; _i < 2; ++_i) \
    __builtin_amdgcn_global_load_lds((const unsigned*)((const char*)(gbase) + (voff)[_i]), (PG8_LAS unsigned*)(lds + (bufoff) + ldsw + _i * 8192), 16, 0, 0); } while (0)
#define PG8_LDA(dst, b, h) do { _Pragma("unroll") for (int m = 0; m < 4; ++m) _Pragma("unroll") for (int k = 0; k < 2; ++k) dst[m][k] = *(const PG8_LAS bf16x8*)(lds + PG8_SA(b, h) + aoff + m * 2048 + k * 1024); } while (0)
#define PG8_LDB(dst, b, h) do { _Pragma("unroll") for (int n = 0; n < 2; ++n) _Pragma("unroll") for (int k = 0; k < 2; ++k) dst[n][k] = *(const PG8_LAS bf16x8*)(lds + PG8_SB(b, h) + boff + n * 2048 + k * 1024); } while (0)
#define PG8_MMA(ai, bj, At, Bt) do { __builtin_amdgcn_s_setprio(1); _Pragma("unroll") for (int m = 0; m < 4; ++m) _Pragma("unroll") for (int n = 0; n < 2; ++n) _Pragma("unroll") for (int k = 0; k < 2; ++k) \
    acc[ai][bj][m][n] = __builtin_amdgcn_mfma_f32_16x16x32_bf16(Bt[n][k], At[m][k], acc[ai][bj][m][n], 0, 0, 0); __builtin_amdgcn_s_setprio(0); } while (0)
#define PG8_WAIT_V(n) asm volatile("s_waitcnt vmcnt(" #n ")" ::: "memory")
#define PG8_WAIT_L(n) asm volatile("s_waitcnt lgkmcnt(" #n ")" ::: "memory")
#define PG8_BAR __builtin_amdgcn_s_barrier()
#define PG8_SCHED __builtin_amdgcn_sched_barrier(0)
  Unit cur, nxt; int ui = 0;
  if (!S.next(0, cur)) return;
  f32x4 acc[2][2][4][2];
#pragma unroll
  for (int a = 0; a < 2; ++a)
#pragma unroll
    for (int b = 0; b < 2; ++b)
#pragma unroll
      for (int m = 0; m < 4; ++m)
#pragma unroll
        for (int n = 0; n < 2; ++n) acc[a][b][m][n] = (f32x4){0.f, 0.f, 0.f, 0.f};
  bf16x8 At[4][2], B0[2][2], B1[2][2];
  const char* cA = (const char*)g.A + (size_t)cur.pm * tstep; const char* cB = (const char*)g.Bt + (size_t)cur.pn * tstep;
  PG8_STAGE(PG8_SB(0, 0), cB, voffB); PG8_STAGE(PG8_SB(0, 1), cB + hstep, voffB); PG8_STAGE(PG8_SA(0, 0), cA, voffA); PG8_STAGE(PG8_SA(0, 1), cA + hstep, voffA);
  if (wr == 1) PG8_BAR;
  PG8_WAIT_V(2); PG8_BAR;
  PG8_STAGE(PG8_SB(1, 0), cB + kstep, voffB); PG8_STAGE(PG8_SA(1, 0), cA + kstep, voffA); PG8_STAGE(PG8_SB(1, 1), cB + hstep + kstep, voffB);
  PG8_WAIT_V(6); PG8_BAR;
  for (;;) {
    const bool has_next = S.next(ui + 1, nxt);
    const char* nA = has_next ? (const char*)g.A + (size_t)nxt.pm * tstep : cA; const char* nB = has_next ? (const char*)g.Bt + (size_t)nxt.pn * tstep : cB;
    for (int t = 0; t < nt; t += 2) {
      const bool last = (t == nt - 2);
      const char* a1 = cA + (size_t)(t + 1) * kstep;
      const char* a2 = last ? nA : cA + (size_t)(t + 2) * kstep; const char* b2 = last ? nB : cB + (size_t)(t + 2) * kstep;
      const char* a3 = a2 + kstep; const char* b3 = b2 + kstep;
      PG8_LDB(B0, 0, 0); PG8_LDB(B1, 0, 1); PG8_SCHED; PG8_LDA(At, 0, 0); PG8_STAGE(PG8_SA(1, 1), a1 + hstep, voffA);
      PG8_WAIT_V(8); PG8_WAIT_L(0); PG8_BAR; PG8_MMA(0, 0, At, B0); PG8_MMA(0, 1, At, B1); PG8_BAR; PG8_SCHED;
      PG8_LDA(At, 0, 1); PG8_STAGE(PG8_SB(0, 0), b2, voffB); PG8_STAGE(PG8_SB(0, 1), b2 + hstep, voffB); PG8_STAGE(PG8_SA(0, 0), a2, voffA);
      PG8_WAIT_V(8); PG8_WAIT_L(0); PG8_BAR; PG8_MMA(1, 0, At, B0); PG8_MMA(1, 1, At, B1); PG8_BAR; PG8_SCHED;
      PG8_LDB(B0, 1, 0); PG8_LDB(B1, 1, 1); PG8_SCHED; PG8_LDA(At, 1, 0); PG8_STAGE(PG8_SA(0, 1), a2 + hstep, voffA);
      PG8_WAIT_V(8); PG8_WAIT_L(0); PG8_BAR; PG8_MMA(0, 0, At, B0); PG8_MMA(0, 1, At, B1); PG8_BAR; PG8_SCHED;
      PG8_LDA(At, 1, 1); PG8_STAGE(PG8_SB(1, 0), b3, voffB); PG8_STAGE(PG8_SB(1, 1), b3 + hstep, voffB); PG8_STAGE(PG8_SA(1, 0), a3, voffA);
      PG8_WAIT_V(8); PG8_WAIT_L(0); PG8_BAR; PG8_MMA(1, 0, At, B0); PG8_MMA(1, 1, At, B1); PG8_BAR; PG8_SCHED;
    }
    if (wr == 0) PG8_BAR;
    E(acc, cur, wr, wc, fr, fq);
    if (!has_next) break;
#pragma unroll
    for (int a = 0; a < 2; ++a)
#pragma unroll
      for (int b = 0; b < 2; ++b)
#pragma unroll
        for (int m = 0; m < 4; ++m)
#pragma unroll
          for (int n = 0; n < 2; ++n) acc[a][b][m][n] = (f32x4){0.f, 0.f, 0.f, 0.f};
    cur = nxt; cA = nA; cB = nB; ++ui;
    if (wr == 1) PG8_BAR;
  }
  PG8_WAIT_V(0);
  PG8_BAR;
#undef PG8_SA
#undef PG8_SB
#undef PG8_STAGE
#undef PG8_LDA
#undef PG8_LDB
#undef PG8_MMA
#undef PG8_WAIT_V
#undef PG8_WAIT_L
#undef PG8_BAR
#undef PG8_SCHED
}

DEVI float rs_from8(const float* s) { const f32x4 a = *(const f32x4*)s, b = *(const f32x4*)(s + 4); return rsqrtf((((a.x + a.y) + (a.z + a.w)) + ((b.x + b.y) + (b.z + b.w))) * (1.f / DM) + EPS); }
struct EpiProj { u16* proj; const int* pos; const float* ssq8;
  DEVI void operator()(const f32x4 (&acc)[2][2][4][2], const Unit& u, int wr, int wc, int fr, int fq) const {
    const int row0 = u.pm * BM + wr * 64 + fr, col0 = u.pn * BM + wc * 32 + 8 * fq;
#pragma unroll
    for (int ai = 0; ai < 2; ++ai)
#pragma unroll
      for (int m = 0; m < 4; ++m) { const int row = row0 + ai * HALF + m * 16; const float rs = rs_from8(ssq8 + (size_t)row * 8); const float posf = (float)pos[row];
#pragma unroll
        for (int bj = 0; bj < 2; ++bj) { const int gcol = col0 + bj * HALF;
          float v[8]; { const f32x4 a = acc[ai][bj][m][0] * rs, b = acc[ai][bj][m][1] * rs; v[0] = a.x; v[1] = a.y; v[2] = a.z; v[3] = a.w; v[4] = b.x; v[5] = b.y; v[6] = b.z; v[7] = b.w; }
          const bool r64 = gcol >= PC_SQ && gcol < PC_SV, r32g = gcol >= PC_KR && gcol < PC_KR + 32;
          if (r64 || r32g) {
#pragma unroll
            for (int q = 0; q < 4; ++q) { const int f = r64 ? (((gcol + 2 * q) & 63) >> 1) : 2 * (((gcol + 2 * q) & 31) >> 1); float sn, cs; rope_sc(posf, f, sn, cs);
              const float x1 = v[2 * q], x2 = v[2 * q + 1]; v[2 * q] = x1 * cs - x2 * sn; v[2 * q + 1] = x2 * cs + x1 * sn; } }
          *(u32x4*)(proj + (size_t)row * INWP + gcol) = pk8(v); } }
  }
};
struct EpiPQ { u16* O; const float* ssq16;
  DEVI void operator()(const f32x4 (&acc)[2][2][4][2], const Unit& u, int wr, int wc, int fr, int fq) const {
    const int row0 = u.pm * BM + wr * 64 + fr, col0 = u.pn * BM + wc * 32 + 8 * fq;
#pragma unroll
    for (int ai = 0; ai < 2; ++ai)
#pragma unroll
      for (int m = 0; m < 4; ++m) { const int row = row0 + ai * HALF + m * 16;
        const f32x4* sp = (const f32x4*)(ssq16 + (size_t)row * 16); const f32x4 s4 = (sp[0] + sp[1]) + (sp[2] + sp[3]);
        const float rs = rsqrtf(((s4.x + s4.y) + (s4.z + s4.w)) * (1.f / DM) + EPS);
#pragma unroll
        for (int bj = 0; bj < 2; ++bj) { float v[8]; { const f32x4 a = acc[ai][bj][m][0] * rs, b = acc[ai][bj][m][1] * rs; v[0] = a.x; v[1] = a.y; v[2] = a.z; v[3] = a.w; v[4] = b.x; v[5] = b.y; v[6] = b.z; v[7] = b.w; }
          *(u32x4*)(O + (size_t)row * 2048 + col0 + bj * HALF) = pk8(v); } }
  }
};
struct EpiRes { const float* xres; float* xout; u16* xg; float* ssq16;
  DEVI void operator()(const f32x4 (&acc)[2][2][4][2], const Unit& u, int wr, int wc, int fr, int fq) const {
    const int row0 = u.pm * BM + wr * 64 + fr, col0 = u.pn * BM + wc * 32 + 8 * fq;
#pragma unroll
    for (int ai = 0; ai < 2; ++ai)
#pragma unroll
      for (int m = 0; m < 4; ++m) { const int row = row0 + ai * HALF + m * 16; float ss = 0.f;
#pragma unroll
        for (int bj = 0; bj < 2; ++bj) { const size_t o = (size_t)row * DM + col0 + bj * HALF;
          float x[8]; ld8(xres + o, x);
          const f32x4 a = acc[ai][bj][m][0], b = acc[ai][bj][m][1];
          x[0] += a.x; x[1] += a.y; x[2] += a.z; x[3] += a.w; x[4] += b.x; x[5] += b.y; x[6] += b.z; x[7] += b.w;
#pragma unroll
          for (int q = 0; q < 8; ++q) ss = fmaf(x[q], x[q], ss);
          *(f32x4*)(xout + o) = (f32x4){x[0], x[1], x[2], x[3]}; *(f32x4*)(xout + o + 4) = (f32x4){x[4], x[5], x[6], x[7]};
          *(u32x4*)(xg + o) = pk8(x); }
        ss += __shfl_xor(ss, 16); ss += __shfl_xor(ss, 32);
        if (fq == 0) ssq16[(size_t)row * 16 + u.pn * 4 + wc] = ss; }
  }
};
}

constexpr int PH_PER_LAYER = 13, N_PHASES = 2 + DEPTH * PH_PER_LAYER;
DEVI void run_phase(const Params& pin, int ph, int vb, int nb, char* lds) {
  const bool dry = ph >= 100; if (dry) ph -= 100;
  Params p = pin; { size_t z = 0; asm volatile("" : "+s"(z)); p.ws = pin.ws + z; p.out = pin.out + z; } asm volatile("" : "+s"(vb));
  const int tid = tidx(), wid = tid >> 6, lane = tid & 63;
#ifdef ONLY_SP
  if (ONLY_SP >= 0 && ph == 0) return;
#endif
  if (ph == 0) { phase0(p, vb, nb, lds); return; }
  if (ph == N_PHASES - 1) {
    const float* ssq = (const float*)(p.ws + WS_SSQ);
    for (size_t i = (size_t)vb * NTHREADS + tid; i < (size_t)T * DM / 8; i += (size_t)nb * NTHREADS) {
      const size_t t = i >> 7; const int c = (int)(i & 127) * 8;
      float s8[8]; ld8(ssq + t * 8, s8); const float rs = rsqrtf((((s8[0] + s8[1]) + (s8[2] + s8[3])) + ((s8[4] + s8[5]) + (s8[6] + s8[7]))) * (1.f / DM) + EPS);
      float x[8], g[8]; ld8(p.out + i * 8, x); ld8(p.norm_final + c, g);
#pragma unroll
      for (int q = 0; q < 8; ++q) x[q] *= rs * g[q];
      *(f32x4*)(p.out + i * 8) = (f32x4){x[0], x[1], x[2], x[3]}; *(f32x4*)(p.out + i * 8 + 4) = (f32x4){x[4], x[5], x[6], x[7]}; }
    return; }
  const int l = (ph - 1) / PH_PER_LAYER, sp = (ph - 1) % PH_PER_LAYER;
  u16* const XG = (u16*)(p.ws + WS_XG); u16* const PROJ = (u16*)(p.ws + WS_R1); u16* const MIX = (u16*)(p.ws + WS_MIX);
  constexpr int NMT = T / 256;
#ifdef ONLY_SP
  if (sp != ONLY_SP) return;
#endif
  switch (sp) {
  case 0: {
    pg8::Gemm g{XG, (const u16*)(p.ws + WS_WIN) + (size_t)l * INWP * DM, T, INWP, DM}; pg8::StaticOrder S; S.init(T, INWP, nb, vb);
    pg8::EpiProj e{PROJ, p.pos, (const float*)(p.ws + WS_SSQ)};
    pg8::gemm_phase((PG8_LAS unsigned char*)lds, g, S, e);
  } break;
  case 1: {
    constexpr int N_C = NMT * 12, N_A = NMT * 5, N_B = NMT * 6;
    for (int it = vb; it < N_C + N_A + N_B; it += nb) {
      if (it < N_C) { const int mt = it / 12, nd = it % 12, n = nd >> 1, d = nd & 1;
        GemmDesc g{}; g.Bt = (const u16*)(p.ws + WS_WLRU) + (size_t)((l * 6 + n) * 2 + d) * 128 * 64; g.ldb = 64; g.KT = 1;
        g.proj = PROJ; g.cw = p.conv_w + l * 4 * LRU_W; g.cb = p.conv_b + l * LRU_W; g.ch0 = n * 64;
        EpiLRU e{PROJ, g.cw, g.cb, p.lru_ba + l * 2 * 384, p.lru_bx + l * 2 * 384, p.lru_lambda + l * 2 * 384, (u16*)(p.ws + WS_LE), (u16*)(p.ws + WS_LB), n, d};
        gemm_tile<1, 0>(g, mt * 256, 0, lds, e);
      } else if (it < N_C + N_A) { const int i2 = it - N_C;
        GemmDesc g = gemm_desc(PROJ + PC_CQ, INWP, (const u16*)(p.ws + WS_WUQ) + (size_t)l * 640 * 256, 256, 256);
        EpiQ e{(u16*)(p.ws + WS_QM), p.pos};
        gemm_tile<0, 1>(g, (i2 / 5) * 256, (i2 % 5) * 128, lds, e);
      } else { const int i2 = it - N_C - N_A;
        GemmDesc g = gemm_desc(PROJ + PC_CKV, INWP, (const u16*)(p.ws + WS_WUKV) + (size_t)l * 768 * 128, 128, 128);
        EpiKV e{(u16*)(p.ws + WS_KM), (u16*)(p.ws + WS_VM), PROJ};
        gemm_tile<0, 1>(g, (i2 / 6) * 256, (i2 % 6) * 128, lds, e);
      }
    }
  } break;
  case 2: {
    for (int it = vb * 8 + wid; it < 2 * NB * NLCH * 6; it += nb * 8) lru_passA(p, it, lane);
  } break;
  case 3: {
    const int wi = vb * 8 + wid;
    if (wi < 48) lru_passB(p, wi, lane);
    __syncthreads();
    for (int it = vb; it < NB * 64 * 2; it += nb) swa_item(p, l, it, lds);
  } break;
  case 4: {
    for (int k = 0; k * nb + vb < NB * MLA_H * 32; ++k) {
      int pair, qb;
      if (nb == 256) { pair = k * 8 + (vb & 7); qb = vb >> 3; } else { const int it = k * nb + vb; pair = it >> 5; qb = it & 31; }
      mla_item(p, pair, qb, lds);
    }
#ifndef NO_LRUF
    for (int it = vb; it < NB * NLCH; it += nb) lru_final(p, it, lds);
#endif
  } break;
  case 5: {
    for (int t = vb * 8 + wid; t < T; t += nb * 8) {
      u32x4* rp = (u32x4*)(MIX + (size_t)t * DM + lane * 16);
      float v[16]; unpk8(rp[0], v); unpk8(rp[1], v + 8);
      float s = 0.f;
#pragma unroll
      for (int q = 0; q < 16; ++q) s = fmaf(v[q], v[q], s);
      const int sg = lane < 24 ? 0 : (lane < 48 ? 1 : 2);
      const float s0 = wave_sum(sg == 0 ? s : 0.f), s2 = wave_sum(sg == 2 ? s : 0.f);
      const float rs = sg == 0 ? rsqrtf(s0 * (1.f / 384.f) + EPS) : rsqrtf(s2 * (1.f / 256.f) + EPS);
      if (sg != 1) {
#pragma unroll
        for (int q = 0; q < 16; ++q) v[q] *= rs;
        rp[0] = pk8(v); rp[1] = pk8(v + 8); } }
  } break;
  case 6: {
    { pg8::Gemm g{MIX, (const u16*)(p.ws + WS_WOUT) + (size_t)l * DM * DM, T, DM, DM}; pg8::StaticOrder S; S.init(T, DM, nb, vb);
      pg8::EpiRes e{l == 0 ? p.x : p.out, dry ? (float*)(p.ws + WS_R1) : p.out, XG, (float*)(p.ws + WS_SSQ16)};
      pg8::gemm_phase((PG8_LAS unsigned char*)lds, g, S, e); }
    const float* us = p.peer_u + (size_t)l * NEXP * DM; const float* vs = p.peer_v + (size_t)l * NEXP * DM;
    u8* ub = (u8*)(p.ws + WS_UB); u8* vbf = (u8*)(p.ws + WS_VB);
    for (size_t i = (size_t)vb * NTHREADS + tid; i < (size_t)NEXP * 64; i += (size_t)nb * NTHREADS) {
      const size_t e = i >> 6; const int c16 = (int)(i & 63), s = c16 >> 3, cc = (c16 & 7) * 16;
      float a[16], b[16]; ld8(us + i * 16, a); ld8(us + i * 16 + 8, a + 8); ld8(vs + i * 16, b); ld8(vs + i * 16 + 8, b + 8);
#pragma unroll
      for (int q = 0; q < 16; ++q) { a[q] *= PEER_SU; b[q] *= PEER_SV; }
      const size_t o = ((size_t)s * NEXP + e) * 128 + cc;
      *(u32x4*)(ub + o) = (u32x4){enc4(a[0], a[1], a[2], a[3]), enc4(a[4], a[5], a[6], a[7]), enc4(a[8], a[9], a[10], a[11]), enc4(a[12], a[13], a[14], a[15])};
      *(u32x4*)(vbf + o) = (u32x4){enc4(b[0], b[1], b[2], b[3]), enc4(b[4], b[5], b[6], b[7]), enc4(b[8], b[9], b[10], b[11]), enc4(b[12], b[13], b[14], b[15])}; }
  } break;
  case 7: {
    pg8::Gemm g{XG, (const u16*)(p.ws + WS_WQ) + (size_t)l * 2048 * DM, T, 2048, DM}; pg8::StaticOrder S; S.init(T, 2048, nb, vb);
    pg8::EpiPQ e{PROJ, (const float*)(p.ws + WS_SSQ16)};
    pg8::gemm_phase((PG8_LAS unsigned char*)lds, g, S, e);
  } break;
  case 8: {
    for (int it = vb; it < NMT * 16; it += nb) { const int mt = it / 16, hj = it % 16, j = hj & 1;
      GemmDesc g{}; g.A = PROJ + hj * 128; g.lda = 2048; g.Bt = (const u16*)(p.ws + WS_SUBK) + (size_t)(l * 2 + j) * 128 * 128; g.ldb = 128; g.KT = 2;
      EpiTop e{(float*)(p.ws + WS_TOP), hj};
      gemm_tile<0, 0>(g, mt * 256, 0, lds, e); }
  } break;
  case 9: peer_cand(p, l, vb, nb, lds); break;
  case 10: case 12: {
    const bool last = l == DEPTH - 1;
    float* xo = dry ? (float*)(p.ws + WS_PD) : p.out;
    int s0, s1, tb, ts;
    if ((nb & 7) == 0) { s0 = vb & 7; s1 = s0 + 1; tb = (vb >> 3) * 8 + wid; ts = (nb >> 3) * 8; } else { s0 = 0; s1 = 8; tb = vb * 8 + wid; ts = nb * 8; }
#pragma unroll 1
    for (int s = s0; s < s1; ++s) { if (sp == 10) peer_slice_phase<false>(p, s, tb, ts, lane, p.out, xo, last); else peer_slice_phase<true>(p, s, tb, ts, lane, p.out, xo, last); }
  } break;
  case 11: {
    const float* pd = (const float*)(p.ws + WS_PD); const float* eg = (const float*)(p.ws + WS_EGATE); u16* cc = (u16*)(p.ws + WS_CC);
    for (size_t i = (size_t)vb * NTHREADS + tid; i < (size_t)T * 128 / 4; i += (size_t)nb * NTHREADS) {
      f32x4 a = *(const f32x4*)(pd + i * 4);
#pragma unroll
      for (int s = 1; s < 8; ++s) a += *(const f32x4*)(pd + (size_t)s * T * 128 + i * 4);
      const f32x4 g = *(const f32x4*)(eg + i * 4);
      f32x4 o; o.x = gelu_erf(a.x * (1.f / PEER_SU)) * g.x * (1.f / PEER_SV); o.y = gelu_erf(a.y * (1.f / PEER_SU)) * g.y * (1.f / PEER_SV);
      o.z = gelu_erf(a.z * (1.f / PEER_SU)) * g.z * (1.f / PEER_SV); o.w = gelu_erf(a.w * (1.f / PEER_SU)) * g.w * (1.f / PEER_SV);
      *(u32x2*)(cc + i * 4) = (u32x2){pk2(o.x, o.y), pk2(o.z, o.w)}; }
  } break;
  }
}

#define XB_TMO      128
#define XB_XCNT(j)  (256  + 64 * (j))
#define XB_XSUB(j)  (1280 + 64 * (j))
#define XB_XGEN(j)  (2304 + 64 * (j))
#define XB_TOP      3328
#define XB_TOPGEN   3392
#define XCD_BAR_WORDS 3456
#define XB_SPIN_CAP (1u << 23)
DEVI unsigned xb_ld(unsigned* p) { return __hip_atomic_load(p, __ATOMIC_RELAXED, __HIP_MEMORY_SCOPE_AGENT); }
DEVI unsigned xb_add(unsigned* p, unsigned v) { return __hip_atomic_fetch_add(p, v, __ATOMIC_RELAXED, __HIP_MEMORY_SCOPE_AGENT); }
DEVI unsigned xb_xcc_id() { return (unsigned)__builtin_amdgcn_s_getreg((3 << 11) | 20) & 0xFu; }
#define XB_SPIN(cond, bar) do { unsigned _sp = 0; while (cond) { __builtin_amdgcn_s_sleep(1); \
    if ((++_sp & 255u) == 0u) { if (xb_ld(&(bar)[XB_TMO])) break; if (_sp > XB_SPIN_CAP) { atomicAdd(&(bar)[XB_TMO], 1u); break; } } } } while (0)
struct XcdBarrier { unsigned* bar; unsigned x; volatile unsigned* st; };
DEVI XcdBarrier xcd_barrier_post(unsigned* bar, volatile unsigned* st) {
  XcdBarrier b; b.bar = bar; b.x = xb_xcc_id(); b.st = st;
  if (threadIdx.x == 0) (void)xb_add(&bar[XB_XCNT(b.x)], 1u);
  return b;
}
DEVI void xcd_barrier_complete(unsigned* bar, unsigned x, unsigned& nloc, unsigned& nx) {
  const unsigned G = gridDim.x * gridDim.y * gridDim.z;
  unsigned sum, cnt, mine, sp = 0u;
  for (;;) {
    sum = 0u; cnt = 0u; mine = 0u;
#pragma unroll
    for (unsigned j = 0; j < 16; ++j) { const unsigned c = xb_ld(&bar[XB_XCNT(j)]); sum += c; cnt += (c > 0u) ? 1u : 0u; mine = (j == x) ? c : mine; }
    if (sum == G) break;
    __builtin_amdgcn_s_sleep(1);
    if ((++sp & 255u) == 0u) { if (xb_ld(&bar[XB_TMO])) break; if (sp > XB_SPIN_CAP) { atomicAdd(&bar[XB_TMO], 1u); break; } }
  }
  nloc = mine > 0u ? mine : 1u; nx = cnt > 0u ? cnt : 1u;
}
DEVI void xcd_barrier(const XcdBarrier& b) {
  asm volatile("s_waitcnt vmcnt(0)" ::: "memory");
  __syncthreads();
  if (threadIdx.x == 0) {
    unsigned* bar = b.bar;
    __builtin_amdgcn_s_waitcnt(0);
    unsigned nloc = b.st[0], nx = b.st[1];
    if (nloc == 0u) { xcd_barrier_complete(bar, b.x, nloc, nx); b.st[0] = nloc; b.st[1] = nx; }
    const unsigned old = xb_add(&bar[XB_XSUB(b.x)], 1u);
    const unsigned gen = old / nloc;
    if (old + 1u == (gen + 1u) * nloc) {
      __builtin_amdgcn_fence(__ATOMIC_RELEASE, "agent");
      asm volatile("s_waitcnt vmcnt(0)" ::: "memory");
      const unsigned og = xb_add(&bar[XB_TOP], 1u);
      const unsigned tg = og / nx;
      if (og + 1u == (tg + 1u) * nx) xb_add(&bar[XB_TOPGEN], 1u);
      else XB_SPIN(xb_ld(&bar[XB_TOPGEN]) == tg, bar);
      __builtin_amdgcn_fence(__ATOMIC_ACQUIRE, "agent");
      xb_add(&bar[XB_XGEN(b.x)], 1u);
      asm volatile("s_waitcnt vmcnt(0)" ::: "memory");
    } else {
      XB_SPIN(xb_ld(&bar[XB_XGEN(b.x)]) == gen, bar);
      __builtin_amdgcn_fence(__ATOMIC_ACQUIRE, "agent");
      asm volatile("s_waitcnt vmcnt(0)" ::: "memory");
    }
  }
  __syncthreads();
}

__global__ void __launch_bounds__(NTHREADS, 2) mega(Params p) {
  extern __shared__ __attribute__((aligned(16))) char smem[];
  cg::grid_group grid = cg::this_grid();
  const int nb = gridDim.x, vb = blockIdx.x;
  volatile unsigned* st = (volatile unsigned*)(smem + LDS_BYTES - 16);
  if (threadIdx.x == 0) { st[0] = 0u; st[1] = 0u; }
  __syncthreads();
  const XcdBarrier bar = xcd_barrier_post((unsigned*)p.ws, st);
#define GRID_BAR(first) do { if (first) grid.sync(); else xcd_barrier(bar); } while (0)
  for (int ph = p.ph_lo; ph < p.ph_hi; ++ph) {
#ifdef PROBE_DUP
    if (ph > 0 && ph < N_PHASES - 1 && ((PROBE_DUP >> ((ph - 1) % PH_PER_LAYER)) & 1)) { run_phase(p, ph + 100, vb, nb, smem); GRID_BAR(false); }
#endif
    run_phase(p, ph, vb, nb, smem);
    if (ph + 1 < p.ph_hi) GRID_BAR(ph == p.ph_lo);
  }
}

#ifndef N_LAUNCH_SPLIT
#define N_LAUNCH_SPLIT 0
#endif
extern "C" void kernel_launch(void* const* d_in, const int* in_sizes, int n_in, void* d_out, int out_size, void* d_ws, size_t ws_size, hipStream_t stream) {
  static int grid_blocks = 0;
  if (grid_blocks == 0) {
    if (n_in != 24 || out_size != T * DM || ws_size < WS_NEED) { fprintf(stderr, "kernel_launch: unexpected shapes n_in %d out %d ws %zu\n", n_in, out_size, ws_size); grid_blocks = -1; return; }
    int dev = 0, cus = 0, per_cu = 0;
    (void)hipGetDevice(&dev); (void)hipDeviceGetAttribute(&cus, hipDeviceAttributeMultiprocessorCount, dev);
    if (hipFuncSetAttribute((const void*)mega, hipFuncAttributeMaxDynamicSharedMemorySize, LDS_BYTES) != hipSuccess) { fprintf(stderr, "kernel_launch: hipFuncSetAttribute failed\n"); grid_blocks = -1; return; }
    if (hipOccupancyMaxActiveBlocksPerMultiprocessor(&per_cu, (const void*)mega, NTHREADS, LDS_BYTES) != hipSuccess || per_cu < 1) { fprintf(stderr, "kernel_launch: occupancy query failed (%d)\n", per_cu); grid_blocks = -1; return; }
    grid_blocks = cus * 1;
    fprintf(stderr, "kernel_launch: cus %d per_cu %d grid %d\n", cus, per_cu, grid_blocks);
  }
  if (grid_blocks < 0) return;
  if (hipMemsetAsync(d_ws, 0, 65536, stream) != hipSuccess) { fprintf(stderr, "kernel_launch: memset failed\n"); return; }
  Params p{};
  p.x = (const float*)d_in[0]; p.pos = (const int*)d_in[1]; p.norm_mix = (const float*)d_in[2]; p.w_in = (const float*)d_in[3]; p.q_norm = (const float*)d_in[4];
  p.w_uq = (const float*)d_in[5]; p.kv_norm = (const float*)d_in[6]; p.w_ukv = (const float*)d_in[7]; p.conv_w = (const float*)d_in[8]; p.conv_b = (const float*)d_in[9];
  p.lru_wa = (const float*)d_in[10]; p.lru_ba = (const float*)d_in[11]; p.lru_wx = (const float*)d_in[12]; p.lru_bx = (const float*)d_in[13]; p.lru_lambda = (const float*)d_in[14];
  p.swa_sink = (const float*)d_in[15]; p.grp_norm = (const float*)d_in[16]; p.w_out = (const float*)d_in[17]; p.norm_ffn = (const float*)d_in[18]; p.peer_wq = (const float*)d_in[19];
  p.peer_subkeys = (const float*)d_in[20]; p.peer_u = (const float*)d_in[21]; p.peer_v = (const float*)d_in[22]; p.norm_final = (const float*)d_in[23];
  p.out = (float*)d_out; p.ws = (unsigned char*)d_ws;
#if N_LAUNCH_SPLIT
  for (int ph = 0; ph < N_PHASES; ++ph) {
    p.ph_lo = ph; p.ph_hi = ph + 1;
    void* args[] = {&p};
    hipError_t e = hipLaunchCooperativeKernel((const void*)mega, dim3(grid_blocks), dim3(NTHREADS), args, LDS_BYTES, stream);
    if (e != hipSuccess) { fprintf(stderr, "kernel_launch: launch of phase %d failed: %s\n", ph, hipGetErrorString(e)); break; }
  }
#else
  p.ph_lo = 0; p.ph_hi = N_PHASES;
  void* args[] = {&p};
  hipError_t e = hipLaunchCooperativeKernel((const void*)mega, dim3(grid_blocks), dim3(NTHREADS), args, LDS_BYTES, stream);
  if (e != hipSuccess) fprintf(stderr, "kernel_launch: cooperative launch failed: %s (grid %d)\n", hipGetErrorString(e), grid_blocks);
#endif
}
```

```cpp
#include <hip/hip_runtime.h>
#include <hip/hip_cooperative_groups.h>
#include <cstdio>
#include <cstdint>
namespace cg = cooperative_groups;

#define DEVI __device__ __forceinline__
typedef unsigned short u16;
typedef short bf16x8 __attribute__((ext_vector_type(8)));
typedef short s16x4 __attribute__((ext_vector_type(4)));
typedef float f32x2 __attribute__((ext_vector_type(2)));
typedef float f32x4 __attribute__((ext_vector_type(4)));
typedef float f32x16 __attribute__((ext_vector_type(16)));
typedef unsigned u32x4 __attribute__((ext_vector_type(4)));
typedef unsigned u32x2 __attribute__((ext_vector_type(2)));
typedef __bf16 bf16x2_t __attribute__((ext_vector_type(2)));

constexpr int NB = 4, SEQ = 8192, T = NB * SEQ, DM = 1024, DEPTH = 2;
constexpr int MLA_H = 6, MLA_QK = 96, MLA_V = 64;
constexpr int LRU_W = 384;
constexpr int INW = 1696, INWP = 1792;
constexpr int PC_CQ = 0, PC_CKV = 256, PC_SQ = 384, PC_SK = 640, PC_SV = 768, PC_LX = 896, PC_LG = 1280, PC_KR = 1664;
constexpr int OC_CQ = 0, OC_CKV = 256, OC_KR = 384, OC_SQ = 416, OC_SK = 672, OC_SV = 800, OC_LX = 928, OC_LG = 1312;
constexpr int NEXP = 16384;
constexpr float EPS = 1e-6f;
constexpr int NTHREADS = 512;
constexpr int LDS_BYTES = 160 * 1024;

constexpr size_t MiB = 1u << 20;
constexpr size_t WS_CTL = 0;
constexpr size_t WS_WIN = 4 * MiB;
constexpr size_t WS_WQ = 11 * MiB;
constexpr size_t WS_WOUT = 19 * MiB;
constexpr size_t WS_WUQ = 23 * MiB;
constexpr size_t WS_WUKV = WS_WUQ + 2 * 640 * 256 * 2;
constexpr size_t WS_WLRU = WS_WUKV + 2 * 768 * 128 * 2;
constexpr size_t WS_SUBK = WS_WLRU + 2 * 6 * 2 * 128 * 64 * 2;
constexpr size_t WS_XG = 25 * MiB;
constexpr size_t WS_R1 = 89 * MiB;
constexpr size_t WS_QM = 217 * MiB;
constexpr size_t WS_KM = 253 * MiB;
constexpr size_t WS_VM = 289 * MiB;
constexpr size_t WS_LE = 313 * MiB;
constexpr size_t WS_LB = 361 * MiB;
constexpr size_t WS_MIX = 409 * MiB;
constexpr size_t WS_UB = 217 * MiB;
constexpr size_t WS_VB = 233 * MiB;
constexpr size_t WS_TOP = 281 * MiB;
constexpr size_t WS_EIDX = 313 * MiB;
constexpr size_t WS_EGATE = 329 * MiB;
constexpr size_t WS_CC = 345 * MiB;
constexpr size_t WS_SSQ = 361 * MiB;
constexpr size_t WS_SSQ16 = 363 * MiB;
constexpr size_t WS_PD = 89 * MiB;
constexpr float PEER_SU = 256.f, PEER_SV = 16.f;
constexpr size_t WS_END = 473 * MiB;

__device__ const float ROPE_HI[32] = {1.591549367e-01f, 1.193493679e-01f, 8.949939907e-02f, 6.711508334e-02f, 5.032921210e-02f, 3.774158657e-02f, 2.830219641e-02f, 2.122365311e-02f, 1.591549441e-02f, 1.193493698e-02f, 8.949940093e-03f, 6.711508147e-03f, 5.032921210e-03f, 3.774158424e-03f, 2.830219688e-03f, 2.122365171e-03f, 1.591549488e-03f, 1.193493721e-03f, 8.949940093e-04f, 6.711508031e-04f, 5.032921326e-04f, 3.774158540e-04f, 2.830219455e-04f, 2.122365258e-04f, 1.591549371e-04f, 1.193493736e-04f, 8.949940093e-05f, 6.711508468e-05f, 5.032921035e-05f, 3.774158540e-05f, 2.830219637e-05f, 2.122365186e-05f};
__device__ const float ROPE_LO[32] = {6.420638243e-09f, 2.294664903e-09f, 2.542919653e-09f, -3.316028840e-10f, 5.173299289e-12f, -1.848551645e-09f, -5.826552019e-10f, -3.431038786e-10f, -1.029942243e-10f, 4.320196978e-11f, 6.802744479e-11f, 1.531042237e-10f, 5.173301024e-13f, 4.797548470e-11f, -1.048316434e-10f, 1.053879969e-10f, -5.686555046e-11f, -1.896286773e-11f, 6.802744999e-12f, 2.695195456e-11f, -1.158979943e-11f, -6.843983713e-12f, 1.279990003e-11f, 1.807650600e-12f, 5.954976963e-12f, -3.351478166e-12f, 6.802744674e-13f, -1.670379113e-12f, 1.751403167e-12f, -6.843983930e-13f, -5.389994549e-13f, 9.083608431e-13f};

DEVI int tidx() { int t = __builtin_amdgcn_workitem_id_x(); asm volatile("" : "+v"(t)); return t; }
DEVI float bf2f(unsigned h) { return __uint_as_float(h << 16); }
DEVI float bflo(unsigned w) { return __uint_as_float(w << 16); }
DEVI float bfhi(unsigned w) { return __uint_as_float(w & 0xffff0000u); }
DEVI unsigned pk2(float lo, float hi) { f32x2 v = {lo, hi}; bf16x2_t b = __builtin_convertvector(v, bf16x2_t); return __builtin_bit_cast(unsigned, b); }
DEVI u16 f2bf(float f) { return (u16)(pk2(f, 0.f) & 0xffffu); }
DEVI u32x4 pk8(const float* v) { u32x4 w; w.x = pk2(v[0], v[1]); w.y = pk2(v[2], v[3]); w.z = pk2(v[4], v[5]); w.w = pk2(v[6], v[7]); return w; }
DEVI void unpk8(u32x4 w, float* v) { v[0] = bflo(w.x); v[1] = bfhi(w.x); v[2] = bflo(w.y); v[3] = bfhi(w.y); v[4] = bflo(w.z); v[5] = bfhi(w.z); v[6] = bflo(w.w); v[7] = bfhi(w.w); }
DEVI void ld8(const float* p, float* v) { const f32x4 a = *(const f32x4*)p, b = *(const f32x4*)(p + 4); v[0] = a.x; v[1] = a.y; v[2] = a.z; v[3] = a.w; v[4] = b.x; v[5] = b.y; v[6] = b.z; v[7] = b.w; }
DEVI int crow(int r, int hi) { return (r & 3) + 8 * (r >> 2) + 4 * hi; }
DEVI float wave_sum(float v) {
#pragma unroll
  for (int o = 1; o < 64; o <<= 1) v += __shfl_xor(v, o);
  return v;
}
DEVI void rope_sc(float pos, int fidx, float& sn, float& cs) {
  const float chi = ROPE_HI[fidx], clo = ROPE_LO[fidx];
  const float t = pos * chi, e = fmaf(pos, chi, -t);
  float fr = t - rintf(t);
  fr = fr + (e + pos * clo);
  sn = __builtin_amdgcn_sinf(fr); cs = __builtin_amdgcn_cosf(fr);
}
DEVI float sigmoidf_(float x) { return 1.f / (1.f + __expf(-x)); }
DEVI float gelu_erf(float x) { return 0.5f * x * (1.f + erff(x * 0.70710678118654752f)); }

struct Params {
  const float* x; const int* pos; const float* norm_mix; const float* w_in; const float* q_norm; const float* w_uq; const float* kv_norm; const float* w_ukv;
  const float* conv_w; const float* conv_b; const float* lru_wa; const float* lru_ba; const float* lru_wx; const float* lru_bx; const float* lru_lambda;
  const float* swa_sink; const float* grp_norm; const float* w_out; const float* norm_ffn; const float* peer_wq; const float* peer_subkeys;
  const float* peer_u; const float* peer_v; const float* norm_final;
  float* out; unsigned char* ws;
  int ph_lo, ph_hi;
};

DEVI void tconv_item(const float* W, int ldw, int src_c0, u16* WT, int K, int dst_r0, const float* gain, float* scr, int kb, int nb, int lane, int pg = 0) {
  const int k0 = 64 * kb, n0 = 32 * nb;
#pragma unroll 8
  for (int i = 0; i < 32; ++i) { const int kk = 2 * i + (lane >> 5); float g = gain ? gain[k0 + kk] : 1.f; scr[kk * 33 + (lane & 31)] = g * W[(size_t)(k0 + kk) * ldw + src_c0 + n0 + (lane & 31)]; }
  __builtin_amdgcn_s_waitcnt(0xc07f); asm volatile("" ::: "memory");
  const int c = lane & 7;
#pragma unroll
  for (int j = 0; j < 4; ++j) { const int n = (lane >> 3) + 8 * j; const float* s = scr + (8 * c) * 33 + n;
    u32x4 o; o.x = pk2(s[0 * 33], s[1 * 33]); o.y = pk2(s[2 * 33], s[3 * 33]); o.z = pk2(s[4 * 33], s[5 * 33]); o.w = pk2(s[6 * 33], s[7 * 33]);
    int nn = n0 + n; if (pg) { const int g = nn & ~(pg - 1), i = nn & (pg - 1), hw = pg >> 1; nn = g + (i < hw ? 2 * i : 2 * (i - hw) + 1); }
    *(u32x4*)(WT + (size_t)(dst_r0 + nn) * K + k0 + 8 * c) = o; }
  __builtin_amdgcn_s_waitcnt(0xc07f); asm volatile("" ::: "memory");
}

DEVI void p0_item(const Params& p, int it, float* scr, int lane) {
  const int l = it / 2552; int r = it - l * 2552;
  const float* win = p.w_in + (size_t)l * DM * INW; u16* wint = (u16*)(p.ws + WS_WIN) + (size_t)l * INWP * DM; const float* gm = p.norm_mix + l * DM;
#define SEG(W, ldw, sc0, ncols, WT, K, dr0, gain, pg) { const int nnb_ = (ncols) / 32, ni_ = ((K) / 64) * nnb_; if (r < ni_) { tconv_item(W, ldw, sc0, WT, K, dr0, gain, scr, r / nnb_, r % nnb_, lane, pg); return; } r -= ni_; }
  SEG(win, INW, OC_CQ, 256, wint, DM, PC_CQ, gm, 0)
  SEG(win, INW, OC_CKV, 128, wint, DM, PC_CKV, gm, 0)
  SEG(win, INW, OC_SQ, 256, wint, DM, PC_SQ, gm, 64)
  SEG(win, INW, OC_SK, 128, wint, DM, PC_SK, gm, 64)
  SEG(win, INW, OC_SV, 128, wint, DM, PC_SV, gm, 0)
  SEG(win, INW, OC_LX, 384, wint, DM, PC_LX, gm, 0)
  SEG(win, INW, OC_LG, 384, wint, DM, PC_LG, gm, 0)
  SEG(win, INW, OC_KR, 32, wint, DM, PC_KR, gm, 32)
  SEG(p.peer_wq + (size_t)l * DM * 2048, 2048, 0, 2048, (u16*)(p.ws + WS_WQ) + (size_t)l * 2048 * DM, DM, 0, p.norm_ffn + l * DM, 0)
  SEG(p.w_out + (size_t)l * DM * DM, DM, 0, DM, (u16*)(p.ws + WS_WOUT) + (size_t)l * DM * DM, DM, 0, p.grp_norm + l * DM, 0)
  SEG(p.w_uq + (size_t)l * 256 * 576, 576, 0, 576, (u16*)(p.ws + WS_WUQ) + (size_t)l * 640 * 256, 256, 0, p.q_norm + l * 256, 0)
  SEG(p.w_ukv + (size_t)l * 128 * 768, 768, 0, 768, (u16*)(p.ws + WS_WUKV) + (size_t)l * 768 * 128, 128, 0, p.kv_norm + l * 128, 0)
#undef SEG
  { const int nbk = r & 1, ax = (r >> 1) & 1, n = (r >> 2) % 6, d = (r >> 2) / 6;
    const float* W = (ax ? p.lru_wx : p.lru_wa) + ((size_t)(l * 2 + d) * 6 + n) * 4096;
    u16* WT = (u16*)(p.ws + WS_WLRU) + ((size_t)((l * 6 + n) * 2 + d)) * 128 * 64;
    tconv_item(W, 64, 0, WT, 64, ax * 64, nullptr, scr, 0, nbk, lane); }
}

DEVI void phase0(const Params& p, int vb, int nb, char* lds) {
  const int tid = tidx(), lane = tid & 63, wid = tid >> 6;
  float* scr = (float*)(lds + wid * 16384);
  const int gw = vb * 8 + wid, ngw = nb * 8;
  for (int it = gw; it < DEPTH * 2552; it += ngw) p0_item(p, it, scr, lane);
  for (int i = vb * NTHREADS + tid; i < DEPTH * 96 * DM / 8; i += nb * NTHREADS) { const int l = i / (96 * DM / 8), r = i % (96 * DM / 8);
    *(u32x4*)((u16*)(p.ws + WS_WIN) + ((size_t)l * INWP + INW) * DM + (size_t)r * 8) = (u32x4){0, 0, 0, 0}; }
  for (int i = vb * NTHREADS + tid; i < DEPTH * 64 * 256 / 8; i += nb * NTHREADS) { const int l = i / (64 * 256 / 8), r = i % (64 * 256 / 8);
    *(u32x4*)((u16*)(p.ws + WS_WUQ) + ((size_t)l * 640 + 576) * 256 + (size_t)r * 8) = (u32x4){0, 0, 0, 0}; }
  for (int i = vb * NTHREADS + tid; i < DEPTH * 2 * 128 * 128 / 8; i += nb * NTHREADS) {
    float a[8]; ld8(p.peer_subkeys + (size_t)i * 8, a);
    *(u32x4*)((u16*)(p.ws + WS_SUBK) + (size_t)i * 8) = pk8(a); }
  { float* ssq = (float*)(p.ws + WS_SSQ); u16* xg = (u16*)(p.ws + WS_XG);
    for (int t = gw * 2; t < T; t += ngw * 2) {
      float a[2][16];
#pragma unroll
      for (int u = 0; u < 2; ++u) { ld8(p.x + (size_t)(t + u) * DM + lane * 16, a[u]); ld8(p.x + (size_t)(t + u) * DM + lane * 16 + 8, a[u] + 8); }
#pragma unroll
      for (int u = 0; u < 2; ++u) { float s = 0.f;
#pragma unroll
        for (int q = 0; q < 16; ++q) s = fmaf(a[u][q], a[u][q], s);
        s += __shfl_xor(s, 1); s += __shfl_xor(s, 2); s += __shfl_xor(s, 4);
        if ((lane & 7) == 0) ssq[(size_t)(t + u) * 8 + (lane >> 3)] = s;
        u32x4* o = (u32x4*)(xg + (size_t)(t + u) * DM + lane * 16); o[0] = pk8(a[u]); o[1] = pk8(a[u] + 8); } } }
}

DEVI int swz(int row, int c) { return row * 128 + ((c ^ ((row >> 1) & 7)) << 4); }
constexpr int CLD = 132;
constexpr int LDS_RS = 135168;

struct GemmDesc {
  const u16* A; int lda; const u16* Bt; int ldb; int KT;
  float inv0;
  const u16* proj; const float* cw; const float* cb; int ch0;
};

template <int AMODE> DEVI bf16x8 load_a(const GemmDesc& g, int row, int kcol) {
  if constexpr (AMODE == 0) {
    return *(const bf16x8*)(g.A + (size_t)row * g.lda + kcol);
  } else {
    const int s = row & (SEQ - 1), ch = g.ch0 + kcol;
    float a[8];
    { const f32x4 b0 = *(const f32x4*)(g.cb + ch), b1 = *(const f32x4*)(g.cb + ch + 4); a[0] = b0.x; a[1] = b0.y; a[2] = b0.z; a[3] = b0.w; a[4] = b1.x; a[5] = b1.y; a[6] = b1.z; a[7] = b1.w; }
#pragma unroll
    for (int tap = 0; tap < 4; ++tap) {
      const int ss = s - 1 + tap;
      if (ss >= 0 && ss < SEQ) {
        const u32x4 v = *(const u32x4*)(g.proj + (size_t)(row - 1 + tap) * INWP + PC_LX + ch);
        float x[8]; unpk8(v, x);
        const f32x4 w0 = *(const f32x4*)(g.cw + tap * LRU_W + ch), w1 = *(const f32x4*)(g.cw + tap * LRU_W + ch + 4);
        a[0] += w0.x * x[0]; a[1] += w0.y * x[1]; a[2] += w0.z * x[2]; a[3] += w0.w * x[3];
        a[4] += w1.x * x[4]; a[5] += w1.y * x[5]; a[6] += w1.z * x[6]; a[7] += w1.w * x[7];
      }
    }
    const u32x4 o = pk8(a);
    return __builtin_bit_cast(bf16x8, o);
  }
}

template <int AMODE> DEVI void g_load(const GemmDesc& g, bf16x8 (&ar)[4], bf16x8 (&br)[2], int m0, int n0, int srow, int sc, int kt) {
#pragma unroll
  for (int i = 0; i < 4; ++i) ar[i] = load_a<AMODE>(g, m0 + srow + 64 * i, kt * 64 + sc * 8);
#pragma unroll
  for (int i = 0; i < 2; ++i) br[i] = *(const bf16x8*)(g.Bt + (size_t)(n0 + srow + 64 * i) * g.ldb + kt * 64 + sc * 8);
}
template <bool NORM> DEVI void g_write(char* Ab, const bf16x8 (&ar)[4], const bf16x8 (&br)[2], float (&ssq)[4], int srow, int sc) {
  char* Bb = Ab + 32768;
#pragma unroll
  for (int i = 0; i < 4; ++i) { *(bf16x8*)(Ab + swz(srow + 64 * i, sc)) = ar[i];
    if (NORM) { float x[8]; unpk8(__builtin_bit_cast(u32x4, ar[i]), x); float s = ssq[i];
#pragma unroll
      for (int q = 0; q < 8; ++q) s = fmaf(x[q], x[q], s);
      ssq[i] = s; } }
#pragma unroll
  for (int i = 0; i < 2; ++i) *(bf16x8*)(Bb + swz(srow + 64 * i, sc)) = br[i];
}

template <int AMODE, int SEG, class Epi>
DEVI void gemm_tile(const GemmDesc& g, int m0, int n0, char* lds, const Epi& epi) {
  const int tid = tidx(), lane = tid & 63, wid = tid >> 6;
  const int wm = wid >> 1, wn = wid & 1, r32 = lane & 31, hi = lane >> 5;
  const int srow = tid >> 3, sc = tid & 7;
  constexpr bool NORM = SEG != 0;
  float* rs = (float*)(lds + LDS_RS);
  f32x16 acc[2][2], acc2[2][2];
#pragma unroll
  for (int i = 0; i < 2; ++i)
#pragma unroll
    for (int j = 0; j < 2; ++j) { acc[i][j] = f32x16{}; acc2[i][j] = f32x16{}; }
  float ssq[4] = {0.f, 0.f, 0.f, 0.f};
  bf16x8 ar[4], br[2];
  g_load<AMODE>(g, ar, br, m0, n0, srow, sc, 0); g_write<NORM>(lds, ar, br, ssq, srow, sc); __syncthreads();
  int seg = 0;
#pragma unroll 1
  for (int kt = 0; kt < g.KT; ++kt) {
    const int cur = kt & 1;
    if (kt + 1 < g.KT) g_load<AMODE>(g, ar, br, m0, n0, srow, sc, kt + 1);
    { const char* Ab = lds + cur * 49152; const char* Bb = Ab + 32768;
#pragma unroll
      for (int k16 = 0; k16 < 4; ++k16) {
        bf16x8 a[2], b[2];
#pragma unroll
        for (int mt = 0; mt < 2; ++mt) a[mt] = *(const bf16x8*)(Ab + swz(wm * 64 + mt * 32 + r32, k16 * 2 + hi));
#pragma unroll
        for (int nt = 0; nt < 2; ++nt) b[nt] = *(const bf16x8*)(Bb + swz(wn * 64 + nt * 32 + r32, k16 * 2 + hi));
#pragma unroll
        for (int mt = 0; mt < 2; ++mt)
#pragma unroll
          for (int nt = 0; nt < 2; ++nt) {
            if (NORM) acc2[mt][nt] = __builtin_amdgcn_mfma_f32_32x32x16_bf16(a[mt], b[nt], acc2[mt][nt], 0, 0, 0);
            else acc[mt][nt] = __builtin_amdgcn_mfma_f32_32x32x16_bf16(a[mt], b[nt], acc[mt][nt], 0, 0, 0);
          }
      } }
    if (NORM) {
      int se; float inv;
      if (SEG == 1) { se = g.KT; inv = g.inv0; }
      else { se = seg == 0 ? 6 : (seg == 1 ? 12 : 16); inv = seg == 2 ? (1.f / 256.f) : (1.f / 384.f); }
      if (kt + 1 == se) {
#pragma unroll
        for (int i = 0; i < 4; ++i) { float s = ssq[i]; s += __shfl_xor(s, 1); s += __shfl_xor(s, 2); s += __shfl_xor(s, 4); if (sc == 0) rs[srow + 64 * i] = rsqrtf(s * inv + EPS); }
        __syncthreads();
#pragma unroll
        for (int mt = 0; mt < 2; ++mt)
#pragma unroll
          for (int r = 0; r < 16; ++r) { const float f = rs[wm * 64 + mt * 32 + crow(r, hi)];
#pragma unroll
            for (int nt = 0; nt < 2; ++nt) { acc[mt][nt][r] = fmaf(f, acc2[mt][nt][r], acc[mt][nt][r]); acc2[mt][nt][r] = 0.f; } }
        ssq[0] = ssq[1] = ssq[2] = ssq[3] = 0.f;
        ++seg;
      }
    }
    if (kt + 1 < g.KT) g_write<NORM>(lds + (cur ^ 1) * 49152, ar, br, ssq, srow, sc);
    __syncthreads();
  }
  float* C = (float*)lds;
#pragma unroll
  for (int mt = 0; mt < 2; ++mt)
#pragma unroll
    for (int nt = 0; nt < 2; ++nt)
#pragma unroll
      for (int r = 0; r < 16; ++r) C[(wm * 64 + mt * 32 + crow(r, hi)) * CLD + wn * 64 + nt * 32 + r32] = acc[mt][nt][r];
  __syncthreads();
  epi(C, m0, n0);
  __syncthreads();
}

DEVI GemmDesc gemm_desc(const u16* A, int lda, const u16* Bt, int ldb, int K) {
  GemmDesc g{}; g.A = A; g.lda = lda; g.Bt = Bt; g.ldb = ldb; g.KT = K / 64; g.inv0 = 1.f / (float)K; return g;
}


template <int HW> DEVI void rope8(float* v, const float* pp, int i0, float posf) {
  const bool first = i0 < HW; const int f0 = i0 & (HW - 1);
#pragma unroll
  for (int j = 0; j < 8; ++j) { float sn, cs; rope_sc(posf, HW == 32 ? (f0 + j) : 2 * (f0 + j), sn, cs); const float pv = pp[j]; v[j] = first ? v[j] * cs - pv * sn : v[j] * cs + pv * sn; }
}

struct EpiP1 { u16* proj; const int* pos;
  DEVI void operator()(const float* C, int m0, int n0) const {
    const int tid = tidx();
#pragma unroll 1
    for (int it = 0; it < 8; ++it) { const int item = it * NTHREADS + tid, row = item >> 4, c8 = (item & 15) * 8, gcol = n0 + c8, grow = m0 + row;
      float v[8]; ld8(C + row * CLD + c8, v);
      const bool r64 = gcol >= PC_SQ && gcol < PC_SV, r32g = gcol >= PC_KR && gcol < PC_KR + 32;
      if (r64) { const int i0 = gcol & 63; float pp[8]; ld8(C + row * CLD + c8 + (i0 < 32 ? 32 : -32), pp); rope8<32>(v, pp, i0, (float)pos[grow]); }
      else if (r32g) { const int i0 = gcol & 31; float pp[8]; ld8(C + row * CLD + c8 + (i0 < 16 ? 16 : -16), pp); rope8<16>(v, pp, i0, (float)pos[grow]); }
      *(u32x4*)(proj + (size_t)grow * INWP + gcol) = pk8(v);
    }
  }
};

struct EpiQ { u16* qm; const int* pos;
  DEVI void operator()(const float* C, int m0, int n0) const {
    const int tid = tidx();
#pragma unroll 1
    for (int it = 0; it < 8; ++it) { const int item = it * NTHREADS + tid, row = item >> 4, c8 = (item & 15) * 8, gcol = n0 + c8, grow = m0 + row;
      if (gcol >= 576) continue;
      const int head = gcol / 96, j0 = gcol - head * 96, b = grow >> 13, s = grow & (SEQ - 1);
      float v[8]; ld8(C + row * CLD + c8, v);
      u16* qrow = qm + ((size_t)(b * MLA_H + head) * SEQ + s) * MLA_QK;
      if (j0 >= 64) { const int i0 = j0 - 64; float pp[8]; ld8(C + row * CLD + c8 + (i0 < 16 ? 16 : -16), pp); rope8<16>(v, pp, i0, (float)pos[grow]);
#pragma unroll
        for (int j = 0; j < 8; ++j) { const int i = i0 + j; qrow[64 + (i < 16 ? 2 * i : 2 * (i - 16) + 1)] = f2bf(v[j]); } }
      else *(u32x4*)(qrow + j0) = pk8(v);
    }
  }
};

struct EpiKV { u16* km; u16* vm; const u16* proj;
  DEVI void operator()(const float* C, int m0, int n0) const {
    const int tid = tidx(), head = n0 >> 7;
#pragma unroll 1
    for (int it = 0; it < 8; ++it) { const int item = it * NTHREADS + tid, row = item >> 4, c8 = (item & 15) * 8, grow = m0 + row;
      const int b = grow >> 13, s = grow & (SEQ - 1);
      float v[8]; ld8(C + row * CLD + c8, v);
      const size_t tok = (size_t)(b * MLA_H + head) * SEQ + s;
      if (c8 < 64) *(u32x4*)(km + tok * MLA_QK + c8) = pk8(v);
      else *(u32x4*)(vm + tok * MLA_V + (c8 - 64)) = pk8(v);
    }
#pragma unroll 1
    for (int it = 0; it < 2; ++it) { const int item = it * NTHREADS + tid, row = item >> 2, c = (item & 3) * 8, grow = m0 + row;
      const int b = grow >> 13, s = grow & (SEQ - 1);
      *(u32x4*)(km + ((size_t)(b * MLA_H + head) * SEQ + s) * MLA_QK + 64 + c) = *(const u32x4*)(proj + (size_t)grow * INWP + PC_KR + c);
    }
  }
};

struct EpiLRU { const u16* proj; const float* cw; const float* cb; const float* ba; const float* bx; const float* lam; u16* le; u16* lb; int n, d;
  DEVI void operator()(const float* C, int m0, int) const {
    const int tid = tidx();
#pragma unroll 1
    for (int it = 0; it < 4; ++it) { const int item = it * NTHREADS + tid, j = item & 63, g8 = item >> 6;
      const int ch = n * 64 + j, grow0 = m0 + g8 * 8, s0 = grow0 & (SEQ - 1), b = grow0 >> 13;
      const float bav = ba[(d * 6 + n) * 64 + j], bxv = bx[(d * 6 + n) * 64 + j];
      const float cdec = -8.f * log1pf(__expf(-lam[d * LRU_W + ch]));
      float xin[11];
#pragma unroll
      for (int q = 0; q < 11; ++q) { const int ss = s0 - 1 + q; xin[q] = (ss >= 0 && ss < SEQ) ? bf2f(proj[(size_t)(grow0 - 1 + q) * INWP + PC_LX + ch]) : 0.f; }
      const float w0 = cw[ch], w1 = cw[LRU_W + ch], w2 = cw[2 * LRU_W + ch], w3 = cw[3 * LRU_W + ch], cbv = cb[ch];
      float ev[8], bv[8];
#pragma unroll
      for (int rr = 0; rr < 8; ++rr) {
        const float xf = cbv + w0 * xin[rr] + w1 * xin[rr + 1] + w2 * xin[rr + 2] + w3 * xin[rr + 3];
        const float r = sigmoidf_(C[(g8 * 8 + rr) * CLD + j] + bav), ig = sigmoidf_(C[(g8 * 8 + rr) * CLD + 64 + j] + bxv);
        const float a = __expf(cdec * r), e = 1.f - a;
        ev[rr] = e; bv[rr] = sqrtf(e * (2.f - e)) * ig * xf;
      }
      const size_t o = (((size_t)(d * NB + b) * (SEQ / 8) + (s0 >> 3)) * LRU_W + ch) * 8;
      *(u32x4*)(le + o) = pk8(ev); *(u32x4*)(lb + o) = pk8(bv);
    }
  }
};

struct EpiP4 { const float* xres; float* xout; u16* xg;
  DEVI void operator()(const float* C, int m0, int n0) const {
    const int tid = tidx();
#pragma unroll 1
    for (int it = 0; it < 8; ++it) { const int item = it * NTHREADS + tid, row = item >> 4, c8 = (item & 15) * 8, gcol = n0 + c8, grow = m0 + row;
      float v[8], x[8]; ld8(C + row * CLD + c8, v); ld8(xres + (size_t)grow * DM + gcol, x);
#pragma unroll
      for (int j = 0; j < 8; ++j) v[j] += x[j];
      *(f32x4*)(xout + (size_t)grow * DM + gcol) = (f32x4){v[0], v[1], v[2], v[3]}; *(f32x4*)(xout + (size_t)grow * DM + gcol + 4) = (f32x4){v[4], v[5], v[6], v[7]};
      *(u32x4*)(xg + (size_t)grow * DM + gcol) = pk8(v);
    }
  }
};

struct EpiBf16 { u16* o; int ldo;
  DEVI void operator()(const float* C, int m0, int n0) const {
    const int tid = tidx();
#pragma unroll 1
    for (int it = 0; it < 8; ++it) { const int item = it * NTHREADS + tid, row = item >> 4, c8 = (item & 15) * 8;
      float v[8]; ld8(C + row * CLD + c8, v);
      *(u32x4*)(o + (size_t)(m0 + row) * ldo + n0 + c8) = pk8(v);
    }
  }
};

DEVI void ce_desc(float& a, float& b) { const float mx = fmaxf(a, b), mn = fminf(a, b); a = mx; b = mn; }
struct EpiTop { float* top; int hj;
  DEVI void operator()(const float* C, int m0, int) const {
    const int tid = tidx(), row = tid >> 1, part = tid & 1;
    float l[16];
#pragma unroll
    for (int i = 0; i < 16; ++i) l[i] = -3.0e38f;
#pragma unroll 4
    for (int c = 0; c < 64; ++c) { const int col = part * 64 + ((c + row) & 63);
      float v = __uint_as_float((__float_as_uint(C[row * CLD + col]) & ~127u) | (unsigned)(127 - col));
#pragma unroll
      for (int i = 0; i < 16; ++i) { const float t = fmaxf(l[i], v); v = fminf(l[i], v); l[i] = t; } }
    float m[16];
#pragma unroll
    for (int i = 0; i < 16; ++i) m[i] = __shfl_xor(l[15 - i], 1);
#pragma unroll
    for (int i = 0; i < 16; ++i) m[i] = fmaxf(m[i], l[i]);
#pragma unroll
    for (int st = 8; st >= 1; st >>= 1)
#pragma unroll
      for (int i = 0; i < 16; ++i) if ((i & st) == 0) ce_desc(m[i], m[i + st]);
    if (part == 0) { float* o = top + ((size_t)(m0 + row) * 16 + hj) * 16;
#pragma unroll
      for (int i = 0; i < 4; ++i) *(f32x4*)(o + 4 * i) = (f32x4){m[4 * i], m[4 * i + 1], m[4 * i + 2], m[4 * i + 3]}; }
  }
};

#define KSWZ(row, colB) ((row) * 256 + ((colB) ^ (((row) & 15) << 4)))
#define SBAR() __builtin_amdgcn_sched_barrier(0)
constexpr int AT_SHM_V = 64 * 64 * 2, AT_SHM_K = 64 * 128 * 2;
constexpr int AT_LDS = 3 * AT_SHM_V + 2 * AT_SHM_K + 8 * 64 * 4;
constexpr float ATT_THR = 8.f;
DEVI unsigned cvtpk(float lo, float hi) { unsigned r; asm volatile("v_cvt_pk_bf16_f32 %0, %1, %2" : "=v"(r) : "v"(lo), "v"(hi)); return r; }
DEVI int v_st(int k, int c) { const int kk = (k & ~0xC) | ((k & 4) << 1) | ((k & 8) >> 1); return ((kk >> 3) * 2 + (c >> 5)) * 512 + ((kk & 7) * 32 + (c & 31)) * 2; }
DEVI int v_rd_base(int lane) { return ((lane & 3) << 3) | (((lane >> 2) & 3) << 6) | (((lane >> 4) & 1) << 5) | (((lane >> 5) & 1) << 8); }
constexpr int v_rd_off(int d0, int ks, int half) { return d0 * 512 + ks * 2048 + half * 1024; }
template <int OFF> DEVI s16x4 tr_read(int vb) { s16x4 r; asm volatile("ds_read_b64_tr_b16 %0, %1 offset:%2" : "=&v"(r) : "v"(vb), "i"(OFF) : "memory"); return r; }

template <bool MASK>
DEVI void partialSM(f32x16& p0, f32x16& p1, float& m_reg, float& mn, float& alpha, float SCALE, int kpos0, int qpos, int hi) {
  const float C = SCALE * 1.4426950408889634f;
  if (MASK) {
#pragma unroll
    for (int r = 0; r < 16; ++r) { const int k0 = kpos0 + crow(r, hi) - qpos; const int k1 = k0 + 32;
      if (k0 > 128 || k0 < -128) p0[r] = -1e30f;
      if (k1 > 128 || k1 < -128) p1[r] = -1e30f; }
  }
  float pmax = p0[0];
#pragma unroll
  for (int r = 1; r < 16; ++r) pmax = fmaxf(pmax, p0[r]);
#pragma unroll
  for (int r = 0; r < 16; ++r) pmax = fmaxf(pmax, p1[r]);
  { auto rr = __builtin_amdgcn_permlane32_swap(__float_as_uint(pmax), __float_as_uint(pmax), false, false);
    pmax = fmaxf(__uint_as_float(rr[0]), __uint_as_float(rr[1])); }
  if (__builtin_expect(__all(pmax - m_reg <= ATT_THR / SCALE), 1)) { mn = m_reg; alpha = 1.f; }
  else { mn = fmaxf(m_reg, pmax); alpha = __builtin_amdgcn_exp2f((m_reg - mn) * C); m_reg = mn; }
  const float mnC = -mn * C;
#pragma unroll
  for (int r = 0; r < 16; ++r) p0[r] = fmaf(p0[r], C, mnC);
#pragma unroll
  for (int r = 0; r < 16; ++r) p1[r] = fmaf(p1[r], C, mnC);
#pragma unroll
  for (int r = 0; r < 16; ++r) p0[r] = __builtin_amdgcn_exp2f(p0[r]);
}
DEVI void finishSM(f32x16& p0, f32x16& p1, float alpha, float& l_reg, bf16x8& pa0, bf16x8& pa1, bf16x8& pa2, bf16x8& pa3) {
#pragma unroll
  for (int r = 0; r < 16; ++r) p1[r] = __builtin_amdgcn_exp2f(p1[r]);
  float ps = 0;
#pragma unroll
  for (int r = 0; r < 16; ++r) ps += p0[r];
#pragma unroll
  for (int r = 0; r < 16; ++r) ps += p1[r];
  { auto rr = __builtin_amdgcn_permlane32_swap(__float_as_uint(ps), __float_as_uint(ps), false, false);
    ps = __uint_as_float(rr[0]) + __uint_as_float(rr[1]); }
  l_reg = l_reg * alpha + ps;
#define PK4(P, BASE, OUT) do { unsigned a0 = cvtpk(P[BASE + 0], P[BASE + 1]), a1 = cvtpk(P[BASE + 2], P[BASE + 3]);   \
    unsigned b0 = cvtpk(P[BASE + 4], P[BASE + 5]), b1 = cvtpk(P[BASE + 6], P[BASE + 7]);                              \
    auto r0 = __builtin_amdgcn_permlane32_swap(a0, b0, false, false); auto r1 = __builtin_amdgcn_permlane32_swap(a1, b1, false, false); \
    u32x4 w = {r0[0], r1[0], r0[1], r1[1]}; OUT = __builtin_bit_cast(bf16x8, w); } while (0)
  PK4(p0, 0, pa0); PK4(p0, 8, pa1); PK4(p1, 0, pa2); PK4(p1, 8, pa3);
#undef PK4
}
template <int ND0>
DEVI void qkt(f32x16& p0, f32x16& p1, const char* Ks, const bf16x8* qr, int r32, int hi) {
  p0 = f32x16{}; p1 = f32x16{};
#pragma unroll
  for (int d0 = 0; d0 < ND0; ++d0) { const int cb = (d0 * 16 + hi * 8) * 2;
    const bf16x8 b0 = *(const bf16x8*)(Ks + KSWZ(r32, cb));
    const bf16x8 b1 = *(const bf16x8*)(Ks + KSWZ(32 + r32, cb));
    p0 = __builtin_amdgcn_mfma_f32_32x32x16_bf16(b0, qr[d0], p0, 0, 0, 0);
    p1 = __builtin_amdgcn_mfma_f32_32x32x16_bf16(b1, qr[d0], p1, 0, 0, 0); }
}
template <int D0> DEVI void pv_one(f32x16& od, int vb, bf16x8 pa0, bf16x8 pa1, bf16x8 pa2, bf16x8 pa3) {
  const s16x4 l0 = tr_read<v_rd_off(D0, 0, 0)>(vb), h0 = tr_read<v_rd_off(D0, 0, 1)>(vb), l1 = tr_read<v_rd_off(D0, 1, 0)>(vb), h1 = tr_read<v_rd_off(D0, 1, 1)>(vb);
  const s16x4 l2 = tr_read<v_rd_off(D0, 2, 0)>(vb), h2 = tr_read<v_rd_off(D0, 2, 1)>(vb), l3 = tr_read<v_rd_off(D0, 3, 0)>(vb), h3 = tr_read<v_rd_off(D0, 3, 1)>(vb);
  asm volatile("s_waitcnt lgkmcnt(0)" ::: "memory"); SBAR();
#define PK(L, H) (bf16x8){L[0], L[1], L[2], L[3], H[0], H[1], H[2], H[3]}
  od = __builtin_amdgcn_mfma_f32_32x32x16_bf16(pa0, PK(l0, h0), od, 0, 0, 0);
  od = __builtin_amdgcn_mfma_f32_32x32x16_bf16(pa1, PK(l1, h1), od, 0, 0, 0);
  od = __builtin_amdgcn_mfma_f32_32x32x16_bf16(pa2, PK(l2, h2), od, 0, 0, 0);
  od = __builtin_amdgcn_mfma_f32_32x32x16_bf16(pa3, PK(l3, h3), od, 0, 0, 0);
#undef PK
}
DEVI void pv_d0(f32x16* o, int vb, bf16x8 pa0, bf16x8 pa1, bf16x8 pa2, bf16x8 pa3) {
  const s16x4 a0 = tr_read<v_rd_off(0, 0, 0)>(vb), b0 = tr_read<v_rd_off(0, 0, 1)>(vb), a1 = tr_read<v_rd_off(0, 1, 0)>(vb), b1 = tr_read<v_rd_off(0, 1, 1)>(vb);
  const s16x4 a2 = tr_read<v_rd_off(0, 2, 0)>(vb), b2 = tr_read<v_rd_off(0, 2, 1)>(vb), a3 = tr_read<v_rd_off(0, 3, 0)>(vb), b3 = tr_read<v_rd_off(0, 3, 1)>(vb);
  const s16x4 c0 = tr_read<v_rd_off(1, 0, 0)>(vb), d0 = tr_read<v_rd_off(1, 0, 1)>(vb), c1 = tr_read<v_rd_off(1, 1, 0)>(vb), d1 = tr_read<v_rd_off(1, 1, 1)>(vb);
  const s16x4 c2 = tr_read<v_rd_off(1, 2, 0)>(vb), d2 = tr_read<v_rd_off(1, 2, 1)>(vb), c3 = tr_read<v_rd_off(1, 3, 0)>(vb), d3 = tr_read<v_rd_off(1, 3, 1)>(vb);
  asm volatile("s_waitcnt lgkmcnt(0)" ::: "memory"); SBAR();
#define PK(L, H) (bf16x8){L[0], L[1], L[2], L[3], H[0], H[1], H[2], H[3]}
  o[0] = __builtin_amdgcn_mfma_f32_32x32x16_bf16(pa0, PK(a0, b0), o[0], 0, 0, 0);
  o[1] = __builtin_amdgcn_mfma_f32_32x32x16_bf16(pa0, PK(c0, d0), o[1], 0, 0, 0);
  o[0] = __builtin_amdgcn_mfma_f32_32x32x16_bf16(pa1, PK(a1, b1), o[0], 0, 0, 0);
  o[1] = __builtin_amdgcn_mfma_f32_32x32x16_bf16(pa1, PK(c1, d1), o[1], 0, 0, 0);
  o[0] = __builtin_amdgcn_mfma_f32_32x32x16_bf16(pa2, PK(a2, b2), o[0], 0, 0, 0);
  o[1] = __builtin_amdgcn_mfma_f32_32x32x16_bf16(pa2, PK(c2, d2), o[1], 0, 0, 0);
  o[0] = __builtin_amdgcn_mfma_f32_32x32x16_bf16(pa3, PK(a3, b3), o[0], 0, 0, 0);
  o[1] = __builtin_amdgcn_mfma_f32_32x32x16_bf16(pa3, PK(c3, d3), o[1], 0, 0, 0);
#undef PK
}

template <int DQK, bool MASK>
DEVI void attn_body(const u16* Qw, const u16* Kh, int ldk, const u16* Vh, int ldv, int kt0, int NT, float SCALE, float m_init, float l_init,
                    int qpos, u16* Ow, char* lds) {
  constexpr int ND0 = DQK / 16, NCK = DQK / 8;
  const int tid = tidx(), wid = __builtin_amdgcn_readfirstlane(tid >> 6), lane = tid & 63, r32 = lane & 31, hi = lane >> 5;
  char* K_lds = lds; char* V_lds = lds + 2 * AT_SHM_K;
  float* wsx = (float*)(lds + 2 * AT_SHM_K + 3 * AT_SHM_V) + wid * 64; float* li_l = wsx; float* al_l = wsx + 32;
  float m_reg = m_init, l_reg = l_init; f32x16 o[2] = {f32x16{}, f32x16{}}; bf16x8 qr[ND0];
#pragma unroll
  for (int d0 = 0; d0 < ND0; ++d0) qr[d0] = *(const bf16x8*)(Qw + d0 * 16);
  unsigned koff[2], voff;
#pragma unroll
  for (int i = 0; i < 2; ++i) { const int row = 4 * (wid + 8 * i) + (lane >> 4), ch = (lane & 15) ^ (row & 15); koff[i] = (unsigned)(row * ldk * 2 + (ch < NCK ? ch : 0) * 16); }
  { const int off = wid * 1024 + lane * 16, sub = off >> 9, kk = ((sub >> 1) << 3) | ((off & 511) >> 6), c = ((sub & 1) << 5) | ((off & 63) >> 1);
    const int k = (kk & ~0xC) | ((kk & 4) << 1) | ((kk & 8) >> 1); voff = (unsigned)(k * ldv * 2 + c * 2); }
  typedef __attribute__((address_space(3))) unsigned lds_u32;
#define DMA(tt_) do { const char* kb_ = (const char*)Kh + (size_t)(kt0 + (tt_)) * 64 * ldk * 2; const char* vb_ = (const char*)Vh + (size_t)(kt0 + (tt_)) * 64 * ldv * 2; \
    char* kd_ = K_lds + ((tt_) & 1) * AT_SHM_K + wid * 1024; char* vd_ = V_lds + ((tt_) % 3) * AT_SHM_V + wid * 1024; \
    __builtin_amdgcn_global_load_lds((const unsigned*)(kb_ + koff[0]), (lds_u32*)kd_, 16, 0, 0); \
    __builtin_amdgcn_global_load_lds((const unsigned*)(kb_ + koff[1]), (lds_u32*)(kd_ + 8192), 16, 0, 0); \
    __builtin_amdgcn_global_load_lds((const unsigned*)(vb_ + voff), (lds_u32*)vd_, 16, 0, 0); } while (0)
#define LANDED() do { asm volatile("s_waitcnt vmcnt(0)" ::: "memory"); __syncthreads(); } while (0)
#define RESC(a) do { if (__any((a) < 1.f)) { if (hi == 0) al_l[r32] = (a); asm volatile("s_waitcnt lgkmcnt(0)" ::: "memory"); \
    _Pragma("unroll") for (int d = 0; d < 2; ++d) _Pragma("unroll") for (int r = 0; r < 16; ++r) o[d][r] *= al_l[crow(r, hi)]; } } while (0)
  const int vb0 = (int)(uintptr_t)V_lds + v_rd_base(lane);
  f32x16 pA0, pA1, pB0, pB1; float mnA, mnB, alA, alB; bf16x8 pa0, pa1, pa2, pa3;
  DMA(0); LANDED();
  DMA(1);
  qkt<ND0>(pA0, pA1, K_lds, qr, r32, hi); partialSM<MASK>(pA0, pA1, m_reg, mnA, alA, SCALE, kt0 * 64, qpos, hi);
  LANDED();
  int vprev = 0;
  for (int tt = 1; tt + 1 < NT; tt += 2) {
    const int v1 = vprev == 2 ? 0 : vprev + 1;
    DMA(tt + 1); SBAR();
    qkt<ND0>(pB0, pB1, K_lds + AT_SHM_K, qr, r32, hi);
    finishSM(pA0, pA1, alA, l_reg, pa0, pa1, pa2, pa3); SBAR();
    pv_d0(o, vb0 + vprev * AT_SHM_V, pa0, pa1, pa2, pa3); partialSM<MASK>(pB0, pB1, m_reg, mnB, alB, SCALE, (kt0 + tt) * 64, qpos, hi);
    RESC(alB); LANDED();
    if (tt + 2 < NT) DMA(tt + 2);
    SBAR();
    qkt<ND0>(pA0, pA1, K_lds, qr, r32, hi);
    finishSM(pB0, pB1, alB, l_reg, pa0, pa1, pa2, pa3); SBAR();
    pv_d0(o, vb0 + v1 * AT_SHM_V, pa0, pa1, pa2, pa3); partialSM<MASK>(pA0, pA1, m_reg, mnA, alA, SCALE, (kt0 + tt + 1) * 64, qpos, hi);
    RESC(alA); LANDED();
    vprev = v1 == 2 ? 0 : v1 + 1;
  }
  { const int v1 = vprev == 2 ? 0 : vprev + 1;
    SBAR(); qkt<ND0>(pB0, pB1, K_lds + AT_SHM_K, qr, r32, hi);
    finishSM(pA0, pA1, alA, l_reg, pa0, pa1, pa2, pa3); SBAR();
    pv_d0(o, vb0 + vprev * AT_SHM_V, pa0, pa1, pa2, pa3); partialSM<MASK>(pB0, pB1, m_reg, mnB, alB, SCALE, (kt0 + NT - 1) * 64, qpos, hi);
    RESC(alB);
    finishSM(pB0, pB1, alB, l_reg, pa0, pa1, pa2, pa3); SBAR();
    pv_d0(o, vb0 + v1 * AT_SHM_V, pa0, pa1, pa2, pa3); }
  if (hi == 0) li_l[r32] = l_reg; asm volatile("s_waitcnt lgkmcnt(0)" ::: "memory");
  float rli[16];
#pragma unroll
  for (int r = 0; r < 16; ++r) rli[r] = __builtin_amdgcn_rcpf(li_l[crow(r, hi)]);
#pragma unroll
  for (int r = 0; r < 16; ++r) { const int orow = crow(r, hi);
#pragma unroll
    for (int d0 = 0; d0 < 2; ++d0) Ow[(size_t)orow * DM + d0 * 32 + r32] = f2bf(o[d0][r] * rli[r]); }
  __syncthreads();
#undef DMA
#undef LANDED
#undef RESC
}

constexpr int LCH = 64, NLCH = SEQ / LCH;
constexpr size_t WS_LP = 1 * MiB, WS_LH = 2560 * 1024;
constexpr size_t WS_LC = 473 * MiB;
constexpr size_t WS_NEED = 475 * MiB;
DEVI void lru_passA(const Params& p, int item, int lane) {
  const int cg = item % 6, c = (item / 6) % NLCH, b = (item / (6 * NLCH)) % NB, d = item / (6 * NLCH * NB);
  const size_t base = (((size_t)(d * NB + b) * (SEQ / 8) + c * 8) * LRU_W + cg * 64 + lane) * 8;
  const u16* E = (const u16*)(p.ws + WS_LE) + base; const u16* Bp = (const u16*)(p.ws + WS_LB) + base;
  u32x4 ev[8], bv[8];
#pragma unroll
  for (int g = 0; g < 8; ++g) { ev[g] = *(const u32x4*)(E + (size_t)g * LRU_W * 8); bv[g] = *(const u32x4*)(Bp + (size_t)g * LRU_W * 8); }
  float h = 0.f, P = 1.f;
#pragma unroll
  for (int gg = 0; gg < 8; ++gg) { const int g = d ? 7 - gg : gg; float e[8], bb[8]; unpk8(ev[g], e); unpk8(bv[g], bb);
#pragma unroll
    for (int rr = 0; rr < 8; ++rr) { const int r = d ? 7 - rr : rr; const float a = 1.f - e[r]; h = fmaf(a, h, bb[r]); P *= a; } }
  const size_t o = ((size_t)(d * NB + b) * NLCH + c) * LRU_W + cg * 64 + lane;
  ((float*)(p.ws + WS_LP))[o] = P; ((float*)(p.ws + WS_LH))[o] = h;
}

DEVI void lru_final(const Params& p, int item, char* lds) {
  const int tid = tidx(), wid = tid >> 6, lane = tid & 63;
  const int c = item % NLCH, b = item / NLCH;
  float* obuf = (float*)lds;
  if (wid < 6) {
    const int ch = wid * 64 + lane;
#pragma unroll
    for (int d = 0; d < 2; ++d) {
      const size_t co = ((size_t)(d * NB + b) * NLCH + c) * LRU_W + ch;
      float h = ((const float*)(p.ws + WS_LC))[co];
      const size_t base = (((size_t)(d * NB + b) * (SEQ / 8) + c * 8) * LRU_W + ch) * 8;
      const u16* E = (const u16*)(p.ws + WS_LE) + base; const u16* Bp = (const u16*)(p.ws + WS_LB) + base;
      u32x4 ev[8], bv[8];
#pragma unroll
      for (int g = 0; g < 8; ++g) { ev[g] = *(const u32x4*)(E + (size_t)g * LRU_W * 8); bv[g] = *(const u32x4*)(Bp + (size_t)g * LRU_W * 8); }
      if (d == 0) {
#pragma unroll
        for (int g = 0; g < 8; ++g) { float e[8], bb[8]; unpk8(ev[g], e); unpk8(bv[g], bb);
#pragma unroll
          for (int r = 0; r < 8; ++r) { h = fmaf(1.f - e[r], h, bb[r]); obuf[(g * 8 + r) * LRU_W + ch] = h; } }
      } else {
        const u16* gp = (const u16*)(p.ws + WS_R1) + ((size_t)b * SEQ + c * LCH) * INWP + PC_LG + ch;
#pragma unroll
        for (int g = 7; g >= 0; --g) { float e[8], bb[8]; unpk8(ev[g], e); unpk8(bv[g], bb);
#pragma unroll
          for (int r = 7; r >= 0; --r) { h = fmaf(1.f - e[r], h, bb[r]); const int tk = g * 8 + r;
            const float gt = bf2f(gp[(size_t)tk * INWP]); obuf[tk * LRU_W + ch] = (obuf[tk * LRU_W + ch] + h) * gelu_erf(gt); } }
      }
    }
  }
  __syncthreads();
  u16* mp = (u16*)(p.ws + WS_MIX) + ((size_t)b * SEQ + c * LCH) * DM + 384;
#pragma unroll 1
  for (int i = 0; i < 8; ++i) { const int tk = wid * 8 + i;
    float v[6]; float s = 0.f;
#pragma unroll
    for (int q = 0; q < 3; ++q) { const f32x2 t2 = *(const f32x2*)(obuf + tk * LRU_W + q * 128 + lane * 2); v[2 * q] = t2.x; v[2 * q + 1] = t2.y; s = fmaf(t2.x, t2.x, s); s = fmaf(t2.y, t2.y, s); }
    s = wave_sum(s);
    const float rs = rsqrtf(s * (1.f / 384.f) + EPS);
#pragma unroll
    for (int q = 0; q < 3; ++q) *(unsigned*)(mp + (size_t)tk * DM + q * 128 + lane * 2) = pk2(v[2 * q] * rs, v[2 * q + 1] * rs);
  }
  __syncthreads();
}

DEVI void peer_cand(const Params& p, int layer, int vb, int nb, char* lds) {
  const int tid = tidx();
  unsigned char* my = (unsigned char*)lds + tid * 32;
  const float* top = (const float*)(p.ws + WS_TOP);
  float* egate = (float*)(p.ws + WS_EGATE);
  for (int it = vb * NTHREADS + tid; it < T * 8; it += nb * NTHREADS) {
    float v1[16], v2[16];
    const float* tp = top + (size_t)it * 32;
#pragma unroll
    for (int i = 0; i < 4; ++i) { const f32x4 a = *(const f32x4*)(tp + 4 * i), b = *(const f32x4*)(tp + 16 + 4 * i);
      v1[4 * i] = a.x; v1[4 * i + 1] = a.y; v1[4 * i + 2] = a.z; v1[4 * i + 3] = a.w; v2[4 * i] = b.x; v2[4 * i + 1] = b.y; v2[4 * i + 2] = b.z; v2[4 * i + 3] = b.w; }
#pragma unroll
    for (int i = 0; i < 16; ++i) { my[i] = (unsigned char)(127u - (__float_as_uint(v1[i]) & 127u)); my[16 + i] = (unsigned char)(127u - (__float_as_uint(v2[i]) & 127u)); }
    float l[16];
#pragma unroll
    for (int i = 0; i < 16; ++i) l[i] = -3.0e38f;
#pragma unroll
    for (int a = 0; a < 16; ++a)
#pragma unroll
      for (int b = 0; b < 16; ++b) if ((a + 1) * (b + 1) <= 16) {
        float v = __uint_as_float((__float_as_uint(v1[a] + v2[b]) & ~255u) | (unsigned)(255 - (a * 16 + b)));
#pragma unroll
        for (int i = 0; i < 16; ++i) { const float t = fmaxf(l[i], v); v = fminf(l[i], v); l[i] = t; } }
    const float mx = __uint_as_float(__float_as_uint(l[0]) & ~255u);
    float w[16], sum = 0.f;
#pragma unroll
    for (int i = 0; i < 16; ++i) { w[i] = __expf(__uint_as_float(__float_as_uint(l[i]) & ~255u) - mx); sum += w[i]; }
    const float inv = 1.f / sum;
    unsigned ev[16];
#pragma unroll
    for (int i = 0; i < 16; ++i) { const unsigned code = 255u - (__float_as_uint(l[i]) & 255u); ev[i] = (unsigned)my[code >> 4] * 128u + (unsigned)my[16 + (code & 15)]; w[i] *= inv; }
    u16* eo = (u16*)(p.ws + WS_EIDX) + (size_t)it * 16;
    *(u32x4*)(eo) = (u32x4){ev[0] | (ev[1] << 16), ev[2] | (ev[3] << 16), ev[4] | (ev[5] << 16), ev[6] | (ev[7] << 16)};
    *(u32x4*)(eo + 8) = (u32x4){ev[8] | (ev[9] << 16), ev[10] | (ev[11] << 16), ev[12] | (ev[13] << 16), ev[14] | (ev[15] << 16)};
#pragma unroll
    for (int i = 0; i < 4; ++i) *(f32x4*)(egate + (size_t)it * 16 + 4 * i) = (f32x4){w[4 * i], w[4 * i + 1], w[4 * i + 2], w[4 * i + 3]};
  }
  { const int wid = tid >> 6, lane = tid & 63; u16* xg = (u16*)(p.ws + WS_XG); const float* gf = p.norm_ffn + layer * DM;
    for (int t = vb * 8 + wid; t < T; t += nb * 8) {
      u32x4* rp = (u32x4*)(xg + (size_t)t * DM + lane * 16);
      float v[16]; unpk8(rp[0], v); unpk8(rp[1], v + 8);
      float s = 0.f;
#pragma unroll
      for (int i = 0; i < 16; ++i) s = fmaf(v[i], v[i], s);
      s = wave_sum(s);
      const float rs = rsqrtf(s * (1.f / DM) + EPS);
      float g[16]; ld8(gf + lane * 16, g); ld8(gf + lane * 16 + 8, g + 8);
#pragma unroll
      for (int i = 0; i < 16; ++i) v[i] *= rs * g[i];
      rp[0] = pk8(v); rp[1] = pk8(v + 8);
    } }
}

typedef unsigned char u8;
DEVI void cvt16(u32x4 w, float* f) {
  f32x2 t;
  t = __builtin_amdgcn_cvt_pk_f32_fp8((int)w.x, false); f[0] = t.x; f[1] = t.y; t = __builtin_amdgcn_cvt_pk_f32_fp8((int)w.x, true); f[2] = t.x; f[3] = t.y;
  t = __builtin_amdgcn_cvt_pk_f32_fp8((int)w.y, false); f[4] = t.x; f[5] = t.y; t = __builtin_amdgcn_cvt_pk_f32_fp8((int)w.y, true); f[6] = t.x; f[7] = t.y;
  t = __builtin_amdgcn_cvt_pk_f32_fp8((int)w.z, false); f[8] = t.x; f[9] = t.y; t = __builtin_amdgcn_cvt_pk_f32_fp8((int)w.z, true); f[10] = t.x; f[11] = t.y;
  t = __builtin_amdgcn_cvt_pk_f32_fp8((int)w.w, false); f[12] = t.x; f[13] = t.y; t = __builtin_amdgcn_cvt_pk_f32_fp8((int)w.w, true); f[14] = t.x; f[15] = t.y;
}
DEVI unsigned enc4(float a, float b, float c, float d) { int w = 0; w = __builtin_amdgcn_cvt_pk_fp8_f32(a, b, w, false); w = __builtin_amdgcn_cvt_pk_fp8_f32(c, d, w, true); return (unsigned)w; }
#define EIDX_AT(i0, i1, i) ((((i) < 8 ? (i0) : (i1))[((i) & 7) >> 1] >> (((i) & 1) * 16)) & 0xffffu)
template <int CTRL> DEVI float dppf(float v) { return __uint_as_float((unsigned)__builtin_amdgcn_mov_dpp((int)__float_as_uint(v), CTRL, 0xF, 0xF, true)); }
DEVI f32x2 fma2(f32x2 a, f32x2 b, f32x2 c) { return __builtin_elementwise_fma(a, b, c); }
DEVI f32x2 cvt8lo(unsigned w) { return __builtin_amdgcn_cvt_pk_f32_fp8((int)w, false); }
DEVI f32x2 cvt8hi(unsigned w) { return __builtin_amdgcn_cvt_pk_f32_fp8((int)w, true); }
struct PeerIdx { u32x4 i0, i1; };
template <bool AXPY>
DEVI void peer_slice_phase(const Params& p, int s, int tbeg, int tstep, int lane, const float* xin, float* xout, bool last) {
  const int r = lane >> 3, j = lane & 7;
  const u8* eidxB = (const u8*)(p.ws + WS_EIDX); const unsigned eoff = (unsigned)r * 32u;
  const u8* TBs = (const u8*)(p.ws + (AXPY ? WS_VB : WS_UB)) + (size_t)s * NEXP * 128; const unsigned toff = 16u * (unsigned)j;
  const u8* xnB = (const u8*)(p.ws + WS_XG) + s * 256; const unsigned xoff = 32u * (unsigned)j;
  const u8* ccB = (const u8*)(p.ws + WS_CC); const unsigned coff = (unsigned)r * 32u;
  float* pdB = (float*)(p.ws + WS_PD) + (size_t)s * T * 128;
  const int ntok = (T - tbeg + tstep - 1) / tstep;
  if (ntok <= 0) return;
#define TOK(k) (tbeg + ((k) < ntok ? (k) : ntok - 1) * tstep)
#define LD_IDX(dst, k) do { const u8* b_ = eidxB + (size_t)TOK(k) * 256; dst.i0 = *(const u32x4*)(b_ + eoff); dst.i1 = *(const u32x4*)(b_ + eoff + 16u); } while (0)
#define LD_HALF(H, ix, h) do { _Pragma("unroll") for (int i = 0; i < 8; ++i) H[i] = *(const u32x4*)(TBs + (EIDX_AT(ix.i0, ix.i1, 8 * (h) + i) * 128u + toff)); } while (0)
#define LD_AUX(a, k) do { if (AXPY) { const u8* b_ = ccB + (size_t)TOK(k) * 256; a[0] = *(const u32x4*)(b_ + coff); a[1] = *(const u32x4*)(b_ + coff + 16u); } \
    else { const u8* b_ = xnB + (size_t)TOK(k) * (DM * 2); a[0] = *(const u32x4*)(b_ + xoff); a[1] = *(const u32x4*)(b_ + xoff + 16u); } } while (0)
  PeerIdx I0, I1, I2; u32x4 H0[8], H1[8], H2[8], X0[2], X1[2], X2[2];
  float av[16];
  f32x2 acc[8];
#define T_BEGIN(X) do { unpk8(X[0], av); unpk8(X[1], av + 8); if (AXPY) { _Pragma("unroll") for (int q = 0; q < 8; ++q) acc[q] = (f32x2){0.f, 0.f}; } } while (0)
#define COMP(H, h, k) do { if ((k) < ntok) { \
    if (!AXPY) { float* o_ = pdB + (size_t)(tbeg + (k) * tstep) * 128 + r * 16 + 8 * (h); \
      _Pragma("unroll") for (int g = 0; g < 2; ++g) { float res[4]; \
        _Pragma("unroll") for (int ii = 0; ii < 4; ++ii) { const u32x4 w_ = H[4 * g + ii]; f32x2 a = {0.f, 0.f}; \
          a = fma2(cvt8lo(w_.x), (f32x2){av[0], av[1]}, a); a = fma2(cvt8hi(w_.x), (f32x2){av[2], av[3]}, a); a = fma2(cvt8lo(w_.y), (f32x2){av[4], av[5]}, a); a = fma2(cvt8hi(w_.y), (f32x2){av[6], av[7]}, a); \
          a = fma2(cvt8lo(w_.z), (f32x2){av[8], av[9]}, a); a = fma2(cvt8hi(w_.z), (f32x2){av[10], av[11]}, a); a = fma2(cvt8lo(w_.w), (f32x2){av[12], av[13]}, a); a = fma2(cvt8hi(w_.w), (f32x2){av[14], av[15]}, a); \
          float v = a.x + a.y; v += dppf<0xB1>(v); v += dppf<0x4E>(v); v += dppf<0x141>(v); res[ii] = v; } \
        if (j == 0) *(f32x4*)(o_ + 4 * g) = (f32x4){res[0], res[1], res[2], res[3]}; } } \
    else { _Pragma("unroll") for (int i = 0; i < 8; ++i) { const u32x4 w_ = H[i]; const float ci = av[8 * (h) + i]; const f32x2 c2 = {ci, ci}; \
        acc[0] = fma2(cvt8lo(w_.x), c2, acc[0]); acc[1] = fma2(cvt8hi(w_.x), c2, acc[1]); acc[2] = fma2(cvt8lo(w_.y), c2, acc[2]); acc[3] = fma2(cvt8hi(w_.y), c2, acc[3]); \
        acc[4] = fma2(cvt8lo(w_.z), c2, acc[4]); acc[5] = fma2(cvt8hi(w_.z), c2, acc[5]); acc[6] = fma2(cvt8lo(w_.w), c2, acc[6]); acc[7] = fma2(cvt8hi(w_.w), c2, acc[7]); } } } } while (0)
  auto finalize = [&](int k) {
    if (!AXPY || k >= ntok) return;
    const int t = tbeg + k * tstep;
    float S[8];
#pragma unroll
    for (int q = 0; q < 8; ++q) { const float A = acc[q >> 1][q & 1], B = acc[(q + 8) >> 1][q & 1];
      auto rr = __builtin_amdgcn_permlane32_swap(__float_as_uint(A), __float_as_uint(B), false, false); S[q] = __uint_as_float(rr[0]) + __uint_as_float(rr[1]); }
    float Tq[4];
#pragma unroll
    for (int q = 0; q < 4; ++q) { auto rr = __builtin_amdgcn_permlane16_swap(__float_as_uint(S[q]), __float_as_uint(S[q + 4]), false, false); Tq[q] = __uint_as_float(rr[0]) + __uint_as_float(rr[1]); }
#pragma unroll
    for (int q = 0; q < 4; ++q) Tq[q] += dppf<0x128>(Tq[q]);
    float ss = 0.f;
    if ((lane & 8) == 0) {
      const size_t o = (size_t)t * DM + s * 128 + 16 * j + ((lane >> 5) & 1) * 8 + ((lane >> 4) & 1) * 4;
      const f32x4 x = *(const f32x4*)(xin + o);
      const f32x4 y = {x.x + Tq[0], x.y + Tq[1], x.z + Tq[2], x.w + Tq[3]};
      *(f32x4*)(xout + o) = y;
      if (!last) *(u32x2*)((u16*)(p.ws + WS_XG) + o) = (u32x2){pk2(y.x, y.y), pk2(y.z, y.w)};
      ss = (y.x * y.x + y.y * y.y) + (y.z * y.z + y.w * y.w);
    }
    ss = wave_sum(ss); if (lane == 0) ((float*)(p.ws + WS_SSQ))[(size_t)t * 8 + s] = ss;
  };
  LD_IDX(I0, 0); LD_IDX(I1, 1); LD_IDX(I2, 2); LD_HALF(H0, I0, 0); LD_HALF(H1, I0, 1); LD_AUX(X0, 0);
#pragma unroll 2
  for (int k = 0; k < ntok; k += 3) {
    LD_HALF(H2, I1, 0); LD_IDX(I0, k + 3); LD_AUX(X1, k + 1);
    T_BEGIN(X0); COMP(H0, 0, k);
    LD_HALF(H0, I1, 1);
    COMP(H1, 1, k); finalize(k);
    LD_HALF(H1, I2, 0); LD_IDX(I1, k + 4); LD_AUX(X2, k + 2);
    T_BEGIN(X1); COMP(H2, 0, k + 1);
    LD_HALF(H2, I2, 1);
    COMP(H0, 1, k + 1); finalize(k + 1);
    LD_HALF(H0, I0, 0); LD_IDX(I2, k + 5); LD_AUX(X0, k + 3);
    T_BEGIN(X2); COMP(H1, 0, k + 2);
    LD_HALF(H1, I0, 1);
    COMP(H2, 1, k + 2); finalize(k + 2);
  }
#undef TOK
#undef LD_IDX
#undef LD_HALF
#undef LD_AUX
#undef T_BEGIN
#undef COMP
}

DEVI void lru_passB(const Params& p, int item, int lane) {
  const int cg = item % 6, b = (item / 6) % NB, d = item / (6 * NB);
  const size_t o = (size_t)(d * NB + b) * NLCH * LRU_W + cg * 64 + lane;
  const float* Pp = (const float*)(p.ws + WS_LP) + o; const float* Hp = (const float*)(p.ws + WS_LH) + o; float* Cp = (float*)(p.ws + WS_LC) + o;
  float h = 0.f;
#pragma unroll 1
  for (int c0 = 0; c0 < NLCH; c0 += 32) {
    float pv[32], hv[32];
#pragma unroll
    for (int i = 0; i < 32; ++i) { const int cc = d ? NLCH - 1 - (c0 + i) : c0 + i; pv[i] = Pp[(size_t)cc * LRU_W]; hv[i] = Hp[(size_t)cc * LRU_W]; }
#pragma unroll
    for (int i = 0; i < 32; ++i) { const int cc = d ? NLCH - 1 - (c0 + i) : c0 + i; Cp[(size_t)cc * LRU_W] = h; h = fmaf(pv[i], h, hv[i]); }
  }
}

DEVI void swa_item(const Params& p, int layer, int item, char* lds) {
  const int tid = tidx(), wid = tid >> 6, lane = tid & 63, r32 = lane & 31, hi = lane >> 5;
  const int g = item & 1, n = (item >> 1) & 63, b = item >> 7;
  const int hq = 2 * g + (wid >> 2), qrow = n * 128 + (wid & 3) * 32;
  const u16* proj = (const u16*)(p.ws + WS_R1);
  const u16* Qw = proj + (size_t)(b * SEQ + qrow + r32) * INWP + PC_SQ + hq * 64 + hi * 8;
  const u16* Kh = proj + (size_t)(b * SEQ) * INWP + PC_SK + g * 64;
  const u16* Vh = proj + (size_t)(b * SEQ) * INWP + PC_SV + g * 64;
  const int kt0 = (2 * n - 2) < 0 ? 0 : (2 * n - 2), kt1 = (2 * n + 4) > SEQ / 64 ? SEQ / 64 : (2 * n + 4);
  const float sink = p.swa_sink[layer * 4 + hq];
  u16* Ow = (u16*)(p.ws + WS_MIX) + (size_t)(b * SEQ + qrow) * DM + 768 + hq * 64;
  attn_body<64, true>(Qw, Kh, INWP, Vh, INWP, kt0, kt1 - kt0, 0.125f, sink * 8.f, 1.f, qrow + r32, Ow, lds);
}
DEVI void mla_item(const Params& p, int pair, int qb, char* lds) {
  const int tid = tidx(), wid = tid >> 6, lane = tid & 63, r32 = lane & 31, hi = lane >> 5;
  const int b = pair / MLA_H, h = pair - b * MLA_H;
  const u16* Qw = (const u16*)(p.ws + WS_QM) + ((size_t)pair * SEQ + qb * 256 + wid * 32 + r32) * MLA_QK + hi * 8;
  const u16* Kh = (const u16*)(p.ws + WS_KM) + (size_t)pair * SEQ * MLA_QK;
  const u16* Vh = (const u16*)(p.ws + WS_VM) + (size_t)pair * SEQ * MLA_V;
  u16* Ow = (u16*)(p.ws + WS_MIX) + (size_t)(b * SEQ + qb * 256 + wid * 32) * DM + h * 64;
  attn_body<96, false>(Qw, Kh, MLA_QK, Vh, MLA_V, 0, SEQ / 64, 0.10206207261596575f, -1e30f, 0.f, 0, Ow, lds);
}


namespace pg8 {
#define PG8_LAS __attribute__((address_space(3)))
constexpr int BM = 256, BK = 64, HALF = 128, HTB = HALF * BK * 2, NXCD = 8, WGM = 8;
DEVI int lds_byte(int r, int c) { const int st = (r >> 4) * 2 + (c >> 5), rr = r & 15, cc = c & 31, ob = rr * 64 + cc * 2; return st * 1024 + (ob ^ (((ob >> 9) & 1) << 5)); }
DEVI void stage_rc(int b, int& R, int& C) { const int st = b / 1024, sb = b % 1024, swz = sb ^ (((sb >> 9) & 1) << 5); R = (st >> 1) * 16 + swz / 64; C = (st & 1) * 32 + (swz % 64) / 2; }
DEVI int perm32(int rho) { const int n = rho >> 4, i = rho & 15; return 8 * (i >> 2) + 4 * n + (i & 3); }
struct Unit { int pm, pn; };
struct Gemm { const u16* A; const u16* Bt; int M, N, K; };
struct StaticOrder {
  int nM, nN, nwg, G, c;
  DEVI void init(int M, int N, int G_, int c_) { nM = M / BM; nN = N / BM; nwg = nM * nN; G = G_; c = c_; }
  DEVI bool next(int i, Unit& u) const {
    const long L = (long)i * G + c; if (L >= nwg) return false;
    int wgid = (int)L; { const int q = nwg / NXCD, r = nwg % NXCD, xcd = wgid % NXCD, off = wgid / NXCD; wgid = (xcd < r ? xcd * (q + 1) : r * (q + 1) + (xcd - r) * q) + off; }
    const int nig = WGM * nN, gid = wgid / nig, fm = gid * WGM, gsz = (nM - fm) < WGM ? (nM - fm) : WGM;
    u.pm = fm + ((wgid % nig) % gsz); u.pn = (wgid % nig) / gsz; return true;
  }
};
template <class Epi>
DEVI void gemm_phase(PG8_LAS unsigned char* lds, const Gemm g, const StaticOrder& S, const Epi& E) {
  const int tid = tidx(), wid = __builtin_amdgcn_readfirstlane(tid >> 6), lane = tid & 63, wr = wid >> 2, wc = wid & 3, fr = lane & 15, fq = lane >> 4;
  const int K = g.K, nt = K / BK;
  unsigned voffA[2], voffB[2];
#pragma unroll
  for (int i = 0; i < 2; ++i) { int R, C; stage_rc(tid * 16 + i * 8192, R, C); const int Rb = (R & ~31) + perm32(R & 31);
    voffA[i] = (unsigned)(R * K + C) * 2u; voffB[i] = (unsigned)(Rb * K + C) * 2u; }
  const size_t kstep = (size_t)(BK * 2), hstep = (size_t)HALF * K * 2, tstep = 2 * hstep;
  const unsigned ldsw = (unsigned)wid * 1024u;
  const int aoff = lds_byte(wr * 64 + fr, fq * 8), boff = lds_byte(wc * 32 + fr, fq * 8);
#define PG8_SA(b, h) (((b) * 2 + (h)) * HTB)
#define PG8_SB(b, h) ((4 + (b) * 2 + (h)) * HTB)
#define PG8_STAGE(bufoff, gbase, voff) do { _Pragma("unroll") for (int _i = 0; _i < 2; ++_i) \
    __builtin_amdgcn_global_load_lds((const unsigned*)((const char*)(gbase) + (voff)[_i]), (PG8_LAS unsigned*)(lds + (bufoff) + ldsw + _i * 8192), 16, 0, 0); } while (0)
#define PG8_LDA(dst, b, h) do { _Pragma("unroll") for (int m = 0; m < 4; ++m) _Pragma("unroll") for (int k = 0; k < 2; ++k) dst[m][k] = *(const PG8_LAS bf16x8*)(lds + PG8_SA(b, h) + aoff + m * 2048 + k * 1024); } while (0)
#define PG8_LDB(dst, b, h) do { _Pragma("unroll") for (int n = 0; n < 2; ++n) _Pragma("unroll") for (int k = 0; k < 2; ++k) dst[n][k] = *(const PG8_LAS bf16x8*)(lds + PG8_SB(b, h) + boff + n * 2048 + k * 1024); } while (0)
#define PG8_MMA(ai, bj, At, Bt) do { __builtin_amdgcn_s_setprio(1); _Pragma("unroll") for (int m = 0; m < 4; ++m) _Pragma("unroll") for (int n = 0; n < 2; ++n) _Pragma("unroll") for (int k = 0; k < 2; ++k) \
    acc[ai][bj][m][n] = __builtin_amdgcn_mfma_f32_16x16x32_bf16(Bt[n][k], At[m][k], acc[ai][bj][m][n], 0, 0, 0); __builtin_amdgcn_s_setprio(0); } while (0)
#define PG8_WAIT_V(n) asm volatile("s_waitcnt vmcnt(" #n ")" ::: "memory")
#define PG8_WAIT_L(n) asm volatile("s_waitcnt lgkmcnt(" #n ")" ::: "memory")
#define PG8_BAR __builtin_amdgcn_s_barrier()
#define PG8_SCHED __builtin_amdgcn_sched_barrier(0)
  Unit cur, nxt; int ui = 0;
  if (!S.next(0, cur)) return;
  f32x4 acc[2][2][4][2];
#pragma unroll
  for (int a = 0; a < 2; ++a)
#pragma unroll
    for (int b = 0; b < 2; ++b)
#pragma unroll
      for (int m = 0; m < 4; ++m)
#pragma unroll
        for (int n = 0; n < 2; ++n) acc[a][b][m][n] = (f32x4){0.f, 0.f, 0.f, 0.f};
  bf16x8 At[4][2], B0[2][2], B1[2][2];
  const char* cA = (const char*)g.A + (size_t)cur.pm * tstep; const char* cB = (const char*)g.Bt + (size_t)cur.pn * tstep;
  PG8_STAGE(PG8_SB(0, 0), cB, voffB); PG8_STAGE(PG8_SB(0, 1), cB + hstep, voffB); PG8_STAGE(PG8_SA(0, 0), cA, voffA); PG8_STAGE(PG8_SA(0, 1), cA + hstep, voffA);
  if (wr == 1) PG8_BAR;
  PG8_WAIT_V(2); PG8_BAR;
  PG8_STAGE(PG8_SB(1, 0), cB + kstep, voffB); PG8_STAGE(PG8_SA(1, 0), cA + kstep, voffA); PG8_STAGE(PG8_SB(1, 1), cB + hstep + kstep, voffB);
  PG8_WAIT_V(6); PG8_BAR;
  for (;;) {
    const bool has_next = S.next(ui + 1, nxt);
    const char* nA = has_next ? (const char*)g.A + (size_t)nxt.pm * tstep : cA; const char* nB = has_next ? (const char*)g.Bt + (size_t)nxt.pn * tstep : cB;
    for (int t = 0; t < nt; t += 2) {
      const bool last = (t == nt - 2);
      const char* a1 = cA + (size_t)(t + 1) * kstep;
      const char* a2 = last ? nA : cA + (size_t)(t + 2) * kstep; const char* b2 = last ? nB : cB + (size_t)(t + 2) * kstep;
      const char* a3 = a2 + kstep; const char* b3 = b2 + kstep;
      PG8_LDB(B0, 0, 0); PG8_LDB(B1, 0, 1); PG8_SCHED; PG8_LDA(At, 0, 0); PG8_STAGE(PG8_SA(1, 1), a1 + hstep, voffA);
      PG8_WAIT_V(8); PG8_WAIT_L(0); PG8_BAR; PG8_MMA(0, 0, At, B0); PG8_MMA(0, 1, At, B1); PG8_BAR; PG8_SCHED;
      PG8_LDA(At, 0, 1); PG8_STAGE(PG8_SB(0, 0), b2, voffB); PG8_STAGE(PG8_SB(0, 1), b2 + hstep, voffB); PG8_STAGE(PG8_SA(0, 0), a2, voffA);
      PG8_WAIT_V(8); PG8_WAIT_L(0); PG8_BAR; PG8_MMA(1, 0, At, B0); PG8_MMA(1, 1, At, B1); PG8_BAR; PG8_SCHED;
      PG8_LDB(B0, 1, 0); PG8_LDB(B1, 1, 1); PG8_SCHED; PG8_LDA(At, 1, 0); PG8_STAGE(PG8_SA(0, 1), a2 + hstep, voffA);
      PG8_WAIT_V(8); PG8_WAIT_L(0); PG8_BAR; PG8_MMA(0, 0, At, B0); PG8_MMA(0, 1, At, B1); PG8_BAR; PG8_SCHED;
      PG8_LDA(At, 1, 1); PG8_STAGE(PG8_SB(1, 0), b3, voffB); PG8_STAGE(PG8_SB(1, 1), b3 + hstep, voffB); PG8_STAGE(PG8_SA(1, 0), a3, voffA);
      PG8_WAIT_V(8); PG8_WAIT_L(0); PG8_BAR; PG8_MMA(1, 0, At, B0); PG8_MMA(1, 1, At, B1); PG8_BAR; PG8_SCHED;
    }
    if (wr == 0) PG8_BAR;
    E(acc, cur, wr, wc, fr, fq);
    if (!has_next) break;
#pragma unroll
    for (int a = 0; a < 2; ++a)
#pragma unroll
      for (int b = 0; b < 2; ++b)
#pragma unroll
        for (int m = 0; m < 4; ++m)
#pragma unroll
          for (int n = 0; n < 2; ++n) acc[a][b][m][n] = (f32x4){0.f, 0.f, 0.f, 0.f};
    cur = nxt; cA = nA; cB = nB; ++ui;
    if (wr == 1) PG8_BAR;
  }
  PG8_WAIT_V(0);
  PG8_BAR;
#undef PG8_SA
#undef PG8_SB
#undef PG8_STAGE
#undef PG8_LDA
#undef PG8_LDB
#undef PG8_MMA
#undef PG8_WAIT_V
#undef PG8_WAIT_L
#undef PG8_BAR
#undef PG8_SCHED
}

DEVI float rs_from8(const float* s) { const f32x4 a = *(const f32x4*)s, b = *(const f32x4*)(s + 4); return rsqrtf((((a.x + a.y) + (a.z + a.w)) + ((b.x + b.y) + (b.z + b.w))) * (1.f / DM) + EPS); }
struct EpiProj { u16* proj; const int* pos; const float* ssq8;
  DEVI void operator()(const f32x4 (&acc)[2][2][4][2], const Unit& u, int wr, int wc, int fr, int fq) const {
    const int row0 = u.pm * BM + wr * 64 + fr, col0 = u.pn * BM + wc * 32 + 8 * fq;
#pragma unroll
    for (int ai = 0; ai < 2; ++ai)
#pragma unroll
      for (int m = 0; m < 4; ++m) { const int row = row0 + ai * HALF + m * 16; const float rs = rs_from8(ssq8 + (size_t)row * 8); const float posf = (float)pos[row];
#pragma unroll
        for (int bj = 0; bj < 2; ++bj) { const int gcol = col0 + bj * HALF;
          float v[8]; { const f32x4 a = acc[ai][bj][m][0] * rs, b = acc[ai][bj][m][1] * rs; v[0] = a.x; v[1] = a.y; v[2] = a.z; v[3] = a.w; v[4] = b.x; v[5] = b.y; v[6] = b.z; v[7] = b.w; }
          const bool r64 = gcol >= PC_SQ && gcol < PC_SV, r32g = gcol >= PC_KR && gcol < PC_KR + 32;
          if (r64 || r32g) {
#pragma unroll
            for (int q = 0; q < 4; ++q) { const int f = r64 ? (((gcol + 2 * q) & 63) >> 1) : 2 * (((gcol + 2 * q) & 31) >> 1); float sn, cs; rope_sc(posf, f, sn, cs);
              const float x1 = v[2 * q], x2 = v[2 * q + 1]; v[2 * q] = x1 * cs - x2 * sn; v[2 * q + 1] = x2 * cs + x1 * sn; } }
          *(u32x4*)(proj + (size_t)row * INWP + gcol) = pk8(v); } }
  }
};
struct EpiPQ { u16* O; const float* ssq16;
  DEVI void operator()(const f32x4 (&acc)[2][2][4][2], const Unit& u, int wr, int wc, int fr, int fq) const {
    const int row0 = u.pm * BM + wr * 64 + fr, col0 = u.pn * BM + wc * 32 + 8 * fq;
#pragma unroll
    for (int ai = 0; ai < 2; ++ai)
#pragma unroll
      for (int m = 0; m < 4; ++m) { const int row = row0 + ai * HALF + m * 16;
        const f32x4* sp = (const f32x4*)(ssq16 + (size_t)row * 16); const f32x4 s4 = (sp[0] + sp[1]) + (sp[2] + sp[3]);
        const float rs = rsqrtf(((s4.x + s4.y) + (s4.z + s4.w)) * (1.f / DM) + EPS);
#pragma unroll
        for (int bj = 0; bj < 2; ++bj) { float v[8]; { const f32x4 a = acc[ai][bj][m][0] * rs, b = acc[ai][bj][m][1] * rs; v[0] = a.x; v[1] = a.y; v[2] = a.z; v[3] = a.w; v[4] = b.x; v[5] = b.y; v[6] = b.z; v[7] = b.w; }
          *(u32x4*)(O + (size_t)row * 2048 + col0 + bj * HALF) = pk8(v); } }
  }
};
struct EpiRes { const float* xres; float* xout; u16* xg; float* ssq16;
  DEVI void operator()(const f32x4 (&acc)[2][2][4][2], const Unit& u, int wr, int wc, int fr, int fq) const {
    const int row0 = u.pm * BM + wr * 64 + fr, col0 = u.pn * BM + wc * 32 + 8 * fq;
#pragma unroll
    for (int ai = 0; ai < 2; ++ai)
#pragma unroll
      for (int m = 0; m < 4; ++m) { const int row = row0 + ai * HALF + m * 16; float ss = 0.f;
#pragma unroll
        for (int bj = 0; bj < 2; ++bj) { const size_t o = (size_t)row * DM + col0 + bj * HALF;
          float x[8]; ld8(xres + o, x);
          const f32x4 a = acc[ai][bj][m][0], b = acc[ai][bj][m][1];
          x[0] += a.x; x[1] += a.y; x[2] += a.z; x[3] += a.w; x[4] += b.x; x[5] += b.y; x[6] += b.z; x[7] += b.w;
#pragma unroll
          for (int q = 0; q < 8; ++q) ss = fmaf(x[q], x[q], ss);
          *(f32x4*)(xout + o) = (f32x4){x[0], x[1], x[2], x[3]}; *(f32x4*)(xout + o + 4) = (f32x4){x[4], x[5], x[6], x[7]};
          *(u32x4*)(xg + o) = pk8(x); }
        ss += __shfl_xor(ss, 16); ss += __shfl_xor(ss, 32);
        if (fq == 0) ssq16[(size_t)row * 16 + u.pn * 4 + wc] = ss; }
  }
};
}

constexpr int PH_PER_LAYER = 13, N_PHASES = 2 + DEPTH * PH_PER_LAYER;
DEVI void run_phase(const Params& pin, int ph, int vb, int nb, char* lds) {
  const bool dry = ph >= 100; if (dry) ph -= 100;
  Params p = pin; { size_t z = 0; asm volatile("" : "+s"(z)); p.ws = pin.ws + z; p.out = pin.out + z; } asm volatile("" : "+s"(vb));
  const int tid = tidx(), wid = tid >> 6, lane = tid & 63;
#ifdef ONLY_SP
  if (ONLY_SP >= 0 && ph == 0) return;
#endif
  if (ph == 0) { phase0(p, vb, nb, lds); return; }
  if (ph == N_PHASES - 1) {
    const float* ssq = (const float*)(p.ws + WS_SSQ);
    for (size_t i = (size_t)vb * NTHREADS + tid; i < (size_t)T * DM / 8; i += (size_t)nb * NTHREADS) {
      const size_t t = i >> 7; const int c = (int)(i & 127) * 8;
      float s8[8]; ld8(ssq + t * 8, s8); const float rs = rsqrtf((((s8[0] + s8[1]) + (s8[2] + s8[3])) + ((s8[4] + s8[5]) + (s8[6] + s8[7]))) * (1.f / DM) + EPS);
      float x[8], g[8]; ld8(p.out + i * 8, x); ld8(p.norm_final + c, g);
#pragma unroll
      for (int q = 0; q < 8; ++q) x[q] *= rs * g[q];
      *(f32x4*)(p.out + i * 8) = (f32x4){x[0], x[1], x[2], x[3]}; *(f32x4*)(p.out + i * 8 + 4) = (f32x4){x[4], x[5], x[6], x[7]}; }
    return; }
  const int l = (ph - 1) / PH_PER_LAYER, sp = (ph - 1) % PH_PER_LAYER;
  u16* const XG = (u16*)(p.ws + WS_XG); u16* const PROJ = (u16*)(p.ws + WS_R1); u16* const MIX = (u16*)(p.ws + WS_MIX);
  constexpr int NMT = T / 256;
#ifdef ONLY_SP
  if (sp != ONLY_SP) return;
#endif
  switch (sp) {
  case 0: {
    pg8::Gemm g{XG, (const u16*)(p.ws + WS_WIN) + (size_t)l * INWP * DM, T, INWP, DM}; pg8::StaticOrder S; S.init(T, INWP, nb, vb);
    pg8::EpiProj e{PROJ, p.pos, (const float*)(p.ws + WS_SSQ)};
    pg8::gemm_phase((PG8_LAS unsigned char*)lds, g, S, e);
  } break;
  case 1: {
    constexpr int N_C = NMT * 12, N_A = NMT * 5, N_B = NMT * 6;
    for (int it = vb; it < N_C + N_A + N_B; it += nb) {
      if (it < N_C) { const int mt = it / 12, nd = it % 12, n = nd >> 1, d = nd & 1;
        GemmDesc g{}; g.Bt = (const u16*)(p.ws + WS_WLRU) + (size_t)((l * 6 + n) * 2 + d) * 128 * 64; g.ldb = 64; g.KT = 1;
        g.proj = PROJ; g.cw = p.conv_w + l * 4 * LRU_W; g.cb = p.conv_b + l * LRU_W; g.ch0 = n * 64;
        EpiLRU e{PROJ, g.cw, g.cb, p.lru_ba + l * 2 * 384, p.lru_bx + l * 2 * 384, p.lru_lambda + l * 2 * 384, (u16*)(p.ws + WS_LE), (u16*)(p.ws + WS_LB), n, d};
        gemm_tile<1, 0>(g, mt * 256, 0, lds, e);
      } else if (it < N_C + N_A) { const int i2 = it - N_C;
        GemmDesc g = gemm_desc(PROJ + PC_CQ, INWP, (const u16*)(p.ws + WS_WUQ) + (size_t)l * 640 * 256, 256, 256);
        EpiQ e{(u16*)(p.ws + WS_QM), p.pos};
        gemm_tile<0, 1>(g, (i2 / 5) * 256, (i2 % 5) * 128, lds, e);
      } else { const int i2 = it - N_C - N_A;
        GemmDesc g = gemm_desc(PROJ + PC_CKV, INWP, (const u16*)(p.ws + WS_WUKV) + (size_t)l * 768 * 128, 128, 128);
        EpiKV e{(u16*)(p.ws + WS_KM), (u16*)(p.ws + WS_VM), PROJ};
        gemm_tile<0, 1>(g, (i2 / 6) * 256, (i2 % 6) * 128, lds, e);
      }
    }
  } break;
  case 2: {
    for (int it = vb * 8 + wid; it < 2 * NB * NLCH * 6; it += nb * 8) lru_passA(p, it, lane);
  } break;
  case 3: {
    const int wi = vb * 8 + wid;
    if (wi < 48) lru_passB(p, wi, lane);
    __syncthreads();
    for (int it = vb; it < NB * 64 * 2; it += nb) swa_item(p, l, it, lds);
  } break;
  case 4: {
    for (int k = 0; k * nb + vb < NB * MLA_H * 32; ++k) {
      int pair, qb;
      if (nb == 256) { pair = k * 8 + (vb & 7); qb = vb >> 3; } else { const int it = k * nb + vb; pair = it >> 5; qb = it & 31; }
      mla_item(p, pair, qb, lds);
    }
#ifndef NO_LRUF
    for (int it = vb; it < NB * NLCH; it += nb) lru_final(p, it, lds);
#endif
  } break;
  case 5: {
    for (int t = vb * 8 + wid; t < T; t += nb * 8) {
      u32x4* rp = (u32x4*)(MIX + (size_t)t * DM + lane * 16);
      float v[16]; unpk8(rp[0], v); unpk8(rp[1], v + 8);
      float s = 0.f;
#pragma unroll
      for (int q = 0; q < 16; ++q) s = fmaf(v[q], v[q], s);
      const int sg = lane < 24 ? 0 : (lane < 48 ? 1 : 2);
      const float s0 = wave_sum(sg == 0 ? s : 0.f), s2 = wave_sum(sg == 2 ? s : 0.f);
      const float rs = sg == 0 ? rsqrtf(s0 * (1.f / 384.f) + EPS) : rsqrtf(s2 * (1.f / 256.f) + EPS);
      if (sg != 1) {
#pragma unroll
        for (int q = 0; q < 16; ++q) v[q] *= rs;
        rp[0] = pk8(v); rp[1] = pk8(v + 8); } }
  } break;
  case 6: {
    { pg8::Gemm g{MIX, (const u16*)(p.ws + WS_WOUT) + (size_t)l * DM * DM, T, DM, DM}; pg8::StaticOrder S; S.init(T, DM, nb, vb);
      pg8::EpiRes e{l == 0 ? p.x : p.out, dry ? (float*)(p.ws + WS_R1) : p.out, XG, (float*)(p.ws + WS_SSQ16)};
      pg8::gemm_phase((PG8_LAS unsigned char*)lds, g, S, e); }
    const float* us = p.peer_u + (size_t)l * NEXP * DM; const float* vs = p.peer_v + (size_t)l * NEXP * DM;
    u8* ub = (u8*)(p.ws + WS_UB); u8* vbf = (u8*)(p.ws + WS_VB);
    for (size_t i = (size_t)vb * NTHREADS + tid; i < (size_t)NEXP * 64; i += (size_t)nb * NTHREADS) {
      const size_t e = i >> 6; const int c16 = (int)(i & 63), s = c16 >> 3, cc = (c16 & 7) * 16;
      float a[16], b[16]; ld8(us + i * 16, a); ld8(us + i * 16 + 8, a + 8); ld8(vs + i * 16, b); ld8(vs + i * 16 + 8, b + 8);
#pragma unroll
      for (int q = 0; q < 16; ++q) { a[q] *= PEER_SU; b[q] *= PEER_SV; }
      const size_t o = ((size_t)s * NEXP + e) * 128 + cc;
      *(u32x4*)(ub + o) = (u32x4){enc4(a[0], a[1], a[2], a[3]), enc4(a[4], a[5], a[6], a[7]), enc4(a[8], a[9], a[10], a[11]), enc4(a[12], a[13], a[14], a[15])};
      *(u32x4*)(vbf + o) = (u32x4){enc4(b[0], b[1], b[2], b[3]), enc4(b[4], b[5], b[6], b[7]), enc4(b[8], b[9], b[10], b[11]), enc4(b[12], b[13], b[14], b[15])}; }
  } break;
  case 7: {
    pg8::Gemm g{XG, (const u16*)(p.ws + WS_WQ) + (size_t)l * 2048 * DM, T, 2048, DM}; pg8::StaticOrder S; S.init(T, 2048, nb, vb);
    pg8::EpiPQ e{PROJ, (const float*)(p.ws + WS_SSQ16)};
    pg8::gemm_phase((PG8_LAS unsigned char*)lds, g, S, e);
  } break;
  case 8: {
    for (int it = vb; it < NMT * 16; it += nb) { const int mt = it / 16, hj = it % 16, j = hj & 1;
      GemmDesc g{}; g.A = PROJ + hj * 128; g.lda = 2048; g.Bt = (const u16*)(p.ws + WS_SUBK) + (size_t)(l * 2 + j) * 128 * 128; g.ldb = 128; g.KT = 2;
      EpiTop e{(float*)(p.ws + WS_TOP), hj};
      gemm_tile<0, 0>(g, mt * 256, 0, lds, e); }
  } break;
  case 9: peer_cand(p, l, vb, nb, lds); break;
  case 10: case 12: {
    const bool last = l == DEPTH - 1;
    float* xo = dry ? (float*)(p.ws + WS_PD) : p.out;
    int s0, s1, tb, ts;
    if ((nb & 7) == 0) { s0 = vb & 7; s1 = s0 + 1; tb = (vb >> 3) * 8 + wid; ts = (nb >> 3) * 8; } else { s0 = 0; s1 = 8; tb = vb * 8 + wid; ts = nb * 8; }
#pragma unroll 1
    for (int s = s0; s < s1; ++s) { if (sp == 10) peer_slice_phase<false>(p, s, tb, ts, lane, p.out, xo, last); else peer_slice_phase<true>(p, s, tb, ts, lane, p.out, xo, last); }
  } break;
  case 11: {
    const float* pd = (const float*)(p.ws + WS_PD); const float* eg = (const float*)(p.ws + WS_EGATE); u16* cc = (u16*)(p.ws + WS_CC);
    for (size_t i = (size_t)vb * NTHREADS + tid; i < (size_t)T * 128 / 4; i += (size_t)nb * NTHREADS) {
      f32x4 a = *(const f32x4*)(pd + i * 4);
#pragma unroll
      for (int s = 1; s < 8; ++s) a += *(const f32x4*)(pd + (size_t)s * T * 128 + i * 4);
      const f32x4 g = *(const f32x4*)(eg + i * 4);
      f32x4 o; o.x = gelu_erf(a.x * (1.f / PEER_SU)) * g.x * (1.f / PEER_SV); o.y = gelu_erf(a.y * (1.f / PEER_SU)) * g.y * (1.f / PEER_SV);
      o.z = gelu_erf(a.z * (1.f / PEER_SU)) * g.z * (1.f / PEER_SV); o.w = gelu_erf(a.w * (1.f / PEER_SU)) * g.w * (1.f / PEER_SV);
      *(u32x2*)(cc + i * 4) = (u32x2){pk2(o.x, o.y), pk2(o.z, o.w)}; }
  } break;
  }
}

#define XB_TMO      128
#define XB_XCNT(j)  (256  + 64 * (j))
#define XB_XSUB(j)  (1280 + 64 * (j))
#define XB_XGEN(j)  (2304 + 64 * (j))
#define XB_TOP      3328
#define XB_TOPGEN   3392
#define XCD_BAR_WORDS 3456
#define XB_SPIN_CAP (1u << 23)
DEVI unsigned xb_ld(unsigned* p) { return __hip_atomic_load(p, __ATOMIC_RELAXED, __HIP_MEMORY_SCOPE_AGENT); }
DEVI unsigned xb_add(unsigned* p, unsigned v) { return __hip_atomic_fetch_add(p, v, __ATOMIC_RELAXED, __HIP_MEMORY_SCOPE_AGENT); }
DEVI unsigned xb_xcc_id() { return (unsigned)__builtin_amdgcn_s_getreg((3 << 11) | 20) & 0xFu; }
#define XB_SPIN(cond, bar) do { unsigned _sp = 0; while (cond) { __builtin_amdgcn_s_sleep(1); \
    if ((++_sp & 255u) == 0u) { if (xb_ld(&(bar)[XB_TMO])) break; if (_sp > XB_SPIN_CAP) { atomicAdd(&(bar)[XB_TMO], 1u); break; } } } } while (0)
struct XcdBarrier { unsigned* bar; unsigned x; volatile unsigned* st; };
DEVI XcdBarrier xcd_barrier_post(unsigned* bar, volatile unsigned* st) {
  XcdBarrier b; b.bar = bar; b.x = xb_xcc_id(); b.st = st;
  if (threadIdx.x == 0) (void)xb_add(&bar[XB_XCNT(b.x)], 1u);
  return b;
}
DEVI void xcd_barrier_complete(unsigned* bar, unsigned x, unsigned& nloc, unsigned& nx) {
  const unsigned G = gridDim.x * gridDim.y * gridDim.z;
  unsigned sum, cnt, mine, sp = 0u;
  for (;;) {
    sum = 0u; cnt = 0u; mine = 0u;
#pragma unroll
    for (unsigned j = 0; j < 16; ++j) { const unsigned c = xb_ld(&bar[XB_XCNT(j)]); sum += c; cnt += (c > 0u) ? 1u : 0u; mine = (j == x) ? c : mine; }
    if (sum == G) break;
    __builtin_amdgcn_s_sleep(1);
    if ((++sp & 255u) == 0u) { if (xb_ld(&bar[XB_TMO])) break; if (sp > XB_SPIN_CAP) { atomicAdd(&bar[XB_TMO], 1u); break; } }
  }
  nloc = mine > 0u ? mine : 1u; nx = cnt > 0u ? cnt : 1u;
}
DEVI void xcd_barrier(const XcdBarrier& b) {
  asm volatile("s_waitcnt vmcnt(0)" ::: "memory");
  __syncthreads();
  if (threadIdx.x == 0) {
    unsigned* bar = b.bar;
    __builtin_amdgcn_s_waitcnt(0);
    unsigned nloc = b.st[0], nx = b.st[1];
    if (nloc == 0u) { xcd_barrier_complete(bar, b.x, nloc, nx); b.st[0] = nloc; b.st[1] = nx; }
    const unsigned old = xb_add(&bar[XB_XSUB(b.x)], 1u);
    const unsigned gen = old / nloc;
    if (old + 1u == (gen + 1u) * nloc) {
      __builtin_amdgcn_fence(__ATOMIC_RELEASE, "agent");
      asm volatile("s_waitcnt vmcnt(0)" ::: "memory");
      const unsigned og = xb_add(&bar[XB_TOP], 1u);
      const unsigned tg = og / nx;
      if (og + 1u == (tg + 1u) * nx) xb_add(&bar[XB_TOPGEN], 1u);
      else XB_SPIN(xb_ld(&bar[XB_TOPGEN]) == tg, bar);
      __builtin_amdgcn_fence(__ATOMIC_ACQUIRE, "agent");
      xb_add(&bar[XB_XGEN(b.x)], 1u);
      asm volatile("s_waitcnt vmcnt(0)" ::: "memory");
    } else {
      XB_SPIN(xb_ld(&bar[XB_XGEN(b.x)]) == gen, bar);
      __builtin_amdgcn_fence(__ATOMIC_ACQUIRE, "agent");
      asm volatile("s_waitcnt vmcnt(0)" ::: "memory");
    }
  }
  __syncthreads();
}

__global__ void __launch_bounds__(NTHREADS, 2) mega(Params p) {
  extern __shared__ __attribute__((aligned(16))) char smem[];
  cg::grid_group grid = cg::this_grid();
  const int nb = gridDim.x, vb = blockIdx.x;
  volatile unsigned* st = (volatile unsigned*)(smem + LDS_BYTES - 16);
  if (threadIdx.x == 0) { st[0] = 0u; st[1] = 0u; }
  __syncthreads();
  const XcdBarrier bar = xcd_barrier_post((unsigned*)p.ws, st);
#define GRID_BAR(first) do { if (first) grid.sync(); else xcd_barrier(bar); } while (0)
  for (int ph = p.ph_lo; ph < p.ph_hi; ++ph) {
#ifdef PROBE_DUP
    if (ph > 0 && ph < N_PHASES - 1 && ((PROBE_DUP >> ((ph - 1) % PH_PER_LAYER)) & 1)) { run_phase(p, ph + 100, vb, nb, smem); GRID_BAR(false); }
#endif
    run_phase(p, ph, vb, nb, smem);
    if (ph + 1 < p.ph_hi) GRID_BAR(ph == p.ph_lo);
  }
}

#ifndef N_LAUNCH_SPLIT
#define N_LAUNCH_SPLIT 0
#endif
extern "C" void kernel_launch(void* const* d_in, const int* in_sizes, int n_in, void* d_out, int out_size, void* d_ws, size_t ws_size, hipStream_t stream) {
  static int grid_blocks = 0;
  if (grid_blocks == 0) {
    if (n_in != 24 || out_size != T * DM || ws_size < WS_NEED) { fprintf(stderr, "kernel_launch: unexpected shapes n_in %d out %d ws %zu\n", n_in, out_size, ws_size); grid_blocks = -1; return; }
    int dev = 0, cus = 0, per_cu = 0;
    (void)hipGetDevice(&dev); (void)hipDeviceGetAttribute(&cus, hipDeviceAttributeMultiprocessorCount, dev);
    if (hipFuncSetAttribute((const void*)mega, hipFuncAttributeMaxDynamicSharedMemorySize, LDS_BYTES) != hipSuccess) { fprintf(stderr, "kernel_launch: hipFuncSetAttribute failed\n"); grid_blocks = -1; return; }
    if (hipOccupancyMaxActiveBlocksPerMultiprocessor(&per_cu, (const void*)mega, NTHREADS, LDS_BYTES) != hipSuccess || per_cu < 1) { fprintf(stderr, "kernel_launch: occupancy query failed (%d)\n", per_cu); grid_blocks = -1; return; }
    grid_blocks = cus * 1;
    fprintf(stderr, "kernel_launch: cus %d per_cu %d grid %d\n", cus, per_cu, grid_blocks);
  }
  if (grid_blocks < 0) return;
  if (hipMemsetAsync(d_ws, 0, 65536, stream) != hipSuccess) { fprintf(stderr, "kernel_launch: memset failed\n"); return; }
  Params p{};
  p.x = (const float*)d_in[0]; p.pos = (const int*)d_in[1]; p.norm_mix = (const float*)d_in[2]; p.w_in = (const float*)d_in[3]; p.q_norm = (const float*)d_in[4];
  p.w_uq = (const float*)d_in[5]; p.kv_norm = (const float*)d_in[6]; p.w_ukv = (const float*)d_in[7]; p.conv_w = (const float*)d_in[8]; p.conv_b = (const float*)d_in[9];
  p.lru_wa = (const float*)d_in[10]; p.lru_ba = (const float*)d_in[11]; p.lru_wx = (const float*)d_in[12]; p.lru_bx = (const float*)d_in[13]; p.lru_lambda = (const float*)d_in[14];
  p.swa_sink = (const float*)d_in[15]; p.grp_norm = (const float*)d_in[16]; p.w_out = (const float*)d_in[17]; p.norm_ffn = (const float*)d_in[18]; p.peer_wq = (const float*)d_in[19];
  p.peer_subkeys = (const float*)d_in[20]; p.peer_u = (const float*)d_in[21]; p.peer_v = (const float*)d_in[22]; p.norm_final = (const float*)d_in[23];
  p.out = (float*)d_out; p.ws = (unsigned char*)d_ws;
#if N_LAUNCH_SPLIT
  for (int ph = 0; ph < N_PHASES; ++ph) {
    p.ph_lo = ph; p.ph_hi = ph + 1;
    void* args[] = {&p};
    hipError_t e = hipLaunchCooperativeKernel((const void*)mega, dim3(grid_blocks), dim3(NTHREADS), args, LDS_BYTES, stream);
    if (e != hipSuccess) { fprintf(stderr, "kernel_launch: launch of phase %d failed: %s\n", ph, hipGetErrorString(e)); break; }
  }
#else
  p.ph_lo = 0; p.ph_hi = N_PHASES;
  void* args[] = {&p};
  hipError_t e = hipLaunchCooperativeKernel((const void*)mega, dim3(grid_blocks), dim3(NTHREADS), args, LDS_BYTES, stream);
  if (e != hipSuccess) fprintf(stderr, "kernel_launch: cooperative launch failed: %s (grid %d)\n", hipGetErrorString(e), grid_blocks);
#endif
}
```

```cpp
#include <hip/hip_runtime.h>
#include <hip/hip_cooperative_groups.h>
#include <cstdio>
#include <cstdint>
namespace cg = cooperative_groups;

#define DEVI __device__ __forceinline__
typedef unsigned short u16;
typedef short bf16x8 __attribute__((ext_vector_type(8)));
typedef short s16x4 __attribute__((ext_vector_type(4)));
typedef float f32x2 __attribute__((ext_vector_type(2)));
typedef float f32x4 __attribute__((ext_vector_type(4)));
typedef float f32x16 __attribute__((ext_vector_type(16)));
typedef unsigned u32x4 __attribute__((ext_vector_type(4)));
typedef unsigned u32x2 __attribute__((ext_vector_type(2)));
typedef __bf16 bf16x2_t __attribute__((ext_vector_type(2)));

constexpr int NB = 4, SEQ = 8192, T = NB * SEQ, DM = 1024, DEPTH = 2;
constexpr int MLA_H = 6, MLA_QK = 96, MLA_V = 64;
constexpr int LRU_W = 384;
constexpr int INW = 1696, INWP = 1792;
constexpr int PC_CQ = 0, PC_CKV = 256, PC_SQ = 384, PC_SK = 640, PC_SV = 768, PC_LX = 896, PC_LG = 1280, PC_KR = 1664;
constexpr int OC_CQ = 0, OC_CKV = 256, OC_KR = 384, OC_SQ = 416, OC_SK = 672, OC_SV = 800, OC_LX = 928, OC_LG = 1312;
constexpr int NEXP = 16384;
constexpr float EPS = 1e-6f;
constexpr int NTHREADS = 512;
constexpr int LDS_BYTES = 160 * 1024;

constexpr size_t MiB = 1u << 20;
constexpr size_t WS_CTL = 0;
constexpr size_t WS_WIN = 4 * MiB;
constexpr size_t WS_WQ = 11 * MiB;
constexpr size_t WS_WOUT = 19 * MiB;
constexpr size_t WS_WUQ = 23 * MiB;
constexpr size_t WS_WUKV = WS_WUQ + 2 * 768 * 256 * 2;
constexpr size_t WS_WLRU = WS_WUKV + 2 * 768 * 128 * 2;
constexpr size_t WS_SUBK = WS_WLRU + 2 * 6 * 2 * 128 * 64 * 2;
constexpr size_t WS_XG = 25 * MiB;
constexpr size_t WS_R1 = 89 * MiB;
constexpr size_t WS_QM = 217 * MiB;
constexpr size_t WS_KM = 253 * MiB;
constexpr size_t WS_VM = 289 * MiB;
constexpr size_t WS_LE = 313 * MiB;
constexpr size_t WS_LB = 361 * MiB;
constexpr size_t WS_MIX = 409 * MiB;
constexpr size_t WS_UB = 217 * MiB;
constexpr size_t WS_VB = 233 * MiB;
constexpr size_t WS_TOP = 281 * MiB;
constexpr size_t WS_EIDX = 313 * MiB;
constexpr size_t WS_EGATE = 329 * MiB;
constexpr size_t WS_CC = 345 * MiB;
constexpr size_t WS_SSQ = 361 * MiB;
constexpr size_t WS_SSQ16 = 363 * MiB;
constexpr size_t WS_SSQQ = 365 * MiB;
constexpr size_t WS_SSQKV = 366 * MiB;
constexpr size_t WS_PD = 89 * MiB;
constexpr float PEER_SU = 256.f, PEER_SV = 16.f;
constexpr size_t WS_END = 473 * MiB;

__device__ const float ROPE_HI[32] = {1.591549367e-01f, 1.193493679e-01f, 8.949939907e-02f, 6.711508334e-02f, 5.032921210e-02f, 3.774158657e-02f, 2.830219641e-02f, 2.122365311e-02f, 1.591549441e-02f, 1.193493698e-02f, 8.949940093e-03f, 6.711508147e-03f, 5.032921210e-03f, 3.774158424e-03f, 2.830219688e-03f, 2.122365171e-03f, 1.591549488e-03f, 1.193493721e-03f, 8.949940093e-04f, 6.711508031e-04f, 5.032921326e-04f, 3.774158540e-04f, 2.830219455e-04f, 2.122365258e-04f, 1.591549371e-04f, 1.193493736e-04f, 8.949940093e-05f, 6.711508468e-05f, 5.032921035e-05f, 3.774158540e-05f, 2.830219637e-05f, 2.122365186e-05f};
__device__ const float ROPE_LO[32] = {6.420638243e-09f, 2.294664903e-09f, 2.542919653e-09f, -3.316028840e-10f, 5.173299289e-12f, -1.848551645e-09f, -5.826552019e-10f, -3.431038786e-10f, -1.029942243e-10f, 4.320196978e-11f, 6.802744479e-11f, 1.531042237e-10f, 5.173301024e-13f, 4.797548470e-11f, -1.048316434e-10f, 1.053879969e-10f, -5.686555046e-11f, -1.896286773e-11f, 6.802744999e-12f, 2.695195456e-11f, -1.158979943e-11f, -6.843983713e-12f, 1.279990003e-11f, 1.807650600e-12f, 5.954976963e-12f, -3.351478166e-12f, 6.802744674e-13f, -1.670379113e-12f, 1.751403167e-12f, -6.843983930e-13f, -5.389994549e-13f, 9.083608431e-13f};

DEVI int tidx() { int t = __builtin_amdgcn_workitem_id_x(); asm volatile("" : "+v"(t)); return t; }
DEVI float bf2f(unsigned h) { return __uint_as_float(h << 16); }
DEVI float bflo(unsigned w) { return __uint_as_float(w << 16); }
DEVI float bfhi(unsigned w) { return __uint_as_float(w & 0xffff0000u); }
DEVI unsigned pk2(float lo, float hi) { f32x2 v = {lo, hi}; bf16x2_t b = __builtin_convertvector(v, bf16x2_t); return __builtin_bit_cast(unsigned, b); }
DEVI u16 f2bf(float f) { return (u16)(pk2(f, 0.f) & 0xffffu); }
DEVI u32x4 pk8(const float* v) { u32x4 w; w.x = pk2(v[0], v[1]); w.y = pk2(v[2], v[3]); w.z = pk2(v[4], v[5]); w.w = pk2(v[6], v[7]); return w; }
DEVI void unpk8(u32x4 w, float* v) { v[0] = bflo(w.x); v[1] = bfhi(w.x); v[2] = bflo(w.y); v[3] = bfhi(w.y); v[4] = bflo(w.z); v[5] = bfhi(w.z); v[6] = bflo(w.w); v[7] = bfhi(w.w); }
DEVI void ld8(const float* p, float* v) { const f32x4 a = *(const f32x4*)p, b = *(const f32x4*)(p + 4); v[0] = a.x; v[1] = a.y; v[2] = a.z; v[3] = a.w; v[4] = b.x; v[5] = b.y; v[6] = b.z; v[7] = b.w; }
DEVI int crow(int r, int hi) { return (r & 3) + 8 * (r >> 2) + 4 * hi; }
DEVI float wave_sum(float v) {
#pragma unroll
  for (int o = 1; o < 64; o <<= 1) v += __shfl_xor(v, o);
  return v;
}
DEVI void rope_sc(float pos, int fidx, float& sn, float& cs) {
  const float chi = ROPE_HI[fidx], clo = ROPE_LO[fidx];
  const float t = pos * chi, e = fmaf(pos, chi, -t);
  float fr = t - rintf(t);
  fr = fr + (e + pos * clo);
  sn = __builtin_amdgcn_sinf(fr); cs = __builtin_amdgcn_cosf(fr);
}
DEVI float sigmoidf_(float x) { return 1.f / (1.f + __expf(-x)); }
DEVI float gelu_erf(float x) { return 0.5f * x * (1.f + erff(x * 0.70710678118654752f)); }

struct Params {
  const float* x; const int* pos; const float* norm_mix; const float* w_in; const float* q_norm; const float* w_uq; const float* kv_norm; const float* w_ukv;
  const float* conv_w; const float* conv_b; const float* lru_wa; const float* lru_ba; const float* lru_wx; const float* lru_bx; const float* lru_lambda;
  const float* swa_sink; const float* grp_norm; const float* w_out; const float* norm_ffn; const float* peer_wq; const float* peer_subkeys;
  const float* peer_u; const float* peer_v; const float* norm_final;
  float* out; unsigned char* ws;
  int ph_lo, ph_hi;
};

DEVI void tconv_item(const float* W, int ldw, int src_c0, u16* WT, int K, int dst_r0, const float* gain, float* scr, int kb, int nb, int lane, int pg = 0) {
  const int k0 = 64 * kb, n0 = 32 * nb;
#pragma unroll 8
  for (int i = 0; i < 32; ++i) { const int kk = 2 * i + (lane >> 5); float g = gain ? gain[k0 + kk] : 1.f; scr[kk * 33 + (lane & 31)] = g * W[(size_t)(k0 + kk) * ldw + src_c0 + n0 + (lane & 31)]; }
  __builtin_amdgcn_s_waitcnt(0xc07f); asm volatile("" ::: "memory");
  const int c = lane & 7;
#pragma unroll
  for (int j = 0; j < 4; ++j) { const int n = (lane >> 3) + 8 * j; const float* s = scr + (8 * c) * 33 + n;
    u32x4 o; o.x = pk2(s[0 * 33], s[1 * 33]); o.y = pk2(s[2 * 33], s[3 * 33]); o.z = pk2(s[4 * 33], s[5 * 33]); o.w = pk2(s[6 * 33], s[7 * 33]);
    int nn = n0 + n; if (pg > 0) { const int g = nn & ~(pg - 1), i = nn & (pg - 1), hw = pg >> 1; nn = g + (i < hw ? 2 * i : 2 * (i - hw) + 1); }
    else if (pg < 0) { const int j = nn % 96; if (j >= 64) { const int i = j - 64; nn = nn - i + (i < 16 ? 2 * i : 2 * (i - 16) + 1); } }
    *(u32x4*)(WT + (size_t)(dst_r0 + nn) * K + k0 + 8 * c) = o; }
  __builtin_amdgcn_s_waitcnt(0xc07f); asm volatile("" ::: "memory");
}

DEVI void p0_item(const Params& p, int it, float* scr, int lane) {
  const int l = it / 2552; int r = it - l * 2552;
  const float* win = p.w_in + (size_t)l * DM * INW; u16* wint = (u16*)(p.ws + WS_WIN) + (size_t)l * INWP * DM; const float* gm = p.norm_mix + l * DM;
#define SEG(W, ldw, sc0, ncols, WT, K, dr0, gain, pg) { const int nnb_ = (ncols) / 32, ni_ = ((K) / 64) * nnb_; if (r < ni_) { tconv_item(W, ldw, sc0, WT, K, dr0, gain, scr, r / nnb_, r % nnb_, lane, pg); return; } r -= ni_; }
  SEG(win, INW, OC_CQ, 256, wint, DM, PC_CQ, gm, 0)
  SEG(win, INW, OC_CKV, 128, wint, DM, PC_CKV, gm, 0)
  SEG(win, INW, OC_SQ, 256, wint, DM, PC_SQ, gm, 64)
  SEG(win, INW, OC_SK, 128, wint, DM, PC_SK, gm, 64)
  SEG(win, INW, OC_SV, 128, wint, DM, PC_SV, gm, 0)
  SEG(win, INW, OC_LX, 384, wint, DM, PC_LX, gm, 0)
  SEG(win, INW, OC_LG, 384, wint, DM, PC_LG, gm, 0)
  SEG(win, INW, OC_KR, 32, wint, DM, PC_KR, gm, 32)
  SEG(p.peer_wq + (size_t)l * DM * 2048, 2048, 0, 2048, (u16*)(p.ws + WS_WQ) + (size_t)l * 2048 * DM, DM, 0, p.norm_ffn + l * DM, 0)
  SEG(p.w_out + (size_t)l * DM * DM, DM, 0, DM, (u16*)(p.ws + WS_WOUT) + (size_t)l * DM * DM, DM, 0, p.grp_norm + l * DM, 0)
  SEG(p.w_uq + (size_t)l * 256 * 576, 576, 0, 576, (u16*)(p.ws + WS_WUQ) + (size_t)l * 768 * 256, 256, 0, p.q_norm + l * 256, -1)
  SEG(p.w_ukv + (size_t)l * 128 * 768, 768, 0, 768, (u16*)(p.ws + WS_WUKV) + (size_t)l * 768 * 128, 128, 0, p.kv_norm + l * 128, 0)
#undef SEG
  { const int nbk = r & 1, ax = (r >> 1) & 1, n = (r >> 2) % 6, d = (r >> 2) / 6;
    const float* W = (ax ? p.lru_wx : p.lru_wa) + ((size_t)(l * 2 + d) * 6 + n) * 4096;
    u16* WT = (u16*)(p.ws + WS_WLRU) + ((size_t)((l * 6 + n) * 2 + d)) * 128 * 64;
    tconv_item(W, 64, 0, WT, 64, 32 * nbk + 32 * ax, nullptr, scr, 0, nbk, lane); }
}

DEVI void phase0(const Params& p, int vb, int nb, char* lds) {
  const int tid = tidx(), lane = tid & 63, wid = tid >> 6;
  float* scr = (float*)(lds + wid * 16384);
  const int gw = vb * 8 + wid, ngw = nb * 8;
  for (int it = gw; it < DEPTH * 2552; it += ngw) p0_item(p, it, scr, lane);
  for (int i = vb * NTHREADS + tid; i < DEPTH * 96 * DM / 8; i += nb * NTHREADS) { const int l = i / (96 * DM / 8), r = i % (96 * DM / 8);
    *(u32x4*)((u16*)(p.ws + WS_WIN) + ((size_t)l * INWP + INW) * DM + (size_t)r * 8) = (u32x4){0, 0, 0, 0}; }
  for (int i = vb * NTHREADS + tid; i < DEPTH * 192 * 256 / 8; i += nb * NTHREADS) { const int l = i / (192 * 256 / 8), r = i % (192 * 256 / 8);
    *(u32x4*)((u16*)(p.ws + WS_WUQ) + ((size_t)l * 768 + 576) * 256 + (size_t)r * 8) = (u32x4){0, 0, 0, 0}; }
  for (int i = vb * NTHREADS + tid; i < DEPTH * 2 * 128 * 128 / 8; i += nb * NTHREADS) {
    float a[8]; ld8(p.peer_subkeys + (size_t)i * 8, a);
    *(u32x4*)((u16*)(p.ws + WS_SUBK) + (size_t)i * 8) = pk8(a); }
  { float* ssq = (float*)(p.ws + WS_SSQ); u16* xg = (u16*)(p.ws + WS_XG);
    for (int t = gw * 2; t < T; t += ngw * 2) {
      float a[2][16];
#pragma unroll
      for (int u = 0; u < 2; ++u) { ld8(p.x + (size_t)(t + u) * DM + lane * 16, a[u]); ld8(p.x + (size_t)(t + u) * DM + lane * 16 + 8, a[u] + 8); }
#pragma unroll
      for (int u = 0; u < 2; ++u) { float s = 0.f;
#pragma unroll
        for (int q = 0; q < 16; ++q) s = fmaf(a[u][q], a[u][q], s);
        s += __shfl_xor(s, 1); s += __shfl_xor(s, 2); s += __shfl_xor(s, 4);
        if ((lane & 7) == 0) ssq[(size_t)(t + u) * 8 + (lane >> 3)] = s;
        u32x4* o = (u32x4*)(xg + (size_t)(t + u) * DM + lane * 16); o[0] = pk8(a[u]); o[1] = pk8(a[u] + 8); } } }
}

DEVI int swz(int row, int c) { return row * 128 + ((c ^ ((row >> 1) & 7)) << 4); }
constexpr int CLD = 132;
constexpr int LDS_RS = 135168;

struct GemmDesc {
  const u16* A; int lda; const u16* Bt; int ldb; int KT;
  float inv0;
  const u16* proj; const float* cw; const float* cb; int ch0;
};

template <int AMODE> DEVI bf16x8 load_a(const GemmDesc& g, int row, int kcol) {
  if constexpr (AMODE == 0) {
    return *(const bf16x8*)(g.A + (size_t)row * g.lda + kcol);
  } else {
    const int s = row & (SEQ - 1), ch = g.ch0 + kcol;
    float a[8];
    { const f32x4 b0 = *(const f32x4*)(g.cb + ch), b1 = *(const f32x4*)(g.cb + ch + 4); a[0] = b0.x; a[1] = b0.y; a[2] = b0.z; a[3] = b0.w; a[4] = b1.x; a[5] = b1.y; a[6] = b1.z; a[7] = b1.w; }
#pragma unroll
    for (int tap = 0; tap < 4; ++tap) {
      const int ss = s - 1 + tap;
      if (ss >= 0 && ss < SEQ) {
        const u32x4 v = *(const u32x4*)(g.proj + (size_t)(row - 1 + tap) * INWP + PC_LX + ch);
        float x[8]; unpk8(v, x);
        const f32x4 w0 = *(const f32x4*)(g.cw + tap * LRU_W + ch), w1 = *(const f32x4*)(g.cw + tap * LRU_W + ch + 4);
        a[0] += w0.x * x[0]; a[1] += w0.y * x[1]; a[2] += w0.z * x[2]; a[3] += w0.w * x[3];
        a[4] += w1.x * x[4]; a[5] += w1.y * x[5]; a[6] += w1.z * x[6]; a[7] += w1.w * x[7];
      }
    }
    const u32x4 o = pk8(a);
    return __builtin_bit_cast(bf16x8, o);
  }
}

template <int AMODE> DEVI void g_load(const GemmDesc& g, bf16x8 (&ar)[4], bf16x8 (&br)[2], int m0, int n0, int srow, int sc, int kt) {
#pragma unroll
  for (int i = 0; i < 4; ++i) ar[i] = load_a<AMODE>(g, m0 + srow + 64 * i, kt * 64 + sc * 8);
#pragma unroll
  for (int i = 0; i < 2; ++i) br[i] = *(const bf16x8*)(g.Bt + (size_t)(n0 + srow + 64 * i) * g.ldb + kt * 64 + sc * 8);
}
template <bool NORM> DEVI void g_write(char* Ab, const bf16x8 (&ar)[4], const bf16x8 (&br)[2], float (&ssq)[4], int srow, int sc) {
  char* Bb = Ab + 32768;
#pragma unroll
  for (int i = 0; i < 4; ++i) { *(bf16x8*)(Ab + swz(srow + 64 * i, sc)) = ar[i];
    if (NORM) { float x[8]; unpk8(__builtin_bit_cast(u32x4, ar[i]), x); float s = ssq[i];
#pragma unroll
      for (int q = 0; q < 8; ++q) s = fmaf(x[q], x[q], s);
      ssq[i] = s; } }
#pragma unroll
  for (int i = 0; i < 2; ++i) *(bf16x8*)(Bb + swz(srow + 64 * i, sc)) = br[i];
}

template <int AMODE, int SEG, class Epi>
DEVI void gemm_tile(const GemmDesc& g, int m0, int n0, char* lds, const Epi& epi) {
  const int tid = tidx(), lane = tid & 63, wid = tid >> 6;
  const int wm = wid >> 1, wn = wid & 1, r32 = lane & 31, hi = lane >> 5;
  const int srow = tid >> 3, sc = tid & 7;
  constexpr bool NORM = SEG != 0;
  float* rs = (float*)(lds + LDS_RS);
  f32x16 acc[2][2], acc2[2][2];
#pragma unroll
  for (int i = 0; i < 2; ++i)
#pragma unroll
    for (int j = 0; j < 2; ++j) { acc[i][j] = f32x16{}; acc2[i][j] = f32x16{}; }
  float ssq[4] = {0.f, 0.f, 0.f, 0.f};
  bf16x8 ar[4], br[2];
  g_load<AMODE>(g, ar, br, m0, n0, srow, sc, 0); g_write<NORM>(lds, ar, br, ssq, srow, sc); __syncthreads();
  int seg = 0;
#pragma unroll 1
  for (int kt = 0; kt < g.KT; ++kt) {
    const int cur = kt & 1;
    if (kt + 1 < g.KT) g_load<AMODE>(g, ar, br, m0, n0, srow, sc, kt + 1);
    { const char* Ab = lds + cur * 49152; const char* Bb = Ab + 32768;
#pragma unroll
      for (int k16 = 0; k16 < 4; ++k16) {
        bf16x8 a[2], b[2];
#pragma unroll
        for (int mt = 0; mt < 2; ++mt) a[mt] = *(const bf16x8*)(Ab + swz(wm * 64 + mt * 32 + r32, k16 * 2 + hi));
#pragma unroll
        for (int nt = 0; nt < 2; ++nt) b[nt] = *(const bf16x8*)(Bb + swz(wn * 64 + nt * 32 + r32, k16 * 2 + hi));
#pragma unroll
        for (int mt = 0; mt < 2; ++mt)
#pragma unroll
          for (int nt = 0; nt < 2; ++nt) {
            if (NORM) acc2[mt][nt] = __builtin_amdgcn_mfma_f32_32x32x16_bf16(a[mt], b[nt], acc2[mt][nt], 0, 0, 0);
            else acc[mt][nt] = __builtin_amdgcn_mfma_f32_32x32x16_bf16(a[mt], b[nt], acc[mt][nt], 0, 0, 0);
          }
      } }
    if (NORM) {
      int se; float inv;
      if (SEG == 1) { se = g.KT; inv = g.inv0; }
      else { se = seg == 0 ? 6 : (seg == 1 ? 12 : 16); inv = seg == 2 ? (1.f / 256.f) : (1.f / 384.f); }
      if (kt + 1 == se) {
#pragma unroll
        for (int i = 0; i < 4; ++i) { float s = ssq[i]; s += __shfl_xor(s, 1); s += __shfl_xor(s, 2); s += __shfl_xor(s, 4); if (sc == 0) rs[srow + 64 * i] = rsqrtf(s * inv + EPS); }
        __syncthreads();
#pragma unroll
        for (int mt = 0; mt < 2; ++mt)
#pragma unroll
          for (int r = 0; r < 16; ++r) { const float f = rs[wm * 64 + mt * 32 + crow(r, hi)];
#pragma unroll
            for (int nt = 0; nt < 2; ++nt) { acc[mt][nt][r] = fmaf(f, acc2[mt][nt][r], acc[mt][nt][r]); acc2[mt][nt][r] = 0.f; } }
        ssq[0] = ssq[1] = ssq[2] = ssq[3] = 0.f;
        ++seg;
      }
    }
    if (kt + 1 < g.KT) g_write<NORM>(lds + (cur ^ 1) * 49152, ar, br, ssq, srow, sc);
    __syncthreads();
  }
  float* C = (float*)lds;
#pragma unroll
  for (int mt = 0; mt < 2; ++mt)
#pragma unroll
    for (int nt = 0; nt < 2; ++nt)
#pragma unroll
      for (int r = 0; r < 16; ++r) C[(wm * 64 + mt * 32 + crow(r, hi)) * CLD + wn * 64 + nt * 32 + r32] = acc[mt][nt][r];
  __syncthreads();
  epi(C, m0, n0);
  __syncthreads();
}

DEVI GemmDesc gemm_desc(const u16* A, int lda, const u16* Bt, int ldb, int K) {
  GemmDesc g{}; g.A = A; g.lda = lda; g.Bt = Bt; g.ldb = ldb; g.KT = K / 64; g.inv0 = 1.f / (float)K; return g;
}


template <int HW> DEVI void rope8(float* v, const float* pp, int i0, float posf) {
  const bool first = i0 < HW; const int f0 = i0 & (HW - 1);
#pragma unroll
  for (int j = 0; j < 8; ++j) { float sn, cs; rope_sc(posf, HW == 32 ? (f0 + j) : 2 * (f0 + j), sn, cs); const float pv = pp[j]; v[j] = first ? v[j] * cs - pv * sn : v[j] * cs + pv * sn; }
}

struct EpiP1 { u16* proj; const int* pos;
  DEVI void operator()(const float* C, int m0, int n0) const {
    const int tid = tidx();
#pragma unroll 1
    for (int it = 0; it < 8; ++it) { const int item = it * NTHREADS + tid, row = item >> 4, c8 = (item & 15) * 8, gcol = n0 + c8, grow = m0 + row;
      float v[8]; ld8(C + row * CLD + c8, v);
      const bool r64 = gcol >= PC_SQ && gcol < PC_SV, r32g = gcol >= PC_KR && gcol < PC_KR + 32;
      if (r64) { const int i0 = gcol & 63; float pp[8]; ld8(C + row * CLD + c8 + (i0 < 32 ? 32 : -32), pp); rope8<32>(v, pp, i0, (float)pos[grow]); }
      else if (r32g) { const int i0 = gcol & 31; float pp[8]; ld8(C + row * CLD + c8 + (i0 < 16 ? 16 : -16), pp); rope8<16>(v, pp, i0, (float)pos[grow]); }
      *(u32x4*)(proj + (size_t)grow * INWP + gcol) = pk8(v);
    }
  }
};

struct EpiQ { u16* qm; const int* pos;
  DEVI void operator()(const float* C, int m0, int n0) const {
    const int tid = tidx();
#pragma unroll 1
    for (int it = 0; it < 8; ++it) { const int item = it * NTHREADS + tid, row = item >> 4, c8 = (item & 15) * 8, gcol = n0 + c8, grow = m0 + row;
      if (gcol >= 576) continue;
      const int head = gcol / 96, j0 = gcol - head * 96, b = grow >> 13, s = grow & (SEQ - 1);
      float v[8]; ld8(C + row * CLD + c8, v);
      u16* qrow = qm + ((size_t)(b * MLA_H + head) * SEQ + s) * MLA_QK;
      if (j0 >= 64) { const int i0 = j0 - 64; float pp[8]; ld8(C + row * CLD + c8 + (i0 < 16 ? 16 : -16), pp); rope8<16>(v, pp, i0, (float)pos[grow]);
#pragma unroll
        for (int j = 0; j < 8; ++j) { const int i = i0 + j; qrow[64 + (i < 16 ? 2 * i : 2 * (i - 16) + 1)] = f2bf(v[j]); } }
      else *(u32x4*)(qrow + j0) = pk8(v);
    }
  }
};

struct EpiKV { u16* km; u16* vm; const u16* proj;
  DEVI void operator()(const float* C, int m0, int n0) const {
    const int tid = tidx(), head = n0 >> 7;
#pragma unroll 1
    for (int it = 0; it < 8; ++it) { const int item = it * NTHREADS + tid, row = item >> 4, c8 = (item & 15) * 8, grow = m0 + row;
      const int b = grow >> 13, s = grow & (SEQ - 1);
      float v[8]; ld8(C + row * CLD + c8, v);
      const size_t tok = (size_t)(b * MLA_H + head) * SEQ + s;
      if (c8 < 64) *(u32x4*)(km + tok * MLA_QK + c8) = pk8(v);
      else *(u32x4*)(vm + tok * MLA_V + (c8 - 64)) = pk8(v);
    }
#pragma unroll 1
    for (int it = 0; it < 2; ++it) { const int item = it * NTHREADS + tid, row = item >> 2, c = (item & 3) * 8, grow = m0 + row;
      const int b = grow >> 13, s = grow & (SEQ - 1);
      *(u32x4*)(km + ((size_t)(b * MLA_H + head) * SEQ + s) * MLA_QK + 64 + c) = *(const u32x4*)(proj + (size_t)grow * INWP + PC_KR + c);
    }
  }
};

struct EpiLRU { const u16* proj; const float* cw; const float* cb; const float* ba; const float* bx; const float* lam; u16* le; u16* lb; int n, d;
  DEVI void operator()(const float* C, int m0, int) const {
    const int tid = tidx();
#pragma unroll 1
    for (int it = 0; it < 4; ++it) { const int item = it * NTHREADS + tid, j = item & 63, g8 = item >> 6;
      const int ch = n * 64 + j, grow0 = m0 + g8 * 8, s0 = grow0 & (SEQ - 1), b = grow0 >> 13;
      const float bav = ba[(d * 6 + n) * 64 + j], bxv = bx[(d * 6 + n) * 64 + j];
      const float cdec = -8.f * log1pf(__expf(-lam[d * LRU_W + ch]));
      float xin[11];
#pragma unroll
      for (int q = 0; q < 11; ++q) { const int ss = s0 - 1 + q; xin[q] = (ss >= 0 && ss < SEQ) ? bf2f(proj[(size_t)(grow0 - 1 + q) * INWP + PC_LX + ch]) : 0.f; }
      const float w0 = cw[ch], w1 = cw[LRU_W + ch], w2 = cw[2 * LRU_W + ch], w3 = cw[3 * LRU_W + ch], cbv = cb[ch];
      float ev[8], bv[8];
#pragma unroll
      for (int rr = 0; rr < 8; ++rr) {
        const float xf = cbv + w0 * xin[rr] + w1 * xin[rr + 1] + w2 * xin[rr + 2] + w3 * xin[rr + 3];
        const float r = sigmoidf_(C[(g8 * 8 + rr) * CLD + j] + bav), ig = sigmoidf_(C[(g8 * 8 + rr) * CLD + 64 + j] + bxv);
        const float a = __expf(cdec * r), e = 1.f - a;
        ev[rr] = e; bv[rr] = sqrtf(e * (2.f - e)) * ig * xf;
      }
      const size_t o = (((size_t)(d * NB + b) * (SEQ / 8) + (s0 >> 3)) * LRU_W + ch) * 8;
      *(u32x4*)(le + o) = pk8(ev); *(u32x4*)(lb + o) = pk8(bv);
    }
  }
};

struct EpiP4 { const float* xres; float* xout; u16* xg;
  DEVI void operator()(const float* C, int m0, int n0) const {
    const int tid = tidx();
#pragma unroll 1
    for (int it = 0; it < 8; ++it) { const int item = it * NTHREADS + tid, row = item >> 4, c8 = (item & 15) * 8, gcol = n0 + c8, grow = m0 + row;
      float v[8], x[8]; ld8(C + row * CLD + c8, v); ld8(xres + (size_t)grow * DM + gcol, x);
#pragma unroll
      for (int j = 0; j < 8; ++j) v[j] += x[j];
      *(f32x4*)(xout + (size_t)grow * DM + gcol) = (f32x4){v[0], v[1], v[2], v[3]}; *(f32x4*)(xout + (size_t)grow * DM + gcol + 4) = (f32x4){v[4], v[5], v[6], v[7]};
      *(u32x4*)(xg + (size_t)grow * DM + gcol) = pk8(v);
    }
  }
};

struct EpiBf16 { u16* o; int ldo;
  DEVI void operator()(const float* C, int m0, int n0) const {
    const int tid = tidx();
#pragma unroll 1
    for (int it = 0; it < 8; ++it) { const int item = it * NTHREADS + tid, row = item >> 4, c8 = (item & 15) * 8;
      float v[8]; ld8(C + row * CLD + c8, v);
      *(u32x4*)(o + (size_t)(m0 + row) * ldo + n0 + c8) = pk8(v);
    }
  }
};

DEVI void ce_desc(float& a, float& b) { const float mx = fmaxf(a, b), mn = fminf(a, b); a = mx; b = mn; }
struct EpiTop { float* top; int hj;
  DEVI void operator()(const float* C, int m0, int) const {
    const int tid = tidx(), row = tid >> 1, part = tid & 1;
    float l[16];
#pragma unroll
    for (int i = 0; i < 16; ++i) l[i] = -3.0e38f;
#pragma unroll 4
    for (int c = 0; c < 64; ++c) { const int col = part * 64 + ((c + row) & 63);
      float v = __uint_as_float((__float_as_uint(C[row * CLD + col]) & ~127u) | (unsigned)(127 - col));
#pragma unroll
      for (int i = 0; i < 16; ++i) { const float t = fmaxf(l[i], v); v = fminf(l[i], v); l[i] = t; } }
    float m[16];
#pragma unroll
    for (int i = 0; i < 16; ++i) m[i] = __shfl_xor(l[15 - i], 1);
#pragma unroll
    for (int i = 0; i < 16; ++i) m[i] = fmaxf(m[i], l[i]);
#pragma unroll
    for (int st = 8; st >= 1; st >>= 1)
#pragma unroll
      for (int i = 0; i < 16; ++i) if ((i & st) == 0) ce_desc(m[i], m[i + st]);
    if (part == 0) { float* o = top + ((size_t)(m0 + row) * 16 + hj) * 16;
#pragma unroll
      for (int i = 0; i < 4; ++i) *(f32x4*)(o + 4 * i) = (f32x4){m[4 * i], m[4 * i + 1], m[4 * i + 2], m[4 * i + 3]}; }
  }
};

#define KSWZ(row, colB) ((row) * 256 + ((colB) ^ (((row) & 15) << 4)))
#define SBAR() __builtin_amdgcn_sched_barrier(0)
constexpr int AT_SHM_V = 64 * 64 * 2, AT_SHM_K = 64 * 128 * 2;
constexpr int AT_LDS = 3 * AT_SHM_V + 2 * AT_SHM_K + 8 * 64 * 4;
constexpr float ATT_THR = 8.f;
DEVI unsigned cvtpk(float lo, float hi) { unsigned r; asm volatile("v_cvt_pk_bf16_f32 %0, %1, %2" : "=v"(r) : "v"(lo), "v"(hi)); return r; }
DEVI int v_st(int k, int c) { const int kk = (k & ~0xC) | ((k & 4) << 1) | ((k & 8) >> 1); return ((kk >> 3) * 2 + (c >> 5)) * 512 + ((kk & 7) * 32 + (c & 31)) * 2; }
DEVI int v_rd_base(int lane) { return ((lane & 3) << 3) | (((lane >> 2) & 3) << 6) | (((lane >> 4) & 1) << 5) | (((lane >> 5) & 1) << 8); }
constexpr int v_rd_off(int d0, int ks, int half) { return d0 * 512 + ks * 2048 + half * 1024; }
template <int OFF> DEVI s16x4 tr_read(int vb) { s16x4 r; asm volatile("ds_read_b64_tr_b16 %0, %1 offset:%2" : "=&v"(r) : "v"(vb), "i"(OFF) : "memory"); return r; }

template <bool MASK>
DEVI void partialSM(f32x16& p0, f32x16& p1, float& m_reg, float& mn, float& alpha, float SCALE, int kpos0, int qpos, int hi) {
  const float C = SCALE * 1.4426950408889634f;
  if (MASK) {
#pragma unroll
    for (int r = 0; r < 16; ++r) { const int k0 = kpos0 + crow(r, hi) - qpos; const int k1 = k0 + 32;
      if (k0 > 128 || k0 < -128) p0[r] = -1e30f;
      if (k1 > 128 || k1 < -128) p1[r] = -1e30f; }
  }
  float pmax = p0[0];
#pragma unroll
  for (int r = 1; r < 16; ++r) pmax = fmaxf(pmax, p0[r]);
#pragma unroll
  for (int r = 0; r < 16; ++r) pmax = fmaxf(pmax, p1[r]);
  { auto rr = __builtin_amdgcn_permlane32_swap(__float_as_uint(pmax), __float_as_uint(pmax), false, false);
    pmax = fmaxf(__uint_as_float(rr[0]), __uint_as_float(rr[1])); }
  if (__builtin_expect(__all(pmax - m_reg <= ATT_THR / SCALE), 1)) { mn = m_reg; alpha = 1.f; }
  else { mn = fmaxf(m_reg, pmax); alpha = __builtin_amdgcn_exp2f((m_reg - mn) * C); m_reg = mn; }
  const float mnC = -mn * C;
#pragma unroll
  for (int r = 0; r < 16; ++r) p0[r] = fmaf(p0[r], C, mnC);
#pragma unroll
  for (int r = 0; r < 16; ++r) p1[r] = fmaf(p1[r], C, mnC);
#pragma unroll
  for (int r = 0; r < 16; ++r) p0[r] = __builtin_amdgcn_exp2f(p0[r]);
}
DEVI void finishSM(f32x16& p0, f32x16& p1, float alpha, float& l_reg, bf16x8& pa0, bf16x8& pa1, bf16x8& pa2, bf16x8& pa3) {
#pragma unroll
  for (int r = 0; r < 16; ++r) p1[r] = __builtin_amdgcn_exp2f(p1[r]);
  float ps = 0;
#pragma unroll
  for (int r = 0; r < 16; ++r) ps += p0[r];
#pragma unroll
  for (int r = 0; r < 16; ++r) ps += p1[r];
  { auto rr = __builtin_amdgcn_permlane32_swap(__float_as_uint(ps), __float_as_uint(ps), false, false);
    ps = __uint_as_float(rr[0]) + __uint_as_float(rr[1]); }
  l_reg = l_reg * alpha + ps;
#define PK4(P, BASE, OUT) do { unsigned a0 = cvtpk(P[BASE + 0], P[BASE + 1]), a1 = cvtpk(P[BASE + 2], P[BASE + 3]);   \
    unsigned b0 = cvtpk(P[BASE + 4], P[BASE + 5]), b1 = cvtpk(P[BASE + 6], P[BASE + 7]);                              \
    auto r0 = __builtin_amdgcn_permlane32_swap(a0, b0, false, false); auto r1 = __builtin_amdgcn_permlane32_swap(a1, b1, false, false); \
    u32x4 w = {r0[0], r1[0], r0[1], r1[1]}; OUT = __builtin_bit_cast(bf16x8, w); } while (0)
  PK4(p0, 0, pa0); PK4(p0, 8, pa1); PK4(p1, 0, pa2); PK4(p1, 8, pa3);
#undef PK4
}
template <int ND0>
DEVI void qkt(f32x16& p0, f32x16& p1, const char* Ks, const bf16x8* qr, int r32, int hi) {
  bf16x8 k0[ND0], k1[ND0];
#pragma unroll
  for (int d0 = 0; d0 < ND0; ++d0) { const int cb = (d0 * 16 + hi * 8) * 2;
    k0[d0] = *(const bf16x8*)(Ks + KSWZ(r32, cb)); k1[d0] = *(const bf16x8*)(Ks + KSWZ(32 + r32, cb)); }
  p0 = f32x16{}; p1 = f32x16{};
#pragma unroll
  for (int d0 = 0; d0 < ND0; ++d0) {
    p0 = __builtin_amdgcn_mfma_f32_32x32x16_bf16(k0[d0], qr[d0], p0, 0, 0, 0);
    p1 = __builtin_amdgcn_mfma_f32_32x32x16_bf16(k1[d0], qr[d0], p1, 0, 0, 0); }
}
template <int D0> DEVI void pv_one(f32x16& od, int vb, bf16x8 pa0, bf16x8 pa1, bf16x8 pa2, bf16x8 pa3) {
  const s16x4 l0 = tr_read<v_rd_off(D0, 0, 0)>(vb), h0 = tr_read<v_rd_off(D0, 0, 1)>(vb), l1 = tr_read<v_rd_off(D0, 1, 0)>(vb), h1 = tr_read<v_rd_off(D0, 1, 1)>(vb);
  const s16x4 l2 = tr_read<v_rd_off(D0, 2, 0)>(vb), h2 = tr_read<v_rd_off(D0, 2, 1)>(vb), l3 = tr_read<v_rd_off(D0, 3, 0)>(vb), h3 = tr_read<v_rd_off(D0, 3, 1)>(vb);
  asm volatile("s_waitcnt lgkmcnt(0)" ::: "memory"); SBAR();
#define PK(L, H) (bf16x8){L[0], L[1], L[2], L[3], H[0], H[1], H[2], H[3]}
  od = __builtin_amdgcn_mfma_f32_32x32x16_bf16(pa0, PK(l0, h0), od, 0, 0, 0);
  od = __builtin_amdgcn_mfma_f32_32x32x16_bf16(pa1, PK(l1, h1), od, 0, 0, 0);
  od = __builtin_amdgcn_mfma_f32_32x32x16_bf16(pa2, PK(l2, h2), od, 0, 0, 0);
  od = __builtin_amdgcn_mfma_f32_32x32x16_bf16(pa3, PK(l3, h3), od, 0, 0, 0);
#undef PK
}
DEVI void pv_d0(f32x16* o, int vb, bf16x8 pa0, bf16x8 pa1, bf16x8 pa2, bf16x8 pa3) {
  const s16x4 a0 = tr_read<v_rd_off(0, 0, 0)>(vb), b0 = tr_read<v_rd_off(0, 0, 1)>(vb), a1 = tr_read<v_rd_off(0, 1, 0)>(vb), b1 = tr_read<v_rd_off(0, 1, 1)>(vb);
  const s16x4 a2 = tr_read<v_rd_off(0, 2, 0)>(vb), b2 = tr_read<v_rd_off(0, 2, 1)>(vb), a3 = tr_read<v_rd_off(0, 3, 0)>(vb), b3 = tr_read<v_rd_off(0, 3, 1)>(vb);
  const s16x4 c0 = tr_read<v_rd_off(1, 0, 0)>(vb), d0 = tr_read<v_rd_off(1, 0, 1)>(vb), c1 = tr_read<v_rd_off(1, 1, 0)>(vb), d1 = tr_read<v_rd_off(1, 1, 1)>(vb);
  const s16x4 c2 = tr_read<v_rd_off(1, 2, 0)>(vb), d2 = tr_read<v_rd_off(1, 2, 1)>(vb), c3 = tr_read<v_rd_off(1, 3, 0)>(vb), d3 = tr_read<v_rd_off(1, 3, 1)>(vb);
  asm volatile("s_waitcnt lgkmcnt(0)" ::: "memory"); SBAR();
#define PK(L, H) (bf16x8){L[0], L[1], L[2], L[3], H[0], H[1], H[2], H[3]}
  o[0] = __builtin_amdgcn_mfma_f32_32x32x16_bf16(pa0, PK(a0, b0), o[0], 0, 0, 0);
  o[1] = __builtin_amdgcn_mfma_f32_32x32x16_bf16(pa0, PK(c0, d0), o[1], 0, 0, 0);
  o[0] = __builtin_amdgcn_mfma_f32_32x32x16_bf16(pa1, PK(a1, b1), o[0], 0, 0, 0);
  o[1] = __builtin_amdgcn_mfma_f32_32x32x16_bf16(pa1, PK(c1, d1), o[1], 0, 0, 0);
  o[0] = __builtin_amdgcn_mfma_f32_32x32x16_bf16(pa2, PK(a2, b2), o[0], 0, 0, 0);
  o[1] = __builtin_amdgcn_mfma_f32_32x32x16_bf16(pa2, PK(c2, d2), o[1], 0, 0, 0);
  o[0] = __builtin_amdgcn_mfma_f32_32x32x16_bf16(pa3, PK(a3, b3), o[0], 0, 0, 0);
  o[1] = __builtin_amdgcn_mfma_f32_32x32x16_bf16(pa3, PK(c3, d3), o[1], 0, 0, 0);
#undef PK
}

template <int DQK, bool MASK>
DEVI void attn_body(const u16* Qw, const u16* Kh, int ldk, const u16* Vh, int ldv, int kt0, int NT, float SCALE, float m_init, float l_init,
                    int qpos, u16* Ow, char* lds, float qrope_pos = 0.f) {
  constexpr int ND0 = DQK / 16, NCK = DQK / 8;
  const int tid = tidx(), wid = __builtin_amdgcn_readfirstlane(tid >> 6), lane = tid & 63, r32 = lane & 31, hi = lane >> 5;
  char* K_lds = lds; char* V_lds = lds + 2 * AT_SHM_K;
  float* wsx = (float*)(lds + 2 * AT_SHM_K + 3 * AT_SHM_V) + wid * 64; float* li_l = wsx; float* al_l = wsx + 32;
  float m_reg = m_init, l_reg = l_init; f32x16 o[2] = {f32x16{}, f32x16{}}; bf16x8 qr[ND0];
#pragma unroll
  for (int d0 = 0; d0 < ND0; ++d0) qr[d0] = *(const bf16x8*)(Qw + d0 * 16);
  if (DQK == 96) {
#pragma unroll
    for (int d0 = 4; d0 < ND0; ++d0) { float v[8]; unpk8(__builtin_bit_cast(u32x4, qr[d0]), v);
#pragma unroll
      for (int q = 0; q < 4; ++q) { const int f = 2 * ((((d0 - 4) * 16 + hi * 8) >> 1) + q); float sn, cs; rope_sc(qrope_pos, f, sn, cs);
        const float x1 = v[2 * q], x2 = v[2 * q + 1]; v[2 * q] = x1 * cs - x2 * sn; v[2 * q + 1] = x2 * cs + x1 * sn; }
      qr[d0] = __builtin_bit_cast(bf16x8, pk8(v)); } }
  unsigned koff[2], voff;
#pragma unroll
  for (int i = 0; i < 2; ++i) { const int row = 4 * (wid + 8 * i) + (lane >> 4), ch = (lane & 15) ^ (row & 15); koff[i] = (unsigned)(row * ldk * 2 + (ch < NCK ? ch : 0) * 16); }
  { const int off = wid * 1024 + lane * 16, sub = off >> 9, kk = ((sub >> 1) << 3) | ((off & 511) >> 6), c = ((sub & 1) << 5) | ((off & 63) >> 1);
    const int k = (kk & ~0xC) | ((kk & 4) << 1) | ((kk & 8) >> 1); voff = (unsigned)(k * ldv * 2 + c * 2); }
  typedef __attribute__((address_space(3))) unsigned lds_u32;
#define DMA(tt_) do { const char* kb_ = (const char*)Kh + (size_t)(kt0 + (tt_)) * 64 * ldk * 2; const char* vb_ = (const char*)Vh + (size_t)(kt0 + (tt_)) * 64 * ldv * 2; \
    char* kd_ = K_lds + ((tt_) & 1) * AT_SHM_K + wid * 1024; char* vd_ = V_lds + ((tt_) % 3) * AT_SHM_V + wid * 1024; \
    __builtin_amdgcn_global_load_lds((const unsigned*)(kb_ + koff[0]), (lds_u32*)kd_, 16, 0, 0); \
    __builtin_amdgcn_global_load_lds((const unsigned*)(kb_ + koff[1]), (lds_u32*)(kd_ + 8192), 16, 0, 0); \
    __builtin_amdgcn_global_load_lds((const unsigned*)(vb_ + voff), (lds_u32*)vd_, 16, 0, 0); } while (0)
#define LANDED() do { asm volatile("s_waitcnt vmcnt(0)" ::: "memory"); __syncthreads(); } while (0)
#define RESC(a) do { if (__any((a) < 1.f)) { if (hi == 0) al_l[r32] = (a); asm volatile("s_waitcnt lgkmcnt(0)" ::: "memory"); \
    _Pragma("unroll") for (int d = 0; d < 2; ++d) _Pragma("unroll") for (int r = 0; r < 16; ++r) o[d][r] *= al_l[crow(r, hi)]; } } while (0)
  const int vb0 = (int)(uintptr_t)V_lds + v_rd_base(lane);
  f32x16 pA0, pA1, pB0, pB1; float mnA, mnB, alA, alB; bf16x8 pa0, pa1, pa2, pa3;
  DMA(0); LANDED();
  DMA(1);
  qkt<ND0>(pA0, pA1, K_lds, qr, r32, hi); partialSM<MASK>(pA0, pA1, m_reg, mnA, alA, SCALE, kt0 * 64, qpos, hi);
  LANDED();
  int vprev = 0;
  for (int tt = 1; tt + 1 < NT; tt += 2) {
    const int v1 = vprev == 2 ? 0 : vprev + 1;
    DMA(tt + 1); SBAR();
    qkt<ND0>(pB0, pB1, K_lds + AT_SHM_K, qr, r32, hi);
    finishSM(pA0, pA1, alA, l_reg, pa0, pa1, pa2, pa3); SBAR();
    pv_d0(o, vb0 + vprev * AT_SHM_V, pa0, pa1, pa2, pa3); partialSM<MASK>(pB0, pB1, m_reg, mnB, alB, SCALE, (kt0 + tt) * 64, qpos, hi);
    RESC(alB); LANDED();
    if (tt + 2 < NT) DMA(tt + 2);
    SBAR();
    qkt<ND0>(pA0, pA1, K_lds, qr, r32, hi);
    finishSM(pB0, pB1, alB, l_reg, pa0, pa1, pa2, pa3); SBAR();
    pv_d0(o, vb0 + v1 * AT_SHM_V, pa0, pa1, pa2, pa3); partialSM<MASK>(pA0, pA1, m_reg, mnA, alA, SCALE, (kt0 + tt + 1) * 64, qpos, hi);
    RESC(alA); LANDED();
    vprev = v1 == 2 ? 0 : v1 + 1;
  }
  { const int v1 = vprev == 2 ? 0 : vprev + 1;
    SBAR(); qkt<ND0>(pB0, pB1, K_lds + AT_SHM_K, qr, r32, hi);
    finishSM(pA0, pA1, alA, l_reg, pa0, pa1, pa2, pa3); SBAR();
    pv_d0(o, vb0 + vprev * AT_SHM_V, pa0, pa1, pa2, pa3); partialSM<MASK>(pB0, pB1, m_reg, mnB, alB, SCALE, (kt0 + NT - 1) * 64, qpos, hi);
    RESC(alB);
    finishSM(pB0, pB1, alB, l_reg, pa0, pa1, pa2, pa3); SBAR();
    pv_d0(o, vb0 + v1 * AT_SHM_V, pa0, pa1, pa2, pa3); }
  if (hi == 0) li_l[r32] = l_reg; asm volatile("s_waitcnt lgkmcnt(0)" ::: "memory");
  float rli[16];
#pragma unroll
  for (int r = 0; r < 16; ++r) rli[r] = __builtin_amdgcn_rcpf(li_l[crow(r, hi)]);
#pragma unroll
  for (int r = 0; r < 16; ++r) { const int orow = crow(r, hi);
#pragma unroll
    for (int d0 = 0; d0 < 2; ++d0) Ow[(size_t)orow * DM + d0 * 32 + r32] = f2bf(o[d0][r] * rli[r]); }
  __syncthreads();
#undef DMA
#undef LANDED
#undef RESC
}

constexpr int LCH = 64, NLCH = SEQ / LCH;
constexpr size_t WS_LP = 1 * MiB, WS_LH = 2560 * 1024;
constexpr size_t WS_LC = 473 * MiB;
constexpr size_t WS_NEED = 475 * MiB;
DEVI void lru_passA(const Params& p, int item, int lane) {
  const int cg = item % 6, c = (item / 6) % NLCH, b = (item / (6 * NLCH)) % NB, d = item / (6 * NLCH * NB);
  const size_t base = (((size_t)(d * NB + b) * (SEQ / 8) + c * 8) * LRU_W + cg * 64 + lane) * 8;
  const u16* E = (const u16*)(p.ws + WS_LE) + base; const u16* Bp = (const u16*)(p.ws + WS_LB) + base;
  u32x4 ev[8], bv[8];
#pragma unroll
  for (int g = 0; g < 8; ++g) { ev[g] = *(const u32x4*)(E + (size_t)g * LRU_W * 8); bv[g] = *(const u32x4*)(Bp + (size_t)g * LRU_W * 8); }
  float h = 0.f, P = 1.f;
#pragma unroll
  for (int gg = 0; gg < 8; ++gg) { const int g = d ? 7 - gg : gg; float e[8], bb[8]; unpk8(ev[g], e); unpk8(bv[g], bb);
#pragma unroll
    for (int rr = 0; rr < 8; ++rr) { const int r = d ? 7 - rr : rr; const float a = 1.f - e[r]; h = fmaf(a, h, bb[r]); P *= a; } }
  const size_t o = ((size_t)(d * NB + b) * NLCH + c) * LRU_W + cg * 64 + lane;
  ((float*)(p.ws + WS_LP))[o] = P; ((float*)(p.ws + WS_LH))[o] = h;
}

DEVI void lru_final(const Params& p, int item, char* lds) {
  const int tid = tidx(), wid = tid >> 6, lane = tid & 63;
  const int c = item % NLCH, b = item / NLCH;
  float* obuf = (float*)lds;
  if (wid < 6) {
    const int ch = wid * 64 + lane;
#pragma unroll
    for (int d = 0; d < 2; ++d) {
      const size_t co = ((size_t)(d * NB + b) * NLCH + c) * LRU_W + ch;
      float h = ((const float*)(p.ws + WS_LC))[co];
      const size_t base = (((size_t)(d * NB + b) * (SEQ / 8) + c * 8) * LRU_W + ch) * 8;
      const u16* E = (const u16*)(p.ws + WS_LE) + base; const u16* Bp = (const u16*)(p.ws + WS_LB) + base;
      u32x4 ev[8], bv[8];
#pragma unroll
      for (int g = 0; g < 8; ++g) { ev[g] = *(const u32x4*)(E + (size_t)g * LRU_W * 8); bv[g] = *(const u32x4*)(Bp + (size_t)g * LRU_W * 8); }
      if (d == 0) {
#pragma unroll
        for (int g = 0; g < 8; ++g) { float e[8], bb[8]; unpk8(ev[g], e); unpk8(bv[g], bb);
#pragma unroll
          for (int r = 0; r < 8; ++r) { h = fmaf(1.f - e[r], h, bb[r]); obuf[(g * 8 + r) * LRU_W + ch] = h; } }
      } else {
        const u16* gp = (const u16*)(p.ws + WS_R1) + ((size_t)b * SEQ + c * LCH) * INWP + PC_LG + ch;
#pragma unroll
        for (int g = 7; g >= 0; --g) { float e[8], bb[8]; unpk8(ev[g], e); unpk8(bv[g], bb);
#pragma unroll
          for (int r = 7; r >= 0; --r) { h = fmaf(1.f - e[r], h, bb[r]); const int tk = g * 8 + r;
            const float gt = bf2f(gp[(size_t)tk * INWP]); obuf[tk * LRU_W + ch] = (obuf[tk * LRU_W + ch] + h) * gelu_erf(gt); } }
      }
    }
  }
  __syncthreads();
  u16* mp = (u16*)(p.ws + WS_MIX) + ((size_t)b * SEQ + c * LCH) * DM + 384;
#pragma unroll 1
  for (int i = 0; i < 8; ++i) { const int tk = wid * 8 + i;
    float v[6]; float s = 0.f;
#pragma unroll
    for (int q = 0; q < 3; ++q) { const f32x2 t2 = *(const f32x2*)(obuf + tk * LRU_W + q * 128 + lane * 2); v[2 * q] = t2.x; v[2 * q + 1] = t2.y; s = fmaf(t2.x, t2.x, s); s = fmaf(t2.y, t2.y, s); }
    s = wave_sum(s);
    const float rs = rsqrtf(s * (1.f / 384.f) + EPS);
#pragma unroll
    for (int q = 0; q < 3; ++q) *(unsigned*)(mp + (size_t)tk * DM + q * 128 + lane * 2) = pk2(v[2 * q] * rs, v[2 * q + 1] * rs);
  }
  __syncthreads();
}

DEVI void peer_cand(const Params& p, int layer, int vb, int nb, char* lds) {
  const int tid = tidx();
  unsigned char* my = (unsigned char*)lds + tid * 32;
  const float* top = (const float*)(p.ws + WS_TOP);
  float* egate = (float*)(p.ws + WS_EGATE);
  for (int it = vb * NTHREADS + tid; it < T * 8; it += nb * NTHREADS) {
    float v1[16], v2[16];
    const float* tp = top + (size_t)it * 32;
#pragma unroll
    for (int i = 0; i < 4; ++i) { const f32x4 a = *(const f32x4*)(tp + 4 * i), b = *(const f32x4*)(tp + 16 + 4 * i);
      v1[4 * i] = a.x; v1[4 * i + 1] = a.y; v1[4 * i + 2] = a.z; v1[4 * i + 3] = a.w; v2[4 * i] = b.x; v2[4 * i + 1] = b.y; v2[4 * i + 2] = b.z; v2[4 * i + 3] = b.w; }
#pragma unroll
    for (int i = 0; i < 16; ++i) { my[i] = (unsigned char)(127u - (__float_as_uint(v1[i]) & 127u)); my[16 + i] = (unsigned char)(127u - (__float_as_uint(v2[i]) & 127u)); }
    float l[16];
#pragma unroll
    for (int i = 0; i < 16; ++i) l[i] = -3.0e38f;
#pragma unroll
    for (int a = 0; a < 16; ++a)
#pragma unroll
      for (int b = 0; b < 16; ++b) if ((a + 1) * (b + 1) <= 16) {
        float v = __uint_as_float((__float_as_uint(v1[a] + v2[b]) & ~255u) | (unsigned)(255 - (a * 16 + b)));
#pragma unroll
        for (int i = 0; i < 16; ++i) { const float t = fmaxf(l[i], v); v = fminf(l[i], v); l[i] = t; } }
    const float mx = __uint_as_float(__float_as_uint(l[0]) & ~255u);
    float w[16], sum = 0.f;
#pragma unroll
    for (int i = 0; i < 16; ++i) { w[i] = __expf(__uint_as_float(__float_as_uint(l[i]) & ~255u) - mx); sum += w[i]; }
    const float inv = 1.f / sum;
    unsigned ev[16];
#pragma unroll
    for (int i = 0; i < 16; ++i) { const unsigned code = 255u - (__float_as_uint(l[i]) & 255u); ev[i] = (unsigned)my[code >> 4] * 128u + (unsigned)my[16 + (code & 15)]; w[i] *= inv; }
    u16* eo = (u16*)(p.ws + WS_EIDX) + (size_t)it * 16;
    *(u32x4*)(eo) = (u32x4){ev[0] | (ev[1] << 16), ev[2] | (ev[3] << 16), ev[4] | (ev[5] << 16), ev[6] | (ev[7] << 16)};
    *(u32x4*)(eo + 8) = (u32x4){ev[8] | (ev[9] << 16), ev[10] | (ev[11] << 16), ev[12] | (ev[13] << 16), ev[14] | (ev[15] << 16)};
#pragma unroll
    for (int i = 0; i < 4; ++i) *(f32x4*)(egate + (size_t)it * 16 + 4 * i) = (f32x4){w[4 * i], w[4 * i + 1], w[4 * i + 2], w[4 * i + 3]};
  }
  { const int wid = tid >> 6, lane = tid & 63; u16* xg = (u16*)(p.ws + WS_XG); const float* gf = p.norm_ffn + layer * DM;
    for (int t = vb * 8 + wid; t < T; t += nb * 8) {
      u32x4* rp = (u32x4*)(xg + (size_t)t * DM + lane * 16);
      float v[16]; unpk8(rp[0], v); unpk8(rp[1], v + 8);
      float s = 0.f;
#pragma unroll
      for (int i = 0; i < 16; ++i) s = fmaf(v[i], v[i], s);
      s = wave_sum(s);
      const float rs = rsqrtf(s * (1.f / DM) + EPS);
      float g[16]; ld8(gf + lane * 16, g); ld8(gf + lane * 16 + 8, g + 8);
#pragma unroll
      for (int i = 0; i < 16; ++i) v[i] *= rs * g[i];
      rp[0] = pk8(v); rp[1] = pk8(v + 8);
    } }
}

typedef unsigned char u8;
DEVI void cvt16(u32x4 w, float* f) {
  f32x2 t;
  t = __builtin_amdgcn_cvt_pk_f32_fp8((int)w.x, false); f[0] = t.x; f[1] = t.y; t = __builtin_amdgcn_cvt_pk_f32_fp8((int)w.x, true); f[2] = t.x; f[3] = t.y;
  t = __builtin_amdgcn_cvt_pk_f32_fp8((int)w.y, false); f[4] = t.x; f[5] = t.y; t = __builtin_amdgcn_cvt_pk_f32_fp8((int)w.y, true); f[6] = t.x; f[7] = t.y;
  t = __builtin_amdgcn_cvt_pk_f32_fp8((int)w.z, false); f[8] = t.x; f[9] = t.y; t = __builtin_amdgcn_cvt_pk_f32_fp8((int)w.z, true); f[10] = t.x; f[11] = t.y;
  t = __builtin_amdgcn_cvt_pk_f32_fp8((int)w.w, false); f[12] = t.x; f[13] = t.y; t = __builtin_amdgcn_cvt_pk_f32_fp8((int)w.w, true); f[14] = t.x; f[15] = t.y;
}
DEVI unsigned enc4(float a, float b, float c, float d) { int w = 0; w = __builtin_amdgcn_cvt_pk_fp8_f32(a, b, w, false); w = __builtin_amdgcn_cvt_pk_fp8_f32(c, d, w, true); return (unsigned)w; }
#define EIDX_AT(i0, i1, i) ((((i) < 8 ? (i0) : (i1))[((i) & 7) >> 1] >> (((i) & 1) * 16)) & 0xffffu)
template <int CTRL> DEVI float dppf(float v) { return __uint_as_float((unsigned)__builtin_amdgcn_mov_dpp((int)__float_as_uint(v), CTRL, 0xF, 0xF, true)); }
DEVI f32x2 fma2(f32x2 a, f32x2 b, f32x2 c) { return __builtin_elementwise_fma(a, b, c); }
DEVI f32x2 cvt8lo(unsigned w) { return __builtin_amdgcn_cvt_pk_f32_fp8((int)w, false); }
DEVI f32x2 cvt8hi(unsigned w) { return __builtin_amdgcn_cvt_pk_f32_fp8((int)w, true); }
struct PeerIdx { u32x4 i0, i1; };
template <bool AXPY>
DEVI void peer_slice_phase(const Params& p, int s, int tbeg, int tstep, int lane, const float* xin, float* xout, bool last) {
  const int r = lane >> 3, j = lane & 7;
  const u8* eidxB = (const u8*)(p.ws + WS_EIDX); const unsigned eoff = (unsigned)r * 32u;
  const u8* TBs = (const u8*)(p.ws + (AXPY ? WS_VB : WS_UB)) + (size_t)s * NEXP * 128; const unsigned toff = 16u * (unsigned)j;
  const u8* xnB = (const u8*)(p.ws + WS_XG) + s * 256; const unsigned xoff = 32u * (unsigned)j;
  const u8* ccB = (const u8*)(p.ws + WS_CC); const unsigned coff = (unsigned)r * 32u;
  float* pdB = (float*)(p.ws + WS_PD) + (size_t)s * T * 128;
  const int ntok = (T - tbeg + tstep - 1) / tstep;
  if (ntok <= 0) return;
#define TOK(k) (tbeg + ((k) < ntok ? (k) : ntok - 1) * tstep)
#define LD_IDX(dst, k) do { const u8* b_ = eidxB + (size_t)TOK(k) * 256; dst.i0 = *(const u32x4*)(b_ + eoff); dst.i1 = *(const u32x4*)(b_ + eoff + 16u); } while (0)
#define LD_HALF(H, ix, h) do { _Pragma("unroll") for (int i = 0; i < 8; ++i) H[i] = *(const u32x4*)(TBs + (EIDX_AT(ix.i0, ix.i1, 8 * (h) + i) * 128u + toff)); } while (0)
#define LD_AUX(a, k) do { if (AXPY) { const u8* b_ = ccB + (size_t)TOK(k) * 256; a[0] = *(const u32x4*)(b_ + coff); a[1] = *(const u32x4*)(b_ + coff + 16u); } \
    else { const u8* b_ = xnB + (size_t)TOK(k) * (DM * 2); a[0] = *(const u32x4*)(b_ + xoff); a[1] = *(const u32x4*)(b_ + xoff + 16u); } } while (0)
  PeerIdx I0, I1, I2; u32x4 H0[8], H1[8], H2[8], X0[2], X1[2], X2[2];
  float av[16];
  f32x2 acc[8];
#define T_BEGIN(X) do { unpk8(X[0], av); unpk8(X[1], av + 8); if (AXPY) { _Pragma("unroll") for (int q = 0; q < 8; ++q) acc[q] = (f32x2){0.f, 0.f}; } } while (0)
#define COMP(H, h, k) do { if ((k) < ntok) { \
    if (!AXPY) { float* o_ = pdB + (size_t)(tbeg + (k) * tstep) * 128 + r * 16 + 8 * (h); \
      _Pragma("unroll") for (int g = 0; g < 2; ++g) { float res[4]; \
        _Pragma("unroll") for (int ii = 0; ii < 4; ++ii) { const u32x4 w_ = H[4 * g + ii]; f32x2 a = {0.f, 0.f}; \
          a = fma2(cvt8lo(w_.x), (f32x2){av[0], av[1]}, a); a = fma2(cvt8hi(w_.x), (f32x2){av[2], av[3]}, a); a = fma2(cvt8lo(w_.y), (f32x2){av[4], av[5]}, a); a = fma2(cvt8hi(w_.y), (f32x2){av[6], av[7]}, a); \
          a = fma2(cvt8lo(w_.z), (f32x2){av[8], av[9]}, a); a = fma2(cvt8hi(w_.z), (f32x2){av[10], av[11]}, a); a = fma2(cvt8lo(w_.w), (f32x2){av[12], av[13]}, a); a = fma2(cvt8hi(w_.w), (f32x2){av[14], av[15]}, a); \
          float v = a.x + a.y; v += dppf<0xB1>(v); v += dppf<0x4E>(v); v += dppf<0x141>(v); res[ii] = v; } \
        if (j == 0) *(f32x4*)(o_ + 4 * g) = (f32x4){res[0], res[1], res[2], res[3]}; } } \
    else { _Pragma("unroll") for (int i = 0; i < 8; ++i) { const u32x4 w_ = H[i]; const float ci = av[8 * (h) + i]; const f32x2 c2 = {ci, ci}; \
        acc[0] = fma2(cvt8lo(w_.x), c2, acc[0]); acc[1] = fma2(cvt8hi(w_.x), c2, acc[1]); acc[2] = fma2(cvt8lo(w_.y), c2, acc[2]); acc[3] = fma2(cvt8hi(w_.y), c2, acc[3]); \
        acc[4] = fma2(cvt8lo(w_.z), c2, acc[4]); acc[5] = fma2(cvt8hi(w_.z), c2, acc[5]); acc[6] = fma2(cvt8lo(w_.w), c2, acc[6]); acc[7] = fma2(cvt8hi(w_.w), c2, acc[7]); } } } } while (0)
  auto finalize = [&](int k) {
    if (!AXPY || k >= ntok) return;
    const int t = tbeg + k * tstep;
    float S[8];
#pragma unroll
    for (int q = 0; q < 8; ++q) { const float A = acc[q >> 1][q & 1], B = acc[(q + 8) >> 1][q & 1];
      auto rr = __builtin_amdgcn_permlane32_swap(__float_as_uint(A), __float_as_uint(B), false, false); S[q] = __uint_as_float(rr[0]) + __uint_as_float(rr[1]); }
    float Tq[4];
#pragma unroll
    for (int q = 0; q < 4; ++q) { auto rr = __builtin_amdgcn_permlane16_swap(__float_as_uint(S[q]), __float_as_uint(S[q + 4]), false, false); Tq[q] = __uint_as_float(rr[0]) + __uint_as_float(rr[1]); }
#pragma unroll
    for (int q = 0; q < 4; ++q) Tq[q] += dppf<0x128>(Tq[q]);
    float ss = 0.f;
    if ((lane & 8) == 0) {
      const size_t o = (size_t)t * DM + s * 128 + 16 * j + ((lane >> 5) & 1) * 8 + ((lane >> 4) & 1) * 4;
      const f32x4 x = *(const f32x4*)(xin + o);
      const f32x4 y = {x.x + Tq[0], x.y + Tq[1], x.z + Tq[2], x.w + Tq[3]};
      *(f32x4*)(xout + o) = y;
      if (!last) *(u32x2*)((u16*)(p.ws + WS_XG) + o) = (u32x2){pk2(y.x, y.y), pk2(y.z, y.w)};
      ss = (y.x * y.x + y.y * y.y) + (y.z * y.z + y.w * y.w);
    }
    ss = wave_sum(ss); if (lane == 0) ((float*)(p.ws + WS_SSQ))[(size_t)t * 8 + s] = ss;
  };
  LD_IDX(I0, 0); LD_IDX(I1, 1); LD_IDX(I2, 2); LD_HALF(H0, I0, 0); LD_HALF(H1, I0, 1); LD_AUX(X0, 0);
#pragma unroll 2
  for (int k = 0; k < ntok; k += 3) {
    LD_HALF(H2, I1, 0); LD_IDX(I0, k + 3); LD_AUX(X1, k + 1);
    T_BEGIN(X0); COMP(H0, 0, k);
    LD_HALF(H0, I1, 1);
    COMP(H1, 1, k); finalize(k);
    LD_HALF(H1, I2, 0); LD_IDX(I1, k + 4); LD_AUX(X2, k + 2);
    T_BEGIN(X1); COMP(H2, 0, k + 1);
    LD_HALF(H2, I2, 1);
    COMP(H0, 1, k + 1); finalize(k + 1);
    LD_HALF(H0, I0, 0); LD_IDX(I2, k + 5); LD_AUX(X0, k + 3);
    T_BEGIN(X2); COMP(H1, 0, k + 2);
    LD_HALF(H1, I0, 1);
    COMP(H2, 1, k + 2); finalize(k + 2);
  }
#undef TOK
#undef LD_IDX
#undef LD_HALF
#undef LD_AUX
#undef T_BEGIN
#undef COMP
}

DEVI void lru_passB(const Params& p, int item, int lane) {
  const int cg = item % 6, b = (item / 6) % NB, d = item / (6 * NB);
  const size_t o = (size_t)(d * NB + b) * NLCH * LRU_W + cg * 64 + lane;
  const float* Pp = (const float*)(p.ws + WS_LP) + o; const float* Hp = (const float*)(p.ws + WS_LH) + o; float* Cp = (float*)(p.ws + WS_LC) + o;
  float h = 0.f;
#pragma unroll 1
  for (int c0 = 0; c0 < NLCH; c0 += 32) {
    float pv[32], hv[32];
#pragma unroll
    for (int i = 0; i < 32; ++i) { const int cc = d ? NLCH - 1 - (c0 + i) : c0 + i; pv[i] = Pp[(size_t)cc * LRU_W]; hv[i] = Hp[(size_t)cc * LRU_W]; }
#pragma unroll
    for (int i = 0; i < 32; ++i) { const int cc = d ? NLCH - 1 - (c0 + i) : c0 + i; Cp[(size_t)cc * LRU_W] = h; h = fmaf(pv[i], h, hv[i]); }
  }
}

DEVI void swa_item(const Params& p, int layer, int item, char* lds) {
  const int tid = tidx(), wid = tid >> 6, lane = tid & 63, r32 = lane & 31, hi = lane >> 5;
  const int g = item & 1, n = (item >> 1) & 63, b = item >> 7;
  const int hq = 2 * g + (wid >> 2), qrow = n * 128 + (wid & 3) * 32;
  const u16* proj = (const u16*)(p.ws + WS_R1);
  const u16* Qw = proj + (size_t)(b * SEQ + qrow + r32) * INWP + PC_SQ + hq * 64 + hi * 8;
  const u16* Kh = proj + (size_t)(b * SEQ) * INWP + PC_SK + g * 64;
  const u16* Vh = proj + (size_t)(b * SEQ) * INWP + PC_SV + g * 64;
  const int kt0 = (2 * n - 2) < 0 ? 0 : (2 * n - 2), kt1 = (2 * n + 4) > SEQ / 64 ? SEQ / 64 : (2 * n + 4);
  const float sink = p.swa_sink[layer * 4 + hq];
  u16* Ow = (u16*)(p.ws + WS_MIX) + (size_t)(b * SEQ + qrow) * DM + 768 + hq * 64;
  attn_body<64, true>(Qw, Kh, INWP, Vh, INWP, kt0, kt1 - kt0, 0.125f, sink * 8.f, 1.f, qrow + r32, Ow, lds);
}
DEVI void mla_item(const Params& p, int pair, int qb, char* lds) {
  const int tid = tidx(), wid = tid >> 6, lane = tid & 63, r32 = lane & 31, hi = lane >> 5;
  const int b = pair / MLA_H, h = pair - b * MLA_H;
  const u16* Qw = (const u16*)(p.ws + WS_QM) + ((size_t)pair * SEQ + qb * 256 + wid * 32 + r32) * MLA_QK + hi * 8;
  const u16* Kh = (const u16*)(p.ws + WS_KM) + (size_t)pair * SEQ * MLA_QK;
  const u16* Vh = (const u16*)(p.ws + WS_VM) + (size_t)pair * SEQ * MLA_V;
  u16* Ow = (u16*)(p.ws + WS_MIX) + (size_t)(b * SEQ + qb * 256 + wid * 32) * DM + h * 64;
  attn_body<96, false>(Qw, Kh, MLA_QK, Vh, MLA_V, 0, SEQ / 64, 0.10206207261596575f, -1e30f, 0.f, 0, Ow, lds, (float)p.pos[b * SEQ + qb * 256 + wid * 32 + r32]);
}


namespace pg8 {
#define PG8_LAS __attribute__((address_space(3)))
constexpr int BM = 256, BK = 64, HALF = 128, HTB = HALF * BK * 2, NXCD = 8, WGM = 8;
DEVI int lds_byte(int r, int c) { const int st = (r >> 4) * 2 + (c >> 5), rr = r & 15, cc = c & 31, ob = rr * 64 + cc * 2; return st * 1024 + (ob ^ (((ob >> 9) & 1) << 5)); }
DEVI void stage_rc(int b, int& R, int& C) { const int st = b / 1024, sb = b % 1024, swz = sb ^ (((sb >> 9) & 1) << 5); R = (st >> 1) * 16 + swz / 64; C = (st & 1) * 32 + (swz % 64) / 2; }
DEVI int perm32(int rho) { const int n = rho >> 4, i = rho & 15; return 8 * (i >> 2) + 4 * n + (i & 3); }
struct Unit { int pm, pn; };
struct Gemm { const u16* A; const u16* Bt; int M, N, K, lda, ldb; };
struct StaticOrder {
  int nM, nN, nwg, G, c;
  DEVI void init(int M, int N, int G_, int c_) { nM = M / BM; nN = N / BM; nwg = nM * nN; G = G_; c = c_; }
  DEVI bool next(int i, Unit& u) const {
    const long L = (long)i * G + c; if (L >= nwg) return false;
    int wgid = (int)L; { const int q = nwg / NXCD, r = nwg % NXCD, xcd = wgid % NXCD, off = wgid / NXCD; wgid = (xcd < r ? xcd * (q + 1) : r * (q + 1) + (xcd - r) * q) + off; }
    const int nig = WGM * nN, gid = wgid / nig, fm = gid * WGM, gsz = (nM - fm) < WGM ? (nM - fm) : WGM;
    u.pm = fm + ((wgid % nig) % gsz); u.pn = (wgid % nig) / gsz; return true;
  }
};
template <class Epi>
DEVI void gemm_phase(PG8_LAS unsigned char* lds, const Gemm g, const StaticOrder& S, const Epi& E) {
  const int tid = tidx(), wid = __builtin_amdgcn_readfirstlane(tid >> 6), lane = tid & 63, wr = wid >> 2, wc = wid & 3, fr = lane & 15, fq = lane >> 4;
  const int K = g.K; int nt = K / BK; asm volatile("" : "+s"(nt));
  unsigned voffA[2], voffB[2];
#pragma unroll
  for (int i = 0; i < 2; ++i) { int R, C; stage_rc(tid * 16 + i * 8192, R, C); const int Rb = (R & ~31) + perm32(R & 31);
    voffA[i] = (unsigned)(R * g.lda + C) * 2u; voffB[i] = (unsigned)(Rb * g.ldb + C) * 2u; }
  const size_t kstep = (size_t)(BK * 2), hstepA = (size_t)HALF * g.lda * 2, hstepB = (size_t)HALF * g.ldb * 2, tstepA = 2 * hstepA, tstepB = 2 * hstepB;
  const unsigned ldsw = (unsigned)wid * 1024u;
  const int aoff = lds_byte(wr * 64 + fr, fq * 8), boff = lds_byte(wc * 32 + fr, fq * 8);
#define PG8_SA(b, h) (((b) * 2 + (h)) * HTB)
#define PG8_SB(b, h) ((4 + (b) * 2 + (h)) * HTB)
#define PG8_STAGE(bufoff, gbase, voff) do { _Pragma("unroll") for (int _i = 0; _i < 2; ++_i) \
    __builtin_amdgcn_global_load_lds((const unsigned*)((const char*)(gbase) + (voff)[_i]), (PG8_LAS unsigned*)(lds + (bufoff) + ldsw + _i * 8192), 16, 0, 0); } while (0)
#define PG8_LDA(dst, b, h) do { _Pragma("unroll") for (int m = 0; m < 4; ++m) _Pragma("unroll") for (int k = 0; k < 2; ++k) dst[m][k] = *(const PG8_LAS bf16x8*)(lds + PG8_SA(b, h) + aoff + m * 2048 + k * 1024); } while (0)
#define PG8_LDB(dst, b, h) do { _Pragma("unroll") for (int n = 0; n < 2; ++n) _Pragma("unroll") for (int k = 0; k < 2; ++k) dst[n][k] = *(const PG8_LAS bf16x8*)(lds + PG8_SB(b, h) + boff + n * 2048 + k * 1024); } while (0)
#define PG8_MMA(ai, bj, At, Bt) do { __builtin_amdgcn_s_setprio(1); _Pragma("unroll") for (int m = 0; m < 4; ++m) _Pragma("unroll") for (int n = 0; n < 2; ++n) _Pragma("unroll") for (int k = 0; k < 2; ++k) \
    acc[ai][bj][m][n] = __builtin_amdgcn_mfma_f32_16x16x32_bf16(Bt[n][k], At[m][k], acc[ai][bj][m][n], 0, 0, 0); __builtin_amdgcn_s_setprio(0); } while (0)
#define PG8_WAIT_V(n) asm volatile("s_waitcnt vmcnt(" #n ")" ::: "memory")
#define PG8_WAIT_L(n) asm volatile("s_waitcnt lgkmcnt(" #n ")" ::: "memory")
#define PG8_BAR __builtin_amdgcn_s_barrier()
#define PG8_SCHED __builtin_amdgcn_sched_barrier(0)
  Unit cur, nxt; int ui = 0;
  if (!S.next(0, cur)) return;
  f32x4 acc[2][2][4][2];
#pragma unroll
  for (int a = 0; a < 2; ++a)
#pragma unroll
    for (int b = 0; b < 2; ++b)
#pragma unroll
      for (int m = 0; m < 4; ++m)
#pragma unroll
        for (int n = 0; n < 2; ++n) acc[a][b][m][n] = (f32x4){0.f, 0.f, 0.f, 0.f};
  bf16x8 At[4][2], B0[2][2], B1[2][2];
  const char* cA = (const char*)g.A + (size_t)cur.pm * tstepA; const char* cB = (const char*)g.Bt + (size_t)cur.pn * tstepB;
  PG8_STAGE(PG8_SB(0, 0), cB, voffB); PG8_STAGE(PG8_SB(0, 1), cB + hstepB, voffB); PG8_STAGE(PG8_SA(0, 0), cA, voffA); PG8_STAGE(PG8_SA(0, 1), cA + hstepA, voffA);
  if (wr == 1) PG8_BAR;
  PG8_WAIT_V(2); PG8_BAR;
  PG8_STAGE(PG8_SB(1, 0), cB + kstep, voffB); PG8_STAGE(PG8_SA(1, 0), cA + kstep, voffA); PG8_STAGE(PG8_SB(1, 1), cB + hstepB + kstep, voffB);
  PG8_WAIT_V(6); PG8_BAR;
  for (;;) {
    const bool has_next = S.next(ui + 1, nxt);
    const char* nA = has_next ? (const char*)g.A + (size_t)nxt.pm * tstepA : cA; const char* nB = has_next ? (const char*)g.Bt + (size_t)nxt.pn * tstepB : cB;
#pragma unroll 1
    for (int t = 0; t < nt; t += 2) {
      const bool last = (t == nt - 2);
      const char* a1 = cA + (size_t)(t + 1) * kstep;
      const char* a2 = last ? nA : cA + (size_t)(t + 2) * kstep; const char* b2 = last ? nB : cB + (size_t)(t + 2) * kstep;
      const char* a3 = a2 + kstep; const char* b3 = b2 + kstep;
      PG8_LDB(B0, 0, 0); PG8_LDB(B1, 0, 1); PG8_SCHED; PG8_LDA(At, 0, 0); PG8_STAGE(PG8_SA(1, 1), a1 + hstepA, voffA);
      PG8_WAIT_V(8); PG8_WAIT_L(0); PG8_BAR; PG8_MMA(0, 0, At, B0); PG8_MMA(0, 1, At, B1); PG8_BAR; PG8_SCHED;
      PG8_LDA(At, 0, 1); PG8_STAGE(PG8_SB(0, 0), b2, voffB); PG8_STAGE(PG8_SB(0, 1), b2 + hstepB, voffB); PG8_STAGE(PG8_SA(0, 0), a2, voffA);
      PG8_WAIT_V(8); PG8_WAIT_L(0); PG8_BAR; PG8_MMA(1, 0, At, B0); PG8_MMA(1, 1, At, B1); PG8_BAR; PG8_SCHED;
      PG8_LDB(B0, 1, 0); PG8_LDB(B1, 1, 1); PG8_SCHED; PG8_LDA(At, 1, 0); PG8_STAGE(PG8_SA(0, 1), a2 + hstepA, voffA);
      PG8_WAIT_V(8); PG8_WAIT_L(0); PG8_BAR; PG8_MMA(0, 0, At, B0); PG8_MMA(0, 1, At, B1); PG8_BAR; PG8_SCHED;
      PG8_LDA(At, 1, 1); PG8_STAGE(PG8_SB(1, 0), b3, voffB); PG8_STAGE(PG8_SB(1, 1), b3 + hstepB, voffB); PG8_STAGE(PG8_SA(1, 0), a3, voffA);
      PG8_WAIT_V(8); PG8_WAIT_L(0); PG8_BAR; PG8_MMA(1, 0, At, B0); PG8_MMA(1, 1, At, B1); PG8_BAR; PG8_SCHED;
    }
    if (wr == 0) PG8_BAR;
    E(acc, cur, wr, wc, fr, fq);
    if (!has_next) break;
#pragma unroll
    for (int a = 0; a < 2; ++a)
#pragma unroll
      for (int b = 0; b < 2; ++b)
#pragma unroll
        for (int m = 0; m < 4; ++m)
#pragma unroll
          for (int n = 0; n < 2; ++n) acc[a][b][m][n] = (f32x4){0.f, 0.f, 0.f, 0.f};
    cur = nxt; cA = nA; cB = nB; ++ui;
    if (wr == 1) PG8_BAR;
  }
  PG8_WAIT_V(0);
  PG8_BAR;
#undef PG8_SA
#undef PG8_SB
#undef PG8_STAGE
#undef PG8_LDA
#undef PG8_LDB
#undef PG8_MMA
#undef PG8_WAIT_V
#undef PG8_WAIT_L
#undef PG8_BAR
#undef PG8_SCHED
}

DEVI float rs_from8(const float* s) { const f32x4 a = *(const f32x4*)s, b = *(const f32x4*)(s + 4); return rsqrtf((((a.x + a.y) + (a.z + a.w)) + ((b.x + b.y) + (b.z + b.w))) * (1.f / DM) + EPS); }
struct EpiProj { u16* proj; const int* pos; const float* ssq8; float* ssqq; float* ssqkv;
  DEVI void operator()(const f32x4 (&acc)[2][2][4][2], const Unit& u, int wr, int wc, int fr, int fq) const {
    const int row0 = u.pm * BM + wr * 64 + fr, col0 = u.pn * BM + wc * 32 + 8 * fq;
#pragma unroll
    for (int ai = 0; ai < 2; ++ai)
#pragma unroll
      for (int m = 0; m < 4; ++m) { const int row = row0 + ai * HALF + m * 16; const float rs = rs_from8(ssq8 + (size_t)row * 8); const float posf = (float)pos[row];
        float sq0 = 0.f, sq1 = 0.f;
#pragma unroll
        for (int bj = 0; bj < 2; ++bj) { const int gcol = col0 + bj * HALF;
          float v[8]; { const f32x4 a = acc[ai][bj][m][0] * rs, b = acc[ai][bj][m][1] * rs; v[0] = a.x; v[1] = a.y; v[2] = a.z; v[3] = a.w; v[4] = b.x; v[5] = b.y; v[6] = b.z; v[7] = b.w; }
          if (u.pn <= 1) { float s = 0.f;
#pragma unroll
            for (int q = 0; q < 8; ++q) s = fmaf(v[q], v[q], s);
            if (bj == 0) sq0 = s; else sq1 = s; }
          const bool r64 = gcol >= PC_SQ && gcol < PC_SV, r32g = gcol >= PC_KR && gcol < PC_KR + 32;
          if (r64 || r32g) {
#pragma unroll
            for (int q = 0; q < 4; ++q) { const int f = r64 ? (((gcol + 2 * q) & 63) >> 1) : 2 * (((gcol + 2 * q) & 31) >> 1); float sn, cs; rope_sc(posf, f, sn, cs);
              const float x1 = v[2 * q], x2 = v[2 * q + 1]; v[2 * q] = x1 * cs - x2 * sn; v[2 * q + 1] = x2 * cs + x1 * sn; } }
          *(u32x4*)(proj + (size_t)row * INWP + gcol) = pk8(v); }
        if (u.pn <= 1) { float s = u.pn == 0 ? sq0 + sq1 : sq0; s += __shfl_xor(s, 16); s += __shfl_xor(s, 32);
          if (fq == 0) (u.pn == 0 ? ssqq : ssqkv)[(size_t)row * 4 + wc] = s; } }
  }
};
struct EpiQ2 { u16* qm; const float* ssqq;
  DEVI void operator()(const f32x4 (&acc)[2][2][4][2], const Unit& u, int wr, int wc, int fr, int fq) const {
    const int b = (u.pm * BM) >> 13, s0 = (u.pm * BM) & (SEQ - 1), lrow = wr * 64 + fr;
    const float* sq = ssqq + (size_t)(u.pm * BM) * 4 + lrow * 4;
    float rs[2][4];
#pragma unroll
    for (int ai = 0; ai < 2; ++ai)
#pragma unroll
      for (int m = 0; m < 4; ++m) { const f32x4 sp = *(const f32x4*)(sq + (ai * HALF + m * 16) * 4); rs[ai][m] = rsqrtf(((sp.x + sp.y) + (sp.z + sp.w)) * (1.f / 256.f) + EPS); }
#pragma unroll
    for (int bj = 0; bj < 2; ++bj) { const int gcol = u.pn * BM + bj * HALF + wc * 32 + 8 * fq;
      if (gcol < 576) { const int head = (gcol * 683) >> 16, j0 = gcol - head * 96;
        u16* base = qm + ((size_t)(b * MLA_H + head) * SEQ + s0) * MLA_QK + (unsigned)(lrow * MLA_QK + j0);
#pragma unroll
        for (int ai = 0; ai < 2; ++ai)
#pragma unroll
          for (int m = 0; m < 4; ++m) { const float r = rs[ai][m];
            float v[8]; { const f32x4 a = acc[ai][bj][m][0] * r, bb = acc[ai][bj][m][1] * r; v[0] = a.x; v[1] = a.y; v[2] = a.z; v[3] = a.w; v[4] = bb.x; v[5] = bb.y; v[6] = bb.z; v[7] = bb.w; }
            *(u32x4*)(base + (ai * HALF + m * 16) * MLA_QK) = pk8(v); } } }
  }
};
struct EpiKV2 { u16* km; u16* vm; const float* ssqkv;
  DEVI void operator()(const f32x4 (&acc)[2][2][4][2], const Unit& u, int wr, int wc, int fr, int fq) const {
    const int b = (u.pm * BM) >> 13, s0 = (u.pm * BM) & (SEQ - 1), lrow = wr * 64 + fr;
    const float* sq = ssqkv + (size_t)(u.pm * BM) * 4 + lrow * 4;
    float rs[2][4];
#pragma unroll
    for (int ai = 0; ai < 2; ++ai)
#pragma unroll
      for (int m = 0; m < 4; ++m) { const f32x4 sp = *(const f32x4*)(sq + (ai * HALF + m * 16) * 4); rs[ai][m] = rsqrtf(((sp.x + sp.y) + (sp.z + sp.w)) * (1.f / 128.f) + EPS); }
#pragma unroll
    for (int bj = 0; bj < 2; ++bj) { const int head = u.pn * 2 + bj, c = wc * 32 + 8 * fq;
      const size_t tok0 = (size_t)(b * MLA_H + head) * SEQ + s0;
      u16* base = c < 64 ? km + tok0 * MLA_QK + (unsigned)(lrow * MLA_QK + c) : vm + tok0 * MLA_V + (unsigned)(lrow * MLA_V + (c - 64));
      const int ld = c < 64 ? MLA_QK : MLA_V;
#pragma unroll
      for (int ai = 0; ai < 2; ++ai)
#pragma unroll
        for (int m = 0; m < 4; ++m) { const float r = rs[ai][m];
          float v[8]; { const f32x4 a = acc[ai][bj][m][0] * r, bb = acc[ai][bj][m][1] * r; v[0] = a.x; v[1] = a.y; v[2] = a.z; v[3] = a.w; v[4] = bb.x; v[5] = bb.y; v[6] = bb.z; v[7] = bb.w; }
          *(u32x4*)(base + (ai * HALF + m * 16) * ld) = pk8(v); } }
  }
};
struct EpiPQ { u16* O; const float* ssq16;
  DEVI void operator()(const f32x4 (&acc)[2][2][4][2], const Unit& u, int wr, int wc, int fr, int fq) const {
    const int row0 = u.pm * BM + wr * 64 + fr, col0 = u.pn * BM + wc * 32 + 8 * fq;
#pragma unroll
    for (int ai = 0; ai < 2; ++ai)
#pragma unroll
      for (int m = 0; m < 4; ++m) { const int row = row0 + ai * HALF + m * 16;
        const f32x4* sp = (const f32x4*)(ssq16 + (size_t)row * 16); const f32x4 s4 = (sp[0] + sp[1]) + (sp[2] + sp[3]);
        const float rs = rsqrtf(((s4.x + s4.y) + (s4.z + s4.w)) * (1.f / DM) + EPS);
#pragma unroll
        for (int bj = 0; bj < 2; ++bj) { float v[8]; { const f32x4 a = acc[ai][bj][m][0] * rs, b = acc[ai][bj][m][1] * rs; v[0] = a.x; v[1] = a.y; v[2] = a.z; v[3] = a.w; v[4] = b.x; v[5] = b.y; v[6] = b.z; v[7] = b.w; }
          *(u32x4*)(O + (size_t)row * 2048 + col0 + bj * HALF) = pk8(v); } }
  }
};
struct EpiRes { const float* xres; float* xout; u16* xg; float* ssq16;
  DEVI void operator()(const f32x4 (&acc)[2][2][4][2], const Unit& u, int wr, int wc, int fr, int fq) const {
    const int row0 = u.pm * BM + wr * 64 + fr, col0 = u.pn * BM + wc * 32 + 8 * fq;
#pragma unroll
    for (int ai = 0; ai < 2; ++ai)
#pragma unroll
      for (int m = 0; m < 4; ++m) { const int row = row0 + ai * HALF + m * 16; float ss = 0.f;
#pragma unroll
        for (int bj = 0; bj < 2; ++bj) { const size_t o = (size_t)row * DM + col0 + bj * HALF;
          float x[8]; ld8(xres + o, x);
          const f32x4 a = acc[ai][bj][m][0], b = acc[ai][bj][m][1];
          x[0] += a.x; x[1] += a.y; x[2] += a.z; x[3] += a.w; x[4] += b.x; x[5] += b.y; x[6] += b.z; x[7] += b.w;
#pragma unroll
          for (int q = 0; q < 8; ++q) ss = fmaf(x[q], x[q], ss);
          *(f32x4*)(xout + o) = (f32x4){x[0], x[1], x[2], x[3]}; *(f32x4*)(xout + o + 4) = (f32x4){x[4], x[5], x[6], x[7]};
          *(u32x4*)(xg + o) = pk8(x); }
        ss += __shfl_xor(ss, 16); ss += __shfl_xor(ss, 32);
        if (fq == 0) ssq16[(size_t)row * 16 + u.pn * 4 + wc] = ss; }
  }
};
}


DEVI void lru_gate_item(const Params& p, int l, int mt, int n, char* lds) {
  const int tid = tidx(), lane = tid & 63, wid = tid >> 6, wm = wid >> 1, wn = wid & 1, r32 = lane & 31, hi = lane >> 5;
  const int srow = tid >> 3, sc = tid & 7, m0 = mt * 256;
  const u16* PROJ = (const u16*)(p.ws + WS_R1);
  GemmDesc g{}; g.proj = PROJ; g.cw = p.conv_w + l * 4 * LRU_W; g.cb = p.conv_b + l * LRU_W; g.ch0 = n * 64;
  char* Ab = lds; char* Bb = lds + 32768;
  { bf16x8 ar[4], br[4];
#pragma unroll
    for (int i = 0; i < 4; ++i) ar[i] = load_a<1>(g, m0 + srow + 64 * i, sc * 8);
    const u16* W = (const u16*)(p.ws + WS_WLRU) + (size_t)((l * 6 + n) * 2) * 128 * 64;
#pragma unroll
    for (int i = 0; i < 4; ++i) br[i] = *(const bf16x8*)(W + (size_t)(srow + 64 * i) * 64 + sc * 8);
#pragma unroll
    for (int i = 0; i < 4; ++i) { *(bf16x8*)(Ab + swz(srow + 64 * i, sc)) = ar[i]; *(bf16x8*)(Bb + (i >> 1) * 16384 + swz(srow + 64 * (i & 1), sc)) = br[i]; } }
  __syncthreads();
  bf16x8 a[2][4];
#pragma unroll
  for (int t = 0; t < 2; ++t)
#pragma unroll
    for (int k = 0; k < 4; ++k) a[t][k] = *(const bf16x8*)(Ab + swz(wm * 64 + t * 32 + r32, k * 2 + hi));
  const int jl = 32 * wn + r32, ch = n * 64 + jl;
  float xf[2][16];
#pragma unroll
  for (int t = 0; t < 2; ++t)
#pragma unroll
    for (int r = 0; r < 16; ++r) { const int row = wm * 64 + t * 32 + crow(r, hi); xf[t][r] = bf2f(*(const u16*)(Ab + swz(row, jl >> 3) + (jl & 7) * 2)); }
  const int bidx = m0 >> 13, s0 = (m0 & (SEQ - 1)) + wm * 64;
#pragma unroll
  for (int d = 0; d < 2; ++d) {
    f32x16 acc[2][2] = {{f32x16{}, f32x16{}}, {f32x16{}, f32x16{}}};
#pragma unroll
    for (int k = 0; k < 4; ++k) { bf16x8 b[2];
#pragma unroll
      for (int q = 0; q < 2; ++q) b[q] = *(const bf16x8*)(Bb + d * 16384 + swz(wn * 64 + q * 32 + r32, k * 2 + hi));
#pragma unroll
      for (int t = 0; t < 2; ++t)
#pragma unroll
        for (int q = 0; q < 2; ++q) acc[t][q] = __builtin_amdgcn_mfma_f32_32x32x16_bf16(a[t][k], b[q], acc[t][q], 0, 0, 0); }
    const float bav = p.lru_ba[((l * 2 + d) * 6 + n) * 64 + jl], bxv = p.lru_bx[((l * 2 + d) * 6 + n) * 64 + jl];
    const float cdec = -8.f * log1pf(__expf(-p.lru_lambda[(l * 2 + d) * LRU_W + ch]));
    u16* le = (u16*)(p.ws + WS_LE); u16* lb = (u16*)(p.ws + WS_LB);
    float runP[2][4], runH[2][4];
#pragma unroll
    for (int t = 0; t < 2; ++t)
#pragma unroll
      for (int rr = 0; rr < 4; ++rr) {
        float ev[4], bv[4];
#pragma unroll
        for (int q = 0; q < 4; ++q) { const int r = rr * 4 + q;
          const float rg = sigmoidf_(acc[t][0][r] + bav), ig = sigmoidf_(acc[t][1][r] + bxv);
          const float aa = __expf(cdec * rg), e = 1.f - aa; ev[q] = e; bv[q] = sqrtf(e * (2.f - e)) * ig * xf[t][r]; }
        const size_t o = (((size_t)(d * NB + bidx) * (SEQ / 8) + ((s0 + 32 * t + 8 * rr) >> 3)) * LRU_W + ch) * 8 + 4 * hi;
        const u32x2 ew = {pk2(ev[0], ev[1]), pk2(ev[2], ev[3])}, bw = {pk2(bv[0], bv[1]), pk2(bv[2], bv[3])};
        *(u32x2*)(le + o) = ew; *(u32x2*)(lb + o) = bw;
        const float a0 = 1.f - bflo(ew.x), a1 = 1.f - bfhi(ew.x), a2 = 1.f - bflo(ew.y), a3 = 1.f - bfhi(ew.y);
        const float b0 = bflo(bw.x), b1 = bfhi(bw.x), b2 = bflo(bw.y), b3 = bfhi(bw.y);
        if (d == 0) { runP[t][rr] = (a0 * a1) * (a2 * a3); runH[t][rr] = fmaf(a3, fmaf(a2, fmaf(a1, b0, b1), b2), b3); }
        else { runP[t][rr] = (a0 * a1) * (a2 * a3); runH[t][rr] = fmaf(a0, fmaf(a1, fmaf(a2, b3, b2), b1), b0); } }
    { float Pc = 1.f, Hc = 0.f;
#pragma unroll
      for (int i = 0; i < 8; ++i) { const int ii = d == 0 ? i : 7 - i, t = ii >> 2, rr = ii & 3;
        auto rp = __builtin_amdgcn_permlane32_swap(__float_as_uint(runP[t][rr]), __float_as_uint(runP[t][rr]), false, false);
        auto rh = __builtin_amdgcn_permlane32_swap(__float_as_uint(runH[t][rr]), __float_as_uint(runH[t][rr]), false, false);
        const float P0 = __uint_as_float(rp[0]), P1 = __uint_as_float(rp[1]), H0 = __uint_as_float(rh[0]), H1 = __uint_as_float(rh[1]);
        if (d == 0) { Hc = fmaf(P0, Hc, H0); Pc *= P0; Hc = fmaf(P1, Hc, H1); Pc *= P1; }
        else { Hc = fmaf(P1, Hc, H1); Pc *= P1; Hc = fmaf(P0, Hc, H0); Pc *= P0; } }
      if (hi == 0) { const size_t o = ((size_t)(d * NB + bidx) * NLCH + (s0 >> 6)) * LRU_W + ch;
        ((float*)(p.ws + WS_LP))[o] = Pc; ((float*)(p.ws + WS_LH))[o] = Hc; } }
  }
  __syncthreads();
}

constexpr int PH_PER_LAYER = 12, N_PHASES = 2 + DEPTH * PH_PER_LAYER;
DEVI void run_phase(const Params& pin, int ph, int vb, int nb, char* lds) {
  const bool dry = ph >= 100; if (dry) ph -= 100;
  Params p = pin; { size_t z = 0; asm volatile("" : "+s"(z)); p.ws = pin.ws + z; p.out = pin.out + z; } asm volatile("" : "+s"(vb));
  const int tid = tidx(), wid = tid >> 6, lane = tid & 63;
#ifdef ONLY_SP
  if (ONLY_SP >= 0 && ph == 0) return;
#endif
  if (ph == 0) { phase0(p, vb, nb, lds); return; }
  if (ph == N_PHASES - 1) {
    const float* ssq = (const float*)(p.ws + WS_SSQ);
    for (size_t i = (size_t)vb * NTHREADS + tid; i < (size_t)T * DM / 8; i += (size_t)nb * NTHREADS) {
      const size_t t = i >> 7; const int c = (int)(i & 127) * 8;
      float s8[8]; ld8(ssq + t * 8, s8); const float rs = rsqrtf((((s8[0] + s8[1]) + (s8[2] + s8[3])) + ((s8[4] + s8[5]) + (s8[6] + s8[7]))) * (1.f / DM) + EPS);
      float x[8], g[8]; ld8(p.out + i * 8, x); ld8(p.norm_final + c, g);
#pragma unroll
      for (int q = 0; q < 8; ++q) x[q] *= rs * g[q];
      *(f32x4*)(p.out + i * 8) = (f32x4){x[0], x[1], x[2], x[3]}; *(f32x4*)(p.out + i * 8 + 4) = (f32x4){x[4], x[5], x[6], x[7]}; }
    return; }
  const int l = (ph - 1) / PH_PER_LAYER, sp = (ph - 1) % PH_PER_LAYER;
  u16* const XG = (u16*)(p.ws + WS_XG); u16* const PROJ = (u16*)(p.ws + WS_R1); u16* const MIX = (u16*)(p.ws + WS_MIX);
  constexpr int NMT = T / 256;
#ifdef ONLY_SP
  if (sp != ONLY_SP) return;
#endif
  switch (sp) {
  case 0: {
    pg8::Gemm g{XG, (const u16*)(p.ws + WS_WIN) + (size_t)l * INWP * DM, T, INWP, DM, DM, DM}; pg8::StaticOrder S; S.init(T, INWP, nb, vb);
    pg8::EpiProj e{PROJ, p.pos, (const float*)(p.ws + WS_SSQ), (float*)(p.ws + WS_SSQQ), (float*)(p.ws + WS_SSQKV)};
    pg8::gemm_phase((PG8_LAS unsigned char*)lds, g, S, e);
  } break;
  case 1: {
    { pg8::Gemm g{PROJ + PC_CQ, (const u16*)(p.ws + WS_WUQ) + (size_t)l * 768 * 256, T, 768, 256, INWP, 256}; pg8::StaticOrder S; S.init(T, 768, nb, vb);
      pg8::EpiQ2 e{(u16*)(p.ws + WS_QM), (const float*)(p.ws + WS_SSQQ)};
      pg8::gemm_phase((PG8_LAS unsigned char*)lds, g, S, e); }
    { pg8::Gemm g{PROJ + PC_CKV, (const u16*)(p.ws + WS_WUKV) + (size_t)l * 768 * 128, T, 768, 128, INWP, 128}; pg8::StaticOrder S; S.init(T, 768, nb, nb - 1 - vb);
      pg8::EpiKV2 e{(u16*)(p.ws + WS_KM), (u16*)(p.ws + WS_VM), (const float*)(p.ws + WS_SSQKV)};
      pg8::gemm_phase((PG8_LAS unsigned char*)lds, g, S, e); }
    for (int i = vb * NTHREADS + tid; i < T * MLA_H * 4; i += nb * NTHREADS) { const int c = (i & 3) * 8, h = (i >> 2) % MLA_H, row = i / (4 * MLA_H), b = row >> 13, s = row & (SEQ - 1);
      *(u32x4*)((u16*)(p.ws + WS_KM) + ((size_t)(b * MLA_H + h) * SEQ + s) * MLA_QK + 64 + c) = *(const u32x4*)(PROJ + (size_t)row * INWP + PC_KR + c); }
    for (int it = vb; it < NMT * 6; it += nb) lru_gate_item(p, l, it / 6, it % 6, lds);
  } break;
  case 2: {
    const int wi = vb * 8 + wid;
    if (wi < 48) lru_passB(p, wi, lane);
    __syncthreads();
    for (int it = vb; it < NB * 64 * 2; it += nb) swa_item(p, l, it, lds);
  } break;
  case 3: {
    for (int k = 0; k * nb + vb < NB * MLA_H * 32; ++k) {
      int pair, qb;
      if (nb == 256) { pair = k * 8 + (vb & 7); qb = vb >> 3; } else { const int it = k * nb + vb; pair = it >> 5; qb = it & 31; }
      mla_item(p, pair, qb, lds);
    }
#ifndef NO_LRUF
    for (int it = vb; it < NB * NLCH; it += nb) lru_final(p, it, lds);
#endif
  } break;
  case 4: {
    for (int t = vb * 8 + wid; t < T; t += nb * 8) {
      u32x4* rp = (u32x4*)(MIX + (size_t)t * DM + lane * 16);
      float v[16]; unpk8(rp[0], v); unpk8(rp[1], v + 8);
      float s = 0.f;
#pragma unroll
      for (int q = 0; q < 16; ++q) s = fmaf(v[q], v[q], s);
      const int sg = lane < 24 ? 0 : (lane < 48 ? 1 : 2);
      const float s0 = wave_sum(sg == 0 ? s : 0.f), s2 = wave_sum(sg == 2 ? s : 0.f);
      const float rs = sg == 0 ? rsqrtf(s0 * (1.f / 384.f) + EPS) : rsqrtf(s2 * (1.f / 256.f) + EPS);
      if (sg != 1) {
#pragma unroll
        for (int q = 0; q < 16; ++q) v[q] *= rs;
        rp[0] = pk8(v); rp[1] = pk8(v + 8); } }
  } break;
  case 5: {
    { pg8::Gemm g{MIX, (const u16*)(p.ws + WS_WOUT) + (size_t)l * DM * DM, T, DM, DM, DM, DM}; pg8::StaticOrder S; S.init(T, DM, nb, vb);
      pg8::EpiRes e{l == 0 ? p.x : p.out, dry ? (float*)(p.ws + WS_R1) : p.out, XG, (float*)(p.ws + WS_SSQ16)};
      pg8::gemm_phase((PG8_LAS unsigned char*)lds, g, S, e); }
    const float* us = p.peer_u + (size_t)l * NEXP * DM; const float* vs = p.peer_v + (size_t)l * NEXP * DM;
    u8* ub = (u8*)(p.ws + WS_UB); u8* vbf = (u8*)(p.ws + WS_VB);
    for (size_t i = (size_t)vb * NTHREADS + tid; i < (size_t)NEXP * 64; i += (size_t)nb * NTHREADS) {
      const size_t e = i >> 6; const int c16 = (int)(i & 63), s = c16 >> 3, cc = (c16 & 7) * 16;
      float a[16], b[16]; ld8(us + i * 16, a); ld8(us + i * 16 + 8, a + 8); ld8(vs + i * 16, b); ld8(vs + i * 16 + 8, b + 8);
#pragma unroll
      for (int q = 0; q < 16; ++q) { a[q] *= PEER_SU; b[q] *= PEER_SV; }
      const size_t o = ((size_t)s * NEXP + e) * 128 + cc;
      *(u32x4*)(ub + o) = (u32x4){enc4(a[0], a[1], a[2], a[3]), enc4(a[4], a[5], a[6], a[7]), enc4(a[8], a[9], a[10], a[11]), enc4(a[12], a[13], a[14], a[15])};
      *(u32x4*)(vbf + o) = (u32x4){enc4(b[0], b[1], b[2], b[3]), enc4(b[4], b[5], b[6], b[7]), enc4(b[8], b[9], b[10], b[11]), enc4(b[12], b[13], b[14], b[15])}; }
  } break;
  case 6: {
    pg8::Gemm g{XG, (const u16*)(p.ws + WS_WQ) + (size_t)l * 2048 * DM, T, 2048, DM, DM, DM}; pg8::StaticOrder S; S.init(T, 2048, nb, vb);
    pg8::EpiPQ e{PROJ, (const float*)(p.ws + WS_SSQ16)};
    pg8::gemm_phase((PG8_LAS unsigned char*)lds, g, S, e);
  } break;
  case 7: {
    for (int it = vb; it < NMT * 16; it += nb) { const int mt = it / 16, hj = it % 16, j = hj & 1;
      GemmDesc g{}; g.A = PROJ + hj * 128; g.lda = 2048; g.Bt = (const u16*)(p.ws + WS_SUBK) + (size_t)(l * 2 + j) * 128 * 128; g.ldb = 128; g.KT = 2;
      EpiTop e{(float*)(p.ws + WS_TOP), hj};
      gemm_tile<0, 0>(g, mt * 256, 0, lds, e); }
  } break;
  case 8: peer_cand(p, l, vb, nb, lds); break;
  case 9: case 11: {
    const bool last = l == DEPTH - 1;
    float* xo = dry ? (float*)(p.ws + WS_PD) : p.out;
    int s0, s1, tb, ts;
    if ((nb & 7) == 0) { s0 = vb & 7; s1 = s0 + 1; tb = (vb >> 3) * 8 + wid; ts = (nb >> 3) * 8; } else { s0 = 0; s1 = 8; tb = vb * 8 + wid; ts = nb * 8; }
#pragma unroll 1
    for (int s = s0; s < s1; ++s) { if (sp == 9) peer_slice_phase<false>(p, s, tb, ts, lane, p.out, xo, last); else peer_slice_phase<true>(p, s, tb, ts, lane, p.out, xo, last); }
  } break;
  case 10: {
    const float* pd = (const float*)(p.ws + WS_PD); const float* eg = (const float*)(p.ws + WS_EGATE); u16* cc = (u16*)(p.ws + WS_CC);
    for (size_t i = (size_t)vb * NTHREADS + tid; i < (size_t)T * 128 / 4; i += (size_t)nb * NTHREADS) {
      f32x4 a = *(const f32x4*)(pd + i * 4);
#pragma unroll
      for (int s = 1; s < 8; ++s) a += *(const f32x4*)(pd + (size_t)s * T * 128 + i * 4);
      const f32x4 g = *(const f32x4*)(eg + i * 4);
      f32x4 o; o.x = gelu_erf(a.x * (1.f / PEER_SU)) * g.x * (1.f / PEER_SV); o.y = gelu_erf(a.y * (1.f / PEER_SU)) * g.y * (1.f / PEER_SV);
      o.z = gelu_erf(a.z * (1.f / PEER_SU)) * g.z * (1.f / PEER_SV); o.w = gelu_erf(a.w * (1.f / PEER_SU)) * g.w * (1.f / PEER_SV);
      *(u32x2*)(cc + i * 4) = (u32x2){pk2(o.x, o.y), pk2(o.z, o.w)}; }
  } break;
  }
}

#define XB_TMO      128
#define XB_XCNT(j)  (256  + 64 * (j))
#define XB_XSUB(j)  (1280 + 64 * (j))
#define XB_XGEN(j)  (2304 + 64 * (j))
#define XB_TOP      3328
#define XB_TOPGEN   3392
#define XCD_BAR_WORDS 3456
#define XB_SPIN_CAP (1u << 23)
DEVI unsigned xb_ld(unsigned* p) { return __hip_atomic_load(p, __ATOMIC_RELAXED, __HIP_MEMORY_SCOPE_AGENT); }
DEVI unsigned xb_add(unsigned* p, unsigned v) { return __hip_atomic_fetch_add(p, v, __ATOMIC_RELAXED, __HIP_MEMORY_SCOPE_AGENT); }
DEVI unsigned xb_xcc_id() { return (unsigned)__builtin_amdgcn_s_getreg((3 << 11) | 20) & 0xFu; }
#define XB_SPIN(cond, bar) do { unsigned _sp = 0; while (cond) { __builtin_amdgcn_s_sleep(1); \
    if ((++_sp & 255u) == 0u) { if (xb_ld(&(bar)[XB_TMO])) break; if (_sp > XB_SPIN_CAP) { atomicAdd(&(bar)[XB_TMO], 1u); break; } } } } while (0)
struct XcdBarrier { unsigned* bar; unsigned x; volatile unsigned* st; };
DEVI XcdBarrier xcd_barrier_post(unsigned* bar, volatile unsigned* st) {
  XcdBarrier b; b.bar = bar; b.x = xb_xcc_id(); b.st = st;
  if (threadIdx.x == 0) (void)xb_add(&bar[XB_XCNT(b.x)], 1u);
  return b;
}
DEVI void xcd_barrier_complete(unsigned* bar, unsigned x, unsigned& nloc, unsigned& nx) {
  const unsigned G = gridDim.x * gridDim.y * gridDim.z;
  unsigned sum, cnt, mine, sp = 0u;
  for (;;) {
    sum = 0u; cnt = 0u; mine = 0u;
#pragma unroll
    for (unsigned j = 0; j < 16; ++j) { const unsigned c = xb_ld(&bar[XB_XCNT(j)]); sum += c; cnt += (c > 0u) ? 1u : 0u; mine = (j == x) ? c : mine; }
    if (sum == G) break;
    __builtin_amdgcn_s_sleep(1);
    if ((++sp & 255u) == 0u) { if (xb_ld(&bar[XB_TMO])) break; if (sp > XB_SPIN_CAP) { atomicAdd(&bar[XB_TMO], 1u); break; } }
  }
  nloc = mine > 0u ? mine : 1u; nx = cnt > 0u ? cnt : 1u;
}
DEVI void xcd_barrier(const XcdBarrier& b) {
  asm volatile("s_waitcnt vmcnt(0)" ::: "memory");
  __syncthreads();
  if (threadIdx.x == 0) {
    unsigned* bar = b.bar;
    __builtin_amdgcn_s_waitcnt(0);
    unsigned nloc = b.st[0], nx = b.st[1];
    if (nloc == 0u) { xcd_barrier_complete(bar, b.x, nloc, nx); b.st[0] = nloc; b.st[1] = nx; }
    const unsigned old = xb_add(&bar[XB_XSUB(b.x)], 1u);
    const unsigned gen = old / nloc;
    if (old + 1u == (gen + 1u) * nloc) {
      __builtin_amdgcn_fence(__ATOMIC_RELEASE, "agent");
      asm volatile("s_waitcnt vmcnt(0)" ::: "memory");
      const unsigned og = xb_add(&bar[XB_TOP], 1u);
      const unsigned tg = og / nx;
      if (og + 1u == (tg + 1u) * nx) xb_add(&bar[XB_TOPGEN], 1u);
      else XB_SPIN(xb_ld(&bar[XB_TOPGEN]) == tg, bar);
      __builtin_amdgcn_fence(__ATOMIC_ACQUIRE, "agent");
      xb_add(&bar[XB_XGEN(b.x)], 1u);
      asm volatile("s_waitcnt vmcnt(0)" ::: "memory");
    } else {
      XB_SPIN(xb_ld(&bar[XB_XGEN(b.x)]) == gen, bar);
      __builtin_amdgcn_fence(__ATOMIC_ACQUIRE, "agent");
      asm volatile("s_waitcnt vmcnt(0)" ::: "memory");
    }
  }
  __syncthreads();
}

__global__ void __launch_bounds__(NTHREADS, 2) mega(Params p) {
  extern __shared__ __attribute__((aligned(16))) char smem[];
  cg::grid_group grid = cg::this_grid();
  const int nb = gridDim.x, vb = blockIdx.x;
  volatile unsigned* st = (volatile unsigned*)(smem + LDS_BYTES - 16);
  if (threadIdx.x == 0) { st[0] = 0u; st[1] = 0u; }
  __syncthreads();
  const XcdBarrier bar = xcd_barrier_post((unsigned*)p.ws, st);
#define GRID_BAR(first) do { if (first) grid.sync(); else xcd_barrier(bar); } while (0)
  for (int ph = p.ph_lo; ph < p.ph_hi; ++ph) {
#ifdef PROBE_DUP
    if (ph > 0 && ph < N_PHASES - 1 && ((PROBE_DUP >> ((ph - 1) % PH_PER_LAYER)) & 1)) { run_phase(p, ph + 100, vb, nb, smem); GRID_BAR(false); }
#endif
    run_phase(p, ph, vb, nb, smem);
    if (ph + 1 < p.ph_hi) GRID_BAR(ph == p.ph_lo);
  }
}

#ifndef N_LAUNCH_SPLIT
#define N_LAUNCH_SPLIT 0
#endif
extern "C" void kernel_launch(void* const* d_in, const int* in_sizes, int n_in, void* d_out, int out_size, void* d_ws, size_t ws_size, hipStream_t stream) {
  static int grid_blocks = 0;
  if (grid_blocks == 0) {
    if (n_in != 24 || out_size != T * DM || ws_size < WS_NEED) { fprintf(stderr, "kernel_launch: unexpected shapes n_in %d out %d ws %zu\n", n_in, out_size, ws_size); grid_blocks = -1; return; }
    int dev = 0, cus = 0, per_cu = 0;
    (void)hipGetDevice(&dev); (void)hipDeviceGetAttribute(&cus, hipDeviceAttributeMultiprocessorCount, dev);
    if (hipFuncSetAttribute((const void*)mega, hipFuncAttributeMaxDynamicSharedMemorySize, LDS_BYTES) != hipSuccess) { fprintf(stderr, "kernel_launch: hipFuncSetAttribute failed\n"); grid_blocks = -1; return; }
    if (hipOccupancyMaxActiveBlocksPerMultiprocessor(&per_cu, (const void*)mega, NTHREADS, LDS_BYTES) != hipSuccess || per_cu < 1) { fprintf(stderr, "kernel_launch: occupancy query failed (%d)\n", per_cu); grid_blocks = -1; return; }
    grid_blocks = cus * 1;
    fprintf(stderr, "kernel_launch: cus %d per_cu %d grid %d\n", cus, per_cu, grid_blocks);
  }
  if (grid_blocks < 0) return;
  if (hipMemsetAsync(d_ws, 0, 65536, stream) != hipSuccess) { fprintf(stderr, "kernel_launch: memset failed\n"); return; }
  Params p{};
  p.x = (const float*)d_in[0]; p.pos = (const int*)d_in[1]; p.norm_mix = (const float*)d_in[2]; p.w_in = (const float*)d_in[3]; p.q_norm = (const float*)d_in[4];
  p.w_uq = (const float*)d_in[5]; p.kv_norm = (const float*)d_in[6]; p.w_ukv = (const float*)d_in[7]; p.conv_w = (const float*)d_in[8]; p.conv_b = (const float*)d_in[9];
  p.lru_wa = (const float*)d_in[10]; p.lru_ba = (const float*)d_in[11]; p.lru_wx = (const float*)d_in[12]; p.lru_bx = (const float*)d_in[13]; p.lru_lambda = (const float*)d_in[14];
  p.swa_sink = (const float*)d_in[15]; p.grp_norm = (const float*)d_in[16]; p.w_out = (const float*)d_in[17]; p.norm_ffn = (const float*)d_in[18]; p.peer_wq = (const float*)d_in[19];
  p.peer_subkeys = (const float*)d_in[20]; p.peer_u = (const float*)d_in[21]; p.peer_v = (const float*)d_in[22]; p.norm_final = (const float*)d_in[23];
  p.out = (float*)d_out; p.ws = (unsigned char*)d_ws;
#if N_LAUNCH_SPLIT
  for (int ph = 0; ph < N_PHASES; ++ph) {
    p.ph_lo = ph; p.ph_hi = ph + 1;
    void* args[] = {&p};
    hipError_t e = hipLaunchCooperativeKernel((const void*)mega, dim3(grid_blocks), dim3(NTHREADS), args, LDS_BYTES, stream);
    if (e != hipSuccess) { fprintf(stderr, "kernel_launch: launch of phase %d failed: %s\n", ph, hipGetErrorString(e)); break; }
  }
#else
  p.ph_lo = 0; p.ph_hi = N_PHASES;
  void* args[] = {&p};
  hipError_t e = hipLaunchCooperativeKernel((const void*)mega, dim3(grid_blocks), dim3(NTHREADS), args, LDS_BYTES, stream);
  if (e != hipSuccess) fprintf(stderr, "kernel_launch: cooperative launch failed: %s (grid %d)\n", hipGetErrorString(e), grid_blocks);
#endif
}
```

```cpp
#include <hip/hip_runtime.h>
#include <hip/hip_cooperative_groups.h>
#include <cstdio>
#include <cstdint>
namespace cg = cooperative_groups;

#define DEVI __device__ __forceinline__
typedef unsigned short u16;
typedef short bf16x8 __attribute__((ext_vector_type(8)));
typedef short s16x4 __attribute__((ext_vector_type(4)));
typedef float f32x2 __attribute__((ext_vector_type(2)));
typedef float f32x4 __attribute__((ext_vector_type(4)));
typedef float f32x16 __attribute__((ext_vector_type(16)));
typedef unsigned u32x4 __attribute__((ext_vector_type(4)));
typedef unsigned u32x2 __attribute__((ext_vector_type(2)));
typedef __bf16 bf16x2_t __attribute__((ext_vector_type(2)));

constexpr int NB = 4, SEQ = 8192, T = NB * SEQ, DM = 1024, DEPTH = 2;
constexpr int MLA_H = 6, MLA_QK = 96, MLA_V = 64;
constexpr int LRU_W = 384;
constexpr int INW = 1696, INWP = 1792;
constexpr int PC_CQ = 0, PC_CKV = 256, PC_SQ = 384, PC_SK = 640, PC_SV = 768, PC_LX = 896, PC_LG = 1280, PC_KR = 1664;
constexpr int OC_CQ = 0, OC_CKV = 256, OC_KR = 384, OC_SQ = 416, OC_SK = 672, OC_SV = 800, OC_LX = 928, OC_LG = 1312;
constexpr int NEXP = 16384;
constexpr float EPS = 1e-6f;
constexpr int NTHREADS = 512;
constexpr int LDS_BYTES = 160 * 1024;

constexpr size_t MiB = 1u << 20;
constexpr size_t WS_CTL = 0;
constexpr size_t WS_WIN = 4 * MiB;
constexpr size_t WS_WQ = 11 * MiB;
constexpr size_t WS_WOUT = 19 * MiB;
constexpr size_t WS_WUQ = 23 * MiB;
constexpr size_t WS_WUKV = WS_WUQ + 2 * 768 * 256 * 2;
constexpr size_t WS_WLRU = WS_WUKV + 2 * 768 * 128 * 2;
constexpr size_t WS_SUBK = WS_WLRU + 2 * 6 * 2 * 128 * 64 * 2;
constexpr size_t WS_XG = 25 * MiB;
constexpr size_t WS_R1 = 89 * MiB;
constexpr size_t WS_QM = 217 * MiB;
constexpr size_t WS_KM = 253 * MiB;
constexpr size_t WS_VM = 289 * MiB;
constexpr size_t WS_LE = 313 * MiB;
constexpr size_t WS_LB = 361 * MiB;
constexpr size_t WS_MIX = 409 * MiB;
constexpr size_t WS_UB = 217 * MiB;
constexpr size_t WS_VB = 233 * MiB;
constexpr size_t WS_TOP = 281 * MiB;
constexpr size_t WS_EIDX = 313 * MiB;
constexpr size_t WS_EGATE = 329 * MiB;
constexpr size_t WS_CC = 345 * MiB;
constexpr size_t WS_SSQ = 361 * MiB;
constexpr size_t WS_SSQ16 = 363 * MiB;
constexpr size_t WS_SSQQ = 476 * MiB;
constexpr size_t WS_SSQKV = 477 * MiB;
constexpr size_t WS_PD = 89 * MiB;
constexpr float PEER_SU = 256.f, PEER_SV = 16.f;
constexpr size_t WS_END = 473 * MiB;

__device__ const float ROPE_HI[32] = {1.591549367e-01f, 1.193493679e-01f, 8.949939907e-02f, 6.711508334e-02f, 5.032921210e-02f, 3.774158657e-02f, 2.830219641e-02f, 2.122365311e-02f, 1.591549441e-02f, 1.193493698e-02f, 8.949940093e-03f, 6.711508147e-03f, 5.032921210e-03f, 3.774158424e-03f, 2.830219688e-03f, 2.122365171e-03f, 1.591549488e-03f, 1.193493721e-03f, 8.949940093e-04f, 6.711508031e-04f, 5.032921326e-04f, 3.774158540e-04f, 2.830219455e-04f, 2.122365258e-04f, 1.591549371e-04f, 1.193493736e-04f, 8.949940093e-05f, 6.711508468e-05f, 5.032921035e-05f, 3.774158540e-05f, 2.830219637e-05f, 2.122365186e-05f};
__device__ const float ROPE_LO[32] = {6.420638243e-09f, 2.294664903e-09f, 2.542919653e-09f, -3.316028840e-10f, 5.173299289e-12f, -1.848551645e-09f, -5.826552019e-10f, -3.431038786e-10f, -1.029942243e-10f, 4.320196978e-11f, 6.802744479e-11f, 1.531042237e-10f, 5.173301024e-13f, 4.797548470e-11f, -1.048316434e-10f, 1.053879969e-10f, -5.686555046e-11f, -1.896286773e-11f, 6.802744999e-12f, 2.695195456e-11f, -1.158979943e-11f, -6.843983713e-12f, 1.279990003e-11f, 1.807650600e-12f, 5.954976963e-12f, -3.351478166e-12f, 6.802744674e-13f, -1.670379113e-12f, 1.751403167e-12f, -6.843983930e-13f, -5.389994549e-13f, 9.083608431e-13f};

DEVI int tidx() { int t = __builtin_amdgcn_workitem_id_x(); asm volatile("" : "+v"(t)); return t; }
DEVI float bf2f(unsigned h) { return __uint_as_float(h << 16); }
DEVI float bflo(unsigned w) { return __uint_as_float(w << 16); }
DEVI float bfhi(unsigned w) { return __uint_as_float(w & 0xffff0000u); }
DEVI unsigned pk2(float lo, float hi) { f32x2 v = {lo, hi}; bf16x2_t b = __builtin_convertvector(v, bf16x2_t); return __builtin_bit_cast(unsigned, b); }
DEVI u16 f2bf(float f) { return (u16)(pk2(f, 0.f) & 0xffffu); }
DEVI u32x4 pk8(const float* v) { u32x4 w; w.x = pk2(v[0], v[1]); w.y = pk2(v[2], v[3]); w.z = pk2(v[4], v[5]); w.w = pk2(v[6], v[7]); return w; }
DEVI void unpk8(u32x4 w, float* v) { v[0] = bflo(w.x); v[1] = bfhi(w.x); v[2] = bflo(w.y); v[3] = bfhi(w.y); v[4] = bflo(w.z); v[5] = bfhi(w.z); v[6] = bflo(w.w); v[7] = bfhi(w.w); }
DEVI void ld8(const float* p, float* v) { const f32x4 a = *(const f32x4*)p, b = *(const f32x4*)(p + 4); v[0] = a.x; v[1] = a.y; v[2] = a.z; v[3] = a.w; v[4] = b.x; v[5] = b.y; v[6] = b.z; v[7] = b.w; }
DEVI int crow(int r, int hi) { return (r & 3) + 8 * (r >> 2) + 4 * hi; }
DEVI float wave_sum(float v) {
#pragma unroll
  for (int o = 1; o < 64; o <<= 1) v += __shfl_xor(v, o);
  return v;
}
DEVI void rope_sc(float pos, int fidx, float& sn, float& cs) {
  const float chi = ROPE_HI[fidx], clo = ROPE_LO[fidx];
  const float t = pos * chi, e = fmaf(pos, chi, -t);
  float fr = t - rintf(t);
  fr = fr + (e + pos * clo);
  sn = __builtin_amdgcn_sinf(fr); cs = __builtin_amdgcn_cosf(fr);
}
DEVI float sigmoidf_(float x) { return 1.f / (1.f + __expf(-x)); }
DEVI float gelu_erf(float x) { return 0.5f * x * (1.f + erff(x * 0.70710678118654752f)); }

struct Params {
  const float* x; const int* pos; const float* norm_mix; const float* w_in; const float* q_norm; const float* w_uq; const float* kv_norm; const float* w_ukv;
  const float* conv_w; const float* conv_b; const float* lru_wa; const float* lru_ba; const float* lru_wx; const float* lru_bx; const float* lru_lambda;
  const float* swa_sink; const float* grp_norm; const float* w_out; const float* norm_ffn; const float* peer_wq; const float* peer_subkeys;
  const float* peer_u; const float* peer_v; const float* norm_final;
  float* out; unsigned char* ws;
  int ph_lo, ph_hi;
};

DEVI void tconv_item(const float* W, int ldw, int src_c0, u16* WT, int K, int dst_r0, const float* gain, float* scr, int kb, int nb, int lane, int pg = 0) {
  const int k0 = 64 * kb, n0 = 32 * nb;
#pragma unroll 8
  for (int i = 0; i < 32; ++i) { const int kk = 2 * i + (lane >> 5); float g = gain ? gain[k0 + kk] : 1.f; scr[kk * 33 + (lane & 31)] = g * W[(size_t)(k0 + kk) * ldw + src_c0 + n0 + (lane & 31)]; }
  __builtin_amdgcn_s_waitcnt(0xc07f); asm volatile("" ::: "memory");
  const int c = lane & 7;
#pragma unroll
  for (int j = 0; j < 4; ++j) { const int n = (lane >> 3) + 8 * j; const float* s = scr + (8 * c) * 33 + n;
    u32x4 o; o.x = pk2(s[0 * 33], s[1 * 33]); o.y = pk2(s[2 * 33], s[3 * 33]); o.z = pk2(s[4 * 33], s[5 * 33]); o.w = pk2(s[6 * 33], s[7 * 33]);
    int nn = n0 + n; if (pg > 0) { const int g = nn & ~(pg - 1), i = nn & (pg - 1), hw = pg >> 1; nn = g + (i < hw ? 2 * i : 2 * (i - hw) + 1); }
    else if (pg < 0) { const int j = nn % 96; if (j >= 64) { const int i = j - 64; nn = nn - i + (i < 16 ? 2 * i : 2 * (i - 16) + 1); } }
    *(u32x4*)(WT + (size_t)(dst_r0 + nn) * K + k0 + 8 * c) = o; }
  __builtin_amdgcn_s_waitcnt(0xc07f); asm volatile("" ::: "memory");
}

DEVI void p0_item(const Params& p, int it, float* scr, int lane) {
  const int l = it / 2552; int r = it - l * 2552;
  const float* win = p.w_in + (size_t)l * DM * INW; u16* wint = (u16*)(p.ws + WS_WIN) + (size_t)l * INWP * DM; const float* gm = p.norm_mix + l * DM;
#define SEG(W, ldw, sc0, ncols, WT, K, dr0, gain, pg) { const int nnb_ = (ncols) / 32, ni_ = ((K) / 64) * nnb_; if (r < ni_) { tconv_item(W, ldw, sc0, WT, K, dr0, gain, scr, r / nnb_, r % nnb_, lane, pg); return; } r -= ni_; }
  SEG(win, INW, OC_CQ, 256, wint, DM, PC_CQ, gm, 0)
  SEG(win, INW, OC_CKV, 128, wint, DM, PC_CKV, gm, 0)
  SEG(win, INW, OC_SQ, 256, wint, DM, PC_SQ, gm, 64)
  SEG(win, INW, OC_SK, 128, wint, DM, PC_SK, gm, 64)
  SEG(win, INW, OC_SV, 128, wint, DM, PC_SV, gm, 0)
  SEG(win, INW, OC_LX, 384, wint, DM, PC_LX, gm, 0)
  SEG(win, INW, OC_LG, 384, wint, DM, PC_LG, gm, 0)
  SEG(win, INW, OC_KR, 32, wint, DM, PC_KR, gm, 32)
  SEG(p.peer_wq + (size_t)l * DM * 2048, 2048, 0, 2048, (u16*)(p.ws + WS_WQ) + (size_t)l * 2048 * DM, DM, 0, p.norm_ffn + l * DM, 0)
  SEG(p.w_out + (size_t)l * DM * DM, DM, 0, DM, (u16*)(p.ws + WS_WOUT) + (size_t)l * DM * DM, DM, 0, p.grp_norm + l * DM, 0)
  SEG(p.w_uq + (size_t)l * 256 * 576, 576, 0, 576, (u16*)(p.ws + WS_WUQ) + (size_t)l * 768 * 256, 256, 0, p.q_norm + l * 256, -1)
  SEG(p.w_ukv + (size_t)l * 128 * 768, 768, 0, 768, (u16*)(p.ws + WS_WUKV) + (size_t)l * 768 * 128, 128, 0, p.kv_norm + l * 128, 0)
#undef SEG
  { const int nbk = r & 1, ax = (r >> 1) & 1, n = (r >> 2) % 6, d = (r >> 2) / 6;
    const float* W = (ax ? p.lru_wx : p.lru_wa) + ((size_t)(l * 2 + d) * 6 + n) * 4096;
    u16* WT = (u16*)(p.ws + WS_WLRU) + ((size_t)((l * 6 + n) * 2 + d)) * 128 * 64;
    tconv_item(W, 64, 0, WT, 64, 32 * nbk + 32 * ax, nullptr, scr, 0, nbk, lane); }
}

DEVI void phase0(const Params& p, int vb, int nb, char* lds) {
  const int tid = tidx(), lane = tid & 63, wid = tid >> 6;
  float* scr = (float*)(lds + wid * 16384);
  const int gw = vb * 8 + wid, ngw = nb * 8;
  for (int it = gw; it < DEPTH * 2552; it += ngw) p0_item(p, it, scr, lane);
  for (int i = vb * NTHREADS + tid; i < DEPTH * 96 * DM / 8; i += nb * NTHREADS) { const int l = i / (96 * DM / 8), r = i % (96 * DM / 8);
    *(u32x4*)((u16*)(p.ws + WS_WIN) + ((size_t)l * INWP + INW) * DM + (size_t)r * 8) = (u32x4){0, 0, 0, 0}; }
  for (int i = vb * NTHREADS + tid; i < DEPTH * 192 * 256 / 8; i += nb * NTHREADS) { const int l = i / (192 * 256 / 8), r = i % (192 * 256 / 8);
    *(u32x4*)((u16*)(p.ws + WS_WUQ) + ((size_t)l * 768 + 576) * 256 + (size_t)r * 8) = (u32x4){0, 0, 0, 0}; }
  for (int i = vb * NTHREADS + tid; i < DEPTH * 2 * 128 * 128 / 8; i += nb * NTHREADS) {
    float a[8]; ld8(p.peer_subkeys + (size_t)i * 8, a);
    *(u32x4*)((u16*)(p.ws + WS_SUBK) + (size_t)i * 8) = pk8(a); }
  { float* ssq = (float*)(p.ws + WS_SSQ); u16* xg = (u16*)(p.ws + WS_XG);
    for (int t = gw * 2; t < T; t += ngw * 2) {
      float a[2][16];
#pragma unroll
      for (int u = 0; u < 2; ++u) { ld8(p.x + (size_t)(t + u) * DM + lane * 16, a[u]); ld8(p.x + (size_t)(t + u) * DM + lane * 16 + 8, a[u] + 8); }
#pragma unroll
      for (int u = 0; u < 2; ++u) { float s = 0.f;
#pragma unroll
        for (int q = 0; q < 16; ++q) s = fmaf(a[u][q], a[u][q], s);
        s += __shfl_xor(s, 1); s += __shfl_xor(s, 2); s += __shfl_xor(s, 4);
        if ((lane & 7) == 0) ssq[(size_t)(t + u) * 8 + (lane >> 3)] = s;
        u32x4* o = (u32x4*)(xg + (size_t)(t + u) * DM + lane * 16); o[0] = pk8(a[u]); o[1] = pk8(a[u] + 8); } } }
}

DEVI int swz(int row, int c) { return row * 128 + ((c ^ ((row >> 1) & 7)) << 4); }
constexpr int CLD = 132;
constexpr int LDS_RS = 135168;

struct GemmDesc {
  const u16* A; int lda; const u16* Bt; int ldb; int KT;
  float inv0;
  const u16* proj; const float* cw; const float* cb; int ch0;
};

template <int AMODE> DEVI bf16x8 load_a(const GemmDesc& g, int row, int kcol) {
  if constexpr (AMODE == 0) {
    return *(const bf16x8*)(g.A + (size_t)row * g.lda + kcol);
  } else {
    const int s = row & (SEQ - 1), ch = g.ch0 + kcol;
    float a[8];
    { const f32x4 b0 = *(const f32x4*)(g.cb + ch), b1 = *(const f32x4*)(g.cb + ch + 4); a[0] = b0.x; a[1] = b0.y; a[2] = b0.z; a[3] = b0.w; a[4] = b1.x; a[5] = b1.y; a[6] = b1.z; a[7] = b1.w; }
#pragma unroll
    for (int tap = 0; tap < 4; ++tap) {
      const int ss = s - 1 + tap;
      if (ss >= 0 && ss < SEQ) {
        const u32x4 v = *(const u32x4*)(g.proj + (size_t)(row - 1 + tap) * INWP + PC_LX + ch);
        float x[8]; unpk8(v, x);
        const f32x4 w0 = *(const f32x4*)(g.cw + tap * LRU_W + ch), w1 = *(const f32x4*)(g.cw + tap * LRU_W + ch + 4);
        a[0] += w0.x * x[0]; a[1] += w0.y * x[1]; a[2] += w0.z * x[2]; a[3] += w0.w * x[3];
        a[4] += w1.x * x[4]; a[5] += w1.y * x[5]; a[6] += w1.z * x[6]; a[7] += w1.w * x[7];
      }
    }
    const u32x4 o = pk8(a);
    return __builtin_bit_cast(bf16x8, o);
  }
}

template <int AMODE> DEVI void g_load(const GemmDesc& g, bf16x8 (&ar)[4], bf16x8 (&br)[2], int m0, int n0, int srow, int sc, int kt) {
#pragma unroll
  for (int i = 0; i < 4; ++i) ar[i] = load_a<AMODE>(g, m0 + srow + 64 * i, kt * 64 + sc * 8);
#pragma unroll
  for (int i = 0; i < 2; ++i) br[i] = *(const bf16x8*)(g.Bt + (size_t)(n0 + srow + 64 * i) * g.ldb + kt * 64 + sc * 8);
}
template <bool NORM> DEVI void g_write(char* Ab, const bf16x8 (&ar)[4], const bf16x8 (&br)[2], float (&ssq)[4], int srow, int sc) {
  char* Bb = Ab + 32768;
#pragma unroll
  for (int i = 0; i < 4; ++i) { *(bf16x8*)(Ab + swz(srow + 64 * i, sc)) = ar[i];
    if (NORM) { float x[8]; unpk8(__builtin_bit_cast(u32x4, ar[i]), x); float s = ssq[i];
#pragma unroll
      for (int q = 0; q < 8; ++q) s = fmaf(x[q], x[q], s);
      ssq[i] = s; } }
#pragma unroll
  for (int i = 0; i < 2; ++i) *(bf16x8*)(Bb + swz(srow + 64 * i, sc)) = br[i];
}

template <int AMODE, int SEG>
DEVI void gemm_core(const GemmDesc& g, int m0, int n0, char* lds) {
  const int tid = tidx(), lane = tid & 63, wid = tid >> 6;
  const int wm = wid >> 1, wn = wid & 1, r32 = lane & 31, hi = lane >> 5;
  const int srow = tid >> 3, sc = tid & 7;
  constexpr bool NORM = SEG != 0;
  float* rs = (float*)(lds + LDS_RS);
  f32x16 acc[2][2], acc2[2][2];
#pragma unroll
  for (int i = 0; i < 2; ++i)
#pragma unroll
    for (int j = 0; j < 2; ++j) { acc[i][j] = f32x16{}; acc2[i][j] = f32x16{}; }
  float ssq[4] = {0.f, 0.f, 0.f, 0.f};
  bf16x8 ar[4], br[2];
  g_load<AMODE>(g, ar, br, m0, n0, srow, sc, 0); g_write<NORM>(lds, ar, br, ssq, srow, sc); __syncthreads();
  int seg = 0;
#pragma unroll 1
  for (int kt = 0; kt < g.KT; ++kt) {
    const int cur = kt & 1;
    if (kt + 1 < g.KT) g_load<AMODE>(g, ar, br, m0, n0, srow, sc, kt + 1);
    { const char* Ab = lds + cur * 49152; const char* Bb = Ab + 32768;
#pragma unroll
      for (int k16 = 0; k16 < 4; ++k16) {
        bf16x8 a[2], b[2];
#pragma unroll
        for (int mt = 0; mt < 2; ++mt) a[mt] = *(const bf16x8*)(Ab + swz(wm * 64 + mt * 32 + r32, k16 * 2 + hi));
#pragma unroll
        for (int nt = 0; nt < 2; ++nt) b[nt] = *(const bf16x8*)(Bb + swz(wn * 64 + nt * 32 + r32, k16 * 2 + hi));
#pragma unroll
        for (int mt = 0; mt < 2; ++mt)
#pragma unroll
          for (int nt = 0; nt < 2; ++nt) {
            if (NORM) acc2[mt][nt] = __builtin_amdgcn_mfma_f32_32x32x16_bf16(a[mt], b[nt], acc2[mt][nt], 0, 0, 0);
            else acc[mt][nt] = __builtin_amdgcn_mfma_f32_32x32x16_bf16(a[mt], b[nt], acc[mt][nt], 0, 0, 0);
          }
      } }
    if (NORM) {
      int se; float inv;
      if (SEG == 1) { se = g.KT; inv = g.inv0; }
      else { se = seg == 0 ? 6 : (seg == 1 ? 12 : 16); inv = seg == 2 ? (1.f / 256.f) : (1.f / 384.f); }
      if (kt + 1 == se) {
#pragma unroll
        for (int i = 0; i < 4; ++i) { float s = ssq[i]; s += __shfl_xor(s, 1); s += __shfl_xor(s, 2); s += __shfl_xor(s, 4); if (sc == 0) rs[srow + 64 * i] = rsqrtf(s * inv + EPS); }
        __syncthreads();
#pragma unroll
        for (int mt = 0; mt < 2; ++mt)
#pragma unroll
          for (int r = 0; r < 16; ++r) { const float f = rs[wm * 64 + mt * 32 + crow(r, hi)];
#pragma unroll
            for (int nt = 0; nt < 2; ++nt) { acc[mt][nt][r] = fmaf(f, acc2[mt][nt][r], acc[mt][nt][r]); acc2[mt][nt][r] = 0.f; } }
        ssq[0] = ssq[1] = ssq[2] = ssq[3] = 0.f;
        ++seg;
      }
    }
    if (kt + 1 < g.KT) g_write<NORM>(lds + (cur ^ 1) * 49152, ar, br, ssq, srow, sc);
    __syncthreads();
  }
  float* C = (float*)lds;
#pragma unroll
  for (int mt = 0; mt < 2; ++mt)
#pragma unroll
    for (int nt = 0; nt < 2; ++nt)
#pragma unroll
      for (int r = 0; r < 16; ++r) C[(wm * 64 + mt * 32 + crow(r, hi)) * CLD + wn * 64 + nt * 32 + r32] = acc[mt][nt][r];
  __syncthreads();
}
template <int AMODE, int SEG, class Epi>
DEVI void gemm_tile(const GemmDesc& g, int m0, int n0, char* lds, const Epi& epi) {
  gemm_core<AMODE, SEG>(g, m0, n0, lds);
  epi((const float*)lds, m0, n0);
  __syncthreads();
}

DEVI GemmDesc gemm_desc(const u16* A, int lda, const u16* Bt, int ldb, int K) {
  GemmDesc g{}; g.A = A; g.lda = lda; g.Bt = Bt; g.ldb = ldb; g.KT = K / 64; g.inv0 = 1.f / (float)K; return g;
}


template <int HW> DEVI void rope8(float* v, const float* pp, int i0, float posf) {
  const bool first = i0 < HW; const int f0 = i0 & (HW - 1);
#pragma unroll
  for (int j = 0; j < 8; ++j) { float sn, cs; rope_sc(posf, HW == 32 ? (f0 + j) : 2 * (f0 + j), sn, cs); const float pv = pp[j]; v[j] = first ? v[j] * cs - pv * sn : v[j] * cs + pv * sn; }
}

struct EpiP1 { u16* proj; const int* pos;
  DEVI void operator()(const float* C, int m0, int n0) const {
    const int tid = tidx();
#pragma unroll 1
    for (int it = 0; it < 8; ++it) { const int item = it * NTHREADS + tid, row = item >> 4, c8 = (item & 15) * 8, gcol = n0 + c8, grow = m0 + row;
      float v[8]; ld8(C + row * CLD + c8, v);
      const bool r64 = gcol >= PC_SQ && gcol < PC_SV, r32g = gcol >= PC_KR && gcol < PC_KR + 32;
      if (r64) { const int i0 = gcol & 63; float pp[8]; ld8(C + row * CLD + c8 + (i0 < 32 ? 32 : -32), pp); rope8<32>(v, pp, i0, (float)pos[grow]); }
      else if (r32g) { const int i0 = gcol & 31; float pp[8]; ld8(C + row * CLD + c8 + (i0 < 16 ? 16 : -16), pp); rope8<16>(v, pp, i0, (float)pos[grow]); }
      *(u32x4*)(proj + (size_t)grow * INWP + gcol) = pk8(v);
    }
  }
};

struct EpiQ { u16* qm; const int* pos;
  DEVI void operator()(const float* C, int m0, int n0) const {
    const int tid = tidx();
#pragma unroll 1
    for (int it = 0; it < 8; ++it) { const int item = it * NTHREADS + tid, row = item >> 4, c8 = (item & 15) * 8, gcol = n0 + c8, grow = m0 + row;
      if (gcol >= 576) continue;
      const int head = gcol / 96, j0 = gcol - head * 96, b = grow >> 13, s = grow & (SEQ - 1);
      float v[8]; ld8(C + row * CLD + c8, v);
      u16* qrow = qm + ((size_t)(b * MLA_H + head) * SEQ + s) * MLA_QK;
      if (j0 >= 64) { const int i0 = j0 - 64; float pp[8]; ld8(C + row * CLD + c8 + (i0 < 16 ? 16 : -16), pp); rope8<16>(v, pp, i0, (float)pos[grow]);
#pragma unroll
        for (int j = 0; j < 8; ++j) { const int i = i0 + j; qrow[64 + (i < 16 ? 2 * i : 2 * (i - 16) + 1)] = f2bf(v[j]); } }
      else *(u32x4*)(qrow + j0) = pk8(v);
    }
  }
};

struct EpiKV { u16* km; u16* vm; const u16* proj;
  DEVI void operator()(const float* C, int m0, int n0) const {
    const int tid = tidx(), head = n0 >> 7;
#pragma unroll 1
    for (int it = 0; it < 8; ++it) { const int item = it * NTHREADS + tid, row = item >> 4, c8 = (item & 15) * 8, grow = m0 + row;
      const int b = grow >> 13, s = grow & (SEQ - 1);
      float v[8]; ld8(C + row * CLD + c8, v);
      const size_t tok = (size_t)(b * MLA_H + head) * SEQ + s;
      if (c8 < 64) *(u32x4*)(km + tok * MLA_QK + c8) = pk8(v);
      else *(u32x4*)(vm + tok * MLA_V + (c8 - 64)) = pk8(v);
    }
#pragma unroll 1
    for (int it = 0; it < 2; ++it) { const int item = it * NTHREADS + tid, row = item >> 2, c = (item & 3) * 8, grow = m0 + row;
      const int b = grow >> 13, s = grow & (SEQ - 1);
      *(u32x4*)(km + ((size_t)(b * MLA_H + head) * SEQ + s) * MLA_QK + 64 + c) = *(const u32x4*)(proj + (size_t)grow * INWP + PC_KR + c);
    }
  }
};

struct EpiLRU { const u16* proj; const float* cw; const float* cb; const float* ba; const float* bx; const float* lam; u16* le; u16* lb; int n, d;
  DEVI void operator()(const float* C, int m0, int) const {
    const int tid = tidx();
#pragma unroll 1
    for (int it = 0; it < 4; ++it) { const int item = it * NTHREADS + tid, j = item & 63, g8 = item >> 6;
      const int ch = n * 64 + j, grow0 = m0 + g8 * 8, s0 = grow0 & (SEQ - 1), b = grow0 >> 13;
      const float bav = ba[(d * 6 + n) * 64 + j], bxv = bx[(d * 6 + n) * 64 + j];
      const float cdec = -8.f * log1pf(__expf(-lam[d * LRU_W + ch]));
      float xin[11];
#pragma unroll
      for (int q = 0; q < 11; ++q) { const int ss = s0 - 1 + q; xin[q] = (ss >= 0 && ss < SEQ) ? bf2f(proj[(size_t)(grow0 - 1 + q) * INWP + PC_LX + ch]) : 0.f; }
      const float w0 = cw[ch], w1 = cw[LRU_W + ch], w2 = cw[2 * LRU_W + ch], w3 = cw[3 * LRU_W + ch], cbv = cb[ch];
      float ev[8], bv[8];
#pragma unroll
      for (int rr = 0; rr < 8; ++rr) {
        const float xf = cbv + w0 * xin[rr] + w1 * xin[rr + 1] + w2 * xin[rr + 2] + w3 * xin[rr + 3];
        const float r = sigmoidf_(C[(g8 * 8 + rr) * CLD + j] + bav), ig = sigmoidf_(C[(g8 * 8 + rr) * CLD + 64 + j] + bxv);
        const float a = __expf(cdec * r), e = 1.f - a;
        ev[rr] = e; bv[rr] = sqrtf(e * (2.f - e)) * ig * xf;
      }
      const size_t o = (((size_t)(d * NB + b) * (SEQ / 8) + (s0 >> 3)) * LRU_W + ch) * 8;
      *(u32x4*)(le + o) = pk8(ev); *(u32x4*)(lb + o) = pk8(bv);
    }
  }
};

struct EpiP4 { const float* xres; float* xout; u16* xg;
  DEVI void operator()(const float* C, int m0, int n0) const {
    const int tid = tidx();
#pragma unroll 1
    for (int it = 0; it < 8; ++it) { const int item = it * NTHREADS + tid, row = item >> 4, c8 = (item & 15) * 8, gcol = n0 + c8, grow = m0 + row;
      float v[8], x[8]; ld8(C + row * CLD + c8, v); ld8(xres + (size_t)grow * DM + gcol, x);
#pragma unroll
      for (int j = 0; j < 8; ++j) v[j] += x[j];
      *(f32x4*)(xout + (size_t)grow * DM + gcol) = (f32x4){v[0], v[1], v[2], v[3]}; *(f32x4*)(xout + (size_t)grow * DM + gcol + 4) = (f32x4){v[4], v[5], v[6], v[7]};
      *(u32x4*)(xg + (size_t)grow * DM + gcol) = pk8(v);
    }
  }
};

struct EpiBf16 { u16* o; int ldo;
  DEVI void operator()(const float* C, int m0, int n0) const {
    const int tid = tidx();
#pragma unroll 1
    for (int it = 0; it < 8; ++it) { const int item = it * NTHREADS + tid, row = item >> 4, c8 = (item & 15) * 8;
      float v[8]; ld8(C + row * CLD + c8, v);
      *(u32x4*)(o + (size_t)(m0 + row) * ldo + n0 + c8) = pk8(v);
    }
  }
};

DEVI void ce_desc(float& a, float& b) { const float mx = fmaxf(a, b), mn = fminf(a, b); a = mx; b = mn; }
struct EpiTop { float* top; int hj;
  DEVI void operator()(const float* C, int m0, int) const {
    const int tid = tidx(), row = tid >> 1, part = tid & 1;
    float l[16];
#pragma unroll
    for (int i = 0; i < 16; ++i) l[i] = -3.0e38f;
#pragma unroll 4
    for (int c = 0; c < 64; ++c) { const int col = part * 64 + ((c + row) & 63);
      float v = __uint_as_float((__float_as_uint(C[row * CLD + col]) & ~127u) | (unsigned)(127 - col));
#pragma unroll
      for (int i = 0; i < 16; ++i) { const float t = fmaxf(l[i], v); v = fminf(l[i], v); l[i] = t; } }
    float m[16];
#pragma unroll
    for (int i = 0; i < 16; ++i) m[i] = __shfl_xor(l[15 - i], 1);
#pragma unroll
    for (int i = 0; i < 16; ++i) m[i] = fmaxf(m[i], l[i]);
#pragma unroll
    for (int st = 8; st >= 1; st >>= 1)
#pragma unroll
      for (int i = 0; i < 16; ++i) if ((i & st) == 0) ce_desc(m[i], m[i + st]);
    if (part == 0) { float* o = top + ((size_t)(m0 + row) * 16 + hj) * 16;
#pragma unroll
      for (int i = 0; i < 4; ++i) *(f32x4*)(o + 4 * i) = (f32x4){m[4 * i], m[4 * i + 1], m[4 * i + 2], m[4 * i + 3]}; }
  }
};

#define KSWZ(row, colB) ((row) * 256 + ((colB) ^ (((row) & 15) << 4)))
#define SBAR() __builtin_amdgcn_sched_barrier(0)
constexpr int AT_SHM_V = 64 * 64 * 2, AT_SHM_K = 64 * 128 * 2;
constexpr int AT_LDS = 3 * AT_SHM_V + 2 * AT_SHM_K + 8 * 64 * 4;
constexpr float ATT_THR = 8.f;
DEVI unsigned cvtpk(float lo, float hi) { unsigned r; asm volatile("v_cvt_pk_bf16_f32 %0, %1, %2" : "=v"(r) : "v"(lo), "v"(hi)); return r; }
DEVI int v_st(int k, int c) { const int kk = (k & ~0xC) | ((k & 4) << 1) | ((k & 8) >> 1); return ((kk >> 3) * 2 + (c >> 5)) * 512 + ((kk & 7) * 32 + (c & 31)) * 2; }
DEVI int v_rd_base(int lane) { return ((lane & 3) << 3) | (((lane >> 2) & 3) << 6) | (((lane >> 4) & 1) << 5) | (((lane >> 5) & 1) << 8); }
constexpr int v_rd_off(int d0, int ks, int half) { return d0 * 512 + ks * 2048 + half * 1024; }
template <int OFF> DEVI s16x4 tr_read(int vb) { s16x4 r; asm volatile("ds_read_b64_tr_b16 %0, %1 offset:%2" : "=&v"(r) : "v"(vb), "i"(OFF) : "memory"); return r; }

template <bool MASK>
DEVI void partialSM(f32x16& p0, f32x16& p1, float& m_reg, float& mn, float& alpha, float SCALE, int kpos0, int qpos, int hi) {
  const float C = SCALE * 1.4426950408889634f;
  if (MASK) {
#pragma unroll
    for (int r = 0; r < 16; ++r) { const int k0 = kpos0 + crow(r, hi) - qpos; const int k1 = k0 + 32;
      if (k0 > 128 || k0 < -128) p0[r] = -1e30f;
      if (k1 > 128 || k1 < -128) p1[r] = -1e30f; }
  }
  float pmax = p0[0];
#pragma unroll
  for (int r = 1; r < 16; ++r) pmax = fmaxf(pmax, p0[r]);
#pragma unroll
  for (int r = 0; r < 16; ++r) pmax = fmaxf(pmax, p1[r]);
  { auto rr = __builtin_amdgcn_permlane32_swap(__float_as_uint(pmax), __float_as_uint(pmax), false, false);
    pmax = fmaxf(__uint_as_float(rr[0]), __uint_as_float(rr[1])); }
  if (__builtin_expect(__all(pmax - m_reg <= ATT_THR / SCALE), 1)) { mn = m_reg; alpha = 1.f; }
  else { mn = fmaxf(m_reg, pmax); alpha = __builtin_amdgcn_exp2f((m_reg - mn) * C); m_reg = mn; }
  const float mnC = -mn * C;
#pragma unroll
  for (int r = 0; r < 16; ++r) p0[r] = fmaf(p0[r], C, mnC);
#pragma unroll
  for (int r = 0; r < 16; ++r) p1[r] = fmaf(p1[r], C, mnC);
#pragma unroll
  for (int r = 0; r < 16; ++r) p0[r] = __builtin_amdgcn_exp2f(p0[r]);
}
DEVI void finishSM(f32x16& p0, f32x16& p1, float alpha, float& l_reg, bf16x8& pa0, bf16x8& pa1, bf16x8& pa2, bf16x8& pa3) {
#pragma unroll
  for (int r = 0; r < 16; ++r) p1[r] = __builtin_amdgcn_exp2f(p1[r]);
  float ps = 0;
#pragma unroll
  for (int r = 0; r < 16; ++r) ps += p0[r];
#pragma unroll
  for (int r = 0; r < 16; ++r) ps += p1[r];
  { auto rr = __builtin_amdgcn_permlane32_swap(__float_as_uint(ps), __float_as_uint(ps), false, false);
    ps = __uint_as_float(rr[0]) + __uint_as_float(rr[1]); }
  l_reg = l_reg * alpha + ps;
#define PK4(P, BASE, OUT) do { unsigned a0 = cvtpk(P[BASE + 0], P[BASE + 1]), a1 = cvtpk(P[BASE + 2], P[BASE + 3]);   \
    unsigned b0 = cvtpk(P[BASE + 4], P[BASE + 5]), b1 = cvtpk(P[BASE + 6], P[BASE + 7]);                              \
    auto r0 = __builtin_amdgcn_permlane32_swap(a0, b0, false, false); auto r1 = __builtin_amdgcn_permlane32_swap(a1, b1, false, false); \
    u32x4 w = {r0[0], r1[0], r0[1], r1[1]}; OUT = __builtin_bit_cast(bf16x8, w); } while (0)
  PK4(p0, 0, pa0); PK4(p0, 8, pa1); PK4(p1, 0, pa2); PK4(p1, 8, pa3);
#undef PK4
}
template <int ND0>
DEVI void qkt(f32x16& p0, f32x16& p1, const char* Ks, const bf16x8* qr, int r32, int hi) {
  bf16x8 k0[ND0], k1[ND0];
#pragma unroll
  for (int d0 = 0; d0 < ND0; ++d0) { const int cb = (d0 * 16 + hi * 8) * 2;
    k0[d0] = *(const bf16x8*)(Ks + KSWZ(r32, cb)); k1[d0] = *(const bf16x8*)(Ks + KSWZ(32 + r32, cb)); }
  p0 = f32x16{}; p1 = f32x16{};
#pragma unroll
  for (int d0 = 0; d0 < ND0; ++d0) {
    p0 = __builtin_amdgcn_mfma_f32_32x32x16_bf16(k0[d0], qr[d0], p0, 0, 0, 0);
    p1 = __builtin_amdgcn_mfma_f32_32x32x16_bf16(k1[d0], qr[d0], p1, 0, 0, 0); }
}
template <int D0> DEVI void pv_one(f32x16& od, int vb, bf16x8 pa0, bf16x8 pa1, bf16x8 pa2, bf16x8 pa3) {
  const s16x4 l0 = tr_read<v_rd_off(D0, 0, 0)>(vb), h0 = tr_read<v_rd_off(D0, 0, 1)>(vb), l1 = tr_read<v_rd_off(D0, 1, 0)>(vb), h1 = tr_read<v_rd_off(D0, 1, 1)>(vb);
  const s16x4 l2 = tr_read<v_rd_off(D0, 2, 0)>(vb), h2 = tr_read<v_rd_off(D0, 2, 1)>(vb), l3 = tr_read<v_rd_off(D0, 3, 0)>(vb), h3 = tr_read<v_rd_off(D0, 3, 1)>(vb);
  asm volatile("s_waitcnt lgkmcnt(0)" ::: "memory"); SBAR();
#define PK(L, H) (bf16x8){L[0], L[1], L[2], L[3], H[0], H[1], H[2], H[3]}
  od = __builtin_amdgcn_mfma_f32_32x32x16_bf16(pa0, PK(l0, h0), od, 0, 0, 0);
  od = __builtin_amdgcn_mfma_f32_32x32x16_bf16(pa1, PK(l1, h1), od, 0, 0, 0);
  od = __builtin_amdgcn_mfma_f32_32x32x16_bf16(pa2, PK(l2, h2), od, 0, 0, 0);
  od = __builtin_amdgcn_mfma_f32_32x32x16_bf16(pa3, PK(l3, h3), od, 0, 0, 0);
#undef PK
}
DEVI void pv_d0(f32x16* o, int vb, bf16x8 pa0, bf16x8 pa1, bf16x8 pa2, bf16x8 pa3) {
  const s16x4 a0 = tr_read<v_rd_off(0, 0, 0)>(vb), b0 = tr_read<v_rd_off(0, 0, 1)>(vb), a1 = tr_read<v_rd_off(0, 1, 0)>(vb), b1 = tr_read<v_rd_off(0, 1, 1)>(vb);
  const s16x4 a2 = tr_read<v_rd_off(0, 2, 0)>(vb), b2 = tr_read<v_rd_off(0, 2, 1)>(vb), a3 = tr_read<v_rd_off(0, 3, 0)>(vb), b3 = tr_read<v_rd_off(0, 3, 1)>(vb);
  const s16x4 c0 = tr_read<v_rd_off(1, 0, 0)>(vb), d0 = tr_read<v_rd_off(1, 0, 1)>(vb), c1 = tr_read<v_rd_off(1, 1, 0)>(vb), d1 = tr_read<v_rd_off(1, 1, 1)>(vb);
  const s16x4 c2 = tr_read<v_rd_off(1, 2, 0)>(vb), d2 = tr_read<v_rd_off(1, 2, 1)>(vb), c3 = tr_read<v_rd_off(1, 3, 0)>(vb), d3 = tr_read<v_rd_off(1, 3, 1)>(vb);
  asm volatile("s_waitcnt lgkmcnt(0)" ::: "memory"); SBAR();
#define PK(L, H) (bf16x8){L[0], L[1], L[2], L[3], H[0], H[1], H[2], H[3]}
  o[0] = __builtin_amdgcn_mfma_f32_32x32x16_bf16(pa0, PK(a0, b0), o[0], 0, 0, 0);
  o[1] = __builtin_amdgcn_mfma_f32_32x32x16_bf16(pa0, PK(c0, d0), o[1], 0, 0, 0);
  o[0] = __builtin_amdgcn_mfma_f32_32x32x16_bf16(pa1, PK(a1, b1), o[0], 0, 0, 0);
  o[1] = __builtin_amdgcn_mfma_f32_32x32x16_bf16(pa1, PK(c1, d1), o[1], 0, 0, 0);
  o[0] = __builtin_amdgcn_mfma_f32_32x32x16_bf16(pa2, PK(a2, b2), o[0], 0, 0, 0);
  o[1] = __builtin_amdgcn_mfma_f32_32x32x16_bf16(pa2, PK(c2, d2), o[1], 0, 0, 0);
  o[0] = __builtin_amdgcn_mfma_f32_32x32x16_bf16(pa3, PK(a3, b3), o[0], 0, 0, 0);
  o[1] = __builtin_amdgcn_mfma_f32_32x32x16_bf16(pa3, PK(c3, d3), o[1], 0, 0, 0);
#undef PK
}

template <int DQK, bool MASK>
DEVI void attn_body(const u16* Qw, const u16* Kh, int ldk, const u16* Vh, int ldv, int kt0, int NT, float SCALE, float m_init, float l_init,
                    int qpos, u16* Ow, char* lds, float qrope_pos = 0.f) {
  constexpr int ND0 = DQK / 16, NCK = DQK / 8;
  const int tid = tidx(), wid = __builtin_amdgcn_readfirstlane(tid >> 6), lane = tid & 63, r32 = lane & 31, hi = lane >> 5;
  char* K_lds = lds; char* V_lds = lds + 2 * AT_SHM_K;
  float* wsx = (float*)(lds + 2 * AT_SHM_K + 3 * AT_SHM_V) + wid * 64; float* li_l = wsx; float* al_l = wsx + 32;
  float m_reg = m_init, l_reg = l_init; f32x16 o[2] = {f32x16{}, f32x16{}}; bf16x8 qr[ND0];
#pragma unroll
  for (int d0 = 0; d0 < ND0; ++d0) qr[d0] = *(const bf16x8*)(Qw + d0 * 16);
  if (DQK == 96) {
#pragma unroll
    for (int d0 = 4; d0 < ND0; ++d0) { float v[8]; unpk8(__builtin_bit_cast(u32x4, qr[d0]), v);
#pragma unroll
      for (int q = 0; q < 4; ++q) { const int f = 2 * ((((d0 - 4) * 16 + hi * 8) >> 1) + q); float sn, cs; rope_sc(qrope_pos, f, sn, cs);
        const float x1 = v[2 * q], x2 = v[2 * q + 1]; v[2 * q] = x1 * cs - x2 * sn; v[2 * q + 1] = x2 * cs + x1 * sn; }
      qr[d0] = __builtin_bit_cast(bf16x8, pk8(v)); } }
  unsigned koff[2], voff;
#pragma unroll
  for (int i = 0; i < 2; ++i) { const int row = 4 * (wid + 8 * i) + (lane >> 4), ch = (lane & 15) ^ (row & 15); koff[i] = (unsigned)(row * ldk * 2 + (ch < NCK ? ch : 0) * 16); }
  { const int off = wid * 1024 + lane * 16, sub = off >> 9, kk = ((sub >> 1) << 3) | ((off & 511) >> 6), c = ((sub & 1) << 5) | ((off & 63) >> 1);
    const int k = (kk & ~0xC) | ((kk & 4) << 1) | ((kk & 8) >> 1); voff = (unsigned)(k * ldv * 2 + c * 2); }
  typedef __attribute__((address_space(3))) unsigned lds_u32;
#define DMA(tt_) do { const char* kb_ = (const char*)Kh + (size_t)(kt0 + (tt_)) * 64 * ldk * 2; const char* vb_ = (const char*)Vh + (size_t)(kt0 + (tt_)) * 64 * ldv * 2; \
    char* kd_ = K_lds + ((tt_) & 1) * AT_SHM_K + wid * 1024; char* vd_ = V_lds + ((tt_) % 3) * AT_SHM_V + wid * 1024; \
    __builtin_amdgcn_global_load_lds((const unsigned*)(kb_ + koff[0]), (lds_u32*)kd_, 16, 0, 0); \
    __builtin_amdgcn_global_load_lds((const unsigned*)(kb_ + koff[1]), (lds_u32*)(kd_ + 8192), 16, 0, 0); \
    __builtin_amdgcn_global_load_lds((const unsigned*)(vb_ + voff), (lds_u32*)vd_, 16, 0, 0); } while (0)
#define LANDED() do { asm volatile("s_waitcnt vmcnt(0)" ::: "memory"); __syncthreads(); } while (0)
#define RESC(a) do { if (__any((a) < 1.f)) { if (hi == 0) al_l[r32] = (a); asm volatile("s_waitcnt lgkmcnt(0)" ::: "memory"); \
    _Pragma("unroll") for (int d = 0; d < 2; ++d) _Pragma("unroll") for (int r = 0; r < 16; ++r) o[d][r] *= al_l[crow(r, hi)]; } } while (0)
  const int vb0 = (int)(uintptr_t)V_lds + v_rd_base(lane);
  f32x16 pA0, pA1, pB0, pB1; float mnA, mnB, alA, alB; bf16x8 pa0, pa1, pa2, pa3;
  DMA(0); LANDED();
  DMA(1);
  qkt<ND0>(pA0, pA1, K_lds, qr, r32, hi); partialSM<MASK>(pA0, pA1, m_reg, mnA, alA, SCALE, kt0 * 64, qpos, hi);
  LANDED();
  int vprev = 0;
  for (int tt = 1; tt + 1 < NT; tt += 2) {
    const int v1 = vprev == 2 ? 0 : vprev + 1;
    DMA(tt + 1); SBAR();
    qkt<ND0>(pB0, pB1, K_lds + AT_SHM_K, qr, r32, hi);
    finishSM(pA0, pA1, alA, l_reg, pa0, pa1, pa2, pa3); SBAR();
    pv_d0(o, vb0 + vprev * AT_SHM_V, pa0, pa1, pa2, pa3); partialSM<MASK>(pB0, pB1, m_reg, mnB, alB, SCALE, (kt0 + tt) * 64, qpos, hi);
    RESC(alB); LANDED();
    if (tt + 2 < NT) DMA(tt + 2);
    SBAR();
    qkt<ND0>(pA0, pA1, K_lds, qr, r32, hi);
    finishSM(pB0, pB1, alB, l_reg, pa0, pa1, pa2, pa3); SBAR();
    pv_d0(o, vb0 + v1 * AT_SHM_V, pa0, pa1, pa2, pa3); partialSM<MASK>(pA0, pA1, m_reg, mnA, alA, SCALE, (kt0 + tt + 1) * 64, qpos, hi);
    RESC(alA); LANDED();
    vprev = v1 == 2 ? 0 : v1 + 1;
  }
  { const int v1 = vprev == 2 ? 0 : vprev + 1;
    SBAR(); qkt<ND0>(pB0, pB1, K_lds + AT_SHM_K, qr, r32, hi);
    finishSM(pA0, pA1, alA, l_reg, pa0, pa1, pa2, pa3); SBAR();
    pv_d0(o, vb0 + vprev * AT_SHM_V, pa0, pa1, pa2, pa3); partialSM<MASK>(pB0, pB1, m_reg, mnB, alB, SCALE, (kt0 + NT - 1) * 64, qpos, hi);
    RESC(alB);
    finishSM(pB0, pB1, alB, l_reg, pa0, pa1, pa2, pa3); SBAR();
    pv_d0(o, vb0 + v1 * AT_SHM_V, pa0, pa1, pa2, pa3); }
  if (hi == 0) li_l[r32] = l_reg; asm volatile("s_waitcnt lgkmcnt(0)" ::: "memory");
  float rli[16];
#pragma unroll
  for (int r = 0; r < 16; ++r) rli[r] = __builtin_amdgcn_rcpf(li_l[crow(r, hi)]);
#pragma unroll
  for (int r = 0; r < 16; ++r) { const int orow = crow(r, hi);
#pragma unroll
    for (int d0 = 0; d0 < 2; ++d0) Ow[(size_t)orow * DM + d0 * 32 + r32] = f2bf(o[d0][r] * rli[r]); }
  __syncthreads();
#undef DMA
#undef LANDED
#undef RESC
}

constexpr int LCH = 64, NLCH = SEQ / LCH;
constexpr size_t WS_LP = 1 * MiB, WS_LH = 2560 * 1024;
constexpr size_t WS_LC = 473 * MiB;
constexpr size_t WS_NEED = 478 * MiB;
DEVI void lru_passA(const Params& p, int item, int lane) {
  const int cg = item % 6, c = (item / 6) % NLCH, b = (item / (6 * NLCH)) % NB, d = item / (6 * NLCH * NB);
  const size_t base = (((size_t)(d * NB + b) * (SEQ / 8) + c * 8) * LRU_W + cg * 64 + lane) * 8;
  const u16* E = (const u16*)(p.ws + WS_LE) + base; const u16* Bp = (const u16*)(p.ws + WS_LB) + base;
  u32x4 ev[8], bv[8];
#pragma unroll
  for (int g = 0; g < 8; ++g) { ev[g] = *(const u32x4*)(E + (size_t)g * LRU_W * 8); bv[g] = *(const u32x4*)(Bp + (size_t)g * LRU_W * 8); }
  float h = 0.f, P = 1.f;
#pragma unroll
  for (int gg = 0; gg < 8; ++gg) { const int g = d ? 7 - gg : gg; float e[8], bb[8]; unpk8(ev[g], e); unpk8(bv[g], bb);
#pragma unroll
    for (int rr = 0; rr < 8; ++rr) { const int r = d ? 7 - rr : rr; const float a = 1.f - e[r]; h = fmaf(a, h, bb[r]); P *= a; } }
  const size_t o = ((size_t)(d * NB + b) * NLCH + c) * LRU_W + cg * 64 + lane;
  ((float*)(p.ws + WS_LP))[o] = P; ((float*)(p.ws + WS_LH))[o] = h;
}

DEVI void lru_final(const Params& p, int item, char* lds) {
  const int tid = tidx(), wid = tid >> 6, lane = tid & 63;
  const int c = item % NLCH, b = item / NLCH;
  float* obuf = (float*)lds;
  if (wid < 6) {
    const int ch = wid * 64 + lane;
#pragma unroll
    for (int d = 0; d < 2; ++d) {
      const size_t co = ((size_t)(d * NB + b) * NLCH + c) * LRU_W + ch;
      float h = ((const float*)(p.ws + WS_LC))[co];
      const size_t base = (((size_t)(d * NB + b) * (SEQ / 8) + c * 8) * LRU_W + ch) * 8;
      const u16* E = (const u16*)(p.ws + WS_LE) + base; const u16* Bp = (const u16*)(p.ws + WS_LB) + base;
      u32x4 ev[8], bv[8];
#pragma unroll
      for (int g = 0; g < 8; ++g) { ev[g] = *(const u32x4*)(E + (size_t)g * LRU_W * 8); bv[g] = *(const u32x4*)(Bp + (size_t)g * LRU_W * 8); }
      if (d == 0) {
#pragma unroll
        for (int g = 0; g < 8; ++g) { float e[8], bb[8]; unpk8(ev[g], e); unpk8(bv[g], bb);
#pragma unroll
          for (int r = 0; r < 8; ++r) { h = fmaf(1.f - e[r], h, bb[r]); obuf[(g * 8 + r) * LRU_W + ch] = h; } }
      } else {
        const u16* gp = (const u16*)(p.ws + WS_R1) + ((size_t)b * SEQ + c * LCH) * INWP + PC_LG + ch;
#pragma unroll
        for (int g = 7; g >= 0; --g) { float e[8], bb[8]; unpk8(ev[g], e); unpk8(bv[g], bb);
#pragma unroll
          for (int r = 7; r >= 0; --r) { h = fmaf(1.f - e[r], h, bb[r]); const int tk = g * 8 + r;
            const float gt = bf2f(gp[(size_t)tk * INWP]); obuf[tk * LRU_W + ch] = (obuf[tk * LRU_W + ch] + h) * gelu_erf(gt); } }
      }
    }
  }
  __syncthreads();
  u16* mp = (u16*)(p.ws + WS_MIX) + ((size_t)b * SEQ + c * LCH) * DM + 384;
#pragma unroll 1
  for (int i = 0; i < 8; ++i) { const int tk = wid * 8 + i;
    float v[6]; float s = 0.f;
#pragma unroll
    for (int q = 0; q < 3; ++q) { const f32x2 t2 = *(const f32x2*)(obuf + tk * LRU_W + q * 128 + lane * 2); v[2 * q] = t2.x; v[2 * q + 1] = t2.y; s = fmaf(t2.x, t2.x, s); s = fmaf(t2.y, t2.y, s); }
    s = wave_sum(s);
    const float rs = rsqrtf(s * (1.f / 384.f) + EPS);
#pragma unroll
    for (int q = 0; q < 3; ++q) *(unsigned*)(mp + (size_t)tk * DM + q * 128 + lane * 2) = pk2(v[2 * q] * rs, v[2 * q + 1] * rs);
  }
  __syncthreads();
}

DEVI void peer_xn_pass(const Params& p, int layer, int vb, int nb) {
  const int tid = tidx(), wid = tid >> 6, lane = tid & 63; u16* xg = (u16*)(p.ws + WS_XG); const float* gf = p.norm_ffn + layer * DM;
  for (int t = vb * 8 + wid; t < T; t += nb * 8) {
    u32x4* rp = (u32x4*)(xg + (size_t)t * DM + lane * 16);
    float v[16]; unpk8(rp[0], v); unpk8(rp[1], v + 8);
    float s = 0.f;
#pragma unroll
    for (int i = 0; i < 16; ++i) s = fmaf(v[i], v[i], s);
    s = wave_sum(s);
    const float rs = rsqrtf(s * (1.f / DM) + EPS);
    float g[16]; ld8(gf + lane * 16, g); ld8(gf + lane * 16 + 8, g + 8);
#pragma unroll
    for (int i = 0; i < 16; ++i) v[i] *= rs * g[i];
    rp[0] = pk8(v); rp[1] = pk8(v + 8);
  }
}

typedef unsigned char u8;
DEVI void cvt16(u32x4 w, float* f) {
  f32x2 t;
  t = __builtin_amdgcn_cvt_pk_f32_fp8((int)w.x, false); f[0] = t.x; f[1] = t.y; t = __builtin_amdgcn_cvt_pk_f32_fp8((int)w.x, true); f[2] = t.x; f[3] = t.y;
  t = __builtin_amdgcn_cvt_pk_f32_fp8((int)w.y, false); f[4] = t.x; f[5] = t.y; t = __builtin_amdgcn_cvt_pk_f32_fp8((int)w.y, true); f[6] = t.x; f[7] = t.y;
  t = __builtin_amdgcn_cvt_pk_f32_fp8((int)w.z, false); f[8] = t.x; f[9] = t.y; t = __builtin_amdgcn_cvt_pk_f32_fp8((int)w.z, true); f[10] = t.x; f[11] = t.y;
  t = __builtin_amdgcn_cvt_pk_f32_fp8((int)w.w, false); f[12] = t.x; f[13] = t.y; t = __builtin_amdgcn_cvt_pk_f32_fp8((int)w.w, true); f[14] = t.x; f[15] = t.y;
}
DEVI unsigned enc4(float a, float b, float c, float d) { int w = 0; w = __builtin_amdgcn_cvt_pk_fp8_f32(a, b, w, false); w = __builtin_amdgcn_cvt_pk_fp8_f32(c, d, w, true); return (unsigned)w; }
#define EIDX_AT(i0, i1, i) ((((i) < 8 ? (i0) : (i1))[((i) & 7) >> 1] >> (((i) & 1) * 16)) & 0xffffu)
template <int CTRL> DEVI float dppf(float v) { return __uint_as_float((unsigned)__builtin_amdgcn_mov_dpp((int)__float_as_uint(v), CTRL, 0xF, 0xF, true)); }
DEVI f32x2 fma2(f32x2 a, f32x2 b, f32x2 c) { return __builtin_elementwise_fma(a, b, c); }
DEVI f32x2 cvt8lo(unsigned w) { return __builtin_amdgcn_cvt_pk_f32_fp8((int)w, false); }
DEVI f32x2 cvt8hi(unsigned w) { return __builtin_amdgcn_cvt_pk_f32_fp8((int)w, true); }
struct PeerIdx { u32x4 i0, i1; };
template <bool AXPY>
DEVI void peer_slice_phase(const Params& p, int s, int tbeg, int tstep, int lane, const float* xin, float* xout, bool last) {
  const int r = lane >> 3, j = lane & 7;
  const u8* eidxB = (const u8*)(p.ws + WS_EIDX); const unsigned eoff = (unsigned)r * 32u;
  const u8* TBs = (const u8*)(p.ws + (AXPY ? WS_VB : WS_UB)) + (size_t)s * NEXP * 128; const unsigned toff = 16u * (unsigned)j;
  const u8* xnB = (const u8*)(p.ws + WS_XG) + s * 256; const unsigned xoff = 32u * (unsigned)j;
  const u8* ccB = (const u8*)(p.ws + WS_CC); const unsigned coff = (unsigned)r * 32u;
  float* pdB = (float*)(p.ws + WS_PD) + (size_t)s * T * 128;
  const int ntok = (T - tbeg + tstep - 1) / tstep;
  if (ntok <= 0) return;
#define TOK(k) (tbeg + ((k) < ntok ? (k) : ntok - 1) * tstep)
#define LD_IDX(dst, k) do { const u8* b_ = eidxB + (size_t)TOK(k) * 256; dst.i0 = *(const u32x4*)(b_ + eoff); dst.i1 = *(const u32x4*)(b_ + eoff + 16u); } while (0)
#define LD_HALF(H, ix, h) do { _Pragma("unroll") for (int i = 0; i < 8; ++i) H[i] = *(const u32x4*)(TBs + (EIDX_AT(ix.i0, ix.i1, 8 * (h) + i) * 128u + toff)); } while (0)
#define LD_AUX(a, k) do { if (AXPY) { const u8* b_ = ccB + (size_t)TOK(k) * 256; a[0] = *(const u32x4*)(b_ + coff); a[1] = *(const u32x4*)(b_ + coff + 16u); } \
    else { const u8* b_ = xnB + (size_t)TOK(k) * (DM * 2); a[0] = *(const u32x4*)(b_ + xoff); a[1] = *(const u32x4*)(b_ + xoff + 16u); } } while (0)
  PeerIdx I0, I1, I2; u32x4 H0[8], H1[8], H2[8], X0[2], X1[2], X2[2];
  float av[16];
  f32x2 acc[8];
#define T_BEGIN(X) do { unpk8(X[0], av); unpk8(X[1], av + 8); if (AXPY) { _Pragma("unroll") for (int q = 0; q < 8; ++q) acc[q] = (f32x2){0.f, 0.f}; } } while (0)
#define COMP(H, h, k) do { if ((k) < ntok) { \
    if (!AXPY) { float* o_ = pdB + (size_t)(tbeg + (k) * tstep) * 128 + r * 16 + 8 * (h); \
      _Pragma("unroll") for (int g = 0; g < 2; ++g) { float res[4]; \
        _Pragma("unroll") for (int ii = 0; ii < 4; ++ii) { const u32x4 w_ = H[4 * g + ii]; f32x2 a = {0.f, 0.f}; \
          a = fma2(cvt8lo(w_.x), (f32x2){av[0], av[1]}, a); a = fma2(cvt8hi(w_.x), (f32x2){av[2], av[3]}, a); a = fma2(cvt8lo(w_.y), (f32x2){av[4], av[5]}, a); a = fma2(cvt8hi(w_.y), (f32x2){av[6], av[7]}, a); \
          a = fma2(cvt8lo(w_.z), (f32x2){av[8], av[9]}, a); a = fma2(cvt8hi(w_.z), (f32x2){av[10], av[11]}, a); a = fma2(cvt8lo(w_.w), (f32x2){av[12], av[13]}, a); a = fma2(cvt8hi(w_.w), (f32x2){av[14], av[15]}, a); \
          float v = a.x + a.y; v += dppf<0xB1>(v); v += dppf<0x4E>(v); v += dppf<0x141>(v); res[ii] = v; } \
        if (j == 0) *(f32x4*)(o_ + 4 * g) = (f32x4){res[0], res[1], res[2], res[3]}; } } \
    else { _Pragma("unroll") for (int i = 0; i < 8; ++i) { const u32x4 w_ = H[i]; const float ci = av[8 * (h) + i]; const f32x2 c2 = {ci, ci}; \
        acc[0] = fma2(cvt8lo(w_.x), c2, acc[0]); acc[1] = fma2(cvt8hi(w_.x), c2, acc[1]); acc[2] = fma2(cvt8lo(w_.y), c2, acc[2]); acc[3] = fma2(cvt8hi(w_.y), c2, acc[3]); \
        acc[4] = fma2(cvt8lo(w_.z), c2, acc[4]); acc[5] = fma2(cvt8hi(w_.z), c2, acc[5]); acc[6] = fma2(cvt8lo(w_.w), c2, acc[6]); acc[7] = fma2(cvt8hi(w_.w), c2, acc[7]); } } } } while (0)
  auto finalize = [&](int k) {
    if (!AXPY || k >= ntok) return;
    const int t = tbeg + k * tstep;
    float S[8];
#pragma unroll
    for (int q = 0; q < 8; ++q) { const float A = acc[q >> 1][q & 1], B = acc[(q + 8) >> 1][q & 1];
      auto rr = __builtin_amdgcn_permlane32_swap(__float_as_uint(A), __float_as_uint(B), false, false); S[q] = __uint_as_float(rr[0]) + __uint_as_float(rr[1]); }
    float Tq[4];
#pragma unroll
    for (int q = 0; q < 4; ++q) { auto rr = __builtin_amdgcn_permlane16_swap(__float_as_uint(S[q]), __float_as_uint(S[q + 4]), false, false); Tq[q] = __uint_as_float(rr[0]) + __uint_as_float(rr[1]); }
#pragma unroll
    for (int q = 0; q < 4; ++q) Tq[q] += dppf<0x128>(Tq[q]);
    float ss = 0.f;
    if ((lane & 8) == 0) {
      const size_t o = (size_t)t * DM + s * 128 + 16 * j + ((lane >> 5) & 1) * 8 + ((lane >> 4) & 1) * 4;
      const f32x4 x = *(const f32x4*)(xin + o);
      const f32x4 y = {x.x + Tq[0], x.y + Tq[1], x.z + Tq[2], x.w + Tq[3]};
      *(f32x4*)(xout + o) = y;
      if (!last) *(u32x2*)((u16*)(p.ws + WS_XG) + o) = (u32x2){pk2(y.x, y.y), pk2(y.z, y.w)};
      ss = (y.x * y.x + y.y * y.y) + (y.z * y.z + y.w * y.w);
    }
    ss = wave_sum(ss); if (lane == 0) ((float*)(p.ws + WS_SSQ))[(size_t)t * 8 + s] = ss;
  };
  LD_IDX(I0, 0); LD_IDX(I1, 1); LD_IDX(I2, 2); LD_HALF(H0, I0, 0); LD_HALF(H1, I0, 1); LD_AUX(X0, 0);
#pragma unroll 2
  for (int k = 0; k < ntok; k += 3) {
    LD_HALF(H2, I1, 0); LD_IDX(I0, k + 3); LD_AUX(X1, k + 1);
    T_BEGIN(X0); COMP(H0, 0, k);
    LD_HALF(H0, I1, 1);
    COMP(H1, 1, k); finalize(k);
    LD_HALF(H1, I2, 0); LD_IDX(I1, k + 4); LD_AUX(X2, k + 2);
    T_BEGIN(X1); COMP(H2, 0, k + 1);
    LD_HALF(H2, I2, 1);
    COMP(H0, 1, k + 1); finalize(k + 1);
    LD_HALF(H0, I0, 0); LD_IDX(I2, k + 5); LD_AUX(X0, k + 3);
    T_BEGIN(X2); COMP(H1, 0, k + 2);
    LD_HALF(H1, I0, 1);
    COMP(H2, 1, k + 2); finalize(k + 2);
  }
#undef TOK
#undef LD_IDX
#undef LD_HALF
#undef LD_AUX
#undef T_BEGIN
#undef COMP
}

DEVI void lru_passB(const Params& p, int item, int lane) {
  const int cg = item % 6, b = (item / 6) % NB, d = item / (6 * NB);
  const size_t o = (size_t)(d * NB + b) * NLCH * LRU_W + cg * 64 + lane;
  const float* Pp = (const float*)(p.ws + WS_LP) + o; const float* Hp = (const float*)(p.ws + WS_LH) + o; float* Cp = (float*)(p.ws + WS_LC) + o;
  float h = 0.f;
#pragma unroll 1
  for (int c0 = 0; c0 < NLCH; c0 += 32) {
    float pv[32], hv[32];
#pragma unroll
    for (int i = 0; i < 32; ++i) { const int cc = d ? NLCH - 1 - (c0 + i) : c0 + i; pv[i] = Pp[(size_t)cc * LRU_W]; hv[i] = Hp[(size_t)cc * LRU_W]; }
#pragma unroll
    for (int i = 0; i < 32; ++i) { const int cc = d ? NLCH - 1 - (c0 + i) : c0 + i; Cp[(size_t)cc * LRU_W] = h; h = fmaf(pv[i], h, hv[i]); }
  }
}

DEVI void swa_item(const Params& p, int layer, int item, char* lds) {
  const int tid = tidx(), wid = tid >> 6, lane = tid & 63, r32 = lane & 31, hi = lane >> 5;
  const int g = item & 1, n = (item >> 1) & 63, b = item >> 7;
  const int hq = 2 * g + (wid >> 2), qrow = n * 128 + (wid & 3) * 32;
  const u16* proj = (const u16*)(p.ws + WS_R1);
  const u16* Qw = proj + (size_t)(b * SEQ + qrow + r32) * INWP + PC_SQ + hq * 64 + hi * 8;
  const u16* Kh = proj + (size_t)(b * SEQ) * INWP + PC_SK + g * 64;
  const u16* Vh = proj + (size_t)(b * SEQ) * INWP + PC_SV + g * 64;
  const int kt0 = (2 * n - 2) < 0 ? 0 : (2 * n - 2), kt1 = (2 * n + 4) > SEQ / 64 ? SEQ / 64 : (2 * n + 4);
  const float sink = p.swa_sink[layer * 4 + hq];
  u16* Ow = (u16*)(p.ws + WS_MIX) + (size_t)(b * SEQ + qrow) * DM + 768 + hq * 64;
  attn_body<64, true>(Qw, Kh, INWP, Vh, INWP, kt0, kt1 - kt0, 0.125f, sink * 8.f, 1.f, qrow + r32, Ow, lds);
}
DEVI void mla_item(const Params& p, int pair, int qb, char* lds) {
  const int tid = tidx(), wid = tid >> 6, lane = tid & 63, r32 = lane & 31, hi = lane >> 5;
  const int b = pair / MLA_H, h = pair - b * MLA_H;
  const u16* Qw = (const u16*)(p.ws + WS_QM) + ((size_t)pair * SEQ + qb * 256 + wid * 32 + r32) * MLA_QK + hi * 8;
  const u16* Kh = (const u16*)(p.ws + WS_KM) + (size_t)pair * SEQ * MLA_QK;
  const u16* Vh = (const u16*)(p.ws + WS_VM) + (size_t)pair * SEQ * MLA_V;
  u16* Ow = (u16*)(p.ws + WS_MIX) + (size_t)(b * SEQ + qb * 256 + wid * 32) * DM + h * 64;
  attn_body<96, false>(Qw, Kh, MLA_QK, Vh, MLA_V, 0, SEQ / 64, 0.10206207261596575f, -1e30f, 0.f, 0, Ow, lds, (float)p.pos[b * SEQ + qb * 256 + wid * 32 + r32]);
}


namespace pg8 {
#define PG8_LAS __attribute__((address_space(3)))
constexpr int BM = 256, BK = 64, HALF = 128, HTB = HALF * BK * 2, NXCD = 8, WGM = 8;
DEVI int lds_byte(int r, int c) { const int st = (r >> 4) * 2 + (c >> 5), rr = r & 15, cc = c & 31, ob = rr * 64 + cc * 2; return st * 1024 + (ob ^ (((ob >> 9) & 1) << 5)); }
DEVI void stage_rc(int b, int& R, int& C) { const int st = b / 1024, sb = b % 1024, swz = sb ^ (((sb >> 9) & 1) << 5); R = (st >> 1) * 16 + swz / 64; C = (st & 1) * 32 + (swz % 64) / 2; }
DEVI int perm32(int rho) { const int n = rho >> 4, i = rho & 15; return 8 * (i >> 2) + 4 * n + (i & 3); }
struct Unit { int pm, pn; };
struct Gemm { const u16* A; const u16* Bt; int M, N, K, lda, ldb; };
struct StaticOrder {
  int nM, nN, nwg, G, c;
  DEVI void init(int M, int N, int G_, int c_) { nM = M / BM; nN = N / BM; nwg = nM * nN; G = G_; c = c_; }
  DEVI bool next(int i, Unit& u) const {
    const long L = (long)i * G + c; if (L >= nwg) return false;
    int wgid = (int)L; { const int q = nwg / NXCD, r = nwg % NXCD, xcd = wgid % NXCD, off = wgid / NXCD; wgid = (xcd < r ? xcd * (q + 1) : r * (q + 1) + (xcd - r) * q) + off; }
    const int nig = WGM * nN, gid = wgid / nig, fm = gid * WGM, gsz = (nM - fm) < WGM ? (nM - fm) : WGM;
    u.pm = fm + ((wgid % nig) % gsz); u.pn = (wgid % nig) / gsz; return true;
  }
};
template <class Epi>
DEVI void gemm_phase(PG8_LAS unsigned char* lds, const Gemm g, const StaticOrder& S, const Epi& E) {
  const int tid = tidx(), wid = __builtin_amdgcn_readfirstlane(tid >> 6), lane = tid & 63, wr = wid >> 2, wc = wid & 3, fr = lane & 15, fq = lane >> 4;
  const int K = g.K; int nt = K / BK; asm volatile("" : "+s"(nt));
  unsigned voffA[2], voffB[2];
#pragma unroll
  for (int i = 0; i < 2; ++i) { int R, C; stage_rc(tid * 16 + i * 8192, R, C); const int Rb = (R & ~31) + perm32(R & 31);
    voffA[i] = (unsigned)(R * g.lda + C) * 2u; voffB[i] = (unsigned)(Rb * g.ldb + C) * 2u; }
  const size_t kstep = (size_t)(BK * 2), hstepA = (size_t)HALF * g.lda * 2, hstepB = (size_t)HALF * g.ldb * 2, tstepA = 2 * hstepA, tstepB = 2 * hstepB;
  const unsigned ldsw = (unsigned)wid * 1024u;
  const int aoff = lds_byte(wr * 64 + fr, fq * 8), boff = lds_byte(wc * 32 + fr, fq * 8);
#define PG8_SA(b, h) (((b) * 2 + (h)) * HTB)
#define PG8_SB(b, h) ((4 + (b) * 2 + (h)) * HTB)
#define PG8_STAGE(bufoff, gbase, voff) do { _Pragma("unroll") for (int _i = 0; _i < 2; ++_i) \
    __builtin_amdgcn_global_load_lds((const unsigned*)((const char*)(gbase) + (voff)[_i]), (PG8_LAS unsigned*)(lds + (bufoff) + ldsw + _i * 8192), 16, 0, 0); } while (0)
#define PG8_LDA(dst, b, h) do { _Pragma("unroll") for (int m = 0; m < 4; ++m) _Pragma("unroll") for (int k = 0; k < 2; ++k) dst[m][k] = *(const PG8_LAS bf16x8*)(lds + PG8_SA(b, h) + aoff + m * 2048 + k * 1024); } while (0)
#define PG8_LDB(dst, b, h) do { _Pragma("unroll") for (int n = 0; n < 2; ++n) _Pragma("unroll") for (int k = 0; k < 2; ++k) dst[n][k] = *(const PG8_LAS bf16x8*)(lds + PG8_SB(b, h) + boff + n * 2048 + k * 1024); } while (0)
#define PG8_MMA(ai, bj, At, Bt) do { __builtin_amdgcn_s_setprio(1); _Pragma("unroll") for (int m = 0; m < 4; ++m) _Pragma("unroll") for (int n = 0; n < 2; ++n) _Pragma("unroll") for (int k = 0; k < 2; ++k) \
    acc[ai][bj][m][n] = __builtin_amdgcn_mfma_f32_16x16x32_bf16(Bt[n][k], At[m][k], acc[ai][bj][m][n], 0, 0, 0); __builtin_amdgcn_s_setprio(0); } while (0)
#define PG8_WAIT_V(n) asm volatile("s_waitcnt vmcnt(" #n ")" ::: "memory")
#define PG8_WAIT_L(n) asm volatile("s_waitcnt lgkmcnt(" #n ")" ::: "memory")
#define PG8_BAR __builtin_amdgcn_s_barrier()
#define PG8_SCHED __builtin_amdgcn_sched_barrier(0)
  Unit cur, nxt; int ui = 0;
  if (!S.next(0, cur)) return;
  f32x4 acc[2][2][4][2];
#pragma unroll
  for (int a = 0; a < 2; ++a)
#pragma unroll
    for (int b = 0; b < 2; ++b)
#pragma unroll
      for (int m = 0; m < 4; ++m)
#pragma unroll
        for (int n = 0; n < 2; ++n) acc[a][b][m][n] = (f32x4){0.f, 0.f, 0.f, 0.f};
  bf16x8 At[4][2], B0[2][2], B1[2][2];
  const char* cA = (const char*)g.A + (size_t)cur.pm * tstepA; const char* cB = (const char*)g.Bt + (size_t)cur.pn * tstepB;
  PG8_STAGE(PG8_SB(0, 0), cB, voffB); PG8_STAGE(PG8_SB(0, 1), cB + hstepB, voffB); PG8_STAGE(PG8_SA(0, 0), cA, voffA); PG8_STAGE(PG8_SA(0, 1), cA + hstepA, voffA);
  if (wr == 1) PG8_BAR;
  PG8_WAIT_V(2); PG8_BAR;
  PG8_STAGE(PG8_SB(1, 0), cB + kstep, voffB); PG8_STAGE(PG8_SA(1, 0), cA + kstep, voffA); PG8_STAGE(PG8_SB(1, 1), cB + hstepB + kstep, voffB);
  PG8_WAIT_V(6); PG8_BAR;
  for (;;) {
    const bool has_next = S.next(ui + 1, nxt);
    const char* nA = has_next ? (const char*)g.A + (size_t)nxt.pm * tstepA : cA; const char* nB = has_next ? (const char*)g.Bt + (size_t)nxt.pn * tstepB : cB;
#pragma unroll 1
    for (int t = 0; t < nt; t += 2) {
      const bool last = (t == nt - 2);
      const char* a1 = cA + (size_t)(t + 1) * kstep;
      const char* a2 = last ? nA : cA + (size_t)(t + 2) * kstep; const char* b2 = last ? nB : cB + (size_t)(t + 2) * kstep;
      const char* a3 = a2 + kstep; const char* b3 = b2 + kstep;
      PG8_LDB(B0, 0, 0); PG8_LDB(B1, 0, 1); PG8_SCHED; PG8_LDA(At, 0, 0); PG8_STAGE(PG8_SA(1, 1), a1 + hstepA, voffA);
      PG8_WAIT_V(8); PG8_WAIT_L(0); PG8_BAR; PG8_MMA(0, 0, At, B0); PG8_MMA(0, 1, At, B1); PG8_BAR; PG8_SCHED;
      PG8_LDA(At, 0, 1); PG8_STAGE(PG8_SB(0, 0), b2, voffB); PG8_STAGE(PG8_SB(0, 1), b2 + hstepB, voffB); PG8_STAGE(PG8_SA(0, 0), a2, voffA);
      PG8_WAIT_V(8); PG8_WAIT_L(0); PG8_BAR; PG8_MMA(1, 0, At, B0); PG8_MMA(1, 1, At, B1); PG8_BAR; PG8_SCHED;
      PG8_LDB(B0, 1, 0); PG8_LDB(B1, 1, 1); PG8_SCHED; PG8_LDA(At, 1, 0); PG8_STAGE(PG8_SA(0, 1), a2 + hstepA, voffA);
      PG8_WAIT_V(8); PG8_WAIT_L(0); PG8_BAR; PG8_MMA(0, 0, At, B0); PG8_MMA(0, 1, At, B1); PG8_BAR; PG8_SCHED;
      PG8_LDA(At, 1, 1); PG8_STAGE(PG8_SB(1, 0), b3, voffB); PG8_STAGE(PG8_SB(1, 1), b3 + hstepB, voffB); PG8_STAGE(PG8_SA(1, 0), a3, voffA);
      PG8_WAIT_V(8); PG8_WAIT_L(0); PG8_BAR; PG8_MMA(1, 0, At, B0); PG8_MMA(1, 1, At, B1); PG8_BAR; PG8_SCHED;
    }
    if (wr == 0) PG8_BAR;
    E(acc, cur, wr, wc, fr, fq);
    if (!has_next) break;
#pragma unroll
    for (int a = 0; a < 2; ++a)
#pragma unroll
      for (int b = 0; b < 2; ++b)
#pragma unroll
        for (int m = 0; m < 4; ++m)
#pragma unroll
          for (int n = 0; n < 2; ++n) acc[a][b][m][n] = (f32x4){0.f, 0.f, 0.f, 0.f};
    cur = nxt; cA = nA; cB = nB; ++ui;
    if (wr == 1) PG8_BAR;
  }
  PG8_WAIT_V(0);
  PG8_BAR;
#undef PG8_SA
#undef PG8_SB
#undef PG8_STAGE
#undef PG8_LDA
#undef PG8_LDB
#undef PG8_MMA
#undef PG8_WAIT_V
#undef PG8_WAIT_L
#undef PG8_BAR
#undef PG8_SCHED
}

DEVI float rs_from8(const float* s) { const f32x4 a = *(const f32x4*)s, b = *(const f32x4*)(s + 4); return rsqrtf((((a.x + a.y) + (a.z + a.w)) + ((b.x + b.y) + (b.z + b.w))) * (1.f / DM) + EPS); }
struct EpiProj { u16* proj; const int* pos; const float* ssq8; float* ssqq; float* ssqkv;
  DEVI void operator()(const f32x4 (&acc)[2][2][4][2], const Unit& u, int wr, int wc, int fr, int fq) const {
    const int row0 = u.pm * BM + wr * 64 + fr, col0 = u.pn * BM + wc * 32 + 8 * fq;
#pragma unroll
    for (int ai = 0; ai < 2; ++ai)
#pragma unroll
      for (int m = 0; m < 4; ++m) { const int row = row0 + ai * HALF + m * 16; const float rs = rs_from8(ssq8 + (size_t)row * 8); const float posf = (float)pos[row];
        float sq0 = 0.f, sq1 = 0.f;
#pragma unroll
        for (int bj = 0; bj < 2; ++bj) { const int gcol = col0 + bj * HALF;
          float v[8]; { const f32x4 a = acc[ai][bj][m][0] * rs, b = acc[ai][bj][m][1] * rs; v[0] = a.x; v[1] = a.y; v[2] = a.z; v[3] = a.w; v[4] = b.x; v[5] = b.y; v[6] = b.z; v[7] = b.w; }
          if (u.pn <= 1) { float s = 0.f;
#pragma unroll
            for (int q = 0; q < 8; ++q) s = fmaf(v[q], v[q], s);
            if (bj == 0) sq0 = s; else sq1 = s; }
          const bool r64 = gcol >= PC_SQ && gcol < PC_SV, r32g = gcol >= PC_KR && gcol < PC_KR + 32;
          if (r64 || r32g) {
#pragma unroll
            for (int q = 0; q < 4; ++q) { const int f = r64 ? (((gcol + 2 * q) & 63) >> 1) : 2 * (((gcol + 2 * q) & 31) >> 1); float sn, cs; rope_sc(posf, f, sn, cs);
              const float x1 = v[2 * q], x2 = v[2 * q + 1]; v[2 * q] = x1 * cs - x2 * sn; v[2 * q + 1] = x2 * cs + x1 * sn; } }
          *(u32x4*)(proj + (size_t)row * INWP + gcol) = pk8(v); }
        if (u.pn <= 1) { float s = u.pn == 0 ? sq0 + sq1 : sq0; s += __shfl_xor(s, 16); s += __shfl_xor(s, 32);
          if (fq == 0) (u.pn == 0 ? ssqq : ssqkv)[(size_t)row * 4 + wc] = s; } }
  }
};
struct EpiQ2 { u16* qm; const float* ssqq;
  DEVI void operator()(const f32x4 (&acc)[2][2][4][2], const Unit& u, int wr, int wc, int fr, int fq) const {
    const int b = (u.pm * BM) >> 13, s0 = (u.pm * BM) & (SEQ - 1), lrow = wr * 64 + fr;
    const float* sq = ssqq + (size_t)(u.pm * BM) * 4 + lrow * 4;
    float rs[2][4];
#pragma unroll
    for (int ai = 0; ai < 2; ++ai)
#pragma unroll
      for (int m = 0; m < 4; ++m) { const f32x4 sp = *(const f32x4*)(sq + (ai * HALF + m * 16) * 4); rs[ai][m] = rsqrtf(((sp.x + sp.y) + (sp.z + sp.w)) * (1.f / 256.f) + EPS); }
#pragma unroll
    for (int bj = 0; bj < 2; ++bj) { const int gcol = u.pn * BM + bj * HALF + wc * 32 + 8 * fq;
      if (gcol < 576) { const int head = (gcol * 683) >> 16, j0 = gcol - head * 96;
        u16* base = qm + ((size_t)(b * MLA_H + head) * SEQ + s0) * MLA_QK + (unsigned)(lrow * MLA_QK + j0);
#pragma unroll
        for (int ai = 0; ai < 2; ++ai)
#pragma unroll
          for (int m = 0; m < 4; ++m) { const float r = rs[ai][m];
            float v[8]; { const f32x4 a = acc[ai][bj][m][0] * r, bb = acc[ai][bj][m][1] * r; v[0] = a.x; v[1] = a.y; v[2] = a.z; v[3] = a.w; v[4] = bb.x; v[5] = bb.y; v[6] = bb.z; v[7] = bb.w; }
            *(u32x4*)(base + (ai * HALF + m * 16) * MLA_QK) = pk8(v); } } }
  }
};
struct EpiKV2 { u16* km; u16* vm; const float* ssqkv;
  DEVI void operator()(const f32x4 (&acc)[2][2][4][2], const Unit& u, int wr, int wc, int fr, int fq) const {
    const int b = (u.pm * BM) >> 13, s0 = (u.pm * BM) & (SEQ - 1), lrow = wr * 64 + fr;
    const float* sq = ssqkv + (size_t)(u.pm * BM) * 4 + lrow * 4;
    float rs[2][4];
#pragma unroll
    for (int ai = 0; ai < 2; ++ai)
#pragma unroll
      for (int m = 0; m < 4; ++m) { const f32x4 sp = *(const f32x4*)(sq + (ai * HALF + m * 16) * 4); rs[ai][m] = rsqrtf(((sp.x + sp.y) + (sp.z + sp.w)) * (1.f / 128.f) + EPS); }
#pragma unroll
    for (int bj = 0; bj < 2; ++bj) { const int head = u.pn * 2 + bj, c = wc * 32 + 8 * fq;
      const size_t tok0 = (size_t)(b * MLA_H + head) * SEQ + s0;
      u16* base = c < 64 ? km + tok0 * MLA_QK + (unsigned)(lrow * MLA_QK + c) : vm + tok0 * MLA_V + (unsigned)(lrow * MLA_V + (c - 64));
      const int ld = c < 64 ? MLA_QK : MLA_V;
#pragma unroll
      for (int ai = 0; ai < 2; ++ai)
#pragma unroll
        for (int m = 0; m < 4; ++m) { const float r = rs[ai][m];
          float v[8]; { const f32x4 a = acc[ai][bj][m][0] * r, bb = acc[ai][bj][m][1] * r; v[0] = a.x; v[1] = a.y; v[2] = a.z; v[3] = a.w; v[4] = bb.x; v[5] = bb.y; v[6] = bb.z; v[7] = bb.w; }
          *(u32x4*)(base + (ai * HALF + m * 16) * ld) = pk8(v); } }
  }
};
struct EpiPQ { u16* O; const float* ssq16;
  DEVI void operator()(const f32x4 (&acc)[2][2][4][2], const Unit& u, int wr, int wc, int fr, int fq) const {
    const int row0 = u.pm * BM + wr * 64 + fr, col0 = u.pn * BM + wc * 32 + 8 * fq;
#pragma unroll
    for (int ai = 0; ai < 2; ++ai)
#pragma unroll
      for (int m = 0; m < 4; ++m) { const int row = row0 + ai * HALF + m * 16;
        const f32x4* sp = (const f32x4*)(ssq16 + (size_t)row * 16); const f32x4 s4 = (sp[0] + sp[1]) + (sp[2] + sp[3]);
        const float rs = rsqrtf(((s4.x + s4.y) + (s4.z + s4.w)) * (1.f / DM) + EPS);
#pragma unroll
        for (int bj = 0; bj < 2; ++bj) { float v[8]; { const f32x4 a = acc[ai][bj][m][0] * rs, b = acc[ai][bj][m][1] * rs; v[0] = a.x; v[1] = a.y; v[2] = a.z; v[3] = a.w; v[4] = b.x; v[5] = b.y; v[6] = b.z; v[7] = b.w; }
          *(u32x4*)(O + (size_t)row * 2048 + col0 + bj * HALF) = pk8(v); } }
  }
};
struct EpiRes { const float* xres; float* xout; u16* xg; float* ssq16;
  DEVI void operator()(const f32x4 (&acc)[2][2][4][2], const Unit& u, int wr, int wc, int fr, int fq) const {
    const int row0 = u.pm * BM + wr * 64 + fr, col0 = u.pn * BM + wc * 32 + 8 * fq;
#pragma unroll
    for (int ai = 0; ai < 2; ++ai)
#pragma unroll
      for (int m = 0; m < 4; ++m) { const int row = row0 + ai * HALF + m * 16; float ss = 0.f;
#pragma unroll
        for (int bj = 0; bj < 2; ++bj) { const size_t o = (size_t)row * DM + col0 + bj * HALF;
          float x[8]; ld8(xres + o, x);
          const f32x4 a = acc[ai][bj][m][0], b = acc[ai][bj][m][1];
          x[0] += a.x; x[1] += a.y; x[2] += a.z; x[3] += a.w; x[4] += b.x; x[5] += b.y; x[6] += b.z; x[7] += b.w;
#pragma unroll
          for (int q = 0; q < 8; ++q) ss = fmaf(x[q], x[q], ss);
          *(f32x4*)(xout + o) = (f32x4){x[0], x[1], x[2], x[3]}; *(f32x4*)(xout + o + 4) = (f32x4){x[4], x[5], x[6], x[7]};
          *(u32x4*)(xg + o) = pk8(x); }
        ss += __shfl_xor(ss, 16); ss += __shfl_xor(ss, 32);
        if (fq == 0) ssq16[(size_t)row * 16 + u.pn * 4 + wc] = ss; }
  }
};
}


DEVI void lru_gate_item(const Params& p, int l, int mt, int n, char* lds) {
  const int tid = tidx(), lane = tid & 63, wid = tid >> 6, wm = wid >> 1, wn = wid & 1, r32 = lane & 31, hi = lane >> 5;
  const int srow = tid >> 3, sc = tid & 7, m0 = mt * 256;
  const u16* PROJ = (const u16*)(p.ws + WS_R1);
  GemmDesc g{}; g.proj = PROJ; g.cw = p.conv_w + l * 4 * LRU_W; g.cb = p.conv_b + l * LRU_W; g.ch0 = n * 64;
  char* Ab = lds; char* Bb = lds + 32768;
  { bf16x8 ar[4], br[4];
#pragma unroll
    for (int i = 0; i < 4; ++i) ar[i] = load_a<1>(g, m0 + srow + 64 * i, sc * 8);
    const u16* W = (const u16*)(p.ws + WS_WLRU) + (size_t)((l * 6 + n) * 2) * 128 * 64;
#pragma unroll
    for (int i = 0; i < 4; ++i) br[i] = *(const bf16x8*)(W + (size_t)(srow + 64 * i) * 64 + sc * 8);
#pragma unroll
    for (int i = 0; i < 4; ++i) { *(bf16x8*)(Ab + swz(srow + 64 * i, sc)) = ar[i]; *(bf16x8*)(Bb + (i >> 1) * 16384 + swz(srow + 64 * (i & 1), sc)) = br[i]; } }
  __syncthreads();
  bf16x8 a[2][4];
#pragma unroll
  for (int t = 0; t < 2; ++t)
#pragma unroll
    for (int k = 0; k < 4; ++k) a[t][k] = *(const bf16x8*)(Ab + swz(wm * 64 + t * 32 + r32, k * 2 + hi));
  const int jl = 32 * wn + r32, ch = n * 64 + jl;
  float xf[2][16];
#pragma unroll
  for (int t = 0; t < 2; ++t)
#pragma unroll
    for (int r = 0; r < 16; ++r) { const int row = wm * 64 + t * 32 + crow(r, hi); xf[t][r] = bf2f(*(const u16*)(Ab + swz(row, jl >> 3) + (jl & 7) * 2)); }
  const int bidx = m0 >> 13, s0 = (m0 & (SEQ - 1)) + wm * 64;
#pragma unroll
  for (int d = 0; d < 2; ++d) {
    f32x16 acc[2][2] = {{f32x16{}, f32x16{}}, {f32x16{}, f32x16{}}};
#pragma unroll
    for (int k = 0; k < 4; ++k) { bf16x8 b[2];
#pragma unroll
      for (int q = 0; q < 2; ++q) b[q] = *(const bf16x8*)(Bb + d * 16384 + swz(wn * 64 + q * 32 + r32, k * 2 + hi));
#pragma unroll
      for (int t = 0; t < 2; ++t)
#pragma unroll
        for (int q = 0; q < 2; ++q) acc[t][q] = __builtin_amdgcn_mfma_f32_32x32x16_bf16(a[t][k], b[q], acc[t][q], 0, 0, 0); }
    const float bav = p.lru_ba[((l * 2 + d) * 6 + n) * 64 + jl], bxv = p.lru_bx[((l * 2 + d) * 6 + n) * 64 + jl];
    const float cdec = -8.f * log1pf(__expf(-p.lru_lambda[(l * 2 + d) * LRU_W + ch]));
    u16* le = (u16*)(p.ws + WS_LE); u16* lb = (u16*)(p.ws + WS_LB);
    float runP[2][4], runH[2][4];
#pragma unroll
    for (int t = 0; t < 2; ++t)
#pragma unroll
      for (int rr = 0; rr < 4; ++rr) {
        float ev[4], bv[4];
#pragma unroll
        for (int q = 0; q < 4; ++q) { const int r = rr * 4 + q;
          const float rg = sigmoidf_(acc[t][0][r] + bav), ig = sigmoidf_(acc[t][1][r] + bxv);
          const float aa = __expf(cdec * rg), e = 1.f - aa; ev[q] = e; bv[q] = sqrtf(e * (2.f - e)) * ig * xf[t][r]; }
        const size_t o = (((size_t)(d * NB + bidx) * (SEQ / 8) + ((s0 + 32 * t + 8 * rr) >> 3)) * LRU_W + ch) * 8 + 4 * hi;
        const u32x2 ew = {pk2(ev[0], ev[1]), pk2(ev[2], ev[3])}, bw = {pk2(bv[0], bv[1]), pk2(bv[2], bv[3])};
        *(u32x2*)(le + o) = ew; *(u32x2*)(lb + o) = bw;
        const float a0 = 1.f - bflo(ew.x), a1 = 1.f - bfhi(ew.x), a2 = 1.f - bflo(ew.y), a3 = 1.f - bfhi(ew.y);
        const float b0 = bflo(bw.x), b1 = bfhi(bw.x), b2 = bflo(bw.y), b3 = bfhi(bw.y);
        if (d == 0) { runP[t][rr] = (a0 * a1) * (a2 * a3); runH[t][rr] = fmaf(a3, fmaf(a2, fmaf(a1, b0, b1), b2), b3); }
        else { runP[t][rr] = (a0 * a1) * (a2 * a3); runH[t][rr] = fmaf(a0, fmaf(a1, fmaf(a2, b3, b2), b1), b0); } }
    { float Pc = 1.f, Hc = 0.f;
#pragma unroll
      for (int i = 0; i < 8; ++i) { const int ii = d == 0 ? i : 7 - i, t = ii >> 2, rr = ii & 3;
        auto rp = __builtin_amdgcn_permlane32_swap(__float_as_uint(runP[t][rr]), __float_as_uint(runP[t][rr]), false, false);
        auto rh = __builtin_amdgcn_permlane32_swap(__float_as_uint(runH[t][rr]), __float_as_uint(runH[t][rr]), false, false);
        const float P0 = __uint_as_float(rp[0]), P1 = __uint_as_float(rp[1]), H0 = __uint_as_float(rh[0]), H1 = __uint_as_float(rh[1]);
        if (d == 0) { Hc = fmaf(P0, Hc, H0); Pc *= P0; Hc = fmaf(P1, Hc, H1); Pc *= P1; }
        else { Hc = fmaf(P1, Hc, H1); Pc *= P1; Hc = fmaf(P0, Hc, H0); Pc *= P0; } }
      if (hi == 0) { const size_t o = ((size_t)(d * NB + bidx) * NLCH + (s0 >> 6)) * LRU_W + ch;
        ((float*)(p.ws + WS_LP))[o] = Pc; ((float*)(p.ws + WS_LH))[o] = Hc; } }
  }
  __syncthreads();
}


DEVI void sort16_desc(float (&v)[16]) {
#pragma unroll
  for (int k = 2; k <= 16; k <<= 1)
#pragma unroll
    for (int j = k >> 1; j > 0; j >>= 1)
#pragma unroll
      for (int i = 0; i < 16; ++i) { const int l = i ^ j; if (l > i) { const float a = v[i], b = v[l]; const bool desc = (i & k) == 0;
          v[i] = desc ? fmaxf(a, b) : fminf(a, b); v[l] = desc ? fminf(a, b) : fmaxf(a, b); } }
}
DEVI void merge16_desc(float (&l)[16], const float (&s)[16]) {
#pragma unroll
  for (int i = 0; i < 16; ++i) l[i] = fmaxf(l[i], s[15 - i]);
#pragma unroll
  for (int st = 8; st >= 1; st >>= 1)
#pragma unroll
    for (int i = 0; i < 16; ++i) if ((i & st) == 0) ce_desc(l[i], l[i + st]);
}
DEVI void pair_merge16(float (&l)[16]) {
  float o[16];
#pragma unroll
  for (int i = 0; i < 16; ++i) o[i] = __shfl_xor(l[i], 1);
  merge16_desc(l, o);
}
DEVI void top16_from_C(const float* C, int row, int part, float (&l)[16]) {
#pragma unroll
  for (int i = 0; i < 16; ++i) l[i] = -3.0e38f;
#pragma unroll 1
  for (int bt = 0; bt < 4; ++bt) { float s[16];
#pragma unroll
    for (int i = 0; i < 16; ++i) { const int col = part * 64 + ((bt * 16 + i + row) & 63);
      s[i] = __uint_as_float((__float_as_uint(C[row * CLD + col]) & ~127u) | (unsigned)(127 - col)); }
    sort16_desc(s);
    merge16_desc(l, s); }
  pair_merge16(l);
}
DEVI void peer_route_item(const Params& p, int l, int mt, int h, char* lds) {
  const int tid = tidx(), row = tid >> 1, part = tid & 1, m0 = mt * 256;
  const u16* PQ = (const u16*)(p.ws + WS_R1);
  float t1[16], t2[16];
#pragma unroll
  for (int j = 0; j < 2; ++j) {
    GemmDesc g{}; g.A = PQ + (h * 2 + j) * 128; g.lda = 2048; g.Bt = (const u16*)(p.ws + WS_SUBK) + (size_t)(l * 2 + j) * 128 * 128; g.ldb = 128; g.KT = 2;
    gemm_core<0, 0>(g, m0, 0, lds);
    if (j == 0) top16_from_C((const float*)lds, row, part, t1); else top16_from_C((const float*)lds, row, part, t2);
    __syncthreads(); }
  constexpr int CA[50] = {0, 0, 0, 0, 0, 0, 0, 0, 0, 0, 0, 0, 0, 0, 0, 0, 1, 1, 1, 1, 1, 1, 1, 1, 2, 2, 2, 2, 2, 3, 3, 3, 3, 4, 4, 4, 5, 5, 6, 6, 7, 7, 8, 9, 10, 11, 12, 13, 14, 15};
  constexpr int CB[50] = {0, 1, 2, 3, 4, 5, 6, 7, 8, 9, 10, 11, 12, 13, 14, 15, 0, 1, 2, 3, 4, 5, 6, 7, 0, 1, 2, 3, 4, 0, 1, 2, 3, 0, 1, 2, 0, 1, 0, 1, 0, 1, 0, 0, 0, 0, 0, 0, 0, 0};
  float lo[16], hi2[16];
#pragma unroll
  for (int k = 0; k < 32; ++k) { float v = -3.0e38f;
    if (k < 25) { const float v0 = __uint_as_float((__float_as_uint(t1[CA[2 * k]] + t2[CB[2 * k]]) & ~255u) | (unsigned)(255 - (CA[2 * k] * 16 + CB[2 * k])));
      const float v1 = __uint_as_float((__float_as_uint(t1[CA[2 * k + 1]] + t2[CB[2 * k + 1]]) & ~255u) | (unsigned)(255 - (CA[2 * k + 1] * 16 + CB[2 * k + 1])));
      v = part ? v1 : v0; }
    if (k < 16) lo[k] = v; else hi2[k - 16] = v; }
  sort16_desc(lo); sort16_desc(hi2); merge16_desc(lo, hi2); pair_merge16(lo);
  const float mx = __uint_as_float(__float_as_uint(lo[0]) & ~255u);
  float w[16], sum = 0.f;
#pragma unroll
  for (int i = 0; i < 16; ++i) { w[i] = __expf(__uint_as_float(__float_as_uint(lo[i]) & ~255u) - mx); sum += w[i]; }
  const float inv = 1.f / sum;
  unsigned char* my = (unsigned char*)lds + tid * 32;
#pragma unroll
  for (int i = 0; i < 16; ++i) { my[i] = (unsigned char)(127u - (__float_as_uint(t1[i]) & 127u)); my[16 + i] = (unsigned char)(127u - (__float_as_uint(t2[i]) & 127u)); }
  unsigned ev[8]; float gv[8];
  const unsigned pm = 0u - (unsigned)part;
#pragma unroll
  for (int i = 0; i < 8; ++i) { const unsigned xb = __float_as_uint(lo[i]) ^ ((__float_as_uint(lo[i]) ^ __float_as_uint(lo[8 + i])) & pm); const unsigned code = 255u - (xb & 255u);
    const unsigned wb = __float_as_uint(w[i]) ^ ((__float_as_uint(w[i]) ^ __float_as_uint(w[8 + i])) & pm);
    ev[i] = (unsigned)my[code >> 4] * 128u + (unsigned)my[16 + (code & 15)]; gv[i] = __uint_as_float(wb) * inv; }
  const size_t o = ((size_t)(m0 + row) * 8 + h) * 16 + part * 8;
  *(u32x4*)((u16*)(p.ws + WS_EIDX) + o) = (u32x4){ev[0] | (ev[1] << 16), ev[2] | (ev[3] << 16), ev[4] | (ev[5] << 16), ev[6] | (ev[7] << 16)};
  *(f32x4*)((float*)(p.ws + WS_EGATE) + o) = (f32x4){gv[0], gv[1], gv[2], gv[3]}; *(f32x4*)((float*)(p.ws + WS_EGATE) + o + 4) = (f32x4){gv[4], gv[5], gv[6], gv[7]};
  __syncthreads();
}

constexpr int PH_PER_LAYER = 10, N_PHASES = 2 + DEPTH * PH_PER_LAYER;
DEVI void run_phase(const Params& pin, int ph, int vb, int nb, char* lds) {
  const bool dry = ph >= 100; if (dry) ph -= 100;
  Params p = pin; { size_t z = 0; asm volatile("" : "+s"(z)); p.ws = pin.ws + z; p.out = pin.out + z; } asm volatile("" : "+s"(vb));
  const int tid = tidx(), wid = tid >> 6, lane = tid & 63;
#ifdef ONLY_SP
  if (ONLY_SP >= 0 && ph == 0) return;
#endif
  if (ph == 0) { phase0(p, vb, nb, lds); return; }
  if (ph == N_PHASES - 1) {
    const float* ssq = (const float*)(p.ws + WS_SSQ);
    for (size_t i = (size_t)vb * NTHREADS + tid; i < (size_t)T * DM / 8; i += (size_t)nb * NTHREADS) {
      const size_t t = i >> 7; const int c = (int)(i & 127) * 8;
      float s8[8]; ld8(ssq + t * 8, s8); const float rs = rsqrtf((((s8[0] + s8[1]) + (s8[2] + s8[3])) + ((s8[4] + s8[5]) + (s8[6] + s8[7]))) * (1.f / DM) + EPS);
      float x[8], g[8]; ld8(p.out + i * 8, x); ld8(p.norm_final + c, g);
#pragma unroll
      for (int q = 0; q < 8; ++q) x[q] *= rs * g[q];
      *(f32x4*)(p.out + i * 8) = (f32x4){x[0], x[1], x[2], x[3]}; *(f32x4*)(p.out + i * 8 + 4) = (f32x4){x[4], x[5], x[6], x[7]}; }
    return; }
  const int l = (ph - 1) / PH_PER_LAYER, sp = (ph - 1) % PH_PER_LAYER;
  u16* const XG = (u16*)(p.ws + WS_XG); u16* const PROJ = (u16*)(p.ws + WS_R1); u16* const MIX = (u16*)(p.ws + WS_MIX);
  constexpr int NMT = T / 256;
#ifdef ONLY_SP
  if (sp != ONLY_SP) return;
#endif
  switch (sp) {
  case 0: {
    pg8::Gemm g{XG, (const u16*)(p.ws + WS_WIN) + (size_t)l * INWP * DM, T, INWP, DM, DM, DM}; pg8::StaticOrder S; S.init(T, INWP, nb, vb);
    pg8::EpiProj e{PROJ, p.pos, (const float*)(p.ws + WS_SSQ), (float*)(p.ws + WS_SSQQ), (float*)(p.ws + WS_SSQKV)};
    pg8::gemm_phase((PG8_LAS unsigned char*)lds, g, S, e);
  } break;
  case 1: {
    { pg8::Gemm g{PROJ + PC_CQ, (const u16*)(p.ws + WS_WUQ) + (size_t)l * 768 * 256, T, 768, 256, INWP, 256}; pg8::StaticOrder S; S.init(T, 768, nb, vb);
      pg8::EpiQ2 e{(u16*)(p.ws + WS_QM), (const float*)(p.ws + WS_SSQQ)};
      pg8::gemm_phase((PG8_LAS unsigned char*)lds, g, S, e); }
    { pg8::Gemm g{PROJ + PC_CKV, (const u16*)(p.ws + WS_WUKV) + (size_t)l * 768 * 128, T, 768, 128, INWP, 128}; pg8::StaticOrder S; S.init(T, 768, nb, nb - 1 - vb);
      pg8::EpiKV2 e{(u16*)(p.ws + WS_KM), (u16*)(p.ws + WS_VM), (const float*)(p.ws + WS_SSQKV)};
      pg8::gemm_phase((PG8_LAS unsigned char*)lds, g, S, e); }
    for (int i = vb * NTHREADS + tid; i < T * MLA_H * 4; i += nb * NTHREADS) { const int c = (i & 3) * 8, h = (i >> 2) % MLA_H, row = i / (4 * MLA_H), b = row >> 13, s = row & (SEQ - 1);
      *(u32x4*)((u16*)(p.ws + WS_KM) + ((size_t)(b * MLA_H + h) * SEQ + s) * MLA_QK + 64 + c) = *(const u32x4*)(PROJ + (size_t)row * INWP + PC_KR + c); }
    for (int it = vb; it < NMT * 6; it += nb) lru_gate_item(p, l, it / 6, it % 6, lds);
    for (int it = vb; it < NB * 64 * 2; it += nb) swa_item(p, l, it, lds);
  } break;
  case 2: {
    { const int wi = vb * 8 + wid; if (wi < 48) lru_passB(p, wi, lane); __syncthreads(); }
    for (int k = 0; k * nb + vb < NB * MLA_H * 32; ++k) {
      int pair, qb;
      if (nb == 256) { pair = k * 8 + (vb & 7); qb = vb >> 3; } else { const int it = k * nb + vb; pair = it >> 5; qb = it & 31; }
      mla_item(p, pair, qb, lds);
    }
  } break;
  case 3: {
#ifndef NO_LRUF
    if (!dry) for (int it = vb; it < NB * NLCH; it += nb) lru_final(p, it, lds);
#endif
    for (int t = vb * 8 + wid; t < T; t += nb * 8) {
      u32x4* rp = (u32x4*)(MIX + (size_t)t * DM + lane * 16);
      float v[16]; unpk8(rp[0], v); unpk8(rp[1], v + 8);
      float s = 0.f;
#pragma unroll
      for (int q = 0; q < 16; ++q) s = fmaf(v[q], v[q], s);
      const int sg = lane < 24 ? 0 : (lane < 48 ? 1 : 2);
      const float s0 = wave_sum(sg == 0 ? s : 0.f), s2 = wave_sum(sg == 2 ? s : 0.f);
      const float rs = sg == 0 ? rsqrtf(s0 * (1.f / 384.f) + EPS) : rsqrtf(s2 * (1.f / 256.f) + EPS);
      if (sg != 1) {
#pragma unroll
        for (int q = 0; q < 16; ++q) v[q] *= rs;
        rp[0] = pk8(v); rp[1] = pk8(v + 8); } }
  } break;
  case 4: {
    { pg8::Gemm g{MIX, (const u16*)(p.ws + WS_WOUT) + (size_t)l * DM * DM, T, DM, DM, DM, DM}; pg8::StaticOrder S; S.init(T, DM, nb, vb);
      pg8::EpiRes e{l == 0 ? p.x : p.out, dry ? (float*)(p.ws + WS_R1) : p.out, XG, (float*)(p.ws + WS_SSQ16)};
      pg8::gemm_phase((PG8_LAS unsigned char*)lds, g, S, e); }
    const float* us = p.peer_u + (size_t)l * NEXP * DM; const float* vs = p.peer_v + (size_t)l * NEXP * DM;
    u8* ub = (u8*)(p.ws + WS_UB); u8* vbf = (u8*)(p.ws + WS_VB);
    for (size_t i = (size_t)vb * NTHREADS + tid; i < (size_t)NEXP * 64; i += (size_t)nb * NTHREADS) {
      const size_t e = i >> 6; const int c16 = (int)(i & 63), s = c16 >> 3, cc = (c16 & 7) * 16;
      float a[16], b[16]; ld8(us + i * 16, a); ld8(us + i * 16 + 8, a + 8); ld8(vs + i * 16, b); ld8(vs + i * 16 + 8, b + 8);
#pragma unroll
      for (int q = 0; q < 16; ++q) { a[q] *= PEER_SU; b[q] *= PEER_SV; }
      const size_t o = ((size_t)s * NEXP + e) * 128 + cc;
      *(u32x4*)(ub + o) = (u32x4){enc4(a[0], a[1], a[2], a[3]), enc4(a[4], a[5], a[6], a[7]), enc4(a[8], a[9], a[10], a[11]), enc4(a[12], a[13], a[14], a[15])};
      *(u32x4*)(vbf + o) = (u32x4){enc4(b[0], b[1], b[2], b[3]), enc4(b[4], b[5], b[6], b[7]), enc4(b[8], b[9], b[10], b[11]), enc4(b[12], b[13], b[14], b[15])}; }
  } break;
  case 5: {
    pg8::Gemm g{XG, (const u16*)(p.ws + WS_WQ) + (size_t)l * 2048 * DM, T, 2048, DM, DM, DM}; pg8::StaticOrder S; S.init(T, 2048, nb, vb);
    pg8::EpiPQ e{PROJ, (const float*)(p.ws + WS_SSQ16)};
    pg8::gemm_phase((PG8_LAS unsigned char*)lds, g, S, e);
  } break;
  case 6: {
    for (int it = vb; it < NMT * 8; it += nb) peer_route_item(p, l, it >> 3, it & 7, lds);
    if (!dry) peer_xn_pass(p, l, vb, nb);
  } break;
  case 7: case 9: {
    const bool last = l == DEPTH - 1;
    float* xo = dry ? (float*)(p.ws + WS_PD) : p.out;
    int s0, s1, tb, ts;
    if ((nb & 7) == 0) { s0 = vb & 7; s1 = s0 + 1; tb = (vb >> 3) * 8 + wid; ts = (nb >> 3) * 8; } else { s0 = 0; s1 = 8; tb = vb * 8 + wid; ts = nb * 8; }
#pragma unroll 1
    for (int s = s0; s < s1; ++s) { if (sp == 7) peer_slice_phase<false>(p, s, tb, ts, lane, p.out, xo, last); else peer_slice_phase<true>(p, s, tb, ts, lane, p.out, xo, last); }
  } break;
  case 8: {
    const float* pd = (const float*)(p.ws + WS_PD); const float* eg = (const float*)(p.ws + WS_EGATE); u16* cc = (u16*)(p.ws + WS_CC);
    for (size_t i = (size_t)vb * NTHREADS + tid; i < (size_t)T * 128 / 4; i += (size_t)nb * NTHREADS) {
      f32x4 a = *(const f32x4*)(pd + i * 4);
#pragma unroll
      for (int s = 1; s < 8; ++s) a += *(const f32x4*)(pd + (size_t)s * T * 128 + i * 4);
      const f32x4 g = *(const f32x4*)(eg + i * 4);
      f32x4 o; o.x = gelu_erf(a.x * (1.f / PEER_SU)) * g.x * (1.f / PEER_SV); o.y = gelu_erf(a.y * (1.f / PEER_SU)) * g.y * (1.f / PEER_SV);
      o.z = gelu_erf(a.z * (1.f / PEER_SU)) * g.z * (1.f / PEER_SV); o.w = gelu_erf(a.w * (1.f / PEER_SU)) * g.w * (1.f / PEER_SV);
      *(u32x2*)(cc + i * 4) = (u32x2){pk2(o.x, o.y), pk2(o.z, o.w)}; }
  } break;
  }
}

#define XB_TMO      128
#define XB_XCNT(j)  (256  + 64 * (j))
#define XB_XSUB(j)  (1280 + 64 * (j))
#define XB_XGEN(j)  (2304 + 64 * (j))
#define XB_TOP      3328
#define XB_TOPGEN   3392
#define XCD_BAR_WORDS 3456
#define XB_SPIN_CAP (1u << 23)
DEVI unsigned xb_ld(unsigned* p) { return __hip_atomic_load(p, __ATOMIC_RELAXED, __HIP_MEMORY_SCOPE_AGENT); }
DEVI unsigned xb_add(unsigned* p, unsigned v) { return __hip_atomic_fetch_add(p, v, __ATOMIC_RELAXED, __HIP_MEMORY_SCOPE_AGENT); }
DEVI unsigned xb_xcc_id() { return (unsigned)__builtin_amdgcn_s_getreg((3 << 11) | 20) & 0xFu; }
#define XB_SPIN(cond, bar) do { unsigned _sp = 0; while (cond) { __builtin_amdgcn_s_sleep(1); \
    if ((++_sp & 255u) == 0u) { if (xb_ld(&(bar)[XB_TMO])) break; if (_sp > XB_SPIN_CAP) { atomicAdd(&(bar)[XB_TMO], 1u); break; } } } } while (0)
struct XcdBarrier { unsigned* bar; unsigned x; volatile unsigned* st; };
DEVI XcdBarrier xcd_barrier_post(unsigned* bar, volatile unsigned* st) {
  XcdBarrier b; b.bar = bar; b.x = xb_xcc_id(); b.st = st;
  if (threadIdx.x == 0) (void)xb_add(&bar[XB_XCNT(b.x)], 1u);
  return b;
}
DEVI void xcd_barrier_complete(unsigned* bar, unsigned x, unsigned& nloc, unsigned& nx) {
  const unsigned G = gridDim.x * gridDim.y * gridDim.z;
  unsigned sum, cnt, mine, sp = 0u;
  for (;;) {
    sum = 0u; cnt = 0u; mine = 0u;
#pragma unroll
    for (unsigned j = 0; j < 16; ++j) { const unsigned c = xb_ld(&bar[XB_XCNT(j)]); sum += c; cnt += (c > 0u) ? 1u : 0u; mine = (j == x) ? c : mine; }
    if (sum == G) break;
    __builtin_amdgcn_s_sleep(1);
    if ((++sp & 255u) == 0u) { if (xb_ld(&bar[XB_TMO])) break; if (sp > XB_SPIN_CAP) { atomicAdd(&bar[XB_TMO], 1u); break; } }
  }
  nloc = mine > 0u ? mine : 1u; nx = cnt > 0u ? cnt : 1u;
}
DEVI void xcd_barrier(const XcdBarrier& b) {
  asm volatile("s_waitcnt vmcnt(0)" ::: "memory");
  __syncthreads();
  if (threadIdx.x == 0) {
    unsigned* bar = b.bar;
    __builtin_amdgcn_s_waitcnt(0);
    unsigned nloc = b.st[0], nx = b.st[1];
    if (nloc == 0u) { xcd_barrier_complete(bar, b.x, nloc, nx); b.st[0] = nloc; b.st[1] = nx; }
    const unsigned old = xb_add(&bar[XB_XSUB(b.x)], 1u);
    const unsigned gen = old / nloc;
    if (old + 1u == (gen + 1u) * nloc) {
      __builtin_amdgcn_fence(__ATOMIC_RELEASE, "agent");
      asm volatile("s_waitcnt vmcnt(0)" ::: "memory");
      const unsigned og = xb_add(&bar[XB_TOP], 1u);
      const unsigned tg = og / nx;
      if (og + 1u == (tg + 1u) * nx) xb_add(&bar[XB_TOPGEN], 1u);
      else XB_SPIN(xb_ld(&bar[XB_TOPGEN]) == tg, bar);
      __builtin_amdgcn_fence(__ATOMIC_ACQUIRE, "agent");
      xb_add(&bar[XB_XGEN(b.x)], 1u);
      asm volatile("s_waitcnt vmcnt(0)" ::: "memory");
    } else {
      XB_SPIN(xb_ld(&bar[XB_XGEN(b.x)]) == gen, bar);
      __builtin_amdgcn_fence(__ATOMIC_ACQUIRE, "agent");
      asm volatile("s_waitcnt vmcnt(0)" ::: "memory");
    }
  }
  __syncthreads();
}

__global__ void __launch_bounds__(NTHREADS, 2) mega(Params p) {
  extern __shared__ __attribute__((aligned(16))) char smem[];
  cg::grid_group grid = cg::this_grid();
  const int nb = gridDim.x, vb = blockIdx.x;
  volatile unsigned* st = (volatile unsigned*)(smem + LDS_BYTES - 16);
  if (threadIdx.x == 0) { st[0] = 0u; st[1] = 0u; }
  __syncthreads();
  const XcdBarrier bar = xcd_barrier_post((unsigned*)p.ws, st);
#define GRID_BAR(first) do { if (first) grid.sync(); else xcd_barrier(bar); } while (0)
  for (int ph = p.ph_lo; ph < p.ph_hi; ++ph) {
#ifdef PROBE_DUP
    if (ph > 0 && ph < N_PHASES - 1 && ((PROBE_DUP >> ((ph - 1) % PH_PER_LAYER)) & 1)) { run_phase(p, ph + 100, vb, nb, smem); GRID_BAR(false); }
#endif
    run_phase(p, ph, vb, nb, smem);
    if (ph + 1 < p.ph_hi) GRID_BAR(ph == p.ph_lo);
  }
}

#ifndef N_LAUNCH_SPLIT
#define N_LAUNCH_SPLIT 0
#endif
extern "C" void kernel_launch(void* const* d_in, const int* in_sizes, int n_in, void* d_out, int out_size, void* d_ws, size_t ws_size, hipStream_t stream) {
  static int grid_blocks = 0;
  if (grid_blocks == 0) {
    if (n_in != 24 || out_size != T * DM || ws_size < WS_NEED) { fprintf(stderr, "kernel_launch: unexpected shapes n_in %d out %d ws %zu\n", n_in, out_size, ws_size); grid_blocks = -1; return; }
    int dev = 0, cus = 0, per_cu = 0;
    (void)hipGetDevice(&dev); (void)hipDeviceGetAttribute(&cus, hipDeviceAttributeMultiprocessorCount, dev);
    if (hipFuncSetAttribute((const void*)mega, hipFuncAttributeMaxDynamicSharedMemorySize, LDS_BYTES) != hipSuccess) { fprintf(stderr, "kernel_launch: hipFuncSetAttribute failed\n"); grid_blocks = -1; return; }
    if (hipOccupancyMaxActiveBlocksPerMultiprocessor(&per_cu, (const void*)mega, NTHREADS, LDS_BYTES) != hipSuccess || per_cu < 1) { fprintf(stderr, "kernel_launch: occupancy query failed (%d)\n", per_cu); grid_blocks = -1; return; }
    grid_blocks = cus * 1;
    fprintf(stderr, "kernel_launch: cus %d per_cu %d grid %d\n", cus, per_cu, grid_blocks);
  }
  if (grid_blocks < 0) return;
  if (hipMemsetAsync(d_ws, 0, 65536, stream) != hipSuccess) { fprintf(stderr, "kernel_launch: memset failed\n"); return; }
  Params p{};
  p.x = (const float*)d_in[0]; p.pos = (const int*)d_in[1]; p.norm_mix = (const float*)d_in[2]; p.w_in = (const float*)d_in[3]; p.q_norm = (const float*)d_in[4];
  p.w_uq = (const float*)d_in[5]; p.kv_norm = (const float*)d_in[6]; p.w_ukv = (const float*)d_in[7]; p.conv_w = (const float*)d_in[8]; p.conv_b = (const float*)d_in[9];
  p.lru_wa = (const float*)d_in[10]; p.lru_ba = (const float*)d_in[11]; p.lru_wx = (const float*)d_in[12]; p.lru_bx = (const float*)d_in[13]; p.lru_lambda = (const float*)d_in[14];
  p.swa_sink = (const float*)d_in[15]; p.grp_norm = (const float*)d_in[16]; p.w_out = (const float*)d_in[17]; p.norm_ffn = (const float*)d_in[18]; p.peer_wq = (const float*)d_in[19];
  p.peer_subkeys = (const float*)d_in[20]; p.peer_u = (const float*)d_in[21]; p.peer_v = (const float*)d_in[22]; p.norm_final = (const float*)d_in[23];
  p.out = (float*)d_out; p.ws = (unsigned char*)d_ws;
#if N_LAUNCH_SPLIT
  for (int ph = 0; ph < N_PHASES; ++ph) {
    p.ph_lo = ph; p.ph_hi = ph + 1;
    void* args[] = {&p};
    hipError_t e = hipLaunchCooperativeKernel((const void*)mega, dim3(grid_blocks), dim3(NTHREADS), args, LDS_BYTES, stream);
    if (e != hipSuccess) { fprintf(stderr, "kernel_launch: launch of phase %d failed: %s\n", ph, hipGetErrorString(e)); break; }
  }
#else
  p.ph_lo = 0; p.ph_hi = N_PHASES;
  void* args[] = {&p};
  hipError_t e = hipLaunchCooperativeKernel((const void*)mega, dim3(grid_blocks), dim3(NTHREADS), args, LDS_BYTES, stream);
  if (e != hipSuccess) fprintf(stderr, "kernel_launch: cooperative launch failed: %s (grid %d)\n", hipGetErrorString(e), grid_blocks);
#endif
}
```

```cpp
#include <hip/hip_runtime.h>
#include <hip/hip_cooperative_groups.h>
#include <cstdio>
#include <cstdint>
namespace cg = cooperative_groups;

#define DEVI __device__ __forceinline__
typedef unsigned short u16;
typedef short bf16x8 __attribute__((ext_vector_type(8)));
typedef short s16x4 __attribute__((ext_vector_type(4)));
typedef float f32x2 __attribute__((ext_vector_type(2)));
typedef float f32x4 __attribute__((ext_vector_type(4)));
typedef float f32x16 __attribute__((ext_vector_type(16)));
typedef unsigned u32x4 __attribute__((ext_vector_type(4)));
typedef unsigned u32x2 __attribute__((ext_vector_type(2)));
typedef __bf16 bf16x2_t __attribute__((ext_vector_type(2)));

constexpr int NB = 4, SEQ = 8192, T = NB * SEQ, DM = 1024, DEPTH = 2;
constexpr int MLA_H = 6, MLA_QK = 96, MLA_V = 64;
constexpr int LRU_W = 384;
constexpr int INW = 1696, INWP = 1792;
constexpr int PC_CQ = 0, PC_CKV = 256, PC_SQ = 384, PC_SK = 640, PC_SV = 768, PC_LX = 896, PC_LG = 1280, PC_KR = 1664;
constexpr int OC_CQ = 0, OC_CKV = 256, OC_KR = 384, OC_SQ = 416, OC_SK = 672, OC_SV = 800, OC_LX = 928, OC_LG = 1312;
constexpr int NEXP = 16384;
constexpr float EPS = 1e-6f;
constexpr int NTHREADS = 512;
constexpr int LDS_BYTES = 160 * 1024;

constexpr size_t MiB = 1u << 20;
constexpr size_t WS_CTL = 0;
constexpr size_t WS_WIN = 4 * MiB;
constexpr size_t WS_WQ = 11 * MiB;
constexpr size_t WS_WOUT = 19 * MiB;
constexpr size_t WS_WUQ = 23 * MiB;
constexpr size_t WS_WUKV = WS_WUQ + 2 * 768 * 256 * 2;
constexpr size_t WS_WLRU = WS_WUKV + 2 * 768 * 128 * 2;
constexpr size_t WS_SUBK = WS_WLRU + 2 * 6 * 2 * 128 * 64 * 2;
constexpr size_t WS_XG = 25 * MiB;
constexpr size_t WS_R1 = 89 * MiB;
constexpr size_t WS_QM = 217 * MiB;
constexpr size_t WS_KM = 253 * MiB;
constexpr size_t WS_VM = 289 * MiB;
constexpr size_t WS_LE = 313 * MiB;
constexpr size_t WS_LB = 361 * MiB;
constexpr size_t WS_MIX = 409 * MiB;
constexpr size_t WS_UB = 217 * MiB;
constexpr size_t WS_VB = 233 * MiB;
constexpr size_t WS_TOP = 281 * MiB;
constexpr size_t WS_EIDX = 313 * MiB;
constexpr size_t WS_EGATE = 329 * MiB;
constexpr size_t WS_CC = 345 * MiB;
constexpr size_t WS_SSQ = 361 * MiB;
constexpr size_t WS_SSQ16 = 363 * MiB;
constexpr size_t WS_SSQQ = 476 * MiB;
constexpr size_t WS_SSQKV = 477 * MiB;
constexpr size_t WS_PD = 89 * MiB;
constexpr float PEER_SU = 903.f, PEER_SV = 16.f;
constexpr size_t WS_XQ = 249 * MiB;
constexpr size_t WS_SX = 281 * MiB;
constexpr size_t WS_END = 473 * MiB;

__device__ const float ROPE_HI[32] = {1.591549367e-01f, 1.193493679e-01f, 8.949939907e-02f, 6.711508334e-02f, 5.032921210e-02f, 3.774158657e-02f, 2.830219641e-02f, 2.122365311e-02f, 1.591549441e-02f, 1.193493698e-02f, 8.949940093e-03f, 6.711508147e-03f, 5.032921210e-03f, 3.774158424e-03f, 2.830219688e-03f, 2.122365171e-03f, 1.591549488e-03f, 1.193493721e-03f, 8.949940093e-04f, 6.711508031e-04f, 5.032921326e-04f, 3.774158540e-04f, 2.830219455e-04f, 2.122365258e-04f, 1.591549371e-04f, 1.193493736e-04f, 8.949940093e-05f, 6.711508468e-05f, 5.032921035e-05f, 3.774158540e-05f, 2.830219637e-05f, 2.122365186e-05f};
__device__ const float ROPE_LO[32] = {6.420638243e-09f, 2.294664903e-09f, 2.542919653e-09f, -3.316028840e-10f, 5.173299289e-12f, -1.848551645e-09f, -5.826552019e-10f, -3.431038786e-10f, -1.029942243e-10f, 4.320196978e-11f, 6.802744479e-11f, 1.531042237e-10f, 5.173301024e-13f, 4.797548470e-11f, -1.048316434e-10f, 1.053879969e-10f, -5.686555046e-11f, -1.896286773e-11f, 6.802744999e-12f, 2.695195456e-11f, -1.158979943e-11f, -6.843983713e-12f, 1.279990003e-11f, 1.807650600e-12f, 5.954976963e-12f, -3.351478166e-12f, 6.802744674e-13f, -1.670379113e-12f, 1.751403167e-12f, -6.843983930e-13f, -5.389994549e-13f, 9.083608431e-13f};

DEVI int tidx() { int t = __builtin_amdgcn_workitem_id_x(); asm volatile("" : "+v"(t)); return t; }
DEVI float bf2f(unsigned h) { return __uint_as_float(h << 16); }
DEVI float bflo(unsigned w) { return __uint_as_float(w << 16); }
DEVI float bfhi(unsigned w) { return __uint_as_float(w & 0xffff0000u); }
DEVI unsigned pk2(float lo, float hi) { f32x2 v = {lo, hi}; bf16x2_t b = __builtin_convertvector(v, bf16x2_t); return __builtin_bit_cast(unsigned, b); }
DEVI u16 f2bf(float f) { return (u16)(pk2(f, 0.f) & 0xffffu); }
DEVI u32x4 pk8(const float* v) { u32x4 w; w.x = pk2(v[0], v[1]); w.y = pk2(v[2], v[3]); w.z = pk2(v[4], v[5]); w.w = pk2(v[6], v[7]); return w; }
DEVI void unpk8(u32x4 w, float* v) { v[0] = bflo(w.x); v[1] = bfhi(w.x); v[2] = bflo(w.y); v[3] = bfhi(w.y); v[4] = bflo(w.z); v[5] = bfhi(w.z); v[6] = bflo(w.w); v[7] = bfhi(w.w); }
DEVI void ld8(const float* p, float* v) { const f32x4 a = *(const f32x4*)p, b = *(const f32x4*)(p + 4); v[0] = a.x; v[1] = a.y; v[2] = a.z; v[3] = a.w; v[4] = b.x; v[5] = b.y; v[6] = b.z; v[7] = b.w; }
DEVI int crow(int r, int hi) { return (r & 3) + 8 * (r >> 2) + 4 * hi; }
DEVI float wave_sum(float v) {
#pragma unroll
  for (int o = 1; o < 64; o <<= 1) v += __shfl_xor(v, o);
  return v;
}
DEVI void rope_sc(float pos, int fidx, float& sn, float& cs) {
  const float chi = ROPE_HI[fidx], clo = ROPE_LO[fidx];
  const float t = pos * chi, e = fmaf(pos, chi, -t);
  float fr = t - rintf(t);
  fr = fr + (e + pos * clo);
  sn = __builtin_amdgcn_sinf(fr); cs = __builtin_amdgcn_cosf(fr);
}
DEVI float sigmoidf_(float x) { return 1.f / (1.f + __expf(-x)); }
DEVI float gelu_erf(float x) { return 0.5f * x * (1.f + erff(x * 0.70710678118654752f)); }

struct Params {
  const float* x; const int* pos; const float* norm_mix; const float* w_in; const float* q_norm; const float* w_uq; const float* kv_norm; const float* w_ukv;
  const float* conv_w; const float* conv_b; const float* lru_wa; const float* lru_ba; const float* lru_wx; const float* lru_bx; const float* lru_lambda;
  const float* swa_sink; const float* grp_norm; const float* w_out; const float* norm_ffn; const float* peer_wq; const float* peer_subkeys;
  const float* peer_u; const float* peer_v; const float* norm_final;
  float* out; unsigned char* ws;
  int ph_lo, ph_hi;
};

DEVI void tconv_item(const float* W, int ldw, int src_c0, u16* WT, int K, int dst_r0, const float* gain, float* scr, int kb, int nb, int lane, int pg = 0) {
  const int k0 = 64 * kb, n0 = 32 * nb;
#pragma unroll 8
  for (int i = 0; i < 32; ++i) { const int kk = 2 * i + (lane >> 5); float g = gain ? gain[k0 + kk] : 1.f; scr[kk * 33 + (lane & 31)] = g * W[(size_t)(k0 + kk) * ldw + src_c0 + n0 + (lane & 31)]; }
  __builtin_amdgcn_s_waitcnt(0xc07f); asm volatile("" ::: "memory");
  const int c = lane & 7;
#pragma unroll
  for (int j = 0; j < 4; ++j) { const int n = (lane >> 3) + 8 * j; const float* s = scr + (8 * c) * 33 + n;
    u32x4 o; o.x = pk2(s[0 * 33], s[1 * 33]); o.y = pk2(s[2 * 33], s[3 * 33]); o.z = pk2(s[4 * 33], s[5 * 33]); o.w = pk2(s[6 * 33], s[7 * 33]);
    int nn = n0 + n; if (pg > 0) { const int g = nn & ~(pg - 1), i = nn & (pg - 1), hw = pg >> 1; nn = g + (i < hw ? 2 * i : 2 * (i - hw) + 1); }
    else if (pg < 0) { const int j = nn % 96; if (j >= 64) { const int i = j - 64; nn = nn - i + (i < 16 ? 2 * i : 2 * (i - 16) + 1); } }
    *(u32x4*)(WT + (size_t)(dst_r0 + nn) * K + k0 + 8 * c) = o; }
  __builtin_amdgcn_s_waitcnt(0xc07f); asm volatile("" ::: "memory");
}

DEVI void p0_item(const Params& p, int it, float* scr, int lane) {
  const int l = it / 2552; int r = it - l * 2552;
  const float* win = p.w_in + (size_t)l * DM * INW; u16* wint = (u16*)(p.ws + WS_WIN) + (size_t)l * INWP * DM; const float* gm = p.norm_mix + l * DM;
#define SEG(W, ldw, sc0, ncols, WT, K, dr0, gain, pg) { const int nnb_ = (ncols) / 32, ni_ = ((K) / 64) * nnb_; if (r < ni_) { tconv_item(W, ldw, sc0, WT, K, dr0, gain, scr, r / nnb_, r % nnb_, lane, pg); return; } r -= ni_; }
  SEG(win, INW, OC_CQ, 256, wint, DM, PC_CQ, gm, 0)
  SEG(win, INW, OC_CKV, 128, wint, DM, PC_CKV, gm, 0)
  SEG(win, INW, OC_SQ, 256, wint, DM, PC_SQ, gm, 64)
  SEG(win, INW, OC_SK, 128, wint, DM, PC_SK, gm, 64)
  SEG(win, INW, OC_SV, 128, wint, DM, PC_SV, gm, 0)
  SEG(win, INW, OC_LX, 384, wint, DM, PC_LX, gm, 0)
  SEG(win, INW, OC_LG, 384, wint, DM, PC_LG, gm, 0)
  SEG(win, INW, OC_KR, 32, wint, DM, PC_KR, gm, 32)
  SEG(p.peer_wq + (size_t)l * DM * 2048, 2048, 0, 2048, (u16*)(p.ws + WS_WQ) + (size_t)l * 2048 * DM, DM, 0, p.norm_ffn + l * DM, 0)
  SEG(p.w_out + (size_t)l * DM * DM, DM, 0, DM, (u16*)(p.ws + WS_WOUT) + (size_t)l * DM * DM, DM, 0, p.grp_norm + l * DM, 0)
  SEG(p.w_uq + (size_t)l * 256 * 576, 576, 0, 576, (u16*)(p.ws + WS_WUQ) + (size_t)l * 768 * 256, 256, 0, p.q_norm + l * 256, -1)
  SEG(p.w_ukv + (size_t)l * 128 * 768, 768, 0, 768, (u16*)(p.ws + WS_WUKV) + (size_t)l * 768 * 128, 128, 0, p.kv_norm + l * 128, 0)
#undef SEG
  { const int nbk = r & 1, ax = (r >> 1) & 1, n = (r >> 2) % 6, d = (r >> 2) / 6;
    const float* W = (ax ? p.lru_wx : p.lru_wa) + ((size_t)(l * 2 + d) * 6 + n) * 4096;
    u16* WT = (u16*)(p.ws + WS_WLRU) + ((size_t)((l * 6 + n) * 2 + d)) * 128 * 64;
    tconv_item(W, 64, 0, WT, 64, 32 * nbk + 32 * ax, nullptr, scr, 0, nbk, lane); }
}

DEVI void phase0(const Params& p, int vb, int nb, char* lds) {
  const int tid = tidx(), lane = tid & 63, wid = tid >> 6;
  float* scr = (float*)(lds + wid * 16384);
  const int gw = vb * 8 + wid, ngw = nb * 8;
  for (int it = gw; it < DEPTH * 2552; it += ngw) p0_item(p, it, scr, lane);
  for (int i = vb * NTHREADS + tid; i < DEPTH * 96 * DM / 8; i += nb * NTHREADS) { const int l = i / (96 * DM / 8), r = i % (96 * DM / 8);
    *(u32x4*)((u16*)(p.ws + WS_WIN) + ((size_t)l * INWP + INW) * DM + (size_t)r * 8) = (u32x4){0, 0, 0, 0}; }
  for (int i = vb * NTHREADS + tid; i < DEPTH * 192 * 256 / 8; i += nb * NTHREADS) { const int l = i / (192 * 256 / 8), r = i % (192 * 256 / 8);
    *(u32x4*)((u16*)(p.ws + WS_WUQ) + ((size_t)l * 768 + 576) * 256 + (size_t)r * 8) = (u32x4){0, 0, 0, 0}; }
  for (int i = vb * NTHREADS + tid; i < DEPTH * 2 * 128 * 128 / 8; i += nb * NTHREADS) {
    float a[8]; ld8(p.peer_subkeys + (size_t)i * 8, a);
    *(u32x4*)((u16*)(p.ws + WS_SUBK) + (size_t)i * 8) = pk8(a); }
  { float* ssq = (float*)(p.ws + WS_SSQ); u16* xg = (u16*)(p.ws + WS_XG);
    for (int t = gw * 2; t < T; t += ngw * 2) {
      float a[2][16];
#pragma unroll
      for (int u = 0; u < 2; ++u) { ld8(p.x + (size_t)(t + u) * DM + lane * 16, a[u]); ld8(p.x + (size_t)(t + u) * DM + lane * 16 + 8, a[u] + 8); }
#pragma unroll
      for (int u = 0; u < 2; ++u) { float s = 0.f;
#pragma unroll
        for (int q = 0; q < 16; ++q) s = fmaf(a[u][q], a[u][q], s);
        s += __shfl_xor(s, 1); s += __shfl_xor(s, 2); s += __shfl_xor(s, 4);
        if ((lane & 7) == 0) ssq[(size_t)(t + u) * 8 + (lane >> 3)] = s;
        u32x4* o = (u32x4*)(xg + (size_t)(t + u) * DM + lane * 16); o[0] = pk8(a[u]); o[1] = pk8(a[u] + 8); } } }
}

DEVI int swz(int row, int c) { return row * 128 + ((c ^ ((row >> 1) & 7)) << 4); }
constexpr int CLD = 132;
constexpr int LDS_RS = 135168;

struct GemmDesc {
  const u16* A; int lda; const u16* Bt; int ldb; int KT;
  float inv0;
  const u16* proj; const float* cw; const float* cb; int ch0;
};

template <int AMODE> DEVI bf16x8 load_a(const GemmDesc& g, int row, int kcol) {
  if constexpr (AMODE == 0) {
    return *(const bf16x8*)(g.A + (size_t)row * g.lda + kcol);
  } else {
    const int s = row & (SEQ - 1), ch = g.ch0 + kcol;
    float a[8];
    { const f32x4 b0 = *(const f32x4*)(g.cb + ch), b1 = *(const f32x4*)(g.cb + ch + 4); a[0] = b0.x; a[1] = b0.y; a[2] = b0.z; a[3] = b0.w; a[4] = b1.x; a[5] = b1.y; a[6] = b1.z; a[7] = b1.w; }
#pragma unroll
    for (int tap = 0; tap < 4; ++tap) {
      const int ss = s - 1 + tap;
      if (ss >= 0 && ss < SEQ) {
        const u32x4 v = *(const u32x4*)(g.proj + (size_t)(row - 1 + tap) * INWP + PC_LX + ch);
        float x[8]; unpk8(v, x);
        const f32x4 w0 = *(const f32x4*)(g.cw + tap * LRU_W + ch), w1 = *(const f32x4*)(g.cw + tap * LRU_W + ch + 4);
        a[0] += w0.x * x[0]; a[1] += w0.y * x[1]; a[2] += w0.z * x[2]; a[3] += w0.w * x[3];
        a[4] += w1.x * x[4]; a[5] += w1.y * x[5]; a[6] += w1.z * x[6]; a[7] += w1.w * x[7];
      }
    }
    const u32x4 o = pk8(a);
    return __builtin_bit_cast(bf16x8, o);
  }
}

template <int AMODE> DEVI void g_load(const GemmDesc& g, bf16x8 (&ar)[4], bf16x8 (&br)[2], int m0, int n0, int srow, int sc, int kt) {
#pragma unroll
  for (int i = 0; i < 4; ++i) ar[i] = load_a<AMODE>(g, m0 + srow + 64 * i, kt * 64 + sc * 8);
#pragma unroll
  for (int i = 0; i < 2; ++i) br[i] = *(const bf16x8*)(g.Bt + (size_t)(n0 + srow + 64 * i) * g.ldb + kt * 64 + sc * 8);
}
template <bool NORM> DEVI void g_write(char* Ab, const bf16x8 (&ar)[4], const bf16x8 (&br)[2], float (&ssq)[4], int srow, int sc) {
  char* Bb = Ab + 32768;
#pragma unroll
  for (int i = 0; i < 4; ++i) { *(bf16x8*)(Ab + swz(srow + 64 * i, sc)) = ar[i];
    if (NORM) { float x[8]; unpk8(__builtin_bit_cast(u32x4, ar[i]), x); float s = ssq[i];
#pragma unroll
      for (int q = 0; q < 8; ++q) s = fmaf(x[q], x[q], s);
      ssq[i] = s; } }
#pragma unroll
  for (int i = 0; i < 2; ++i) *(bf16x8*)(Bb + swz(srow + 64 * i, sc)) = br[i];
}

template <int AMODE, int SEG>
DEVI void gemm_core(const GemmDesc& g, int m0, int n0, char* lds) {
  const int tid = tidx(), lane = tid & 63, wid = tid >> 6;
  const int wm = wid >> 1, wn = wid & 1, r32 = lane & 31, hi = lane >> 5;
  const int srow = tid >> 3, sc = tid & 7;
  constexpr bool NORM = SEG != 0;
  float* rs = (float*)(lds + LDS_RS);
  f32x16 acc[2][2], acc2[2][2];
#pragma unroll
  for (int i = 0; i < 2; ++i)
#pragma unroll
    for (int j = 0; j < 2; ++j) { acc[i][j] = f32x16{}; acc2[i][j] = f32x16{}; }
  float ssq[4] = {0.f, 0.f, 0.f, 0.f};
  bf16x8 ar[4], br[2];
  g_load<AMODE>(g, ar, br, m0, n0, srow, sc, 0); g_write<NORM>(lds, ar, br, ssq, srow, sc); __syncthreads();
  int seg = 0;
#pragma unroll 1
  for (int kt = 0; kt < g.KT; ++kt) {
    const int cur = kt & 1;
    if (kt + 1 < g.KT) g_load<AMODE>(g, ar, br, m0, n0, srow, sc, kt + 1);
    { const char* Ab = lds + cur * 49152; const char* Bb = Ab + 32768;
#pragma unroll
      for (int k16 = 0; k16 < 4; ++k16) {
        bf16x8 a[2], b[2];
#pragma unroll
        for (int mt = 0; mt < 2; ++mt) a[mt] = *(const bf16x8*)(Ab + swz(wm * 64 + mt * 32 + r32, k16 * 2 + hi));
#pragma unroll
        for (int nt = 0; nt < 2; ++nt) b[nt] = *(const bf16x8*)(Bb + swz(wn * 64 + nt * 32 + r32, k16 * 2 + hi));
#pragma unroll
        for (int mt = 0; mt < 2; ++mt)
#pragma unroll
          for (int nt = 0; nt < 2; ++nt) {
            if (NORM) acc2[mt][nt] = __builtin_amdgcn_mfma_f32_32x32x16_bf16(a[mt], b[nt], acc2[mt][nt], 0, 0, 0);
            else acc[mt][nt] = __builtin_amdgcn_mfma_f32_32x32x16_bf16(a[mt], b[nt], acc[mt][nt], 0, 0, 0);
          }
      } }
    if (NORM) {
      int se; float inv;
      if (SEG == 1) { se = g.KT; inv = g.inv0; }
      else { se = seg == 0 ? 6 : (seg == 1 ? 12 : 16); inv = seg == 2 ? (1.f / 256.f) : (1.f / 384.f); }
      if (kt + 1 == se) {
#pragma unroll
        for (int i = 0; i < 4; ++i) { float s = ssq[i]; s += __shfl_xor(s, 1); s += __shfl_xor(s, 2); s += __shfl_xor(s, 4); if (sc == 0) rs[srow + 64 * i] = rsqrtf(s * inv + EPS); }
        __syncthreads();
#pragma unroll
        for (int mt = 0; mt < 2; ++mt)
#pragma unroll
          for (int r = 0; r < 16; ++r) { const float f = rs[wm * 64 + mt * 32 + crow(r, hi)];
#pragma unroll
            for (int nt = 0; nt < 2; ++nt) { acc[mt][nt][r] = fmaf(f, acc2[mt][nt][r], acc[mt][nt][r]); acc2[mt][nt][r] = 0.f; } }
        ssq[0] = ssq[1] = ssq[2] = ssq[3] = 0.f;
        ++seg;
      }
    }
    if (kt + 1 < g.KT) g_write<NORM>(lds + (cur ^ 1) * 49152, ar, br, ssq, srow, sc);
    __syncthreads();
  }
  float* C = (float*)lds;
#pragma unroll
  for (int mt = 0; mt < 2; ++mt)
#pragma unroll
    for (int nt = 0; nt < 2; ++nt)
#pragma unroll
      for (int r = 0; r < 16; ++r) C[(wm * 64 + mt * 32 + crow(r, hi)) * CLD + wn * 64 + nt * 32 + r32] = acc[mt][nt][r];
  __syncthreads();
}
template <int AMODE, int SEG, class Epi>
DEVI void gemm_tile(const GemmDesc& g, int m0, int n0, char* lds, const Epi& epi) {
  gemm_core<AMODE, SEG>(g, m0, n0, lds);
  epi((const float*)lds, m0, n0);
  __syncthreads();
}

DEVI GemmDesc gemm_desc(const u16* A, int lda, const u16* Bt, int ldb, int K) {
  GemmDesc g{}; g.A = A; g.lda = lda; g.Bt = Bt; g.ldb = ldb; g.KT = K / 64; g.inv0 = 1.f / (float)K; return g;
}


template <int HW> DEVI void rope8(float* v, const float* pp, int i0, float posf) {
  const bool first = i0 < HW; const int f0 = i0 & (HW - 1);
#pragma unroll
  for (int j = 0; j < 8; ++j) { float sn, cs; rope_sc(posf, HW == 32 ? (f0 + j) : 2 * (f0 + j), sn, cs); const float pv = pp[j]; v[j] = first ? v[j] * cs - pv * sn : v[j] * cs + pv * sn; }
}

struct EpiP1 { u16* proj; const int* pos;
  DEVI void operator()(const float* C, int m0, int n0) const {
    const int tid = tidx();
#pragma unroll 1
    for (int it = 0; it < 8; ++it) { const int item = it * NTHREADS + tid, row = item >> 4, c8 = (item & 15) * 8, gcol = n0 + c8, grow = m0 + row;
      float v[8]; ld8(C + row * CLD + c8, v);
      const bool r64 = gcol >= PC_SQ && gcol < PC_SV, r32g = gcol >= PC_KR && gcol < PC_KR + 32;
      if (r64) { const int i0 = gcol & 63; float pp[8]; ld8(C + row * CLD + c8 + (i0 < 32 ? 32 : -32), pp); rope8<32>(v, pp, i0, (float)pos[grow]); }
      else if (r32g) { const int i0 = gcol & 31; float pp[8]; ld8(C + row * CLD + c8 + (i0 < 16 ? 16 : -16), pp); rope8<16>(v, pp, i0, (float)pos[grow]); }
      *(u32x4*)(proj + (size_t)grow * INWP + gcol) = pk8(v);
    }
  }
};

struct EpiQ { u16* qm; const int* pos;
  DEVI void operator()(const float* C, int m0, int n0) const {
    const int tid = tidx();
#pragma unroll 1
    for (int it = 0; it < 8; ++it) { const int item = it * NTHREADS + tid, row = item >> 4, c8 = (item & 15) * 8, gcol = n0 + c8, grow = m0 + row;
      if (gcol >= 576) continue;
      const int head = gcol / 96, j0 = gcol - head * 96, b = grow >> 13, s = grow & (SEQ - 1);
      float v[8]; ld8(C + row * CLD + c8, v);
      u16* qrow = qm + ((size_t)(b * MLA_H + head) * SEQ + s) * MLA_QK;
      if (j0 >= 64) { const int i0 = j0 - 64; float pp[8]; ld8(C + row * CLD + c8 + (i0 < 16 ? 16 : -16), pp); rope8<16>(v, pp, i0, (float)pos[grow]);
#pragma unroll
        for (int j = 0; j < 8; ++j) { const int i = i0 + j; qrow[64 + (i < 16 ? 2 * i : 2 * (i - 16) + 1)] = f2bf(v[j]); } }
      else *(u32x4*)(qrow + j0) = pk8(v);
    }
  }
};

struct EpiKV { u16* km; u16* vm; const u16* proj;
  DEVI void operator()(const float* C, int m0, int n0) const {
    const int tid = tidx(), head = n0 >> 7;
#pragma unroll 1
    for (int it = 0; it < 8; ++it) { const int item = it * NTHREADS + tid, row = item >> 4, c8 = (item & 15) * 8, grow = m0 + row;
      const int b = grow >> 13, s = grow & (SEQ - 1);
      float v[8]; ld8(C + row * CLD + c8, v);
      const size_t tok = (size_t)(b * MLA_H + head) * SEQ + s;
      if (c8 < 64) *(u32x4*)(km + tok * MLA_QK + c8) = pk8(v);
      else *(u32x4*)(vm + tok * MLA_V + (c8 - 64)) = pk8(v);
    }
#pragma unroll 1
    for (int it = 0; it < 2; ++it) { const int item = it * NTHREADS + tid, row = item >> 2, c = (item & 3) * 8, grow = m0 + row;
      const int b = grow >> 13, s = grow & (SEQ - 1);
      *(u32x4*)(km + ((size_t)(b * MLA_H + head) * SEQ + s) * MLA_QK + 64 + c) = *(const u32x4*)(proj + (size_t)grow * INWP + PC_KR + c);
    }
  }
};

struct EpiLRU { const u16* proj; const float* cw; const float* cb; const float* ba; const float* bx; const float* lam; u16* le; u16* lb; int n, d;
  DEVI void operator()(const float* C, int m0, int) const {
    const int tid = tidx();
#pragma unroll 1
    for (int it = 0; it < 4; ++it) { const int item = it * NTHREADS + tid, j = item & 63, g8 = item >> 6;
      const int ch = n * 64 + j, grow0 = m0 + g8 * 8, s0 = grow0 & (SEQ - 1), b = grow0 >> 13;
      const float bav = ba[(d * 6 + n) * 64 + j], bxv = bx[(d * 6 + n) * 64 + j];
      const float cdec = -8.f * log1pf(__expf(-lam[d * LRU_W + ch]));
      float xin[11];
#pragma unroll
      for (int q = 0; q < 11; ++q) { const int ss = s0 - 1 + q; xin[q] = (ss >= 0 && ss < SEQ) ? bf2f(proj[(size_t)(grow0 - 1 + q) * INWP + PC_LX + ch]) : 0.f; }
      const float w0 = cw[ch], w1 = cw[LRU_W + ch], w2 = cw[2 * LRU_W + ch], w3 = cw[3 * LRU_W + ch], cbv = cb[ch];
      float ev[8], bv[8];
#pragma unroll
      for (int rr = 0; rr < 8; ++rr) {
        const float xf = cbv + w0 * xin[rr] + w1 * xin[rr + 1] + w2 * xin[rr + 2] + w3 * xin[rr + 3];
        const float r = sigmoidf_(C[(g8 * 8 + rr) * CLD + j] + bav), ig = sigmoidf_(C[(g8 * 8 + rr) * CLD + 64 + j] + bxv);
        const float a = __expf(cdec * r), e = 1.f - a;
        ev[rr] = e; bv[rr] = sqrtf(e * (2.f - e)) * ig * xf;
      }
      const size_t o = (((size_t)(d * NB + b) * (SEQ / 8) + (s0 >> 3)) * LRU_W + ch) * 8;
      *(u32x4*)(le + o) = pk8(ev); *(u32x4*)(lb + o) = pk8(bv);
    }
  }
};

struct EpiP4 { const float* xres; float* xout; u16* xg;
  DEVI void operator()(const float* C, int m0, int n0) const {
    const int tid = tidx();
#pragma unroll 1
    for (int it = 0; it < 8; ++it) { const int item = it * NTHREADS + tid, row = item >> 4, c8 = (item & 15) * 8, gcol = n0 + c8, grow = m0 + row;
      float v[8], x[8]; ld8(C + row * CLD + c8, v); ld8(xres + (size_t)grow * DM + gcol, x);
#pragma unroll
      for (int j = 0; j < 8; ++j) v[j] += x[j];
      *(f32x4*)(xout + (size_t)grow * DM + gcol) = (f32x4){v[0], v[1], v[2], v[3]}; *(f32x4*)(xout + (size_t)grow * DM + gcol + 4) = (f32x4){v[4], v[5], v[6], v[7]};
      *(u32x4*)(xg + (size_t)grow * DM + gcol) = pk8(v);
    }
  }
};

struct EpiBf16 { u16* o; int ldo;
  DEVI void operator()(const float* C, int m0, int n0) const {
    const int tid = tidx();
#pragma unroll 1
    for (int it = 0; it < 8; ++it) { const int item = it * NTHREADS + tid, row = item >> 4, c8 = (item & 15) * 8;
      float v[8]; ld8(C + row * CLD + c8, v);
      *(u32x4*)(o + (size_t)(m0 + row) * ldo + n0 + c8) = pk8(v);
    }
  }
};

DEVI void ce_desc(float& a, float& b) { const float mx = fmaxf(a, b), mn = fminf(a, b); a = mx; b = mn; }
struct EpiTop { float* top; int hj;
  DEVI void operator()(const float* C, int m0, int) const {
    const int tid = tidx(), row = tid >> 1, part = tid & 1;
    float l[16];
#pragma unroll
    for (int i = 0; i < 16; ++i) l[i] = -3.0e38f;
#pragma unroll 4
    for (int c = 0; c < 64; ++c) { const int col = part * 64 + ((c + row) & 63);
      float v = __uint_as_float((__float_as_uint(C[row * CLD + col]) & ~127u) | (unsigned)(127 - col));
#pragma unroll
      for (int i = 0; i < 16; ++i) { const float t = fmaxf(l[i], v); v = fminf(l[i], v); l[i] = t; } }
    float m[16];
#pragma unroll
    for (int i = 0; i < 16; ++i) m[i] = __shfl_xor(l[15 - i], 1);
#pragma unroll
    for (int i = 0; i < 16; ++i) m[i] = fmaxf(m[i], l[i]);
#pragma unroll
    for (int st = 8; st >= 1; st >>= 1)
#pragma unroll
      for (int i = 0; i < 16; ++i) if ((i & st) == 0) ce_desc(m[i], m[i + st]);
    if (part == 0) { float* o = top + ((size_t)(m0 + row) * 16 + hj) * 16;
#pragma unroll
      for (int i = 0; i < 4; ++i) *(f32x4*)(o + 4 * i) = (f32x4){m[4 * i], m[4 * i + 1], m[4 * i + 2], m[4 * i + 3]}; }
  }
};

#define KSWZ(row, colB) ((row) * 256 + ((colB) ^ (((row) & 15) << 4)))
#define SBAR() __builtin_amdgcn_sched_barrier(0)
constexpr int AT_SHM_V = 64 * 64 * 2, AT_SHM_K = 64 * 128 * 2;
constexpr int AT_LDS = 3 * AT_SHM_V + 2 * AT_SHM_K + 8 * 64 * 4;
constexpr float ATT_THR = 8.f;
DEVI unsigned cvtpk(float lo, float hi) { unsigned r; asm volatile("v_cvt_pk_bf16_f32 %0, %1, %2" : "=v"(r) : "v"(lo), "v"(hi)); return r; }
DEVI int v_st(int k, int c) { const int kk = (k & ~0xC) | ((k & 4) << 1) | ((k & 8) >> 1); return ((kk >> 3) * 2 + (c >> 5)) * 512 + ((kk & 7) * 32 + (c & 31)) * 2; }
DEVI int v_rd_base(int lane) { return ((lane & 3) << 3) | (((lane >> 2) & 3) << 6) | (((lane >> 4) & 1) << 5) | (((lane >> 5) & 1) << 8); }
constexpr int v_rd_off(int d0, int ks, int half) { return d0 * 512 + ks * 2048 + half * 1024; }
template <int OFF> DEVI s16x4 tr_read(int vb) { s16x4 r; asm volatile("ds_read_b64_tr_b16 %0, %1 offset:%2" : "=&v"(r) : "v"(vb), "i"(OFF) : "memory"); return r; }

template <bool MASK, bool FIRST>
DEVI void partialSM(f32x16& p0, f32x16& p1, float& m_reg, float& mn, float& alpha, float SCALE, int kpos0, int qpos, int hi) {
  const float C = SCALE * 1.4426950408889634f;
  if (MASK) {
#pragma unroll
    for (int r = 0; r < 16; ++r) { const int k0 = kpos0 + crow(r, hi) - qpos; const int k1 = k0 + 32;
      if (k0 > 128 || k0 < -128) p0[r] = -1e30f;
      if (k1 > 128 || k1 < -128) p1[r] = -1e30f; }
  }
  if (FIRST) {
    float pmax = p0[0];
#pragma unroll
    for (int r = 1; r < 16; ++r) pmax = fmaxf(pmax, p0[r]);
#pragma unroll
    for (int r = 0; r < 16; ++r) pmax = fmaxf(pmax, p1[r]);
    { auto rr = __builtin_amdgcn_permlane32_swap(__float_as_uint(pmax), __float_as_uint(pmax), false, false);
      pmax = fmaxf(__uint_as_float(rr[0]), __uint_as_float(rr[1])); }
    if (__builtin_expect(__all(pmax - m_reg <= ATT_THR / SCALE), 1)) { mn = m_reg; alpha = 1.f; }
    else { mn = fmaxf(m_reg, pmax); alpha = __builtin_amdgcn_exp2f((m_reg - mn) * C); m_reg = mn; }
    const float mnC = -mn * C;
#pragma unroll
    for (int r = 0; r < 16; ++r) p0[r] = fmaf(p0[r], C, mnC);
#pragma unroll
    for (int r = 0; r < 16; ++r) p1[r] = fmaf(p1[r], C, mnC);
#pragma unroll
    for (int r = 0; r < 16; ++r) p0[r] = __builtin_amdgcn_exp2f(p0[r]);
    return;
  }
  const float mC = -m_reg * C;
#pragma unroll
  for (int r = 0; r < 16; ++r) p0[r] = fmaf(p0[r], C, mC);
#pragma unroll
  for (int r = 0; r < 16; ++r) p1[r] = fmaf(p1[r], C, mC);
  float tmax = p0[0];
#pragma unroll
  for (int r = 1; r < 16; ++r) tmax = fmaxf(tmax, p0[r]);
#pragma unroll
  for (int r = 0; r < 16; ++r) tmax = fmaxf(tmax, p1[r]);
#pragma unroll
  for (int r = 0; r < 16; ++r) p0[r] = __builtin_amdgcn_exp2f(p0[r]);
  { auto rr = __builtin_amdgcn_permlane32_swap(__float_as_uint(tmax), __float_as_uint(tmax), false, false);
    tmax = fmaxf(__uint_as_float(rr[0]), __uint_as_float(rr[1])); }
  mn = m_reg; alpha = 1.f;
  if (__builtin_expect(!__all(tmax <= ATT_THR * 1.4426950408889634f), 0)) {
    const float sh = fmaxf(tmax, 0.f);
    alpha = __builtin_amdgcn_exp2f(-sh); m_reg = m_reg + sh / C; mn = m_reg;
#pragma unroll
    for (int r = 0; r < 16; ++r) { p0[r] *= alpha; p1[r] -= sh; }
  }
}
DEVI void finishSM(f32x16& p0, f32x16& p1, float alpha, float& l_reg, bf16x8& pa0, bf16x8& pa1, bf16x8& pa2, bf16x8& pa3) {
#pragma unroll
  for (int r = 0; r < 16; ++r) p1[r] = __builtin_amdgcn_exp2f(p1[r]);
  float ps = 0;
#pragma unroll
  for (int r = 0; r < 16; ++r) ps += p0[r];
#pragma unroll
  for (int r = 0; r < 16; ++r) ps += p1[r];
  { auto rr = __builtin_amdgcn_permlane32_swap(__float_as_uint(ps), __float_as_uint(ps), false, false);
    ps = __uint_as_float(rr[0]) + __uint_as_float(rr[1]); }
  l_reg = l_reg * alpha + ps;
#define PK4(P, BASE, OUT) do { unsigned a0 = cvtpk(P[BASE + 0], P[BASE + 1]), a1 = cvtpk(P[BASE + 2], P[BASE + 3]);   \
    unsigned b0 = cvtpk(P[BASE + 4], P[BASE + 5]), b1 = cvtpk(P[BASE + 6], P[BASE + 7]);                              \
    auto r0 = __builtin_amdgcn_permlane32_swap(a0, b0, false, false); auto r1 = __builtin_amdgcn_permlane32_swap(a1, b1, false, false); \
    u32x4 w = {r0[0], r1[0], r0[1], r1[1]}; OUT = __builtin_bit_cast(bf16x8, w); } while (0)
  PK4(p0, 0, pa0); PK4(p0, 8, pa1); PK4(p1, 0, pa2); PK4(p1, 8, pa3);
#undef PK4
}
template <int ND0>
DEVI void qkt(f32x16& p0, f32x16& p1, const char* Ks, const bf16x8* qr, int r32, int hi) {
  bf16x8 k0[ND0], k1[ND0];
#pragma unroll
  for (int d0 = 0; d0 < ND0; ++d0) { const int cb = (d0 * 16 + hi * 8) * 2;
    k0[d0] = *(const bf16x8*)(Ks + KSWZ(r32, cb)); k1[d0] = *(const bf16x8*)(Ks + KSWZ(32 + r32, cb)); }
  p0 = f32x16{}; p1 = f32x16{};
#pragma unroll
  for (int d0 = 0; d0 < ND0; ++d0) {
    p0 = __builtin_amdgcn_mfma_f32_32x32x16_bf16(k0[d0], qr[d0], p0, 0, 0, 0);
    p1 = __builtin_amdgcn_mfma_f32_32x32x16_bf16(k1[d0], qr[d0], p1, 0, 0, 0); }
}
template <int D0> DEVI void pv_one(f32x16& od, int vb, bf16x8 pa0, bf16x8 pa1, bf16x8 pa2, bf16x8 pa3) {
  const s16x4 l0 = tr_read<v_rd_off(D0, 0, 0)>(vb), h0 = tr_read<v_rd_off(D0, 0, 1)>(vb), l1 = tr_read<v_rd_off(D0, 1, 0)>(vb), h1 = tr_read<v_rd_off(D0, 1, 1)>(vb);
  const s16x4 l2 = tr_read<v_rd_off(D0, 2, 0)>(vb), h2 = tr_read<v_rd_off(D0, 2, 1)>(vb), l3 = tr_read<v_rd_off(D0, 3, 0)>(vb), h3 = tr_read<v_rd_off(D0, 3, 1)>(vb);
  asm volatile("s_waitcnt lgkmcnt(0)" ::: "memory"); SBAR();
#define PK(L, H) (bf16x8){L[0], L[1], L[2], L[3], H[0], H[1], H[2], H[3]}
  od = __builtin_amdgcn_mfma_f32_32x32x16_bf16(pa0, PK(l0, h0), od, 0, 0, 0);
  od = __builtin_amdgcn_mfma_f32_32x32x16_bf16(pa1, PK(l1, h1), od, 0, 0, 0);
  od = __builtin_amdgcn_mfma_f32_32x32x16_bf16(pa2, PK(l2, h2), od, 0, 0, 0);
  od = __builtin_amdgcn_mfma_f32_32x32x16_bf16(pa3, PK(l3, h3), od, 0, 0, 0);
#undef PK
}
DEVI void pv_d0(f32x16* o, int vb, bf16x8 pa0, bf16x8 pa1, bf16x8 pa2, bf16x8 pa3) {
  const s16x4 a0 = tr_read<v_rd_off(0, 0, 0)>(vb), b0 = tr_read<v_rd_off(0, 0, 1)>(vb), a1 = tr_read<v_rd_off(0, 1, 0)>(vb), b1 = tr_read<v_rd_off(0, 1, 1)>(vb);
  const s16x4 a2 = tr_read<v_rd_off(0, 2, 0)>(vb), b2 = tr_read<v_rd_off(0, 2, 1)>(vb), a3 = tr_read<v_rd_off(0, 3, 0)>(vb), b3 = tr_read<v_rd_off(0, 3, 1)>(vb);
  const s16x4 c0 = tr_read<v_rd_off(1, 0, 0)>(vb), d0 = tr_read<v_rd_off(1, 0, 1)>(vb), c1 = tr_read<v_rd_off(1, 1, 0)>(vb), d1 = tr_read<v_rd_off(1, 1, 1)>(vb);
  const s16x4 c2 = tr_read<v_rd_off(1, 2, 0)>(vb), d2 = tr_read<v_rd_off(1, 2, 1)>(vb), c3 = tr_read<v_rd_off(1, 3, 0)>(vb), d3 = tr_read<v_rd_off(1, 3, 1)>(vb);
  asm volatile("s_waitcnt lgkmcnt(0)" ::: "memory"); SBAR();
#define PK(L, H) (bf16x8){L[0], L[1], L[2], L[3], H[0], H[1], H[2], H[3]}
  o[0] = __builtin_amdgcn_mfma_f32_32x32x16_bf16(pa0, PK(a0, b0), o[0], 0, 0, 0);
  o[1] = __builtin_amdgcn_mfma_f32_32x32x16_bf16(pa0, PK(c0, d0), o[1], 0, 0, 0);
  o[0] = __builtin_amdgcn_mfma_f32_32x32x16_bf16(pa1, PK(a1, b1), o[0], 0, 0, 0);
  o[1] = __builtin_amdgcn_mfma_f32_32x32x16_bf16(pa1, PK(c1, d1), o[1], 0, 0, 0);
  o[0] = __builtin_amdgcn_mfma_f32_32x32x16_bf16(pa2, PK(a2, b2), o[0], 0, 0, 0);
  o[1] = __builtin_amdgcn_mfma_f32_32x32x16_bf16(pa2, PK(c2, d2), o[1], 0, 0, 0);
  o[0] = __builtin_amdgcn_mfma_f32_32x32x16_bf16(pa3, PK(a3, b3), o[0], 0, 0, 0);
  o[1] = __builtin_amdgcn_mfma_f32_32x32x16_bf16(pa3, PK(c3, d3), o[1], 0, 0, 0);
#undef PK
}

template <int DQK, bool MASK>
DEVI void attn_body(const u16* Qw, const u16* Kh, int ldk, const u16* Vh, int ldv, int kt0, int NT, float SCALE, float m_init, float l_init,
                    int qpos, u16* Ow, char* lds, float qrope_pos = 0.f) {
  constexpr int ND0 = DQK / 16, NCK = DQK / 8;
  const int tid = tidx(), wid = __builtin_amdgcn_readfirstlane(tid >> 6), lane = tid & 63, r32 = lane & 31, hi = lane >> 5;
  char* K_lds = lds; char* V_lds = lds + 2 * AT_SHM_K;
  float* wsx = (float*)(lds + 2 * AT_SHM_K + 3 * AT_SHM_V) + wid * 64; float* li_l = wsx; float* al_l = wsx + 32;
  float m_reg = m_init, l_reg = l_init; f32x16 o[2] = {f32x16{}, f32x16{}}; bf16x8 qr[ND0];
#pragma unroll
  for (int d0 = 0; d0 < ND0; ++d0) qr[d0] = *(const bf16x8*)(Qw + d0 * 16);
  if (DQK == 96) {
#pragma unroll
    for (int d0 = 4; d0 < ND0; ++d0) { float v[8]; unpk8(__builtin_bit_cast(u32x4, qr[d0]), v);
#pragma unroll
      for (int q = 0; q < 4; ++q) { const int f = 2 * ((((d0 - 4) * 16 + hi * 8) >> 1) + q); float sn, cs; rope_sc(qrope_pos, f, sn, cs);
        const float x1 = v[2 * q], x2 = v[2 * q + 1]; v[2 * q] = x1 * cs - x2 * sn; v[2 * q + 1] = x2 * cs + x1 * sn; }
      qr[d0] = __builtin_bit_cast(bf16x8, pk8(v)); } }
  unsigned koff[2], voff;
#pragma unroll
  for (int i = 0; i < 2; ++i) { const int row = 4 * (wid + 8 * i) + (lane >> 4), ch = (lane & 15) ^ (row & 15); koff[i] = (unsigned)(row * ldk * 2 + (ch < NCK ? ch : 0) * 16); }
  { const int off = wid * 1024 + lane * 16, sub = off >> 9, kk = ((sub >> 1) << 3) | ((off & 511) >> 6), c = ((sub & 1) << 5) | ((off & 63) >> 1);
    const int k = (kk & ~0xC) | ((kk & 4) << 1) | ((kk & 8) >> 1); voff = (unsigned)(k * ldv * 2 + c * 2); }
  typedef __attribute__((address_space(3))) unsigned lds_u32;
#define DMA(tt_) do { const char* kb_ = (const char*)Kh + (size_t)(kt0 + (tt_)) * 64 * ldk * 2; const char* vb_ = (const char*)Vh + (size_t)(kt0 + (tt_)) * 64 * ldv * 2; \
    char* kd_ = K_lds + ((tt_) & 1) * AT_SHM_K + wid * 1024; char* vd_ = V_lds + ((tt_) % 3) * AT_SHM_V + wid * 1024; \
    __builtin_amdgcn_global_load_lds((const unsigned*)(kb_ + koff[0]), (lds_u32*)kd_, 16, 0, 0); \
    __builtin_amdgcn_global_load_lds((const unsigned*)(kb_ + koff[1]), (lds_u32*)(kd_ + 8192), 16, 0, 0); \
    __builtin_amdgcn_global_load_lds((const unsigned*)(vb_ + voff), (lds_u32*)vd_, 16, 0, 0); } while (0)
#define LANDED() do { asm volatile("s_waitcnt vmcnt(0)" ::: "memory"); __syncthreads(); } while (0)
#define RESC(a) do { if (__any((a) < 1.f)) { if (hi == 0) al_l[r32] = (a); asm volatile("s_waitcnt lgkmcnt(0)" ::: "memory"); \
    _Pragma("unroll") for (int d = 0; d < 2; ++d) _Pragma("unroll") for (int r = 0; r < 16; ++r) o[d][r] *= al_l[crow(r, hi)]; } } while (0)
  const int vb0 = (int)(uintptr_t)V_lds + v_rd_base(lane);
  f32x16 pA0, pA1, pB0, pB1; float mnA, mnB, alA, alB; bf16x8 pa0, pa1, pa2, pa3;
  DMA(0); LANDED();
  DMA(1);
  qkt<ND0>(pA0, pA1, K_lds, qr, r32, hi); partialSM<MASK, true>(pA0, pA1, m_reg, mnA, alA, SCALE, kt0 * 64, qpos, hi);
  LANDED();
  int vprev = 0;
  for (int tt = 1; tt + 1 < NT; tt += 2) {
    const int v1 = vprev == 2 ? 0 : vprev + 1;
    DMA(tt + 1); SBAR();
    qkt<ND0>(pB0, pB1, K_lds + AT_SHM_K, qr, r32, hi);
    finishSM(pA0, pA1, alA, l_reg, pa0, pa1, pa2, pa3); SBAR();
    pv_d0(o, vb0 + vprev * AT_SHM_V, pa0, pa1, pa2, pa3); partialSM<MASK, false>(pB0, pB1, m_reg, mnB, alB, SCALE, (kt0 + tt) * 64, qpos, hi);
    RESC(alB); LANDED();
    if (tt + 2 < NT) DMA(tt + 2);
    SBAR();
    qkt<ND0>(pA0, pA1, K_lds, qr, r32, hi);
    finishSM(pB0, pB1, alB, l_reg, pa0, pa1, pa2, pa3); SBAR();
    pv_d0(o, vb0 + v1 * AT_SHM_V, pa0, pa1, pa2, pa3); partialSM<MASK, false>(pA0, pA1, m_reg, mnA, alA, SCALE, (kt0 + tt + 1) * 64, qpos, hi);
    RESC(alA); LANDED();
    vprev = v1 == 2 ? 0 : v1 + 1;
  }
  { const int v1 = vprev == 2 ? 0 : vprev + 1;
    SBAR(); qkt<ND0>(pB0, pB1, K_lds + AT_SHM_K, qr, r32, hi);
    finishSM(pA0, pA1, alA, l_reg, pa0, pa1, pa2, pa3); SBAR();
    pv_d0(o, vb0 + vprev * AT_SHM_V, pa0, pa1, pa2, pa3); partialSM<MASK, false>(pB0, pB1, m_reg, mnB, alB, SCALE, (kt0 + NT - 1) * 64, qpos, hi);
    RESC(alB);
    finishSM(pB0, pB1, alB, l_reg, pa0, pa1, pa2, pa3); SBAR();
    pv_d0(o, vb0 + v1 * AT_SHM_V, pa0, pa1, pa2, pa3); }
  if (hi == 0) li_l[r32] = l_reg; asm volatile("s_waitcnt lgkmcnt(0)" ::: "memory");
  float rli[16];
#pragma unroll
  for (int r = 0; r < 16; ++r) rli[r] = __builtin_amdgcn_rcpf(li_l[crow(r, hi)]);
#pragma unroll
  for (int r = 0; r < 16; ++r) { const int orow = crow(r, hi);
#pragma unroll
    for (int d0 = 0; d0 < 2; ++d0) Ow[(size_t)orow * DM + d0 * 32 + r32] = f2bf(o[d0][r] * rli[r]); }
  __syncthreads();
#undef DMA
#undef LANDED
#undef RESC
}

constexpr int LCH = 64, NLCH = SEQ / LCH;
constexpr size_t WS_LP = 1 * MiB, WS_LH = 2560 * 1024;
constexpr size_t WS_LC = 473 * MiB;
constexpr size_t WS_NEED = 478 * MiB;
DEVI void lru_passA(const Params& p, int item, int lane) {
  const int cg = item % 6, c = (item / 6) % NLCH, b = (item / (6 * NLCH)) % NB, d = item / (6 * NLCH * NB);
  const size_t base = (((size_t)(d * NB + b) * (SEQ / 8) + c * 8) * LRU_W + cg * 64 + lane) * 8;
  const u16* E = (const u16*)(p.ws + WS_LE) + base; const u16* Bp = (const u16*)(p.ws + WS_LB) + base;
  u32x4 ev[8], bv[8];
#pragma unroll
  for (int g = 0; g < 8; ++g) { ev[g] = *(const u32x4*)(E + (size_t)g * LRU_W * 8); bv[g] = *(const u32x4*)(Bp + (size_t)g * LRU_W * 8); }
  float h = 0.f, P = 1.f;
#pragma unroll
  for (int gg = 0; gg < 8; ++gg) { const int g = d ? 7 - gg : gg; float e[8], bb[8]; unpk8(ev[g], e); unpk8(bv[g], bb);
#pragma unroll
    for (int rr = 0; rr < 8; ++rr) { const int r = d ? 7 - rr : rr; const float a = 1.f - e[r]; h = fmaf(a, h, bb[r]); P *= a; } }
  const size_t o = ((size_t)(d * NB + b) * NLCH + c) * LRU_W + cg * 64 + lane;
  ((float*)(p.ws + WS_LP))[o] = P; ((float*)(p.ws + WS_LH))[o] = h;
}

DEVI void lru_final(const Params& p, int item, char* lds) {
  const int tid = tidx(), wid = tid >> 6, lane = tid & 63;
  const int c = item % NLCH, b = item / NLCH;
  float* obuf = (float*)lds;
  if (wid < 6) {
    const int ch = wid * 64 + lane;
#pragma unroll
    for (int d = 0; d < 2; ++d) {
      const size_t co = ((size_t)(d * NB + b) * NLCH + c) * LRU_W + ch;
      float h = ((const float*)(p.ws + WS_LC))[co];
      const size_t base = (((size_t)(d * NB + b) * (SEQ / 8) + c * 8) * LRU_W + ch) * 8;
      const u16* E = (const u16*)(p.ws + WS_LE) + base; const u16* Bp = (const u16*)(p.ws + WS_LB) + base;
      u32x4 ev[8], bv[8];
#pragma unroll
      for (int g = 0; g < 8; ++g) { ev[g] = *(const u32x4*)(E + (size_t)g * LRU_W * 8); bv[g] = *(const u32x4*)(Bp + (size_t)g * LRU_W * 8); }
      if (d == 0) {
#pragma unroll
        for (int g = 0; g < 8; ++g) { float e[8], bb[8]; unpk8(ev[g], e); unpk8(bv[g], bb);
#pragma unroll
          for (int r = 0; r < 8; ++r) { h = fmaf(1.f - e[r], h, bb[r]); obuf[(g * 8 + r) * LRU_W + ch] = h; } }
      } else {
        const u16* gp = (const u16*)(p.ws + WS_R1) + ((size_t)b * SEQ + c * LCH) * INWP + PC_LG + ch;
#pragma unroll
        for (int g = 7; g >= 0; --g) { float e[8], bb[8]; unpk8(ev[g], e); unpk8(bv[g], bb);
#pragma unroll
          for (int r = 7; r >= 0; --r) { h = fmaf(1.f - e[r], h, bb[r]); const int tk = g * 8 + r;
            const float gt = bf2f(gp[(size_t)tk * INWP]); obuf[tk * LRU_W + ch] = (obuf[tk * LRU_W + ch] + h) * gelu_erf(gt); } }
      }
    }
  }
  __syncthreads();
  u16* mp = (u16*)(p.ws + WS_MIX) + ((size_t)b * SEQ + c * LCH) * DM + 384;
#pragma unroll 1
  for (int i = 0; i < 8; ++i) { const int tk = wid * 8 + i;
    float v[6]; float s = 0.f;
#pragma unroll
    for (int q = 0; q < 3; ++q) { const f32x2 t2 = *(const f32x2*)(obuf + tk * LRU_W + q * 128 + lane * 2); v[2 * q] = t2.x; v[2 * q + 1] = t2.y; s = fmaf(t2.x, t2.x, s); s = fmaf(t2.y, t2.y, s); }
    s = wave_sum(s);
    const float rs = rsqrtf(s * (1.f / 384.f) + EPS);
#pragma unroll
    for (int q = 0; q < 3; ++q) *(unsigned*)(mp + (size_t)tk * DM + q * 128 + lane * 2) = pk2(v[2 * q] * rs, v[2 * q + 1] * rs);
  }
  __syncthreads();
}

typedef unsigned char u8;
DEVI unsigned q8x4(const float* v, float s) {
  unsigned w = 0;
#pragma unroll
  for (int i = 0; i < 4; ++i) { int q = __float2int_rn(v[i] * s); q = q < -127 ? -127 : (q > 127 ? 127 : q); w |= ((unsigned)q & 255u) << (8 * i); }
  return w;
}
DEVI void peer_xn_pass(const Params& p, int layer, int vb, int nb) {
  const int tid = tidx(), wid = tid >> 6, lane = tid & 63; const u16* xg = (const u16*)(p.ws + WS_XG); const float* gf = p.norm_ffn + layer * DM;
  u8* xq = (u8*)(p.ws + WS_XQ); float* sxp = (float*)(p.ws + WS_SX);
  for (int t = vb * 8 + wid; t < T; t += nb * 8) {
    const u32x4* rp = (const u32x4*)(xg + (size_t)t * DM + lane * 16);
    float v[16]; unpk8(rp[0], v); unpk8(rp[1], v + 8);
    float s = 0.f;
#pragma unroll
    for (int i = 0; i < 16; ++i) s = fmaf(v[i], v[i], s);
    s = wave_sum(s);
    const float rs = rsqrtf(s * (1.f / DM) + EPS);
    float g[16]; ld8(gf + lane * 16, g); ld8(gf + lane * 16 + 8, g + 8);
    float mx = 0.f;
#pragma unroll
    for (int i = 0; i < 16; ++i) { v[i] *= rs * g[i]; mx = fmaxf(mx, fabsf(v[i])); }
#pragma unroll
    for (int o = 1; o < 64; o <<= 1) mx = fmaxf(mx, __shfl_xor(mx, o));
    const float sx = fmaxf(mx, 1e-20f) * (1.f / 127.f), isx = 1.f / sx;
    *(u32x4*)(xq + (size_t)t * DM + lane * 16) = (u32x4){q8x4(v, isx), q8x4(v + 4, isx), q8x4(v + 8, isx), q8x4(v + 12, isx)};
    if (lane == 0) sxp[t] = sx;
  }
}

DEVI void cvt16(u32x4 w, float* f) {
  f32x2 t;
  t = __builtin_amdgcn_cvt_pk_f32_fp8((int)w.x, false); f[0] = t.x; f[1] = t.y; t = __builtin_amdgcn_cvt_pk_f32_fp8((int)w.x, true); f[2] = t.x; f[3] = t.y;
  t = __builtin_amdgcn_cvt_pk_f32_fp8((int)w.y, false); f[4] = t.x; f[5] = t.y; t = __builtin_amdgcn_cvt_pk_f32_fp8((int)w.y, true); f[6] = t.x; f[7] = t.y;
  t = __builtin_amdgcn_cvt_pk_f32_fp8((int)w.z, false); f[8] = t.x; f[9] = t.y; t = __builtin_amdgcn_cvt_pk_f32_fp8((int)w.z, true); f[10] = t.x; f[11] = t.y;
  t = __builtin_amdgcn_cvt_pk_f32_fp8((int)w.w, false); f[12] = t.x; f[13] = t.y; t = __builtin_amdgcn_cvt_pk_f32_fp8((int)w.w, true); f[14] = t.x; f[15] = t.y;
}
DEVI unsigned enc4(float a, float b, float c, float d) { int w = 0; w = __builtin_amdgcn_cvt_pk_fp8_f32(a, b, w, false); w = __builtin_amdgcn_cvt_pk_fp8_f32(c, d, w, true); return (unsigned)w; }
#define EIDX_AT(i0, i1, i) ((((i) < 8 ? (i0) : (i1))[((i) & 7) >> 1] >> (((i) & 1) * 16)) & 0xffffu)
template <int CTRL> DEVI float dppf(float v) { return __uint_as_float((unsigned)__builtin_amdgcn_mov_dpp((int)__float_as_uint(v), CTRL, 0xF, 0xF, true)); }
DEVI f32x2 fma2(f32x2 a, f32x2 b, f32x2 c) { return __builtin_elementwise_fma(a, b, c); }
DEVI f32x2 cvt8lo(unsigned w) { return __builtin_amdgcn_cvt_pk_f32_fp8((int)w, false); }
DEVI f32x2 cvt8hi(unsigned w) { return __builtin_amdgcn_cvt_pk_f32_fp8((int)w, true); }
struct PeerIdx { u32x4 i0, i1; };
template <bool AXPY>
DEVI void peer_slice_phase(const Params& p, int s, int tbeg, int tstep, int lane, const float* xin, float* xout, bool last) {
  const int r = lane >> 3, j = lane & 7;
  const u8* eidxB = (const u8*)(p.ws + WS_EIDX); const unsigned eoff = (unsigned)r * 32u;
  const u8* TBs = (const u8*)(p.ws + (AXPY ? WS_VB : WS_UB)) + (size_t)s * NEXP * 128; const unsigned toff = 16u * (unsigned)j;
  const u8* xnB = (const u8*)(p.ws + WS_XQ) + s * 128; const unsigned xoff = 16u * (unsigned)j;
  const float* sxp = (const float*)(p.ws + WS_SX);
  const u8* ccB = (const u8*)(p.ws + WS_CC); const unsigned coff = (unsigned)r * 32u;
  float* pdB = (float*)(p.ws + WS_PD) + (size_t)s * T * 128;
  const int ntok = (T - tbeg + tstep - 1) / tstep;
  if (ntok <= 0) return;
#define TOK(k) (tbeg + ((k) < ntok ? (k) : ntok - 1) * tstep)
#define LD_IDX(dst, k) do { const u8* b_ = eidxB + (size_t)TOK(k) * 256; dst.i0 = *(const u32x4*)(b_ + eoff); dst.i1 = *(const u32x4*)(b_ + eoff + 16u); } while (0)
#define LD_HALF(H, ix, h) do { _Pragma("unroll") for (int i = 0; i < 8; ++i) H[i] = *(const u32x4*)(TBs + (EIDX_AT(ix.i0, ix.i1, 8 * (h) + i) * 128u + toff)); } while (0)
#define LD_AUX(a, k) do { if (AXPY) { const u8* b_ = ccB + (size_t)TOK(k) * 256; a[0] = *(const u32x4*)(b_ + coff); a[1] = *(const u32x4*)(b_ + coff + 16u); } \
    else { const u8* b_ = xnB + (size_t)TOK(k) * DM; a[0] = *(const u32x4*)(b_ + xoff); a[1].x = __float_as_uint(sxp[TOK(k)]); } } while (0)
  PeerIdx I0, I1, I2; u32x4 H0[8], H1[8], H2[8], X0[2], X1[2], X2[2];
  float av[16];
  u32x4 xq4 = {0, 0, 0, 0}; float sxk = 0.f;
  f32x2 acc[8];
#define T_BEGIN(X) do { if (AXPY) { unpk8(X[0], av); unpk8(X[1], av + 8); _Pragma("unroll") for (int q = 0; q < 8; ++q) acc[q] = (f32x2){0.f, 0.f}; } \
    else { xq4 = X[0]; sxk = __uint_as_float(X[1].x); } } while (0)
#define COMP(H, h, k) do { if ((k) < ntok) { \
    if (!AXPY) { float* o_ = pdB + (size_t)(tbeg + (k) * tstep) * 128 + r * 16 + 8 * (h); \
      _Pragma("unroll") for (int g = 0; g < 2; ++g) { float res[4]; \
        _Pragma("unroll") for (int ii = 0; ii < 4; ++ii) { const u32x4 w_ = H[4 * g + ii]; \
          int a_ = __builtin_amdgcn_sdot4((int)w_.x, (int)xq4.x, 0, false); a_ = __builtin_amdgcn_sdot4((int)w_.y, (int)xq4.y, a_, false); \
          a_ = __builtin_amdgcn_sdot4((int)w_.z, (int)xq4.z, a_, false); a_ = __builtin_amdgcn_sdot4((int)w_.w, (int)xq4.w, a_, false); \
          a_ += __builtin_amdgcn_mov_dpp(a_, 0xB1, 0xF, 0xF, true); a_ += __builtin_amdgcn_mov_dpp(a_, 0x4E, 0xF, 0xF, true); a_ += __builtin_amdgcn_mov_dpp(a_, 0x141, 0xF, 0xF, true); \
          res[ii] = (float)a_ * sxk; } \
        if (j == 0) *(f32x4*)(o_ + 4 * g) = (f32x4){res[0], res[1], res[2], res[3]}; } } \
    else { _Pragma("unroll") for (int i = 0; i < 8; ++i) { const u32x4 w_ = H[i]; const float ci = av[8 * (h) + i]; const f32x2 c2 = {ci, ci}; \
        acc[0] = fma2(cvt8lo(w_.x), c2, acc[0]); acc[1] = fma2(cvt8hi(w_.x), c2, acc[1]); acc[2] = fma2(cvt8lo(w_.y), c2, acc[2]); acc[3] = fma2(cvt8hi(w_.y), c2, acc[3]); \
        acc[4] = fma2(cvt8lo(w_.z), c2, acc[4]); acc[5] = fma2(cvt8hi(w_.z), c2, acc[5]); acc[6] = fma2(cvt8lo(w_.w), c2, acc[6]); acc[7] = fma2(cvt8hi(w_.w), c2, acc[7]); } } } } while (0)
  auto finalize = [&](int k) {
    if (!AXPY || k >= ntok) return;
    const int t = tbeg + k * tstep;
    float S[8];
#pragma unroll
    for (int q = 0; q < 8; ++q) { const float A = acc[q >> 1][q & 1], B = acc[(q + 8) >> 1][q & 1];
      auto rr = __builtin_amdgcn_permlane32_swap(__float_as_uint(A), __float_as_uint(B), false, false); S[q] = __uint_as_float(rr[0]) + __uint_as_float(rr[1]); }
    float Tq[4];
#pragma unroll
    for (int q = 0; q < 4; ++q) { auto rr = __builtin_amdgcn_permlane16_swap(__float_as_uint(S[q]), __float_as_uint(S[q + 4]), false, false); Tq[q] = __uint_as_float(rr[0]) + __uint_as_float(rr[1]); }
#pragma unroll
    for (int q = 0; q < 4; ++q) Tq[q] += dppf<0x128>(Tq[q]);
    float ss = 0.f;
    if ((lane & 8) == 0) {
      const size_t o = (size_t)t * DM + s * 128 + 16 * j + ((lane >> 5) & 1) * 8 + ((lane >> 4) & 1) * 4;
      const f32x4 x = *(const f32x4*)(xin + o);
      const f32x4 y = {x.x + Tq[0], x.y + Tq[1], x.z + Tq[2], x.w + Tq[3]};
      *(f32x4*)(xout + o) = y;
      if (!last) *(u32x2*)((u16*)(p.ws + WS_XG) + o) = (u32x2){pk2(y.x, y.y), pk2(y.z, y.w)};
      ss = (y.x * y.x + y.y * y.y) + (y.z * y.z + y.w * y.w);
    }
    ss = wave_sum(ss); if (lane == 0) ((float*)(p.ws + WS_SSQ))[(size_t)t * 8 + s] = ss;
  };
  LD_IDX(I0, 0); LD_IDX(I1, 1); LD_IDX(I2, 2); LD_HALF(H0, I0, 0); LD_HALF(H1, I0, 1); LD_AUX(X0, 0);
#pragma unroll 2
  for (int k = 0; k < ntok; k += 3) {
    LD_HALF(H2, I1, 0); LD_IDX(I0, k + 3); LD_AUX(X1, k + 1);
    T_BEGIN(X0); COMP(H0, 0, k);
    LD_HALF(H0, I1, 1);
    COMP(H1, 1, k); finalize(k);
    LD_HALF(H1, I2, 0); LD_IDX(I1, k + 4); LD_AUX(X2, k + 2);
    T_BEGIN(X1); COMP(H2, 0, k + 1);
    LD_HALF(H2, I2, 1);
    COMP(H0, 1, k + 1); finalize(k + 1);
    LD_HALF(H0, I0, 0); LD_IDX(I2, k + 5); LD_AUX(X0, k + 3);
    T_BEGIN(X2); COMP(H1, 0, k + 2);
    LD_HALF(H1, I0, 1);
    COMP(H2, 1, k + 2); finalize(k + 2);
  }
#undef TOK
#undef LD_IDX
#undef LD_HALF
#undef LD_AUX
#undef T_BEGIN
#undef COMP
}

DEVI void lru_passB(const Params& p, int item, int lane) {
  const int cg = item % 6, b = (item / 6) % NB, d = item / (6 * NB);
  const size_t o = (size_t)(d * NB + b) * NLCH * LRU_W + cg * 64 + lane;
  const float* Pp = (const float*)(p.ws + WS_LP) + o; const float* Hp = (const float*)(p.ws + WS_LH) + o; float* Cp = (float*)(p.ws + WS_LC) + o;
  float h = 0.f;
#pragma unroll 1
  for (int c0 = 0; c0 < NLCH; c0 += 32) {
    float pv[32], hv[32];
#pragma unroll
    for (int i = 0; i < 32; ++i) { const int cc = d ? NLCH - 1 - (c0 + i) : c0 + i; pv[i] = Pp[(size_t)cc * LRU_W]; hv[i] = Hp[(size_t)cc * LRU_W]; }
#pragma unroll
    for (int i = 0; i < 32; ++i) { const int cc = d ? NLCH - 1 - (c0 + i) : c0 + i; Cp[(size_t)cc * LRU_W] = h; h = fmaf(pv[i], h, hv[i]); }
  }
}

DEVI void swa_item(const Params& p, int layer, int item, char* lds) {
  const int tid = tidx(), wid = tid >> 6, lane = tid & 63, r32 = lane & 31, hi = lane >> 5;
  const int g = item & 1, n = (item >> 1) & 63, b = item >> 7;
  const int hq = 2 * g + (wid >> 2), qrow = n * 128 + (wid & 3) * 32;
  const u16* proj = (const u16*)(p.ws + WS_R1);
  const u16* Qw = proj + (size_t)(b * SEQ + qrow + r32) * INWP + PC_SQ + hq * 64 + hi * 8;
  const u16* Kh = proj + (size_t)(b * SEQ) * INWP + PC_SK + g * 64;
  const u16* Vh = proj + (size_t)(b * SEQ) * INWP + PC_SV + g * 64;
  const int kt0 = (2 * n - 2) < 0 ? 0 : (2 * n - 2), kt1 = (2 * n + 4) > SEQ / 64 ? SEQ / 64 : (2 * n + 4);
  const float sink = p.swa_sink[layer * 4 + hq];
  u16* Ow = (u16*)(p.ws + WS_MIX) + (size_t)(b * SEQ + qrow) * DM + 768 + hq * 64;
  attn_body<64, true>(Qw, Kh, INWP, Vh, INWP, kt0, kt1 - kt0, 0.125f, sink * 8.f, 1.f, qrow + r32, Ow, lds);
}
DEVI void mla_item(const Params& p, int pair, int qb, char* lds) {
  const int tid = tidx(), wid = tid >> 6, lane = tid & 63, r32 = lane & 31, hi = lane >> 5;
  const int b = pair / MLA_H, h = pair - b * MLA_H;
  const u16* Qw = (const u16*)(p.ws + WS_QM) + ((size_t)pair * SEQ + qb * 256 + wid * 32 + r32) * MLA_QK + hi * 8;
  const u16* Kh = (const u16*)(p.ws + WS_KM) + (size_t)pair * SEQ * MLA_QK;
  const u16* Vh = (const u16*)(p.ws + WS_VM) + (size_t)pair * SEQ * MLA_V;
  u16* Ow = (u16*)(p.ws + WS_MIX) + (size_t)(b * SEQ + qb * 256 + wid * 32) * DM + h * 64;
  attn_body<96, false>(Qw, Kh, MLA_QK, Vh, MLA_V, 0, SEQ / 64, 0.10206207261596575f, -1e30f, 0.f, 0, Ow, lds, (float)p.pos[b * SEQ + qb * 256 + wid * 32 + r32]);
}


namespace pg8 {
#define PG8_LAS __attribute__((address_space(3)))
constexpr int BM = 256, BK = 64, HALF = 128, HTB = HALF * BK * 2, NXCD = 8, WGM = 8;
DEVI int lds_byte(int r, int c) { const int st = (r >> 4) * 2 + (c >> 5), rr = r & 15, cc = c & 31, ob = rr * 64 + cc * 2; return st * 1024 + (ob ^ (((ob >> 9) & 1) << 5)); }
DEVI void stage_rc(int b, int& R, int& C) { const int st = b / 1024, sb = b % 1024, swz = sb ^ (((sb >> 9) & 1) << 5); R = (st >> 1) * 16 + swz / 64; C = (st & 1) * 32 + (swz % 64) / 2; }
DEVI int perm32(int rho) { const int n = rho >> 4, i = rho & 15; return 8 * (i >> 2) + 4 * n + (i & 3); }
struct Unit { int pm, pn; };
struct Gemm { const u16* A; const u16* Bt; int M, N, K, lda, ldb; };
struct StaticOrder {
  int nM, nN, nwg, G, c;
  DEVI void init(int M, int N, int G_, int c_) { nM = M / BM; nN = N / BM; nwg = nM * nN; G = G_; c = c_; }
  DEVI bool next(int i, Unit& u) const {
    const long L = (long)i * G + c; if (L >= nwg) return false;
    int wgid = (int)L; { const int q = nwg / NXCD, r = nwg % NXCD, xcd = wgid % NXCD, off = wgid / NXCD; wgid = (xcd < r ? xcd * (q + 1) : r * (q + 1) + (xcd - r) * q) + off; }
    const int nig = WGM * nN, gid = wgid / nig, fm = gid * WGM, gsz = (nM - fm) < WGM ? (nM - fm) : WGM;
    u.pm = fm + ((wgid % nig) % gsz); u.pn = (wgid % nig) / gsz; return true;
  }
};
template <class Epi>
DEVI void gemm_phase(PG8_LAS unsigned char* lds, const Gemm g, const StaticOrder& S, const Epi& E) {
  const int tid = tidx(), wid = __builtin_amdgcn_readfirstlane(tid >> 6), lane = tid & 63, wr = wid >> 2, wc = wid & 3, fr = lane & 15, fq = lane >> 4;
  const int K = g.K; int nt = K / BK; asm volatile("" : "+s"(nt));
  unsigned voffA[2], voffB[2];
#pragma unroll
  for (int i = 0; i < 2; ++i) { int R, C; stage_rc(tid * 16 + i * 8192, R, C); const int Rb = (R & ~31) + perm32(R & 31);
    voffA[i] = (unsigned)(R * g.lda + C) * 2u; voffB[i] = (unsigned)(Rb * g.ldb + C) * 2u; }
  const size_t kstep = (size_t)(BK * 2), hstepA = (size_t)HALF * g.lda * 2, hstepB = (size_t)HALF * g.ldb * 2, tstepA = 2 * hstepA, tstepB = 2 * hstepB;
  const unsigned ldsw = (unsigned)wid * 1024u;
  const int aoff = lds_byte(wr * 64 + fr, fq * 8), boff = lds_byte(wc * 32 + fr, fq * 8);
#define PG8_SA(b, h) (((b) * 2 + (h)) * HTB)
#define PG8_SB(b, h) ((4 + (b) * 2 + (h)) * HTB)
#define PG8_STAGE(bufoff, gbase, voff) do { _Pragma("unroll") for (int _i = 0; _i < 2; ++_i) \
    __builtin_amdgcn_global_load_lds((const unsigned*)((const char*)(gbase) + (voff)[_i]), (PG8_LAS unsigned*)(lds + (bufoff) + ldsw + _i * 8192), 16, 0, 0); } while (0)
#define PG8_LDA(dst, b, h) do { _Pragma("unroll") for (int m = 0; m < 4; ++m) _Pragma("unroll") for (int k = 0; k < 2; ++k) dst[m][k] = *(const PG8_LAS bf16x8*)(lds + PG8_SA(b, h) + aoff + m * 2048 + k * 1024); } while (0)
#define PG8_LDB(dst, b, h) do { _Pragma("unroll") for (int n = 0; n < 2; ++n) _Pragma("unroll") for (int k = 0; k < 2; ++k) dst[n][k] = *(const PG8_LAS bf16x8*)(lds + PG8_SB(b, h) + boff + n * 2048 + k * 1024); } while (0)
#define PG8_MMA(ai, bj, At, Bt) do { __builtin_amdgcn_s_setprio(1); _Pragma("unroll") for (int m = 0; m < 4; ++m) _Pragma("unroll") for (int n = 0; n < 2; ++n) _Pragma("unroll") for (int k = 0; k < 2; ++k) \
    acc[ai][bj][m][n] = __builtin_amdgcn_mfma_f32_16x16x32_bf16(Bt[n][k], At[m][k], acc[ai][bj][m][n], 0, 0, 0); __builtin_amdgcn_s_setprio(0); } while (0)
#define PG8_WAIT_V(n) asm volatile("s_waitcnt vmcnt(" #n ")" ::: "memory")
#define PG8_WAIT_L(n) asm volatile("s_waitcnt lgkmcnt(" #n ")" ::: "memory")
#define PG8_BAR __builtin_amdgcn_s_barrier()
#define PG8_SCHED __builtin_amdgcn_sched_barrier(0)
  Unit cur, nxt; int ui = 0;
  if (!S.next(0, cur)) return;
  f32x4 acc[2][2][4][2];
#pragma unroll
  for (int a = 0; a < 2; ++a)
#pragma unroll
    for (int b = 0; b < 2; ++b)
#pragma unroll
      for (int m = 0; m < 4; ++m)
#pragma unroll
        for (int n = 0; n < 2; ++n) acc[a][b][m][n] = (f32x4){0.f, 0.f, 0.f, 0.f};
  bf16x8 At[4][2], B0[2][2], B1[2][2];
  const char* cA = (const char*)g.A + (size_t)cur.pm * tstepA; const char* cB = (const char*)g.Bt + (size_t)cur.pn * tstepB;
  PG8_STAGE(PG8_SB(0, 0), cB, voffB); PG8_STAGE(PG8_SB(0, 1), cB + hstepB, voffB); PG8_STAGE(PG8_SA(0, 0), cA, voffA); PG8_STAGE(PG8_SA(0, 1), cA + hstepA, voffA);
  if (wr == 1) PG8_BAR;
  PG8_WAIT_V(2); PG8_BAR;
  PG8_STAGE(PG8_SB(1, 0), cB + kstep, voffB); PG8_STAGE(PG8_SA(1, 0), cA + kstep, voffA); PG8_STAGE(PG8_SB(1, 1), cB + hstepB + kstep, voffB);
  PG8_WAIT_V(6); PG8_BAR;
  for (;;) {
    const bool has_next = S.next(ui + 1, nxt);
    const char* nA = has_next ? (const char*)g.A + (size_t)nxt.pm * tstepA : cA; const char* nB = has_next ? (const char*)g.Bt + (size_t)nxt.pn * tstepB : cB;
#pragma unroll 1
    for (int t = 0; t < nt; t += 2) {
      const bool last = (t == nt - 2);
      const char* a1 = cA + (size_t)(t + 1) * kstep;
      const char* a2 = last ? nA : cA + (size_t)(t + 2) * kstep; const char* b2 = last ? nB : cB + (size_t)(t + 2) * kstep;
      const char* a3 = a2 + kstep; const char* b3 = b2 + kstep;
      PG8_LDB(B0, 0, 0); PG8_LDB(B1, 0, 1); PG8_SCHED; PG8_LDA(At, 0, 0); PG8_STAGE(PG8_SA(1, 1), a1 + hstepA, voffA);
      PG8_WAIT_V(8); PG8_WAIT_L(0); PG8_BAR; PG8_MMA(0, 0, At, B0); PG8_MMA(0, 1, At, B1); PG8_BAR; PG8_SCHED;
      PG8_LDA(At, 0, 1); PG8_STAGE(PG8_SB(0, 0), b2, voffB); PG8_STAGE(PG8_SB(0, 1), b2 + hstepB, voffB); PG8_STAGE(PG8_SA(0, 0), a2, voffA);
      PG8_WAIT_V(8); PG8_WAIT_L(0); PG8_BAR; PG8_MMA(1, 0, At, B0); PG8_MMA(1, 1, At, B1); PG8_BAR; PG8_SCHED;
      PG8_LDB(B0, 1, 0); PG8_LDB(B1, 1, 1); PG8_SCHED; PG8_LDA(At, 1, 0); PG8_STAGE(PG8_SA(0, 1), a2 + hstepA, voffA);
      PG8_WAIT_V(8); PG8_WAIT_L(0); PG8_BAR; PG8_MMA(0, 0, At, B0); PG8_MMA(0, 1, At, B1); PG8_BAR; PG8_SCHED;
      PG8_LDA(At, 1, 1); PG8_STAGE(PG8_SB(1, 0), b3, voffB); PG8_STAGE(PG8_SB(1, 1), b3 + hstepB, voffB); PG8_STAGE(PG8_SA(1, 0), a3, voffA);
      PG8_WAIT_V(8); PG8_WAIT_L(0); PG8_BAR; PG8_MMA(1, 0, At, B0); PG8_MMA(1, 1, At, B1); PG8_BAR; PG8_SCHED;
    }
    if (wr == 0) PG8_BAR;
    E(acc, cur, wr, wc, fr, fq);
    if (!has_next) break;
#pragma unroll
    for (int a = 0; a < 2; ++a)
#pragma unroll
      for (int b = 0; b < 2; ++b)
#pragma unroll
        for (int m = 0; m < 4; ++m)
#pragma unroll
          for (int n = 0; n < 2; ++n) acc[a][b][m][n] = (f32x4){0.f, 0.f, 0.f, 0.f};
    cur = nxt; cA = nA; cB = nB; ++ui;
    if (wr == 1) PG8_BAR;
  }
  PG8_WAIT_V(0);
  PG8_BAR;
#undef PG8_SA
#undef PG8_SB
#undef PG8_STAGE
#undef PG8_LDA
#undef PG8_LDB
#undef PG8_MMA
#undef PG8_WAIT_V
#undef PG8_WAIT_L
#undef PG8_BAR
#undef PG8_SCHED
}

DEVI float rs_from8(const float* s) { const f32x4 a = *(const f32x4*)s, b = *(const f32x4*)(s + 4); return rsqrtf((((a.x + a.y) + (a.z + a.w)) + ((b.x + b.y) + (b.z + b.w))) * (1.f / DM) + EPS); }
struct EpiProj { u16* proj; const int* pos; const float* ssq8; float* ssqq; float* ssqkv;
  DEVI void operator()(const f32x4 (&acc)[2][2][4][2], const Unit& u, int wr, int wc, int fr, int fq) const {
    const int row0 = u.pm * BM + wr * 64 + fr, col0 = u.pn * BM + wc * 32 + 8 * fq;
#pragma unroll
    for (int ai = 0; ai < 2; ++ai)
#pragma unroll
      for (int m = 0; m < 4; ++m) { const int row = row0 + ai * HALF + m * 16; const float rs = rs_from8(ssq8 + (size_t)row * 8); const float posf = (float)pos[row];
        float sq0 = 0.f, sq1 = 0.f;
#pragma unroll
        for (int bj = 0; bj < 2; ++bj) { const int gcol = col0 + bj * HALF;
          float v[8]; { const f32x4 a = acc[ai][bj][m][0] * rs, b = acc[ai][bj][m][1] * rs; v[0] = a.x; v[1] = a.y; v[2] = a.z; v[3] = a.w; v[4] = b.x; v[5] = b.y; v[6] = b.z; v[7] = b.w; }
          if (u.pn <= 1) { float s = 0.f;
#pragma unroll
            for (int q = 0; q < 8; ++q) s = fmaf(v[q], v[q], s);
            if (bj == 0) sq0 = s; else sq1 = s; }
          const bool r64 = gcol >= PC_SQ && gcol < PC_SV, r32g = gcol >= PC_KR && gcol < PC_KR + 32;
          if (r64 || r32g) {
#pragma unroll
            for (int q = 0; q < 4; ++q) { const int f = r64 ? (((gcol + 2 * q) & 63) >> 1) : 2 * (((gcol + 2 * q) & 31) >> 1); float sn, cs; rope_sc(posf, f, sn, cs);
              const float x1 = v[2 * q], x2 = v[2 * q + 1]; v[2 * q] = x1 * cs - x2 * sn; v[2 * q + 1] = x2 * cs + x1 * sn; } }
          *(u32x4*)(proj + (size_t)row * INWP + gcol) = pk8(v); }
        if (u.pn <= 1) { float s = u.pn == 0 ? sq0 + sq1 : sq0; s += __shfl_xor(s, 16); s += __shfl_xor(s, 32);
          if (fq == 0) (u.pn == 0 ? ssqq : ssqkv)[(size_t)row * 4 + wc] = s; } }
  }
};
struct EpiQ2 { u16* qm; const float* ssqq;
  DEVI void operator()(const f32x4 (&acc)[2][2][4][2], const Unit& u, int wr, int wc, int fr, int fq) const {
    const int b = (u.pm * BM) >> 13, s0 = (u.pm * BM) & (SEQ - 1), lrow = wr * 64 + fr;
    const float* sq = ssqq + (size_t)(u.pm * BM) * 4 + lrow * 4;
    float rs[2][4];
#pragma unroll
    for (int ai = 0; ai < 2; ++ai)
#pragma unroll
      for (int m = 0; m < 4; ++m) { const f32x4 sp = *(const f32x4*)(sq + (ai * HALF + m * 16) * 4); rs[ai][m] = rsqrtf(((sp.x + sp.y) + (sp.z + sp.w)) * (1.f / 256.f) + EPS); }
#pragma unroll
    for (int bj = 0; bj < 2; ++bj) { const int gcol = u.pn * BM + bj * HALF + wc * 32 + 8 * fq;
      if (gcol < 576) { const int head = (gcol * 683) >> 16, j0 = gcol - head * 96;
        u16* base = qm + ((size_t)(b * MLA_H + head) * SEQ + s0) * MLA_QK + (unsigned)(lrow * MLA_QK + j0);
#pragma unroll
        for (int ai = 0; ai < 2; ++ai)
#pragma unroll
          for (int m = 0; m < 4; ++m) { const float r = rs[ai][m];
            float v[8]; { const f32x4 a = acc[ai][bj][m][0] * r, bb = acc[ai][bj][m][1] * r; v[0] = a.x; v[1] = a.y; v[2] = a.z; v[3] = a.w; v[4] = bb.x; v[5] = bb.y; v[6] = bb.z; v[7] = bb.w; }
            *(u32x4*)(base + (ai * HALF + m * 16) * MLA_QK) = pk8(v); } } }
  }
};
struct EpiKV2 { u16* km; u16* vm; const float* ssqkv;
  DEVI void operator()(const f32x4 (&acc)[2][2][4][2], const Unit& u, int wr, int wc, int fr, int fq) const {
    const int b = (u.pm * BM) >> 13, s0 = (u.pm * BM) & (SEQ - 1), lrow = wr * 64 + fr;
    const float* sq = ssqkv + (size_t)(u.pm * BM) * 4 + lrow * 4;
    float rs[2][4];
#pragma unroll
    for (int ai = 0; ai < 2; ++ai)
#pragma unroll
      for (int m = 0; m < 4; ++m) { const f32x4 sp = *(const f32x4*)(sq + (ai * HALF + m * 16) * 4); rs[ai][m] = rsqrtf(((sp.x + sp.y) + (sp.z + sp.w)) * (1.f / 128.f) + EPS); }
#pragma unroll
    for (int bj = 0; bj < 2; ++bj) { const int head = u.pn * 2 + bj, c = wc * 32 + 8 * fq;
      const size_t tok0 = (size_t)(b * MLA_H + head) * SEQ + s0;
      u16* base = c < 64 ? km + tok0 * MLA_QK + (unsigned)(lrow * MLA_QK + c) : vm + tok0 * MLA_V + (unsigned)(lrow * MLA_V + (c - 64));
      const int ld = c < 64 ? MLA_QK : MLA_V;
#pragma unroll
      for (int ai = 0; ai < 2; ++ai)
#pragma unroll
        for (int m = 0; m < 4; ++m) { const float r = rs[ai][m];
          float v[8]; { const f32x4 a = acc[ai][bj][m][0] * r, bb = acc[ai][bj][m][1] * r; v[0] = a.x; v[1] = a.y; v[2] = a.z; v[3] = a.w; v[4] = bb.x; v[5] = bb.y; v[6] = bb.z; v[7] = bb.w; }
          *(u32x4*)(base + (ai * HALF + m * 16) * ld) = pk8(v); } }
  }
};
struct EpiPQ { u16* O; const float* ssq16;
  DEVI void operator()(const f32x4 (&acc)[2][2][4][2], const Unit& u, int wr, int wc, int fr, int fq) const {
    const int row0 = u.pm * BM + wr * 64 + fr, col0 = u.pn * BM + wc * 32 + 8 * fq;
#pragma unroll
    for (int ai = 0; ai < 2; ++ai)
#pragma unroll
      for (int m = 0; m < 4; ++m) { const int row = row0 + ai * HALF + m * 16;
        const f32x4* sp = (const f32x4*)(ssq16 + (size_t)row * 16); const f32x4 s4 = (sp[0] + sp[1]) + (sp[2] + sp[3]);
        const float rs = rsqrtf(((s4.x + s4.y) + (s4.z + s4.w)) * (1.f / DM) + EPS);
#pragma unroll
        for (int bj = 0; bj < 2; ++bj) { float v[8]; { const f32x4 a = acc[ai][bj][m][0] * rs, b = acc[ai][bj][m][1] * rs; v[0] = a.x; v[1] = a.y; v[2] = a.z; v[3] = a.w; v[4] = b.x; v[5] = b.y; v[6] = b.z; v[7] = b.w; }
          *(u32x4*)(O + (size_t)row * 2048 + col0 + bj * HALF) = pk8(v); } }
  }
};
struct EpiRes { const float* xres; float* xout; u16* xg; float* ssq16;
  DEVI void operator()(const f32x4 (&acc)[2][2][4][2], const Unit& u, int wr, int wc, int fr, int fq) const {
    const int row0 = u.pm * BM + wr * 64 + fr, col0 = u.pn * BM + wc * 32 + 8 * fq;
#pragma unroll
    for (int ai = 0; ai < 2; ++ai)
#pragma unroll
      for (int m = 0; m < 4; ++m) { const int row = row0 + ai * HALF + m * 16; float ss = 0.f;
#pragma unroll
        for (int bj = 0; bj < 2; ++bj) { const size_t o = (size_t)row * DM + col0 + bj * HALF;
          float x[8]; ld8(xres + o, x);
          const f32x4 a = acc[ai][bj][m][0], b = acc[ai][bj][m][1];
          x[0] += a.x; x[1] += a.y; x[2] += a.z; x[3] += a.w; x[4] += b.x; x[5] += b.y; x[6] += b.z; x[7] += b.w;
#pragma unroll
          for (int q = 0; q < 8; ++q) ss = fmaf(x[q], x[q], ss);
          *(f32x4*)(xout + o) = (f32x4){x[0], x[1], x[2], x[3]}; *(f32x4*)(xout + o + 4) = (f32x4){x[4], x[5], x[6], x[7]};
          *(u32x4*)(xg + o) = pk8(x); }
        ss += __shfl_xor(ss, 16); ss += __shfl_xor(ss, 32);
        if (fq == 0) ssq16[(size_t)row * 16 + u.pn * 4 + wc] = ss; }
  }
};
}


DEVI void lru_gate_item(const Params& p, int l, int mt, int n, char* lds) {
  const int tid = tidx(), lane = tid & 63, wid = tid >> 6, wm = wid >> 1, wn = wid & 1, r32 = lane & 31, hi = lane >> 5;
  const int srow = tid >> 3, sc = tid & 7, m0 = mt * 256;
  const u16* PROJ = (const u16*)(p.ws + WS_R1);
  GemmDesc g{}; g.proj = PROJ; g.cw = p.conv_w + l * 4 * LRU_W; g.cb = p.conv_b + l * LRU_W; g.ch0 = n * 64;
  char* Ab = lds; char* Bb = lds + 32768;
  { bf16x8 ar[4], br[4];
#pragma unroll
    for (int i = 0; i < 4; ++i) ar[i] = load_a<1>(g, m0 + srow + 64 * i, sc * 8);
    const u16* W = (const u16*)(p.ws + WS_WLRU) + (size_t)((l * 6 + n) * 2) * 128 * 64;
#pragma unroll
    for (int i = 0; i < 4; ++i) br[i] = *(const bf16x8*)(W + (size_t)(srow + 64 * i) * 64 + sc * 8);
#pragma unroll
    for (int i = 0; i < 4; ++i) { *(bf16x8*)(Ab + swz(srow + 64 * i, sc)) = ar[i]; *(bf16x8*)(Bb + (i >> 1) * 16384 + swz(srow + 64 * (i & 1), sc)) = br[i]; } }
  __syncthreads();
  bf16x8 a[2][4];
#pragma unroll
  for (int t = 0; t < 2; ++t)
#pragma unroll
    for (int k = 0; k < 4; ++k) a[t][k] = *(const bf16x8*)(Ab + swz(wm * 64 + t * 32 + r32, k * 2 + hi));
  const int jl = 32 * wn + r32, ch = n * 64 + jl;
  float xf[2][16];
#pragma unroll
  for (int t = 0; t < 2; ++t)
#pragma unroll
    for (int r = 0; r < 16; ++r) { const int row = wm * 64 + t * 32 + crow(r, hi); xf[t][r] = bf2f(*(const u16*)(Ab + swz(row, jl >> 3) + (jl & 7) * 2)); }
  const int bidx = m0 >> 13, s0 = (m0 & (SEQ - 1)) + wm * 64;
#pragma unroll
  for (int d = 0; d < 2; ++d) {
    f32x16 acc[2][2] = {{f32x16{}, f32x16{}}, {f32x16{}, f32x16{}}};
#pragma unroll
    for (int k = 0; k < 4; ++k) { bf16x8 b[2];
#pragma unroll
      for (int q = 0; q < 2; ++q) b[q] = *(const bf16x8*)(Bb + d * 16384 + swz(wn * 64 + q * 32 + r32, k * 2 + hi));
#pragma unroll
      for (int t = 0; t < 2; ++t)
#pragma unroll
        for (int q = 0; q < 2; ++q) acc[t][q] = __builtin_amdgcn_mfma_f32_32x32x16_bf16(a[t][k], b[q], acc[t][q], 0, 0, 0); }
    const float bav = p.lru_ba[((l * 2 + d) * 6 + n) * 64 + jl], bxv = p.lru_bx[((l * 2 + d) * 6 + n) * 64 + jl];
    const float cdec = -8.f * log1pf(__expf(-p.lru_lambda[(l * 2 + d) * LRU_W + ch]));
    u16* le = (u16*)(p.ws + WS_LE); u16* lb = (u16*)(p.ws + WS_LB);
    float runP[2][4], runH[2][4];
#pragma unroll
    for (int t = 0; t < 2; ++t)
#pragma unroll
      for (int rr = 0; rr < 4; ++rr) {
        float ev[4], bv[4];
#pragma unroll
        for (int q = 0; q < 4; ++q) { const int r = rr * 4 + q;
          const float rg = sigmoidf_(acc[t][0][r] + bav), ig = sigmoidf_(acc[t][1][r] + bxv);
          const float aa = __expf(cdec * rg), e = 1.f - aa; ev[q] = e; bv[q] = sqrtf(e * (2.f - e)) * ig * xf[t][r]; }
        const size_t o = (((size_t)(d * NB + bidx) * (SEQ / 8) + ((s0 + 32 * t + 8 * rr) >> 3)) * LRU_W + ch) * 8 + 4 * hi;
        const u32x2 ew = {pk2(ev[0], ev[1]), pk2(ev[2], ev[3])}, bw = {pk2(bv[0], bv[1]), pk2(bv[2], bv[3])};
        *(u32x2*)(le + o) = ew; *(u32x2*)(lb + o) = bw;
        const float a0 = 1.f - bflo(ew.x), a1 = 1.f - bfhi(ew.x), a2 = 1.f - bflo(ew.y), a3 = 1.f - bfhi(ew.y);
        const float b0 = bflo(bw.x), b1 = bfhi(bw.x), b2 = bflo(bw.y), b3 = bfhi(bw.y);
        if (d == 0) { runP[t][rr] = (a0 * a1) * (a2 * a3); runH[t][rr] = fmaf(a3, fmaf(a2, fmaf(a1, b0, b1), b2), b3); }
        else { runP[t][rr] = (a0 * a1) * (a2 * a3); runH[t][rr] = fmaf(a0, fmaf(a1, fmaf(a2, b3, b2), b1), b0); } }
    { float Pc = 1.f, Hc = 0.f;
#pragma unroll
      for (int i = 0; i < 8; ++i) { const int ii = d == 0 ? i : 7 - i, t = ii >> 2, rr = ii & 3;
        auto rp = __builtin_amdgcn_permlane32_swap(__float_as_uint(runP[t][rr]), __float_as_uint(runP[t][rr]), false, false);
        auto rh = __builtin_amdgcn_permlane32_swap(__float_as_uint(runH[t][rr]), __float_as_uint(runH[t][rr]), false, false);
        const float P0 = __uint_as_float(rp[0]), P1 = __uint_as_float(rp[1]), H0 = __uint_as_float(rh[0]), H1 = __uint_as_float(rh[1]);
        if (d == 0) { Hc = fmaf(P0, Hc, H0); Pc *= P0; Hc = fmaf(P1, Hc, H1); Pc *= P1; }
        else { Hc = fmaf(P1, Hc, H1); Pc *= P1; Hc = fmaf(P0, Hc, H0); Pc *= P0; } }
      if (hi == 0) { const size_t o = ((size_t)(d * NB + bidx) * NLCH + (s0 >> 6)) * LRU_W + ch;
        ((float*)(p.ws + WS_LP))[o] = Pc; ((float*)(p.ws + WS_LH))[o] = Hc; } }
  }
  __syncthreads();
}


DEVI void sort16_desc(float (&v)[16]) {
#pragma unroll
  for (int k = 2; k <= 16; k <<= 1)
#pragma unroll
    for (int j = k >> 1; j > 0; j >>= 1)
#pragma unroll
      for (int i = 0; i < 16; ++i) { const int l = i ^ j; if (l > i) { const float a = v[i], b = v[l]; const bool desc = (i & k) == 0;
          v[i] = desc ? fmaxf(a, b) : fminf(a, b); v[l] = desc ? fminf(a, b) : fmaxf(a, b); } }
}
DEVI void merge16_desc(float (&l)[16], const float (&s)[16]) {
#pragma unroll
  for (int i = 0; i < 16; ++i) l[i] = fmaxf(l[i], s[15 - i]);
#pragma unroll
  for (int st = 8; st >= 1; st >>= 1)
#pragma unroll
    for (int i = 0; i < 16; ++i) if ((i & st) == 0) ce_desc(l[i], l[i + st]);
}
DEVI void pair_merge16(float (&l)[16]) {
  float o[16];
#pragma unroll
  for (int i = 0; i < 16; ++i) o[i] = __shfl_xor(l[i], 1);
  merge16_desc(l, o);
}
DEVI void top16_from_C(const float* C, int row, int part, float (&l)[16]) {
#pragma unroll
  for (int i = 0; i < 16; ++i) l[i] = -3.0e38f;
#pragma unroll 1
  for (int bt = 0; bt < 4; ++bt) { float s[16];
#pragma unroll
    for (int i = 0; i < 16; ++i) { const int col = part * 64 + ((bt * 16 + i + row) & 63);
      s[i] = __uint_as_float((__float_as_uint(C[row * CLD + col]) & ~127u) | (unsigned)(127 - col)); }
    sort16_desc(s);
    merge16_desc(l, s); }
  pair_merge16(l);
}
DEVI void peer_route_item(const Params& p, int l, int mt, int h, char* lds) {
  const int tid = tidx(), row = tid >> 1, part = tid & 1, m0 = mt * 256;
  const u16* PQ = (const u16*)(p.ws + WS_R1);
  float t1[16], t2[16];
#pragma unroll
  for (int j = 0; j < 2; ++j) {
    GemmDesc g{}; g.A = PQ + (h * 2 + j) * 128; g.lda = 2048; g.Bt = (const u16*)(p.ws + WS_SUBK) + (size_t)(l * 2 + j) * 128 * 128; g.ldb = 128; g.KT = 2;
    gemm_core<0, 0>(g, m0, 0, lds);
    if (j == 0) top16_from_C((const float*)lds, row, part, t1); else top16_from_C((const float*)lds, row, part, t2);
    __syncthreads(); }
  constexpr int CA[50] = {0, 0, 0, 0, 0, 0, 0, 0, 0, 0, 0, 0, 0, 0, 0, 0, 1, 1, 1, 1, 1, 1, 1, 1, 2, 2, 2, 2, 2, 3, 3, 3, 3, 4, 4, 4, 5, 5, 6, 6, 7, 7, 8, 9, 10, 11, 12, 13, 14, 15};
  constexpr int CB[50] = {0, 1, 2, 3, 4, 5, 6, 7, 8, 9, 10, 11, 12, 13, 14, 15, 0, 1, 2, 3, 4, 5, 6, 7, 0, 1, 2, 3, 4, 0, 1, 2, 3, 0, 1, 2, 0, 1, 0, 1, 0, 1, 0, 0, 0, 0, 0, 0, 0, 0};
  float lo[16], hi2[16];
#pragma unroll
  for (int k = 0; k < 32; ++k) { float v = -3.0e38f;
    if (k < 25) { const float v0 = __uint_as_float((__float_as_uint(t1[CA[2 * k]] + t2[CB[2 * k]]) & ~255u) | (unsigned)(255 - (CA[2 * k] * 16 + CB[2 * k])));
      const float v1 = __uint_as_float((__float_as_uint(t1[CA[2 * k + 1]] + t2[CB[2 * k + 1]]) & ~255u) | (unsigned)(255 - (CA[2 * k + 1] * 16 + CB[2 * k + 1])));
      v = part ? v1 : v0; }
    if (k < 16) lo[k] = v; else hi2[k - 16] = v; }
  sort16_desc(lo); sort16_desc(hi2); merge16_desc(lo, hi2); pair_merge16(lo);
  const float mx = __uint_as_float(__float_as_uint(lo[0]) & ~255u);
  float w[16], sum = 0.f;
#pragma unroll
  for (int i = 0; i < 16; ++i) { w[i] = __expf(__uint_as_float(__float_as_uint(lo[i]) & ~255u) - mx); sum += w[i]; }
  const float inv = 1.f / sum;
  unsigned char* my = (unsigned char*)lds + tid * 32;
#pragma unroll
  for (int i = 0; i < 16; ++i) { my[i] = (unsigned char)(127u - (__float_as_uint(t1[i]) & 127u)); my[16 + i] = (unsigned char)(127u - (__float_as_uint(t2[i]) & 127u)); }
  unsigned ev[8]; float gv[8];
  const unsigned pm = 0u - (unsigned)part;
#pragma unroll
  for (int i = 0; i < 8; ++i) { const unsigned xb = __float_as_uint(lo[i]) ^ ((__float_as_uint(lo[i]) ^ __float_as_uint(lo[8 + i])) & pm); const unsigned code = 255u - (xb & 255u);
    const unsigned wb = __float_as_uint(w[i]) ^ ((__float_as_uint(w[i]) ^ __float_as_uint(w[8 + i])) & pm);
    ev[i] = (unsigned)my[code >> 4] * 128u + (unsigned)my[16 + (code & 15)]; gv[i] = __uint_as_float(wb) * inv; }
  const size_t o = ((size_t)(m0 + row) * 8 + h) * 16 + part * 8;
  *(u32x4*)((u16*)(p.ws + WS_EIDX) + o) = (u32x4){ev[0] | (ev[1] << 16), ev[2] | (ev[3] << 16), ev[4] | (ev[5] << 16), ev[6] | (ev[7] << 16)};
  *(f32x4*)((float*)(p.ws + WS_EGATE) + o) = (f32x4){gv[0], gv[1], gv[2], gv[3]}; *(f32x4*)((float*)(p.ws + WS_EGATE) + o + 4) = (f32x4){gv[4], gv[5], gv[6], gv[7]};
  __syncthreads();
}

constexpr int PH_PER_LAYER = 10, N_PHASES = 2 + DEPTH * PH_PER_LAYER;
DEVI void run_phase(const Params& pin, int ph, int vb, int nb, char* lds) {
  const bool dry = ph >= 100; if (dry) ph -= 100;
  Params p = pin; { size_t z = 0; asm volatile("" : "+s"(z)); p.ws = pin.ws + z; p.out = pin.out + z; } asm volatile("" : "+s"(vb));
  const int tid = tidx(), wid = tid >> 6, lane = tid & 63;
#ifdef ONLY_SP
  if (ONLY_SP >= 0 && ph == 0) return;
#endif
  if (ph == 0) { phase0(p, vb, nb, lds); return; }
  if (ph == N_PHASES - 1) {
    const float* ssq = (const float*)(p.ws + WS_SSQ);
    for (size_t i = (size_t)vb * NTHREADS + tid; i < (size_t)T * DM / 8; i += (size_t)nb * NTHREADS) {
      const size_t t = i >> 7; const int c = (int)(i & 127) * 8;
      float s8[8]; ld8(ssq + t * 8, s8); const float rs = rsqrtf((((s8[0] + s8[1]) + (s8[2] + s8[3])) + ((s8[4] + s8[5]) + (s8[6] + s8[7]))) * (1.f / DM) + EPS);
      float x[8], g[8]; ld8(p.out + i * 8, x); ld8(p.norm_final + c, g);
#pragma unroll
      for (int q = 0; q < 8; ++q) x[q] *= rs * g[q];
      *(f32x4*)(p.out + i * 8) = (f32x4){x[0], x[1], x[2], x[3]}; *(f32x4*)(p.out + i * 8 + 4) = (f32x4){x[4], x[5], x[6], x[7]}; }
    return; }
  const int l = (ph - 1) / PH_PER_LAYER, sp = (ph - 1) % PH_PER_LAYER;
  u16* const XG = (u16*)(p.ws + WS_XG); u16* const PROJ = (u16*)(p.ws + WS_R1); u16* const MIX = (u16*)(p.ws + WS_MIX);
  constexpr int NMT = T / 256;
#ifdef ONLY_SP
  if (sp != ONLY_SP) return;
#endif
  switch (sp) {
  case 0: {
    pg8::Gemm g{XG, (const u16*)(p.ws + WS_WIN) + (size_t)l * INWP * DM, T, INWP, DM, DM, DM}; pg8::StaticOrder S; S.init(T, INWP, nb, vb);
    pg8::EpiProj e{PROJ, p.pos, (const float*)(p.ws + WS_SSQ), (float*)(p.ws + WS_SSQQ), (float*)(p.ws + WS_SSQKV)};
    pg8::gemm_phase((PG8_LAS unsigned char*)lds, g, S, e);
  } break;
  case 1: {
    { pg8::Gemm g{PROJ + PC_CQ, (const u16*)(p.ws + WS_WUQ) + (size_t)l * 768 * 256, T, 768, 256, INWP, 256}; pg8::StaticOrder S; S.init(T, 768, nb, vb);
      pg8::EpiQ2 e{(u16*)(p.ws + WS_QM), (const float*)(p.ws + WS_SSQQ)};
      pg8::gemm_phase((PG8_LAS unsigned char*)lds, g, S, e); }
    { pg8::Gemm g{PROJ + PC_CKV, (const u16*)(p.ws + WS_WUKV) + (size_t)l * 768 * 128, T, 768, 128, INWP, 128}; pg8::StaticOrder S; S.init(T, 768, nb, nb - 1 - vb);
      pg8::EpiKV2 e{(u16*)(p.ws + WS_KM), (u16*)(p.ws + WS_VM), (const float*)(p.ws + WS_SSQKV)};
      pg8::gemm_phase((PG8_LAS unsigned char*)lds, g, S, e); }
    for (int i = vb * NTHREADS + tid; i < T * MLA_H * 4; i += nb * NTHREADS) { const int c = (i & 3) * 8, h = (i >> 2) % MLA_H, row = i / (4 * MLA_H), b = row >> 13, s = row & (SEQ - 1);
      *(u32x4*)((u16*)(p.ws + WS_KM) + ((size_t)(b * MLA_H + h) * SEQ + s) * MLA_QK + 64 + c) = *(const u32x4*)(PROJ + (size_t)row * INWP + PC_KR + c); }
    for (int it = vb; it < NMT * 6; it += nb) lru_gate_item(p, l, it / 6, it % 6, lds);
    for (int it = vb; it < NB * 64 * 2; it += nb) swa_item(p, l, it, lds);
  } break;
  case 2: {
    { const int wi = vb * 8 + wid; if (wi < 48) lru_passB(p, wi, lane); __syncthreads(); }
    for (int k = 0; k * nb + vb < NB * MLA_H * 32; ++k) {
      int pair, qb;
      if (nb == 256) { pair = k * 8 + (vb & 7); qb = vb >> 3; } else { const int it = k * nb + vb; pair = it >> 5; qb = it & 31; }
      mla_item(p, pair, qb, lds);
    }
  } break;
  case 3: {
#ifndef NO_LRUF
    if (!dry) for (int it = vb; it < NB * NLCH; it += nb) lru_final(p, it, lds);
#endif
    for (int t = vb * 8 + wid; t < T; t += nb * 8) {
      u32x4* rp = (u32x4*)(MIX + (size_t)t * DM + lane * 16);
      float v[16]; unpk8(rp[0], v); unpk8(rp[1], v + 8);
      float s = 0.f;
#pragma unroll
      for (int q = 0; q < 16; ++q) s = fmaf(v[q], v[q], s);
      const int sg = lane < 24 ? 0 : (lane < 48 ? 1 : 2);
      const float s0 = wave_sum(sg == 0 ? s : 0.f), s2 = wave_sum(sg == 2 ? s : 0.f);
      const float rs = sg == 0 ? rsqrtf(s0 * (1.f / 384.f) + EPS) : rsqrtf(s2 * (1.f / 256.f) + EPS);
      if (sg != 1) {
#pragma unroll
        for (int q = 0; q < 16; ++q) v[q] *= rs;
        rp[0] = pk8(v); rp[1] = pk8(v + 8); } }
  } break;
  case 4: {
    { pg8::Gemm g{MIX, (const u16*)(p.ws + WS_WOUT) + (size_t)l * DM * DM, T, DM, DM, DM, DM}; pg8::StaticOrder S; S.init(T, DM, nb, vb);
      pg8::EpiRes e{l == 0 ? p.x : p.out, dry ? (float*)(p.ws + WS_R1) : p.out, XG, (float*)(p.ws + WS_SSQ16)};
      pg8::gemm_phase((PG8_LAS unsigned char*)lds, g, S, e); }
    const float* us = p.peer_u + (size_t)l * NEXP * DM; const float* vs = p.peer_v + (size_t)l * NEXP * DM;
    u8* ub = (u8*)(p.ws + WS_UB); u8* vbf = (u8*)(p.ws + WS_VB);
    for (size_t i = (size_t)vb * NTHREADS + tid; i < (size_t)NEXP * 64; i += (size_t)nb * NTHREADS) {
      const size_t e = i >> 6; const int c16 = (int)(i & 63), s = c16 >> 3, cc = (c16 & 7) * 16;
      float a[16], b[16]; ld8(us + i * 16, a); ld8(us + i * 16 + 8, a + 8); ld8(vs + i * 16, b); ld8(vs + i * 16 + 8, b + 8);
#pragma unroll
      for (int q = 0; q < 16; ++q) b[q] *= PEER_SV;
      const size_t o = ((size_t)s * NEXP + e) * 128 + cc;
      *(u32x4*)(ub + o) = (u32x4){q8x4(a, PEER_SU), q8x4(a + 4, PEER_SU), q8x4(a + 8, PEER_SU), q8x4(a + 12, PEER_SU)};
      *(u32x4*)(vbf + o) = (u32x4){enc4(b[0], b[1], b[2], b[3]), enc4(b[4], b[5], b[6], b[7]), enc4(b[8], b[9], b[10], b[11]), enc4(b[12], b[13], b[14], b[15])}; }
  } break;
  case 5: {
    pg8::Gemm g{XG, (const u16*)(p.ws + WS_WQ) + (size_t)l * 2048 * DM, T, 2048, DM, DM, DM}; pg8::StaticOrder S; S.init(T, 2048, nb, vb);
    pg8::EpiPQ e{PROJ, (const float*)(p.ws + WS_SSQ16)};
    pg8::gemm_phase((PG8_LAS unsigned char*)lds, g, S, e);
  } break;
  case 6: {
    for (int it = vb; it < NMT * 8; it += nb) peer_route_item(p, l, it >> 3, it & 7, lds);
    if (!dry) peer_xn_pass(p, l, vb, nb);
  } break;
  case 7: case 9: {
    const bool last = l == DEPTH - 1;
    float* xo = dry ? (float*)(p.ws + WS_PD) : p.out;
    int s0, s1, tb, ts;
    if ((nb & 7) == 0) { s0 = vb & 7; s1 = s0 + 1; tb = (vb >> 3) * 8 + wid; ts = (nb >> 3) * 8; } else { s0 = 0; s1 = 8; tb = vb * 8 + wid; ts = nb * 8; }
#pragma unroll 1
    for (int s = s0; s < s1; ++s) { if (sp == 7) peer_slice_phase<false>(p, s, tb, ts, lane, p.out, xo, last); else peer_slice_phase<true>(p, s, tb, ts, lane, p.out, xo, last); }
  } break;
  case 8: {
    const float* pd = (const float*)(p.ws + WS_PD); const float* eg = (const float*)(p.ws + WS_EGATE); u16* cc = (u16*)(p.ws + WS_CC);
    for (size_t i = (size_t)vb * NTHREADS + tid; i < (size_t)T * 128 / 4; i += (size_t)nb * NTHREADS) {
      f32x4 a = *(const f32x4*)(pd + i * 4);
#pragma unroll
      for (int s = 1; s < 8; ++s) a += *(const f32x4*)(pd + (size_t)s * T * 128 + i * 4);
      const f32x4 g = *(const f32x4*)(eg + i * 4);
      f32x4 o; o.x = gelu_erf(a.x * (1.f / PEER_SU)) * g.x * (1.f / PEER_SV); o.y = gelu_erf(a.y * (1.f / PEER_SU)) * g.y * (1.f / PEER_SV);
      o.z = gelu_erf(a.z * (1.f / PEER_SU)) * g.z * (1.f / PEER_SV); o.w = gelu_erf(a.w * (1.f / PEER_SU)) * g.w * (1.f / PEER_SV);
      *(u32x2*)(cc + i * 4) = (u32x2){pk2(o.x, o.y), pk2(o.z, o.w)}; }
  } break;
  }
}

#define XB_TMO      128
#define XB_XCNT(j)  (256  + 64 * (j))
#define XB_XSUB(j)  (1280 + 64 * (j))
#define XB_XGEN(j)  (2304 + 64 * (j))
#define XB_TOP      3328
#define XB_TOPGEN   3392
#define XCD_BAR_WORDS 3456
#define XB_SPIN_CAP (1u << 23)
DEVI unsigned xb_ld(unsigned* p) { return __hip_atomic_load(p, __ATOMIC_RELAXED, __HIP_MEMORY_SCOPE_AGENT); }
DEVI unsigned xb_add(unsigned* p, unsigned v) { return __hip_atomic_fetch_add(p, v, __ATOMIC_RELAXED, __HIP_MEMORY_SCOPE_AGENT); }
DEVI unsigned xb_xcc_id() { return (unsigned)__builtin_amdgcn_s_getreg((3 << 11) | 20) & 0xFu; }
#define XB_SPIN(cond, bar) do { unsigned _sp = 0; while (cond) { __builtin_amdgcn_s_sleep(1); \
    if ((++_sp & 255u) == 0u) { if (xb_ld(&(bar)[XB_TMO])) break; if (_sp > XB_SPIN_CAP) { atomicAdd(&(bar)[XB_TMO], 1u); break; } } } } while (0)
struct XcdBarrier { unsigned* bar; unsigned x; volatile unsigned* st; };
DEVI XcdBarrier xcd_barrier_post(unsigned* bar, volatile unsigned* st) {
  XcdBarrier b; b.bar = bar; b.x = xb_xcc_id(); b.st = st;
  if (threadIdx.x == 0) (void)xb_add(&bar[XB_XCNT(b.x)], 1u);
  return b;
}
DEVI void xcd_barrier_complete(unsigned* bar, unsigned x, unsigned& nloc, unsigned& nx) {
  const unsigned G = gridDim.x * gridDim.y * gridDim.z;
  unsigned sum, cnt, mine, sp = 0u;
  for (;;) {
    sum = 0u; cnt = 0u; mine = 0u;
#pragma unroll
    for (unsigned j = 0; j < 16; ++j) { const unsigned c = xb_ld(&bar[XB_XCNT(j)]); sum += c; cnt += (c > 0u) ? 1u : 0u; mine = (j == x) ? c : mine; }
    if (sum == G) break;
    __builtin_amdgcn_s_sleep(1);
    if ((++sp & 255u) == 0u) { if (xb_ld(&bar[XB_TMO])) break; if (sp > XB_SPIN_CAP) { atomicAdd(&bar[XB_TMO], 1u); break; } }
  }
  nloc = mine > 0u ? mine : 1u; nx = cnt > 0u ? cnt : 1u;
}
DEVI void xcd_barrier(const XcdBarrier& b) {
  asm volatile("s_waitcnt vmcnt(0)" ::: "memory");
  __syncthreads();
  if (threadIdx.x == 0) {
    unsigned* bar = b.bar;
    __builtin_amdgcn_s_waitcnt(0);
    unsigned nloc = b.st[0], nx = b.st[1];
    if (nloc == 0u) { xcd_barrier_complete(bar, b.x, nloc, nx); b.st[0] = nloc; b.st[1] = nx; }
    const unsigned old = xb_add(&bar[XB_XSUB(b.x)], 1u);
    const unsigned gen = old / nloc;
    if (old + 1u == (gen + 1u) * nloc) {
      __builtin_amdgcn_fence(__ATOMIC_RELEASE, "agent");
      asm volatile("s_waitcnt vmcnt(0)" ::: "memory");
      const unsigned og = xb_add(&bar[XB_TOP], 1u);
      const unsigned tg = og / nx;
      if (og + 1u == (tg + 1u) * nx) xb_add(&bar[XB_TOPGEN], 1u);
      else XB_SPIN(xb_ld(&bar[XB_TOPGEN]) == tg, bar);
      __builtin_amdgcn_fence(__ATOMIC_ACQUIRE, "agent");
      xb_add(&bar[XB_XGEN(b.x)], 1u);
      asm volatile("s_waitcnt vmcnt(0)" ::: "memory");
    } else {
      XB_SPIN(xb_ld(&bar[XB_XGEN(b.x)]) == gen, bar);
      __builtin_amdgcn_fence(__ATOMIC_ACQUIRE, "agent");
      asm volatile("s_waitcnt vmcnt(0)" ::: "memory");
    }
  }
  __syncthreads();
}

__global__ void __launch_bounds__(NTHREADS, 2) mega(Params p) {
  extern __shared__ __attribute__((aligned(16))) char smem[];
  cg::grid_group grid = cg::this_grid();
  const int nb = gridDim.x, vb = blockIdx.x;
  volatile unsigned* st = (volatile unsigned*)(smem + LDS_BYTES - 16);
  if (threadIdx.x == 0) { st[0] = 0u; st[1] = 0u; }
  __syncthreads();
  const XcdBarrier bar = xcd_barrier_post((unsigned*)p.ws, st);
#define GRID_BAR(first) do { if (first) grid.sync(); else xcd_barrier(bar); } while (0)
  for (int ph = p.ph_lo; ph < p.ph_hi; ++ph) {
#ifdef PROBE_DUP
    if (ph > 0 && ph < N_PHASES - 1 && ((PROBE_DUP >> ((ph - 1) % PH_PER_LAYER)) & 1)) { run_phase(p, ph + 100, vb, nb, smem); GRID_BAR(false); }
#endif
    run_phase(p, ph, vb, nb, smem);
    if (ph + 1 < p.ph_hi) GRID_BAR(ph == p.ph_lo);
  }
}

#ifndef N_LAUNCH_SPLIT
#define N_LAUNCH_SPLIT 0
#endif
extern "C" void kernel_launch(void* const* d_in, const int* in_sizes, int n_in, void* d_out, int out_size, void* d_ws, size_t ws_size, hipStream_t stream) {
  static int grid_blocks = 0;
  if (grid_blocks == 0) {
    if (n_in != 24 || out_size != T * DM || ws_size < WS_NEED) { fprintf(stderr, "kernel_launch: unexpected shapes n_in %d out %d ws %zu\n", n_in, out_size, ws_size); grid_blocks = -1; return; }
    int dev = 0, cus = 0, per_cu = 0;
    (void)hipGetDevice(&dev); (void)hipDeviceGetAttribute(&cus, hipDeviceAttributeMultiprocessorCount, dev);
    if (hipFuncSetAttribute((const void*)mega, hipFuncAttributeMaxDynamicSharedMemorySize, LDS_BYTES) != hipSuccess) { fprintf(stderr, "kernel_launch: hipFuncSetAttribute failed\n"); grid_blocks = -1; return; }
    if (hipOccupancyMaxActiveBlocksPerMultiprocessor(&per_cu, (const void*)mega, NTHREADS, LDS_BYTES) != hipSuccess || per_cu < 1) { fprintf(stderr, "kernel_launch: occupancy query failed (%d)\n", per_cu); grid_blocks = -1; return; }
    grid_blocks = cus * 1;
    fprintf(stderr, "kernel_launch: cus %d per_cu %d grid %d\n", cus, per_cu, grid_blocks);
  }
  if (grid_blocks < 0) return;
  if (hipMemsetAsync(d_ws, 0, 65536, stream) != hipSuccess) { fprintf(stderr, "kernel_launch: memset failed\n"); return; }
  Params p{};
  p.x = (const float*)d_in[0]; p.pos = (const int*)d_in[1]; p.norm_mix = (const float*)d_in[2]; p.w_in = (const float*)d_in[3]; p.q_norm = (const float*)d_in[4];
  p.w_uq = (const float*)d_in[5]; p.kv_norm = (const float*)d_in[6]; p.w_ukv = (const float*)d_in[7]; p.conv_w = (const float*)d_in[8]; p.conv_b = (const float*)d_in[9];
  p.lru_wa = (const float*)d_in[10]; p.lru_ba = (const float*)d_in[11]; p.lru_wx = (const float*)d_in[12]; p.lru_bx = (const float*)d_in[13]; p.lru_lambda = (const float*)d_in[14];
  p.swa_sink = (const float*)d_in[15]; p.grp_norm = (const float*)d_in[16]; p.w_out = (const float*)d_in[17]; p.norm_ffn = (const float*)d_in[18]; p.peer_wq = (const float*)d_in[19];
  p.peer_subkeys = (const float*)d_in[20]; p.peer_u = (const float*)d_in[21]; p.peer_v = (const float*)d_in[22]; p.norm_final = (const float*)d_in[23];
  p.out = (float*)d_out; p.ws = (unsigned char*)d_ws;
#if N_LAUNCH_SPLIT
  for (int ph = 0; ph < N_PHASES; ++ph) {
    p.ph_lo = ph; p.ph_hi = ph + 1;
    void* args[] = {&p};
    hipError_t e = hipLaunchCooperativeKernel((const void*)mega, dim3(grid_blocks), dim3(NTHREADS), args, LDS_BYTES, stream);
    if (e != hipSuccess) { fprintf(stderr, "kernel_launch: launch of phase %d failed: %s\n", ph, hipGetErrorString(e)); break; }
  }
#else
  p.ph_lo = 0; p.ph_hi = N_PHASES;
  void* args[] = {&p};
  hipError_t e = hipLaunchCooperativeKernel((const void*)mega, dim3(grid_blocks), dim3(NTHREADS), args, LDS_BYTES, stream);
  if (e != hipSuccess) fprintf(stderr, "kernel_launch: cooperative launch failed: %s (grid %d)\n", hipGetErrorString(e), grid_blocks);
#endif
}
```

```cpp
#include <hip/hip_runtime.h>
#include <hip/hip_cooperative_groups.h>
#include <cstdio>
#include <cstdint>
namespace cg = cooperative_groups;

#define DEVI __device__ __forceinline__
typedef unsigned short u16;
typedef short bf16x8 __attribute__((ext_vector_type(8)));
typedef short s16x4 __attribute__((ext_vector_type(4)));
typedef float f32x2 __attribute__((ext_vector_type(2)));
typedef float f32x4 __attribute__((ext_vector_type(4)));
typedef float f32x16 __attribute__((ext_vector_type(16)));
typedef unsigned u32x4 __attribute__((ext_vector_type(4)));
typedef unsigned u32x2 __attribute__((ext_vector_type(2)));
typedef __bf16 bf16x2_t __attribute__((ext_vector_type(2)));

constexpr int NB = 4, SEQ = 8192, T = NB * SEQ, DM = 1024, DEPTH = 2;
constexpr int MLA_H = 6, MLA_QK = 96, MLA_V = 64;
constexpr int LRU_W = 384;
constexpr int INW = 1696, INWP = 1792;
constexpr int PC_CQ = 0, PC_CKV = 256, PC_SQ = 384, PC_SK = 640, PC_SV = 768, PC_LX = 896, PC_LG = 1280, PC_KR = 1664;
constexpr int OC_CQ = 0, OC_CKV = 256, OC_KR = 384, OC_SQ = 416, OC_SK = 672, OC_SV = 800, OC_LX = 928, OC_LG = 1312;
constexpr int NEXP = 16384;
constexpr float EPS = 1e-6f;
constexpr int NTHREADS = 512;
constexpr int LDS_BYTES = 160 * 1024;

constexpr size_t MiB = 1u << 20;
constexpr size_t WS_CTL = 0;
constexpr size_t WS_WIN = 4 * MiB;
constexpr size_t WS_WQ = 11 * MiB;
constexpr size_t WS_WOUT = 19 * MiB;
constexpr size_t WS_WUQ = 23 * MiB;
constexpr size_t WS_WUKV = WS_WUQ + 2 * 768 * 256 * 2;
constexpr size_t WS_WLRU = WS_WUKV + 2 * 768 * 128 * 2;
constexpr size_t WS_SUBK = WS_WLRU + 2 * 6 * 2 * 128 * 64 * 2;
constexpr size_t WS_XG = 25 * MiB;
constexpr size_t WS_R1 = 89 * MiB;
constexpr size_t WS_QM = 217 * MiB;
constexpr size_t WS_KM = 253 * MiB;
constexpr size_t WS_VM = 289 * MiB;
constexpr size_t WS_LE = 313 * MiB;
constexpr size_t WS_LB = 361 * MiB;
constexpr size_t WS_MIX = 409 * MiB;
constexpr size_t WS_UB = 478 * MiB;
constexpr size_t WS_VB = 494 * MiB;
constexpr size_t WS_TOP = 281 * MiB;
constexpr size_t WS_EIDX = 313 * MiB;
constexpr size_t WS_EGATE = 329 * MiB;
constexpr size_t WS_CC = 345 * MiB;
constexpr size_t WS_SSQ = 361 * MiB;
constexpr size_t WS_SSQ16 = 363 * MiB;
constexpr size_t WS_SSQQ = 476 * MiB;
constexpr size_t WS_SSQKV = 477 * MiB;
constexpr size_t WS_PD = 89 * MiB;
constexpr float PEER_SU = 903.f, PEER_SV = 56.f;
constexpr size_t WS_CS = 349 * MiB;
constexpr size_t WS_XQ = 249 * MiB;
constexpr size_t WS_SX = 281 * MiB;
constexpr size_t WS_END = 473 * MiB;

__device__ const float ROPE_HI[32] = {1.591549367e-01f, 1.193493679e-01f, 8.949939907e-02f, 6.711508334e-02f, 5.032921210e-02f, 3.774158657e-02f, 2.830219641e-02f, 2.122365311e-02f, 1.591549441e-02f, 1.193493698e-02f, 8.949940093e-03f, 6.711508147e-03f, 5.032921210e-03f, 3.774158424e-03f, 2.830219688e-03f, 2.122365171e-03f, 1.591549488e-03f, 1.193493721e-03f, 8.949940093e-04f, 6.711508031e-04f, 5.032921326e-04f, 3.774158540e-04f, 2.830219455e-04f, 2.122365258e-04f, 1.591549371e-04f, 1.193493736e-04f, 8.949940093e-05f, 6.711508468e-05f, 5.032921035e-05f, 3.774158540e-05f, 2.830219637e-05f, 2.122365186e-05f};
__device__ const float ROPE_LO[32] = {6.420638243e-09f, 2.294664903e-09f, 2.542919653e-09f, -3.316028840e-10f, 5.173299289e-12f, -1.848551645e-09f, -5.826552019e-10f, -3.431038786e-10f, -1.029942243e-10f, 4.320196978e-11f, 6.802744479e-11f, 1.531042237e-10f, 5.173301024e-13f, 4.797548470e-11f, -1.048316434e-10f, 1.053879969e-10f, -5.686555046e-11f, -1.896286773e-11f, 6.802744999e-12f, 2.695195456e-11f, -1.158979943e-11f, -6.843983713e-12f, 1.279990003e-11f, 1.807650600e-12f, 5.954976963e-12f, -3.351478166e-12f, 6.802744674e-13f, -1.670379113e-12f, 1.751403167e-12f, -6.843983930e-13f, -5.389994549e-13f, 9.083608431e-13f};

DEVI int tidx() { int t = __builtin_amdgcn_workitem_id_x(); asm volatile("" : "+v"(t)); return t; }
DEVI float bf2f(unsigned h) { return __uint_as_float(h << 16); }
DEVI float bflo(unsigned w) { return __uint_as_float(w << 16); }
DEVI float bfhi(unsigned w) { return __uint_as_float(w & 0xffff0000u); }
DEVI unsigned pk2(float lo, float hi) { f32x2 v = {lo, hi}; bf16x2_t b = __builtin_convertvector(v, bf16x2_t); return __builtin_bit_cast(unsigned, b); }
DEVI u16 f2bf(float f) { return (u16)(pk2(f, 0.f) & 0xffffu); }
DEVI u32x4 pk8(const float* v) { u32x4 w; w.x = pk2(v[0], v[1]); w.y = pk2(v[2], v[3]); w.z = pk2(v[4], v[5]); w.w = pk2(v[6], v[7]); return w; }
DEVI void unpk8(u32x4 w, float* v) { v[0] = bflo(w.x); v[1] = bfhi(w.x); v[2] = bflo(w.y); v[3] = bfhi(w.y); v[4] = bflo(w.z); v[5] = bfhi(w.z); v[6] = bflo(w.w); v[7] = bfhi(w.w); }
DEVI void ld8(const float* p, float* v) { const f32x4 a = *(const f32x4*)p, b = *(const f32x4*)(p + 4); v[0] = a.x; v[1] = a.y; v[2] = a.z; v[3] = a.w; v[4] = b.x; v[5] = b.y; v[6] = b.z; v[7] = b.w; }
DEVI int crow(int r, int hi) { return (r & 3) + 8 * (r >> 2) + 4 * hi; }
DEVI float wave_sum(float v) {
#pragma unroll
  for (int o = 1; o < 64; o <<= 1) v += __shfl_xor(v, o);
  return v;
}
DEVI void rope_sc(float pos, int fidx, float& sn, float& cs) {
  const float chi = ROPE_HI[fidx], clo = ROPE_LO[fidx];
  const float t = pos * chi, e = fmaf(pos, chi, -t);
  float fr = t - rintf(t);
  fr = fr + (e + pos * clo);
  sn = __builtin_amdgcn_sinf(fr); cs = __builtin_amdgcn_cosf(fr);
}
DEVI float sigmoidf_(float x) { return 1.f / (1.f + __expf(-x)); }
DEVI float gelu_erf(float x) { return 0.5f * x * (1.f + erff(x * 0.70710678118654752f)); }

struct Params {
  const float* x; const int* pos; const float* norm_mix; const float* w_in; const float* q_norm; const float* w_uq; const float* kv_norm; const float* w_ukv;
  const float* conv_w; const float* conv_b; const float* lru_wa; const float* lru_ba; const float* lru_wx; const float* lru_bx; const float* lru_lambda;
  const float* swa_sink; const float* grp_norm; const float* w_out; const float* norm_ffn; const float* peer_wq; const float* peer_subkeys;
  const float* peer_u; const float* peer_v; const float* norm_final;
  float* out; unsigned char* ws;
  int ph_lo, ph_hi;
};

DEVI void tconv_item(const float* W, int ldw, int src_c0, u16* WT, int K, int dst_r0, const float* gain, float* scr, int kb, int nb, int lane, int pg = 0) {
  const int k0 = 64 * kb, n0 = 32 * nb;
#pragma unroll 8
  for (int i = 0; i < 32; ++i) { const int kk = 2 * i + (lane >> 5); float g = gain ? gain[k0 + kk] : 1.f; scr[kk * 33 + (lane & 31)] = g * W[(size_t)(k0 + kk) * ldw + src_c0 + n0 + (lane & 31)]; }
  __builtin_amdgcn_s_waitcnt(0xc07f); asm volatile("" ::: "memory");
  const int c = lane & 7;
#pragma unroll
  for (int j = 0; j < 4; ++j) { const int n = (lane >> 3) + 8 * j; const float* s = scr + (8 * c) * 33 + n;
    u32x4 o; o.x = pk2(s[0 * 33], s[1 * 33]); o.y = pk2(s[2 * 33], s[3 * 33]); o.z = pk2(s[4 * 33], s[5 * 33]); o.w = pk2(s[6 * 33], s[7 * 33]);
    int nn = n0 + n; if (pg > 0) { const int g = nn & ~(pg - 1), i = nn & (pg - 1), hw = pg >> 1; nn = g + (i < hw ? 2 * i : 2 * (i - hw) + 1); }
    else if (pg < 0) { const int j = nn % 96; if (j >= 64) { const int i = j - 64; nn = nn - i + (i < 16 ? 2 * i : 2 * (i - 16) + 1); } }
    *(u32x4*)(WT + (size_t)(dst_r0 + nn) * K + k0 + 8 * c) = o; }
  __builtin_amdgcn_s_waitcnt(0xc07f); asm volatile("" ::: "memory");
}

DEVI void p0_item(const Params& p, int it, float* scr, int lane) {
  const int l = it / 2552; int r = it - l * 2552;
  const float* win = p.w_in + (size_t)l * DM * INW; u16* wint = (u16*)(p.ws + WS_WIN) + (size_t)l * INWP * DM; const float* gm = p.norm_mix + l * DM;
#define SEG(W, ldw, sc0, ncols, WT, K, dr0, gain, pg) { const int nnb_ = (ncols) / 32, ni_ = ((K) / 64) * nnb_; if (r < ni_) { tconv_item(W, ldw, sc0, WT, K, dr0, gain, scr, r / nnb_, r % nnb_, lane, pg); return; } r -= ni_; }
  SEG(win, INW, OC_CQ, 256, wint, DM, PC_CQ, gm, 0)
  SEG(win, INW, OC_CKV, 128, wint, DM, PC_CKV, gm, 0)
  SEG(win, INW, OC_SQ, 256, wint, DM, PC_SQ, gm, 64)
  SEG(win, INW, OC_SK, 128, wint, DM, PC_SK, gm, 64)
  SEG(win, INW, OC_SV, 128, wint, DM, PC_SV, gm, 0)
  SEG(win, INW, OC_LX, 384, wint, DM, PC_LX, gm, 0)
  SEG(win, INW, OC_LG, 384, wint, DM, PC_LG, gm, 0)
  SEG(win, INW, OC_KR, 32, wint, DM, PC_KR, gm, 32)
  SEG(p.peer_wq + (size_t)l * DM * 2048, 2048, 0, 2048, (u16*)(p.ws + WS_WQ) + (size_t)l * 2048 * DM, DM, 0, p.norm_ffn + l * DM, 0)
  SEG(p.w_out + (size_t)l * DM * DM, DM, 0, DM, (u16*)(p.ws + WS_WOUT) + (size_t)l * DM * DM, DM, 0, p.grp_norm + l * DM, 0)
  SEG(p.w_uq + (size_t)l * 256 * 576, 576, 0, 576, (u16*)(p.ws + WS_WUQ) + (size_t)l * 768 * 256, 256, 0, p.q_norm + l * 256, -1)
  SEG(p.w_ukv + (size_t)l * 128 * 768, 768, 0, 768, (u16*)(p.ws + WS_WUKV) + (size_t)l * 768 * 128, 128, 0, p.kv_norm + l * 128, 0)
#undef SEG
  { const int nbk = r & 1, ax = (r >> 1) & 1, n = (r >> 2) % 6, d = (r >> 2) / 6;
    const float* W = (ax ? p.lru_wx : p.lru_wa) + ((size_t)(l * 2 + d) * 6 + n) * 4096;
    u16* WT = (u16*)(p.ws + WS_WLRU) + ((size_t)((l * 6 + n) * 2 + d)) * 128 * 64;
    tconv_item(W, 64, 0, WT, 64, 32 * nbk + 32 * ax, nullptr, scr, 0, nbk, lane); }
}

DEVI void phase0(const Params& p, int vb, int nb, char* lds) {
  const int tid = tidx(), lane = tid & 63, wid = tid >> 6;
  float* scr = (float*)(lds + wid * 16384);
  const int gw = vb * 8 + wid, ngw = nb * 8;
  for (int it = gw; it < DEPTH * 2552; it += ngw) p0_item(p, it, scr, lane);
  for (int i = vb * NTHREADS + tid; i < DEPTH * 96 * DM / 8; i += nb * NTHREADS) { const int l = i / (96 * DM / 8), r = i % (96 * DM / 8);
    *(u32x4*)((u16*)(p.ws + WS_WIN) + ((size_t)l * INWP + INW) * DM + (size_t)r * 8) = (u32x4){0, 0, 0, 0}; }
  for (int i = vb * NTHREADS + tid; i < DEPTH * 192 * 256 / 8; i += nb * NTHREADS) { const int l = i / (192 * 256 / 8), r = i % (192 * 256 / 8);
    *(u32x4*)((u16*)(p.ws + WS_WUQ) + ((size_t)l * 768 + 576) * 256 + (size_t)r * 8) = (u32x4){0, 0, 0, 0}; }
  for (int i = vb * NTHREADS + tid; i < DEPTH * 2 * 128 * 128 / 8; i += nb * NTHREADS) {
    float a[8]; ld8(p.peer_subkeys + (size_t)i * 8, a);
    *(u32x4*)((u16*)(p.ws + WS_SUBK) + (size_t)i * 8) = pk8(a); }
  { float* ssq = (float*)(p.ws + WS_SSQ); u16* xg = (u16*)(p.ws + WS_XG);
    for (int t = gw * 2; t < T; t += ngw * 2) {
      float a[2][16];
#pragma unroll
      for (int u = 0; u < 2; ++u) { ld8(p.x + (size_t)(t + u) * DM + lane * 16, a[u]); ld8(p.x + (size_t)(t + u) * DM + lane * 16 + 8, a[u] + 8); }
#pragma unroll
      for (int u = 0; u < 2; ++u) { float s = 0.f;
#pragma unroll
        for (int q = 0; q < 16; ++q) s = fmaf(a[u][q], a[u][q], s);
        s += __shfl_xor(s, 1); s += __shfl_xor(s, 2); s += __shfl_xor(s, 4);
        if ((lane & 7) == 0) ssq[(size_t)(t + u) * 8 + (lane >> 3)] = s;
        u32x4* o = (u32x4*)(xg + (size_t)(t + u) * DM + lane * 16); o[0] = pk8(a[u]); o[1] = pk8(a[u] + 8); } } }
}

DEVI int swz(int row, int c) { return row * 128 + ((c ^ ((row >> 1) & 7)) << 4); }
constexpr int CLD = 132;
constexpr int LDS_RS = 135168;

struct GemmDesc {
  const u16* A; int lda; const u16* Bt; int ldb; int KT;
  float inv0;
  const u16* proj; const float* cw; const float* cb; int ch0;
};

template <int AMODE> DEVI bf16x8 load_a(const GemmDesc& g, int row, int kcol) {
  if constexpr (AMODE == 0) {
    return *(const bf16x8*)(g.A + (size_t)row * g.lda + kcol);
  } else {
    const int s = row & (SEQ - 1), ch = g.ch0 + kcol;
    float a[8];
    { const f32x4 b0 = *(const f32x4*)(g.cb + ch), b1 = *(const f32x4*)(g.cb + ch + 4); a[0] = b0.x; a[1] = b0.y; a[2] = b0.z; a[3] = b0.w; a[4] = b1.x; a[5] = b1.y; a[6] = b1.z; a[7] = b1.w; }
#pragma unroll
    for (int tap = 0; tap < 4; ++tap) {
      const int ss = s - 1 + tap;
      if (ss >= 0 && ss < SEQ) {
        const u32x4 v = *(const u32x4*)(g.proj + (size_t)(row - 1 + tap) * INWP + PC_LX + ch);
        float x[8]; unpk8(v, x);
        const f32x4 w0 = *(const f32x4*)(g.cw + tap * LRU_W + ch), w1 = *(const f32x4*)(g.cw + tap * LRU_W + ch + 4);
        a[0] += w0.x * x[0]; a[1] += w0.y * x[1]; a[2] += w0.z * x[2]; a[3] += w0.w * x[3];
        a[4] += w1.x * x[4]; a[5] += w1.y * x[5]; a[6] += w1.z * x[6]; a[7] += w1.w * x[7];
      }
    }
    const u32x4 o = pk8(a);
    return __builtin_bit_cast(bf16x8, o);
  }
}

template <int AMODE> DEVI void g_load(const GemmDesc& g, bf16x8 (&ar)[4], bf16x8 (&br)[2], int m0, int n0, int srow, int sc, int kt) {
#pragma unroll
  for (int i = 0; i < 4; ++i) ar[i] = load_a<AMODE>(g, m0 + srow + 64 * i, kt * 64 + sc * 8);
#pragma unroll
  for (int i = 0; i < 2; ++i) br[i] = *(const bf16x8*)(g.Bt + (size_t)(n0 + srow + 64 * i) * g.ldb + kt * 64 + sc * 8);
}
template <bool NORM> DEVI void g_write(char* Ab, const bf16x8 (&ar)[4], const bf16x8 (&br)[2], float (&ssq)[4], int srow, int sc) {
  char* Bb = Ab + 32768;
#pragma unroll
  for (int i = 0; i < 4; ++i) { *(bf16x8*)(Ab + swz(srow + 64 * i, sc)) = ar[i];
    if (NORM) { float x[8]; unpk8(__builtin_bit_cast(u32x4, ar[i]), x); float s = ssq[i];
#pragma unroll
      for (int q = 0; q < 8; ++q) s = fmaf(x[q], x[q], s);
      ssq[i] = s; } }
#pragma unroll
  for (int i = 0; i < 2; ++i) *(bf16x8*)(Bb + swz(srow + 64 * i, sc)) = br[i];
}

template <int AMODE, int SEG>
DEVI void gemm_core(const GemmDesc& g, int m0, int n0, char* lds) {
  const int tid = tidx(), lane = tid & 63, wid = tid >> 6;
  const int wm = wid >> 1, wn = wid & 1, r32 = lane & 31, hi = lane >> 5;
  const int srow = tid >> 3, sc = tid & 7;
  constexpr bool NORM = SEG != 0;
  float* rs = (float*)(lds + LDS_RS);
  f32x16 acc[2][2], acc2[2][2];
#pragma unroll
  for (int i = 0; i < 2; ++i)
#pragma unroll
    for (int j = 0; j < 2; ++j) { acc[i][j] = f32x16{}; acc2[i][j] = f32x16{}; }
  float ssq[4] = {0.f, 0.f, 0.f, 0.f};
  bf16x8 ar[4], br[2];
  g_load<AMODE>(g, ar, br, m0, n0, srow, sc, 0); g_write<NORM>(lds, ar, br, ssq, srow, sc); __syncthreads();
  int seg = 0;
#pragma unroll 1
  for (int kt = 0; kt < g.KT; ++kt) {
    const int cur = kt & 1;
    if (kt + 1 < g.KT) g_load<AMODE>(g, ar, br, m0, n0, srow, sc, kt + 1);
    { const char* Ab = lds + cur * 49152; const char* Bb = Ab + 32768;
#pragma unroll
      for (int k16 = 0; k16 < 4; ++k16) {
        bf16x8 a[2], b[2];
#pragma unroll
        for (int mt = 0; mt < 2; ++mt) a[mt] = *(const bf16x8*)(Ab + swz(wm * 64 + mt * 32 + r32, k16 * 2 + hi));
#pragma unroll
        for (int nt = 0; nt < 2; ++nt) b[nt] = *(const bf16x8*)(Bb + swz(wn * 64 + nt * 32 + r32, k16 * 2 + hi));
#pragma unroll
        for (int mt = 0; mt < 2; ++mt)
#pragma unroll
          for (int nt = 0; nt < 2; ++nt) {
            if (NORM) acc2[mt][nt] = __builtin_amdgcn_mfma_f32_32x32x16_bf16(a[mt], b[nt], acc2[mt][nt], 0, 0, 0);
            else acc[mt][nt] = __builtin_amdgcn_mfma_f32_32x32x16_bf16(a[mt], b[nt], acc[mt][nt], 0, 0, 0);
          }
      } }
    if (NORM) {
      int se; float inv;
      if (SEG == 1) { se = g.KT; inv = g.inv0; }
      else { se = seg == 0 ? 6 : (seg == 1 ? 12 : 16); inv = seg == 2 ? (1.f / 256.f) : (1.f / 384.f); }
      if (kt + 1 == se) {
#pragma unroll
        for (int i = 0; i < 4; ++i) { float s = ssq[i]; s += __shfl_xor(s, 1); s += __shfl_xor(s, 2); s += __shfl_xor(s, 4); if (sc == 0) rs[srow + 64 * i] = rsqrtf(s * inv + EPS); }
        __syncthreads();
#pragma unroll
        for (int mt = 0; mt < 2; ++mt)
#pragma unroll
          for (int r = 0; r < 16; ++r) { const float f = rs[wm * 64 + mt * 32 + crow(r, hi)];
#pragma unroll
            for (int nt = 0; nt < 2; ++nt) { acc[mt][nt][r] = fmaf(f, acc2[mt][nt][r], acc[mt][nt][r]); acc2[mt][nt][r] = 0.f; } }
        ssq[0] = ssq[1] = ssq[2] = ssq[3] = 0.f;
        ++seg;
      }
    }
    if (kt + 1 < g.KT) g_write<NORM>(lds + (cur ^ 1) * 49152, ar, br, ssq, srow, sc);
    __syncthreads();
  }
  float* C = (float*)lds;
#pragma unroll
  for (int mt = 0; mt < 2; ++mt)
#pragma unroll
    for (int nt = 0; nt < 2; ++nt)
#pragma unroll
      for (int r = 0; r < 16; ++r) C[(wm * 64 + mt * 32 + crow(r, hi)) * CLD + wn * 64 + nt * 32 + r32] = acc[mt][nt][r];
  __syncthreads();
}
template <int AMODE, int SEG, class Epi>
DEVI void gemm_tile(const GemmDesc& g, int m0, int n0, char* lds, const Epi& epi) {
  gemm_core<AMODE, SEG>(g, m0, n0, lds);
  epi((const float*)lds, m0, n0);
  __syncthreads();
}

DEVI GemmDesc gemm_desc(const u16* A, int lda, const u16* Bt, int ldb, int K) {
  GemmDesc g{}; g.A = A; g.lda = lda; g.Bt = Bt; g.ldb = ldb; g.KT = K / 64; g.inv0 = 1.f / (float)K; return g;
}


template <int HW> DEVI void rope8(float* v, const float* pp, int i0, float posf) {
  const bool first = i0 < HW; const int f0 = i0 & (HW - 1);
#pragma unroll
  for (int j = 0; j < 8; ++j) { float sn, cs; rope_sc(posf, HW == 32 ? (f0 + j) : 2 * (f0 + j), sn, cs); const float pv = pp[j]; v[j] = first ? v[j] * cs - pv * sn : v[j] * cs + pv * sn; }
}

struct EpiP1 { u16* proj; const int* pos;
  DEVI void operator()(const float* C, int m0, int n0) const {
    const int tid = tidx();
#pragma unroll 1
    for (int it = 0; it < 8; ++it) { const int item = it * NTHREADS + tid, row = item >> 4, c8 = (item & 15) * 8, gcol = n0 + c8, grow = m0 + row;
      float v[8]; ld8(C + row * CLD + c8, v);
      const bool r64 = gcol >= PC_SQ && gcol < PC_SV, r32g = gcol >= PC_KR && gcol < PC_KR + 32;
      if (r64) { const int i0 = gcol & 63; float pp[8]; ld8(C + row * CLD + c8 + (i0 < 32 ? 32 : -32), pp); rope8<32>(v, pp, i0, (float)pos[grow]); }
      else if (r32g) { const int i0 = gcol & 31; float pp[8]; ld8(C + row * CLD + c8 + (i0 < 16 ? 16 : -16), pp); rope8<16>(v, pp, i0, (float)pos[grow]); }
      *(u32x4*)(proj + (size_t)grow * INWP + gcol) = pk8(v);
    }
  }
};

struct EpiQ { u16* qm; const int* pos;
  DEVI void operator()(const float* C, int m0, int n0) const {
    const int tid = tidx();
#pragma unroll 1
    for (int it = 0; it < 8; ++it) { const int item = it * NTHREADS + tid, row = item >> 4, c8 = (item & 15) * 8, gcol = n0 + c8, grow = m0 + row;
      if (gcol >= 576) continue;
      const int head = gcol / 96, j0 = gcol - head * 96, b = grow >> 13, s = grow & (SEQ - 1);
      float v[8]; ld8(C + row * CLD + c8, v);
      u16* qrow = qm + ((size_t)(b * MLA_H + head) * SEQ + s) * MLA_QK;
      if (j0 >= 64) { const int i0 = j0 - 64; float pp[8]; ld8(C + row * CLD + c8 + (i0 < 16 ? 16 : -16), pp); rope8<16>(v, pp, i0, (float)pos[grow]);
#pragma unroll
        for (int j = 0; j < 8; ++j) { const int i = i0 + j; qrow[64 + (i < 16 ? 2 * i : 2 * (i - 16) + 1)] = f2bf(v[j]); } }
      else *(u32x4*)(qrow + j0) = pk8(v);
    }
  }
};

struct EpiKV { u16* km; u16* vm; const u16* proj;
  DEVI void operator()(const float* C, int m0, int n0) const {
    const int tid = tidx(), head = n0 >> 7;
#pragma unroll 1
    for (int it = 0; it < 8; ++it) { const int item = it * NTHREADS + tid, row = item >> 4, c8 = (item & 15) * 8, grow = m0 + row;
      const int b = grow >> 13, s = grow & (SEQ - 1);
      float v[8]; ld8(C + row * CLD + c8, v);
      const size_t tok = (size_t)(b * MLA_H + head) * SEQ + s;
      if (c8 < 64) *(u32x4*)(km + tok * MLA_QK + c8) = pk8(v);
      else *(u32x4*)(vm + tok * MLA_V + (c8 - 64)) = pk8(v);
    }
#pragma unroll 1
    for (int it = 0; it < 2; ++it) { const int item = it * NTHREADS + tid, row = item >> 2, c = (item & 3) * 8, grow = m0 + row;
      const int b = grow >> 13, s = grow & (SEQ - 1);
      *(u32x4*)(km + ((size_t)(b * MLA_H + head) * SEQ + s) * MLA_QK + 64 + c) = *(const u32x4*)(proj + (size_t)grow * INWP + PC_KR + c);
    }
  }
};

struct EpiLRU { const u16* proj; const float* cw; const float* cb; const float* ba; const float* bx; const float* lam; u16* le; u16* lb; int n, d;
  DEVI void operator()(const float* C, int m0, int) const {
    const int tid = tidx();
#pragma unroll 1
    for (int it = 0; it < 4; ++it) { const int item = it * NTHREADS + tid, j = item & 63, g8 = item >> 6;
      const int ch = n * 64 + j, grow0 = m0 + g8 * 8, s0 = grow0 & (SEQ - 1), b = grow0 >> 13;
      const float bav = ba[(d * 6 + n) * 64 + j], bxv = bx[(d * 6 + n) * 64 + j];
      const float cdec = -8.f * log1pf(__expf(-lam[d * LRU_W + ch]));
      float xin[11];
#pragma unroll
      for (int q = 0; q < 11; ++q) { const int ss = s0 - 1 + q; xin[q] = (ss >= 0 && ss < SEQ) ? bf2f(proj[(size_t)(grow0 - 1 + q) * INWP + PC_LX + ch]) : 0.f; }
      const float w0 = cw[ch], w1 = cw[LRU_W + ch], w2 = cw[2 * LRU_W + ch], w3 = cw[3 * LRU_W + ch], cbv = cb[ch];
      float ev[8], bv[8];
#pragma unroll
      for (int rr = 0; rr < 8; ++rr) {
        const float xf = cbv + w0 * xin[rr] + w1 * xin[rr + 1] + w2 * xin[rr + 2] + w3 * xin[rr + 3];
        const float r = sigmoidf_(C[(g8 * 8 + rr) * CLD + j] + bav), ig = sigmoidf_(C[(g8 * 8 + rr) * CLD + 64 + j] + bxv);
        const float a = __expf(cdec * r), e = 1.f - a;
        ev[rr] = e; bv[rr] = sqrtf(e * (2.f - e)) * ig * xf;
      }
      const size_t o = (((size_t)(d * NB + b) * (SEQ / 8) + (s0 >> 3)) * LRU_W + ch) * 8;
      *(u32x4*)(le + o) = pk8(ev); *(u32x4*)(lb + o) = pk8(bv);
    }
  }
};

struct EpiP4 { const float* xres; float* xout; u16* xg;
  DEVI void operator()(const float* C, int m0, int n0) const {
    const int tid = tidx();
#pragma unroll 1
    for (int it = 0; it < 8; ++it) { const int item = it * NTHREADS + tid, row = item >> 4, c8 = (item & 15) * 8, gcol = n0 + c8, grow = m0 + row;
      float v[8], x[8]; ld8(C + row * CLD + c8, v); ld8(xres + (size_t)grow * DM + gcol, x);
#pragma unroll
      for (int j = 0; j < 8; ++j) v[j] += x[j];
      *(f32x4*)(xout + (size_t)grow * DM + gcol) = (f32x4){v[0], v[1], v[2], v[3]}; *(f32x4*)(xout + (size_t)grow * DM + gcol + 4) = (f32x4){v[4], v[5], v[6], v[7]};
      *(u32x4*)(xg + (size_t)grow * DM + gcol) = pk8(v);
    }
  }
};

struct EpiBf16 { u16* o; int ldo;
  DEVI void operator()(const float* C, int m0, int n0) const {
    const int tid = tidx();
#pragma unroll 1
    for (int it = 0; it < 8; ++it) { const int item = it * NTHREADS + tid, row = item >> 4, c8 = (item & 15) * 8;
      float v[8]; ld8(C + row * CLD + c8, v);
      *(u32x4*)(o + (size_t)(m0 + row) * ldo + n0 + c8) = pk8(v);
    }
  }
};

DEVI void ce_desc(float& a, float& b) { const float mx = fmaxf(a, b), mn = fminf(a, b); a = mx; b = mn; }
struct EpiTop { float* top; int hj;
  DEVI void operator()(const float* C, int m0, int) const {
    const int tid = tidx(), row = tid >> 1, part = tid & 1;
    float l[16];
#pragma unroll
    for (int i = 0; i < 16; ++i) l[i] = -3.0e38f;
#pragma unroll 4
    for (int c = 0; c < 64; ++c) { const int col = part * 64 + ((c + row) & 63);
      float v = __uint_as_float((__float_as_uint(C[row * CLD + col]) & ~127u) | (unsigned)(127 - col));
#pragma unroll
      for (int i = 0; i < 16; ++i) { const float t = fmaxf(l[i], v); v = fminf(l[i], v); l[i] = t; } }
    float m[16];
#pragma unroll
    for (int i = 0; i < 16; ++i) m[i] = __shfl_xor(l[15 - i], 1);
#pragma unroll
    for (int i = 0; i < 16; ++i) m[i] = fmaxf(m[i], l[i]);
#pragma unroll
    for (int st = 8; st >= 1; st >>= 1)
#pragma unroll
      for (int i = 0; i < 16; ++i) if ((i & st) == 0) ce_desc(m[i], m[i + st]);
    if (part == 0) { float* o = top + ((size_t)(m0 + row) * 16 + hj) * 16;
#pragma unroll
      for (int i = 0; i < 4; ++i) *(f32x4*)(o + 4 * i) = (f32x4){m[4 * i], m[4 * i + 1], m[4 * i + 2], m[4 * i + 3]}; }
  }
};

#define KSWZ(row, colB) ((row) * 256 + ((colB) ^ (((row) & 15) << 4)))
#define SBAR() __builtin_amdgcn_sched_barrier(0)
constexpr int AT_SHM_V = 64 * 64 * 2, AT_SHM_K = 64 * 128 * 2;
constexpr int AT_LDS = 3 * AT_SHM_V + 2 * AT_SHM_K + 8 * 64 * 4;
constexpr float ATT_THR = 8.f;
DEVI unsigned cvtpk(float lo, float hi) { unsigned r; asm volatile("v_cvt_pk_bf16_f32 %0, %1, %2" : "=v"(r) : "v"(lo), "v"(hi)); return r; }
DEVI int v_st(int k, int c) { const int kk = (k & ~0xC) | ((k & 4) << 1) | ((k & 8) >> 1); return ((kk >> 3) * 2 + (c >> 5)) * 512 + ((kk & 7) * 32 + (c & 31)) * 2; }
DEVI int v_rd_base(int lane) { return ((lane & 3) << 3) | (((lane >> 2) & 3) << 6) | (((lane >> 4) & 1) << 5) | (((lane >> 5) & 1) << 8); }
constexpr int v_rd_off(int d0, int ks, int half) { return d0 * 512 + ks * 2048 + half * 1024; }
template <int OFF> DEVI s16x4 tr_read(int vb) { s16x4 r; asm volatile("ds_read_b64_tr_b16 %0, %1 offset:%2" : "=&v"(r) : "v"(vb), "i"(OFF) : "memory"); return r; }

template <bool MASK, bool FIRST>
DEVI void partialSM(f32x16& p0, f32x16& p1, float& m_reg, float& mn, float& alpha, float SCALE, int kpos0, int qpos, int hi) {
  const float C = SCALE * 1.4426950408889634f;
  if (MASK) {
#pragma unroll
    for (int r = 0; r < 16; ++r) { const int k0 = kpos0 + crow(r, hi) - qpos; const int k1 = k0 + 32;
      if (k0 > 128 || k0 < -128) p0[r] = -1e30f;
      if (k1 > 128 || k1 < -128) p1[r] = -1e30f; }
  }
  if (FIRST) {
    float pmax = p0[0];
#pragma unroll
    for (int r = 1; r < 16; ++r) pmax = fmaxf(pmax, p0[r]);
#pragma unroll
    for (int r = 0; r < 16; ++r) pmax = fmaxf(pmax, p1[r]);
    { auto rr = __builtin_amdgcn_permlane32_swap(__float_as_uint(pmax), __float_as_uint(pmax), false, false);
      pmax = fmaxf(__uint_as_float(rr[0]), __uint_as_float(rr[1])); }
    if (__builtin_expect(__all(pmax - m_reg <= ATT_THR / SCALE), 1)) { mn = m_reg; alpha = 1.f; }
    else { mn = fmaxf(m_reg, pmax); alpha = __builtin_amdgcn_exp2f((m_reg - mn) * C); m_reg = mn; }
    const float mnC = -mn * C;
#pragma unroll
    for (int r = 0; r < 16; ++r) p0[r] = fmaf(p0[r], C, mnC);
#pragma unroll
    for (int r = 0; r < 16; ++r) p1[r] = fmaf(p1[r], C, mnC);
#pragma unroll
    for (int r = 0; r < 16; ++r) p0[r] = __builtin_amdgcn_exp2f(p0[r]);
    return;
  }
  const float mC = -m_reg * C;
#pragma unroll
  for (int r = 0; r < 16; ++r) p0[r] = fmaf(p0[r], C, mC);
#pragma unroll
  for (int r = 0; r < 16; ++r) p1[r] = fmaf(p1[r], C, mC);
  float tmax = p0[0];
#pragma unroll
  for (int r = 1; r < 16; ++r) tmax = fmaxf(tmax, p0[r]);
#pragma unroll
  for (int r = 0; r < 16; ++r) tmax = fmaxf(tmax, p1[r]);
#pragma unroll
  for (int r = 0; r < 16; ++r) p0[r] = __builtin_amdgcn_exp2f(p0[r]);
  { auto rr = __builtin_amdgcn_permlane32_swap(__float_as_uint(tmax), __float_as_uint(tmax), false, false);
    tmax = fmaxf(__uint_as_float(rr[0]), __uint_as_float(rr[1])); }
  mn = m_reg; alpha = 1.f;
  if (__builtin_expect(!__all(tmax <= ATT_THR * 1.4426950408889634f), 0)) {
    const float sh = fmaxf(tmax, 0.f);
    alpha = __builtin_amdgcn_exp2f(-sh); m_reg = m_reg + sh / C; mn = m_reg;
#pragma unroll
    for (int r = 0; r < 16; ++r) { p0[r] *= alpha; p1[r] -= sh; }
  }
}
DEVI void finishSM(f32x16& p0, f32x16& p1, float alpha, float& l_reg, bf16x8& pa0, bf16x8& pa1, bf16x8& pa2, bf16x8& pa3) {
#pragma unroll
  for (int r = 0; r < 16; ++r) p1[r] = __builtin_amdgcn_exp2f(p1[r]);
  float ps = 0;
#pragma unroll
  for (int r = 0; r < 16; ++r) ps += p0[r];
#pragma unroll
  for (int r = 0; r < 16; ++r) ps += p1[r];
  { auto rr = __builtin_amdgcn_permlane32_swap(__float_as_uint(ps), __float_as_uint(ps), false, false);
    ps = __uint_as_float(rr[0]) + __uint_as_float(rr[1]); }
  l_reg = l_reg * alpha + ps;
#define PK4(P, BASE, OUT) do { unsigned a0 = cvtpk(P[BASE + 0], P[BASE + 1]), a1 = cvtpk(P[BASE + 2], P[BASE + 3]);   \
    unsigned b0 = cvtpk(P[BASE + 4], P[BASE + 5]), b1 = cvtpk(P[BASE + 6], P[BASE + 7]);                              \
    auto r0 = __builtin_amdgcn_permlane32_swap(a0, b0, false, false); auto r1 = __builtin_amdgcn_permlane32_swap(a1, b1, false, false); \
    u32x4 w = {r0[0], r1[0], r0[1], r1[1]}; OUT = __builtin_bit_cast(bf16x8, w); } while (0)
  PK4(p0, 0, pa0); PK4(p0, 8, pa1); PK4(p1, 0, pa2); PK4(p1, 8, pa3);
#undef PK4
}
template <int ND0>
DEVI void qkt(f32x16& p0, f32x16& p1, const char* Ks, const bf16x8* qr, int r32, int hi) {
  bf16x8 k0[ND0], k1[ND0];
#pragma unroll
  for (int d0 = 0; d0 < ND0; ++d0) { const int cb = (d0 * 16 + hi * 8) * 2;
    k0[d0] = *(const bf16x8*)(Ks + KSWZ(r32, cb)); k1[d0] = *(const bf16x8*)(Ks + KSWZ(32 + r32, cb)); }
  p0 = f32x16{}; p1 = f32x16{};
#pragma unroll
  for (int d0 = 0; d0 < ND0; ++d0) {
    p0 = __builtin_amdgcn_mfma_f32_32x32x16_bf16(k0[d0], qr[d0], p0, 0, 0, 0);
    p1 = __builtin_amdgcn_mfma_f32_32x32x16_bf16(k1[d0], qr[d0], p1, 0, 0, 0); }
}
template <int D0> DEVI void pv_one(f32x16& od, int vb, bf16x8 pa0, bf16x8 pa1, bf16x8 pa2, bf16x8 pa3) {
  const s16x4 l0 = tr_read<v_rd_off(D0, 0, 0)>(vb), h0 = tr_read<v_rd_off(D0, 0, 1)>(vb), l1 = tr_read<v_rd_off(D0, 1, 0)>(vb), h1 = tr_read<v_rd_off(D0, 1, 1)>(vb);
  const s16x4 l2 = tr_read<v_rd_off(D0, 2, 0)>(vb), h2 = tr_read<v_rd_off(D0, 2, 1)>(vb), l3 = tr_read<v_rd_off(D0, 3, 0)>(vb), h3 = tr_read<v_rd_off(D0, 3, 1)>(vb);
  asm volatile("s_waitcnt lgkmcnt(0)" ::: "memory"); SBAR();
#define PK(L, H) (bf16x8){L[0], L[1], L[2], L[3], H[0], H[1], H[2], H[3]}
  od = __builtin_amdgcn_mfma_f32_32x32x16_bf16(pa0, PK(l0, h0), od, 0, 0, 0);
  od = __builtin_amdgcn_mfma_f32_32x32x16_bf16(pa1, PK(l1, h1), od, 0, 0, 0);
  od = __builtin_amdgcn_mfma_f32_32x32x16_bf16(pa2, PK(l2, h2), od, 0, 0, 0);
  od = __builtin_amdgcn_mfma_f32_32x32x16_bf16(pa3, PK(l3, h3), od, 0, 0, 0);
#undef PK
}
DEVI void pv_d0(f32x16* o, int vb, bf16x8 pa0, bf16x8 pa1, bf16x8 pa2, bf16x8 pa3) {
  const s16x4 a0 = tr_read<v_rd_off(0, 0, 0)>(vb), b0 = tr_read<v_rd_off(0, 0, 1)>(vb), a1 = tr_read<v_rd_off(0, 1, 0)>(vb), b1 = tr_read<v_rd_off(0, 1, 1)>(vb);
  const s16x4 a2 = tr_read<v_rd_off(0, 2, 0)>(vb), b2 = tr_read<v_rd_off(0, 2, 1)>(vb), a3 = tr_read<v_rd_off(0, 3, 0)>(vb), b3 = tr_read<v_rd_off(0, 3, 1)>(vb);
  const s16x4 c0 = tr_read<v_rd_off(1, 0, 0)>(vb), d0 = tr_read<v_rd_off(1, 0, 1)>(vb), c1 = tr_read<v_rd_off(1, 1, 0)>(vb), d1 = tr_read<v_rd_off(1, 1, 1)>(vb);
  const s16x4 c2 = tr_read<v_rd_off(1, 2, 0)>(vb), d2 = tr_read<v_rd_off(1, 2, 1)>(vb), c3 = tr_read<v_rd_off(1, 3, 0)>(vb), d3 = tr_read<v_rd_off(1, 3, 1)>(vb);
  asm volatile("s_waitcnt lgkmcnt(0)" ::: "memory"); SBAR();
#define PK(L, H) (bf16x8){L[0], L[1], L[2], L[3], H[0], H[1], H[2], H[3]}
  o[0] = __builtin_amdgcn_mfma_f32_32x32x16_bf16(pa0, PK(a0, b0), o[0], 0, 0, 0);
  o[1] = __builtin_amdgcn_mfma_f32_32x32x16_bf16(pa0, PK(c0, d0), o[1], 0, 0, 0);
  o[0] = __builtin_amdgcn_mfma_f32_32x32x16_bf16(pa1, PK(a1, b1), o[0], 0, 0, 0);
  o[1] = __builtin_amdgcn_mfma_f32_32x32x16_bf16(pa1, PK(c1, d1), o[1], 0, 0, 0);
  o[0] = __builtin_amdgcn_mfma_f32_32x32x16_bf16(pa2, PK(a2, b2), o[0], 0, 0, 0);
  o[1] = __builtin_amdgcn_mfma_f32_32x32x16_bf16(pa2, PK(c2, d2), o[1], 0, 0, 0);
  o[0] = __builtin_amdgcn_mfma_f32_32x32x16_bf16(pa3, PK(a3, b3), o[0], 0, 0, 0);
  o[1] = __builtin_amdgcn_mfma_f32_32x32x16_bf16(pa3, PK(c3, d3), o[1], 0, 0, 0);
#undef PK
}

template <int DQK, bool MASK>
DEVI void attn_body(const u16* Qw, const u16* Kh, int ldk, const u16* Vh, int ldv, int kt0, int NT, float SCALE, float m_init, float l_init,
                    int qpos, u16* Ow, char* lds, float qrope_pos = 0.f) {
  constexpr int ND0 = DQK / 16, NCK = DQK / 8;
  const int tid = tidx(), wid = __builtin_amdgcn_readfirstlane(tid >> 6), lane = tid & 63, r32 = lane & 31, hi = lane >> 5;
  char* K_lds = lds; char* V_lds = lds + 2 * AT_SHM_K;
  float* wsx = (float*)(lds + 2 * AT_SHM_K + 3 * AT_SHM_V) + wid * 64; float* li_l = wsx; float* al_l = wsx + 32;
  float m_reg = m_init, l_reg = l_init; f32x16 o[2] = {f32x16{}, f32x16{}}; bf16x8 qr[ND0];
#pragma unroll
  for (int d0 = 0; d0 < ND0; ++d0) qr[d0] = *(const bf16x8*)(Qw + d0 * 16);
  if (DQK == 96) {
#pragma unroll
    for (int d0 = 4; d0 < ND0; ++d0) { float v[8]; unpk8(__builtin_bit_cast(u32x4, qr[d0]), v);
#pragma unroll
      for (int q = 0; q < 4; ++q) { const int f = 2 * ((((d0 - 4) * 16 + hi * 8) >> 1) + q); float sn, cs; rope_sc(qrope_pos, f, sn, cs);
        const float x1 = v[2 * q], x2 = v[2 * q + 1]; v[2 * q] = x1 * cs - x2 * sn; v[2 * q + 1] = x2 * cs + x1 * sn; }
      qr[d0] = __builtin_bit_cast(bf16x8, pk8(v)); } }
  unsigned koff[2], voff;
#pragma unroll
  for (int i = 0; i < 2; ++i) { const int row = 4 * (wid + 8 * i) + (lane >> 4), ch = (lane & 15) ^ (row & 15); koff[i] = (unsigned)(row * ldk * 2 + (ch < NCK ? ch : 0) * 16); }
  { const int off = wid * 1024 + lane * 16, sub = off >> 9, kk = ((sub >> 1) << 3) | ((off & 511) >> 6), c = ((sub & 1) << 5) | ((off & 63) >> 1);
    const int k = (kk & ~0xC) | ((kk & 4) << 1) | ((kk & 8) >> 1); voff = (unsigned)(k * ldv * 2 + c * 2); }
  typedef __attribute__((address_space(3))) unsigned lds_u32;
#define DMA(tt_) do { const char* kb_ = (const char*)Kh + (size_t)(kt0 + (tt_)) * 64 * ldk * 2; const char* vb_ = (const char*)Vh + (size_t)(kt0 + (tt_)) * 64 * ldv * 2; \
    char* kd_ = K_lds + ((tt_) & 1) * AT_SHM_K + wid * 1024; char* vd_ = V_lds + ((tt_) % 3) * AT_SHM_V + wid * 1024; \
    __builtin_amdgcn_global_load_lds((const unsigned*)(kb_ + koff[0]), (lds_u32*)kd_, 16, 0, 0); \
    __builtin_amdgcn_global_load_lds((const unsigned*)(kb_ + koff[1]), (lds_u32*)(kd_ + 8192), 16, 0, 0); \
    __builtin_amdgcn_global_load_lds((const unsigned*)(vb_ + voff), (lds_u32*)vd_, 16, 0, 0); } while (0)
#define LANDED() do { asm volatile("s_waitcnt vmcnt(0)" ::: "memory"); __syncthreads(); } while (0)
#define RESC(a) do { if (__any((a) < 1.f)) { if (hi == 0) al_l[r32] = (a); asm volatile("s_waitcnt lgkmcnt(0)" ::: "memory"); \
    _Pragma("unroll") for (int d = 0; d < 2; ++d) _Pragma("unroll") for (int r = 0; r < 16; ++r) o[d][r] *= al_l[crow(r, hi)]; } } while (0)
  const int vb0 = (int)(uintptr_t)V_lds + v_rd_base(lane);
  f32x16 pA0, pA1, pB0, pB1; float mnA, mnB, alA, alB; bf16x8 pa0, pa1, pa2, pa3;
  DMA(0); LANDED();
  DMA(1);
  qkt<ND0>(pA0, pA1, K_lds, qr, r32, hi); partialSM<MASK, true>(pA0, pA1, m_reg, mnA, alA, SCALE, kt0 * 64, qpos, hi);
  LANDED();
  int vprev = 0;
  for (int tt = 1; tt + 1 < NT; tt += 2) {
    const int v1 = vprev == 2 ? 0 : vprev + 1;
    DMA(tt + 1); SBAR();
    qkt<ND0>(pB0, pB1, K_lds + AT_SHM_K, qr, r32, hi);
    finishSM(pA0, pA1, alA, l_reg, pa0, pa1, pa2, pa3); SBAR();
    pv_d0(o, vb0 + vprev * AT_SHM_V, pa0, pa1, pa2, pa3); partialSM<MASK, false>(pB0, pB1, m_reg, mnB, alB, SCALE, (kt0 + tt) * 64, qpos, hi);
    RESC(alB); LANDED();
    if (tt + 2 < NT) DMA(tt + 2);
    SBAR();
    qkt<ND0>(pA0, pA1, K_lds, qr, r32, hi);
    finishSM(pB0, pB1, alB, l_reg, pa0, pa1, pa2, pa3); SBAR();
    pv_d0(o, vb0 + v1 * AT_SHM_V, pa0, pa1, pa2, pa3); partialSM<MASK, false>(pA0, pA1, m_reg, mnA, alA, SCALE, (kt0 + tt + 1) * 64, qpos, hi);
    RESC(alA); LANDED();
    vprev = v1 == 2 ? 0 : v1 + 1;
  }
  { const int v1 = vprev == 2 ? 0 : vprev + 1;
    SBAR(); qkt<ND0>(pB0, pB1, K_lds + AT_SHM_K, qr, r32, hi);
    finishSM(pA0, pA1, alA, l_reg, pa0, pa1, pa2, pa3); SBAR();
    pv_d0(o, vb0 + vprev * AT_SHM_V, pa0, pa1, pa2, pa3); partialSM<MASK, false>(pB0, pB1, m_reg, mnB, alB, SCALE, (kt0 + NT - 1) * 64, qpos, hi);
    RESC(alB);
    finishSM(pB0, pB1, alB, l_reg, pa0, pa1, pa2, pa3); SBAR();
    pv_d0(o, vb0 + v1 * AT_SHM_V, pa0, pa1, pa2, pa3); }
  if (hi == 0) li_l[r32] = l_reg; asm volatile("s_waitcnt lgkmcnt(0)" ::: "memory");
  float rli[16];
#pragma unroll
  for (int r = 0; r < 16; ++r) rli[r] = __builtin_amdgcn_rcpf(li_l[crow(r, hi)]);
#pragma unroll
  for (int r = 0; r < 16; ++r) { const int orow = crow(r, hi);
#pragma unroll
    for (int d0 = 0; d0 < 2; ++d0) Ow[(size_t)orow * DM + d0 * 32 + r32] = f2bf(o[d0][r] * rli[r]); }
  __syncthreads();
#undef DMA
#undef LANDED
#undef RESC
}

constexpr int LCH = 64, NLCH = SEQ / LCH;
constexpr size_t WS_LP = 1 * MiB, WS_LH = 2560 * 1024;
constexpr size_t WS_LC = 473 * MiB;
constexpr size_t WS_NEED = 510 * MiB;
DEVI void lru_passA(const Params& p, int item, int lane) {
  const int cg = item % 6, c = (item / 6) % NLCH, b = (item / (6 * NLCH)) % NB, d = item / (6 * NLCH * NB);
  const size_t base = (((size_t)(d * NB + b) * (SEQ / 8) + c * 8) * LRU_W + cg * 64 + lane) * 8;
  const u16* E = (const u16*)(p.ws + WS_LE) + base; const u16* Bp = (const u16*)(p.ws + WS_LB) + base;
  u32x4 ev[8], bv[8];
#pragma unroll
  for (int g = 0; g < 8; ++g) { ev[g] = *(const u32x4*)(E + (size_t)g * LRU_W * 8); bv[g] = *(const u32x4*)(Bp + (size_t)g * LRU_W * 8); }
  float h = 0.f, P = 1.f;
#pragma unroll
  for (int gg = 0; gg < 8; ++gg) { const int g = d ? 7 - gg : gg; float e[8], bb[8]; unpk8(ev[g], e); unpk8(bv[g], bb);
#pragma unroll
    for (int rr = 0; rr < 8; ++rr) { const int r = d ? 7 - rr : rr; const float a = 1.f - e[r]; h = fmaf(a, h, bb[r]); P *= a; } }
  const size_t o = ((size_t)(d * NB + b) * NLCH + c) * LRU_W + cg * 64 + lane;
  ((float*)(p.ws + WS_LP))[o] = P; ((float*)(p.ws + WS_LH))[o] = h;
}

DEVI void lru_final(const Params& p, int item, char* lds) {
  const int tid = tidx(), wid = tid >> 6, lane = tid & 63;
  const int c = item % NLCH, b = item / NLCH;
  float* obuf = (float*)lds;
  if (wid < 6) {
    const int ch = wid * 64 + lane;
#pragma unroll
    for (int d = 0; d < 2; ++d) {
      const size_t co = ((size_t)(d * NB + b) * NLCH + c) * LRU_W + ch;
      float h = ((const float*)(p.ws + WS_LC))[co];
      const size_t base = (((size_t)(d * NB + b) * (SEQ / 8) + c * 8) * LRU_W + ch) * 8;
      const u16* E = (const u16*)(p.ws + WS_LE) + base; const u16* Bp = (const u16*)(p.ws + WS_LB) + base;
      u32x4 ev[8], bv[8];
#pragma unroll
      for (int g = 0; g < 8; ++g) { ev[g] = *(const u32x4*)(E + (size_t)g * LRU_W * 8); bv[g] = *(const u32x4*)(Bp + (size_t)g * LRU_W * 8); }
      if (d == 0) {
#pragma unroll
        for (int g = 0; g < 8; ++g) { float e[8], bb[8]; unpk8(ev[g], e); unpk8(bv[g], bb);
#pragma unroll
          for (int r = 0; r < 8; ++r) { h = fmaf(1.f - e[r], h, bb[r]); obuf[(g * 8 + r) * LRU_W + ch] = h; } }
      } else {
        const u16* gp = (const u16*)(p.ws + WS_R1) + ((size_t)b * SEQ + c * LCH) * INWP + PC_LG + ch;
#pragma unroll
        for (int g = 7; g >= 0; --g) { float e[8], bb[8]; unpk8(ev[g], e); unpk8(bv[g], bb);
#pragma unroll
          for (int r = 7; r >= 0; --r) { h = fmaf(1.f - e[r], h, bb[r]); const int tk = g * 8 + r;
            const float gt = bf2f(gp[(size_t)tk * INWP]); obuf[tk * LRU_W + ch] = (obuf[tk * LRU_W + ch] + h) * gelu_erf(gt); } }
      }
    }
  }
  __syncthreads();
  u16* mp = (u16*)(p.ws + WS_MIX) + ((size_t)b * SEQ + c * LCH) * DM + 384;
#pragma unroll 1
  for (int i = 0; i < 8; ++i) { const int tk = wid * 8 + i;
    float v[6]; float s = 0.f;
#pragma unroll
    for (int q = 0; q < 3; ++q) { const f32x2 t2 = *(const f32x2*)(obuf + tk * LRU_W + q * 128 + lane * 2); v[2 * q] = t2.x; v[2 * q + 1] = t2.y; s = fmaf(t2.x, t2.x, s); s = fmaf(t2.y, t2.y, s); }
    s = wave_sum(s);
    const float rs = rsqrtf(s * (1.f / 384.f) + EPS);
#pragma unroll
    for (int q = 0; q < 3; ++q) *(unsigned*)(mp + (size_t)tk * DM + q * 128 + lane * 2) = pk2(v[2 * q] * rs, v[2 * q + 1] * rs);
  }
  __syncthreads();
}

typedef unsigned char u8;
DEVI unsigned q8x4(const float* v, float s) {
  unsigned w = 0;
#pragma unroll
  for (int i = 0; i < 4; ++i) { int q = __float2int_rn(v[i] * s); q = q < -127 ? -127 : (q > 127 ? 127 : q); w |= ((unsigned)q & 255u) << (8 * i); }
  return w;
}
DEVI void peer_xn_pass(const Params& p, int layer, int vb, int nb) {
  const int tid = tidx(), wid = tid >> 6, lane = tid & 63; const u16* xg = (const u16*)(p.ws + WS_XG); const float* gf = p.norm_ffn + layer * DM;
  u8* xq = (u8*)(p.ws + WS_XQ); float* sxp = (float*)(p.ws + WS_SX);
  for (int t = vb * 8 + wid; t < T; t += nb * 8) {
    const u32x4* rp = (const u32x4*)(xg + (size_t)t * DM + lane * 16);
    float v[16]; unpk8(rp[0], v); unpk8(rp[1], v + 8);
    float s = 0.f;
#pragma unroll
    for (int i = 0; i < 16; ++i) s = fmaf(v[i], v[i], s);
    s = wave_sum(s);
    const float rs = rsqrtf(s * (1.f / DM) + EPS);
    float g[16]; ld8(gf + lane * 16, g); ld8(gf + lane * 16 + 8, g + 8);
    float mx = 0.f;
#pragma unroll
    for (int i = 0; i < 16; ++i) { v[i] *= rs * g[i]; mx = fmaxf(mx, fabsf(v[i])); }
#pragma unroll
    for (int o = 1; o < 64; o <<= 1) mx = fmaxf(mx, __shfl_xor(mx, o));
    const float sx = fmaxf(mx, 1e-20f) * (1.f / 127.f), isx = 1.f / sx;
    *(u32x4*)(xq + (size_t)t * DM + lane * 16) = (u32x4){q8x4(v, isx), q8x4(v + 4, isx), q8x4(v + 8, isx), q8x4(v + 12, isx)};
    if (lane == 0) sxp[t] = sx;
  }
}

DEVI void cvt16(u32x4 w, float* f) {
  f32x2 t;
  t = __builtin_amdgcn_cvt_pk_f32_fp8((int)w.x, false); f[0] = t.x; f[1] = t.y; t = __builtin_amdgcn_cvt_pk_f32_fp8((int)w.x, true); f[2] = t.x; f[3] = t.y;
  t = __builtin_amdgcn_cvt_pk_f32_fp8((int)w.y, false); f[4] = t.x; f[5] = t.y; t = __builtin_amdgcn_cvt_pk_f32_fp8((int)w.y, true); f[6] = t.x; f[7] = t.y;
  t = __builtin_amdgcn_cvt_pk_f32_fp8((int)w.z, false); f[8] = t.x; f[9] = t.y; t = __builtin_amdgcn_cvt_pk_f32_fp8((int)w.z, true); f[10] = t.x; f[11] = t.y;
  t = __builtin_amdgcn_cvt_pk_f32_fp8((int)w.w, false); f[12] = t.x; f[13] = t.y; t = __builtin_amdgcn_cvt_pk_f32_fp8((int)w.w, true); f[14] = t.x; f[15] = t.y;
}
DEVI unsigned enc4(float a, float b, float c, float d) { int w = 0; w = __builtin_amdgcn_cvt_pk_fp8_f32(a, b, w, false); w = __builtin_amdgcn_cvt_pk_fp8_f32(c, d, w, true); return (unsigned)w; }
#define EIDX_AT(i0, i1, i) ((((i) < 8 ? (i0) : (i1))[((i) & 7) >> 1] >> (((i) & 1) * 16)) & 0xffffu)
template <int CTRL> DEVI float dppf(float v) { return __uint_as_float((unsigned)__builtin_amdgcn_mov_dpp((int)__float_as_uint(v), CTRL, 0xF, 0xF, true)); }
DEVI f32x2 fma2(f32x2 a, f32x2 b, f32x2 c) { return __builtin_elementwise_fma(a, b, c); }
DEVI f32x2 cvt8lo(unsigned w) { return __builtin_amdgcn_cvt_pk_f32_fp8((int)w, false); }
DEVI f32x2 cvt8hi(unsigned w) { return __builtin_amdgcn_cvt_pk_f32_fp8((int)w, true); }
struct PeerIdx { u32x4 i0, i1; };
template <bool AXPY>
DEVI void peer_slice_phase(const Params& p, int s, int tbeg, int tstep, int lane, const float* xin, float* xout, bool last) {
  const int r = lane >> 3, j = lane & 7;
  const u8* eidxB = (const u8*)(p.ws + WS_EIDX); const unsigned eoff = (unsigned)r * 32u;
  const u8* TBs = (const u8*)(p.ws + (AXPY ? WS_VB : WS_UB)) + (size_t)s * NEXP * 128; const unsigned toff = 16u * (unsigned)j;
  const u8* xnB = (const u8*)(p.ws + WS_XQ) + s * 128; const unsigned xoff = 16u * (unsigned)j;
  const float* sxp = (const float*)(p.ws + WS_SX);
  const u8* ccB = (const u8*)(p.ws + WS_CC); const unsigned coff = (unsigned)r * 16u;
  const float* csp = (const float*)(p.ws + WS_CS);
  float* pdB = (float*)(p.ws + WS_PD) + (size_t)s * T * 128;
  const int ntok = (T - tbeg + tstep - 1) / tstep;
  if (ntok <= 0) return;
#define TOK(k) (tbeg + ((k) < ntok ? (k) : ntok - 1) * tstep)
#define LD_IDX(dst, k) do { const u8* b_ = eidxB + (size_t)TOK(k) * 256; dst.i0 = *(const u32x4*)(b_ + eoff); dst.i1 = *(const u32x4*)(b_ + eoff + 16u); } while (0)
#define LD_HALF(H, ix, h) do { _Pragma("unroll") for (int i = 0; i < 8; ++i) H[i] = *(const u32x4*)(TBs + (EIDX_AT(ix.i0, ix.i1, 8 * (h) + i) * 128u + toff)); } while (0)
#define LD_AUX(a, k) do { if (AXPY) { const u8* b_ = ccB + (size_t)TOK(k) * 128; a[0] = *(const u32x4*)(b_ + coff); a[1].x = __float_as_uint(csp[TOK(k)]); } \
    else { const u8* b_ = xnB + (size_t)TOK(k) * DM; a[0] = *(const u32x4*)(b_ + xoff); a[1].x = __float_as_uint(sxp[TOK(k)]); } } while (0)
  PeerIdx I0, I1, I2; u32x4 H0[8], H1[8], H2[8], X0[2], X1[2], X2[2];
  u32x4 xq4 = {0, 0, 0, 0}; float sxk = 0.f;
  int acc[16];
#define T_BEGIN(X) do { xq4 = X[0]; sxk = __uint_as_float(X[1].x); if (AXPY) { _Pragma("unroll") for (int q = 0; q < 16; ++q) acc[q] = 0; } } while (0)
#define COMP(H, h, k) do { if ((k) < ntok) { \
    if (!AXPY) { float* o_ = pdB + (size_t)(tbeg + (k) * tstep) * 128 + r * 16 + 8 * (h); \
      _Pragma("unroll") for (int g = 0; g < 2; ++g) { float res[4]; \
        _Pragma("unroll") for (int ii = 0; ii < 4; ++ii) { const u32x4 w_ = H[4 * g + ii]; \
          int a_ = __builtin_amdgcn_sdot4((int)w_.x, (int)xq4.x, 0, false); a_ = __builtin_amdgcn_sdot4((int)w_.y, (int)xq4.y, a_, false); \
          a_ = __builtin_amdgcn_sdot4((int)w_.z, (int)xq4.z, a_, false); a_ = __builtin_amdgcn_sdot4((int)w_.w, (int)xq4.w, a_, false); \
          a_ += __builtin_amdgcn_mov_dpp(a_, 0xB1, 0xF, 0xF, true); a_ += __builtin_amdgcn_mov_dpp(a_, 0x4E, 0xF, 0xF, true); a_ += __builtin_amdgcn_mov_dpp(a_, 0x141, 0xF, 0xF, true); \
          res[ii] = (float)a_ * sxk; } \
        if (j == 0) *(f32x4*)(o_ + 4 * g) = (f32x4){res[0], res[1], res[2], res[3]}; } } \
    else { _Pragma("unroll") for (int gi = 0; gi < 2; ++gi) { const int cv_ = (int)xq4[2 * (h) + gi];        \
        _Pragma("unroll") for (int dc = 0; dc < 4; ++dc) { const unsigned A_ = H[4 * gi][dc], B_ = H[4 * gi + 1][dc], C_ = H[4 * gi + 2][dc], D_ = H[4 * gi + 3][dc]; \
            \
          const unsigned X_ = __builtin_amdgcn_perm(B_, A_, 0x05010400u), Y_ = __builtin_amdgcn_perm(B_, A_, 0x07030602u), Z_ = __builtin_amdgcn_perm(D_, C_, 0x05010400u), W_ = __builtin_amdgcn_perm(D_, C_, 0x07030602u); \
          acc[4 * dc + 0] = __builtin_amdgcn_sdot4((int)__builtin_amdgcn_perm(Z_, X_, 0x05040100u), cv_, acc[4 * dc + 0], false); \
          acc[4 * dc + 1] = __builtin_amdgcn_sdot4((int)__builtin_amdgcn_perm(Z_, X_, 0x07060302u), cv_, acc[4 * dc + 1], false); \
          acc[4 * dc + 2] = __builtin_amdgcn_sdot4((int)__builtin_amdgcn_perm(W_, Y_, 0x05040100u), cv_, acc[4 * dc + 2], false); \
          acc[4 * dc + 3] = __builtin_amdgcn_sdot4((int)__builtin_amdgcn_perm(W_, Y_, 0x07060302u), cv_, acc[4 * dc + 3], false); } } } } } while (0)
  auto finalize = [&](int k) {
    if (!AXPY || k >= ntok) return;
    const int t = tbeg + k * tstep;
    int S[8];
#pragma unroll
    for (int q = 0; q < 8; ++q) { auto rr = __builtin_amdgcn_permlane32_swap((unsigned)acc[q], (unsigned)acc[q + 8], false, false); S[q] = (int)rr[0] + (int)rr[1]; }
    int Tq[4];
#pragma unroll
    for (int q = 0; q < 4; ++q) { auto rr = __builtin_amdgcn_permlane16_swap((unsigned)S[q], (unsigned)S[q + 4], false, false); Tq[q] = (int)rr[0] + (int)rr[1]; }
#pragma unroll
    for (int q = 0; q < 4; ++q) Tq[q] += __builtin_amdgcn_mov_dpp(Tq[q], 0x128, 0xF, 0xF, true);
    float ss = 0.f;
    if ((lane & 8) == 0) {
      const size_t o = (size_t)t * DM + s * 128 + 16 * j + ((lane >> 5) & 1) * 8 + ((lane >> 4) & 1) * 4;
      u32x2* xgp = (u32x2*)((u16*)(p.ws + WS_XG) + o); const u32x2 xb = *xgp;
      const f32x4 y = {fmaf((float)Tq[0], sxk, bflo(xb.x)), fmaf((float)Tq[1], sxk, bfhi(xb.x)), fmaf((float)Tq[2], sxk, bflo(xb.y)), fmaf((float)Tq[3], sxk, bfhi(xb.y))};
      if (last) *(f32x4*)(xout + o) = y; else *xgp = (u32x2){pk2(y.x, y.y), pk2(y.z, y.w)};
      ss = (y.x * y.x + y.y * y.y) + (y.z * y.z + y.w * y.w);
    }
    ss = wave_sum(ss); if (lane == 0) ((float*)(p.ws + WS_SSQ))[(size_t)t * 8 + s] = ss;
  };
  LD_IDX(I0, 0); LD_IDX(I1, 1); LD_IDX(I2, 2); LD_HALF(H0, I0, 0); LD_HALF(H1, I0, 1); LD_AUX(X0, 0);
#pragma unroll 2
  for (int k = 0; k < ntok; k += 3) {
    LD_HALF(H2, I1, 0); LD_IDX(I0, k + 3); LD_AUX(X1, k + 1);
    T_BEGIN(X0); COMP(H0, 0, k);
    LD_HALF(H0, I1, 1);
    COMP(H1, 1, k); finalize(k);
    LD_HALF(H1, I2, 0); LD_IDX(I1, k + 4); LD_AUX(X2, k + 2);
    T_BEGIN(X1); COMP(H2, 0, k + 1);
    LD_HALF(H2, I2, 1);
    COMP(H0, 1, k + 1); finalize(k + 1);
    LD_HALF(H0, I0, 0); LD_IDX(I2, k + 5); LD_AUX(X0, k + 3);
    T_BEGIN(X2); COMP(H1, 0, k + 2);
    LD_HALF(H1, I0, 1);
    COMP(H2, 1, k + 2); finalize(k + 2);
  }
#undef TOK
#undef LD_IDX
#undef LD_HALF
#undef LD_AUX
#undef T_BEGIN
#undef COMP
}

DEVI void lru_passB(const Params& p, int item, int lane) {
  const int cg = item % 6, b = (item / 6) % NB, d = item / (6 * NB);
  const size_t o = (size_t)(d * NB + b) * NLCH * LRU_W + cg * 64 + lane;
  const float* Pp = (const float*)(p.ws + WS_LP) + o; const float* Hp = (const float*)(p.ws + WS_LH) + o; float* Cp = (float*)(p.ws + WS_LC) + o;
  float h = 0.f;
#pragma unroll 1
  for (int c0 = 0; c0 < NLCH; c0 += 32) {
    float pv[32], hv[32];
#pragma unroll
    for (int i = 0; i < 32; ++i) { const int cc = d ? NLCH - 1 - (c0 + i) : c0 + i; pv[i] = Pp[(size_t)cc * LRU_W]; hv[i] = Hp[(size_t)cc * LRU_W]; }
#pragma unroll
    for (int i = 0; i < 32; ++i) { const int cc = d ? NLCH - 1 - (c0 + i) : c0 + i; Cp[(size_t)cc * LRU_W] = h; h = fmaf(pv[i], h, hv[i]); }
  }
}

DEVI void swa_item(const Params& p, int layer, int item, char* lds) {
  const int tid = tidx(), wid = tid >> 6, lane = tid & 63, r32 = lane & 31, hi = lane >> 5;
  const int g = item & 1, n = (item >> 1) & 63, b = item >> 7;
  const int hq = 2 * g + (wid >> 2), qrow = n * 128 + (wid & 3) * 32;
  const u16* proj = (const u16*)(p.ws + WS_R1);
  const u16* Qw = proj + (size_t)(b * SEQ + qrow + r32) * INWP + PC_SQ + hq * 64 + hi * 8;
  const u16* Kh = proj + (size_t)(b * SEQ) * INWP + PC_SK + g * 64;
  const u16* Vh = proj + (size_t)(b * SEQ) * INWP + PC_SV + g * 64;
  const int kt0 = (2 * n - 2) < 0 ? 0 : (2 * n - 2), kt1 = (2 * n + 4) > SEQ / 64 ? SEQ / 64 : (2 * n + 4);
  const float sink = p.swa_sink[layer * 4 + hq];
  u16* Ow = (u16*)(p.ws + WS_MIX) + (size_t)(b * SEQ + qrow) * DM + 768 + hq * 64;
  attn_body<64, true>(Qw, Kh, INWP, Vh, INWP, kt0, kt1 - kt0, 0.125f, sink * 8.f, 1.f, qrow + r32, Ow, lds);
}
DEVI void mla_item(const Params& p, int pair, int qb, char* lds) {
  const int tid = tidx(), wid = tid >> 6, lane = tid & 63, r32 = lane & 31, hi = lane >> 5;
  const int b = pair / MLA_H, h = pair - b * MLA_H;
  const u16* Qw = (const u16*)(p.ws + WS_QM) + ((size_t)pair * SEQ + qb * 256 + wid * 32 + r32) * MLA_QK + hi * 8;
  const u16* Kh = (const u16*)(p.ws + WS_KM) + (size_t)pair * SEQ * MLA_QK;
  const u16* Vh = (const u16*)(p.ws + WS_VM) + (size_t)pair * SEQ * MLA_V;
  u16* Ow = (u16*)(p.ws + WS_MIX) + (size_t)(b * SEQ + qb * 256 + wid * 32) * DM + h * 64;
  attn_body<96, false>(Qw, Kh, MLA_QK, Vh, MLA_V, 0, SEQ / 64, 0.10206207261596575f, -1e30f, 0.f, 0, Ow, lds, (float)p.pos[b * SEQ + qb * 256 + wid * 32 + r32]);
}


namespace pg8 {
#define PG8_LAS __attribute__((address_space(3)))
constexpr int BM = 256, BK = 64, HALF = 128, HTB = HALF * BK * 2, NXCD = 8, WGM = 8;
DEVI int lds_byte(int r, int c) { const int st = (r >> 4) * 2 + (c >> 5), rr = r & 15, cc = c & 31, ob = rr * 64 + cc * 2; return st * 1024 + (ob ^ (((ob >> 9) & 1) << 5)); }
DEVI void stage_rc(int b, int& R, int& C) { const int st = b / 1024, sb = b % 1024, swz = sb ^ (((sb >> 9) & 1) << 5); R = (st >> 1) * 16 + swz / 64; C = (st & 1) * 32 + (swz % 64) / 2; }
DEVI int perm32(int rho) { const int n = rho >> 4, i = rho & 15; return 8 * (i >> 2) + 4 * n + (i & 3); }
struct Unit { int pm, pn; };
struct Gemm { const u16* A; const u16* Bt; int M, N, K, lda, ldb; };
struct StaticOrder {
  int nM, nN, nwg, G, c;
  DEVI void init(int M, int N, int G_, int c_) { nM = M / BM; nN = N / BM; nwg = nM * nN; G = G_; c = c_; }
  DEVI bool next(int i, Unit& u) const {
    const long L = (long)i * G + c; if (L >= nwg) return false;
    int wgid = (int)L; { const int q = nwg / NXCD, r = nwg % NXCD, xcd = wgid % NXCD, off = wgid / NXCD; wgid = (xcd < r ? xcd * (q + 1) : r * (q + 1) + (xcd - r) * q) + off; }
    const int nig = WGM * nN, gid = wgid / nig, fm = gid * WGM, gsz = (nM - fm) < WGM ? (nM - fm) : WGM;
    u.pm = fm + ((wgid % nig) % gsz); u.pn = (wgid % nig) / gsz; return true;
  }
};
template <class Epi>
DEVI void gemm_phase(PG8_LAS unsigned char* lds, const Gemm g, const StaticOrder& S, const Epi& E) {
  const int tid = tidx(), wid = __builtin_amdgcn_readfirstlane(tid >> 6), lane = tid & 63, wr = wid >> 2, wc = wid & 3, fr = lane & 15, fq = lane >> 4;
  const int K = g.K; int nt = K / BK; asm volatile("" : "+s"(nt));
  unsigned voffA[2], voffB[2];
#pragma unroll
  for (int i = 0; i < 2; ++i) { int R, C; stage_rc(tid * 16 + i * 8192, R, C); const int Rb = (R & ~31) + perm32(R & 31);
    voffA[i] = (unsigned)(R * g.lda + C) * 2u; voffB[i] = (unsigned)(Rb * g.ldb + C) * 2u; }
  const size_t kstep = (size_t)(BK * 2), hstepA = (size_t)HALF * g.lda * 2, hstepB = (size_t)HALF * g.ldb * 2, tstepA = 2 * hstepA, tstepB = 2 * hstepB;
  const unsigned ldsw = (unsigned)wid * 1024u;
  const int aoff = lds_byte(wr * 64 + fr, fq * 8), boff = lds_byte(wc * 32 + fr, fq * 8);
#define PG8_SA(b, h) (((b) * 2 + (h)) * HTB)
#define PG8_SB(b, h) ((4 + (b) * 2 + (h)) * HTB)
#define PG8_STAGE(bufoff, gbase, voff) do { _Pragma("unroll") for (int _i = 0; _i < 2; ++_i) \
    __builtin_amdgcn_global_load_lds((const unsigned*)((const char*)(gbase) + (voff)[_i]), (PG8_LAS unsigned*)(lds + (bufoff) + ldsw + _i * 8192), 16, 0, 0); } while (0)
#define PG8_LDA(dst, b, h) do { _Pragma("unroll") for (int m = 0; m < 4; ++m) _Pragma("unroll") for (int k = 0; k < 2; ++k) dst[m][k] = *(const PG8_LAS bf16x8*)(lds + PG8_SA(b, h) + aoff + m * 2048 + k * 1024); } while (0)
#define PG8_LDB(dst, b, h) do { _Pragma("unroll") for (int n = 0; n < 2; ++n) _Pragma("unroll") for (int k = 0; k < 2; ++k) dst[n][k] = *(const PG8_LAS bf16x8*)(lds + PG8_SB(b, h) + boff + n * 2048 + k * 1024); } while (0)
#define PG8_MMA(ai, bj, At, Bt) do { __builtin_amdgcn_s_setprio(1); _Pragma("unroll") for (int m = 0; m < 4; ++m) _Pragma("unroll") for (int n = 0; n < 2; ++n) _Pragma("unroll") for (int k = 0; k < 2; ++k) \
    acc[ai][bj][m][n] = __builtin_amdgcn_mfma_f32_16x16x32_bf16(Bt[n][k], At[m][k], acc[ai][bj][m][n], 0, 0, 0); __builtin_amdgcn_s_setprio(0); } while (0)
#define PG8_WAIT_V(n) asm volatile("s_waitcnt vmcnt(" #n ")" ::: "memory")
#define PG8_WAIT_L(n) asm volatile("s_waitcnt lgkmcnt(" #n ")" ::: "memory")
#define PG8_BAR __builtin_amdgcn_s_barrier()
#define PG8_SCHED __builtin_amdgcn_sched_barrier(0)
  Unit cur, nxt; int ui = 0;
  if (!S.next(0, cur)) return;
  f32x4 acc[2][2][4][2];
#pragma unroll
  for (int a = 0; a < 2; ++a)
#pragma unroll
    for (int b = 0; b < 2; ++b)
#pragma unroll
      for (int m = 0; m < 4; ++m)
#pragma unroll
        for (int n = 0; n < 2; ++n) acc[a][b][m][n] = (f32x4){0.f, 0.f, 0.f, 0.f};
  bf16x8 At[4][2], B0[2][2], B1[2][2];
  const char* cA = (const char*)g.A + (size_t)cur.pm * tstepA; const char* cB = (const char*)g.Bt + (size_t)cur.pn * tstepB;
  PG8_STAGE(PG8_SB(0, 0), cB, voffB); PG8_STAGE(PG8_SB(0, 1), cB + hstepB, voffB); PG8_STAGE(PG8_SA(0, 0), cA, voffA); PG8_STAGE(PG8_SA(0, 1), cA + hstepA, voffA);
  if (wr == 1) PG8_BAR;
  PG8_WAIT_V(2); PG8_BAR;
  PG8_STAGE(PG8_SB(1, 0), cB + kstep, voffB); PG8_STAGE(PG8_SA(1, 0), cA + kstep, voffA); PG8_STAGE(PG8_SB(1, 1), cB + hstepB + kstep, voffB);
  PG8_WAIT_V(6); PG8_BAR;
  for (;;) {
    const bool has_next = S.next(ui + 1, nxt);
    const char* nA = has_next ? (const char*)g.A + (size_t)nxt.pm * tstepA : cA; const char* nB = has_next ? (const char*)g.Bt + (size_t)nxt.pn * tstepB : cB;
#pragma unroll 1
    for (int t = 0; t < nt; t += 2) {
      const bool last = (t == nt - 2);
      const char* a1 = cA + (size_t)(t + 1) * kstep;
      const char* a2 = last ? nA : cA + (size_t)(t + 2) * kstep; const char* b2 = last ? nB : cB + (size_t)(t + 2) * kstep;
      const char* a3 = a2 + kstep; const char* b3 = b2 + kstep;
      PG8_LDB(B0, 0, 0); PG8_LDB(B1, 0, 1); PG8_SCHED; PG8_LDA(At, 0, 0); PG8_STAGE(PG8_SA(1, 1), a1 + hstepA, voffA);
      PG8_WAIT_V(8); PG8_WAIT_L(0); PG8_BAR; PG8_MMA(0, 0, At, B0); PG8_MMA(0, 1, At, B1); PG8_BAR; PG8_SCHED;
      PG8_LDA(At, 0, 1); PG8_STAGE(PG8_SB(0, 0), b2, voffB); PG8_STAGE(PG8_SB(0, 1), b2 + hstepB, voffB); PG8_STAGE(PG8_SA(0, 0), a2, voffA);
      PG8_WAIT_V(8); PG8_WAIT_L(0); PG8_BAR; PG8_MMA(1, 0, At, B0); PG8_MMA(1, 1, At, B1); PG8_BAR; PG8_SCHED;
      PG8_LDB(B0, 1, 0); PG8_LDB(B1, 1, 1); PG8_SCHED; PG8_LDA(At, 1, 0); PG8_STAGE(PG8_SA(0, 1), a2 + hstepA, voffA);
      PG8_WAIT_V(8); PG8_WAIT_L(0); PG8_BAR; PG8_MMA(0, 0, At, B0); PG8_MMA(0, 1, At, B1); PG8_BAR; PG8_SCHED;
      PG8_LDA(At, 1, 1); PG8_STAGE(PG8_SB(1, 0), b3, voffB); PG8_STAGE(PG8_SB(1, 1), b3 + hstepB, voffB); PG8_STAGE(PG8_SA(1, 0), a3, voffA);
      PG8_WAIT_V(8); PG8_WAIT_L(0); PG8_BAR; PG8_MMA(1, 0, At, B0); PG8_MMA(1, 1, At, B1); PG8_BAR; PG8_SCHED;
    }
    if (wr == 0) PG8_BAR;
    E(acc, cur, wr, wc, fr, fq);
    if (!has_next) break;
#pragma unroll
    for (int a = 0; a < 2; ++a)
#pragma unroll
      for (int b = 0; b < 2; ++b)
#pragma unroll
        for (int m = 0; m < 4; ++m)
#pragma unroll
          for (int n = 0; n < 2; ++n) acc[a][b][m][n] = (f32x4){0.f, 0.f, 0.f, 0.f};
    cur = nxt; cA = nA; cB = nB; ++ui;
    if (wr == 1) PG8_BAR;
  }
  PG8_WAIT_V(0);
  PG8_BAR;
#undef PG8_SA
#undef PG8_SB
#undef PG8_STAGE
#undef PG8_LDA
#undef PG8_LDB
#undef PG8_MMA
#undef PG8_WAIT_V
#undef PG8_WAIT_L
#undef PG8_BAR
#undef PG8_SCHED
}

DEVI float rs_from8(const float* s) { const f32x4 a = *(const f32x4*)s, b = *(const f32x4*)(s + 4); return rsqrtf((((a.x + a.y) + (a.z + a.w)) + ((b.x + b.y) + (b.z + b.w))) * (1.f / DM) + EPS); }
struct EpiProj { u16* proj; const int* pos; const float* ssq8; float* ssqq; float* ssqkv;
  DEVI void operator()(const f32x4 (&acc)[2][2][4][2], const Unit& u, int wr, int wc, int fr, int fq) const {
    const int row0 = u.pm * BM + wr * 64 + fr, col0 = u.pn * BM + wc * 32 + 8 * fq;
#pragma unroll
    for (int ai = 0; ai < 2; ++ai)
#pragma unroll
      for (int m = 0; m < 4; ++m) { const int row = row0 + ai * HALF + m * 16; const float rs = rs_from8(ssq8 + (size_t)row * 8); const float posf = (float)pos[row];
        float sq0 = 0.f, sq1 = 0.f;
#pragma unroll
        for (int bj = 0; bj < 2; ++bj) { const int gcol = col0 + bj * HALF;
          float v[8]; { const f32x4 a = acc[ai][bj][m][0] * rs, b = acc[ai][bj][m][1] * rs; v[0] = a.x; v[1] = a.y; v[2] = a.z; v[3] = a.w; v[4] = b.x; v[5] = b.y; v[6] = b.z; v[7] = b.w; }
          if (u.pn <= 1) { float s = 0.f;
#pragma unroll
            for (int q = 0; q < 8; ++q) s = fmaf(v[q], v[q], s);
            if (bj == 0) sq0 = s; else sq1 = s; }
          const bool r64 = gcol >= PC_SQ && gcol < PC_SV, r32g = gcol >= PC_KR && gcol < PC_KR + 32;
          if (r64 || r32g) {
#pragma unroll
            for (int q = 0; q < 4; ++q) { const int f = r64 ? (((gcol + 2 * q) & 63) >> 1) : 2 * (((gcol + 2 * q) & 31) >> 1); float sn, cs; rope_sc(posf, f, sn, cs);
              const float x1 = v[2 * q], x2 = v[2 * q + 1]; v[2 * q] = x1 * cs - x2 * sn; v[2 * q + 1] = x2 * cs + x1 * sn; } }
          *(u32x4*)(proj + (size_t)row * INWP + gcol) = pk8(v); }
        if (u.pn <= 1) { float s = u.pn == 0 ? sq0 + sq1 : sq0; s += __shfl_xor(s, 16); s += __shfl_xor(s, 32);
          if (fq == 0) (u.pn == 0 ? ssqq : ssqkv)[(size_t)row * 4 + wc] = s; } }
  }
};
struct EpiQ2 { u16* qm; const float* ssqq;
  DEVI void operator()(const f32x4 (&acc)[2][2][4][2], const Unit& u, int wr, int wc, int fr, int fq) const {
    const int b = (u.pm * BM) >> 13, s0 = (u.pm * BM) & (SEQ - 1), lrow = wr * 64 + fr;
    const float* sq = ssqq + (size_t)(u.pm * BM) * 4 + lrow * 4;
    float rs[2][4];
#pragma unroll
    for (int ai = 0; ai < 2; ++ai)
#pragma unroll
      for (int m = 0; m < 4; ++m) { const f32x4 sp = *(const f32x4*)(sq + (ai * HALF + m * 16) * 4); rs[ai][m] = rsqrtf(((sp.x + sp.y) + (sp.z + sp.w)) * (1.f / 256.f) + EPS); }
#pragma unroll
    for (int bj = 0; bj < 2; ++bj) { const int gcol = u.pn * BM + bj * HALF + wc * 32 + 8 * fq;
      if (gcol < 576) { const int head = (gcol * 683) >> 16, j0 = gcol - head * 96;
        u16* base = qm + ((size_t)(b * MLA_H + head) * SEQ + s0) * MLA_QK + (unsigned)(lrow * MLA_QK + j0);
#pragma unroll
        for (int ai = 0; ai < 2; ++ai)
#pragma unroll
          for (int m = 0; m < 4; ++m) { const float r = rs[ai][m];
            float v[8]; { const f32x4 a = acc[ai][bj][m][0] * r, bb = acc[ai][bj][m][1] * r; v[0] = a.x; v[1] = a.y; v[2] = a.z; v[3] = a.w; v[4] = bb.x; v[5] = bb.y; v[6] = bb.z; v[7] = bb.w; }
            *(u32x4*)(base + (ai * HALF + m * 16) * MLA_QK) = pk8(v); } } }
  }
};
struct EpiKV2 { u16* km; u16* vm; const float* ssqkv;
  DEVI void operator()(const f32x4 (&acc)[2][2][4][2], const Unit& u, int wr, int wc, int fr, int fq) const {
    const int b = (u.pm * BM) >> 13, s0 = (u.pm * BM) & (SEQ - 1), lrow = wr * 64 + fr;
    const float* sq = ssqkv + (size_t)(u.pm * BM) * 4 + lrow * 4;
    float rs[2][4];
#pragma unroll
    for (int ai = 0; ai < 2; ++ai)
#pragma unroll
      for (int m = 0; m < 4; ++m) { const f32x4 sp = *(const f32x4*)(sq + (ai * HALF + m * 16) * 4); rs[ai][m] = rsqrtf(((sp.x + sp.y) + (sp.z + sp.w)) * (1.f / 128.f) + EPS); }
#pragma unroll
    for (int bj = 0; bj < 2; ++bj) { const int head = u.pn * 2 + bj, c = wc * 32 + 8 * fq;
      const size_t tok0 = (size_t)(b * MLA_H + head) * SEQ + s0;
      u16* base = c < 64 ? km + tok0 * MLA_QK + (unsigned)(lrow * MLA_QK + c) : vm + tok0 * MLA_V + (unsigned)(lrow * MLA_V + (c - 64));
      const int ld = c < 64 ? MLA_QK : MLA_V;
#pragma unroll
      for (int ai = 0; ai < 2; ++ai)
#pragma unroll
        for (int m = 0; m < 4; ++m) { const float r = rs[ai][m];
          float v[8]; { const f32x4 a = acc[ai][bj][m][0] * r, bb = acc[ai][bj][m][1] * r; v[0] = a.x; v[1] = a.y; v[2] = a.z; v[3] = a.w; v[4] = bb.x; v[5] = bb.y; v[6] = bb.z; v[7] = bb.w; }
          *(u32x4*)(base + (ai * HALF + m * 16) * ld) = pk8(v); } }
  }
};
struct EpiPQ { u16* O; const float* ssq16;
  DEVI void operator()(const f32x4 (&acc)[2][2][4][2], const Unit& u, int wr, int wc, int fr, int fq) const {
    const int row0 = u.pm * BM + wr * 64 + fr, col0 = u.pn * BM + wc * 32 + 8 * fq;
#pragma unroll
    for (int ai = 0; ai < 2; ++ai)
#pragma unroll
      for (int m = 0; m < 4; ++m) { const int row = row0 + ai * HALF + m * 16;
        const f32x4* sp = (const f32x4*)(ssq16 + (size_t)row * 16); const f32x4 s4 = (sp[0] + sp[1]) + (sp[2] + sp[3]);
        const float rs = rsqrtf(((s4.x + s4.y) + (s4.z + s4.w)) * (1.f / DM) + EPS);
#pragma unroll
        for (int bj = 0; bj < 2; ++bj) { float v[8]; { const f32x4 a = acc[ai][bj][m][0] * rs, b = acc[ai][bj][m][1] * rs; v[0] = a.x; v[1] = a.y; v[2] = a.z; v[3] = a.w; v[4] = b.x; v[5] = b.y; v[6] = b.z; v[7] = b.w; }
          *(u32x4*)(O + (size_t)row * 2048 + col0 + bj * HALF) = pk8(v); } }
  }
};
struct EpiRes { u16* xg; float* ssq16;
  DEVI void operator()(const f32x4 (&acc)[2][2][4][2], const Unit& u, int wr, int wc, int fr, int fq) const {
    const int row0 = u.pm * BM + wr * 64 + fr, col0 = u.pn * BM + wc * 32 + 8 * fq;
#pragma unroll
    for (int ai = 0; ai < 2; ++ai)
#pragma unroll
      for (int m = 0; m < 4; ++m) { const int row = row0 + ai * HALF + m * 16; float ss = 0.f;
#pragma unroll
        for (int bj = 0; bj < 2; ++bj) { const size_t o = (size_t)row * DM + col0 + bj * HALF;
          float x[8]; unpk8(*(const u32x4*)(xg + o), x);
          const f32x4 a = acc[ai][bj][m][0], b = acc[ai][bj][m][1];
          x[0] += a.x; x[1] += a.y; x[2] += a.z; x[3] += a.w; x[4] += b.x; x[5] += b.y; x[6] += b.z; x[7] += b.w;
#pragma unroll
          for (int q = 0; q < 8; ++q) ss = fmaf(x[q], x[q], ss);
          *(u32x4*)(xg + o) = pk8(x); }
        ss += __shfl_xor(ss, 16); ss += __shfl_xor(ss, 32);
        if (fq == 0) ssq16[(size_t)row * 16 + u.pn * 4 + wc] = ss; }
  }
};
}


DEVI void lru_gate_item(const Params& p, int l, int mt, int n, char* lds) {
  const int tid = tidx(), lane = tid & 63, wid = tid >> 6, wm = wid >> 1, wn = wid & 1, r32 = lane & 31, hi = lane >> 5;
  const int srow = tid >> 3, sc = tid & 7, m0 = mt * 256;
  const u16* PROJ = (const u16*)(p.ws + WS_R1);
  GemmDesc g{}; g.proj = PROJ; g.cw = p.conv_w + l * 4 * LRU_W; g.cb = p.conv_b + l * LRU_W; g.ch0 = n * 64;
  char* Ab = lds; char* Bb = lds + 32768;
  { bf16x8 ar[4], br[4];
#pragma unroll
    for (int i = 0; i < 4; ++i) ar[i] = load_a<1>(g, m0 + srow + 64 * i, sc * 8);
    const u16* W = (const u16*)(p.ws + WS_WLRU) + (size_t)((l * 6 + n) * 2) * 128 * 64;
#pragma unroll
    for (int i = 0; i < 4; ++i) br[i] = *(const bf16x8*)(W + (size_t)(srow + 64 * i) * 64 + sc * 8);
#pragma unroll
    for (int i = 0; i < 4; ++i) { *(bf16x8*)(Ab + swz(srow + 64 * i, sc)) = ar[i]; *(bf16x8*)(Bb + (i >> 1) * 16384 + swz(srow + 64 * (i & 1), sc)) = br[i]; } }
  __syncthreads();
  bf16x8 a[2][4];
#pragma unroll
  for (int t = 0; t < 2; ++t)
#pragma unroll
    for (int k = 0; k < 4; ++k) a[t][k] = *(const bf16x8*)(Ab + swz(wm * 64 + t * 32 + r32, k * 2 + hi));
  const int jl = 32 * wn + r32, ch = n * 64 + jl;
  float xf[2][16];
#pragma unroll
  for (int t = 0; t < 2; ++t)
#pragma unroll
    for (int r = 0; r < 16; ++r) { const int row = wm * 64 + t * 32 + crow(r, hi); xf[t][r] = bf2f(*(const u16*)(Ab + swz(row, jl >> 3) + (jl & 7) * 2)); }
  const int bidx = m0 >> 13, s0 = (m0 & (SEQ - 1)) + wm * 64;
#pragma unroll
  for (int d = 0; d < 2; ++d) {
    f32x16 acc[2][2] = {{f32x16{}, f32x16{}}, {f32x16{}, f32x16{}}};
#pragma unroll
    for (int k = 0; k < 4; ++k) { bf16x8 b[2];
#pragma unroll
      for (int q = 0; q < 2; ++q) b[q] = *(const bf16x8*)(Bb + d * 16384 + swz(wn * 64 + q * 32 + r32, k * 2 + hi));
#pragma unroll
      for (int t = 0; t < 2; ++t)
#pragma unroll
        for (int q = 0; q < 2; ++q) acc[t][q] = __builtin_amdgcn_mfma_f32_32x32x16_bf16(a[t][k], b[q], acc[t][q], 0, 0, 0); }
    const float bav = p.lru_ba[((l * 2 + d) * 6 + n) * 64 + jl], bxv = p.lru_bx[((l * 2 + d) * 6 + n) * 64 + jl];
    const float cdec = -8.f * log1pf(__expf(-p.lru_lambda[(l * 2 + d) * LRU_W + ch]));
    u16* le = (u16*)(p.ws + WS_LE); u16* lb = (u16*)(p.ws + WS_LB);
    float runP[2][4], runH[2][4];
#pragma unroll
    for (int t = 0; t < 2; ++t)
#pragma unroll
      for (int rr = 0; rr < 4; ++rr) {
        float ev[4], bv[4];
#pragma unroll
        for (int q = 0; q < 4; ++q) { const int r = rr * 4 + q;
          const float rg = sigmoidf_(acc[t][0][r] + bav), ig = sigmoidf_(acc[t][1][r] + bxv);
          const float aa = __expf(cdec * rg), e = 1.f - aa; ev[q] = e; bv[q] = sqrtf(e * (2.f - e)) * ig * xf[t][r]; }
        const size_t o = (((size_t)(d * NB + bidx) * (SEQ / 8) + ((s0 + 32 * t + 8 * rr) >> 3)) * LRU_W + ch) * 8 + 4 * hi;
        const u32x2 ew = {pk2(ev[0], ev[1]), pk2(ev[2], ev[3])}, bw = {pk2(bv[0], bv[1]), pk2(bv[2], bv[3])};
        *(u32x2*)(le + o) = ew; *(u32x2*)(lb + o) = bw;
        const float a0 = 1.f - bflo(ew.x), a1 = 1.f - bfhi(ew.x), a2 = 1.f - bflo(ew.y), a3 = 1.f - bfhi(ew.y);
        const float b0 = bflo(bw.x), b1 = bfhi(bw.x), b2 = bflo(bw.y), b3 = bfhi(bw.y);
        if (d == 0) { runP[t][rr] = (a0 * a1) * (a2 * a3); runH[t][rr] = fmaf(a3, fmaf(a2, fmaf(a1, b0, b1), b2), b3); }
        else { runP[t][rr] = (a0 * a1) * (a2 * a3); runH[t][rr] = fmaf(a0, fmaf(a1, fmaf(a2, b3, b2), b1), b0); } }
    { float Pc = 1.f, Hc = 0.f;
#pragma unroll
      for (int i = 0; i < 8; ++i) { const int ii = d == 0 ? i : 7 - i, t = ii >> 2, rr = ii & 3;
        auto rp = __builtin_amdgcn_permlane32_swap(__float_as_uint(runP[t][rr]), __float_as_uint(runP[t][rr]), false, false);
        auto rh = __builtin_amdgcn_permlane32_swap(__float_as_uint(runH[t][rr]), __float_as_uint(runH[t][rr]), false, false);
        const float P0 = __uint_as_float(rp[0]), P1 = __uint_as_float(rp[1]), H0 = __uint_as_float(rh[0]), H1 = __uint_as_float(rh[1]);
        if (d == 0) { Hc = fmaf(P0, Hc, H0); Pc *= P0; Hc = fmaf(P1, Hc, H1); Pc *= P1; }
        else { Hc = fmaf(P1, Hc, H1); Pc *= P1; Hc = fmaf(P0, Hc, H0); Pc *= P0; } }
      if (hi == 0) { const size_t o = ((size_t)(d * NB + bidx) * NLCH + (s0 >> 6)) * LRU_W + ch;
        ((float*)(p.ws + WS_LP))[o] = Pc; ((float*)(p.ws + WS_LH))[o] = Hc; } }
  }
  __syncthreads();
}


DEVI void sort16_desc(float (&v)[16]) {
#pragma unroll
  for (int k = 2; k <= 16; k <<= 1)
#pragma unroll
    for (int j = k >> 1; j > 0; j >>= 1)
#pragma unroll
      for (int i = 0; i < 16; ++i) { const int l = i ^ j; if (l > i) { const float a = v[i], b = v[l]; const bool desc = (i & k) == 0;
          v[i] = desc ? fmaxf(a, b) : fminf(a, b); v[l] = desc ? fminf(a, b) : fmaxf(a, b); } }
}
DEVI void merge16_desc(float (&l)[16], const float (&s)[16]) {
#pragma unroll
  for (int i = 0; i < 16; ++i) l[i] = fmaxf(l[i], s[15 - i]);
#pragma unroll
  for (int st = 8; st >= 1; st >>= 1)
#pragma unroll
    for (int i = 0; i < 16; ++i) if ((i & st) == 0) ce_desc(l[i], l[i + st]);
}
DEVI void pair_merge16(float (&l)[16]) {
  float o[16];
#pragma unroll
  for (int i = 0; i < 16; ++i) o[i] = __shfl_xor(l[i], 1);
  merge16_desc(l, o);
}
DEVI void top16_from_C(const float* C, int row, int part, float (&l)[16]) {
#pragma unroll
  for (int i = 0; i < 16; ++i) l[i] = -3.0e38f;
#pragma unroll 1
  for (int bt = 0; bt < 4; ++bt) { float s[16];
#pragma unroll
    for (int i = 0; i < 16; ++i) { const int col = part * 64 + ((bt * 16 + i + row) & 63);
      s[i] = __uint_as_float((__float_as_uint(C[row * CLD + col]) & ~127u) | (unsigned)(127 - col)); }
    sort16_desc(s);
    merge16_desc(l, s); }
  pair_merge16(l);
}
DEVI void peer_route_item(const Params& p, int l, int mt, int h, char* lds) {
  const int tid = tidx(), row = tid >> 1, part = tid & 1, m0 = mt * 256;
  const u16* PQ = (const u16*)(p.ws + WS_R1);
  float t1[16], t2[16];
#pragma unroll
  for (int j = 0; j < 2; ++j) {
    GemmDesc g{}; g.A = PQ + (h * 2 + j) * 128; g.lda = 2048; g.Bt = (const u16*)(p.ws + WS_SUBK) + (size_t)(l * 2 + j) * 128 * 128; g.ldb = 128; g.KT = 2;
    gemm_core<0, 0>(g, m0, 0, lds);
    if (j == 0) top16_from_C((const float*)lds, row, part, t1); else top16_from_C((const float*)lds, row, part, t2);
    __syncthreads(); }
  constexpr int CA[50] = {0, 0, 0, 0, 0, 0, 0, 0, 0, 0, 0, 0, 0, 0, 0, 0, 1, 1, 1, 1, 1, 1, 1, 1, 2, 2, 2, 2, 2, 3, 3, 3, 3, 4, 4, 4, 5, 5, 6, 6, 7, 7, 8, 9, 10, 11, 12, 13, 14, 15};
  constexpr int CB[50] = {0, 1, 2, 3, 4, 5, 6, 7, 8, 9, 10, 11, 12, 13, 14, 15, 0, 1, 2, 3, 4, 5, 6, 7, 0, 1, 2, 3, 4, 0, 1, 2, 3, 0, 1, 2, 0, 1, 0, 1, 0, 1, 0, 0, 0, 0, 0, 0, 0, 0};
  float lo[16], hi2[16];
#pragma unroll
  for (int k = 0; k < 32; ++k) { float v = -3.0e38f;
    if (k < 25) { const float v0 = __uint_as_float((__float_as_uint(t1[CA[2 * k]] + t2[CB[2 * k]]) & ~255u) | (unsigned)(255 - (CA[2 * k] * 16 + CB[2 * k])));
      const float v1 = __uint_as_float((__float_as_uint(t1[CA[2 * k + 1]] + t2[CB[2 * k + 1]]) & ~255u) | (unsigned)(255 - (CA[2 * k + 1] * 16 + CB[2 * k + 1])));
      v = part ? v1 : v0; }
    if (k < 16) lo[k] = v; else hi2[k - 16] = v; }
  sort16_desc(lo); sort16_desc(hi2); merge16_desc(lo, hi2); pair_merge16(lo);
  const float mx = __uint_as_float(__float_as_uint(lo[0]) & ~255u);
  float w[16], sum = 0.f;
#pragma unroll
  for (int i = 0; i < 16; ++i) { w[i] = __expf(__uint_as_float(__float_as_uint(lo[i]) & ~255u) - mx); sum += w[i]; }
  const float inv = 1.f / sum;
  unsigned char* my = (unsigned char*)lds + tid * 32;
#pragma unroll
  for (int i = 0; i < 16; ++i) { my[i] = (unsigned char)(127u - (__float_as_uint(t1[i]) & 127u)); my[16 + i] = (unsigned char)(127u - (__float_as_uint(t2[i]) & 127u)); }
  unsigned ev[8]; float gv[8];
  const unsigned pm = 0u - (unsigned)part;
#pragma unroll
  for (int i = 0; i < 8; ++i) { const unsigned xb = __float_as_uint(lo[i]) ^ ((__float_as_uint(lo[i]) ^ __float_as_uint(lo[8 + i])) & pm); const unsigned code = 255u - (xb & 255u);
    const unsigned wb = __float_as_uint(w[i]) ^ ((__float_as_uint(w[i]) ^ __float_as_uint(w[8 + i])) & pm);
    ev[i] = (unsigned)my[code >> 4] * 128u + (unsigned)my[16 + (code & 15)]; gv[i] = __uint_as_float(wb) * inv; }
  const size_t o = ((size_t)(m0 + row) * 8 + h) * 16 + part * 8;
  *(u32x4*)((u16*)(p.ws + WS_EIDX) + o) = (u32x4){ev[0] | (ev[1] << 16), ev[2] | (ev[3] << 16), ev[4] | (ev[5] << 16), ev[6] | (ev[7] << 16)};
  *(f32x4*)((float*)(p.ws + WS_EGATE) + o) = (f32x4){gv[0], gv[1], gv[2], gv[3]}; *(f32x4*)((float*)(p.ws + WS_EGATE) + o + 4) = (f32x4){gv[4], gv[5], gv[6], gv[7]};
  __syncthreads();
}

DEVI void peer_convert_tables(const Params& p, int l, size_t i0, size_t istep) {
  const float* us = p.peer_u + (size_t)l * NEXP * DM; const float* vs = p.peer_v + (size_t)l * NEXP * DM;
  u8* ub = (u8*)(p.ws + WS_UB); u8* vbf = (u8*)(p.ws + WS_VB);
  for (size_t i = i0; i < (size_t)NEXP * 64; i += istep) {
    const size_t e = i >> 6; const int c16 = (int)(i & 63), s = c16 >> 3, cc = (c16 & 7) * 16;
    float a[16], b[16]; ld8(us + i * 16, a); ld8(us + i * 16 + 8, a + 8); ld8(vs + i * 16, b); ld8(vs + i * 16 + 8, b + 8);
    const size_t o = ((size_t)s * NEXP + e) * 128 + cc;
    *(u32x4*)(ub + o) = (u32x4){q8x4(a, PEER_SU), q8x4(a + 4, PEER_SU), q8x4(a + 8, PEER_SU), q8x4(a + 12, PEER_SU)};
    *(u32x4*)(vbf + o) = (u32x4){q8x4(b, PEER_SV), q8x4(b + 4, PEER_SV), q8x4(b + 8, PEER_SV), q8x4(b + 12, PEER_SV)}; }
}

constexpr int PH_PER_LAYER = 10, N_PHASES = 2 + DEPTH * PH_PER_LAYER;
DEVI void run_phase(const Params& pin, int ph, int vb, int nb, char* lds) {
  const bool dry = ph >= 100; if (dry) ph -= 100;
  Params p = pin; { size_t z = 0; asm volatile("" : "+s"(z)); p.ws = pin.ws + z; p.out = pin.out + z; } asm volatile("" : "+s"(vb));
  const int tid = tidx(), wid = tid >> 6, lane = tid & 63;
#ifdef ONLY_SP
  if (ONLY_SP >= 0 && ph == 0) return;
#endif
  if (ph == 0) { phase0(p, vb, nb, lds); return; }
  if (ph == N_PHASES - 1) {
    const float* ssq = (const float*)(p.ws + WS_SSQ);
    for (size_t i = (size_t)vb * NTHREADS + tid; i < (size_t)T * DM / 8; i += (size_t)nb * NTHREADS) {
      const size_t t = i >> 7; const int c = (int)(i & 127) * 8;
      float s8[8]; ld8(ssq + t * 8, s8); const float rs = rsqrtf((((s8[0] + s8[1]) + (s8[2] + s8[3])) + ((s8[4] + s8[5]) + (s8[6] + s8[7]))) * (1.f / DM) + EPS);
      float x[8], g[8]; ld8(p.out + i * 8, x); ld8(p.norm_final + c, g);
#pragma unroll
      for (int q = 0; q < 8; ++q) x[q] *= rs * g[q];
      *(f32x4*)(p.out + i * 8) = (f32x4){x[0], x[1], x[2], x[3]}; *(f32x4*)(p.out + i * 8 + 4) = (f32x4){x[4], x[5], x[6], x[7]}; }
    return; }
  const int l = (ph - 1) / PH_PER_LAYER, sp = (ph - 1) % PH_PER_LAYER;
  u16* const XG = (u16*)(p.ws + WS_XG); u16* const PROJ = (u16*)(p.ws + WS_R1); u16* const MIX = (u16*)(p.ws + WS_MIX);
  constexpr int NMT = T / 256;
#ifdef ONLY_SP
  if (sp != ONLY_SP) return;
#endif
  switch (sp) {
  case 0: {
    pg8::Gemm g{XG, (const u16*)(p.ws + WS_WIN) + (size_t)l * INWP * DM, T, INWP, DM, DM, DM}; pg8::StaticOrder S; S.init(T, INWP, nb, vb);
    pg8::EpiProj e{PROJ, p.pos, (const float*)(p.ws + WS_SSQ), (float*)(p.ws + WS_SSQQ), (float*)(p.ws + WS_SSQKV)};
    pg8::gemm_phase((PG8_LAS unsigned char*)lds, g, S, e);
    if (!dry) { if (nb == 256) { if (vb >= 128) peer_convert_tables(p, l, (size_t)(vb - 128) * NTHREADS + tid, (size_t)128 * NTHREADS); }
                else peer_convert_tables(p, l, (size_t)vb * NTHREADS + tid, (size_t)nb * NTHREADS); }
  } break;
  case 1: {
    { pg8::Gemm g{PROJ + PC_CQ, (const u16*)(p.ws + WS_WUQ) + (size_t)l * 768 * 256, T, 768, 256, INWP, 256}; pg8::StaticOrder S; S.init(T, 768, nb, vb);
      pg8::EpiQ2 e{(u16*)(p.ws + WS_QM), (const float*)(p.ws + WS_SSQQ)};
      pg8::gemm_phase((PG8_LAS unsigned char*)lds, g, S, e); }
    { pg8::Gemm g{PROJ + PC_CKV, (const u16*)(p.ws + WS_WUKV) + (size_t)l * 768 * 128, T, 768, 128, INWP, 128}; pg8::StaticOrder S; S.init(T, 768, nb, nb - 1 - vb);
      pg8::EpiKV2 e{(u16*)(p.ws + WS_KM), (u16*)(p.ws + WS_VM), (const float*)(p.ws + WS_SSQKV)};
      pg8::gemm_phase((PG8_LAS unsigned char*)lds, g, S, e); }
    for (int i = vb * NTHREADS + tid; i < T * MLA_H * 4; i += nb * NTHREADS) { const int c = (i & 3) * 8, h = (i >> 2) % MLA_H, row = i / (4 * MLA_H), b = row >> 13, s = row & (SEQ - 1);
      *(u32x4*)((u16*)(p.ws + WS_KM) + ((size_t)(b * MLA_H + h) * SEQ + s) * MLA_QK + 64 + c) = *(const u32x4*)(PROJ + (size_t)row * INWP + PC_KR + c); }
    for (int it = vb; it < NMT * 6; it += nb) lru_gate_item(p, l, it / 6, it % 6, lds);
    for (int it = vb; it < NB * 64 * 2; it += nb) swa_item(p, l, it, lds);
  } break;
  case 2: {
    { const int wi = vb * 8 + wid; if (wi < 48) lru_passB(p, wi, lane); __syncthreads(); }
    for (int k = 0; k * nb + vb < NB * MLA_H * 32; ++k) {
      int pair, qb;
      if (nb == 256) { pair = k * 8 + (vb & 7); qb = vb >> 3; } else { const int it = k * nb + vb; pair = it >> 5; qb = it & 31; }
      mla_item(p, pair, qb, lds);
    }
  } break;
  case 3: {
#ifndef NO_LRUF
    if (!dry) for (int it = vb; it < NB * NLCH; it += nb) lru_final(p, it, lds);
#endif
    for (int t = vb * 8 + wid; t < T; t += nb * 8) {
      u32x4* rp = (u32x4*)(MIX + (size_t)t * DM + lane * 16);
      float v[16]; unpk8(rp[0], v); unpk8(rp[1], v + 8);
      float s = 0.f;
#pragma unroll
      for (int q = 0; q < 16; ++q) s = fmaf(v[q], v[q], s);
      const int sg = lane < 24 ? 0 : (lane < 48 ? 1 : 2);
      const float s0 = wave_sum(sg == 0 ? s : 0.f), s2 = wave_sum(sg == 2 ? s : 0.f);
      const float rs = sg == 0 ? rsqrtf(s0 * (1.f / 384.f) + EPS) : rsqrtf(s2 * (1.f / 256.f) + EPS);
      if (sg != 1) {
#pragma unroll
        for (int q = 0; q < 16; ++q) v[q] *= rs;
        rp[0] = pk8(v); rp[1] = pk8(v + 8); } }
  } break;
  case 4: {
    { pg8::Gemm g{MIX, (const u16*)(p.ws + WS_WOUT) + (size_t)l * DM * DM, T, DM, DM, DM, DM}; pg8::StaticOrder S; S.init(T, DM, nb, vb);
      pg8::EpiRes e{dry ? (u16*)(p.ws + WS_R1) : XG, (float*)(p.ws + WS_SSQ16)};
      pg8::gemm_phase((PG8_LAS unsigned char*)lds, g, S, e); }
  } break;
  case 5: {
    pg8::Gemm g{XG, (const u16*)(p.ws + WS_WQ) + (size_t)l * 2048 * DM, T, 2048, DM, DM, DM}; pg8::StaticOrder S; S.init(T, 2048, nb, vb);
    pg8::EpiPQ e{PROJ, (const float*)(p.ws + WS_SSQ16)};
    pg8::gemm_phase((PG8_LAS unsigned char*)lds, g, S, e);
  } break;
  case 6: {
    for (int it = vb; it < NMT * 8; it += nb) peer_route_item(p, l, it >> 3, it & 7, lds);
    if (!dry) peer_xn_pass(p, l, vb, nb);
  } break;
  case 7: case 9: {
    const bool last = l == DEPTH - 1;
    float* xo = dry ? (float*)(p.ws + WS_PD) : p.out;
    int s0, s1, tb, ts;
    if ((nb & 7) == 0) { s0 = vb & 7; s1 = s0 + 1; tb = (vb >> 3) * 8 + wid; ts = (nb >> 3) * 8; } else { s0 = 0; s1 = 8; tb = vb * 8 + wid; ts = nb * 8; }
#pragma unroll 1
    for (int s = s0; s < s1; ++s) { if (sp == 7) peer_slice_phase<false>(p, s, tb, ts, lane, p.out, xo, last); else peer_slice_phase<true>(p, s, tb, ts, lane, p.out, xo, last); }
  } break;
  case 8: {
    const float* pd = (const float*)(p.ws + WS_PD); const float* eg = (const float*)(p.ws + WS_EGATE); u16* cc = (u16*)(p.ws + WS_CC); float* cs = (float*)(p.ws + WS_CS);
    for (int t = vb * 8 + wid; t < T; t += nb * 8) {
      f32x2 a = *(const f32x2*)(pd + (size_t)t * 128 + 2 * lane);
#pragma unroll
      for (int s = 1; s < 8; ++s) a += *(const f32x2*)(pd + ((size_t)s * T + t) * 128 + 2 * lane);
      const f32x2 g = *(const f32x2*)(eg + (size_t)t * 128 + 2 * lane);
      const float c0 = gelu_erf(a.x * (1.f / PEER_SU)) * g.x, c1 = gelu_erf(a.y * (1.f / PEER_SU)) * g.y;
      float mx = fmaxf(fabsf(c0), fabsf(c1));
#pragma unroll
      for (int o = 1; o < 64; o <<= 1) mx = fmaxf(mx, __shfl_xor(mx, o));
      const float st = fmaxf(mx, 1e-30f) * (1.f / 127.f), ist = 1.f / st;
      int q0 = __float2int_rn(c0 * ist), q1 = __float2int_rn(c1 * ist);
      cc[(size_t)t * 64 + lane] = (u16)(((unsigned)q0 & 255u) | (((unsigned)q1 & 255u) << 8));
      if (lane == 0) cs[t] = st * (1.f / PEER_SV);
    }
  } break;
  }
}

#define XB_TMO      128
#define XB_XCNT(j)  (256  + 64 * (j))
#define XB_XSUB(j)  (1280 + 64 * (j))
#define XB_XGEN(j)  (2304 + 64 * (j))
#define XB_TOP      3328
#define XB_TOPGEN   3392
#define XCD_BAR_WORDS 3456
#define XB_SPIN_CAP (1u << 23)
DEVI unsigned xb_ld(unsigned* p) { return __hip_atomic_load(p, __ATOMIC_RELAXED, __HIP_MEMORY_SCOPE_AGENT); }
DEVI unsigned xb_add(unsigned* p, unsigned v) { return __hip_atomic_fetch_add(p, v, __ATOMIC_RELAXED, __HIP_MEMORY_SCOPE_AGENT); }
DEVI unsigned xb_xcc_id() { return (unsigned)__builtin_amdgcn_s_getreg((3 << 11) | 20) & 0xFu; }
#define XB_SPIN(cond, bar) do { unsigned _sp = 0; while (cond) { __builtin_amdgcn_s_sleep(1); \
    if ((++_sp & 255u) == 0u) { if (xb_ld(&(bar)[XB_TMO])) break; if (_sp > XB_SPIN_CAP) { atomicAdd(&(bar)[XB_TMO], 1u); break; } } } } while (0)
struct XcdBarrier { unsigned* bar; unsigned x; volatile unsigned* st; };
DEVI XcdBarrier xcd_barrier_post(unsigned* bar, volatile unsigned* st) {
  XcdBarrier b; b.bar = bar; b.x = xb_xcc_id(); b.st = st;
  if (threadIdx.x == 0) (void)xb_add(&bar[XB_XCNT(b.x)], 1u);
  return b;
}
DEVI void xcd_barrier_complete(unsigned* bar, unsigned x, unsigned& nloc, unsigned& nx) {
  const unsigned G = gridDim.x * gridDim.y * gridDim.z;
  unsigned sum, cnt, mine, sp = 0u;
  for (;;) {
    sum = 0u; cnt = 0u; mine = 0u;
#pragma unroll
    for (unsigned j = 0; j < 16; ++j) { const unsigned c = xb_ld(&bar[XB_XCNT(j)]); sum += c; cnt += (c > 0u) ? 1u : 0u; mine = (j == x) ? c : mine; }
    if (sum == G) break;
    __builtin_amdgcn_s_sleep(1);
    if ((++sp & 255u) == 0u) { if (xb_ld(&bar[XB_TMO])) break; if (sp > XB_SPIN_CAP) { atomicAdd(&bar[XB_TMO], 1u); break; } }
  }
  nloc = mine > 0u ? mine : 1u; nx = cnt > 0u ? cnt : 1u;
}
DEVI void xcd_barrier(const XcdBarrier& b) {
  asm volatile("s_waitcnt vmcnt(0)" ::: "memory");
  __syncthreads();
  if (threadIdx.x == 0) {
    unsigned* bar = b.bar;
    __builtin_amdgcn_s_waitcnt(0);
    unsigned nloc = b.st[0], nx = b.st[1];
    if (nloc == 0u) { xcd_barrier_complete(bar, b.x, nloc, nx); b.st[0] = nloc; b.st[1] = nx; }
    const unsigned old = xb_add(&bar[XB_XSUB(b.x)], 1u);
    const unsigned gen = old / nloc;
    if (old + 1u == (gen + 1u) * nloc) {
      __builtin_amdgcn_fence(__ATOMIC_RELEASE, "agent");
      asm volatile("s_waitcnt vmcnt(0)" ::: "memory");
      const unsigned og = xb_add(&bar[XB_TOP], 1u);
      const unsigned tg = og / nx;
      if (og + 1u == (tg + 1u) * nx) xb_add(&bar[XB_TOPGEN], 1u);
      else XB_SPIN(xb_ld(&bar[XB_TOPGEN]) == tg, bar);
      __builtin_amdgcn_fence(__ATOMIC_ACQUIRE, "agent");
      xb_add(&bar[XB_XGEN(b.x)], 1u);
      asm volatile("s_waitcnt vmcnt(0)" ::: "memory");
    } else {
      XB_SPIN(xb_ld(&bar[XB_XGEN(b.x)]) == gen, bar);
      __builtin_amdgcn_fence(__ATOMIC_ACQUIRE, "agent");
      asm volatile("s_waitcnt vmcnt(0)" ::: "memory");
    }
  }
  __syncthreads();
}

__global__ void __launch_bounds__(NTHREADS, 2) mega(Params p) {
  extern __shared__ __attribute__((aligned(16))) char smem[];
  cg::grid_group grid = cg::this_grid();
  const int nb = gridDim.x, vb = blockIdx.x;
  volatile unsigned* st = (volatile unsigned*)(smem + LDS_BYTES - 16);
  if (threadIdx.x == 0) { st[0] = 0u; st[1] = 0u; }
  __syncthreads();
  const XcdBarrier bar = xcd_barrier_post((unsigned*)p.ws, st);
#define GRID_BAR(first) do { if (first) grid.sync(); else xcd_barrier(bar); } while (0)
  for (int ph = p.ph_lo; ph < p.ph_hi; ++ph) {
#ifdef PROBE_DUP
    if (ph > 0 && ph < N_PHASES - 1 && ((PROBE_DUP >> ((ph - 1) % PH_PER_LAYER)) & 1)) { run_phase(p, ph + 100, vb, nb, smem); GRID_BAR(false); }
#endif
    run_phase(p, ph, vb, nb, smem);
    if (ph + 1 < p.ph_hi) GRID_BAR(ph == p.ph_lo);
  }
}

#ifndef N_LAUNCH_SPLIT
#define N_LAUNCH_SPLIT 0
#endif
extern "C" void kernel_launch(void* const* d_in, const int* in_sizes, int n_in, void* d_out, int out_size, void* d_ws, size_t ws_size, hipStream_t stream) {
  static int grid_blocks = 0;
  if (grid_blocks == 0) {
    if (n_in != 24 || out_size != T * DM || ws_size < WS_NEED) { fprintf(stderr, "kernel_launch: unexpected shapes n_in %d out %d ws %zu\n", n_in, out_size, ws_size); grid_blocks = -1; return; }
    int dev = 0, cus = 0, per_cu = 0;
    (void)hipGetDevice(&dev); (void)hipDeviceGetAttribute(&cus, hipDeviceAttributeMultiprocessorCount, dev);
    if (hipFuncSetAttribute((const void*)mega, hipFuncAttributeMaxDynamicSharedMemorySize, LDS_BYTES) != hipSuccess) { fprintf(stderr, "kernel_launch: hipFuncSetAttribute failed\n"); grid_blocks = -1; return; }
    if (hipOccupancyMaxActiveBlocksPerMultiprocessor(&per_cu, (const void*)mega, NTHREADS, LDS_BYTES) != hipSuccess || per_cu < 1) { fprintf(stderr, "kernel_launch: occupancy query failed (%d)\n", per_cu); grid_blocks = -1; return; }
    grid_blocks = cus * 1;
    fprintf(stderr, "kernel_launch: cus %d per_cu %d grid %d\n", cus, per_cu, grid_blocks);
  }
  if (grid_blocks < 0) return;
  if (hipMemsetAsync(d_ws, 0, 65536, stream) != hipSuccess) { fprintf(stderr, "kernel_launch: memset failed\n"); return; }
  Params p{};
  p.x = (const float*)d_in[0]; p.pos = (const int*)d_in[1]; p.norm_mix = (const float*)d_in[2]; p.w_in = (const float*)d_in[3]; p.q_norm = (const float*)d_in[4];
  p.w_uq = (const float*)d_in[5]; p.kv_norm = (const float*)d_in[6]; p.w_ukv = (const float*)d_in[7]; p.conv_w = (const float*)d_in[8]; p.conv_b = (const float*)d_in[9];
  p.lru_wa = (const float*)d_in[10]; p.lru_ba = (const float*)d_in[11]; p.lru_wx = (const float*)d_in[12]; p.lru_bx = (const float*)d_in[13]; p.lru_lambda = (const float*)d_in[14];
  p.swa_sink = (const float*)d_in[15]; p.grp_norm = (const float*)d_in[16]; p.w_out = (const float*)d_in[17]; p.norm_ffn = (const float*)d_in[18]; p.peer_wq = (const float*)d_in[19];
  p.peer_subkeys = (const float*)d_in[20]; p.peer_u = (const float*)d_in[21]; p.peer_v = (const float*)d_in[22]; p.norm_final = (const float*)d_in[23];
  p.out = (float*)d_out; p.ws = (unsigned char*)d_ws;
#if N_LAUNCH_SPLIT
  for (int ph = 0; ph < N_PHASES; ++ph) {
    p.ph_lo = ph; p.ph_hi = ph + 1;
    void* args[] = {&p};
    hipError_t e = hipLaunchCooperativeKernel((const void*)mega, dim3(grid_blocks), dim3(NTHREADS), args, LDS_BYTES, stream);
    if (e != hipSuccess) { fprintf(stderr, "kernel_launch: launch of phase %d failed: %s\n", ph, hipGetErrorString(e)); break; }
  }
#else
  p.ph_lo = 0; p.ph_hi = N_PHASES;
  void* args[] = {&p};
  hipError_t e = hipLaunchCooperativeKernel((const void*)mega, dim3(grid_blocks), dim3(NTHREADS), args, LDS_BYTES, stream);
  if (e != hipSuccess) fprintf(stderr, "kernel_launch: cooperative launch failed: %s (grid %d)\n", hipGetErrorString(e), grid_blocks);
#endif
}
```

```cpp
#include <hip/hip_runtime.h>
#include <hip/hip_cooperative_groups.h>
#include <cstdio>
#include <cstdint>
namespace cg = cooperative_groups;

#define DEVI __device__ __forceinline__
typedef unsigned short u16;
typedef short bf16x8 __attribute__((ext_vector_type(8)));
typedef short s16x4 __attribute__((ext_vector_type(4)));
typedef float f32x2 __attribute__((ext_vector_type(2)));
typedef float f32x4 __attribute__((ext_vector_type(4)));
typedef float f32x16 __attribute__((ext_vector_type(16)));
typedef unsigned u32x4 __attribute__((ext_vector_type(4)));
typedef unsigned u32x2 __attribute__((ext_vector_type(2)));
typedef __bf16 bf16x2_t __attribute__((ext_vector_type(2)));

constexpr int NB = 4, SEQ = 8192, T = NB * SEQ, DM = 1024, DEPTH = 2;
constexpr int MLA_H = 6, MLA_QK = 96, MLA_V = 64;
constexpr int LRU_W = 384;
constexpr int INW = 1696, INWP = 1792;
constexpr int PC_CQ = 0, PC_CKV = 256, PC_SQ = 384, PC_SK = 640, PC_SV = 768, PC_LX = 896, PC_LG = 1280, PC_KR = 1664;
constexpr int OC_CQ = 0, OC_CKV = 256, OC_KR = 384, OC_SQ = 416, OC_SK = 672, OC_SV = 800, OC_LX = 928, OC_LG = 1312;
constexpr int NEXP = 16384;
constexpr float EPS = 1e-6f;
constexpr int NTHREADS = 512;
constexpr int LDS_BYTES = 160 * 1024;

constexpr size_t MiB = 1u << 20;
constexpr size_t WS_CTL = 0;
constexpr size_t WS_WIN = 4 * MiB;
constexpr size_t WS_WQ = 11 * MiB;
constexpr size_t WS_WOUT = 19 * MiB;
constexpr size_t WS_WUQ = 23 * MiB;
constexpr size_t WS_WUKV = WS_WUQ + 2 * 768 * 256 * 2;
constexpr size_t WS_WLRU = WS_WUKV + 2 * 768 * 128 * 2;
constexpr size_t WS_SUBK = WS_WLRU + 2 * 6 * 2 * 128 * 64 * 2;
constexpr size_t WS_XG = 25 * MiB;
constexpr size_t WS_R1 = 89 * MiB;
constexpr size_t WS_QM = 217 * MiB;
constexpr size_t WS_KM = 253 * MiB;
constexpr size_t WS_VM = 289 * MiB;
constexpr size_t WS_LE = 313 * MiB;
constexpr size_t WS_LB = 361 * MiB;
constexpr size_t WS_MIX = 409 * MiB;
constexpr size_t WS_UB = 478 * MiB;
constexpr size_t WS_VB = 494 * MiB;
constexpr size_t WS_TOP = 281 * MiB;
constexpr size_t WS_EIDX = 313 * MiB;
constexpr size_t WS_EGATE = 329 * MiB;
constexpr size_t WS_CC = 345 * MiB;
constexpr size_t WS_SSQ = 361 * MiB;
constexpr size_t WS_SSQ16 = 363 * MiB;
constexpr size_t WS_SSQQ = 476 * MiB;
constexpr size_t WS_SSQKV = 477 * MiB;
constexpr size_t WS_PD = 89 * MiB;
constexpr float PEER_SU = 903.f, PEER_SV = 56.f;
constexpr size_t WS_CS = 349 * MiB;
constexpr size_t WS_XQ = 249 * MiB;
constexpr size_t WS_SX = 281 * MiB;
constexpr size_t WS_END = 473 * MiB;

__device__ const float ROPE_HI[32] = {1.591549367e-01f, 1.193493679e-01f, 8.949939907e-02f, 6.711508334e-02f, 5.032921210e-02f, 3.774158657e-02f, 2.830219641e-02f, 2.122365311e-02f, 1.591549441e-02f, 1.193493698e-02f, 8.949940093e-03f, 6.711508147e-03f, 5.032921210e-03f, 3.774158424e-03f, 2.830219688e-03f, 2.122365171e-03f, 1.591549488e-03f, 1.193493721e-03f, 8.949940093e-04f, 6.711508031e-04f, 5.032921326e-04f, 3.774158540e-04f, 2.830219455e-04f, 2.122365258e-04f, 1.591549371e-04f, 1.193493736e-04f, 8.949940093e-05f, 6.711508468e-05f, 5.032921035e-05f, 3.774158540e-05f, 2.830219637e-05f, 2.122365186e-05f};
__device__ const float ROPE_LO[32] = {6.420638243e-09f, 2.294664903e-09f, 2.542919653e-09f, -3.316028840e-10f, 5.173299289e-12f, -1.848551645e-09f, -5.826552019e-10f, -3.431038786e-10f, -1.029942243e-10f, 4.320196978e-11f, 6.802744479e-11f, 1.531042237e-10f, 5.173301024e-13f, 4.797548470e-11f, -1.048316434e-10f, 1.053879969e-10f, -5.686555046e-11f, -1.896286773e-11f, 6.802744999e-12f, 2.695195456e-11f, -1.158979943e-11f, -6.843983713e-12f, 1.279990003e-11f, 1.807650600e-12f, 5.954976963e-12f, -3.351478166e-12f, 6.802744674e-13f, -1.670379113e-12f, 1.751403167e-12f, -6.843983930e-13f, -5.389994549e-13f, 9.083608431e-13f};

DEVI int tidx() { int t = __builtin_amdgcn_workitem_id_x(); asm volatile("" : "+v"(t)); return t; }
DEVI float bf2f(unsigned h) { return __uint_as_float(h << 16); }
DEVI float bflo(unsigned w) { return __uint_as_float(w << 16); }
DEVI float bfhi(unsigned w) { return __uint_as_float(w & 0xffff0000u); }
DEVI unsigned pk2(float lo, float hi) { f32x2 v = {lo, hi}; bf16x2_t b = __builtin_convertvector(v, bf16x2_t); return __builtin_bit_cast(unsigned, b); }
DEVI u16 f2bf(float f) { return (u16)(pk2(f, 0.f) & 0xffffu); }
DEVI u32x4 pk8(const float* v) { u32x4 w; w.x = pk2(v[0], v[1]); w.y = pk2(v[2], v[3]); w.z = pk2(v[4], v[5]); w.w = pk2(v[6], v[7]); return w; }
DEVI void unpk8(u32x4 w, float* v) { v[0] = bflo(w.x); v[1] = bfhi(w.x); v[2] = bflo(w.y); v[3] = bfhi(w.y); v[4] = bflo(w.z); v[5] = bfhi(w.z); v[6] = bflo(w.w); v[7] = bfhi(w.w); }
DEVI void ld8(const float* p, float* v) { const f32x4 a = *(const f32x4*)p, b = *(const f32x4*)(p + 4); v[0] = a.x; v[1] = a.y; v[2] = a.z; v[3] = a.w; v[4] = b.x; v[5] = b.y; v[6] = b.z; v[7] = b.w; }
DEVI int crow(int r, int hi) { return (r & 3) + 8 * (r >> 2) + 4 * hi; }
DEVI float wave_sum(float v) {
#pragma unroll
  for (int o = 1; o < 64; o <<= 1) v += __shfl_xor(v, o);
  return v;
}
DEVI void rope_sc(float pos, int fidx, float& sn, float& cs) {
  const float chi = ROPE_HI[fidx], clo = ROPE_LO[fidx];
  const float t = pos * chi, e = fmaf(pos, chi, -t);
  float fr = t - rintf(t);
  fr = fr + (e + pos * clo);
  sn = __builtin_amdgcn_sinf(fr); cs = __builtin_amdgcn_cosf(fr);
}
DEVI float sigmoidf_(float x) { return 1.f / (1.f + __expf(-x)); }
DEVI float gelu_erf(float x) { return 0.5f * x * (1.f + erff(x * 0.70710678118654752f)); }

struct Params {
  const float* x; const int* pos; const float* norm_mix; const float* w_in; const float* q_norm; const float* w_uq; const float* kv_norm; const float* w_ukv;
  const float* conv_w; const float* conv_b; const float* lru_wa; const float* lru_ba; const float* lru_wx; const float* lru_bx; const float* lru_lambda;
  const float* swa_sink; const float* grp_norm; const float* w_out; const float* norm_ffn; const float* peer_wq; const float* peer_subkeys;
  const float* peer_u; const float* peer_v; const float* norm_final;
  float* out; unsigned char* ws;
  int ph_lo, ph_hi;
};

DEVI void tconv_item(const float* W, int ldw, int src_c0, u16* WT, int K, int dst_r0, const float* gain, float* scr, int kb, int nb, int lane, int pg = 0) {
  const int k0 = 64 * kb, n0 = 32 * nb;
#pragma unroll 8
  for (int i = 0; i < 32; ++i) { const int kk = 2 * i + (lane >> 5); float g = gain ? gain[k0 + kk] : 1.f; scr[kk * 33 + (lane & 31)] = g * W[(size_t)(k0 + kk) * ldw + src_c0 + n0 + (lane & 31)]; }
  __builtin_amdgcn_s_waitcnt(0xc07f); asm volatile("" ::: "memory");
  const int c = lane & 7;
#pragma unroll
  for (int j = 0; j < 4; ++j) { const int n = (lane >> 3) + 8 * j; const float* s = scr + (8 * c) * 33 + n;
    u32x4 o; o.x = pk2(s[0 * 33], s[1 * 33]); o.y = pk2(s[2 * 33], s[3 * 33]); o.z = pk2(s[4 * 33], s[5 * 33]); o.w = pk2(s[6 * 33], s[7 * 33]);
    int nn = n0 + n; if (pg > 0) { const int g = nn & ~(pg - 1), i = nn & (pg - 1), hw = pg >> 1; nn = g + (i < hw ? 2 * i : 2 * (i - hw) + 1); }
    else if (pg < 0) { const int j = nn % 96; if (j >= 64) { const int i = j - 64; nn = nn - i + (i < 16 ? 2 * i : 2 * (i - 16) + 1); } }
    *(u32x4*)(WT + (size_t)(dst_r0 + nn) * K + k0 + 8 * c) = o; }
  __builtin_amdgcn_s_waitcnt(0xc07f); asm volatile("" ::: "memory");
}

DEVI void p0_item(const Params& p, int it, float* scr, int lane) {
  const int l = it / 2552; int r = it - l * 2552;
  const float* win = p.w_in + (size_t)l * DM * INW; u16* wint = (u16*)(p.ws + WS_WIN) + (size_t)l * INWP * DM; const float* gm = p.norm_mix + l * DM;
#define SEG(W, ldw, sc0, ncols, WT, K, dr0, gain, pg) { const int nnb_ = (ncols) / 32, ni_ = ((K) / 64) * nnb_; if (r < ni_) { tconv_item(W, ldw, sc0, WT, K, dr0, gain, scr, r / nnb_, r % nnb_, lane, pg); return; } r -= ni_; }
  SEG(win, INW, OC_CQ, 256, wint, DM, PC_CQ, gm, 0)
  SEG(win, INW, OC_CKV, 128, wint, DM, PC_CKV, gm, 0)
  SEG(win, INW, OC_SQ, 256, wint, DM, PC_SQ, gm, 64)
  SEG(win, INW, OC_SK, 128, wint, DM, PC_SK, gm, 64)
  SEG(win, INW, OC_SV, 128, wint, DM, PC_SV, gm, 0)
  SEG(win, INW, OC_LX, 384, wint, DM, PC_LX, gm, 0)
  SEG(win, INW, OC_LG, 384, wint, DM, PC_LG, gm, 0)
  SEG(win, INW, OC_KR, 32, wint, DM, PC_KR, gm, 32)
  SEG(p.peer_wq + (size_t)l * DM * 2048, 2048, 0, 2048, (u16*)(p.ws + WS_WQ) + (size_t)l * 2048 * DM, DM, 0, p.norm_ffn + l * DM, 0)
  SEG(p.w_out + (size_t)l * DM * DM, DM, 0, DM, (u16*)(p.ws + WS_WOUT) + (size_t)l * DM * DM, DM, 0, p.grp_norm + l * DM, 0)
  SEG(p.w_uq + (size_t)l * 256 * 576, 576, 0, 576, (u16*)(p.ws + WS_WUQ) + (size_t)l * 768 * 256, 256, 0, p.q_norm + l * 256, -1)
  SEG(p.w_ukv + (size_t)l * 128 * 768, 768, 0, 768, (u16*)(p.ws + WS_WUKV) + (size_t)l * 768 * 128, 128, 0, p.kv_norm + l * 128, 0)
#undef SEG
  { const int nbk = r & 1, ax = (r >> 1) & 1, n = (r >> 2) % 6, d = (r >> 2) / 6;
    const float* W = (ax ? p.lru_wx : p.lru_wa) + ((size_t)(l * 2 + d) * 6 + n) * 4096;
    u16* WT = (u16*)(p.ws + WS_WLRU) + ((size_t)((l * 6 + n) * 2 + d)) * 128 * 64;
    tconv_item(W, 64, 0, WT, 64, 32 * nbk + 32 * ax, nullptr, scr, 0, nbk, lane); }
}

DEVI void phase0(const Params& p, int vb, int nb, char* lds) {
  const int tid = tidx(), lane = tid & 63, wid = tid >> 6;
  float* scr = (float*)(lds + wid * 16384);
  const int gw = vb * 8 + wid, ngw = nb * 8;
  for (int it = gw; it < DEPTH * 2552; it += ngw) p0_item(p, it, scr, lane);
  for (int i = vb * NTHREADS + tid; i < DEPTH * 96 * DM / 8; i += nb * NTHREADS) { const int l = i / (96 * DM / 8), r = i % (96 * DM / 8);
    *(u32x4*)((u16*)(p.ws + WS_WIN) + ((size_t)l * INWP + INW) * DM + (size_t)r * 8) = (u32x4){0, 0, 0, 0}; }
  for (int i = vb * NTHREADS + tid; i < DEPTH * 192 * 256 / 8; i += nb * NTHREADS) { const int l = i / (192 * 256 / 8), r = i % (192 * 256 / 8);
    *(u32x4*)((u16*)(p.ws + WS_WUQ) + ((size_t)l * 768 + 576) * 256 + (size_t)r * 8) = (u32x4){0, 0, 0, 0}; }
  for (int i = vb * NTHREADS + tid; i < DEPTH * 2 * 128 * 128 / 8; i += nb * NTHREADS) {
    float a[8]; ld8(p.peer_subkeys + (size_t)i * 8, a);
    *(u32x4*)((u16*)(p.ws + WS_SUBK) + (size_t)i * 8) = pk8(a); }
  { float* ssq = (float*)(p.ws + WS_SSQ); u16* xg = (u16*)(p.ws + WS_XG);
    for (int t = gw * 2; t < T; t += ngw * 2) {
      float a[2][16];
#pragma unroll
      for (int u = 0; u < 2; ++u) { ld8(p.x + (size_t)(t + u) * DM + lane * 16, a[u]); ld8(p.x + (size_t)(t + u) * DM + lane * 16 + 8, a[u] + 8); }
#pragma unroll
      for (int u = 0; u < 2; ++u) { float s = 0.f;
#pragma unroll
        for (int q = 0; q < 16; ++q) s = fmaf(a[u][q], a[u][q], s);
        s += __shfl_xor(s, 1); s += __shfl_xor(s, 2); s += __shfl_xor(s, 4);
        if ((lane & 7) == 0) ssq[(size_t)(t + u) * 8 + (lane >> 3)] = s;
        u32x4* o = (u32x4*)(xg + (size_t)(t + u) * DM + lane * 16); o[0] = pk8(a[u]); o[1] = pk8(a[u] + 8); } } }
}

DEVI int swz(int row, int c) { return row * 128 + ((c ^ ((row >> 1) & 7)) << 4); }
constexpr int CLD = 132;
constexpr int LDS_RS = 135168;

struct GemmDesc {
  const u16* A; int lda; const u16* Bt; int ldb; int KT;
  float inv0;
  const u16* proj; const float* cw; const float* cb; int ch0;
};

template <int AMODE> DEVI bf16x8 load_a(const GemmDesc& g, int row, int kcol) {
  if constexpr (AMODE == 0) {
    return *(const bf16x8*)(g.A + (size_t)row * g.lda + kcol);
  } else {
    const int s = row & (SEQ - 1), ch = g.ch0 + kcol;
    float a[8];
    { const f32x4 b0 = *(const f32x4*)(g.cb + ch), b1 = *(const f32x4*)(g.cb + ch + 4); a[0] = b0.x; a[1] = b0.y; a[2] = b0.z; a[3] = b0.w; a[4] = b1.x; a[5] = b1.y; a[6] = b1.z; a[7] = b1.w; }
#pragma unroll
    for (int tap = 0; tap < 4; ++tap) {
      const int ss = s - 1 + tap;
      if (ss >= 0 && ss < SEQ) {
        const u32x4 v = *(const u32x4*)(g.proj + (size_t)(row - 1 + tap) * INWP + PC_LX + ch);
        float x[8]; unpk8(v, x);
        const f32x4 w0 = *(const f32x4*)(g.cw + tap * LRU_W + ch), w1 = *(const f32x4*)(g.cw + tap * LRU_W + ch + 4);
        a[0] += w0.x * x[0]; a[1] += w0.y * x[1]; a[2] += w0.z * x[2]; a[3] += w0.w * x[3];
        a[4] += w1.x * x[4]; a[5] += w1.y * x[5]; a[6] += w1.z * x[6]; a[7] += w1.w * x[7];
      }
    }
    const u32x4 o = pk8(a);
    return __builtin_bit_cast(bf16x8, o);
  }
}

template <int AMODE> DEVI void g_load(const GemmDesc& g, bf16x8 (&ar)[4], bf16x8 (&br)[2], int m0, int n0, int srow, int sc, int kt) {
#pragma unroll
  for (int i = 0; i < 4; ++i) ar[i] = load_a<AMODE>(g, m0 + srow + 64 * i, kt * 64 + sc * 8);
#pragma unroll
  for (int i = 0; i < 2; ++i) br[i] = *(const bf16x8*)(g.Bt + (size_t)(n0 + srow + 64 * i) * g.ldb + kt * 64 + sc * 8);
}
template <bool NORM> DEVI void g_write(char* Ab, const bf16x8 (&ar)[4], const bf16x8 (&br)[2], float (&ssq)[4], int srow, int sc) {
  char* Bb = Ab + 32768;
#pragma unroll
  for (int i = 0; i < 4; ++i) { *(bf16x8*)(Ab + swz(srow + 64 * i, sc)) = ar[i];
    if (NORM) { float x[8]; unpk8(__builtin_bit_cast(u32x4, ar[i]), x); float s = ssq[i];
#pragma unroll
      for (int q = 0; q < 8; ++q) s = fmaf(x[q], x[q], s);
      ssq[i] = s; } }
#pragma unroll
  for (int i = 0; i < 2; ++i) *(bf16x8*)(Bb + swz(srow + 64 * i, sc)) = br[i];
}

template <int AMODE, int SEG>
DEVI void gemm_core(const GemmDesc& g, int m0, int n0, char* lds) {
  const int tid = tidx(), lane = tid & 63, wid = tid >> 6;
  const int wm = wid >> 1, wn = wid & 1, r32 = lane & 31, hi = lane >> 5;
  const int srow = tid >> 3, sc = tid & 7;
  constexpr bool NORM = SEG != 0;
  float* rs = (float*)(lds + LDS_RS);
  f32x16 acc[2][2], acc2[2][2];
#pragma unroll
  for (int i = 0; i < 2; ++i)
#pragma unroll
    for (int j = 0; j < 2; ++j) { acc[i][j] = f32x16{}; acc2[i][j] = f32x16{}; }
  float ssq[4] = {0.f, 0.f, 0.f, 0.f};
  bf16x8 ar[4], br[2];
  g_load<AMODE>(g, ar, br, m0, n0, srow, sc, 0); g_write<NORM>(lds, ar, br, ssq, srow, sc); __syncthreads();
  int seg = 0;
#pragma unroll 1
  for (int kt = 0; kt < g.KT; ++kt) {
    const int cur = kt & 1;
    if (kt + 1 < g.KT) g_load<AMODE>(g, ar, br, m0, n0, srow, sc, kt + 1);
    { const char* Ab = lds + cur * 49152; const char* Bb = Ab + 32768;
#pragma unroll
      for (int k16 = 0; k16 < 4; ++k16) {
        bf16x8 a[2], b[2];
#pragma unroll
        for (int mt = 0; mt < 2; ++mt) a[mt] = *(const bf16x8*)(Ab + swz(wm * 64 + mt * 32 + r32, k16 * 2 + hi));
#pragma unroll
        for (int nt = 0; nt < 2; ++nt) b[nt] = *(const bf16x8*)(Bb + swz(wn * 64 + nt * 32 + r32, k16 * 2 + hi));
#pragma unroll
        for (int mt = 0; mt < 2; ++mt)
#pragma unroll
          for (int nt = 0; nt < 2; ++nt) {
            if (NORM) acc2[mt][nt] = __builtin_amdgcn_mfma_f32_32x32x16_bf16(a[mt], b[nt], acc2[mt][nt], 0, 0, 0);
            else acc[mt][nt] = __builtin_amdgcn_mfma_f32_32x32x16_bf16(a[mt], b[nt], acc[mt][nt], 0, 0, 0);
          }
      } }
    if (NORM) {
      int se; float inv;
      if (SEG == 1) { se = g.KT; inv = g.inv0; }
      else { se = seg == 0 ? 6 : (seg == 1 ? 12 : 16); inv = seg == 2 ? (1.f / 256.f) : (1.f / 384.f); }
      if (kt + 1 == se) {
#pragma unroll
        for (int i = 0; i < 4; ++i) { float s = ssq[i]; s += __shfl_xor(s, 1); s += __shfl_xor(s, 2); s += __shfl_xor(s, 4); if (sc == 0) rs[srow + 64 * i] = rsqrtf(s * inv + EPS); }
        __syncthreads();
#pragma unroll
        for (int mt = 0; mt < 2; ++mt)
#pragma unroll
          for (int r = 0; r < 16; ++r) { const float f = rs[wm * 64 + mt * 32 + crow(r, hi)];
#pragma unroll
            for (int nt = 0; nt < 2; ++nt) { acc[mt][nt][r] = fmaf(f, acc2[mt][nt][r], acc[mt][nt][r]); acc2[mt][nt][r] = 0.f; } }
        ssq[0] = ssq[1] = ssq[2] = ssq[3] = 0.f;
        ++seg;
      }
    }
    if (kt + 1 < g.KT) g_write<NORM>(lds + (cur ^ 1) * 49152, ar, br, ssq, srow, sc);
    __syncthreads();
  }
  float* C = (float*)lds;
#pragma unroll
  for (int mt = 0; mt < 2; ++mt)
#pragma unroll
    for (int nt = 0; nt < 2; ++nt)
#pragma unroll
      for (int r = 0; r < 16; ++r) C[(wm * 64 + mt * 32 + crow(r, hi)) * CLD + wn * 64 + nt * 32 + r32] = acc[mt][nt][r];
  __syncthreads();
}
template <int AMODE, int SEG, class Epi>
DEVI void gemm_tile(const GemmDesc& g, int m0, int n0, char* lds, const Epi& epi) {
  gemm_core<AMODE, SEG>(g, m0, n0, lds);
  epi((const float*)lds, m0, n0);
  __syncthreads();
}

DEVI GemmDesc gemm_desc(const u16* A, int lda, const u16* Bt, int ldb, int K) {
  GemmDesc g{}; g.A = A; g.lda = lda; g.Bt = Bt; g.ldb = ldb; g.KT = K / 64; g.inv0 = 1.f / (float)K; return g;
}


template <int HW> DEVI void rope8(float* v, const float* pp, int i0, float posf) {
  const bool first = i0 < HW; const int f0 = i0 & (HW - 1);
#pragma unroll
  for (int j = 0; j < 8; ++j) { float sn, cs; rope_sc(posf, HW == 32 ? (f0 + j) : 2 * (f0 + j), sn, cs); const float pv = pp[j]; v[j] = first ? v[j] * cs - pv * sn : v[j] * cs + pv * sn; }
}

struct EpiP1 { u16* proj; const int* pos;
  DEVI void operator()(const float* C, int m0, int n0) const {
    const int tid = tidx();
#pragma unroll 1
    for (int it = 0; it < 8; ++it) { const int item = it * NTHREADS + tid, row = item >> 4, c8 = (item & 15) * 8, gcol = n0 + c8, grow = m0 + row;
      float v[8]; ld8(C + row * CLD + c8, v);
      const bool r64 = gcol >= PC_SQ && gcol < PC_SV, r32g = gcol >= PC_KR && gcol < PC_KR + 32;
      if (r64) { const int i0 = gcol & 63; float pp[8]; ld8(C + row * CLD + c8 + (i0 < 32 ? 32 : -32), pp); rope8<32>(v, pp, i0, (float)pos[grow]); }
      else if (r32g) { const int i0 = gcol & 31; float pp[8]; ld8(C + row * CLD + c8 + (i0 < 16 ? 16 : -16), pp); rope8<16>(v, pp, i0, (float)pos[grow]); }
      *(u32x4*)(proj + (size_t)grow * INWP + gcol) = pk8(v);
    }
  }
};

struct EpiQ { u16* qm; const int* pos;
  DEVI void operator()(const float* C, int m0, int n0) const {
    const int tid = tidx();
#pragma unroll 1
    for (int it = 0; it < 8; ++it) { const int item = it * NTHREADS + tid, row = item >> 4, c8 = (item & 15) * 8, gcol = n0 + c8, grow = m0 + row;
      if (gcol >= 576) continue;
      const int head = gcol / 96, j0 = gcol - head * 96, b = grow >> 13, s = grow & (SEQ - 1);
      float v[8]; ld8(C + row * CLD + c8, v);
      u16* qrow = qm + ((size_t)(b * MLA_H + head) * SEQ + s) * MLA_QK;
      if (j0 >= 64) { const int i0 = j0 - 64; float pp[8]; ld8(C + row * CLD + c8 + (i0 < 16 ? 16 : -16), pp); rope8<16>(v, pp, i0, (float)pos[grow]);
#pragma unroll
        for (int j = 0; j < 8; ++j) { const int i = i0 + j; qrow[64 + (i < 16 ? 2 * i : 2 * (i - 16) + 1)] = f2bf(v[j]); } }
      else *(u32x4*)(qrow + j0) = pk8(v);
    }
  }
};

struct EpiKV { u16* km; u16* vm; const u16* proj;
  DEVI void operator()(const float* C, int m0, int n0) const {
    const int tid = tidx(), head = n0 >> 7;
#pragma unroll 1
    for (int it = 0; it < 8; ++it) { const int item = it * NTHREADS + tid, row = item >> 4, c8 = (item & 15) * 8, grow = m0 + row;
      const int b = grow >> 13, s = grow & (SEQ - 1);
      float v[8]; ld8(C + row * CLD + c8, v);
      const size_t tok = (size_t)(b * MLA_H + head) * SEQ + s;
      if (c8 < 64) *(u32x4*)(km + tok * MLA_QK + c8) = pk8(v);
      else *(u32x4*)(vm + tok * MLA_V + (c8 - 64)) = pk8(v);
    }
#pragma unroll 1
    for (int it = 0; it < 2; ++it) { const int item = it * NTHREADS + tid, row = item >> 2, c = (item & 3) * 8, grow = m0 + row;
      const int b = grow >> 13, s = grow & (SEQ - 1);
      *(u32x4*)(km + ((size_t)(b * MLA_H + head) * SEQ + s) * MLA_QK + 64 + c) = *(const u32x4*)(proj + (size_t)grow * INWP + PC_KR + c);
    }
  }
};

struct EpiLRU { const u16* proj; const float* cw; const float* cb; const float* ba; const float* bx; const float* lam; u16* le; u16* lb; int n, d;
  DEVI void operator()(const float* C, int m0, int) const {
    const int tid = tidx();
#pragma unroll 1
    for (int it = 0; it < 4; ++it) { const int item = it * NTHREADS + tid, j = item & 63, g8 = item >> 6;
      const int ch = n * 64 + j, grow0 = m0 + g8 * 8, s0 = grow0 & (SEQ - 1), b = grow0 >> 13;
      const float bav = ba[(d * 6 + n) * 64 + j], bxv = bx[(d * 6 + n) * 64 + j];
      const float cdec = -8.f * log1pf(__expf(-lam[d * LRU_W + ch]));
      float xin[11];
#pragma unroll
      for (int q = 0; q < 11; ++q) { const int ss = s0 - 1 + q; xin[q] = (ss >= 0 && ss < SEQ) ? bf2f(proj[(size_t)(grow0 - 1 + q) * INWP + PC_LX + ch]) : 0.f; }
      const float w0 = cw[ch], w1 = cw[LRU_W + ch], w2 = cw[2 * LRU_W + ch], w3 = cw[3 * LRU_W + ch], cbv = cb[ch];
      float ev[8], bv[8];
#pragma unroll
      for (int rr = 0; rr < 8; ++rr) {
        const float xf = cbv + w0 * xin[rr] + w1 * xin[rr + 1] + w2 * xin[rr + 2] + w3 * xin[rr + 3];
        const float r = sigmoidf_(C[(g8 * 8 + rr) * CLD + j] + bav), ig = sigmoidf_(C[(g8 * 8 + rr) * CLD + 64 + j] + bxv);
        const float a = __expf(cdec * r), e = 1.f - a;
        ev[rr] = e; bv[rr] = sqrtf(e * (2.f - e)) * ig * xf;
      }
      const size_t o = (((size_t)(d * NB + b) * (SEQ / 8) + (s0 >> 3)) * LRU_W + ch) * 8;
      *(u32x4*)(le + o) = pk8(ev); *(u32x4*)(lb + o) = pk8(bv);
    }
  }
};

struct EpiP4 { const float* xres; float* xout; u16* xg;
  DEVI void operator()(const float* C, int m0, int n0) const {
    const int tid = tidx();
#pragma unroll 1
    for (int it = 0; it < 8; ++it) { const int item = it * NTHREADS + tid, row = item >> 4, c8 = (item & 15) * 8, gcol = n0 + c8, grow = m0 + row;
      float v[8], x[8]; ld8(C + row * CLD + c8, v); ld8(xres + (size_t)grow * DM + gcol, x);
#pragma unroll
      for (int j = 0; j < 8; ++j) v[j] += x[j];
      *(f32x4*)(xout + (size_t)grow * DM + gcol) = (f32x4){v[0], v[1], v[2], v[3]}; *(f32x4*)(xout + (size_t)grow * DM + gcol + 4) = (f32x4){v[4], v[5], v[6], v[7]};
      *(u32x4*)(xg + (size_t)grow * DM + gcol) = pk8(v);
    }
  }
};

struct EpiBf16 { u16* o; int ldo;
  DEVI void operator()(const float* C, int m0, int n0) const {
    const int tid = tidx();
#pragma unroll 1
    for (int it = 0; it < 8; ++it) { const int item = it * NTHREADS + tid, row = item >> 4, c8 = (item & 15) * 8;
      float v[8]; ld8(C + row * CLD + c8, v);
      *(u32x4*)(o + (size_t)(m0 + row) * ldo + n0 + c8) = pk8(v);
    }
  }
};

DEVI void ce_desc(float& a, float& b) { const float mx = fmaxf(a, b), mn = fminf(a, b); a = mx; b = mn; }
struct EpiTop { float* top; int hj;
  DEVI void operator()(const float* C, int m0, int) const {
    const int tid = tidx(), row = tid >> 1, part = tid & 1;
    float l[16];
#pragma unroll
    for (int i = 0; i < 16; ++i) l[i] = -3.0e38f;
#pragma unroll 4
    for (int c = 0; c < 64; ++c) { const int col = part * 64 + ((c + row) & 63);
      float v = __uint_as_float((__float_as_uint(C[row * CLD + col]) & ~127u) | (unsigned)(127 - col));
#pragma unroll
      for (int i = 0; i < 16; ++i) { const float t = fmaxf(l[i], v); v = fminf(l[i], v); l[i] = t; } }
    float m[16];
#pragma unroll
    for (int i = 0; i < 16; ++i) m[i] = __shfl_xor(l[15 - i], 1);
#pragma unroll
    for (int i = 0; i < 16; ++i) m[i] = fmaxf(m[i], l[i]);
#pragma unroll
    for (int st = 8; st >= 1; st >>= 1)
#pragma unroll
      for (int i = 0; i < 16; ++i) if ((i & st) == 0) ce_desc(m[i], m[i + st]);
    if (part == 0) { float* o = top + ((size_t)(m0 + row) * 16 + hj) * 16;
#pragma unroll
      for (int i = 0; i < 4; ++i) *(f32x4*)(o + 4 * i) = (f32x4){m[4 * i], m[4 * i + 1], m[4 * i + 2], m[4 * i + 3]}; }
  }
};

#define KSWZ(row, colB) ((row) * 256 + ((colB) ^ (((row) & 15) << 4)))
#define SBAR() __builtin_amdgcn_sched_barrier(0)
constexpr int AT_SHM_V = 64 * 64 * 2, AT_SHM_K = 64 * 128 * 2;
constexpr int AT_LDS = 3 * AT_SHM_V + 2 * AT_SHM_K + 8 * 64 * 4;
constexpr float ATT_THR = 8.f;
DEVI unsigned cvtpk(float lo, float hi) { unsigned r; asm volatile("v_cvt_pk_bf16_f32 %0, %1, %2" : "=v"(r) : "v"(lo), "v"(hi)); return r; }
DEVI int v_st(int k, int c) { const int kk = (k & ~0xC) | ((k & 4) << 1) | ((k & 8) >> 1); return ((kk >> 3) * 2 + (c >> 5)) * 512 + ((kk & 7) * 32 + (c & 31)) * 2; }
DEVI int v_rd_base(int lane) { return ((lane & 3) << 3) | (((lane >> 2) & 3) << 6) | (((lane >> 4) & 1) << 5) | (((lane >> 5) & 1) << 8); }
constexpr int v_rd_off(int d0, int ks, int half) { return d0 * 512 + ks * 2048 + half * 1024; }
template <int OFF> DEVI s16x4 tr_read(int vb) { s16x4 r; asm volatile("ds_read_b64_tr_b16 %0, %1 offset:%2" : "=&v"(r) : "v"(vb), "i"(OFF) : "memory"); return r; }

template <bool MASK, bool FIRST>
DEVI void partialSM(f32x16& p0, f32x16& p1, float& m_reg, float& mn, float& alpha, float SCALE, int kpos0, int qpos, int hi) {
  const float C = SCALE * 1.4426950408889634f;
  if (MASK) {
#pragma unroll
    for (int r = 0; r < 16; ++r) { const int k0 = kpos0 + crow(r, hi) - qpos; const int k1 = k0 + 32;
      if (k0 > 128 || k0 < -128) p0[r] = -1e30f;
      if (k1 > 128 || k1 < -128) p1[r] = -1e30f; }
  }
  if (FIRST) {
    float pmax = p0[0];
#pragma unroll
    for (int r = 1; r < 16; ++r) pmax = fmaxf(pmax, p0[r]);
#pragma unroll
    for (int r = 0; r < 16; ++r) pmax = fmaxf(pmax, p1[r]);
    { auto rr = __builtin_amdgcn_permlane32_swap(__float_as_uint(pmax), __float_as_uint(pmax), false, false);
      pmax = fmaxf(__uint_as_float(rr[0]), __uint_as_float(rr[1])); }
    if (__builtin_expect(__all(pmax - m_reg <= ATT_THR / SCALE), 1)) { mn = m_reg; alpha = 1.f; }
    else { mn = fmaxf(m_reg, pmax); alpha = __builtin_amdgcn_exp2f((m_reg - mn) * C); m_reg = mn; }
    const float mnC = -mn * C;
#pragma unroll
    for (int r = 0; r < 16; ++r) p0[r] = fmaf(p0[r], C, mnC);
#pragma unroll
    for (int r = 0; r < 16; ++r) p1[r] = fmaf(p1[r], C, mnC);
#pragma unroll
    for (int r = 0; r < 16; ++r) p0[r] = __builtin_amdgcn_exp2f(p0[r]);
    return;
  }
  const float mC = -m_reg * C;
#pragma unroll
  for (int r = 0; r < 16; ++r) p0[r] = fmaf(p0[r], C, mC);
#pragma unroll
  for (int r = 0; r < 16; ++r) p1[r] = fmaf(p1[r], C, mC);
  float tmax = p0[0];
#pragma unroll
  for (int r = 1; r < 16; ++r) tmax = fmaxf(tmax, p0[r]);
#pragma unroll
  for (int r = 0; r < 16; ++r) tmax = fmaxf(tmax, p1[r]);
#pragma unroll
  for (int r = 0; r < 16; ++r) p0[r] = __builtin_amdgcn_exp2f(p0[r]);
  { auto rr = __builtin_amdgcn_permlane32_swap(__float_as_uint(tmax), __float_as_uint(tmax), false, false);
    tmax = fmaxf(__uint_as_float(rr[0]), __uint_as_float(rr[1])); }
  mn = m_reg; alpha = 1.f;
  if (__builtin_expect(!__all(tmax <= ATT_THR * 1.4426950408889634f), 0)) {
    const float sh = fmaxf(tmax, 0.f);
    alpha = __builtin_amdgcn_exp2f(-sh); m_reg = m_reg + sh / C; mn = m_reg;
#pragma unroll
    for (int r = 0; r < 16; ++r) { p0[r] *= alpha; p1[r] -= sh; }
  }
}
DEVI void finishSM(f32x16& p0, f32x16& p1, float alpha, float& l_reg, bf16x8& pa0, bf16x8& pa1, bf16x8& pa2, bf16x8& pa3) {
#pragma unroll
  for (int r = 0; r < 16; ++r) p1[r] = __builtin_amdgcn_exp2f(p1[r]);
  float ps = 0;
#pragma unroll
  for (int r = 0; r < 16; ++r) ps += p0[r];
#pragma unroll
  for (int r = 0; r < 16; ++r) ps += p1[r];
  { auto rr = __builtin_amdgcn_permlane32_swap(__float_as_uint(ps), __float_as_uint(ps), false, false);
    ps = __uint_as_float(rr[0]) + __uint_as_float(rr[1]); }
  l_reg = l_reg * alpha + ps;
#define PK4(P, BASE, OUT) do { unsigned a0 = cvtpk(P[BASE + 0], P[BASE + 1]), a1 = cvtpk(P[BASE + 2], P[BASE + 3]);   \
    unsigned b0 = cvtpk(P[BASE + 4], P[BASE + 5]), b1 = cvtpk(P[BASE + 6], P[BASE + 7]);                              \
    auto r0 = __builtin_amdgcn_permlane32_swap(a0, b0, false, false); auto r1 = __builtin_amdgcn_permlane32_swap(a1, b1, false, false); \
    u32x4 w = {r0[0], r1[0], r0[1], r1[1]}; OUT = __builtin_bit_cast(bf16x8, w); } while (0)
  PK4(p0, 0, pa0); PK4(p0, 8, pa1); PK4(p1, 0, pa2); PK4(p1, 8, pa3);
#undef PK4
}
template <int ND0>
DEVI void qkt(f32x16& p0, f32x16& p1, const char* Ks, const bf16x8* qr, int r32, int hi) {
  bf16x8 k0[ND0], k1[ND0];
#pragma unroll
  for (int d0 = 0; d0 < ND0; ++d0) { const int cb = (d0 * 16 + hi * 8) * 2;
    k0[d0] = *(const bf16x8*)(Ks + KSWZ(r32, cb)); k1[d0] = *(const bf16x8*)(Ks + KSWZ(32 + r32, cb)); }
  p0 = f32x16{}; p1 = f32x16{};
#pragma unroll
  for (int d0 = 0; d0 < ND0; ++d0) {
    p0 = __builtin_amdgcn_mfma_f32_32x32x16_bf16(k0[d0], qr[d0], p0, 0, 0, 0);
    p1 = __builtin_amdgcn_mfma_f32_32x32x16_bf16(k1[d0], qr[d0], p1, 0, 0, 0); }
}
template <int D0> DEVI void pv_one(f32x16& od, int vb, bf16x8 pa0, bf16x8 pa1, bf16x8 pa2, bf16x8 pa3) {
  const s16x4 l0 = tr_read<v_rd_off(D0, 0, 0)>(vb), h0 = tr_read<v_rd_off(D0, 0, 1)>(vb), l1 = tr_read<v_rd_off(D0, 1, 0)>(vb), h1 = tr_read<v_rd_off(D0, 1, 1)>(vb);
  const s16x4 l2 = tr_read<v_rd_off(D0, 2, 0)>(vb), h2 = tr_read<v_rd_off(D0, 2, 1)>(vb), l3 = tr_read<v_rd_off(D0, 3, 0)>(vb), h3 = tr_read<v_rd_off(D0, 3, 1)>(vb);
  asm volatile("s_waitcnt lgkmcnt(0)" ::: "memory"); SBAR();
#define PK(L, H) (bf16x8){L[0], L[1], L[2], L[3], H[0], H[1], H[2], H[3]}
  od = __builtin_amdgcn_mfma_f32_32x32x16_bf16(pa0, PK(l0, h0), od, 0, 0, 0);
  od = __builtin_amdgcn_mfma_f32_32x32x16_bf16(pa1, PK(l1, h1), od, 0, 0, 0);
  od = __builtin_amdgcn_mfma_f32_32x32x16_bf16(pa2, PK(l2, h2), od, 0, 0, 0);
  od = __builtin_amdgcn_mfma_f32_32x32x16_bf16(pa3, PK(l3, h3), od, 0, 0, 0);
#undef PK
}
DEVI void pv_d0(f32x16* o, int vb, bf16x8 pa0, bf16x8 pa1, bf16x8 pa2, bf16x8 pa3) {
  const s16x4 a0 = tr_read<v_rd_off(0, 0, 0)>(vb), b0 = tr_read<v_rd_off(0, 0, 1)>(vb), a1 = tr_read<v_rd_off(0, 1, 0)>(vb), b1 = tr_read<v_rd_off(0, 1, 1)>(vb);
  const s16x4 a2 = tr_read<v_rd_off(0, 2, 0)>(vb), b2 = tr_read<v_rd_off(0, 2, 1)>(vb), a3 = tr_read<v_rd_off(0, 3, 0)>(vb), b3 = tr_read<v_rd_off(0, 3, 1)>(vb);
  const s16x4 c0 = tr_read<v_rd_off(1, 0, 0)>(vb), d0 = tr_read<v_rd_off(1, 0, 1)>(vb), c1 = tr_read<v_rd_off(1, 1, 0)>(vb), d1 = tr_read<v_rd_off(1, 1, 1)>(vb);
  const s16x4 c2 = tr_read<v_rd_off(1, 2, 0)>(vb), d2 = tr_read<v_rd_off(1, 2, 1)>(vb), c3 = tr_read<v_rd_off(1, 3, 0)>(vb), d3 = tr_read<v_rd_off(1, 3, 1)>(vb);
  asm volatile("s_waitcnt lgkmcnt(0)" ::: "memory"); SBAR();
#define PK(L, H) (bf16x8){L[0], L[1], L[2], L[3], H[0], H[1], H[2], H[3]}
  o[0] = __builtin_amdgcn_mfma_f32_32x32x16_bf16(pa0, PK(a0, b0), o[0], 0, 0, 0);
  o[1] = __builtin_amdgcn_mfma_f32_32x32x16_bf16(pa0, PK(c0, d0), o[1], 0, 0, 0);
  o[0] = __builtin_amdgcn_mfma_f32_32x32x16_bf16(pa1, PK(a1, b1), o[0], 0, 0, 0);
  o[1] = __builtin_amdgcn_mfma_f32_32x32x16_bf16(pa1, PK(c1, d1), o[1], 0, 0, 0);
  o[0] = __builtin_amdgcn_mfma_f32_32x32x16_bf16(pa2, PK(a2, b2), o[0], 0, 0, 0);
  o[1] = __builtin_amdgcn_mfma_f32_32x32x16_bf16(pa2, PK(c2, d2), o[1], 0, 0, 0);
  o[0] = __builtin_amdgcn_mfma_f32_32x32x16_bf16(pa3, PK(a3, b3), o[0], 0, 0, 0);
  o[1] = __builtin_amdgcn_mfma_f32_32x32x16_bf16(pa3, PK(c3, d3), o[1], 0, 0, 0);
#undef PK
}

template <int DQK, bool MASK>
DEVI void attn_body(const u16* Qw, const u16* Kh, int ldk, const u16* Vh, int ldv, int kt0, int NT, float SCALE, float m_init, float l_init,
                    int qpos, u16* Ow, char* lds, float qrope_pos = 0.f) {
  constexpr int ND0 = DQK / 16, NCK = DQK / 8;
  const int tid = tidx(), wid = __builtin_amdgcn_readfirstlane(tid >> 6), lane = tid & 63, r32 = lane & 31, hi = lane >> 5;
  char* K_lds = lds; char* V_lds = lds + 2 * AT_SHM_K;
  float* wsx = (float*)(lds + 2 * AT_SHM_K + 3 * AT_SHM_V) + wid * 64; float* li_l = wsx; float* al_l = wsx + 32;
  float m_reg = m_init, l_reg = l_init; f32x16 o[2] = {f32x16{}, f32x16{}}; bf16x8 qr[ND0];
#pragma unroll
  for (int d0 = 0; d0 < ND0; ++d0) qr[d0] = *(const bf16x8*)(Qw + d0 * 16);
  if (DQK == 96) {
#pragma unroll
    for (int d0 = 4; d0 < ND0; ++d0) { float v[8]; unpk8(__builtin_bit_cast(u32x4, qr[d0]), v);
#pragma unroll
      for (int q = 0; q < 4; ++q) { const int f = 2 * ((((d0 - 4) * 16 + hi * 8) >> 1) + q); float sn, cs; rope_sc(qrope_pos, f, sn, cs);
        const float x1 = v[2 * q], x2 = v[2 * q + 1]; v[2 * q] = x1 * cs - x2 * sn; v[2 * q + 1] = x2 * cs + x1 * sn; }
      qr[d0] = __builtin_bit_cast(bf16x8, pk8(v)); } }
  unsigned koff[2], voff;
#pragma unroll
  for (int i = 0; i < 2; ++i) { const int row = 4 * (wid + 8 * i) + (lane >> 4), ch = (lane & 15) ^ (row & 15); koff[i] = (unsigned)(row * ldk * 2 + (ch < NCK ? ch : 0) * 16); }
  { const int off = wid * 1024 + lane * 16, sub = off >> 9, kk = ((sub >> 1) << 3) | ((off & 511) >> 6), c = ((sub & 1) << 5) | ((off & 63) >> 1);
    const int k = (kk & ~0xC) | ((kk & 4) << 1) | ((kk & 8) >> 1); voff = (unsigned)(k * ldv * 2 + c * 2); }
  typedef __attribute__((address_space(3))) unsigned lds_u32;
#define DMA(tt_) do { const char* kb_ = (const char*)Kh + (size_t)(kt0 + (tt_)) * 64 * ldk * 2; const char* vb_ = (const char*)Vh + (size_t)(kt0 + (tt_)) * 64 * ldv * 2; \
    char* kd_ = K_lds + ((tt_) & 1) * AT_SHM_K + wid * 1024; char* vd_ = V_lds + ((tt_) % 3) * AT_SHM_V + wid * 1024; \
    __builtin_amdgcn_global_load_lds((const unsigned*)(kb_ + koff[0]), (lds_u32*)kd_, 16, 0, 0); \
    __builtin_amdgcn_global_load_lds((const unsigned*)(kb_ + koff[1]), (lds_u32*)(kd_ + 8192), 16, 0, 0); \
    __builtin_amdgcn_global_load_lds((const unsigned*)(vb_ + voff), (lds_u32*)vd_, 16, 0, 0); } while (0)
#define LANDED() do { asm volatile("s_waitcnt vmcnt(0)" ::: "memory"); __syncthreads(); } while (0)
#define RESC(a) do { if (__any((a) < 1.f)) { if (hi == 0) al_l[r32] = (a); asm volatile("s_waitcnt lgkmcnt(0)" ::: "memory"); \
    _Pragma("unroll") for (int d = 0; d < 2; ++d) _Pragma("unroll") for (int r = 0; r < 16; ++r) o[d][r] *= al_l[crow(r, hi)]; } } while (0)
  const int vb0 = (int)(uintptr_t)V_lds + v_rd_base(lane);
  f32x16 pA0, pA1, pB0, pB1; float mnA, mnB, alA, alB; bf16x8 pa0, pa1, pa2, pa3;
  DMA(0); LANDED();
  DMA(1);
  qkt<ND0>(pA0, pA1, K_lds, qr, r32, hi); partialSM<MASK, true>(pA0, pA1, m_reg, mnA, alA, SCALE, kt0 * 64, qpos, hi);
  LANDED();
  int vprev = 0;
  for (int tt = 1; tt + 1 < NT; tt += 2) {
    const int v1 = vprev == 2 ? 0 : vprev + 1;
    DMA(tt + 1); SBAR();
    qkt<ND0>(pB0, pB1, K_lds + AT_SHM_K, qr, r32, hi);
    finishSM(pA0, pA1, alA, l_reg, pa0, pa1, pa2, pa3); SBAR();
    pv_d0(o, vb0 + vprev * AT_SHM_V, pa0, pa1, pa2, pa3); partialSM<MASK, false>(pB0, pB1, m_reg, mnB, alB, SCALE, (kt0 + tt) * 64, qpos, hi);
    RESC(alB); LANDED();
    if (tt + 2 < NT) DMA(tt + 2);
    SBAR();
    qkt<ND0>(pA0, pA1, K_lds, qr, r32, hi);
    finishSM(pB0, pB1, alB, l_reg, pa0, pa1, pa2, pa3); SBAR();
    pv_d0(o, vb0 + v1 * AT_SHM_V, pa0, pa1, pa2, pa3); partialSM<MASK, false>(pA0, pA1, m_reg, mnA, alA, SCALE, (kt0 + tt + 1) * 64, qpos, hi);
    RESC(alA); LANDED();
    vprev = v1 == 2 ? 0 : v1 + 1;
  }
  { const int v1 = vprev == 2 ? 0 : vprev + 1;
    SBAR(); qkt<ND0>(pB0, pB1, K_lds + AT_SHM_K, qr, r32, hi);
    finishSM(pA0, pA1, alA, l_reg, pa0, pa1, pa2, pa3); SBAR();
    pv_d0(o, vb0 + vprev * AT_SHM_V, pa0, pa1, pa2, pa3); partialSM<MASK, false>(pB0, pB1, m_reg, mnB, alB, SCALE, (kt0 + NT - 1) * 64, qpos, hi);
    RESC(alB);
    finishSM(pB0, pB1, alB, l_reg, pa0, pa1, pa2, pa3); SBAR();
    pv_d0(o, vb0 + v1 * AT_SHM_V, pa0, pa1, pa2, pa3); }
  if (hi == 0) li_l[r32] = l_reg; asm volatile("s_waitcnt lgkmcnt(0)" ::: "memory");
  float rli[16];
#pragma unroll
  for (int r = 0; r < 16; ++r) rli[r] = __builtin_amdgcn_rcpf(li_l[crow(r, hi)]);
#pragma unroll
  for (int r = 0; r < 16; ++r) { const int orow = crow(r, hi);
#pragma unroll
    for (int d0 = 0; d0 < 2; ++d0) Ow[(size_t)orow * DM + d0 * 32 + r32] = f2bf(o[d0][r] * rli[r]); }
  __syncthreads();
#undef DMA
#undef LANDED
#undef RESC
}

constexpr int LCH = 64, NLCH = SEQ / LCH;
constexpr size_t WS_LP = 1 * MiB, WS_LH = 2560 * 1024;
constexpr size_t WS_LC = 473 * MiB;
constexpr size_t WS_NEED = 510 * MiB;
DEVI void lru_passA(const Params& p, int item, int lane) {
  const int cg = item % 6, c = (item / 6) % NLCH, b = (item / (6 * NLCH)) % NB, d = item / (6 * NLCH * NB);
  const size_t base = (((size_t)(d * NB + b) * (SEQ / 8) + c * 8) * LRU_W + cg * 64 + lane) * 8;
  const u16* E = (const u16*)(p.ws + WS_LE) + base; const u16* Bp = (const u16*)(p.ws + WS_LB) + base;
  u32x4 ev[8], bv[8];
#pragma unroll
  for (int g = 0; g < 8; ++g) { ev[g] = *(const u32x4*)(E + (size_t)g * LRU_W * 8); bv[g] = *(const u32x4*)(Bp + (size_t)g * LRU_W * 8); }
  float h = 0.f, P = 1.f;
#pragma unroll
  for (int gg = 0; gg < 8; ++gg) { const int g = d ? 7 - gg : gg; float e[8], bb[8]; unpk8(ev[g], e); unpk8(bv[g], bb);
#pragma unroll
    for (int rr = 0; rr < 8; ++rr) { const int r = d ? 7 - rr : rr; const float a = 1.f - e[r]; h = fmaf(a, h, bb[r]); P *= a; } }
  const size_t o = ((size_t)(d * NB + b) * NLCH + c) * LRU_W + cg * 64 + lane;
  ((float*)(p.ws + WS_LP))[o] = P; ((float*)(p.ws + WS_LH))[o] = h;
}

DEVI void lru_final(const Params& p, int item, char* lds) {
  const int tid = tidx(), wid = tid >> 6, lane = tid & 63;
  const int c = item % NLCH, b = item / NLCH;
  float* obuf = (float*)lds;
  if (wid < 6) {
    const int ch = wid * 64 + lane;
#pragma unroll
    for (int d = 0; d < 2; ++d) {
      const size_t co = ((size_t)(d * NB + b) * NLCH + c) * LRU_W + ch;
      float h = ((const float*)(p.ws + WS_LC))[co];
      const size_t base = (((size_t)(d * NB + b) * (SEQ / 8) + c * 8) * LRU_W + ch) * 8;
      const u16* E = (const u16*)(p.ws + WS_LE) + base; const u16* Bp = (const u16*)(p.ws + WS_LB) + base;
      u32x4 ev[8], bv[8];
#pragma unroll
      for (int g = 0; g < 8; ++g) { ev[g] = *(const u32x4*)(E + (size_t)g * LRU_W * 8); bv[g] = *(const u32x4*)(Bp + (size_t)g * LRU_W * 8); }
      if (d == 0) {
#pragma unroll
        for (int g = 0; g < 8; ++g) { float e[8], bb[8]; unpk8(ev[g], e); unpk8(bv[g], bb);
#pragma unroll
          for (int r = 0; r < 8; ++r) { h = fmaf(1.f - e[r], h, bb[r]); obuf[(g * 8 + r) * LRU_W + ch] = h; } }
      } else {
        const u16* gp = (const u16*)(p.ws + WS_R1) + ((size_t)b * SEQ + c * LCH) * INWP + PC_LG + ch;
#pragma unroll
        for (int g = 7; g >= 0; --g) { float e[8], bb[8]; unpk8(ev[g], e); unpk8(bv[g], bb);
#pragma unroll
          for (int r = 7; r >= 0; --r) { h = fmaf(1.f - e[r], h, bb[r]); const int tk = g * 8 + r;
            const float gt = bf2f(gp[(size_t)tk * INWP]); obuf[tk * LRU_W + ch] = (obuf[tk * LRU_W + ch] + h) * gelu_erf(gt); } }
      }
    }
  }
  __syncthreads();
  u16* mp = (u16*)(p.ws + WS_MIX) + ((size_t)b * SEQ + c * LCH) * DM + 384;
#pragma unroll 1
  for (int i = 0; i < 8; ++i) { const int tk = wid * 8 + i;
    float v[6]; float s = 0.f;
#pragma unroll
    for (int q = 0; q < 3; ++q) { const f32x2 t2 = *(const f32x2*)(obuf + tk * LRU_W + q * 128 + lane * 2); v[2 * q] = t2.x; v[2 * q + 1] = t2.y; s = fmaf(t2.x, t2.x, s); s = fmaf(t2.y, t2.y, s); }
    s = wave_sum(s);
    const float rs = rsqrtf(s * (1.f / 384.f) + EPS);
#pragma unroll
    for (int q = 0; q < 3; ++q) *(unsigned*)(mp + (size_t)tk * DM + q * 128 + lane * 2) = pk2(v[2 * q] * rs, v[2 * q + 1] * rs);
  }
  __syncthreads();
}

typedef unsigned char u8;
DEVI unsigned q8x4(const float* v, float s) {
  unsigned w = 0;
#pragma unroll
  for (int i = 0; i < 4; ++i) { int q = __float2int_rn(v[i] * s); q = q < -127 ? -127 : (q > 127 ? 127 : q); w |= ((unsigned)q & 255u) << (8 * i); }
  return w;
}
DEVI void peer_xn_pass(const Params& p, int layer, int vb, int nb) {
  const int tid = tidx(), wid = tid >> 6, lane = tid & 63; const u16* xg = (const u16*)(p.ws + WS_XG); const float* gf = p.norm_ffn + layer * DM;
  u8* xq = (u8*)(p.ws + WS_XQ); float* sxp = (float*)(p.ws + WS_SX);
  for (int t = vb * 8 + wid; t < T; t += nb * 8) {
    const u32x4* rp = (const u32x4*)(xg + (size_t)t * DM + lane * 16);
    float v[16]; unpk8(rp[0], v); unpk8(rp[1], v + 8);
    float s = 0.f;
#pragma unroll
    for (int i = 0; i < 16; ++i) s = fmaf(v[i], v[i], s);
    s = wave_sum(s);
    const float rs = rsqrtf(s * (1.f / DM) + EPS);
    float g[16]; ld8(gf + lane * 16, g); ld8(gf + lane * 16 + 8, g + 8);
    float mx = 0.f;
#pragma unroll
    for (int i = 0; i < 16; ++i) { v[i] *= rs * g[i]; mx = fmaxf(mx, fabsf(v[i])); }
#pragma unroll
    for (int o = 1; o < 64; o <<= 1) mx = fmaxf(mx, __shfl_xor(mx, o));
    const float sx = fmaxf(mx, 1e-20f) * (1.f / 127.f), isx = 1.f / sx;
    *(u32x4*)(xq + (size_t)t * DM + lane * 16) = (u32x4){q8x4(v, isx), q8x4(v + 4, isx), q8x4(v + 8, isx), q8x4(v + 12, isx)};
    if (lane == 0) sxp[t] = sx;
  }
}

DEVI void cvt16(u32x4 w, float* f) {
  f32x2 t;
  t = __builtin_amdgcn_cvt_pk_f32_fp8((int)w.x, false); f[0] = t.x; f[1] = t.y; t = __builtin_amdgcn_cvt_pk_f32_fp8((int)w.x, true); f[2] = t.x; f[3] = t.y;
  t = __builtin_amdgcn_cvt_pk_f32_fp8((int)w.y, false); f[4] = t.x; f[5] = t.y; t = __builtin_amdgcn_cvt_pk_f32_fp8((int)w.y, true); f[6] = t.x; f[7] = t.y;
  t = __builtin_amdgcn_cvt_pk_f32_fp8((int)w.z, false); f[8] = t.x; f[9] = t.y; t = __builtin_amdgcn_cvt_pk_f32_fp8((int)w.z, true); f[10] = t.x; f[11] = t.y;
  t = __builtin_amdgcn_cvt_pk_f32_fp8((int)w.w, false); f[12] = t.x; f[13] = t.y; t = __builtin_amdgcn_cvt_pk_f32_fp8((int)w.w, true); f[14] = t.x; f[15] = t.y;
}
DEVI unsigned enc4(float a, float b, float c, float d) { int w = 0; w = __builtin_amdgcn_cvt_pk_fp8_f32(a, b, w, false); w = __builtin_amdgcn_cvt_pk_fp8_f32(c, d, w, true); return (unsigned)w; }
#define EIDX_AT(i0, i1, i) ((((i) < 8 ? (i0) : (i1))[((i) & 7) >> 1] >> (((i) & 1) * 16)) & 0xffffu)
template <int CTRL> DEVI float dppf(float v) { return __uint_as_float((unsigned)__builtin_amdgcn_mov_dpp((int)__float_as_uint(v), CTRL, 0xF, 0xF, true)); }
DEVI f32x2 fma2(f32x2 a, f32x2 b, f32x2 c) { return __builtin_elementwise_fma(a, b, c); }
DEVI f32x2 cvt8lo(unsigned w) { return __builtin_amdgcn_cvt_pk_f32_fp8((int)w, false); }
DEVI f32x2 cvt8hi(unsigned w) { return __builtin_amdgcn_cvt_pk_f32_fp8((int)w, true); }
struct PeerIdx { u32x4 i0, i1; };
template <bool AXPY>
DEVI void peer_slice_phase(const Params& p, int s, int tbeg, int tstep, int lane, const float* xin, float* xout, bool last) {
  const int r = lane >> 3, j = lane & 7;
  const u8* eidxB = (const u8*)(p.ws + WS_EIDX); const unsigned eoff = (unsigned)r * 32u;
  const u8* TBs = (const u8*)(p.ws + (AXPY ? WS_VB : WS_UB)) + (size_t)s * NEXP * 128; const unsigned toff = 16u * (unsigned)j;
  const u8* xnB = (const u8*)(p.ws + WS_XQ) + s * 128; const unsigned xoff = 16u * (unsigned)j;
  const float* sxp = (const float*)(p.ws + WS_SX);
  const u8* ccB = (const u8*)(p.ws + WS_CC); const unsigned coff = (unsigned)r * 16u;
  const float* csp = (const float*)(p.ws + WS_CS);
  u16* pdB = (u16*)(p.ws + WS_PD) + (size_t)s * T * 128;
  const int ntok = (T - tbeg + tstep - 1) / tstep;
  if (ntok <= 0) return;
#define TOK(k) (tbeg + ((k) < ntok ? (k) : ntok - 1) * tstep)
#define LD_IDX(dst, k) do { const u8* b_ = eidxB + (size_t)TOK(k) * 256; dst.i0 = *(const u32x4*)(b_ + eoff); dst.i1 = *(const u32x4*)(b_ + eoff + 16u); } while (0)
#define LD_HALF(H, ix, h) do { _Pragma("unroll") for (int i = 0; i < 8; ++i) H[i] = *(const u32x4*)(TBs + (EIDX_AT(ix.i0, ix.i1, 8 * (h) + i) * 128u + toff)); } while (0)
#define LD_AUX(a, k) do { if (AXPY) { const u8* b_ = ccB + (size_t)TOK(k) * 128; a[0] = *(const u32x4*)(b_ + coff); a[1].x = __float_as_uint(csp[TOK(k)]); } \
    else { const u8* b_ = xnB + (size_t)TOK(k) * DM; a[0] = *(const u32x4*)(b_ + xoff); a[1].x = __float_as_uint(sxp[TOK(k)]); } } while (0)
  PeerIdx I0, I1, I2; u32x4 H0[8], H1[8], H2[8], X0[2], X1[2], X2[2];
  u32x4 xq4 = {0, 0, 0, 0}; float sxk = 0.f;
  int acc[16];
#define T_BEGIN(X) do { xq4 = X[0]; sxk = __uint_as_float(X[1].x); if (AXPY) { _Pragma("unroll") for (int q = 0; q < 16; ++q) acc[q] = 0; } } while (0)
#define COMP(H, h, k) do { if ((k) < ntok) { \
    if (!AXPY) { u16* o_ = pdB + (size_t)(tbeg + (k) * tstep) * 128 + r * 16 + 8 * (h); \
      _Pragma("unroll") for (int g = 0; g < 2; ++g) { float res[4]; \
        _Pragma("unroll") for (int ii = 0; ii < 4; ++ii) { const u32x4 w_ = H[4 * g + ii]; \
          int a_ = __builtin_amdgcn_sdot4((int)w_.x, (int)xq4.x, 0, false); a_ = __builtin_amdgcn_sdot4((int)w_.y, (int)xq4.y, a_, false); \
          a_ = __builtin_amdgcn_sdot4((int)w_.z, (int)xq4.z, a_, false); a_ = __builtin_amdgcn_sdot4((int)w_.w, (int)xq4.w, a_, false); \
          a_ += __builtin_amdgcn_mov_dpp(a_, 0xB1, 0xF, 0xF, true); a_ += __builtin_amdgcn_mov_dpp(a_, 0x4E, 0xF, 0xF, true); a_ += __builtin_amdgcn_mov_dpp(a_, 0x141, 0xF, 0xF, true); \
          res[ii] = (float)a_ * sxk; } \
        if (j == 0) *(u32x2*)(o_ + 4 * g) = (u32x2){pk2(res[0], res[1]), pk2(res[2], res[3])}; } } \
    else { _Pragma("unroll") for (int gi = 0; gi < 2; ++gi) { const int cv_ = (int)xq4[2 * (h) + gi];        \
        _Pragma("unroll") for (int dc = 0; dc < 4; ++dc) { const unsigned A_ = H[4 * gi][dc], B_ = H[4 * gi + 1][dc], C_ = H[4 * gi + 2][dc], D_ = H[4 * gi + 3][dc]; \
            \
          const unsigned X_ = __builtin_amdgcn_perm(B_, A_, 0x05010400u), Y_ = __builtin_amdgcn_perm(B_, A_, 0x07030602u), Z_ = __builtin_amdgcn_perm(D_, C_, 0x05010400u), W_ = __builtin_amdgcn_perm(D_, C_, 0x07030602u); \
          acc[4 * dc + 0] = __builtin_amdgcn_sdot4((int)__builtin_amdgcn_perm(Z_, X_, 0x05040100u), cv_, acc[4 * dc + 0], false); \
          acc[4 * dc + 1] = __builtin_amdgcn_sdot4((int)__builtin_amdgcn_perm(Z_, X_, 0x07060302u), cv_, acc[4 * dc + 1], false); \
          acc[4 * dc + 2] = __builtin_amdgcn_sdot4((int)__builtin_amdgcn_perm(W_, Y_, 0x05040100u), cv_, acc[4 * dc + 2], false); \
          acc[4 * dc + 3] = __builtin_amdgcn_sdot4((int)__builtin_amdgcn_perm(W_, Y_, 0x07060302u), cv_, acc[4 * dc + 3], false); } } } } } while (0)
  auto finalize = [&](int k) {
    if (!AXPY || k >= ntok) return;
    const int t = tbeg + k * tstep;
    int S[8];
#pragma unroll
    for (int q = 0; q < 8; ++q) { auto rr = __builtin_amdgcn_permlane32_swap((unsigned)acc[q], (unsigned)acc[q + 8], false, false); S[q] = (int)rr[0] + (int)rr[1]; }
    int Tq[4];
#pragma unroll
    for (int q = 0; q < 4; ++q) { auto rr = __builtin_amdgcn_permlane16_swap((unsigned)S[q], (unsigned)S[q + 4], false, false); Tq[q] = (int)rr[0] + (int)rr[1]; }
#pragma unroll
    for (int q = 0; q < 4; ++q) Tq[q] += __builtin_amdgcn_mov_dpp(Tq[q], 0x128, 0xF, 0xF, true);
    float ss = 0.f;
    if ((lane & 8) == 0) {
      const size_t o = (size_t)t * DM + s * 128 + 16 * j + ((lane >> 5) & 1) * 8 + ((lane >> 4) & 1) * 4;
      u32x2* xgp = (u32x2*)((u16*)(p.ws + WS_XG) + o); const u32x2 xb = *xgp;
      const f32x4 y = {fmaf((float)Tq[0], sxk, bflo(xb.x)), fmaf((float)Tq[1], sxk, bfhi(xb.x)), fmaf((float)Tq[2], sxk, bflo(xb.y)), fmaf((float)Tq[3], sxk, bfhi(xb.y))};
      *xgp = (u32x2){pk2(y.x, y.y), pk2(y.z, y.w)};
      ss = (y.x * y.x + y.y * y.y) + (y.z * y.z + y.w * y.w);
    }
    ss = wave_sum(ss); if (lane == 0) ((float*)(p.ws + WS_SSQ))[(size_t)t * 8 + s] = ss;
  };
  LD_IDX(I0, 0); LD_IDX(I1, 1); LD_IDX(I2, 2); LD_HALF(H0, I0, 0); LD_HALF(H1, I0, 1); LD_AUX(X0, 0);
#pragma unroll 2
  for (int k = 0; k < ntok; k += 3) {
    LD_HALF(H2, I1, 0); LD_IDX(I0, k + 3); LD_AUX(X1, k + 1);
    T_BEGIN(X0); COMP(H0, 0, k);
    LD_HALF(H0, I1, 1);
    COMP(H1, 1, k); finalize(k);
    LD_HALF(H1, I2, 0); LD_IDX(I1, k + 4); LD_AUX(X2, k + 2);
    T_BEGIN(X1); COMP(H2, 0, k + 1);
    LD_HALF(H2, I2, 1);
    COMP(H0, 1, k + 1); finalize(k + 1);
    LD_HALF(H0, I0, 0); LD_IDX(I2, k + 5); LD_AUX(X0, k + 3);
    T_BEGIN(X2); COMP(H1, 0, k + 2);
    LD_HALF(H1, I0, 1);
    COMP(H2, 1, k + 2); finalize(k + 2);
  }
#undef TOK
#undef LD_IDX
#undef LD_HALF
#undef LD_AUX
#undef T_BEGIN
#undef COMP
}

DEVI void lru_passB(const Params& p, int item, int lane) {
  const int cg = item % 6, b = (item / 6) % NB, d = item / (6 * NB);
  const size_t o = (size_t)(d * NB + b) * NLCH * LRU_W + cg * 64 + lane;
  const float* Pp = (const float*)(p.ws + WS_LP) + o; const float* Hp = (const float*)(p.ws + WS_LH) + o; float* Cp = (float*)(p.ws + WS_LC) + o;
  float h = 0.f;
#pragma unroll 1
  for (int c0 = 0; c0 < NLCH; c0 += 32) {
    float pv[32], hv[32];
#pragma unroll
    for (int i = 0; i < 32; ++i) { const int cc = d ? NLCH - 1 - (c0 + i) : c0 + i; pv[i] = Pp[(size_t)cc * LRU_W]; hv[i] = Hp[(size_t)cc * LRU_W]; }
#pragma unroll
    for (int i = 0; i < 32; ++i) { const int cc = d ? NLCH - 1 - (c0 + i) : c0 + i; Cp[(size_t)cc * LRU_W] = h; h = fmaf(pv[i], h, hv[i]); }
  }
}

DEVI void swa_item(const Params& p, int layer, int item, char* lds) {
  const int tid = tidx(), wid = tid >> 6, lane = tid & 63, r32 = lane & 31, hi = lane >> 5;
  const int g = item & 1, n = (item >> 1) & 63, b = item >> 7;
  const int hq = 2 * g + (wid >> 2), qrow = n * 128 + (wid & 3) * 32;
  const u16* proj = (const u16*)(p.ws + WS_R1);
  const u16* Qw = proj + (size_t)(b * SEQ + qrow + r32) * INWP + PC_SQ + hq * 64 + hi * 8;
  const u16* Kh = proj + (size_t)(b * SEQ) * INWP + PC_SK + g * 64;
  const u16* Vh = proj + (size_t)(b * SEQ) * INWP + PC_SV + g * 64;
  const int kt0 = (2 * n - 2) < 0 ? 0 : (2 * n - 2), kt1 = (2 * n + 4) > SEQ / 64 ? SEQ / 64 : (2 * n + 4);
  const float sink = p.swa_sink[layer * 4 + hq];
  u16* Ow = (u16*)(p.ws + WS_MIX) + (size_t)(b * SEQ + qrow) * DM + 768 + hq * 64;
  attn_body<64, true>(Qw, Kh, INWP, Vh, INWP, kt0, kt1 - kt0, 0.125f, sink * 8.f, 1.f, qrow + r32, Ow, lds);
}
DEVI void mla_item(const Params& p, int pair, int qb, char* lds) {
  const int tid = tidx(), wid = tid >> 6, lane = tid & 63, r32 = lane & 31, hi = lane >> 5;
  const int b = pair / MLA_H, h = pair - b * MLA_H;
  const u16* Qw = (const u16*)(p.ws + WS_QM) + ((size_t)pair * SEQ + qb * 256 + wid * 32 + r32) * MLA_QK + hi * 8;
  const u16* Kh = (const u16*)(p.ws + WS_KM) + (size_t)pair * SEQ * MLA_QK;
  const u16* Vh = (const u16*)(p.ws + WS_VM) + (size_t)pair * SEQ * MLA_V;
  u16* Ow = (u16*)(p.ws + WS_MIX) + (size_t)(b * SEQ + qb * 256 + wid * 32) * DM + h * 64;
  attn_body<96, false>(Qw, Kh, MLA_QK, Vh, MLA_V, 0, SEQ / 64, 0.10206207261596575f, -1e30f, 0.f, 0, Ow, lds, (float)p.pos[b * SEQ + qb * 256 + wid * 32 + r32]);
}


namespace pg8 {
#define PG8_LAS __attribute__((address_space(3)))
constexpr int BM = 256, BK = 64, HALF = 128, HTB = HALF * BK * 2, NXCD = 8, WGM = 8;
DEVI int lds_byte(int r, int c) { const int st = (r >> 4) * 2 + (c >> 5), rr = r & 15, cc = c & 31, ob = rr * 64 + cc * 2; return st * 1024 + (ob ^ (((ob >> 9) & 1) << 5)); }
DEVI void stage_rc(int b, int& R, int& C) { const int st = b / 1024, sb = b % 1024, swz = sb ^ (((sb >> 9) & 1) << 5); R = (st >> 1) * 16 + swz / 64; C = (st & 1) * 32 + (swz % 64) / 2; }
DEVI int perm32(int rho) { const int n = rho >> 4, i = rho & 15; return 8 * (i >> 2) + 4 * n + (i & 3); }
struct Unit { int pm, pn; };
struct Gemm { const u16* A; const u16* Bt; int M, N, K, lda, ldb; };
struct StaticOrder {
  int nM, nN, nwg, G, c;
  DEVI void init(int M, int N, int G_, int c_) { nM = M / BM; nN = N / BM; nwg = nM * nN; G = G_; c = c_; }
  DEVI bool next(int i, Unit& u) const {
    const long L = (long)i * G + c; if (L >= nwg) return false;
    int wgid = (int)L; { const int q = nwg / NXCD, r = nwg % NXCD, xcd = wgid % NXCD, off = wgid / NXCD; wgid = (xcd < r ? xcd * (q + 1) : r * (q + 1) + (xcd - r) * q) + off; }
    const int nig = WGM * nN, gid = wgid / nig, fm = gid * WGM, gsz = (nM - fm) < WGM ? (nM - fm) : WGM;
    u.pm = fm + ((wgid % nig) % gsz); u.pn = (wgid % nig) / gsz; return true;
  }
};
template <class Epi>
DEVI void gemm_phase(PG8_LAS unsigned char* lds, const Gemm g, const StaticOrder& S, const Epi& E) {
  const int tid = tidx(), wid = __builtin_amdgcn_readfirstlane(tid >> 6), lane = tid & 63, wr = wid >> 2, wc = wid & 3, fr = lane & 15, fq = lane >> 4;
  const int K = g.K; int nt = K / BK; asm volatile("" : "+s"(nt));
  unsigned voffA[2], voffB[2];
#pragma unroll
  for (int i = 0; i < 2; ++i) { int R, C; stage_rc(tid * 16 + i * 8192, R, C); const int Rb = (R & ~31) + perm32(R & 31);
    voffA[i] = (unsigned)(R * g.lda + C) * 2u; voffB[i] = (unsigned)(Rb * g.ldb + C) * 2u; }
  const size_t kstep = (size_t)(BK * 2), hstepA = (size_t)HALF * g.lda * 2, hstepB = (size_t)HALF * g.ldb * 2, tstepA = 2 * hstepA, tstepB = 2 * hstepB;
  const unsigned ldsw = (unsigned)wid * 1024u;
  const int aoff = lds_byte(wr * 64 + fr, fq * 8), boff = lds_byte(wc * 32 + fr, fq * 8);
#define PG8_SA(b, h) (((b) * 2 + (h)) * HTB)
#define PG8_SB(b, h) ((4 + (b) * 2 + (h)) * HTB)
#define PG8_STAGE(bufoff, gbase, voff) do { _Pragma("unroll") for (int _i = 0; _i < 2; ++_i) \
    __builtin_amdgcn_global_load_lds((const unsigned*)((const char*)(gbase) + (voff)[_i]), (PG8_LAS unsigned*)(lds + (bufoff) + ldsw + _i * 8192), 16, 0, 0); } while (0)
#define PG8_LDA(dst, b, h) do { _Pragma("unroll") for (int m = 0; m < 4; ++m) _Pragma("unroll") for (int k = 0; k < 2; ++k) dst[m][k] = *(const PG8_LAS bf16x8*)(lds + PG8_SA(b, h) + aoff + m * 2048 + k * 1024); } while (0)
#define PG8_LDB(dst, b, h) do { _Pragma("unroll") for (int n = 0; n < 2; ++n) _Pragma("unroll") for (int k = 0; k < 2; ++k) dst[n][k] = *(const PG8_LAS bf16x8*)(lds + PG8_SB(b, h) + boff + n * 2048 + k * 1024); } while (0)
#define PG8_MMA(ai, bj, At, Bt) do { __builtin_amdgcn_s_setprio(1); _Pragma("unroll") for (int m = 0; m < 4; ++m) _Pragma("unroll") for (int n = 0; n < 2; ++n) _Pragma("unroll") for (int k = 0; k < 2; ++k) \
    acc[ai][bj][m][n] = __builtin_amdgcn_mfma_f32_16x16x32_bf16(Bt[n][k], At[m][k], acc[ai][bj][m][n], 0, 0, 0); __builtin_amdgcn_s_setprio(0); } while (0)
#define PG8_WAIT_V(n) asm volatile("s_waitcnt vmcnt(" #n ")" ::: "memory")
#define PG8_WAIT_L(n) asm volatile("s_waitcnt lgkmcnt(" #n ")" ::: "memory")
#define PG8_BAR __builtin_amdgcn_s_barrier()
#define PG8_SCHED __builtin_amdgcn_sched_barrier(0)
  Unit cur, nxt; int ui = 0;
  if (!S.next(0, cur)) return;
  f32x4 acc[2][2][4][2];
#pragma unroll
  for (int a = 0; a < 2; ++a)
#pragma unroll
    for (int b = 0; b < 2; ++b)
#pragma unroll
      for (int m = 0; m < 4; ++m)
#pragma unroll
        for (int n = 0; n < 2; ++n) acc[a][b][m][n] = (f32x4){0.f, 0.f, 0.f, 0.f};
  bf16x8 At[4][2], B0[2][2], B1[2][2];
  const char* cA = (const char*)g.A + (size_t)cur.pm * tstepA; const char* cB = (const char*)g.Bt + (size_t)cur.pn * tstepB;
  PG8_STAGE(PG8_SB(0, 0), cB, voffB); PG8_STAGE(PG8_SB(0, 1), cB + hstepB, voffB); PG8_STAGE(PG8_SA(0, 0), cA, voffA); PG8_STAGE(PG8_SA(0, 1), cA + hstepA, voffA);
  if (wr == 1) PG8_BAR;
  PG8_WAIT_V(2); PG8_BAR;
  PG8_STAGE(PG8_SB(1, 0), cB + kstep, voffB); PG8_STAGE(PG8_SA(1, 0), cA + kstep, voffA); PG8_STAGE(PG8_SB(1, 1), cB + hstepB + kstep, voffB);
  PG8_WAIT_V(6); PG8_BAR;
  for (;;) {
    const bool has_next = S.next(ui + 1, nxt);
    const char* nA = has_next ? (const char*)g.A + (size_t)nxt.pm * tstepA : cA; const char* nB = has_next ? (const char*)g.Bt + (size_t)nxt.pn * tstepB : cB;
#pragma unroll 1
    for (int t = 0; t < nt; t += 2) {
      const bool last = (t == nt - 2);
      const char* a1 = cA + (size_t)(t + 1) * kstep;
      const char* a2 = last ? nA : cA + (size_t)(t + 2) * kstep; const char* b2 = last ? nB : cB + (size_t)(t + 2) * kstep;
      const char* a3 = a2 + kstep; const char* b3 = b2 + kstep;
      PG8_LDB(B0, 0, 0); PG8_LDB(B1, 0, 1); PG8_SCHED; PG8_LDA(At, 0, 0); PG8_STAGE(PG8_SA(1, 1), a1 + hstepA, voffA);
      PG8_WAIT_V(8); PG8_WAIT_L(0); PG8_BAR; PG8_MMA(0, 0, At, B0); PG8_MMA(0, 1, At, B1); PG8_BAR; PG8_SCHED;
      PG8_LDA(At, 0, 1); PG8_STAGE(PG8_SB(0, 0), b2, voffB); PG8_STAGE(PG8_SB(0, 1), b2 + hstepB, voffB); PG8_STAGE(PG8_SA(0, 0), a2, voffA);
      PG8_WAIT_V(8); PG8_WAIT_L(0); PG8_BAR; PG8_MMA(1, 0, At, B0); PG8_MMA(1, 1, At, B1); PG8_BAR; PG8_SCHED;
      PG8_LDB(B0, 1, 0); PG8_LDB(B1, 1, 1); PG8_SCHED; PG8_LDA(At, 1, 0); PG8_STAGE(PG8_SA(0, 1), a2 + hstepA, voffA);
      PG8_WAIT_V(8); PG8_WAIT_L(0); PG8_BAR; PG8_MMA(0, 0, At, B0); PG8_MMA(0, 1, At, B1); PG8_BAR; PG8_SCHED;
      PG8_LDA(At, 1, 1); PG8_STAGE(PG8_SB(1, 0), b3, voffB); PG8_STAGE(PG8_SB(1, 1), b3 + hstepB, voffB); PG8_STAGE(PG8_SA(1, 0), a3, voffA);
      PG8_WAIT_V(8); PG8_WAIT_L(0); PG8_BAR; PG8_MMA(1, 0, At, B0); PG8_MMA(1, 1, At, B1); PG8_BAR; PG8_SCHED;
    }
    if (wr == 0) PG8_BAR;
    E(acc, cur, wr, wc, fr, fq);
    if (!has_next) break;
#pragma unroll
    for (int a = 0; a < 2; ++a)
#pragma unroll
      for (int b = 0; b < 2; ++b)
#pragma unroll
        for (int m = 0; m < 4; ++m)
#pragma unroll
          for (int n = 0; n < 2; ++n) acc[a][b][m][n] = (f32x4){0.f, 0.f, 0.f, 0.f};
    cur = nxt; cA = nA; cB = nB; ++ui;
    if (wr == 1) PG8_BAR;
  }
  PG8_WAIT_V(0);
  PG8_BAR;
#undef PG8_SA
#undef PG8_SB
#undef PG8_STAGE
#undef PG8_LDA
#undef PG8_LDB
#undef PG8_MMA
#undef PG8_WAIT_V
#undef PG8_WAIT_L
#undef PG8_BAR
#undef PG8_SCHED
}

DEVI float rs_from8(const float* s) { const f32x4 a = *(const f32x4*)s, b = *(const f32x4*)(s + 4); return rsqrtf((((a.x + a.y) + (a.z + a.w)) + ((b.x + b.y) + (b.z + b.w))) * (1.f / DM) + EPS); }
struct EpiProj { u16* proj; const int* pos; const float* ssq8; float* ssqq; float* ssqkv;
  DEVI void operator()(const f32x4 (&acc)[2][2][4][2], const Unit& u, int wr, int wc, int fr, int fq) const {
    const int row0 = u.pm * BM + wr * 64 + fr, col0 = u.pn * BM + wc * 32 + 8 * fq;
#pragma unroll
    for (int ai = 0; ai < 2; ++ai)
#pragma unroll
      for (int m = 0; m < 4; ++m) { const int row = row0 + ai * HALF + m * 16; const float rs = rs_from8(ssq8 + (size_t)row * 8); const float posf = (float)pos[row];
        float sq0 = 0.f, sq1 = 0.f;
#pragma unroll
        for (int bj = 0; bj < 2; ++bj) { const int gcol = col0 + bj * HALF;
          float v[8]; { const f32x4 a = acc[ai][bj][m][0] * rs, b = acc[ai][bj][m][1] * rs; v[0] = a.x; v[1] = a.y; v[2] = a.z; v[3] = a.w; v[4] = b.x; v[5] = b.y; v[6] = b.z; v[7] = b.w; }
          if (u.pn <= 1) { float s = 0.f;
#pragma unroll
            for (int q = 0; q < 8; ++q) s = fmaf(v[q], v[q], s);
            if (bj == 0) sq0 = s; else sq1 = s; }
          const bool r64 = gcol >= PC_SQ && gcol < PC_SV, r32g = gcol >= PC_KR && gcol < PC_KR + 32;
          if (r64 || r32g) {
#pragma unroll
            for (int q = 0; q < 4; ++q) { const int f = r64 ? (((gcol + 2 * q) & 63) >> 1) : 2 * (((gcol + 2 * q) & 31) >> 1); float sn, cs; rope_sc(posf, f, sn, cs);
              const float x1 = v[2 * q], x2 = v[2 * q + 1]; v[2 * q] = x1 * cs - x2 * sn; v[2 * q + 1] = x2 * cs + x1 * sn; } }
          *(u32x4*)(proj + (size_t)row * INWP + gcol) = pk8(v); }
        if (u.pn <= 1) { float s = u.pn == 0 ? sq0 + sq1 : sq0; s += __shfl_xor(s, 16); s += __shfl_xor(s, 32);
          if (fq == 0) (u.pn == 0 ? ssqq : ssqkv)[(size_t)row * 4 + wc] = s; } }
  }
};
struct EpiQ2 { u16* qm; const float* ssqq;
  DEVI void operator()(const f32x4 (&acc)[2][2][4][2], const Unit& u, int wr, int wc, int fr, int fq) const {
    const int b = (u.pm * BM) >> 13, s0 = (u.pm * BM) & (SEQ - 1), lrow = wr * 64 + fr;
    const float* sq = ssqq + (size_t)(u.pm * BM) * 4 + lrow * 4;
    float rs[2][4];
#pragma unroll
    for (int ai = 0; ai < 2; ++ai)
#pragma unroll
      for (int m = 0; m < 4; ++m) { const f32x4 sp = *(const f32x4*)(sq + (ai * HALF + m * 16) * 4); rs[ai][m] = rsqrtf(((sp.x + sp.y) + (sp.z + sp.w)) * (1.f / 256.f) + EPS); }
#pragma unroll
    for (int bj = 0; bj < 2; ++bj) { const int gcol = u.pn * BM + bj * HALF + wc * 32 + 8 * fq;
      if (gcol < 576) { const int head = (gcol * 683) >> 16, j0 = gcol - head * 96;
        u16* base = qm + ((size_t)(b * MLA_H + head) * SEQ + s0) * MLA_QK + (unsigned)(lrow * MLA_QK + j0);
#pragma unroll
        for (int ai = 0; ai < 2; ++ai)
#pragma unroll
          for (int m = 0; m < 4; ++m) { const float r = rs[ai][m];
            float v[8]; { const f32x4 a = acc[ai][bj][m][0] * r, bb = acc[ai][bj][m][1] * r; v[0] = a.x; v[1] = a.y; v[2] = a.z; v[3] = a.w; v[4] = bb.x; v[5] = bb.y; v[6] = bb.z; v[7] = bb.w; }
            *(u32x4*)(base + (ai * HALF + m * 16) * MLA_QK) = pk8(v); } } }
  }
};
struct EpiKV2 { u16* km; u16* vm; const float* ssqkv;
  DEVI void operator()(const f32x4 (&acc)[2][2][4][2], const Unit& u, int wr, int wc, int fr, int fq) const {
    const int b = (u.pm * BM) >> 13, s0 = (u.pm * BM) & (SEQ - 1), lrow = wr * 64 + fr;
    const float* sq = ssqkv + (size_t)(u.pm * BM) * 4 + lrow * 4;
    float rs[2][4];
#pragma unroll
    for (int ai = 0; ai < 2; ++ai)
#pragma unroll
      for (int m = 0; m < 4; ++m) { const f32x4 sp = *(const f32x4*)(sq + (ai * HALF + m * 16) * 4); rs[ai][m] = rsqrtf(((sp.x + sp.y) + (sp.z + sp.w)) * (1.f / 128.f) + EPS); }
#pragma unroll
    for (int bj = 0; bj < 2; ++bj) { const int head = u.pn * 2 + bj, c = wc * 32 + 8 * fq;
      const size_t tok0 = (size_t)(b * MLA_H + head) * SEQ + s0;
      u16* base = c < 64 ? km + tok0 * MLA_QK + (unsigned)(lrow * MLA_QK + c) : vm + tok0 * MLA_V + (unsigned)(lrow * MLA_V + (c - 64));
      const int ld = c < 64 ? MLA_QK : MLA_V;
#pragma unroll
      for (int ai = 0; ai < 2; ++ai)
#pragma unroll
        for (int m = 0; m < 4; ++m) { const float r = rs[ai][m];
          float v[8]; { const f32x4 a = acc[ai][bj][m][0] * r, bb = acc[ai][bj][m][1] * r; v[0] = a.x; v[1] = a.y; v[2] = a.z; v[3] = a.w; v[4] = bb.x; v[5] = bb.y; v[6] = bb.z; v[7] = bb.w; }
          *(u32x4*)(base + (ai * HALF + m * 16) * ld) = pk8(v); } }
  }
};
struct EpiPQ { u16* O; const float* ssq16;
  DEVI void operator()(const f32x4 (&acc)[2][2][4][2], const Unit& u, int wr, int wc, int fr, int fq) const {
    const int row0 = u.pm * BM + wr * 64 + fr, col0 = u.pn * BM + wc * 32 + 8 * fq;
#pragma unroll
    for (int ai = 0; ai < 2; ++ai)
#pragma unroll
      for (int m = 0; m < 4; ++m) { const int row = row0 + ai * HALF + m * 16;
        const f32x4* sp = (const f32x4*)(ssq16 + (size_t)row * 16); const f32x4 s4 = (sp[0] + sp[1]) + (sp[2] + sp[3]);
        const float rs = rsqrtf(((s4.x + s4.y) + (s4.z + s4.w)) * (1.f / DM) + EPS);
#pragma unroll
        for (int bj = 0; bj < 2; ++bj) { float v[8]; { const f32x4 a = acc[ai][bj][m][0] * rs, b = acc[ai][bj][m][1] * rs; v[0] = a.x; v[1] = a.y; v[2] = a.z; v[3] = a.w; v[4] = b.x; v[5] = b.y; v[6] = b.z; v[7] = b.w; }
          *(u32x4*)(O + (size_t)row * 2048 + col0 + bj * HALF) = pk8(v); } }
  }
};
struct EpiRes { u16* xg; float* ssq16;
  DEVI void operator()(const f32x4 (&acc)[2][2][4][2], const Unit& u, int wr, int wc, int fr, int fq) const {
    const int row0 = u.pm * BM + wr * 64 + fr, col0 = u.pn * BM + wc * 32 + 8 * fq;
#pragma unroll
    for (int ai = 0; ai < 2; ++ai)
#pragma unroll
      for (int m = 0; m < 4; ++m) { const int row = row0 + ai * HALF + m * 16; float ss = 0.f;
#pragma unroll
        for (int bj = 0; bj < 2; ++bj) { const size_t o = (size_t)row * DM + col0 + bj * HALF;
          float x[8]; unpk8(*(const u32x4*)(xg + o), x);
          const f32x4 a = acc[ai][bj][m][0], b = acc[ai][bj][m][1];
          x[0] += a.x; x[1] += a.y; x[2] += a.z; x[3] += a.w; x[4] += b.x; x[5] += b.y; x[6] += b.z; x[7] += b.w;
#pragma unroll
          for (int q = 0; q < 8; ++q) ss = fmaf(x[q], x[q], ss);
          *(u32x4*)(xg + o) = pk8(x); }
        ss += __shfl_xor(ss, 16); ss += __shfl_xor(ss, 32);
        if (fq == 0) ssq16[(size_t)row * 16 + u.pn * 4 + wc] = ss; }
  }
};
}


DEVI void lru_gate_item(const Params& p, int l, int mt, int n, char* lds) {
  const int tid = tidx(), lane = tid & 63, wid = tid >> 6, wm = wid >> 1, wn = wid & 1, r32 = lane & 31, hi = lane >> 5;
  const int srow = tid >> 3, sc = tid & 7, m0 = mt * 256;
  const u16* PROJ = (const u16*)(p.ws + WS_R1);
  GemmDesc g{}; g.proj = PROJ; g.cw = p.conv_w + l * 4 * LRU_W; g.cb = p.conv_b + l * LRU_W; g.ch0 = n * 64;
  char* Ab = lds; char* Bb = lds + 32768;
  { bf16x8 ar[4], br[4];
#pragma unroll
    for (int i = 0; i < 4; ++i) ar[i] = load_a<1>(g, m0 + srow + 64 * i, sc * 8);
    const u16* W = (const u16*)(p.ws + WS_WLRU) + (size_t)((l * 6 + n) * 2) * 128 * 64;
#pragma unroll
    for (int i = 0; i < 4; ++i) br[i] = *(const bf16x8*)(W + (size_t)(srow + 64 * i) * 64 + sc * 8);
#pragma unroll
    for (int i = 0; i < 4; ++i) { *(bf16x8*)(Ab + swz(srow + 64 * i, sc)) = ar[i]; *(bf16x8*)(Bb + (i >> 1) * 16384 + swz(srow + 64 * (i & 1), sc)) = br[i]; } }
  __syncthreads();
  bf16x8 a[2][4];
#pragma unroll
  for (int t = 0; t < 2; ++t)
#pragma unroll
    for (int k = 0; k < 4; ++k) a[t][k] = *(const bf16x8*)(Ab + swz(wm * 64 + t * 32 + r32, k * 2 + hi));
  const int jl = 32 * wn + r32, ch = n * 64 + jl;
  float xf[2][16];
#pragma unroll
  for (int t = 0; t < 2; ++t)
#pragma unroll
    for (int r = 0; r < 16; ++r) { const int row = wm * 64 + t * 32 + crow(r, hi); xf[t][r] = bf2f(*(const u16*)(Ab + swz(row, jl >> 3) + (jl & 7) * 2)); }
  const int bidx = m0 >> 13, s0 = (m0 & (SEQ - 1)) + wm * 64;
#pragma unroll
  for (int d = 0; d < 2; ++d) {
    f32x16 acc[2][2] = {{f32x16{}, f32x16{}}, {f32x16{}, f32x16{}}};
#pragma unroll
    for (int k = 0; k < 4; ++k) { bf16x8 b[2];
#pragma unroll
      for (int q = 0; q < 2; ++q) b[q] = *(const bf16x8*)(Bb + d * 16384 + swz(wn * 64 + q * 32 + r32, k * 2 + hi));
#pragma unroll
      for (int t = 0; t < 2; ++t)
#pragma unroll
        for (int q = 0; q < 2; ++q) acc[t][q] = __builtin_amdgcn_mfma_f32_32x32x16_bf16(a[t][k], b[q], acc[t][q], 0, 0, 0); }
    const float bav = p.lru_ba[((l * 2 + d) * 6 + n) * 64 + jl], bxv = p.lru_bx[((l * 2 + d) * 6 + n) * 64 + jl];
    const float cdec = -8.f * log1pf(__expf(-p.lru_lambda[(l * 2 + d) * LRU_W + ch]));
    u16* le = (u16*)(p.ws + WS_LE); u16* lb = (u16*)(p.ws + WS_LB);
    float runP[2][4], runH[2][4];
#pragma unroll
    for (int t = 0; t < 2; ++t)
#pragma unroll
      for (int rr = 0; rr < 4; ++rr) {
        float ev[4], bv[4];
#pragma unroll
        for (int q = 0; q < 4; ++q) { const int r = rr * 4 + q;
          const float rg = sigmoidf_(acc[t][0][r] + bav), ig = sigmoidf_(acc[t][1][r] + bxv);
          const float aa = __expf(cdec * rg), e = 1.f - aa; ev[q] = e; bv[q] = sqrtf(e * (2.f - e)) * ig * xf[t][r]; }
        const size_t o = (((size_t)(d * NB + bidx) * (SEQ / 8) + ((s0 + 32 * t + 8 * rr) >> 3)) * LRU_W + ch) * 8 + 4 * hi;
        const u32x2 ew = {pk2(ev[0], ev[1]), pk2(ev[2], ev[3])}, bw = {pk2(bv[0], bv[1]), pk2(bv[2], bv[3])};
        *(u32x2*)(le + o) = ew; *(u32x2*)(lb + o) = bw;
        const float a0 = 1.f - bflo(ew.x), a1 = 1.f - bfhi(ew.x), a2 = 1.f - bflo(ew.y), a3 = 1.f - bfhi(ew.y);
        const float b0 = bflo(bw.x), b1 = bfhi(bw.x), b2 = bflo(bw.y), b3 = bfhi(bw.y);
        if (d == 0) { runP[t][rr] = (a0 * a1) * (a2 * a3); runH[t][rr] = fmaf(a3, fmaf(a2, fmaf(a1, b0, b1), b2), b3); }
        else { runP[t][rr] = (a0 * a1) * (a2 * a3); runH[t][rr] = fmaf(a0, fmaf(a1, fmaf(a2, b3, b2), b1), b0); } }
    { float Pc = 1.f, Hc = 0.f;
#pragma unroll
      for (int i = 0; i < 8; ++i) { const int ii = d == 0 ? i : 7 - i, t = ii >> 2, rr = ii & 3;
        auto rp = __builtin_amdgcn_permlane32_swap(__float_as_uint(runP[t][rr]), __float_as_uint(runP[t][rr]), false, false);
        auto rh = __builtin_amdgcn_permlane32_swap(__float_as_uint(runH[t][rr]), __float_as_uint(runH[t][rr]), false, false);
        const float P0 = __uint_as_float(rp[0]), P1 = __uint_as_float(rp[1]), H0 = __uint_as_float(rh[0]), H1 = __uint_as_float(rh[1]);
        if (d == 0) { Hc = fmaf(P0, Hc, H0); Pc *= P0; Hc = fmaf(P1, Hc, H1); Pc *= P1; }
        else { Hc = fmaf(P1, Hc, H1); Pc *= P1; Hc = fmaf(P0, Hc, H0); Pc *= P0; } }
      if (hi == 0) { const size_t o = ((size_t)(d * NB + bidx) * NLCH + (s0 >> 6)) * LRU_W + ch;
        ((float*)(p.ws + WS_LP))[o] = Pc; ((float*)(p.ws + WS_LH))[o] = Hc; } }
  }
  __syncthreads();
}


DEVI void sort16_desc(float (&v)[16]) {
#pragma unroll
  for (int k = 2; k <= 16; k <<= 1)
#pragma unroll
    for (int j = k >> 1; j > 0; j >>= 1)
#pragma unroll
      for (int i = 0; i < 16; ++i) { const int l = i ^ j; if (l > i) { const float a = v[i], b = v[l]; const bool desc = (i & k) == 0;
          v[i] = desc ? fmaxf(a, b) : fminf(a, b); v[l] = desc ? fminf(a, b) : fmaxf(a, b); } }
}
DEVI void merge16_desc(float (&l)[16], const float (&s)[16]) {
#pragma unroll
  for (int i = 0; i < 16; ++i) l[i] = fmaxf(l[i], s[15 - i]);
#pragma unroll
  for (int st = 8; st >= 1; st >>= 1)
#pragma unroll
    for (int i = 0; i < 16; ++i) if ((i & st) == 0) ce_desc(l[i], l[i + st]);
}
DEVI void pair_merge16(float (&l)[16]) {
  float o[16];
#pragma unroll
  for (int i = 0; i < 16; ++i) o[i] = __shfl_xor(l[i], 1);
  merge16_desc(l, o);
}
DEVI void top16_from_C(const float* C, int row, int part, float (&l)[16]) {
#pragma unroll
  for (int i = 0; i < 16; ++i) l[i] = -3.0e38f;
#pragma unroll 1
  for (int bt = 0; bt < 4; ++bt) { float s[16];
#pragma unroll
    for (int i = 0; i < 16; ++i) { const int col = part * 64 + ((bt * 16 + i + row) & 63);
      s[i] = __uint_as_float((__float_as_uint(C[row * CLD + col]) & ~127u) | (unsigned)(127 - col)); }
    sort16_desc(s);
    merge16_desc(l, s); }
  pair_merge16(l);
}
DEVI void peer_route_item(const Params& p, int l, int mt, int h, char* lds) {
  const int tid = tidx(), row = tid >> 1, part = tid & 1, m0 = mt * 256;
  const u16* PQ = (const u16*)(p.ws + WS_R1);
  float t1[16], t2[16];
#pragma unroll
  for (int j = 0; j < 2; ++j) {
    GemmDesc g{}; g.A = PQ + (h * 2 + j) * 128; g.lda = 2048; g.Bt = (const u16*)(p.ws + WS_SUBK) + (size_t)(l * 2 + j) * 128 * 128; g.ldb = 128; g.KT = 2;
    gemm_core<0, 0>(g, m0, 0, lds);
    if (j == 0) top16_from_C((const float*)lds, row, part, t1); else top16_from_C((const float*)lds, row, part, t2);
    __syncthreads(); }
  constexpr int CA[50] = {0, 0, 0, 0, 0, 0, 0, 0, 0, 0, 0, 0, 0, 0, 0, 0, 1, 1, 1, 1, 1, 1, 1, 1, 2, 2, 2, 2, 2, 3, 3, 3, 3, 4, 4, 4, 5, 5, 6, 6, 7, 7, 8, 9, 10, 11, 12, 13, 14, 15};
  constexpr int CB[50] = {0, 1, 2, 3, 4, 5, 6, 7, 8, 9, 10, 11, 12, 13, 14, 15, 0, 1, 2, 3, 4, 5, 6, 7, 0, 1, 2, 3, 4, 0, 1, 2, 3, 0, 1, 2, 0, 1, 0, 1, 0, 1, 0, 0, 0, 0, 0, 0, 0, 0};
  float lo[16], hi2[16];
#pragma unroll
  for (int k = 0; k < 32; ++k) { float v = -3.0e38f;
    if (k < 25) { const float v0 = __uint_as_float((__float_as_uint(t1[CA[2 * k]] + t2[CB[2 * k]]) & ~255u) | (unsigned)(255 - (CA[2 * k] * 16 + CB[2 * k])));
      const float v1 = __uint_as_float((__float_as_uint(t1[CA[2 * k + 1]] + t2[CB[2 * k + 1]]) & ~255u) | (unsigned)(255 - (CA[2 * k + 1] * 16 + CB[2 * k + 1])));
      v = part ? v1 : v0; }
    if (k < 16) lo[k] = v; else hi2[k - 16] = v; }
  sort16_desc(lo); sort16_desc(hi2); merge16_desc(lo, hi2); pair_merge16(lo);
  const float mx = __uint_as_float(__float_as_uint(lo[0]) & ~255u);
  float w[16], sum = 0.f;
#pragma unroll
  for (int i = 0; i < 16; ++i) { w[i] = __expf(__uint_as_float(__float_as_uint(lo[i]) & ~255u) - mx); sum += w[i]; }
  const float inv = 1.f / sum;
  unsigned char* my = (unsigned char*)lds + tid * 32;
#pragma unroll
  for (int i = 0; i < 16; ++i) { my[i] = (unsigned char)(127u - (__float_as_uint(t1[i]) & 127u)); my[16 + i] = (unsigned char)(127u - (__float_as_uint(t2[i]) & 127u)); }
  unsigned ev[8]; float gv[8];
  const unsigned pm = 0u - (unsigned)part;
#pragma unroll
  for (int i = 0; i < 8; ++i) { const unsigned xb = __float_as_uint(lo[i]) ^ ((__float_as_uint(lo[i]) ^ __float_as_uint(lo[8 + i])) & pm); const unsigned code = 255u - (xb & 255u);
    const unsigned wb = __float_as_uint(w[i]) ^ ((__float_as_uint(w[i]) ^ __float_as_uint(w[8 + i])) & pm);
    ev[i] = (unsigned)my[code >> 4] * 128u + (unsigned)my[16 + (code & 15)]; gv[i] = __uint_as_float(wb) * inv; }
  const size_t o = ((size_t)(m0 + row) * 8 + h) * 16 + part * 8;
  *(u32x4*)((u16*)(p.ws + WS_EIDX) + o) = (u32x4){ev[0] | (ev[1] << 16), ev[2] | (ev[3] << 16), ev[4] | (ev[5] << 16), ev[6] | (ev[7] << 16)};
  *(f32x4*)((float*)(p.ws + WS_EGATE) + o) = (f32x4){gv[0], gv[1], gv[2], gv[3]}; *(f32x4*)((float*)(p.ws + WS_EGATE) + o + 4) = (f32x4){gv[4], gv[5], gv[6], gv[7]};
  __syncthreads();
}

DEVI void peer_convert_tables(const Params& p, int l, size_t i0, size_t istep) {
  const float* us = p.peer_u + (size_t)l * NEXP * DM; const float* vs = p.peer_v + (size_t)l * NEXP * DM;
  u8* ub = (u8*)(p.ws + WS_UB); u8* vbf = (u8*)(p.ws + WS_VB);
  for (size_t i = i0; i < (size_t)NEXP * 64; i += istep) {
    const size_t e = i >> 6; const int c16 = (int)(i & 63), s = c16 >> 3, cc = (c16 & 7) * 16;
    float a[16], b[16]; ld8(us + i * 16, a); ld8(us + i * 16 + 8, a + 8); ld8(vs + i * 16, b); ld8(vs + i * 16 + 8, b + 8);
    const size_t o = ((size_t)s * NEXP + e) * 128 + cc;
    *(u32x4*)(ub + o) = (u32x4){q8x4(a, PEER_SU), q8x4(a + 4, PEER_SU), q8x4(a + 8, PEER_SU), q8x4(a + 12, PEER_SU)};
    *(u32x4*)(vbf + o) = (u32x4){q8x4(b, PEER_SV), q8x4(b + 4, PEER_SV), q8x4(b + 8, PEER_SV), q8x4(b + 12, PEER_SV)}; }
}

constexpr int PH_PER_LAYER = 10, N_PHASES = 2 + DEPTH * PH_PER_LAYER;
DEVI void run_phase(const Params& pin, int ph, int vb, int nb, char* lds) {
  const bool dry = ph >= 100; if (dry) ph -= 100;
  Params p = pin; { size_t z = 0; asm volatile("" : "+s"(z)); p.ws = pin.ws + z; p.out = pin.out + z; } asm volatile("" : "+s"(vb));
  const int tid = tidx(), wid = tid >> 6, lane = tid & 63;
#ifdef ONLY_SP
  if (ONLY_SP >= 0 && ph == 0) return;
#endif
  if (ph == 0) { phase0(p, vb, nb, lds); return; }
  if (ph == N_PHASES - 1) {
    const float* ssq = (const float*)(p.ws + WS_SSQ); const u16* xg = (const u16*)(p.ws + WS_XG);
    for (size_t i = (size_t)vb * NTHREADS + tid; i < (size_t)T * DM / 8; i += (size_t)nb * NTHREADS) {
      const size_t t = i >> 7; const int c = (int)(i & 127) * 8;
      float s8[8]; ld8(ssq + t * 8, s8); const float rs = rsqrtf((((s8[0] + s8[1]) + (s8[2] + s8[3])) + ((s8[4] + s8[5]) + (s8[6] + s8[7]))) * (1.f / DM) + EPS);
      float x[8], g[8]; unpk8(*(const u32x4*)(xg + i * 8), x); ld8(p.norm_final + c, g);
#pragma unroll
      for (int q = 0; q < 8; ++q) x[q] *= rs * g[q];
      *(f32x4*)(p.out + i * 8) = (f32x4){x[0], x[1], x[2], x[3]}; *(f32x4*)(p.out + i * 8 + 4) = (f32x4){x[4], x[5], x[6], x[7]}; }
    return; }
  const int l = (ph - 1) / PH_PER_LAYER, sp = (ph - 1) % PH_PER_LAYER;
  u16* const XG = (u16*)(p.ws + WS_XG); u16* const PROJ = (u16*)(p.ws + WS_R1); u16* const MIX = (u16*)(p.ws + WS_MIX);
  constexpr int NMT = T / 256;
#ifdef ONLY_SP
  if (sp != ONLY_SP) return;
#endif
  switch (sp) {
  case 0: {
    pg8::Gemm g{XG, (const u16*)(p.ws + WS_WIN) + (size_t)l * INWP * DM, T, INWP, DM, DM, DM}; pg8::StaticOrder S; S.init(T, INWP, nb, vb);
    pg8::EpiProj e{PROJ, p.pos, (const float*)(p.ws + WS_SSQ), (float*)(p.ws + WS_SSQQ), (float*)(p.ws + WS_SSQKV)};
    pg8::gemm_phase((PG8_LAS unsigned char*)lds, g, S, e);
    if (!dry) { if (nb == 256) { if (vb >= 128) peer_convert_tables(p, l, (size_t)(vb - 128) * NTHREADS + tid, (size_t)128 * NTHREADS); }
                else peer_convert_tables(p, l, (size_t)vb * NTHREADS + tid, (size_t)nb * NTHREADS); }
  } break;
  case 1: {
    { pg8::Gemm g{PROJ + PC_CQ, (const u16*)(p.ws + WS_WUQ) + (size_t)l * 768 * 256, T, 768, 256, INWP, 256}; pg8::StaticOrder S; S.init(T, 768, nb, vb);
      pg8::EpiQ2 e{(u16*)(p.ws + WS_QM), (const float*)(p.ws + WS_SSQQ)};
      pg8::gemm_phase((PG8_LAS unsigned char*)lds, g, S, e); }
    { pg8::Gemm g{PROJ + PC_CKV, (const u16*)(p.ws + WS_WUKV) + (size_t)l * 768 * 128, T, 768, 128, INWP, 128}; pg8::StaticOrder S; S.init(T, 768, nb, nb - 1 - vb);
      pg8::EpiKV2 e{(u16*)(p.ws + WS_KM), (u16*)(p.ws + WS_VM), (const float*)(p.ws + WS_SSQKV)};
      pg8::gemm_phase((PG8_LAS unsigned char*)lds, g, S, e); }
    for (int i = vb * NTHREADS + tid; i < T * MLA_H * 4; i += nb * NTHREADS) { const int c = (i & 3) * 8, h = (i >> 2) % MLA_H, row = i / (4 * MLA_H), b = row >> 13, s = row & (SEQ - 1);
      *(u32x4*)((u16*)(p.ws + WS_KM) + ((size_t)(b * MLA_H + h) * SEQ + s) * MLA_QK + 64 + c) = *(const u32x4*)(PROJ + (size_t)row * INWP + PC_KR + c); }
    for (int it = vb; it < NMT * 6; it += nb) lru_gate_item(p, l, it / 6, it % 6, lds);
    for (int it = vb; it < NB * 64 * 2; it += nb) swa_item(p, l, it, lds);
  } break;
  case 2: {
    { const int wi = vb * 8 + wid; if (wi < 48) lru_passB(p, wi, lane); __syncthreads(); }
    for (int k = 0; k * nb + vb < NB * MLA_H * 32; ++k) {
      int pair, qb;
      if (nb == 256) { pair = k * 8 + (vb & 7); qb = vb >> 3; } else { const int it = k * nb + vb; pair = it >> 5; qb = it & 31; }
      mla_item(p, pair, qb, lds);
    }
  } break;
  case 3: {
#ifndef NO_LRUF
    if (!dry) for (int it = vb; it < NB * NLCH; it += nb) lru_final(p, it, lds);
#endif
    for (int t = vb * 8 + wid; t < T; t += nb * 8) {
      u32x4* rp = (u32x4*)(MIX + (size_t)t * DM + lane * 16);
      float v[16]; unpk8(rp[0], v); unpk8(rp[1], v + 8);
      float s = 0.f;
#pragma unroll
      for (int q = 0; q < 16; ++q) s = fmaf(v[q], v[q], s);
      const int sg = lane < 24 ? 0 : (lane < 48 ? 1 : 2);
      const float s0 = wave_sum(sg == 0 ? s : 0.f), s2 = wave_sum(sg == 2 ? s : 0.f);
      const float rs = sg == 0 ? rsqrtf(s0 * (1.f / 384.f) + EPS) : rsqrtf(s2 * (1.f / 256.f) + EPS);
      if (sg != 1) {
#pragma unroll
        for (int q = 0; q < 16; ++q) v[q] *= rs;
        rp[0] = pk8(v); rp[1] = pk8(v + 8); } }
  } break;
  case 4: {
    { pg8::Gemm g{MIX, (const u16*)(p.ws + WS_WOUT) + (size_t)l * DM * DM, T, DM, DM, DM, DM}; pg8::StaticOrder S; S.init(T, DM, nb, vb);
      pg8::EpiRes e{dry ? (u16*)(p.ws + WS_R1) : XG, (float*)(p.ws + WS_SSQ16)};
      pg8::gemm_phase((PG8_LAS unsigned char*)lds, g, S, e); }
  } break;
  case 5: {
    pg8::Gemm g{XG, (const u16*)(p.ws + WS_WQ) + (size_t)l * 2048 * DM, T, 2048, DM, DM, DM}; pg8::StaticOrder S; S.init(T, 2048, nb, vb);
    pg8::EpiPQ e{PROJ, (const float*)(p.ws + WS_SSQ16)};
    pg8::gemm_phase((PG8_LAS unsigned char*)lds, g, S, e);
  } break;
  case 6: {
    for (int it = vb; it < NMT * 8; it += nb) peer_route_item(p, l, it >> 3, it & 7, lds);
    if (!dry) peer_xn_pass(p, l, vb, nb);
  } break;
  case 7: case 9: {
    const bool last = l == DEPTH - 1;
    float* xo = dry ? (float*)(p.ws + WS_PD) : p.out;
    int s0, s1, tb, ts;
    if ((nb & 7) == 0) { s0 = vb & 7; s1 = s0 + 1; tb = (vb >> 3) * 8 + wid; ts = (nb >> 3) * 8; } else { s0 = 0; s1 = 8; tb = vb * 8 + wid; ts = nb * 8; }
#pragma unroll 1
    for (int s = s0; s < s1; ++s) { if (sp == 7) peer_slice_phase<false>(p, s, tb, ts, lane, p.out, xo, last); else peer_slice_phase<true>(p, s, tb, ts, lane, p.out, xo, last); }
  } break;
  case 8: {
    const u16* pd = (const u16*)(p.ws + WS_PD); const float* eg = (const float*)(p.ws + WS_EGATE); u16* cc = (u16*)(p.ws + WS_CC); float* cs = (float*)(p.ws + WS_CS);
    for (int t = vb * 8 + wid; t < T; t += nb * 8) {
      f32x2 a = {0.f, 0.f};
#pragma unroll
      for (int s = 0; s < 8; ++s) { const unsigned w = *(const unsigned*)(pd + ((size_t)s * T + t) * 128 + 2 * lane); a.x += bflo(w); a.y += bfhi(w); }
      const f32x2 g = *(const f32x2*)(eg + (size_t)t * 128 + 2 * lane);
      const float c0 = gelu_erf(a.x * (1.f / PEER_SU)) * g.x, c1 = gelu_erf(a.y * (1.f / PEER_SU)) * g.y;
      float mx = fmaxf(fabsf(c0), fabsf(c1));
#pragma unroll
      for (int o = 1; o < 64; o <<= 1) mx = fmaxf(mx, __shfl_xor(mx, o));
      const float st = fmaxf(mx, 1e-30f) * (1.f / 127.f), ist = 1.f / st;
      int q0 = __float2int_rn(c0 * ist), q1 = __float2int_rn(c1 * ist);
      cc[(size_t)t * 64 + lane] = (u16)(((unsigned)q0 & 255u) | (((unsigned)q1 & 255u) << 8));
      if (lane == 0) cs[t] = st * (1.f / PEER_SV);
    }
  } break;
  }
}

#define XB_TMO      128
#define XB_XCNT(j)  (256  + 64 * (j))
#define XB_XSUB(j)  (1280 + 64 * (j))
#define XB_XGEN(j)  (2304 + 64 * (j))
#define XB_TOP      3328
#define XB_TOPGEN   3392
#define XCD_BAR_WORDS 3456
#define XB_SPIN_CAP (1u << 23)
DEVI unsigned xb_ld(unsigned* p) { return __hip_atomic_load(p, __ATOMIC_RELAXED, __HIP_MEMORY_SCOPE_AGENT); }
DEVI unsigned xb_add(unsigned* p, unsigned v) { return __hip_atomic_fetch_add(p, v, __ATOMIC_RELAXED, __HIP_MEMORY_SCOPE_AGENT); }
DEVI unsigned xb_xcc_id() { return (unsigned)__builtin_amdgcn_s_getreg((3 << 11) | 20) & 0xFu; }
#define XB_SPIN(cond, bar) do { unsigned _sp = 0; while (cond) { __builtin_amdgcn_s_sleep(1); \
    if ((++_sp & 255u) == 0u) { if (xb_ld(&(bar)[XB_TMO])) break; if (_sp > XB_SPIN_CAP) { atomicAdd(&(bar)[XB_TMO], 1u); break; } } } } while (0)
struct XcdBarrier { unsigned* bar; unsigned x; volatile unsigned* st; };
DEVI XcdBarrier xcd_barrier_post(unsigned* bar, volatile unsigned* st) {
  XcdBarrier b; b.bar = bar; b.x = xb_xcc_id(); b.st = st;
  if (threadIdx.x == 0) (void)xb_add(&bar[XB_XCNT(b.x)], 1u);
  return b;
}
DEVI void xcd_barrier_complete(unsigned* bar, unsigned x, unsigned& nloc, unsigned& nx) {
  const unsigned G = gridDim.x * gridDim.y * gridDim.z;
  unsigned sum, cnt, mine, sp = 0u;
  for (;;) {
    sum = 0u; cnt = 0u; mine = 0u;
#pragma unroll
    for (unsigned j = 0; j < 16; ++j) { const unsigned c = xb_ld(&bar[XB_XCNT(j)]); sum += c; cnt += (c > 0u) ? 1u : 0u; mine = (j == x) ? c : mine; }
    if (sum == G) break;
    __builtin_amdgcn_s_sleep(1);
    if ((++sp & 255u) == 0u) { if (xb_ld(&bar[XB_TMO])) break; if (sp > XB_SPIN_CAP) { atomicAdd(&bar[XB_TMO], 1u); break; } }
  }
  nloc = mine > 0u ? mine : 1u; nx = cnt > 0u ? cnt : 1u;
}
DEVI void xcd_barrier(const XcdBarrier& b) {
  asm volatile("s_waitcnt vmcnt(0)" ::: "memory");
  __syncthreads();
  if (threadIdx.x == 0) {
    unsigned* bar = b.bar;
    __builtin_amdgcn_s_waitcnt(0);
    unsigned nloc = b.st[0], nx = b.st[1];
    if (nloc == 0u) { xcd_barrier_complete(bar, b.x, nloc, nx); b.st[0] = nloc; b.st[1] = nx; }
    const unsigned old = xb_add(&bar[XB_XSUB(b.x)], 1u);
    const unsigned gen = old / nloc;
    if (old + 1u == (gen + 1u) * nloc) {
      __builtin_amdgcn_fence(__ATOMIC_RELEASE, "agent");
      asm volatile("s_waitcnt vmcnt(0)" ::: "memory");
      const unsigned og = xb_add(&bar[XB_TOP], 1u);
      const unsigned tg = og / nx;
      if (og + 1u == (tg + 1u) * nx) xb_add(&bar[XB_TOPGEN], 1u);
      else XB_SPIN(xb_ld(&bar[XB_TOPGEN]) == tg, bar);
      __builtin_amdgcn_fence(__ATOMIC_ACQUIRE, "agent");
      xb_add(&bar[XB_XGEN(b.x)], 1u);
      asm volatile("s_waitcnt vmcnt(0)" ::: "memory");
    } else {
      XB_SPIN(xb_ld(&bar[XB_XGEN(b.x)]) == gen, bar);
      __builtin_amdgcn_fence(__ATOMIC_ACQUIRE, "agent");
      asm volatile("s_waitcnt vmcnt(0)" ::: "memory");
    }
  }
  __syncthreads();
}

__global__ void __launch_bounds__(NTHREADS, 2) mega(Params p) {
  extern __shared__ __attribute__((aligned(16))) char smem[];
  cg::grid_group grid = cg::this_grid();
  const int nb = gridDim.x, vb = blockIdx.x;
  volatile unsigned* st = (volatile unsigned*)(smem + LDS_BYTES - 16);
  if (threadIdx.x == 0) { st[0] = 0u; st[1] = 0u; }
  __syncthreads();
  const XcdBarrier bar = xcd_barrier_post((unsigned*)p.ws, st);
#define GRID_BAR(first) do { if (first) grid.sync(); else xcd_barrier(bar); } while (0)
  for (int ph = p.ph_lo; ph < p.ph_hi; ++ph) {
#ifdef PROBE_DUP
    if (ph > 0 && ph < N_PHASES - 1 && ((PROBE_DUP >> ((ph - 1) % PH_PER_LAYER)) & 1)) { run_phase(p, ph + 100, vb, nb, smem); GRID_BAR(false); }
#endif
    run_phase(p, ph, vb, nb, smem);
    if (ph + 1 < p.ph_hi) GRID_BAR(ph == p.ph_lo);
  }
}

#ifndef N_LAUNCH_SPLIT
#define N_LAUNCH_SPLIT 0
#endif
extern "C" void kernel_launch(void* const* d_in, const int* in_sizes, int n_in, void* d_out, int out_size, void* d_ws, size_t ws_size, hipStream_t stream) {
  static int grid_blocks = 0;
  if (grid_blocks == 0) {
    if (n_in != 24 || out_size != T * DM || ws_size < WS_NEED) { fprintf(stderr, "kernel_launch: unexpected shapes n_in %d out %d ws %zu\n", n_in, out_size, ws_size); grid_blocks = -1; return; }
    int dev = 0, cus = 0, per_cu = 0;
    (void)hipGetDevice(&dev); (void)hipDeviceGetAttribute(&cus, hipDeviceAttributeMultiprocessorCount, dev);
    if (hipFuncSetAttribute((const void*)mega, hipFuncAttributeMaxDynamicSharedMemorySize, LDS_BYTES) != hipSuccess) { fprintf(stderr, "kernel_launch: hipFuncSetAttribute failed\n"); grid_blocks = -1; return; }
    if (hipOccupancyMaxActiveBlocksPerMultiprocessor(&per_cu, (const void*)mega, NTHREADS, LDS_BYTES) != hipSuccess || per_cu < 1) { fprintf(stderr, "kernel_launch: occupancy query failed (%d)\n", per_cu); grid_blocks = -1; return; }
    grid_blocks = cus * 1;
    fprintf(stderr, "kernel_launch: cus %d per_cu %d grid %d\n", cus, per_cu, grid_blocks);
  }
  if (grid_blocks < 0) return;
  if (hipMemsetAsync(d_ws, 0, 65536, stream) != hipSuccess) { fprintf(stderr, "kernel_launch: memset failed\n"); return; }
  Params p{};
  p.x = (const float*)d_in[0]; p.pos = (const int*)d_in[1]; p.norm_mix = (const float*)d_in[2]; p.w_in = (const float*)d_in[3]; p.q_norm = (const float*)d_in[4];
  p.w_uq = (const float*)d_in[5]; p.kv_norm = (const float*)d_in[6]; p.w_ukv = (const float*)d_in[7]; p.conv_w = (const float*)d_in[8]; p.conv_b = (const float*)d_in[9];
  p.lru_wa = (const float*)d_in[10]; p.lru_ba = (const float*)d_in[11]; p.lru_wx = (const float*)d_in[12]; p.lru_bx = (const float*)d_in[13]; p.lru_lambda = (const float*)d_in[14];
  p.swa_sink = (const float*)d_in[15]; p.grp_norm = (const float*)d_in[16]; p.w_out = (const float*)d_in[17]; p.norm_ffn = (const float*)d_in[18]; p.peer_wq = (const float*)d_in[19];
  p.peer_subkeys = (const float*)d_in[20]; p.peer_u = (const float*)d_in[21]; p.peer_v = (const float*)d_in[22]; p.norm_final = (const float*)d_in[23];
  p.out = (float*)d_out; p.ws = (unsigned char*)d_ws;
#if N_LAUNCH_SPLIT
  for (int ph = 0; ph < N_PHASES; ++ph) {
    p.ph_lo = ph; p.ph_hi = ph + 1;
    void* args[] = {&p};
    hipError_t e = hipLaunchCooperativeKernel((const void*)mega, dim3(grid_blocks), dim3(NTHREADS), args, LDS_BYTES, stream);
    if (e != hipSuccess) { fprintf(stderr, "kernel_launch: launch of phase %d failed: %s\n", ph, hipGetErrorString(e)); break; }
  }
#else
  p.ph_lo = 0; p.ph_hi = N_PHASES;
  void* args[] = {&p};
  hipError_t e = hipLaunchCooperativeKernel((const void*)mega, dim3(grid_blocks), dim3(NTHREADS), args, LDS_BYTES, stream);
  if (e != hipSuccess) fprintf(stderr, "kernel_launch: cooperative launch failed: %s (grid %d)\n", hipGetErrorString(e), grid_blocks);
#endif
}
```

```cpp
#include <hip/hip_runtime.h>
#include <hip/hip_cooperative_groups.h>
#include <cstdio>
#include <cstdint>
namespace cg = cooperative_groups;

#define DEVI __device__ __forceinline__
typedef unsigned short u16;
typedef short bf16x8 __attribute__((ext_vector_type(8)));
typedef short s16x4 __attribute__((ext_vector_type(4)));
typedef float f32x2 __attribute__((ext_vector_type(2)));
typedef float f32x4 __attribute__((ext_vector_type(4)));
typedef float f32x16 __attribute__((ext_vector_type(16)));
typedef unsigned u32x4 __attribute__((ext_vector_type(4)));
typedef unsigned u32x2 __attribute__((ext_vector_type(2)));
typedef __bf16 bf16x2_t __attribute__((ext_vector_type(2)));

constexpr int NB = 4, SEQ = 8192, T = NB * SEQ, DM = 1024, DEPTH = 2;
constexpr int MLA_H = 6, MLA_QK = 96, MLA_V = 64;
constexpr int LRU_W = 384;
constexpr int INW = 1696, INWP = 1792;
constexpr int PC_CQ = 0, PC_CKV = 256, PC_SQ = 384, PC_SK = 640, PC_SV = 768, PC_LX = 896, PC_LG = 1280, PC_KR = 1664;
constexpr int OC_CQ = 0, OC_CKV = 256, OC_KR = 384, OC_SQ = 416, OC_SK = 672, OC_SV = 800, OC_LX = 928, OC_LG = 1312;
constexpr int NEXP = 16384;
constexpr float EPS = 1e-6f;
constexpr int NTHREADS = 512;
constexpr int LDS_BYTES = 160 * 1024;

constexpr size_t MiB = 1u << 20;
constexpr size_t WS_CTL = 0;
constexpr size_t WS_WIN = 4 * MiB;
constexpr size_t WS_WQ = 11 * MiB;
constexpr size_t WS_WOUT = 19 * MiB;
constexpr size_t WS_WUQ = 23 * MiB;
constexpr size_t WS_WUKV = WS_WUQ + 2 * 768 * 256 * 2;
constexpr size_t WS_WLRU = WS_WUKV + 2 * 768 * 128 * 2;
constexpr size_t WS_SUBK = WS_WLRU + 2 * 6 * 2 * 128 * 64 * 2;
constexpr size_t WS_XG = 25 * MiB;
constexpr size_t WS_R1 = 89 * MiB;
constexpr size_t WS_QM = 217 * MiB;
constexpr size_t WS_KM = 253 * MiB;
constexpr size_t WS_VM = 289 * MiB;
constexpr size_t WS_LE = 313 * MiB;
constexpr size_t WS_LB = 361 * MiB;
constexpr size_t WS_MIX = 409 * MiB;
constexpr size_t WS_UB = 478 * MiB;
constexpr size_t WS_VB = 494 * MiB;
constexpr size_t WS_TOP = 281 * MiB;
constexpr size_t WS_EIDX = 313 * MiB;
constexpr size_t WS_EGATE = 329 * MiB;
constexpr size_t WS_CC = 345 * MiB;
constexpr size_t WS_SSQ = 361 * MiB;
constexpr size_t WS_SSQ16 = 363 * MiB;
constexpr size_t WS_SSQQ = 476 * MiB;
constexpr size_t WS_SSQKV = 477 * MiB;
constexpr size_t WS_PD = 89 * MiB;
constexpr float PEER_SU = 903.f, PEER_SV = 56.f;
constexpr size_t WS_CS = 349 * MiB;
constexpr size_t WS_XQ = 249 * MiB;
constexpr size_t WS_SX = 281 * MiB;
constexpr size_t WS_END = 473 * MiB;

__device__ const float ROPE_HI[32] = {1.591549367e-01f, 1.193493679e-01f, 8.949939907e-02f, 6.711508334e-02f, 5.032921210e-02f, 3.774158657e-02f, 2.830219641e-02f, 2.122365311e-02f, 1.591549441e-02f, 1.193493698e-02f, 8.949940093e-03f, 6.711508147e-03f, 5.032921210e-03f, 3.774158424e-03f, 2.830219688e-03f, 2.122365171e-03f, 1.591549488e-03f, 1.193493721e-03f, 8.949940093e-04f, 6.711508031e-04f, 5.032921326e-04f, 3.774158540e-04f, 2.830219455e-04f, 2.122365258e-04f, 1.591549371e-04f, 1.193493736e-04f, 8.949940093e-05f, 6.711508468e-05f, 5.032921035e-05f, 3.774158540e-05f, 2.830219637e-05f, 2.122365186e-05f};
__device__ const float ROPE_LO[32] = {6.420638243e-09f, 2.294664903e-09f, 2.542919653e-09f, -3.316028840e-10f, 5.173299289e-12f, -1.848551645e-09f, -5.826552019e-10f, -3.431038786e-10f, -1.029942243e-10f, 4.320196978e-11f, 6.802744479e-11f, 1.531042237e-10f, 5.173301024e-13f, 4.797548470e-11f, -1.048316434e-10f, 1.053879969e-10f, -5.686555046e-11f, -1.896286773e-11f, 6.802744999e-12f, 2.695195456e-11f, -1.158979943e-11f, -6.843983713e-12f, 1.279990003e-11f, 1.807650600e-12f, 5.954976963e-12f, -3.351478166e-12f, 6.802744674e-13f, -1.670379113e-12f, 1.751403167e-12f, -6.843983930e-13f, -5.389994549e-13f, 9.083608431e-13f};

DEVI int tidx() { int t = __builtin_amdgcn_workitem_id_x(); asm volatile("" : "+v"(t)); return t; }
DEVI float bf2f(unsigned h) { return __uint_as_float(h << 16); }
DEVI float bflo(unsigned w) { return __uint_as_float(w << 16); }
DEVI float bfhi(unsigned w) { return __uint_as_float(w & 0xffff0000u); }
DEVI unsigned pk2(float lo, float hi) { f32x2 v = {lo, hi}; bf16x2_t b = __builtin_convertvector(v, bf16x2_t); return __builtin_bit_cast(unsigned, b); }
DEVI u16 f2bf(float f) { return (u16)(pk2(f, 0.f) & 0xffffu); }
DEVI u32x4 pk8(const float* v) { u32x4 w; w.x = pk2(v[0], v[1]); w.y = pk2(v[2], v[3]); w.z = pk2(v[4], v[5]); w.w = pk2(v[6], v[7]); return w; }
DEVI void unpk8(u32x4 w, float* v) { v[0] = bflo(w.x); v[1] = bfhi(w.x); v[2] = bflo(w.y); v[3] = bfhi(w.y); v[4] = bflo(w.z); v[5] = bfhi(w.z); v[6] = bflo(w.w); v[7] = bfhi(w.w); }
DEVI void ld8(const float* p, float* v) { const f32x4 a = *(const f32x4*)p, b = *(const f32x4*)(p + 4); v[0] = a.x; v[1] = a.y; v[2] = a.z; v[3] = a.w; v[4] = b.x; v[5] = b.y; v[6] = b.z; v[7] = b.w; }
DEVI int crow(int r, int hi) { return (r & 3) + 8 * (r >> 2) + 4 * hi; }
DEVI float wave_sum(float v) {
#pragma unroll
  for (int o = 1; o < 64; o <<= 1) v += __shfl_xor(v, o);
  return v;
}
DEVI void rope_sc(float pos, int fidx, float& sn, float& cs) {
  const float chi = ROPE_HI[fidx], clo = ROPE_LO[fidx];
  const float t = pos * chi, e = fmaf(pos, chi, -t);
  float fr = t - rintf(t);
  fr = fr + (e + pos * clo);
  sn = __builtin_amdgcn_sinf(fr); cs = __builtin_amdgcn_cosf(fr);
}
DEVI float sigmoidf_(float x) { return 1.f / (1.f + __expf(-x)); }
DEVI float gelu_erf(float x) { return 0.5f * x * (1.f + erff(x * 0.70710678118654752f)); }

struct Params {
  const float* x; const int* pos; const float* norm_mix; const float* w_in; const float* q_norm; const float* w_uq; const float* kv_norm; const float* w_ukv;
  const float* conv_w; const float* conv_b; const float* lru_wa; const float* lru_ba; const float* lru_wx; const float* lru_bx; const float* lru_lambda;
  const float* swa_sink; const float* grp_norm; const float* w_out; const float* norm_ffn; const float* peer_wq; const float* peer_subkeys;
  const float* peer_u; const float* peer_v; const float* norm_final;
  float* out; unsigned char* ws;
  int ph_lo, ph_hi;
};

DEVI void tconv_item(const float* W, int ldw, int src_c0, u16* WT, int K, int dst_r0, const float* gain, float* scr, int kb, int nb, int lane, int pg = 0) {
  const int k0 = 64 * kb, n0 = 32 * nb;
#pragma unroll 8
  for (int i = 0; i < 32; ++i) { const int kk = 2 * i + (lane >> 5); float g = gain ? gain[k0 + kk] : 1.f; scr[kk * 33 + (lane & 31)] = g * W[(size_t)(k0 + kk) * ldw + src_c0 + n0 + (lane & 31)]; }
  __builtin_amdgcn_s_waitcnt(0xc07f); asm volatile("" ::: "memory");
  const int c = lane & 7;
#pragma unroll
  for (int j = 0; j < 4; ++j) { const int n = (lane >> 3) + 8 * j; const float* s = scr + (8 * c) * 33 + n;
    u32x4 o; o.x = pk2(s[0 * 33], s[1 * 33]); o.y = pk2(s[2 * 33], s[3 * 33]); o.z = pk2(s[4 * 33], s[5 * 33]); o.w = pk2(s[6 * 33], s[7 * 33]);
    int nn = n0 + n; if (pg > 0) { const int g = nn & ~(pg - 1), i = nn & (pg - 1), hw = pg >> 1; nn = g + (i < hw ? 2 * i : 2 * (i - hw) + 1); }
    else if (pg < 0) { const int j = nn % 96; if (j >= 64) { const int i = j - 64; nn = nn - i + (i < 16 ? 2 * i : 2 * (i - 16) + 1); } }
    *(u32x4*)(WT + (size_t)(dst_r0 + nn) * K + k0 + 8 * c) = o; }
  __builtin_amdgcn_s_waitcnt(0xc07f); asm volatile("" ::: "memory");
}

DEVI void p0_item(const Params& p, int it, float* scr, int lane) {
  const int l = it / 2552; int r = it - l * 2552;
  const float* win = p.w_in + (size_t)l * DM * INW; u16* wint = (u16*)(p.ws + WS_WIN) + (size_t)l * INWP * DM; const float* gm = p.norm_mix + l * DM;
#define SEG(W, ldw, sc0, ncols, WT, K, dr0, gain, pg) { const int nnb_ = (ncols) / 32, ni_ = ((K) / 64) * nnb_; if (r < ni_) { tconv_item(W, ldw, sc0, WT, K, dr0, gain, scr, r / nnb_, r % nnb_, lane, pg); return; } r -= ni_; }
  SEG(win, INW, OC_CQ, 256, wint, DM, PC_CQ, gm, 0)
  SEG(win, INW, OC_CKV, 128, wint, DM, PC_CKV, gm, 0)
  SEG(win, INW, OC_SQ, 256, wint, DM, PC_SQ, gm, 64)
  SEG(win, INW, OC_SK, 128, wint, DM, PC_SK, gm, 64)
  SEG(win, INW, OC_SV, 128, wint, DM, PC_SV, gm, 0)
  SEG(win, INW, OC_LX, 384, wint, DM, PC_LX, gm, 0)
  SEG(win, INW, OC_LG, 384, wint, DM, PC_LG, gm, 0)
  SEG(win, INW, OC_KR, 32, wint, DM, PC_KR, gm, 32)
  SEG(p.peer_wq + (size_t)l * DM * 2048, 2048, 0, 2048, (u16*)(p.ws + WS_WQ) + (size_t)l * 2048 * DM, DM, 0, p.norm_ffn + l * DM, 0)
  SEG(p.w_out + (size_t)l * DM * DM, DM, 0, DM, (u16*)(p.ws + WS_WOUT) + (size_t)l * DM * DM, DM, 0, p.grp_norm + l * DM, 0)
  SEG(p.w_uq + (size_t)l * 256 * 576, 576, 0, 576, (u16*)(p.ws + WS_WUQ) + (size_t)l * 768 * 256, 256, 0, p.q_norm + l * 256, -1)
  SEG(p.w_ukv + (size_t)l * 128 * 768, 768, 0, 768, (u16*)(p.ws + WS_WUKV) + (size_t)l * 768 * 128, 128, 0, p.kv_norm + l * 128, 0)
#undef SEG
  { const int nbk = r & 1, ax = (r >> 1) & 1, n = (r >> 2) % 6, d = (r >> 2) / 6;
    const float* W = (ax ? p.lru_wx : p.lru_wa) + ((size_t)(l * 2 + d) * 6 + n) * 4096;
    u16* WT = (u16*)(p.ws + WS_WLRU) + ((size_t)((l * 6 + n) * 2 + d)) * 128 * 64;
    tconv_item(W, 64, 0, WT, 64, 32 * nbk + 32 * ax, nullptr, scr, 0, nbk, lane); }
}

DEVI void phase0(const Params& p, int vb, int nb, char* lds) {
  const int tid = tidx(), lane = tid & 63, wid = tid >> 6;
  float* scr = (float*)(lds + wid * 16384);
  const int gw = vb * 8 + wid, ngw = nb * 8;
  for (int it = gw; it < DEPTH * 2552; it += ngw) p0_item(p, it, scr, lane);
  for (int i = vb * NTHREADS + tid; i < DEPTH * 96 * DM / 8; i += nb * NTHREADS) { const int l = i / (96 * DM / 8), r = i % (96 * DM / 8);
    *(u32x4*)((u16*)(p.ws + WS_WIN) + ((size_t)l * INWP + INW) * DM + (size_t)r * 8) = (u32x4){0, 0, 0, 0}; }
  for (int i = vb * NTHREADS + tid; i < DEPTH * 192 * 256 / 8; i += nb * NTHREADS) { const int l = i / (192 * 256 / 8), r = i % (192 * 256 / 8);
    *(u32x4*)((u16*)(p.ws + WS_WUQ) + ((size_t)l * 768 + 576) * 256 + (size_t)r * 8) = (u32x4){0, 0, 0, 0}; }
  for (int i = vb * NTHREADS + tid; i < DEPTH * 2 * 128 * 128 / 8; i += nb * NTHREADS) {
    float a[8]; ld8(p.peer_subkeys + (size_t)i * 8, a);
    *(u32x4*)((u16*)(p.ws + WS_SUBK) + (size_t)i * 8) = pk8(a); }
  { float* ssq = (float*)(p.ws + WS_SSQ); u16* xg = (u16*)(p.ws + WS_XG);
    for (int t = gw * 2; t < T; t += ngw * 2) {
      float a[2][16];
#pragma unroll
      for (int u = 0; u < 2; ++u) { ld8(p.x + (size_t)(t + u) * DM + lane * 16, a[u]); ld8(p.x + (size_t)(t + u) * DM + lane * 16 + 8, a[u] + 8); }
#pragma unroll
      for (int u = 0; u < 2; ++u) { float s = 0.f;
#pragma unroll
        for (int q = 0; q < 16; ++q) s = fmaf(a[u][q], a[u][q], s);
        s += __shfl_xor(s, 1); s += __shfl_xor(s, 2); s += __shfl_xor(s, 4);
        if ((lane & 7) == 0) ssq[(size_t)(t + u) * 8 + (lane >> 3)] = s;
        u32x4* o = (u32x4*)(xg + (size_t)(t + u) * DM + lane * 16); o[0] = pk8(a[u]); o[1] = pk8(a[u] + 8); } } }
}

DEVI int swz(int row, int c) { return row * 128 + ((c ^ ((row >> 1) & 7)) << 4); }
constexpr int CLD = 132;
constexpr int LDS_RS = 135168;

struct GemmDesc {
  const u16* A; int lda; const u16* Bt; int ldb; int KT;
  float inv0;
  const u16* proj; const float* cw; const float* cb; int ch0;
};

template <int AMODE> DEVI bf16x8 load_a(const GemmDesc& g, int row, int kcol) {
  if constexpr (AMODE == 0) {
    return *(const bf16x8*)(g.A + (size_t)row * g.lda + kcol);
  } else {
    const int s = row & (SEQ - 1), ch = g.ch0 + kcol;
    float a[8];
    { const f32x4 b0 = *(const f32x4*)(g.cb + ch), b1 = *(const f32x4*)(g.cb + ch + 4); a[0] = b0.x; a[1] = b0.y; a[2] = b0.z; a[3] = b0.w; a[4] = b1.x; a[5] = b1.y; a[6] = b1.z; a[7] = b1.w; }
#pragma unroll
    for (int tap = 0; tap < 4; ++tap) {
      const int ss = s - 1 + tap;
      if (ss >= 0 && ss < SEQ) {
        const u32x4 v = *(const u32x4*)(g.proj + (size_t)(row - 1 + tap) * INWP + PC_LX + ch);
        float x[8]; unpk8(v, x);
        const f32x4 w0 = *(const f32x4*)(g.cw + tap * LRU_W + ch), w1 = *(const f32x4*)(g.cw + tap * LRU_W + ch + 4);
        a[0] += w0.x * x[0]; a[1] += w0.y * x[1]; a[2] += w0.z * x[2]; a[3] += w0.w * x[3];
        a[4] += w1.x * x[4]; a[5] += w1.y * x[5]; a[6] += w1.z * x[6]; a[7] += w1.w * x[7];
      }
    }
    const u32x4 o = pk8(a);
    return __builtin_bit_cast(bf16x8, o);
  }
}

template <int AMODE> DEVI void g_load(const GemmDesc& g, bf16x8 (&ar)[4], bf16x8 (&br)[2], int m0, int n0, int srow, int sc, int kt) {
#pragma unroll
  for (int i = 0; i < 4; ++i) ar[i] = load_a<AMODE>(g, m0 + srow + 64 * i, kt * 64 + sc * 8);
#pragma unroll
  for (int i = 0; i < 2; ++i) br[i] = *(const bf16x8*)(g.Bt + (size_t)(n0 + srow + 64 * i) * g.ldb + kt * 64 + sc * 8);
}
template <bool NORM> DEVI void g_write(char* Ab, const bf16x8 (&ar)[4], const bf16x8 (&br)[2], float (&ssq)[4], int srow, int sc) {
  char* Bb = Ab + 32768;
#pragma unroll
  for (int i = 0; i < 4; ++i) { *(bf16x8*)(Ab + swz(srow + 64 * i, sc)) = ar[i];
    if (NORM) { float x[8]; unpk8(__builtin_bit_cast(u32x4, ar[i]), x); float s = ssq[i];
#pragma unroll
      for (int q = 0; q < 8; ++q) s = fmaf(x[q], x[q], s);
      ssq[i] = s; } }
#pragma unroll
  for (int i = 0; i < 2; ++i) *(bf16x8*)(Bb + swz(srow + 64 * i, sc)) = br[i];
}

template <int AMODE, int SEG>
DEVI void gemm_core(const GemmDesc& g, int m0, int n0, char* lds) {
  const int tid = tidx(), lane = tid & 63, wid = tid >> 6;
  const int wm = wid >> 1, wn = wid & 1, r32 = lane & 31, hi = lane >> 5;
  const int srow = tid >> 3, sc = tid & 7;
  constexpr bool NORM = SEG != 0;
  float* rs = (float*)(lds + LDS_RS);
  f32x16 acc[2][2], acc2[2][2];
#pragma unroll
  for (int i = 0; i < 2; ++i)
#pragma unroll
    for (int j = 0; j < 2; ++j) { acc[i][j] = f32x16{}; acc2[i][j] = f32x16{}; }
  float ssq[4] = {0.f, 0.f, 0.f, 0.f};
  bf16x8 ar[4], br[2];
  g_load<AMODE>(g, ar, br, m0, n0, srow, sc, 0); g_write<NORM>(lds, ar, br, ssq, srow, sc); __syncthreads();
  int seg = 0;
#pragma unroll 1
  for (int kt = 0; kt < g.KT; ++kt) {
    const int cur = kt & 1;
    if (kt + 1 < g.KT) g_load<AMODE>(g, ar, br, m0, n0, srow, sc, kt + 1);
    { const char* Ab = lds + cur * 49152; const char* Bb = Ab + 32768;
#pragma unroll
      for (int k16 = 0; k16 < 4; ++k16) {
        bf16x8 a[2], b[2];
#pragma unroll
        for (int mt = 0; mt < 2; ++mt) a[mt] = *(const bf16x8*)(Ab + swz(wm * 64 + mt * 32 + r32, k16 * 2 + hi));
#pragma unroll
        for (int nt = 0; nt < 2; ++nt) b[nt] = *(const bf16x8*)(Bb + swz(wn * 64 + nt * 32 + r32, k16 * 2 + hi));
#pragma unroll
        for (int mt = 0; mt < 2; ++mt)
#pragma unroll
          for (int nt = 0; nt < 2; ++nt) {
            if (NORM) acc2[mt][nt] = __builtin_amdgcn_mfma_f32_32x32x16_bf16(a[mt], b[nt], acc2[mt][nt], 0, 0, 0);
            else acc[mt][nt] = __builtin_amdgcn_mfma_f32_32x32x16_bf16(a[mt], b[nt], acc[mt][nt], 0, 0, 0);
          }
      } }
    if (NORM) {
      int se; float inv;
      if (SEG == 1) { se = g.KT; inv = g.inv0; }
      else { se = seg == 0 ? 6 : (seg == 1 ? 12 : 16); inv = seg == 2 ? (1.f / 256.f) : (1.f / 384.f); }
      if (kt + 1 == se) {
#pragma unroll
        for (int i = 0; i < 4; ++i) { float s = ssq[i]; s += __shfl_xor(s, 1); s += __shfl_xor(s, 2); s += __shfl_xor(s, 4); if (sc == 0) rs[srow + 64 * i] = rsqrtf(s * inv + EPS); }
        __syncthreads();
#pragma unroll
        for (int mt = 0; mt < 2; ++mt)
#pragma unroll
          for (int r = 0; r < 16; ++r) { const float f = rs[wm * 64 + mt * 32 + crow(r, hi)];
#pragma unroll
            for (int nt = 0; nt < 2; ++nt) { acc[mt][nt][r] = fmaf(f, acc2[mt][nt][r], acc[mt][nt][r]); acc2[mt][nt][r] = 0.f; } }
        ssq[0] = ssq[1] = ssq[2] = ssq[3] = 0.f;
        ++seg;
      }
    }
    if (kt + 1 < g.KT) g_write<NORM>(lds + (cur ^ 1) * 49152, ar, br, ssq, srow, sc);
    __syncthreads();
  }
  float* C = (float*)lds;
#pragma unroll
  for (int mt = 0; mt < 2; ++mt)
#pragma unroll
    for (int nt = 0; nt < 2; ++nt)
#pragma unroll
      for (int r = 0; r < 16; ++r) C[(wm * 64 + mt * 32 + crow(r, hi)) * CLD + wn * 64 + nt * 32 + r32] = acc[mt][nt][r];
  __syncthreads();
}
template <int AMODE, int SEG, class Epi>
DEVI void gemm_tile(const GemmDesc& g, int m0, int n0, char* lds, const Epi& epi) {
  gemm_core<AMODE, SEG>(g, m0, n0, lds);
  epi((const float*)lds, m0, n0);
  __syncthreads();
}

DEVI GemmDesc gemm_desc(const u16* A, int lda, const u16* Bt, int ldb, int K) {
  GemmDesc g{}; g.A = A; g.lda = lda; g.Bt = Bt; g.ldb = ldb; g.KT = K / 64; g.inv0 = 1.f / (float)K; return g;
}


template <int HW> DEVI void rope8(float* v, const float* pp, int i0, float posf) {
  const bool first = i0 < HW; const int f0 = i0 & (HW - 1);
#pragma unroll
  for (int j = 0; j < 8; ++j) { float sn, cs; rope_sc(posf, HW == 32 ? (f0 + j) : 2 * (f0 + j), sn, cs); const float pv = pp[j]; v[j] = first ? v[j] * cs - pv * sn : v[j] * cs + pv * sn; }
}

struct EpiP1 { u16* proj; const int* pos;
  DEVI void operator()(const float* C, int m0, int n0) const {
    const int tid = tidx();
#pragma unroll 1
    for (int it = 0; it < 8; ++it) { const int item = it * NTHREADS + tid, row = item >> 4, c8 = (item & 15) * 8, gcol = n0 + c8, grow = m0 + row;
      float v[8]; ld8(C + row * CLD + c8, v);
      const bool r64 = gcol >= PC_SQ && gcol < PC_SV, r32g = gcol >= PC_KR && gcol < PC_KR + 32;
      if (r64) { const int i0 = gcol & 63; float pp[8]; ld8(C + row * CLD + c8 + (i0 < 32 ? 32 : -32), pp); rope8<32>(v, pp, i0, (float)pos[grow]); }
      else if (r32g) { const int i0 = gcol & 31; float pp[8]; ld8(C + row * CLD + c8 + (i0 < 16 ? 16 : -16), pp); rope8<16>(v, pp, i0, (float)pos[grow]); }
      *(u32x4*)(proj + (size_t)grow * INWP + gcol) = pk8(v);
    }
  }
};

struct EpiQ { u16* qm; const int* pos;
  DEVI void operator()(const float* C, int m0, int n0) const {
    const int tid = tidx();
#pragma unroll 1
    for (int it = 0; it < 8; ++it) { const int item = it * NTHREADS + tid, row = item >> 4, c8 = (item & 15) * 8, gcol = n0 + c8, grow = m0 + row;
      if (gcol >= 576) continue;
      const int head = gcol / 96, j0 = gcol - head * 96, b = grow >> 13, s = grow & (SEQ - 1);
      float v[8]; ld8(C + row * CLD + c8, v);
      u16* qrow = qm + ((size_t)(b * MLA_H + head) * SEQ + s) * MLA_QK;
      if (j0 >= 64) { const int i0 = j0 - 64; float pp[8]; ld8(C + row * CLD + c8 + (i0 < 16 ? 16 : -16), pp); rope8<16>(v, pp, i0, (float)pos[grow]);
#pragma unroll
        for (int j = 0; j < 8; ++j) { const int i = i0 + j; qrow[64 + (i < 16 ? 2 * i : 2 * (i - 16) + 1)] = f2bf(v[j]); } }
      else *(u32x4*)(qrow + j0) = pk8(v);
    }
  }
};

struct EpiKV { u16* km; u16* vm; const u16* proj;
  DEVI void operator()(const float* C, int m0, int n0) const {
    const int tid = tidx(), head = n0 >> 7;
#pragma unroll 1
    for (int it = 0; it < 8; ++it) { const int item = it * NTHREADS + tid, row = item >> 4, c8 = (item & 15) * 8, grow = m0 + row;
      const int b = grow >> 13, s = grow & (SEQ - 1);
      float v[8]; ld8(C + row * CLD + c8, v);
      const size_t tok = (size_t)(b * MLA_H + head) * SEQ + s;
      if (c8 < 64) *(u32x4*)(km + tok * MLA_QK + c8) = pk8(v);
      else *(u32x4*)(vm + tok * MLA_V + (c8 - 64)) = pk8(v);
    }
#pragma unroll 1
    for (int it = 0; it < 2; ++it) { const int item = it * NTHREADS + tid, row = item >> 2, c = (item & 3) * 8, grow = m0 + row;
      const int b = grow >> 13, s = grow & (SEQ - 1);
      *(u32x4*)(km + ((size_t)(b * MLA_H + head) * SEQ + s) * MLA_QK + 64 + c) = *(const u32x4*)(proj + (size_t)grow * INWP + PC_KR + c);
    }
  }
};

struct EpiLRU { const u16* proj; const float* cw; const float* cb; const float* ba; const float* bx; const float* lam; u16* le; u16* lb; int n, d;
  DEVI void operator()(const float* C, int m0, int) const {
    const int tid = tidx();
#pragma unroll 1
    for (int it = 0; it < 4; ++it) { const int item = it * NTHREADS + tid, j = item & 63, g8 = item >> 6;
      const int ch = n * 64 + j, grow0 = m0 + g8 * 8, s0 = grow0 & (SEQ - 1), b = grow0 >> 13;
      const float bav = ba[(d * 6 + n) * 64 + j], bxv = bx[(d * 6 + n) * 64 + j];
      const float cdec = -8.f * log1pf(__expf(-lam[d * LRU_W + ch]));
      float xin[11];
#pragma unroll
      for (int q = 0; q < 11; ++q) { const int ss = s0 - 1 + q; xin[q] = (ss >= 0 && ss < SEQ) ? bf2f(proj[(size_t)(grow0 - 1 + q) * INWP + PC_LX + ch]) : 0.f; }
      const float w0 = cw[ch], w1 = cw[LRU_W + ch], w2 = cw[2 * LRU_W + ch], w3 = cw[3 * LRU_W + ch], cbv = cb[ch];
      float ev[8], bv[8];
#pragma unroll
      for (int rr = 0; rr < 8; ++rr) {
        const float xf = cbv + w0 * xin[rr] + w1 * xin[rr + 1] + w2 * xin[rr + 2] + w3 * xin[rr + 3];
        const float r = sigmoidf_(C[(g8 * 8 + rr) * CLD + j] + bav), ig = sigmoidf_(C[(g8 * 8 + rr) * CLD + 64 + j] + bxv);
        const float a = __expf(cdec * r), e = 1.f - a;
        ev[rr] = e; bv[rr] = sqrtf(e * (2.f - e)) * ig * xf;
      }
      const size_t o = (((size_t)(d * NB + b) * (SEQ / 8) + (s0 >> 3)) * LRU_W + ch) * 8;
      *(u32x4*)(le + o) = pk8(ev); *(u32x4*)(lb + o) = pk8(bv);
    }
  }
};

struct EpiP4 { const float* xres; float* xout; u16* xg;
  DEVI void operator()(const float* C, int m0, int n0) const {
    const int tid = tidx();
#pragma unroll 1
    for (int it = 0; it < 8; ++it) { const int item = it * NTHREADS + tid, row = item >> 4, c8 = (item & 15) * 8, gcol = n0 + c8, grow = m0 + row;
      float v[8], x[8]; ld8(C + row * CLD + c8, v); ld8(xres + (size_t)grow * DM + gcol, x);
#pragma unroll
      for (int j = 0; j < 8; ++j) v[j] += x[j];
      *(f32x4*)(xout + (size_t)grow * DM + gcol) = (f32x4){v[0], v[1], v[2], v[3]}; *(f32x4*)(xout + (size_t)grow * DM + gcol + 4) = (f32x4){v[4], v[5], v[6], v[7]};
      *(u32x4*)(xg + (size_t)grow * DM + gcol) = pk8(v);
    }
  }
};

struct EpiBf16 { u16* o; int ldo;
  DEVI void operator()(const float* C, int m0, int n0) const {
    const int tid = tidx();
#pragma unroll 1
    for (int it = 0; it < 8; ++it) { const int item = it * NTHREADS + tid, row = item >> 4, c8 = (item & 15) * 8;
      float v[8]; ld8(C + row * CLD + c8, v);
      *(u32x4*)(o + (size_t)(m0 + row) * ldo + n0 + c8) = pk8(v);
    }
  }
};

DEVI void ce_desc(float& a, float& b) { const float mx = fmaxf(a, b), mn = fminf(a, b); a = mx; b = mn; }
struct EpiTop { float* top; int hj;
  DEVI void operator()(const float* C, int m0, int) const {
    const int tid = tidx(), row = tid >> 1, part = tid & 1;
    float l[16];
#pragma unroll
    for (int i = 0; i < 16; ++i) l[i] = -3.0e38f;
#pragma unroll 4
    for (int c = 0; c < 64; ++c) { const int col = part * 64 + ((c + row) & 63);
      float v = __uint_as_float((__float_as_uint(C[row * CLD + col]) & ~127u) | (unsigned)(127 - col));
#pragma unroll
      for (int i = 0; i < 16; ++i) { const float t = fmaxf(l[i], v); v = fminf(l[i], v); l[i] = t; } }
    float m[16];
#pragma unroll
    for (int i = 0; i < 16; ++i) m[i] = __shfl_xor(l[15 - i], 1);
#pragma unroll
    for (int i = 0; i < 16; ++i) m[i] = fmaxf(m[i], l[i]);
#pragma unroll
    for (int st = 8; st >= 1; st >>= 1)
#pragma unroll
      for (int i = 0; i < 16; ++i) if ((i & st) == 0) ce_desc(m[i], m[i + st]);
    if (part == 0) { float* o = top + ((size_t)(m0 + row) * 16 + hj) * 16;
#pragma unroll
      for (int i = 0; i < 4; ++i) *(f32x4*)(o + 4 * i) = (f32x4){m[4 * i], m[4 * i + 1], m[4 * i + 2], m[4 * i + 3]}; }
  }
};

#define KSWZ(row, colB) ((row) * 256 + ((colB) ^ (((row) & 15) << 4)))
#define SBAR() __builtin_amdgcn_sched_barrier(0)
constexpr int AT_SHM_V = 64 * 64 * 2, AT_SHM_K = 64 * 128 * 2;
constexpr int AT_LDS = 3 * AT_SHM_V + 2 * AT_SHM_K + 8 * 64 * 4;
constexpr float ATT_THR = 8.f;
DEVI unsigned cvtpk(float lo, float hi) { unsigned r; asm volatile("v_cvt_pk_bf16_f32 %0, %1, %2" : "=v"(r) : "v"(lo), "v"(hi)); return r; }
DEVI int v_st(int k, int c) { const int kk = (k & ~0xC) | ((k & 4) << 1) | ((k & 8) >> 1); return ((kk >> 3) * 2 + (c >> 5)) * 512 + ((kk & 7) * 32 + (c & 31)) * 2; }
DEVI int v_rd_base(int lane) { return ((lane & 3) << 3) | (((lane >> 2) & 3) << 6) | (((lane >> 4) & 1) << 5) | (((lane >> 5) & 1) << 8); }
constexpr int v_rd_off(int d0, int ks, int half) { return d0 * 512 + ks * 2048 + half * 1024; }
template <int OFF> DEVI s16x4 tr_read(int vb) { s16x4 r; asm volatile("ds_read_b64_tr_b16 %0, %1 offset:%2" : "=&v"(r) : "v"(vb), "i"(OFF) : "memory"); return r; }

template <bool MASK, bool FIRST>
DEVI void partialSM(f32x16& p0, f32x16& p1, float& m_reg, float& mn, float& alpha, float SCALE, int kpos0, int qpos, int hi) {
  const float C = SCALE * 1.4426950408889634f;
  if (MASK) {
#pragma unroll
    for (int r = 0; r < 16; ++r) { const int k0 = kpos0 + crow(r, hi) - qpos; const int k1 = k0 + 32;
      if (k0 > 128 || k0 < -128) p0[r] = -1e30f;
      if (k1 > 128 || k1 < -128) p1[r] = -1e30f; }
  }
  if (FIRST) {
    float pmax = p0[0];
#pragma unroll
    for (int r = 1; r < 16; ++r) pmax = fmaxf(pmax, p0[r]);
#pragma unroll
    for (int r = 0; r < 16; ++r) pmax = fmaxf(pmax, p1[r]);
    { auto rr = __builtin_amdgcn_permlane32_swap(__float_as_uint(pmax), __float_as_uint(pmax), false, false);
      pmax = fmaxf(__uint_as_float(rr[0]), __uint_as_float(rr[1])); }
    if (__builtin_expect(__all(pmax - m_reg <= ATT_THR / SCALE), 1)) { mn = m_reg; alpha = 1.f; }
    else { mn = fmaxf(m_reg, pmax); alpha = __builtin_amdgcn_exp2f((m_reg - mn) * C); m_reg = mn; }
    const float mnC = -mn * C;
#pragma unroll
    for (int r = 0; r < 16; ++r) p0[r] = fmaf(p0[r], C, mnC);
#pragma unroll
    for (int r = 0; r < 16; ++r) p1[r] = fmaf(p1[r], C, mnC);
#pragma unroll
    for (int r = 0; r < 16; ++r) p0[r] = __builtin_amdgcn_exp2f(p0[r]);
    return;
  }
  const float mC = -m_reg * C;
#pragma unroll
  for (int r = 0; r < 16; ++r) p0[r] = fmaf(p0[r], C, mC);
#pragma unroll
  for (int r = 0; r < 16; ++r) p1[r] = fmaf(p1[r], C, mC);
  float tmax = p0[0];
#pragma unroll
  for (int r = 1; r < 16; ++r) tmax = fmaxf(tmax, p0[r]);
#pragma unroll
  for (int r = 0; r < 16; ++r) tmax = fmaxf(tmax, p1[r]);
#pragma unroll
  for (int r = 0; r < 16; ++r) p0[r] = __builtin_amdgcn_exp2f(p0[r]);
  { auto rr = __builtin_amdgcn_permlane32_swap(__float_as_uint(tmax), __float_as_uint(tmax), false, false);
    tmax = fmaxf(__uint_as_float(rr[0]), __uint_as_float(rr[1])); }
  mn = m_reg; alpha = 1.f;
  if (__builtin_expect(!__all(tmax <= ATT_THR * 1.4426950408889634f), 0)) {
    const float sh = fmaxf(tmax, 0.f);
    alpha = __builtin_amdgcn_exp2f(-sh); m_reg = m_reg + sh / C; mn = m_reg;
#pragma unroll
    for (int r = 0; r < 16; ++r) { p0[r] *= alpha; p1[r] -= sh; }
  }
}
DEVI void finishSM(f32x16& p0, f32x16& p1, float alpha, float& l_reg, bf16x8& pa0, bf16x8& pa1, bf16x8& pa2, bf16x8& pa3) {
#pragma unroll
  for (int r = 0; r < 16; ++r) p1[r] = __builtin_amdgcn_exp2f(p1[r]);
  float ps = 0;
#pragma unroll
  for (int r = 0; r < 16; ++r) ps += p0[r];
#pragma unroll
  for (int r = 0; r < 16; ++r) ps += p1[r];
  { auto rr = __builtin_amdgcn_permlane32_swap(__float_as_uint(ps), __float_as_uint(ps), false, false);
    ps = __uint_as_float(rr[0]) + __uint_as_float(rr[1]); }
  l_reg = l_reg * alpha + ps;
#define PK4(P, BASE, OUT) do { unsigned a0 = cvtpk(P[BASE + 0], P[BASE + 1]), a1 = cvtpk(P[BASE + 2], P[BASE + 3]);   \
    unsigned b0 = cvtpk(P[BASE + 4], P[BASE + 5]), b1 = cvtpk(P[BASE + 6], P[BASE + 7]);                              \
    auto r0 = __builtin_amdgcn_permlane32_swap(a0, b0, false, false); auto r1 = __builtin_amdgcn_permlane32_swap(a1, b1, false, false); \
    u32x4 w = {r0[0], r1[0], r0[1], r1[1]}; OUT = __builtin_bit_cast(bf16x8, w); } while (0)
  PK4(p0, 0, pa0); PK4(p0, 8, pa1); PK4(p1, 0, pa2); PK4(p1, 8, pa3);
#undef PK4
}
template <int ND0>
DEVI void qkt(f32x16& p0, f32x16& p1, const char* Ks, const bf16x8* qr, int r32, int hi) {
  bf16x8 k0[ND0], k1[ND0];
#pragma unroll
  for (int d0 = 0; d0 < ND0; ++d0) { const int cb = (d0 * 16 + hi * 8) * 2;
    k0[d0] = *(const bf16x8*)(Ks + KSWZ(r32, cb)); k1[d0] = *(const bf16x8*)(Ks + KSWZ(32 + r32, cb)); }
  p0 = f32x16{}; p1 = f32x16{};
#pragma unroll
  for (int d0 = 0; d0 < ND0; ++d0) {
    p0 = __builtin_amdgcn_mfma_f32_32x32x16_bf16(k0[d0], qr[d0], p0, 0, 0, 0);
    p1 = __builtin_amdgcn_mfma_f32_32x32x16_bf16(k1[d0], qr[d0], p1, 0, 0, 0); }
}
template <int D0> DEVI void pv_one(f32x16& od, int vb, bf16x8 pa0, bf16x8 pa1, bf16x8 pa2, bf16x8 pa3) {
  const s16x4 l0 = tr_read<v_rd_off(D0, 0, 0)>(vb), h0 = tr_read<v_rd_off(D0, 0, 1)>(vb), l1 = tr_read<v_rd_off(D0, 1, 0)>(vb), h1 = tr_read<v_rd_off(D0, 1, 1)>(vb);
  const s16x4 l2 = tr_read<v_rd_off(D0, 2, 0)>(vb), h2 = tr_read<v_rd_off(D0, 2, 1)>(vb), l3 = tr_read<v_rd_off(D0, 3, 0)>(vb), h3 = tr_read<v_rd_off(D0, 3, 1)>(vb);
  asm volatile("s_waitcnt lgkmcnt(0)" ::: "memory"); SBAR();
#define PK(L, H) (bf16x8){L[0], L[1], L[2], L[3], H[0], H[1], H[2], H[3]}
  od = __builtin_amdgcn_mfma_f32_32x32x16_bf16(pa0, PK(l0, h0), od, 0, 0, 0);
  od = __builtin_amdgcn_mfma_f32_32x32x16_bf16(pa1, PK(l1, h1), od, 0, 0, 0);
  od = __builtin_amdgcn_mfma_f32_32x32x16_bf16(pa2, PK(l2, h2), od, 0, 0, 0);
  od = __builtin_amdgcn_mfma_f32_32x32x16_bf16(pa3, PK(l3, h3), od, 0, 0, 0);
#undef PK
}
DEVI void pv_d0(f32x16* o, int vb, bf16x8 pa0, bf16x8 pa1, bf16x8 pa2, bf16x8 pa3) {
  const s16x4 a0 = tr_read<v_rd_off(0, 0, 0)>(vb), b0 = tr_read<v_rd_off(0, 0, 1)>(vb), a1 = tr_read<v_rd_off(0, 1, 0)>(vb), b1 = tr_read<v_rd_off(0, 1, 1)>(vb);
  const s16x4 a2 = tr_read<v_rd_off(0, 2, 0)>(vb), b2 = tr_read<v_rd_off(0, 2, 1)>(vb), a3 = tr_read<v_rd_off(0, 3, 0)>(vb), b3 = tr_read<v_rd_off(0, 3, 1)>(vb);
  const s16x4 c0 = tr_read<v_rd_off(1, 0, 0)>(vb), d0 = tr_read<v_rd_off(1, 0, 1)>(vb), c1 = tr_read<v_rd_off(1, 1, 0)>(vb), d1 = tr_read<v_rd_off(1, 1, 1)>(vb);
  const s16x4 c2 = tr_read<v_rd_off(1, 2, 0)>(vb), d2 = tr_read<v_rd_off(1, 2, 1)>(vb), c3 = tr_read<v_rd_off(1, 3, 0)>(vb), d3 = tr_read<v_rd_off(1, 3, 1)>(vb);
  asm volatile("s_waitcnt lgkmcnt(0)" ::: "memory"); SBAR();
#define PK(L, H) (bf16x8){L[0], L[1], L[2], L[3], H[0], H[1], H[2], H[3]}
  o[0] = __builtin_amdgcn_mfma_f32_32x32x16_bf16(pa0, PK(a0, b0), o[0], 0, 0, 0);
  o[1] = __builtin_amdgcn_mfma_f32_32x32x16_bf16(pa0, PK(c0, d0), o[1], 0, 0, 0);
  o[0] = __builtin_amdgcn_mfma_f32_32x32x16_bf16(pa1, PK(a1, b1), o[0], 0, 0, 0);
  o[1] = __builtin_amdgcn_mfma_f32_32x32x16_bf16(pa1, PK(c1, d1), o[1], 0, 0, 0);
  o[0] = __builtin_amdgcn_mfma_f32_32x32x16_bf16(pa2, PK(a2, b2), o[0], 0, 0, 0);
  o[1] = __builtin_amdgcn_mfma_f32_32x32x16_bf16(pa2, PK(c2, d2), o[1], 0, 0, 0);
  o[0] = __builtin_amdgcn_mfma_f32_32x32x16_bf16(pa3, PK(a3, b3), o[0], 0, 0, 0);
  o[1] = __builtin_amdgcn_mfma_f32_32x32x16_bf16(pa3, PK(c3, d3), o[1], 0, 0, 0);
#undef PK
}

template <int DQK, bool MASK>
DEVI void attn_body(const u16* Qw, const u16* Kh, int ldk, const u16* Vh, int ldv, int kt0, int NT, float SCALE, float m_init, float l_init,
                    int qpos, u16* Ow, char* lds, float qrope_pos = 0.f) {
  constexpr int ND0 = DQK / 16, NCK = DQK / 8;
  const int tid = tidx(), wid = __builtin_amdgcn_readfirstlane(tid >> 6), lane = tid & 63, r32 = lane & 31, hi = lane >> 5;
  char* K_lds = lds; char* V_lds = lds + 2 * AT_SHM_K;
  float* wsx = (float*)(lds + 2 * AT_SHM_K + 3 * AT_SHM_V) + wid * 64; float* li_l = wsx; float* al_l = wsx + 32;
  float m_reg = m_init, l_reg = l_init; f32x16 o[2] = {f32x16{}, f32x16{}}; bf16x8 qr[ND0];
#pragma unroll
  for (int d0 = 0; d0 < ND0; ++d0) qr[d0] = *(const bf16x8*)(Qw + d0 * 16);
  if (DQK == 96) {
#pragma unroll
    for (int d0 = 4; d0 < ND0; ++d0) { float v[8]; unpk8(__builtin_bit_cast(u32x4, qr[d0]), v);
#pragma unroll
      for (int q = 0; q < 4; ++q) { const int f = 2 * ((((d0 - 4) * 16 + hi * 8) >> 1) + q); float sn, cs; rope_sc(qrope_pos, f, sn, cs);
        const float x1 = v[2 * q], x2 = v[2 * q + 1]; v[2 * q] = x1 * cs - x2 * sn; v[2 * q + 1] = x2 * cs + x1 * sn; }
      qr[d0] = __builtin_bit_cast(bf16x8, pk8(v)); } }
  unsigned koff[2], voff;
#pragma unroll
  for (int i = 0; i < 2; ++i) { const int row = 4 * (wid + 8 * i) + (lane >> 4), ch = (lane & 15) ^ (row & 15); koff[i] = (unsigned)(row * ldk * 2 + (ch < NCK ? ch : 0) * 16); }
  { const int off = wid * 1024 + lane * 16, sub = off >> 9, kk = ((sub >> 1) << 3) | ((off & 511) >> 6), c = ((sub & 1) << 5) | ((off & 63) >> 1);
    const int k = (kk & ~0xC) | ((kk & 4) << 1) | ((kk & 8) >> 1); voff = (unsigned)(k * ldv * 2 + c * 2); }
  typedef __attribute__((address_space(3))) unsigned lds_u32;
#define DMA(tt_) do { const char* kb_ = (const char*)Kh + (size_t)(kt0 + (tt_)) * 64 * ldk * 2; const char* vb_ = (const char*)Vh + (size_t)(kt0 + (tt_)) * 64 * ldv * 2; \
    char* kd_ = K_lds + ((tt_) & 1) * AT_SHM_K + wid * 1024; char* vd_ = V_lds + ((tt_) % 3) * AT_SHM_V + wid * 1024; \
    __builtin_amdgcn_global_load_lds((const unsigned*)(kb_ + koff[0]), (lds_u32*)kd_, 16, 0, 0); \
    __builtin_amdgcn_global_load_lds((const unsigned*)(kb_ + koff[1]), (lds_u32*)(kd_ + 8192), 16, 0, 0); \
    __builtin_amdgcn_global_load_lds((const unsigned*)(vb_ + voff), (lds_u32*)vd_, 16, 0, 0); } while (0)
#define LANDED() do { asm volatile("s_waitcnt vmcnt(0)" ::: "memory"); __syncthreads(); } while (0)
#define RESC(a) do { if (__any((a) < 1.f)) { if (hi == 0) al_l[r32] = (a); asm volatile("s_waitcnt lgkmcnt(0)" ::: "memory"); \
    _Pragma("unroll") for (int d = 0; d < 2; ++d) _Pragma("unroll") for (int r = 0; r < 16; ++r) o[d][r] *= al_l[crow(r, hi)]; } } while (0)
  const int vb0 = (int)(uintptr_t)V_lds + v_rd_base(lane);
  f32x16 pA0, pA1, pB0, pB1; float mnA, mnB, alA, alB; bf16x8 pa0, pa1, pa2, pa3;
  DMA(0); LANDED();
  DMA(1);
  qkt<ND0>(pA0, pA1, K_lds, qr, r32, hi); partialSM<MASK, true>(pA0, pA1, m_reg, mnA, alA, SCALE, kt0 * 64, qpos, hi);
  LANDED();
  int vprev = 0;
  for (int tt = 1; tt + 1 < NT; tt += 2) {
    const int v1 = vprev == 2 ? 0 : vprev + 1;
    DMA(tt + 1); SBAR();
    qkt<ND0>(pB0, pB1, K_lds + AT_SHM_K, qr, r32, hi);
    finishSM(pA0, pA1, alA, l_reg, pa0, pa1, pa2, pa3); SBAR();
    pv_d0(o, vb0 + vprev * AT_SHM_V, pa0, pa1, pa2, pa3); partialSM<MASK, false>(pB0, pB1, m_reg, mnB, alB, SCALE, (kt0 + tt) * 64, qpos, hi);
    RESC(alB); LANDED();
    if (tt + 2 < NT) DMA(tt + 2);
    SBAR();
    qkt<ND0>(pA0, pA1, K_lds, qr, r32, hi);
    finishSM(pB0, pB1, alB, l_reg, pa0, pa1, pa2, pa3); SBAR();
    pv_d0(o, vb0 + v1 * AT_SHM_V, pa0, pa1, pa2, pa3); partialSM<MASK, false>(pA0, pA1, m_reg, mnA, alA, SCALE, (kt0 + tt + 1) * 64, qpos, hi);
    RESC(alA); LANDED();
    vprev = v1 == 2 ? 0 : v1 + 1;
  }
  { const int v1 = vprev == 2 ? 0 : vprev + 1;
    SBAR(); qkt<ND0>(pB0, pB1, K_lds + AT_SHM_K, qr, r32, hi);
    finishSM(pA0, pA1, alA, l_reg, pa0, pa1, pa2, pa3); SBAR();
    pv_d0(o, vb0 + vprev * AT_SHM_V, pa0, pa1, pa2, pa3); partialSM<MASK, false>(pB0, pB1, m_reg, mnB, alB, SCALE, (kt0 + NT - 1) * 64, qpos, hi);
    RESC(alB);
    finishSM(pB0, pB1, alB, l_reg, pa0, pa1, pa2, pa3); SBAR();
    pv_d0(o, vb0 + v1 * AT_SHM_V, pa0, pa1, pa2, pa3); }
  if (hi == 0) li_l[r32] = l_reg; asm volatile("s_waitcnt lgkmcnt(0)" ::: "memory");
  float rli[16];
#pragma unroll
  for (int r = 0; r < 16; ++r) rli[r] = __builtin_amdgcn_rcpf(li_l[crow(r, hi)]);
#pragma unroll
  for (int r = 0; r < 16; ++r) { const int orow = crow(r, hi);
#pragma unroll
    for (int d0 = 0; d0 < 2; ++d0) Ow[(size_t)orow * DM + d0 * 32 + r32] = f2bf(o[d0][r] * rli[r]); }
  __syncthreads();
#undef DMA
#undef LANDED
#undef RESC
}

constexpr int LCH = 64, NLCH = SEQ / LCH;
constexpr size_t WS_LP = 1 * MiB, WS_LH = 2560 * 1024;
constexpr size_t WS_LC = 473 * MiB;
constexpr size_t WS_NEED = 510 * MiB;
DEVI void lru_passA(const Params& p, int item, int lane) {
  const int cg = item % 6, c = (item / 6) % NLCH, b = (item / (6 * NLCH)) % NB, d = item / (6 * NLCH * NB);
  const size_t base = (((size_t)(d * NB + b) * (SEQ / 8) + c * 8) * LRU_W + cg * 64 + lane) * 8;
  const u16* E = (const u16*)(p.ws + WS_LE) + base; const u16* Bp = (const u16*)(p.ws + WS_LB) + base;
  u32x4 ev[8], bv[8];
#pragma unroll
  for (int g = 0; g < 8; ++g) { ev[g] = *(const u32x4*)(E + (size_t)g * LRU_W * 8); bv[g] = *(const u32x4*)(Bp + (size_t)g * LRU_W * 8); }
  float h = 0.f, P = 1.f;
#pragma unroll
  for (int gg = 0; gg < 8; ++gg) { const int g = d ? 7 - gg : gg; float e[8], bb[8]; unpk8(ev[g], e); unpk8(bv[g], bb);
#pragma unroll
    for (int rr = 0; rr < 8; ++rr) { const int r = d ? 7 - rr : rr; const float a = 1.f - e[r]; h = fmaf(a, h, bb[r]); P *= a; } }
  const size_t o = ((size_t)(d * NB + b) * NLCH + c) * LRU_W + cg * 64 + lane;
  ((float*)(p.ws + WS_LP))[o] = P; ((float*)(p.ws + WS_LH))[o] = h;
}

DEVI void lru_final(const Params& p, int item, char* lds) {
  const int tid = tidx(), wid = tid >> 6, lane = tid & 63;
  const int c = item % NLCH, b = item / NLCH;
  float* obuf = (float*)lds;
  if (wid < 6) {
    const int ch = wid * 64 + lane;
#pragma unroll
    for (int d = 0; d < 2; ++d) {
      const size_t co = ((size_t)(d * NB + b) * NLCH + c) * LRU_W + ch;
      float h = ((const float*)(p.ws + WS_LC))[co];
      const size_t base = (((size_t)(d * NB + b) * (SEQ / 8) + c * 8) * LRU_W + ch) * 8;
      const u16* E = (const u16*)(p.ws + WS_LE) + base; const u16* Bp = (const u16*)(p.ws + WS_LB) + base;
      u32x4 ev[8], bv[8];
#pragma unroll
      for (int g = 0; g < 8; ++g) { ev[g] = *(const u32x4*)(E + (size_t)g * LRU_W * 8); bv[g] = *(const u32x4*)(Bp + (size_t)g * LRU_W * 8); }
      if (d == 0) {
#pragma unroll
        for (int g = 0; g < 8; ++g) { float e[8], bb[8]; unpk8(ev[g], e); unpk8(bv[g], bb);
#pragma unroll
          for (int r = 0; r < 8; ++r) { h = fmaf(1.f - e[r], h, bb[r]); obuf[(g * 8 + r) * LRU_W + ch] = h; } }
      } else {
        const u16* gp = (const u16*)(p.ws + WS_R1) + ((size_t)b * SEQ + c * LCH) * INWP + PC_LG + ch;
#pragma unroll
        for (int g = 7; g >= 0; --g) { float e[8], bb[8]; unpk8(ev[g], e); unpk8(bv[g], bb);
#pragma unroll
          for (int r = 7; r >= 0; --r) { h = fmaf(1.f - e[r], h, bb[r]); const int tk = g * 8 + r;
            const float gt = bf2f(gp[(size_t)tk * INWP]); obuf[tk * LRU_W + ch] = (obuf[tk * LRU_W + ch] + h) * gelu_erf(gt); } }
      }
    }
  }
  __syncthreads();
  u16* mp = (u16*)(p.ws + WS_MIX) + ((size_t)b * SEQ + c * LCH) * DM + 384;
#pragma unroll 1
  for (int i = 0; i < 8; ++i) { const int tk = wid * 8 + i;
    float v[6]; float s = 0.f;
#pragma unroll
    for (int q = 0; q < 3; ++q) { const f32x2 t2 = *(const f32x2*)(obuf + tk * LRU_W + q * 128 + lane * 2); v[2 * q] = t2.x; v[2 * q + 1] = t2.y; s = fmaf(t2.x, t2.x, s); s = fmaf(t2.y, t2.y, s); }
    s = wave_sum(s);
    const float rs = rsqrtf(s * (1.f / 384.f) + EPS);
#pragma unroll
    for (int q = 0; q < 3; ++q) *(unsigned*)(mp + (size_t)tk * DM + q * 128 + lane * 2) = pk2(v[2 * q] * rs, v[2 * q + 1] * rs);
  }
  __syncthreads();
}

typedef unsigned char u8;
DEVI unsigned q8x4(const float* v, float s) {
  unsigned w = 0;
#pragma unroll
  for (int i = 0; i < 4; ++i) { int q = __float2int_rn(v[i] * s); q = q < -127 ? -127 : (q > 127 ? 127 : q); w |= ((unsigned)q & 255u) << (8 * i); }
  return w;
}
DEVI void peer_xn_pass(const Params& p, int layer, int vb, int nb) {
  const int tid = tidx(), wid = tid >> 6, lane = tid & 63; const u16* xg = (const u16*)(p.ws + WS_XG); const float* gf = p.norm_ffn + layer * DM;
  u8* xq = (u8*)(p.ws + WS_XQ); float* sxp = (float*)(p.ws + WS_SX);
  for (int t = vb * 8 + wid; t < T; t += nb * 8) {
    const u32x4* rp = (const u32x4*)(xg + (size_t)t * DM + lane * 16);
    float v[16]; unpk8(rp[0], v); unpk8(rp[1], v + 8);
    float s = 0.f;
#pragma unroll
    for (int i = 0; i < 16; ++i) s = fmaf(v[i], v[i], s);
    s = wave_sum(s);
    const float rs = rsqrtf(s * (1.f / DM) + EPS);
    float g[16]; ld8(gf + lane * 16, g); ld8(gf + lane * 16 + 8, g + 8);
    float mx = 0.f;
#pragma unroll
    for (int i = 0; i < 16; ++i) { v[i] *= rs * g[i]; mx = fmaxf(mx, fabsf(v[i])); }
#pragma unroll
    for (int o = 1; o < 64; o <<= 1) mx = fmaxf(mx, __shfl_xor(mx, o));
    const float sx = fmaxf(mx, 1e-20f) * (1.f / 127.f), isx = 1.f / sx;
    *(u32x4*)(xq + (size_t)t * DM + lane * 16) = (u32x4){q8x4(v, isx), q8x4(v + 4, isx), q8x4(v + 8, isx), q8x4(v + 12, isx)};
    if (lane == 0) sxp[t] = sx;
  }
}

DEVI void cvt16(u32x4 w, float* f) {
  f32x2 t;
  t = __builtin_amdgcn_cvt_pk_f32_fp8((int)w.x, false); f[0] = t.x; f[1] = t.y; t = __builtin_amdgcn_cvt_pk_f32_fp8((int)w.x, true); f[2] = t.x; f[3] = t.y;
  t = __builtin_amdgcn_cvt_pk_f32_fp8((int)w.y, false); f[4] = t.x; f[5] = t.y; t = __builtin_amdgcn_cvt_pk_f32_fp8((int)w.y, true); f[6] = t.x; f[7] = t.y;
  t = __builtin_amdgcn_cvt_pk_f32_fp8((int)w.z, false); f[8] = t.x; f[9] = t.y; t = __builtin_amdgcn_cvt_pk_f32_fp8((int)w.z, true); f[10] = t.x; f[11] = t.y;
  t = __builtin_amdgcn_cvt_pk_f32_fp8((int)w.w, false); f[12] = t.x; f[13] = t.y; t = __builtin_amdgcn_cvt_pk_f32_fp8((int)w.w, true); f[14] = t.x; f[15] = t.y;
}
DEVI unsigned enc4(float a, float b, float c, float d) { int w = 0; w = __builtin_amdgcn_cvt_pk_fp8_f32(a, b, w, false); w = __builtin_amdgcn_cvt_pk_fp8_f32(c, d, w, true); return (unsigned)w; }
#define EIDX_AT(i0, i1, i) ((((i) < 8 ? (i0) : (i1))[((i) & 7) >> 1] >> (((i) & 1) * 16)) & 0xffffu)
template <int CTRL> DEVI float dppf(float v) { return __uint_as_float((unsigned)__builtin_amdgcn_mov_dpp((int)__float_as_uint(v), CTRL, 0xF, 0xF, true)); }
DEVI f32x2 fma2(f32x2 a, f32x2 b, f32x2 c) { return __builtin_elementwise_fma(a, b, c); }
DEVI f32x2 cvt8lo(unsigned w) { return __builtin_amdgcn_cvt_pk_f32_fp8((int)w, false); }
DEVI f32x2 cvt8hi(unsigned w) { return __builtin_amdgcn_cvt_pk_f32_fp8((int)w, true); }
struct PeerIdx { u32x4 i0, i1; };
template <bool AXPY>
DEVI void peer_slice_phase(const Params& p, int s, int tbeg, int tstep, int lane, const float* xin, float* xout, bool last) {
  const int r = lane >> 3, j = lane & 7;
  const u8* eidxB = (const u8*)(p.ws + WS_EIDX); const unsigned eoff = (unsigned)r * 32u;
  const u8* TBs = (const u8*)(p.ws + (AXPY ? WS_VB : WS_UB)) + (size_t)s * NEXP * 128; const unsigned toff = 16u * (unsigned)j;
  const u8* xnB = (const u8*)(p.ws + WS_XQ) + s * 128; const unsigned xoff = 16u * (unsigned)j;
  const float* sxp = (const float*)(p.ws + WS_SX);
  const u8* ccB = (const u8*)(p.ws + WS_CC); const unsigned coff = (unsigned)r * 16u;
  const float* csp = (const float*)(p.ws + WS_CS);
  u16* pdB = (u16*)(p.ws + WS_PD) + (size_t)s * T * 128;
  const int ntok = (T - tbeg + tstep - 1) / tstep;
  if (ntok <= 0) return;
#define TOK(k) (tbeg + ((k) < ntok ? (k) : ntok - 1) * tstep)
#define LD_IDX(dst, k) do { const u8* b_ = eidxB + (size_t)TOK(k) * 256; dst.i0 = *(const u32x4*)(b_ + eoff); dst.i1 = *(const u32x4*)(b_ + eoff + 16u); } while (0)
#define LD_HALF(H, ix, h) do { _Pragma("unroll") for (int i = 0; i < 8; ++i) H[i] = *(const u32x4*)(TBs + (EIDX_AT(ix.i0, ix.i1, 8 * (h) + i) * 128u + toff)); } while (0)
#define LD_AUX(a, k) do { if (AXPY) { const u8* b_ = ccB + (size_t)TOK(k) * 128; a[0] = *(const u32x4*)(b_ + coff); a[1].x = __float_as_uint(csp[TOK(k)]); } \
    else { const u8* b_ = xnB + (size_t)TOK(k) * DM; a[0] = *(const u32x4*)(b_ + xoff); a[1].x = __float_as_uint(sxp[TOK(k)]); } } while (0)
  PeerIdx I0, I1, I2; u32x4 H0[8], H1[8], H2[8], X0[2], X1[2], X2[2];
  u32x4 xq4 = {0, 0, 0, 0}; float sxk = 0.f;
  int acc[16];
#define T_BEGIN(X) do { xq4 = X[0]; sxk = __uint_as_float(X[1].x); if (AXPY) { _Pragma("unroll") for (int q = 0; q < 16; ++q) acc[q] = 0; } } while (0)
#define COMP(H, h, k) do { if ((k) < ntok) { \
    if (!AXPY) { u16* o_ = pdB + (size_t)(tbeg + (k) * tstep) * 128 + r * 16 + 8 * (h); \
      _Pragma("unroll") for (int g = 0; g < 2; ++g) { float res[4]; \
        _Pragma("unroll") for (int ii = 0; ii < 4; ++ii) { const u32x4 w_ = H[4 * g + ii]; \
          int a_ = __builtin_amdgcn_sdot4((int)w_.x, (int)xq4.x, 0, false); a_ = __builtin_amdgcn_sdot4((int)w_.y, (int)xq4.y, a_, false); \
          a_ = __builtin_amdgcn_sdot4((int)w_.z, (int)xq4.z, a_, false); a_ = __builtin_amdgcn_sdot4((int)w_.w, (int)xq4.w, a_, false); \
          a_ += __builtin_amdgcn_mov_dpp(a_, 0xB1, 0xF, 0xF, true); a_ += __builtin_amdgcn_mov_dpp(a_, 0x4E, 0xF, 0xF, true); a_ += __builtin_amdgcn_mov_dpp(a_, 0x141, 0xF, 0xF, true); \
          res[ii] = (float)a_ * sxk; } \
        if (j == 0) *(u32x2*)(o_ + 4 * g) = (u32x2){pk2(res[0], res[1]), pk2(res[2], res[3])}; } } \
    else { _Pragma("unroll") for (int gi = 0; gi < 2; ++gi) { const int cv_ = (int)xq4[2 * (h) + gi];        \
        _Pragma("unroll") for (int dc = 0; dc < 4; ++dc) { const unsigned A_ = H[4 * gi][dc], B_ = H[4 * gi + 1][dc], C_ = H[4 * gi + 2][dc], D_ = H[4 * gi + 3][dc]; \
            \
          const unsigned X_ = __builtin_amdgcn_perm(B_, A_, 0x05010400u), Y_ = __builtin_amdgcn_perm(B_, A_, 0x07030602u), Z_ = __builtin_amdgcn_perm(D_, C_, 0x05010400u), W_ = __builtin_amdgcn_perm(D_, C_, 0x07030602u); \
          acc[4 * dc + 0] = __builtin_amdgcn_sdot4((int)__builtin_amdgcn_perm(Z_, X_, 0x05040100u), cv_, acc[4 * dc + 0], false); \
          acc[4 * dc + 1] = __builtin_amdgcn_sdot4((int)__builtin_amdgcn_perm(Z_, X_, 0x07060302u), cv_, acc[4 * dc + 1], false); \
          acc[4 * dc + 2] = __builtin_amdgcn_sdot4((int)__builtin_amdgcn_perm(W_, Y_, 0x05040100u), cv_, acc[4 * dc + 2], false); \
          acc[4 * dc + 3] = __builtin_amdgcn_sdot4((int)__builtin_amdgcn_perm(W_, Y_, 0x07060302u), cv_, acc[4 * dc + 3], false); } } } } } while (0)
  auto finalize = [&](int k) {
    if (!AXPY || k >= ntok) return;
    const int t = tbeg + k * tstep;
    int S[8];
#pragma unroll
    for (int q = 0; q < 8; ++q) { auto rr = __builtin_amdgcn_permlane32_swap((unsigned)acc[q], (unsigned)acc[q + 8], false, false); S[q] = (int)rr[0] + (int)rr[1]; }
    int Tq[4];
#pragma unroll
    for (int q = 0; q < 4; ++q) { auto rr = __builtin_amdgcn_permlane16_swap((unsigned)S[q], (unsigned)S[q + 4], false, false); Tq[q] = (int)rr[0] + (int)rr[1]; }
#pragma unroll
    for (int q = 0; q < 4; ++q) Tq[q] += __builtin_amdgcn_mov_dpp(Tq[q], 0x128, 0xF, 0xF, true);
    float ss = 0.f;
    if ((lane & 8) == 0) {
      const size_t o = (size_t)t * DM + s * 128 + 16 * j + ((lane >> 5) & 1) * 8 + ((lane >> 4) & 1) * 4;
      u32x2* xgp = (u32x2*)((u16*)(p.ws + WS_XG) + o); const u32x2 xb = *xgp;
      const f32x4 y = {fmaf((float)Tq[0], sxk, bflo(xb.x)), fmaf((float)Tq[1], sxk, bfhi(xb.x)), fmaf((float)Tq[2], sxk, bflo(xb.y)), fmaf((float)Tq[3], sxk, bfhi(xb.y))};
      *xgp = (u32x2){pk2(y.x, y.y), pk2(y.z, y.w)};
      ss = (y.x * y.x + y.y * y.y) + (y.z * y.z + y.w * y.w);
    }
    ss = wave_sum(ss); if (lane == 0) ((float*)(p.ws + WS_SSQ))[(size_t)t * 8 + s] = ss;
  };
  LD_IDX(I0, 0); LD_IDX(I1, 1); LD_IDX(I2, 2); LD_HALF(H0, I0, 0); LD_HALF(H1, I0, 1); LD_AUX(X0, 0);
#pragma unroll 2
  for (int k = 0; k < ntok; k += 3) {
    LD_HALF(H2, I1, 0); LD_IDX(I0, k + 3); LD_AUX(X1, k + 1);
    T_BEGIN(X0); COMP(H0, 0, k);
    LD_HALF(H0, I1, 1);
    COMP(H1, 1, k); finalize(k);
    LD_HALF(H1, I2, 0); LD_IDX(I1, k + 4); LD_AUX(X2, k + 2);
    T_BEGIN(X1); COMP(H2, 0, k + 1);
    LD_HALF(H2, I2, 1);
    COMP(H0, 1, k + 1); finalize(k + 1);
    LD_HALF(H0, I0, 0); LD_IDX(I2, k + 5); LD_AUX(X0, k + 3);
    T_BEGIN(X2); COMP(H1, 0, k + 2);
    LD_HALF(H1, I0, 1);
    COMP(H2, 1, k + 2); finalize(k + 2);
  }
#undef TOK
#undef LD_IDX
#undef LD_HALF
#undef LD_AUX
#undef T_BEGIN
#undef COMP
}

DEVI void lru_passB(const Params& p, int item, int lane) {
  const int cg = item % 6, b = (item / 6) % NB, d = item / (6 * NB);
  const size_t o = (size_t)(d * NB + b) * NLCH * LRU_W + cg * 64 + lane;
  const float* Pp = (const float*)(p.ws + WS_LP) + o; const float* Hp = (const float*)(p.ws + WS_LH) + o; float* Cp = (float*)(p.ws + WS_LC) + o;
  float h = 0.f;
#pragma unroll 1
  for (int c0 = 0; c0 < NLCH; c0 += 32) {
    float pv[32], hv[32];
#pragma unroll
    for (int i = 0; i < 32; ++i) { const int cc = d ? NLCH - 1 - (c0 + i) : c0 + i; pv[i] = Pp[(size_t)cc * LRU_W]; hv[i] = Hp[(size_t)cc * LRU_W]; }
#pragma unroll
    for (int i = 0; i < 32; ++i) { const int cc = d ? NLCH - 1 - (c0 + i) : c0 + i; Cp[(size_t)cc * LRU_W] = h; h = fmaf(pv[i], h, hv[i]); }
  }
}

DEVI void swa_item(const Params& p, int layer, int item, char* lds) {
  const int tid = tidx(), wid = tid >> 6, lane = tid & 63, r32 = lane & 31, hi = lane >> 5;
  const int g = item & 1, n = (item >> 1) & 63, b = item >> 7;
  const int hq = 2 * g + (wid >> 2), qrow = n * 128 + (wid & 3) * 32;
  const u16* proj = (const u16*)(p.ws + WS_R1);
  const u16* Qw = proj + (size_t)(b * SEQ + qrow + r32) * INWP + PC_SQ + hq * 64 + hi * 8;
  const u16* Kh = proj + (size_t)(b * SEQ) * INWP + PC_SK + g * 64;
  const u16* Vh = proj + (size_t)(b * SEQ) * INWP + PC_SV + g * 64;
  const int kt0 = (2 * n - 2) < 0 ? 0 : (2 * n - 2), kt1 = (2 * n + 4) > SEQ / 64 ? SEQ / 64 : (2 * n + 4);
  const float sink = p.swa_sink[layer * 4 + hq];
  u16* Ow = (u16*)(p.ws + WS_MIX) + (size_t)(b * SEQ + qrow) * DM + 768 + hq * 64;
  attn_body<64, true>(Qw, Kh, INWP, Vh, INWP, kt0, kt1 - kt0, 0.125f, sink * 8.f, 1.f, qrow + r32, Ow, lds);
}
DEVI void mla_item(const Params& p, int pair, int qb, char* lds) {
  const int tid = tidx(), wid = tid >> 6, lane = tid & 63, r32 = lane & 31, hi = lane >> 5;
  const int b = pair / MLA_H, h = pair - b * MLA_H;
  const u16* Qw = (const u16*)(p.ws + WS_QM) + ((size_t)pair * SEQ + qb * 256 + wid * 32 + r32) * MLA_QK + hi * 8;
  const u16* Kh = (const u16*)(p.ws + WS_KM) + (size_t)pair * SEQ * MLA_QK;
  const u16* Vh = (const u16*)(p.ws + WS_VM) + (size_t)pair * SEQ * MLA_V;
  u16* Ow = (u16*)(p.ws + WS_MIX) + (size_t)(b * SEQ + qb * 256 + wid * 32) * DM + h * 64;
  attn_body<96, false>(Qw, Kh, MLA_QK, Vh, MLA_V, 0, SEQ / 64, 0.10206207261596575f, -1e30f, 0.f, 0, Ow, lds, (float)p.pos[b * SEQ + qb * 256 + wid * 32 + r32]);
}


namespace pg8 {
#define PG8_LAS __attribute__((address_space(3)))
constexpr int BM = 256, BK = 64, HALF = 128, HTB = HALF * BK * 2, NXCD = 8, WGM = 8;
DEVI int lds_byte(int r, int c) { const int st = (r >> 4) * 2 + (c >> 5), rr = r & 15, cc = c & 31, ob = rr * 64 + cc * 2; return st * 1024 + (ob ^ (((ob >> 9) & 1) << 5)); }
DEVI void stage_rc(int b, int& R, int& C) { const int st = b / 1024, sb = b % 1024, swz = sb ^ (((sb >> 9) & 1) << 5); R = (st >> 1) * 16 + swz / 64; C = (st & 1) * 32 + (swz % 64) / 2; }
DEVI int perm32(int rho) { const int n = rho >> 4, i = rho & 15; return 8 * (i >> 2) + 4 * n + (i & 3); }
struct Unit { int pm, pn; };
struct Gemm { const u16* A; const u16* Bt; int M, N, K, lda, ldb; };
struct StaticOrder {
  int nM, nN, nwg, G, c;
  DEVI void init(int M, int N, int G_, int c_) { nM = M / BM; nN = N / BM; nwg = nM * nN; G = G_; c = c_; }
  DEVI bool next(int i, Unit& u) const {
    const long L = (long)i * G + c; if (L >= nwg) return false;
    int wgid = (int)L; { const int q = nwg / NXCD, r = nwg % NXCD, xcd = wgid % NXCD, off = wgid / NXCD; wgid = (xcd < r ? xcd * (q + 1) : r * (q + 1) + (xcd - r) * q) + off; }
    const int nig = WGM * nN, gid = wgid / nig, fm = gid * WGM, gsz = (nM - fm) < WGM ? (nM - fm) : WGM;
    u.pm = fm + ((wgid % nig) % gsz); u.pn = (wgid % nig) / gsz; return true;
  }
};
template <class Epi>
DEVI void gemm_phase(PG8_LAS unsigned char* lds, const Gemm g, const StaticOrder& S, const Epi& E) {
  const int tid = tidx(), wid = __builtin_amdgcn_readfirstlane(tid >> 6), lane = tid & 63, wr = wid >> 2, wc = wid & 3, fr = lane & 15, fq = lane >> 4;
  const int K = g.K; int nt = K / BK; asm volatile("" : "+s"(nt));
  unsigned voffA[2], voffB[2];
#pragma unroll
  for (int i = 0; i < 2; ++i) { int R, C; stage_rc(tid * 16 + i * 8192, R, C); const int Rb = (R & ~31) + perm32(R & 31);
    voffA[i] = (unsigned)(R * g.lda + C) * 2u; voffB[i] = (unsigned)(Rb * g.ldb + C) * 2u; }
  const size_t kstep = (size_t)(BK * 2), hstepA = (size_t)HALF * g.lda * 2, hstepB = (size_t)HALF * g.ldb * 2, tstepA = 2 * hstepA, tstepB = 2 * hstepB;
  const unsigned ldsw = (unsigned)wid * 1024u;
  const int aoff = lds_byte(wr * 64 + fr, fq * 8), boff = lds_byte(wc * 32 + fr, fq * 8);
#define PG8_SA(b, h) (((b) * 2 + (h)) * HTB)
#define PG8_SB(b, h) ((4 + (b) * 2 + (h)) * HTB)
#define PG8_STAGE(bufoff, gbase, voff) do { _Pragma("unroll") for (int _i = 0; _i < 2; ++_i) \
    __builtin_amdgcn_global_load_lds((const unsigned*)((const char*)(gbase) + (voff)[_i]), (PG8_LAS unsigned*)(lds + (bufoff) + ldsw + _i * 8192), 16, 0, 0); } while (0)
#define PG8_LDA(dst, b, h) do { _Pragma("unroll") for (int m = 0; m < 4; ++m) _Pragma("unroll") for (int k = 0; k < 2; ++k) dst[m][k] = *(const PG8_LAS bf16x8*)(lds + PG8_SA(b, h) + aoff + m * 2048 + k * 1024); } while (0)
#define PG8_LDB(dst, b, h) do { _Pragma("unroll") for (int n = 0; n < 2; ++n) _Pragma("unroll") for (int k = 0; k < 2; ++k) dst[n][k] = *(const PG8_LAS bf16x8*)(lds + PG8_SB(b, h) + boff + n * 2048 + k * 1024); } while (0)
#define PG8_MMA(ai, bj, At, Bt) do { __builtin_amdgcn_s_setprio(1); _Pragma("unroll") for (int m = 0; m < 4; ++m) _Pragma("unroll") for (int n = 0; n < 2; ++n) _Pragma("unroll") for (int k = 0; k < 2; ++k) \
    acc[ai][bj][m][n] = __builtin_amdgcn_mfma_f32_16x16x32_bf16(Bt[n][k], At[m][k], acc[ai][bj][m][n], 0, 0, 0); __builtin_amdgcn_s_setprio(0); } while (0)
#define PG8_WAIT_V(n) asm volatile("s_waitcnt vmcnt(" #n ")" ::: "memory")
#define PG8_WAIT_L(n) asm volatile("s_waitcnt lgkmcnt(" #n ")" ::: "memory")
#define PG8_BAR __builtin_amdgcn_s_barrier()
#define PG8_SCHED __builtin_amdgcn_sched_barrier(0)
  Unit cur, nxt; int ui = 0;
  if (!S.next(0, cur)) return;
  f32x4 acc[2][2][4][2];
#pragma unroll
  for (int a = 0; a < 2; ++a)
#pragma unroll
    for (int b = 0; b < 2; ++b)
#pragma unroll
      for (int m = 0; m < 4; ++m)
#pragma unroll
        for (int n = 0; n < 2; ++n) acc[a][b][m][n] = (f32x4){0.f, 0.f, 0.f, 0.f};
  bf16x8 At[4][2], B0[2][2], B1[2][2];
  const char* cA = (const char*)g.A + (size_t)cur.pm * tstepA; const char* cB = (const char*)g.Bt + (size_t)cur.pn * tstepB;
  PG8_STAGE(PG8_SB(0, 0), cB, voffB); PG8_STAGE(PG8_SB(0, 1), cB + hstepB, voffB); PG8_STAGE(PG8_SA(0, 0), cA, voffA); PG8_STAGE(PG8_SA(0, 1), cA + hstepA, voffA);
  if (wr == 1) PG8_BAR;
  PG8_WAIT_V(2); PG8_BAR;
  PG8_STAGE(PG8_SB(1, 0), cB + kstep, voffB); PG8_STAGE(PG8_SA(1, 0), cA + kstep, voffA); PG8_STAGE(PG8_SB(1, 1), cB + hstepB + kstep, voffB);
  PG8_WAIT_V(6); PG8_BAR;
  for (;;) {
    const bool has_next = S.next(ui + 1, nxt);
    const char* nA = has_next ? (const char*)g.A + (size_t)nxt.pm * tstepA : cA; const char* nB = has_next ? (const char*)g.Bt + (size_t)nxt.pn * tstepB : cB;
#pragma unroll 1
    for (int t = 0; t < nt; t += 2) {
      const bool last = (t == nt - 2);
      const char* a1 = cA + (size_t)(t + 1) * kstep;
      const char* a2 = last ? nA : cA + (size_t)(t + 2) * kstep; const char* b2 = last ? nB : cB + (size_t)(t + 2) * kstep;
      const char* a3 = a2 + kstep; const char* b3 = b2 + kstep;
      PG8_LDB(B0, 0, 0); PG8_LDB(B1, 0, 1); PG8_SCHED; PG8_LDA(At, 0, 0); PG8_STAGE(PG8_SA(1, 1), a1 + hstepA, voffA);
      PG8_WAIT_V(8); PG8_WAIT_L(0); PG8_BAR; PG8_MMA(0, 0, At, B0); PG8_MMA(0, 1, At, B1); PG8_BAR; PG8_SCHED;
      PG8_LDA(At, 0, 1); PG8_STAGE(PG8_SB(0, 0), b2, voffB); PG8_STAGE(PG8_SB(0, 1), b2 + hstepB, voffB); PG8_STAGE(PG8_SA(0, 0), a2, voffA);
      PG8_WAIT_V(8); PG8_WAIT_L(0); PG8_BAR; PG8_MMA(1, 0, At, B0); PG8_MMA(1, 1, At, B1); PG8_BAR; PG8_SCHED;
      PG8_LDB(B0, 1, 0); PG8_LDB(B1, 1, 1); PG8_SCHED; PG8_LDA(At, 1, 0); PG8_STAGE(PG8_SA(0, 1), a2 + hstepA, voffA);
      PG8_WAIT_V(8); PG8_WAIT_L(0); PG8_BAR; PG8_MMA(0, 0, At, B0); PG8_MMA(0, 1, At, B1); PG8_BAR; PG8_SCHED;
      PG8_LDA(At, 1, 1); PG8_STAGE(PG8_SB(1, 0), b3, voffB); PG8_STAGE(PG8_SB(1, 1), b3 + hstepB, voffB); PG8_STAGE(PG8_SA(1, 0), a3, voffA);
      PG8_WAIT_V(8); PG8_WAIT_L(0); PG8_BAR; PG8_MMA(1, 0, At, B0); PG8_MMA(1, 1, At, B1); PG8_BAR; PG8_SCHED;
    }
    if (wr == 0) PG8_BAR;
    E(acc, cur, wr, wc, fr, fq);
    if (!has_next) break;
#pragma unroll
    for (int a = 0; a < 2; ++a)
#pragma unroll
      for (int b = 0; b < 2; ++b)
#pragma unroll
        for (int m = 0; m < 4; ++m)
#pragma unroll
          for (int n = 0; n < 2; ++n) acc[a][b][m][n] = (f32x4){0.f, 0.f, 0.f, 0.f};
    cur = nxt; cA = nA; cB = nB; ++ui;
    if (wr == 1) PG8_BAR;
  }
  PG8_WAIT_V(0);
  PG8_BAR;
#undef PG8_SA
#undef PG8_SB
#undef PG8_STAGE
#undef PG8_LDA
#undef PG8_LDB
#undef PG8_MMA
#undef PG8_WAIT_V
#undef PG8_WAIT_L
#undef PG8_BAR
#undef PG8_SCHED
}

DEVI float rs_from8(const float* s) { const f32x4 a = *(const f32x4*)s, b = *(const f32x4*)(s + 4); return rsqrtf((((a.x + a.y) + (a.z + a.w)) + ((b.x + b.y) + (b.z + b.w))) * (1.f / DM) + EPS); }
struct EpiProj { u16* proj; const int* pos; const float* ssq8; float* ssqq; float* ssqkv;
  DEVI void operator()(const f32x4 (&acc)[2][2][4][2], const Unit& u, int wr, int wc, int fr, int fq) const {
    const int row0 = u.pm * BM + wr * 64 + fr, col0 = u.pn * BM + wc * 32 + 8 * fq;
#pragma unroll
    for (int ai = 0; ai < 2; ++ai)
#pragma unroll
      for (int m = 0; m < 4; ++m) { const int row = row0 + ai * HALF + m * 16; const float rs = rs_from8(ssq8 + (size_t)row * 8); const float posf = (float)pos[row];
        float sq0 = 0.f, sq1 = 0.f;
#pragma unroll
        for (int bj = 0; bj < 2; ++bj) { const int gcol = col0 + bj * HALF;
          float v[8]; { const f32x4 a = acc[ai][bj][m][0] * rs, b = acc[ai][bj][m][1] * rs; v[0] = a.x; v[1] = a.y; v[2] = a.z; v[3] = a.w; v[4] = b.x; v[5] = b.y; v[6] = b.z; v[7] = b.w; }
          if (u.pn <= 1) { float s = 0.f;
#pragma unroll
            for (int q = 0; q < 8; ++q) s = fmaf(v[q], v[q], s);
            if (bj == 0) sq0 = s; else sq1 = s; }
          const bool r64 = gcol >= PC_SQ && gcol < PC_SV, r32g = gcol >= PC_KR && gcol < PC_KR + 32;
          if (r64 || r32g) {
#pragma unroll
            for (int q = 0; q < 4; ++q) { const int f = r64 ? (((gcol + 2 * q) & 63) >> 1) : 2 * (((gcol + 2 * q) & 31) >> 1); float sn, cs; rope_sc(posf, f, sn, cs);
              const float x1 = v[2 * q], x2 = v[2 * q + 1]; v[2 * q] = x1 * cs - x2 * sn; v[2 * q + 1] = x2 * cs + x1 * sn; } }
          *(u32x4*)(proj + (size_t)row * INWP + gcol) = pk8(v); }
        if (u.pn <= 1) { float s = u.pn == 0 ? sq0 + sq1 : sq0; s += __shfl_xor(s, 16); s += __shfl_xor(s, 32);
          if (fq == 0) (u.pn == 0 ? ssqq : ssqkv)[(size_t)row * 4 + wc] = s; } }
  }
};
struct EpiQ2 { u16* qm; const float* ssqq;
  DEVI void operator()(const f32x4 (&acc)[2][2][4][2], const Unit& u, int wr, int wc, int fr, int fq) const {
    const int b = (u.pm * BM) >> 13, s0 = (u.pm * BM) & (SEQ - 1), lrow = wr * 64 + fr;
    const float* sq = ssqq + (size_t)(u.pm * BM) * 4 + lrow * 4;
    float rs[2][4];
#pragma unroll
    for (int ai = 0; ai < 2; ++ai)
#pragma unroll
      for (int m = 0; m < 4; ++m) { const f32x4 sp = *(const f32x4*)(sq + (ai * HALF + m * 16) * 4); rs[ai][m] = rsqrtf(((sp.x + sp.y) + (sp.z + sp.w)) * (1.f / 256.f) + EPS); }
#pragma unroll
    for (int bj = 0; bj < 2; ++bj) { const int gcol = u.pn * BM + bj * HALF + wc * 32 + 8 * fq;
      if (gcol < 576) { const int head = (gcol * 683) >> 16, j0 = gcol - head * 96;
        u16* base = qm + ((size_t)(b * MLA_H + head) * SEQ + s0) * MLA_QK + (unsigned)(lrow * MLA_QK + j0);
#pragma unroll
        for (int ai = 0; ai < 2; ++ai)
#pragma unroll
          for (int m = 0; m < 4; ++m) { const float r = rs[ai][m];
            float v[8]; { const f32x4 a = acc[ai][bj][m][0] * r, bb = acc[ai][bj][m][1] * r; v[0] = a.x; v[1] = a.y; v[2] = a.z; v[3] = a.w; v[4] = bb.x; v[5] = bb.y; v[6] = bb.z; v[7] = bb.w; }
            *(u32x4*)(base + (ai * HALF + m * 16) * MLA_QK) = pk8(v); } } }
  }
};
struct EpiKV2 { u16* km; u16* vm; const float* ssqkv;
  DEVI void operator()(const f32x4 (&acc)[2][2][4][2], const Unit& u, int wr, int wc, int fr, int fq) const {
    const int b = (u.pm * BM) >> 13, s0 = (u.pm * BM) & (SEQ - 1), lrow = wr * 64 + fr;
    const float* sq = ssqkv + (size_t)(u.pm * BM) * 4 + lrow * 4;
    float rs[2][4];
#pragma unroll
    for (int ai = 0; ai < 2; ++ai)
#pragma unroll
      for (int m = 0; m < 4; ++m) { const f32x4 sp = *(const f32x4*)(sq + (ai * HALF + m * 16) * 4); rs[ai][m] = rsqrtf(((sp.x + sp.y) + (sp.z + sp.w)) * (1.f / 128.f) + EPS); }
#pragma unroll
    for (int bj = 0; bj < 2; ++bj) { const int head = u.pn * 2 + bj, c = wc * 32 + 8 * fq;
      const size_t tok0 = (size_t)(b * MLA_H + head) * SEQ + s0;
      u16* base = c < 64 ? km + tok0 * MLA_QK + (unsigned)(lrow * MLA_QK + c) : vm + tok0 * MLA_V + (unsigned)(lrow * MLA_V + (c - 64));
      const int ld = c < 64 ? MLA_QK : MLA_V;
#pragma unroll
      for (int ai = 0; ai < 2; ++ai)
#pragma unroll
        for (int m = 0; m < 4; ++m) { const float r = rs[ai][m];
          float v[8]; { const f32x4 a = acc[ai][bj][m][0] * r, bb = acc[ai][bj][m][1] * r; v[0] = a.x; v[1] = a.y; v[2] = a.z; v[3] = a.w; v[4] = bb.x; v[5] = bb.y; v[6] = bb.z; v[7] = bb.w; }
          *(u32x4*)(base + (ai * HALF + m * 16) * ld) = pk8(v); } }
  }
};
struct EpiPQ { u16* O; const float* ssq16;
  DEVI void operator()(const f32x4 (&acc)[2][2][4][2], const Unit& u, int wr, int wc, int fr, int fq) const {
    const int row0 = u.pm * BM + wr * 64 + fr, col0 = u.pn * BM + wc * 32 + 8 * fq;
#pragma unroll
    for (int ai = 0; ai < 2; ++ai)
#pragma unroll
      for (int m = 0; m < 4; ++m) { const int row = row0 + ai * HALF + m * 16;
        const f32x4* sp = (const f32x4*)(ssq16 + (size_t)row * 16); const f32x4 s4 = (sp[0] + sp[1]) + (sp[2] + sp[3]);
        const float rs = rsqrtf(((s4.x + s4.y) + (s4.z + s4.w)) * (1.f / DM) + EPS);
#pragma unroll
        for (int bj = 0; bj < 2; ++bj) { float v[8]; { const f32x4 a = acc[ai][bj][m][0] * rs, b = acc[ai][bj][m][1] * rs; v[0] = a.x; v[1] = a.y; v[2] = a.z; v[3] = a.w; v[4] = b.x; v[5] = b.y; v[6] = b.z; v[7] = b.w; }
          *(u32x4*)(O + (size_t)row * 2048 + col0 + bj * HALF) = pk8(v); } }
  }
};
struct EpiRes { u16* xg; float* ssq16;
  DEVI void operator()(const f32x4 (&acc)[2][2][4][2], const Unit& u, int wr, int wc, int fr, int fq) const {
    const int row0 = u.pm * BM + wr * 64 + fr, col0 = u.pn * BM + wc * 32 + 8 * fq;
#pragma unroll
    for (int ai = 0; ai < 2; ++ai)
#pragma unroll
      for (int m = 0; m < 4; ++m) { const int row = row0 + ai * HALF + m * 16; float ss = 0.f;
#pragma unroll
        for (int bj = 0; bj < 2; ++bj) { const size_t o = (size_t)row * DM + col0 + bj * HALF;
          float x[8]; unpk8(*(const u32x4*)(xg + o), x);
          const f32x4 a = acc[ai][bj][m][0], b = acc[ai][bj][m][1];
          x[0] += a.x; x[1] += a.y; x[2] += a.z; x[3] += a.w; x[4] += b.x; x[5] += b.y; x[6] += b.z; x[7] += b.w;
#pragma unroll
          for (int q = 0; q < 8; ++q) ss = fmaf(x[q], x[q], ss);
          *(u32x4*)(xg + o) = pk8(x); }
        ss += __shfl_xor(ss, 16); ss += __shfl_xor(ss, 32);
        if (fq == 0) ssq16[(size_t)row * 16 + u.pn * 4 + wc] = ss; }
  }
};
}


DEVI void lru_gate_item(const Params& p, int l, int mt, int n, char* lds) {
  const int tid = tidx(), lane = tid & 63, wid = tid >> 6, wm = wid >> 1, wn = wid & 1, r32 = lane & 31, hi = lane >> 5;
  const int srow = tid >> 3, sc = tid & 7, m0 = mt * 256;
  const u16* PROJ = (const u16*)(p.ws + WS_R1);
  GemmDesc g{}; g.proj = PROJ; g.cw = p.conv_w + l * 4 * LRU_W; g.cb = p.conv_b + l * LRU_W; g.ch0 = n * 64;
  char* Ab = lds; char* Bb = lds + 32768;
  { bf16x8 ar[4], br[4];
#pragma unroll
    for (int i = 0; i < 4; ++i) ar[i] = load_a<1>(g, m0 + srow + 64 * i, sc * 8);
    const u16* W = (const u16*)(p.ws + WS_WLRU) + (size_t)((l * 6 + n) * 2) * 128 * 64;
#pragma unroll
    for (int i = 0; i < 4; ++i) br[i] = *(const bf16x8*)(W + (size_t)(srow + 64 * i) * 64 + sc * 8);
#pragma unroll
    for (int i = 0; i < 4; ++i) { *(bf16x8*)(Ab + swz(srow + 64 * i, sc)) = ar[i]; *(bf16x8*)(Bb + (i >> 1) * 16384 + swz(srow + 64 * (i & 1), sc)) = br[i]; } }
  __syncthreads();
  bf16x8 a[2][4];
#pragma unroll
  for (int t = 0; t < 2; ++t)
#pragma unroll
    for (int k = 0; k < 4; ++k) a[t][k] = *(const bf16x8*)(Ab + swz(wm * 64 + t * 32 + r32, k * 2 + hi));
  const int jl = 32 * wn + r32, ch = n * 64 + jl;
  float xf[2][16];
#pragma unroll
  for (int t = 0; t < 2; ++t)
#pragma unroll
    for (int r = 0; r < 16; ++r) { const int row = wm * 64 + t * 32 + crow(r, hi); xf[t][r] = bf2f(*(const u16*)(Ab + swz(row, jl >> 3) + (jl & 7) * 2)); }
  const int bidx = m0 >> 13, s0 = (m0 & (SEQ - 1)) + wm * 64;
#pragma unroll
  for (int d = 0; d < 2; ++d) {
    f32x16 acc[2][2] = {{f32x16{}, f32x16{}}, {f32x16{}, f32x16{}}};
#pragma unroll
    for (int k = 0; k < 4; ++k) { bf16x8 b[2];
#pragma unroll
      for (int q = 0; q < 2; ++q) b[q] = *(const bf16x8*)(Bb + d * 16384 + swz(wn * 64 + q * 32 + r32, k * 2 + hi));
#pragma unroll
      for (int t = 0; t < 2; ++t)
#pragma unroll
        for (int q = 0; q < 2; ++q) acc[t][q] = __builtin_amdgcn_mfma_f32_32x32x16_bf16(a[t][k], b[q], acc[t][q], 0, 0, 0); }
    const float bav = p.lru_ba[((l * 2 + d) * 6 + n) * 64 + jl], bxv = p.lru_bx[((l * 2 + d) * 6 + n) * 64 + jl];
    const float cdec2 = -8.f * 1.4426950408889634f * log1pf(__expf(-p.lru_lambda[(l * 2 + d) * LRU_W + ch]));
    u16* le = (u16*)(p.ws + WS_LE); u16* lb = (u16*)(p.ws + WS_LB);
    float runP[2][4], runH[2][4];
#pragma unroll
    for (int t = 0; t < 2; ++t)
#pragma unroll
      for (int rr = 0; rr < 4; ++rr) {
        float ev[4], bv[4];
#pragma unroll
        for (int q = 0; q < 4; ++q) { const int r = rr * 4 + q;
          const float rg = __builtin_amdgcn_rcpf(1.f + __builtin_amdgcn_exp2f(-1.4426950408889634f * (acc[t][0][r] + bav)));
          const float ig = __builtin_amdgcn_rcpf(1.f + __builtin_amdgcn_exp2f(-1.4426950408889634f * (acc[t][1][r] + bxv)));
          const float aa = __builtin_amdgcn_exp2f(cdec2 * rg), e = 1.f - aa; ev[q] = e; bv[q] = __builtin_amdgcn_sqrtf(e * (2.f - e)) * ig * xf[t][r]; }
        const size_t o = (((size_t)(d * NB + bidx) * (SEQ / 8) + ((s0 + 32 * t + 8 * rr) >> 3)) * LRU_W + ch) * 8 + 4 * hi;
        const u32x2 ew = {pk2(ev[0], ev[1]), pk2(ev[2], ev[3])}, bw = {pk2(bv[0], bv[1]), pk2(bv[2], bv[3])};
        *(u32x2*)(le + o) = ew; *(u32x2*)(lb + o) = bw;
        const float a0 = 1.f - bflo(ew.x), a1 = 1.f - bfhi(ew.x), a2 = 1.f - bflo(ew.y), a3 = 1.f - bfhi(ew.y);
        const float b0 = bflo(bw.x), b1 = bfhi(bw.x), b2 = bflo(bw.y), b3 = bfhi(bw.y);
        if (d == 0) { runP[t][rr] = (a0 * a1) * (a2 * a3); runH[t][rr] = fmaf(a3, fmaf(a2, fmaf(a1, b0, b1), b2), b3); }
        else { runP[t][rr] = (a0 * a1) * (a2 * a3); runH[t][rr] = fmaf(a0, fmaf(a1, fmaf(a2, b3, b2), b1), b0); } }
    { float Pc = 1.f, Hc = 0.f;
#pragma unroll
      for (int i = 0; i < 8; ++i) { const int ii = d == 0 ? i : 7 - i, t = ii >> 2, rr = ii & 3;
        auto rp = __builtin_amdgcn_permlane32_swap(__float_as_uint(runP[t][rr]), __float_as_uint(runP[t][rr]), false, false);
        auto rh = __builtin_amdgcn_permlane32_swap(__float_as_uint(runH[t][rr]), __float_as_uint(runH[t][rr]), false, false);
        const float P0 = __uint_as_float(rp[0]), P1 = __uint_as_float(rp[1]), H0 = __uint_as_float(rh[0]), H1 = __uint_as_float(rh[1]);
        if (d == 0) { Hc = fmaf(P0, Hc, H0); Pc *= P0; Hc = fmaf(P1, Hc, H1); Pc *= P1; }
        else { Hc = fmaf(P1, Hc, H1); Pc *= P1; Hc = fmaf(P0, Hc, H0); Pc *= P0; } }
      if (hi == 0) { const size_t o = ((size_t)(d * NB + bidx) * NLCH + (s0 >> 6)) * LRU_W + ch;
        ((float*)(p.ws + WS_LP))[o] = Pc; ((float*)(p.ws + WS_LH))[o] = Hc; } }
  }
  __syncthreads();
}


DEVI void sort16_desc(float (&v)[16]) {
#pragma unroll
  for (int k = 2; k <= 16; k <<= 1)
#pragma unroll
    for (int j = k >> 1; j > 0; j >>= 1)
#pragma unroll
      for (int i = 0; i < 16; ++i) { const int l = i ^ j; if (l > i) { const float a = v[i], b = v[l]; const bool desc = (i & k) == 0;
          v[i] = desc ? fmaxf(a, b) : fminf(a, b); v[l] = desc ? fminf(a, b) : fmaxf(a, b); } }
}
DEVI void merge16_desc(float (&l)[16], const float (&s)[16]) {
#pragma unroll
  for (int i = 0; i < 16; ++i) l[i] = fmaxf(l[i], s[15 - i]);
#pragma unroll
  for (int st = 8; st >= 1; st >>= 1)
#pragma unroll
    for (int i = 0; i < 16; ++i) if ((i & st) == 0) ce_desc(l[i], l[i + st]);
}
DEVI void pair_merge16(float (&l)[16]) {
  float o[16];
#pragma unroll
  for (int i = 0; i < 16; ++i) o[i] = __shfl_xor(l[i], 1);
  merge16_desc(l, o);
}
DEVI void top16_from_C(const float* C, int row, int part, float (&l)[16]) {
#pragma unroll
  for (int i = 0; i < 16; ++i) l[i] = -3.0e38f;
#pragma unroll 1
  for (int bt = 0; bt < 4; ++bt) { float s[16];
#pragma unroll
    for (int i = 0; i < 16; ++i) { const int col = part * 64 + ((bt * 16 + i + row) & 63);
      s[i] = __uint_as_float((__float_as_uint(C[row * CLD + col]) & ~127u) | (unsigned)(127 - col)); }
    sort16_desc(s);
    merge16_desc(l, s); }
  pair_merge16(l);
}
DEVI void peer_route_item(const Params& p, int l, int mt, int h, char* lds) {
  const int tid = tidx(), row = tid >> 1, part = tid & 1, m0 = mt * 256;
  const u16* PQ = (const u16*)(p.ws + WS_R1);
  float t1[16], t2[16];
#pragma unroll
  for (int j = 0; j < 2; ++j) {
    GemmDesc g{}; g.A = PQ + (h * 2 + j) * 128; g.lda = 2048; g.Bt = (const u16*)(p.ws + WS_SUBK) + (size_t)(l * 2 + j) * 128 * 128; g.ldb = 128; g.KT = 2;
    gemm_core<0, 0>(g, m0, 0, lds);
    if (j == 0) top16_from_C((const float*)lds, row, part, t1); else top16_from_C((const float*)lds, row, part, t2);
    __syncthreads(); }
  constexpr int CA[50] = {0, 0, 0, 0, 0, 0, 0, 0, 0, 0, 0, 0, 0, 0, 0, 0, 1, 1, 1, 1, 1, 1, 1, 1, 2, 2, 2, 2, 2, 3, 3, 3, 3, 4, 4, 4, 5, 5, 6, 6, 7, 7, 8, 9, 10, 11, 12, 13, 14, 15};
  constexpr int CB[50] = {0, 1, 2, 3, 4, 5, 6, 7, 8, 9, 10, 11, 12, 13, 14, 15, 0, 1, 2, 3, 4, 5, 6, 7, 0, 1, 2, 3, 4, 0, 1, 2, 3, 0, 1, 2, 0, 1, 0, 1, 0, 1, 0, 0, 0, 0, 0, 0, 0, 0};
  float lo[16], hi2[16];
#pragma unroll
  for (int k = 0; k < 32; ++k) { float v = -3.0e38f;
    if (k < 25) { const float v0 = __uint_as_float((__float_as_uint(t1[CA[2 * k]] + t2[CB[2 * k]]) & ~255u) | (unsigned)(255 - (CA[2 * k] * 16 + CB[2 * k])));
      const float v1 = __uint_as_float((__float_as_uint(t1[CA[2 * k + 1]] + t2[CB[2 * k + 1]]) & ~255u) | (unsigned)(255 - (CA[2 * k + 1] * 16 + CB[2 * k + 1])));
      v = part ? v1 : v0; }
    if (k < 16) lo[k] = v; else hi2[k - 16] = v; }
  sort16_desc(lo); sort16_desc(hi2); merge16_desc(lo, hi2); pair_merge16(lo);
  const float mx = __uint_as_float(__float_as_uint(lo[0]) & ~255u);
  float w[16], sum = 0.f;
#pragma unroll
  for (int i = 0; i < 16; ++i) { w[i] = __expf(__uint_as_float(__float_as_uint(lo[i]) & ~255u) - mx); sum += w[i]; }
  const float inv = 1.f / sum;
  unsigned char* my = (unsigned char*)lds + tid * 32;
#pragma unroll
  for (int i = 0; i < 16; ++i) { my[i] = (unsigned char)(127u - (__float_as_uint(t1[i]) & 127u)); my[16 + i] = (unsigned char)(127u - (__float_as_uint(t2[i]) & 127u)); }
  unsigned ev[8]; float gv[8];
  const unsigned pm = 0u - (unsigned)part;
#pragma unroll
  for (int i = 0; i < 8; ++i) { const unsigned xb = __float_as_uint(lo[i]) ^ ((__float_as_uint(lo[i]) ^ __float_as_uint(lo[8 + i])) & pm); const unsigned code = 255u - (xb & 255u);
    const unsigned wb = __float_as_uint(w[i]) ^ ((__float_as_uint(w[i]) ^ __float_as_uint(w[8 + i])) & pm);
    ev[i] = (unsigned)my[code >> 4] * 128u + (unsigned)my[16 + (code & 15)]; gv[i] = __uint_as_float(wb) * inv; }
  const size_t o = ((size_t)(m0 + row) * 8 + h) * 16 + part * 8;
  *(u32x4*)((u16*)(p.ws + WS_EIDX) + o) = (u32x4){ev[0] | (ev[1] << 16), ev[2] | (ev[3] << 16), ev[4] | (ev[5] << 16), ev[6] | (ev[7] << 16)};
  *(f32x4*)((float*)(p.ws + WS_EGATE) + o) = (f32x4){gv[0], gv[1], gv[2], gv[3]}; *(f32x4*)((float*)(p.ws + WS_EGATE) + o + 4) = (f32x4){gv[4], gv[5], gv[6], gv[7]};
  __syncthreads();
}

DEVI void peer_convert_tables(const Params& p, int l, size_t i0, size_t istep) {
  const float* us = p.peer_u + (size_t)l * NEXP * DM; const float* vs = p.peer_v + (size_t)l * NEXP * DM;
  u8* ub = (u8*)(p.ws + WS_UB); u8* vbf = (u8*)(p.ws + WS_VB);
  for (size_t i = i0; i < (size_t)NEXP * 64; i += istep) {
    const size_t e = i >> 6; const int c16 = (int)(i & 63), s = c16 >> 3, cc = (c16 & 7) * 16;
    float a[16], b[16]; ld8(us + i * 16, a); ld8(us + i * 16 + 8, a + 8); ld8(vs + i * 16, b); ld8(vs + i * 16 + 8, b + 8);
    const size_t o = ((size_t)s * NEXP + e) * 128 + cc;
    *(u32x4*)(ub + o) = (u32x4){q8x4(a, PEER_SU), q8x4(a + 4, PEER_SU), q8x4(a + 8, PEER_SU), q8x4(a + 12, PEER_SU)};
    *(u32x4*)(vbf + o) = (u32x4){q8x4(b, PEER_SV), q8x4(b + 4, PEER_SV), q8x4(b + 8, PEER_SV), q8x4(b + 12, PEER_SV)}; }
}

constexpr int PH_PER_LAYER = 10, N_PHASES = 2 + DEPTH * PH_PER_LAYER;
DEVI void run_phase(const Params& pin, int ph, int vb, int nb, char* lds) {
  const bool dry = ph >= 100; if (dry) ph -= 100;
  Params p = pin; { size_t z = 0; asm volatile("" : "+s"(z)); p.ws = pin.ws + z; p.out = pin.out + z; } asm volatile("" : "+s"(vb));
  const int tid = tidx(), wid = tid >> 6, lane = tid & 63;
#ifdef ONLY_SP
  if (ONLY_SP >= 0 && ph == 0) return;
#endif
  if (ph == 0) { phase0(p, vb, nb, lds); return; }
  if (ph == N_PHASES - 1) {
    const float* ssq = (const float*)(p.ws + WS_SSQ); const u16* xg = (const u16*)(p.ws + WS_XG);
    for (size_t i = (size_t)vb * NTHREADS + tid; i < (size_t)T * DM / 8; i += (size_t)nb * NTHREADS) {
      const size_t t = i >> 7; const int c = (int)(i & 127) * 8;
      float s8[8]; ld8(ssq + t * 8, s8); const float rs = rsqrtf((((s8[0] + s8[1]) + (s8[2] + s8[3])) + ((s8[4] + s8[5]) + (s8[6] + s8[7]))) * (1.f / DM) + EPS);
      float x[8], g[8]; unpk8(*(const u32x4*)(xg + i * 8), x); ld8(p.norm_final + c, g);
#pragma unroll
      for (int q = 0; q < 8; ++q) x[q] *= rs * g[q];
      *(f32x4*)(p.out + i * 8) = (f32x4){x[0], x[1], x[2], x[3]}; *(f32x4*)(p.out + i * 8 + 4) = (f32x4){x[4], x[5], x[6], x[7]}; }
    return; }
  const int l = (ph - 1) / PH_PER_LAYER, sp = (ph - 1) % PH_PER_LAYER;
  u16* const XG = (u16*)(p.ws + WS_XG); u16* const PROJ = (u16*)(p.ws + WS_R1); u16* const MIX = (u16*)(p.ws + WS_MIX);
  constexpr int NMT = T / 256;
#ifdef ONLY_SP
  if (sp != ONLY_SP) return;
#endif
  switch (sp) {
  case 0: {
    pg8::Gemm g{XG, (const u16*)(p.ws + WS_WIN) + (size_t)l * INWP * DM, T, INWP, DM, DM, DM}; pg8::StaticOrder S; S.init(T, INWP, nb, vb);
    pg8::EpiProj e{PROJ, p.pos, (const float*)(p.ws + WS_SSQ), (float*)(p.ws + WS_SSQQ), (float*)(p.ws + WS_SSQKV)};
    pg8::gemm_phase((PG8_LAS unsigned char*)lds, g, S, e);
    if (!dry) { if (nb == 256) { if (vb >= 128) peer_convert_tables(p, l, (size_t)(vb - 128) * NTHREADS + tid, (size_t)128 * NTHREADS); }
                else peer_convert_tables(p, l, (size_t)vb * NTHREADS + tid, (size_t)nb * NTHREADS); }
  } break;
  case 1: {
    { pg8::Gemm g{PROJ + PC_CQ, (const u16*)(p.ws + WS_WUQ) + (size_t)l * 768 * 256, T, 768, 256, INWP, 256}; pg8::StaticOrder S; S.init(T, 768, nb, vb);
      pg8::EpiQ2 e{(u16*)(p.ws + WS_QM), (const float*)(p.ws + WS_SSQQ)};
      pg8::gemm_phase((PG8_LAS unsigned char*)lds, g, S, e); }
    { pg8::Gemm g{PROJ + PC_CKV, (const u16*)(p.ws + WS_WUKV) + (size_t)l * 768 * 128, T, 768, 128, INWP, 128}; pg8::StaticOrder S; S.init(T, 768, nb, nb - 1 - vb);
      pg8::EpiKV2 e{(u16*)(p.ws + WS_KM), (u16*)(p.ws + WS_VM), (const float*)(p.ws + WS_SSQKV)};
      pg8::gemm_phase((PG8_LAS unsigned char*)lds, g, S, e); }
    for (int i = vb * NTHREADS + tid; i < T * MLA_H * 4; i += nb * NTHREADS) { const int c = (i & 3) * 8, h = (i >> 2) % MLA_H, row = i / (4 * MLA_H), b = row >> 13, s = row & (SEQ - 1);
      *(u32x4*)((u16*)(p.ws + WS_KM) + ((size_t)(b * MLA_H + h) * SEQ + s) * MLA_QK + 64 + c) = *(const u32x4*)(PROJ + (size_t)row * INWP + PC_KR + c); }
    for (int it = vb; it < NMT * 6; it += nb) lru_gate_item(p, l, it / 6, it % 6, lds);
    for (int it = vb; it < NB * 64 * 2; it += nb) swa_item(p, l, it, lds);
  } break;
  case 2: {
    { const int wi = vb * 8 + wid; if (wi < 48) lru_passB(p, wi, lane); __syncthreads(); }
    for (int k = 0; k * nb + vb < NB * MLA_H * 32; ++k) {
      int pair, qb;
      if (nb == 256) { pair = k * 8 + (vb & 7); qb = vb >> 3; } else { const int it = k * nb + vb; pair = it >> 5; qb = it & 31; }
      mla_item(p, pair, qb, lds);
    }
  } break;
  case 3: {
#ifndef NO_LRUF
    if (!dry) for (int it = vb; it < NB * NLCH; it += nb) lru_final(p, it, lds);
#endif
    for (int t = vb * 8 + wid; t < T; t += nb * 8) {
      u32x4* rp = (u32x4*)(MIX + (size_t)t * DM + lane * 16);
      float v[16]; unpk8(rp[0], v); unpk8(rp[1], v + 8);
      float s = 0.f;
#pragma unroll
      for (int q = 0; q < 16; ++q) s = fmaf(v[q], v[q], s);
      const int sg = lane < 24 ? 0 : (lane < 48 ? 1 : 2);
      const float s0 = wave_sum(sg == 0 ? s : 0.f), s2 = wave_sum(sg == 2 ? s : 0.f);
      const float rs = sg == 0 ? rsqrtf(s0 * (1.f / 384.f) + EPS) : rsqrtf(s2 * (1.f / 256.f) + EPS);
      if (sg != 1) {
#pragma unroll
        for (int q = 0; q < 16; ++q) v[q] *= rs;
        rp[0] = pk8(v); rp[1] = pk8(v + 8); } }
  } break;
  case 4: {
    { pg8::Gemm g{MIX, (const u16*)(p.ws + WS_WOUT) + (size_t)l * DM * DM, T, DM, DM, DM, DM}; pg8::StaticOrder S; S.init(T, DM, nb, vb);
      pg8::EpiRes e{dry ? (u16*)(p.ws + WS_R1) : XG, (float*)(p.ws + WS_SSQ16)};
      pg8::gemm_phase((PG8_LAS unsigned char*)lds, g, S, e); }
  } break;
  case 5: {
    pg8::Gemm g{XG, (const u16*)(p.ws + WS_WQ) + (size_t)l * 2048 * DM, T, 2048, DM, DM, DM}; pg8::StaticOrder S; S.init(T, 2048, nb, vb);
    pg8::EpiPQ e{PROJ, (const float*)(p.ws + WS_SSQ16)};
    pg8::gemm_phase((PG8_LAS unsigned char*)lds, g, S, e);
  } break;
  case 6: {
    for (int it = vb; it < NMT * 8; it += nb) peer_route_item(p, l, it >> 3, it & 7, lds);
    if (!dry) peer_xn_pass(p, l, vb, nb);
  } break;
  case 7: case 9: {
    const bool last = l == DEPTH - 1;
    float* xo = dry ? (float*)(p.ws + WS_PD) : p.out;
    int s0, s1, tb, ts;
    if ((nb & 7) == 0) { s0 = vb & 7; s1 = s0 + 1; tb = (vb >> 3) * 8 + wid; ts = (nb >> 3) * 8; } else { s0 = 0; s1 = 8; tb = vb * 8 + wid; ts = nb * 8; }
#pragma unroll 1
    for (int s = s0; s < s1; ++s) { if (sp == 7) peer_slice_phase<false>(p, s, tb, ts, lane, p.out, xo, last); else peer_slice_phase<true>(p, s, tb, ts, lane, p.out, xo, last); }
  } break;
  case 8: {
    const u16* pd = (const u16*)(p.ws + WS_PD); const float* eg = (const float*)(p.ws + WS_EGATE); u16* cc = (u16*)(p.ws + WS_CC); float* cs = (float*)(p.ws + WS_CS);
    for (int t = vb * 8 + wid; t < T; t += nb * 8) {
      f32x2 a = {0.f, 0.f};
#pragma unroll
      for (int s = 0; s < 8; ++s) { const unsigned w = *(const unsigned*)(pd + ((size_t)s * T + t) * 128 + 2 * lane); a.x += bflo(w); a.y += bfhi(w); }
      const f32x2 g = *(const f32x2*)(eg + (size_t)t * 128 + 2 * lane);
      const float c0 = gelu_erf(a.x * (1.f / PEER_SU)) * g.x, c1 = gelu_erf(a.y * (1.f / PEER_SU)) * g.y;
      float mx = fmaxf(fabsf(c0), fabsf(c1));
#pragma unroll
      for (int o = 1; o < 64; o <<= 1) mx = fmaxf(mx, __shfl_xor(mx, o));
      const float st = fmaxf(mx, 1e-30f) * (1.f / 127.f), ist = 1.f / st;
      int q0 = __float2int_rn(c0 * ist), q1 = __float2int_rn(c1 * ist);
      cc[(size_t)t * 64 + lane] = (u16)(((unsigned)q0 & 255u) | (((unsigned)q1 & 255u) << 8));
      if (lane == 0) cs[t] = st * (1.f / PEER_SV);
    }
  } break;
  }
}

#define XB_TMO      128
#define XB_XCNT(j)  (256  + 64 * (j))
#define XB_XSUB(j)  (1280 + 64 * (j))
#define XB_XGEN(j)  (2304 + 64 * (j))
#define XB_TOP      3328
#define XB_TOPGEN   3392
#define XCD_BAR_WORDS 3456
#define XB_SPIN_CAP (1u << 23)
DEVI unsigned xb_ld(unsigned* p) { return __hip_atomic_load(p, __ATOMIC_RELAXED, __HIP_MEMORY_SCOPE_AGENT); }
DEVI unsigned xb_add(unsigned* p, unsigned v) { return __hip_atomic_fetch_add(p, v, __ATOMIC_RELAXED, __HIP_MEMORY_SCOPE_AGENT); }
DEVI unsigned xb_xcc_id() { return (unsigned)__builtin_amdgcn_s_getreg((3 << 11) | 20) & 0xFu; }
#define XB_SPIN(cond, bar) do { unsigned _sp = 0; while (cond) { __builtin_amdgcn_s_sleep(1); \
    if ((++_sp & 255u) == 0u) { if (xb_ld(&(bar)[XB_TMO])) break; if (_sp > XB_SPIN_CAP) { atomicAdd(&(bar)[XB_TMO], 1u); break; } } } } while (0)
struct XcdBarrier { unsigned* bar; unsigned x; volatile unsigned* st; };
DEVI XcdBarrier xcd_barrier_post(unsigned* bar, volatile unsigned* st) {
  XcdBarrier b; b.bar = bar; b.x = xb_xcc_id(); b.st = st;
  if (threadIdx.x == 0) (void)xb_add(&bar[XB_XCNT(b.x)], 1u);
  return b;
}
DEVI void xcd_barrier_complete(unsigned* bar, unsigned x, unsigned& nloc, unsigned& nx) {
  const unsigned G = gridDim.x * gridDim.y * gridDim.z;
  unsigned sum, cnt, mine, sp = 0u;
  for (;;) {
    sum = 0u; cnt = 0u; mine = 0u;
#pragma unroll
    for (unsigned j = 0; j < 16; ++j) { const unsigned c = xb_ld(&bar[XB_XCNT(j)]); sum += c; cnt += (c > 0u) ? 1u : 0u; mine = (j == x) ? c : mine; }
    if (sum == G) break;
    __builtin_amdgcn_s_sleep(1);
    if ((++sp & 255u) == 0u) { if (xb_ld(&bar[XB_TMO])) break; if (sp > XB_SPIN_CAP) { atomicAdd(&bar[XB_TMO], 1u); break; } }
  }
  nloc = mine > 0u ? mine : 1u; nx = cnt > 0u ? cnt : 1u;
}
DEVI void xcd_barrier(const XcdBarrier& b) {
  asm volatile("s_waitcnt vmcnt(0)" ::: "memory");
  __syncthreads();
  if (threadIdx.x == 0) {
    unsigned* bar = b.bar;
    __builtin_amdgcn_s_waitcnt(0);
    unsigned nloc = b.st[0], nx = b.st[1];
    if (nloc == 0u) { xcd_barrier_complete(bar, b.x, nloc, nx); b.st[0] = nloc; b.st[1] = nx; }
    const unsigned old = xb_add(&bar[XB_XSUB(b.x)], 1u);
    const unsigned gen = old / nloc;
    if (old + 1u == (gen + 1u) * nloc) {
      __builtin_amdgcn_fence(__ATOMIC_RELEASE, "agent");
      asm volatile("s_waitcnt vmcnt(0)" ::: "memory");
      const unsigned og = xb_add(&bar[XB_TOP], 1u);
      const unsigned tg = og / nx;
      if (og + 1u == (tg + 1u) * nx) xb_add(&bar[XB_TOPGEN], 1u);
      else XB_SPIN(xb_ld(&bar[XB_TOPGEN]) == tg, bar);
      __builtin_amdgcn_fence(__ATOMIC_ACQUIRE, "agent");
      xb_add(&bar[XB_XGEN(b.x)], 1u);
      asm volatile("s_waitcnt vmcnt(0)" ::: "memory");
    } else {
      XB_SPIN(xb_ld(&bar[XB_XGEN(b.x)]) == gen, bar);
      __builtin_amdgcn_fence(__ATOMIC_ACQUIRE, "agent");
      asm volatile("s_waitcnt vmcnt(0)" ::: "memory");
    }
  }
  __syncthreads();
}

__global__ void __launch_bounds__(NTHREADS, 2) mega(Params p) {
  extern __shared__ __attribute__((aligned(16))) char smem[];
  cg::grid_group grid = cg::this_grid();
  const int nb = gridDim.x, vb = blockIdx.x;
  volatile unsigned* st = (volatile unsigned*)(smem + LDS_BYTES - 16);
  if (threadIdx.x == 0) { st[0] = 0u; st[1] = 0u; }
  __syncthreads();
  const XcdBarrier bar = xcd_barrier_post((unsigned*)p.ws, st);
#define GRID_BAR(first) do { if (first) grid.sync(); else xcd_barrier(bar); } while (0)
  for (int ph = p.ph_lo; ph < p.ph_hi; ++ph) {
#ifdef PROBE_DUP
    if (ph > 0 && ph < N_PHASES - 1 && ((PROBE_DUP >> ((ph - 1) % PH_PER_LAYER)) & 1)) { run_phase(p, ph + 100, vb, nb, smem); GRID_BAR(false); }
#endif
    run_phase(p, ph, vb, nb, smem);
    if (ph + 1 < p.ph_hi) GRID_BAR(ph == p.ph_lo);
  }
}

#ifndef N_LAUNCH_SPLIT
#define N_LAUNCH_SPLIT 0
#endif
extern "C" void kernel_launch(void* const* d_in, const int* in_sizes, int n_in, void* d_out, int out_size, void* d_ws, size_t ws_size, hipStream_t stream) {
  static int grid_blocks = 0;
  if (grid_blocks == 0) {
    if (n_in != 24 || out_size != T * DM || ws_size < WS_NEED) { fprintf(stderr, "kernel_launch: unexpected shapes n_in %d out %d ws %zu\n", n_in, out_size, ws_size); grid_blocks = -1; return; }
    int dev = 0, cus = 0, per_cu = 0;
    (void)hipGetDevice(&dev); (void)hipDeviceGetAttribute(&cus, hipDeviceAttributeMultiprocessorCount, dev);
    if (hipFuncSetAttribute((const void*)mega, hipFuncAttributeMaxDynamicSharedMemorySize, LDS_BYTES) != hipSuccess) { fprintf(stderr, "kernel_launch: hipFuncSetAttribute failed\n"); grid_blocks = -1; return; }
    if (hipOccupancyMaxActiveBlocksPerMultiprocessor(&per_cu, (const void*)mega, NTHREADS, LDS_BYTES) != hipSuccess || per_cu < 1) { fprintf(stderr, "kernel_launch: occupancy query failed (%d)\n", per_cu); grid_blocks = -1; return; }
    grid_blocks = cus * 1;
    fprintf(stderr, "kernel_launch: cus %d per_cu %d grid %d\n", cus, per_cu, grid_blocks);
  }
  if (grid_blocks < 0) return;
  if (hipMemsetAsync(d_ws, 0, 65536, stream) != hipSuccess) { fprintf(stderr, "kernel_launch: memset failed\n"); return; }
  Params p{};
  p.x = (const float*)d_in[0]; p.pos = (const int*)d_in[1]; p.norm_mix = (const float*)d_in[2]; p.w_in = (const float*)d_in[3]; p.q_norm = (const float*)d_in[4];
  p.w_uq = (const float*)d_in[5]; p.kv_norm = (const float*)d_in[6]; p.w_ukv = (const float*)d_in[7]; p.conv_w = (const float*)d_in[8]; p.conv_b = (const float*)d_in[9];
  p.lru_wa = (const float*)d_in[10]; p.lru_ba = (const float*)d_in[11]; p.lru_wx = (const float*)d_in[12]; p.lru_bx = (const float*)d_in[13]; p.lru_lambda = (const float*)d_in[14];
  p.swa_sink = (const float*)d_in[15]; p.grp_norm = (const float*)d_in[16]; p.w_out = (const float*)d_in[17]; p.norm_ffn = (const float*)d_in[18]; p.peer_wq = (const float*)d_in[19];
  p.peer_subkeys = (const float*)d_in[20]; p.peer_u = (const float*)d_in[21]; p.peer_v = (const float*)d_in[22]; p.norm_final = (const float*)d_in[23];
  p.out = (float*)d_out; p.ws = (unsigned char*)d_ws;
#if N_LAUNCH_SPLIT
  for (int ph = 0; ph < N_PHASES; ++ph) {
    p.ph_lo = ph; p.ph_hi = ph + 1;
    void* args[] = {&p};
    hipError_t e = hipLaunchCooperativeKernel((const void*)mega, dim3(grid_blocks), dim3(NTHREADS), args, LDS_BYTES, stream);
    if (e != hipSuccess) { fprintf(stderr, "kernel_launch: launch of phase %d failed: %s\n", ph, hipGetErrorString(e)); break; }
  }
#else
  p.ph_lo = 0; p.ph_hi = N_PHASES;
  void* args[] = {&p};
  hipError_t e = hipLaunchCooperativeKernel((const void*)mega, dim3(grid_blocks), dim3(NTHREADS), args, LDS_BYTES, stream);
  if (e != hipSuccess) fprintf(stderr, "kernel_launch: cooperative launch failed: %s (grid %d)\n", hipGetErrorString(e), grid_blocks);
#endif
}
```

```cpp
#include <hip/hip_runtime.h>
#include <hip/hip_cooperative_groups.h>
#include <cstdio>
#include <cstdint>
namespace cg = cooperative_groups;

#define DEVI __device__ __forceinline__
typedef unsigned short u16;
typedef short bf16x8 __attribute__((ext_vector_type(8)));
typedef short s16x4 __attribute__((ext_vector_type(4)));
typedef float f32x2 __attribute__((ext_vector_type(2)));
typedef float f32x4 __attribute__((ext_vector_type(4)));
typedef float f32x16 __attribute__((ext_vector_type(16)));
typedef unsigned u32x4 __attribute__((ext_vector_type(4)));
typedef unsigned u32x2 __attribute__((ext_vector_type(2)));
typedef __bf16 bf16x2_t __attribute__((ext_vector_type(2)));

constexpr int NB = 4, SEQ = 8192, T = NB * SEQ, DM = 1024, DEPTH = 2;
constexpr int MLA_H = 6, MLA_QK = 96, MLA_V = 64;
constexpr int LRU_W = 384;
constexpr int INW = 1696, INWP = 1792;
constexpr int PC_CQ = 0, PC_CKV = 256, PC_SQ = 384, PC_SK = 640, PC_SV = 768, PC_LX = 896, PC_LG = 1280, PC_KR = 1664;
constexpr int OC_CQ = 0, OC_CKV = 256, OC_KR = 384, OC_SQ = 416, OC_SK = 672, OC_SV = 800, OC_LX = 928, OC_LG = 1312;
constexpr int NEXP = 16384;
constexpr float EPS = 1e-6f;
constexpr int NTHREADS = 512;
constexpr int LDS_BYTES = 160 * 1024;

constexpr size_t MiB = 1u << 20;
constexpr size_t WS_CTL = 0;
constexpr size_t WS_WIN = 4 * MiB;
constexpr size_t WS_WQ = 11 * MiB;
constexpr size_t WS_WOUT = 19 * MiB;
constexpr size_t WS_WUQ = 23 * MiB;
constexpr size_t WS_WUKV = WS_WUQ + 2 * 768 * 256 * 2;
constexpr size_t WS_WLRU = WS_WUKV + 2 * 768 * 128 * 2;
constexpr size_t WS_SUBK = WS_WLRU + 2 * 6 * 2 * 128 * 64 * 2;
constexpr size_t WS_XG = 25 * MiB;
constexpr size_t WS_R1 = 89 * MiB;
constexpr size_t WS_QM = 217 * MiB;
constexpr size_t WS_KM = 253 * MiB;
constexpr size_t WS_VM = 289 * MiB;
constexpr size_t WS_LE = 313 * MiB;
constexpr size_t WS_LB = 361 * MiB;
constexpr size_t WS_MIX = 409 * MiB;
constexpr size_t WS_UB = 478 * MiB;
constexpr size_t WS_VB = 494 * MiB;
constexpr size_t WS_TOP = 281 * MiB;
constexpr size_t WS_EIDX = 313 * MiB;
constexpr size_t WS_EGATE = 329 * MiB;
constexpr size_t WS_CC = 345 * MiB;
constexpr size_t WS_SSQ = 361 * MiB;
constexpr size_t WS_SSQ16 = 363 * MiB;
constexpr size_t WS_SSQQ = 476 * MiB;
constexpr size_t WS_SSQKV = 477 * MiB;
constexpr size_t WS_PD = 89 * MiB;
constexpr float PEER_SU = 903.f, PEER_SV = 56.f;
constexpr size_t WS_CS = 349 * MiB;
constexpr size_t WS_XQ = 249 * MiB;
constexpr size_t WS_SX = 281 * MiB;
constexpr size_t WS_END = 473 * MiB;

__device__ const float ROPE_HI[32] = {1.591549367e-01f, 1.193493679e-01f, 8.949939907e-02f, 6.711508334e-02f, 5.032921210e-02f, 3.774158657e-02f, 2.830219641e-02f, 2.122365311e-02f, 1.591549441e-02f, 1.193493698e-02f, 8.949940093e-03f, 6.711508147e-03f, 5.032921210e-03f, 3.774158424e-03f, 2.830219688e-03f, 2.122365171e-03f, 1.591549488e-03f, 1.193493721e-03f, 8.949940093e-04f, 6.711508031e-04f, 5.032921326e-04f, 3.774158540e-04f, 2.830219455e-04f, 2.122365258e-04f, 1.591549371e-04f, 1.193493736e-04f, 8.949940093e-05f, 6.711508468e-05f, 5.032921035e-05f, 3.774158540e-05f, 2.830219637e-05f, 2.122365186e-05f};
__device__ const float ROPE_LO[32] = {6.420638243e-09f, 2.294664903e-09f, 2.542919653e-09f, -3.316028840e-10f, 5.173299289e-12f, -1.848551645e-09f, -5.826552019e-10f, -3.431038786e-10f, -1.029942243e-10f, 4.320196978e-11f, 6.802744479e-11f, 1.531042237e-10f, 5.173301024e-13f, 4.797548470e-11f, -1.048316434e-10f, 1.053879969e-10f, -5.686555046e-11f, -1.896286773e-11f, 6.802744999e-12f, 2.695195456e-11f, -1.158979943e-11f, -6.843983713e-12f, 1.279990003e-11f, 1.807650600e-12f, 5.954976963e-12f, -3.351478166e-12f, 6.802744674e-13f, -1.670379113e-12f, 1.751403167e-12f, -6.843983930e-13f, -5.389994549e-13f, 9.083608431e-13f};

DEVI int tidx() { int t = __builtin_amdgcn_workitem_id_x(); asm volatile("" : "+v"(t)); return t; }
DEVI float bf2f(unsigned h) { return __uint_as_float(h << 16); }
DEVI float bflo(unsigned w) { return __uint_as_float(w << 16); }
DEVI float bfhi(unsigned w) { return __uint_as_float(w & 0xffff0000u); }
DEVI unsigned pk2(float lo, float hi) { f32x2 v = {lo, hi}; bf16x2_t b = __builtin_convertvector(v, bf16x2_t); return __builtin_bit_cast(unsigned, b); }
DEVI u16 f2bf(float f) { return (u16)(pk2(f, 0.f) & 0xffffu); }
DEVI u32x4 pk8(const float* v) { u32x4 w; w.x = pk2(v[0], v[1]); w.y = pk2(v[2], v[3]); w.z = pk2(v[4], v[5]); w.w = pk2(v[6], v[7]); return w; }
DEVI void unpk8(u32x4 w, float* v) { v[0] = bflo(w.x); v[1] = bfhi(w.x); v[2] = bflo(w.y); v[3] = bfhi(w.y); v[4] = bflo(w.z); v[5] = bfhi(w.z); v[6] = bflo(w.w); v[7] = bfhi(w.w); }
DEVI void ld8(const float* p, float* v) { const f32x4 a = *(const f32x4*)p, b = *(const f32x4*)(p + 4); v[0] = a.x; v[1] = a.y; v[2] = a.z; v[3] = a.w; v[4] = b.x; v[5] = b.y; v[6] = b.z; v[7] = b.w; }
DEVI int crow(int r, int hi) { return (r & 3) + 8 * (r >> 2) + 4 * hi; }
DEVI float wave_sum(float v) {
#pragma unroll
  for (int o = 1; o < 64; o <<= 1) v += __shfl_xor(v, o);
  return v;
}
DEVI void rope_sc(float pos, int fidx, float& sn, float& cs) {
  const float chi = ROPE_HI[fidx], clo = ROPE_LO[fidx];
  const float t = pos * chi, e = fmaf(pos, chi, -t);
  float fr = t - rintf(t);
  fr = fr + (e + pos * clo);
  sn = __builtin_amdgcn_sinf(fr); cs = __builtin_amdgcn_cosf(fr);
}
DEVI float sigmoidf_(float x) { return 1.f / (1.f + __expf(-x)); }
DEVI float gelu_erf(float x) { return 0.5f * x * (1.f + erff(x * 0.70710678118654752f)); }

struct Params {
  const float* x; const int* pos; const float* norm_mix; const float* w_in; const float* q_norm; const float* w_uq; const float* kv_norm; const float* w_ukv;
  const float* conv_w; const float* conv_b; const float* lru_wa; const float* lru_ba; const float* lru_wx; const float* lru_bx; const float* lru_lambda;
  const float* swa_sink; const float* grp_norm; const float* w_out; const float* norm_ffn; const float* peer_wq; const float* peer_subkeys;
  const float* peer_u; const float* peer_v; const float* norm_final;
  float* out; unsigned char* ws;
  int ph_lo, ph_hi;
};

DEVI void tconv_item(const float* W, int ldw, int src_c0, u16* WT, int K, int dst_r0, const float* gain, float* scr, int kb, int nb, int lane, int pg = 0) {
  const int k0 = 64 * kb, n0 = 32 * nb;
#pragma unroll 8
  for (int i = 0; i < 32; ++i) { const int kk = 2 * i + (lane >> 5); float g = gain ? gain[k0 + kk] : 1.f; scr[kk * 33 + (lane & 31)] = g * W[(size_t)(k0 + kk) * ldw + src_c0 + n0 + (lane & 31)]; }
  __builtin_amdgcn_s_waitcnt(0xc07f); asm volatile("" ::: "memory");
  const int c = lane & 7;
#pragma unroll
  for (int j = 0; j < 4; ++j) { const int n = (lane >> 3) + 8 * j; const float* s = scr + (8 * c) * 33 + n;
    u32x4 o; o.x = pk2(s[0 * 33], s[1 * 33]); o.y = pk2(s[2 * 33], s[3 * 33]); o.z = pk2(s[4 * 33], s[5 * 33]); o.w = pk2(s[6 * 33], s[7 * 33]);
    int nn = n0 + n; if (pg > 0) { const int g = nn & ~(pg - 1), i = nn & (pg - 1), hw = pg >> 1; nn = g + (i < hw ? 2 * i : 2 * (i - hw) + 1); }
    else if (pg < 0) { const int j = nn % 96; if (j >= 64) { const int i = j - 64; nn = nn - i + (i < 16 ? 2 * i : 2 * (i - 16) + 1); } }
    *(u32x4*)(WT + (size_t)(dst_r0 + nn) * K + k0 + 8 * c) = o; }
  __builtin_amdgcn_s_waitcnt(0xc07f); asm volatile("" ::: "memory");
}

DEVI void p0_item(const Params& p, int it, float* scr, int lane) {
  const int l = it / 2552; int r = it - l * 2552;
  const float* win = p.w_in + (size_t)l * DM * INW; u16* wint = (u16*)(p.ws + WS_WIN) + (size_t)l * INWP * DM; const float* gm = p.norm_mix + l * DM;
#define SEG(W, ldw, sc0, ncols, WT, K, dr0, gain, pg) { const int nnb_ = (ncols) / 32, ni_ = ((K) / 64) * nnb_; if (r < ni_) { tconv_item(W, ldw, sc0, WT, K, dr0, gain, scr, r / nnb_, r % nnb_, lane, pg); return; } r -= ni_; }
  SEG(win, INW, OC_CQ, 256, wint, DM, PC_CQ, gm, 0)
  SEG(win, INW, OC_CKV, 128, wint, DM, PC_CKV, gm, 0)
  SEG(win, INW, OC_SQ, 256, wint, DM, PC_SQ, gm, 64)
  SEG(win, INW, OC_SK, 128, wint, DM, PC_SK, gm, 64)
  SEG(win, INW, OC_SV, 128, wint, DM, PC_SV, gm, 0)
  SEG(win, INW, OC_LX, 384, wint, DM, PC_LX, gm, 0)
  SEG(win, INW, OC_LG, 384, wint, DM, PC_LG, gm, 0)
  SEG(win, INW, OC_KR, 32, wint, DM, PC_KR, gm, 32)
  SEG(p.peer_wq + (size_t)l * DM * 2048, 2048, 0, 2048, (u16*)(p.ws + WS_WQ) + (size_t)l * 2048 * DM, DM, 0, p.norm_ffn + l * DM, 0)
  SEG(p.w_out + (size_t)l * DM * DM, DM, 0, DM, (u16*)(p.ws + WS_WOUT) + (size_t)l * DM * DM, DM, 0, p.grp_norm + l * DM, 0)
  SEG(p.w_uq + (size_t)l * 256 * 576, 576, 0, 576, (u16*)(p.ws + WS_WUQ) + (size_t)l * 768 * 256, 256, 0, p.q_norm + l * 256, -1)
  SEG(p.w_ukv + (size_t)l * 128 * 768, 768, 0, 768, (u16*)(p.ws + WS_WUKV) + (size_t)l * 768 * 128, 128, 0, p.kv_norm + l * 128, 0)
#undef SEG
  { const int nbk = r & 1, ax = (r >> 1) & 1, n = (r >> 2) % 6, d = (r >> 2) / 6;
    const float* W = (ax ? p.lru_wx : p.lru_wa) + ((size_t)(l * 2 + d) * 6 + n) * 4096;
    u16* WT = (u16*)(p.ws + WS_WLRU) + ((size_t)((l * 6 + n) * 2 + d)) * 128 * 64;
    tconv_item(W, 64, 0, WT, 64, 32 * nbk + 32 * ax, nullptr, scr, 0, nbk, lane); }
}

DEVI void phase0(const Params& p, int vb, int nb, char* lds) {
  const int tid = tidx(), lane = tid & 63, wid = tid >> 6;
  float* scr = (float*)(lds + wid * 16384);
  const int gw = vb * 8 + wid, ngw = nb * 8;
  for (int it = gw; it < DEPTH * 2552; it += ngw) p0_item(p, it, scr, lane);
  for (int i = vb * NTHREADS + tid; i < DEPTH * 96 * DM / 8; i += nb * NTHREADS) { const int l = i / (96 * DM / 8), r = i % (96 * DM / 8);
    *(u32x4*)((u16*)(p.ws + WS_WIN) + ((size_t)l * INWP + INW) * DM + (size_t)r * 8) = (u32x4){0, 0, 0, 0}; }
  for (int i = vb * NTHREADS + tid; i < DEPTH * 192 * 256 / 8; i += nb * NTHREADS) { const int l = i / (192 * 256 / 8), r = i % (192 * 256 / 8);
    *(u32x4*)((u16*)(p.ws + WS_WUQ) + ((size_t)l * 768 + 576) * 256 + (size_t)r * 8) = (u32x4){0, 0, 0, 0}; }
  for (int i = vb * NTHREADS + tid; i < DEPTH * 2 * 128 * 128 / 8; i += nb * NTHREADS) {
    float a[8]; ld8(p.peer_subkeys + (size_t)i * 8, a);
    *(u32x4*)((u16*)(p.ws + WS_SUBK) + (size_t)i * 8) = pk8(a); }
  { float* ssq = (float*)(p.ws + WS_SSQ); u16* xg = (u16*)(p.ws + WS_XG);
    for (int t = gw * 2; t < T; t += ngw * 2) {
      float a[2][16];
#pragma unroll
      for (int u = 0; u < 2; ++u) { ld8(p.x + (size_t)(t + u) * DM + lane * 16, a[u]); ld8(p.x + (size_t)(t + u) * DM + lane * 16 + 8, a[u] + 8); }
#pragma unroll
      for (int u = 0; u < 2; ++u) { float s = 0.f;
#pragma unroll
        for (int q = 0; q < 16; ++q) s = fmaf(a[u][q], a[u][q], s);
        s += __shfl_xor(s, 1); s += __shfl_xor(s, 2); s += __shfl_xor(s, 4);
        if ((lane & 7) == 0) ssq[(size_t)(t + u) * 8 + (lane >> 3)] = s;
        u32x4* o = (u32x4*)(xg + (size_t)(t + u) * DM + lane * 16); o[0] = pk8(a[u]); o[1] = pk8(a[u] + 8); } } }
}

DEVI int swz(int row, int c) { return row * 128 + ((c ^ ((row >> 1) & 7)) << 4); }
constexpr int CLD = 132;
constexpr int LDS_RS = 135168;

struct GemmDesc {
  const u16* A; int lda; const u16* Bt; int ldb; int KT;
  float inv0;
  const u16* proj; const float* cw; const float* cb; int ch0;
};

template <int AMODE> DEVI bf16x8 load_a(const GemmDesc& g, int row, int kcol) {
  if constexpr (AMODE == 0) {
    return *(const bf16x8*)(g.A + (size_t)row * g.lda + kcol);
  } else {
    const int s = row & (SEQ - 1), ch = g.ch0 + kcol;
    float a[8];
    { const f32x4 b0 = *(const f32x4*)(g.cb + ch), b1 = *(const f32x4*)(g.cb + ch + 4); a[0] = b0.x; a[1] = b0.y; a[2] = b0.z; a[3] = b0.w; a[4] = b1.x; a[5] = b1.y; a[6] = b1.z; a[7] = b1.w; }
#pragma unroll
    for (int tap = 0; tap < 4; ++tap) {
      const int ss = s - 1 + tap;
      if (ss >= 0 && ss < SEQ) {
        const u32x4 v = *(const u32x4*)(g.proj + (size_t)(row - 1 + tap) * INWP + PC_LX + ch);
        float x[8]; unpk8(v, x);
        const f32x4 w0 = *(const f32x4*)(g.cw + tap * LRU_W + ch), w1 = *(const f32x4*)(g.cw + tap * LRU_W + ch + 4);
        a[0] += w0.x * x[0]; a[1] += w0.y * x[1]; a[2] += w0.z * x[2]; a[3] += w0.w * x[3];
        a[4] += w1.x * x[4]; a[5] += w1.y * x[5]; a[6] += w1.z * x[6]; a[7] += w1.w * x[7];
      }
    }
    const u32x4 o = pk8(a);
    return __builtin_bit_cast(bf16x8, o);
  }
}

template <int AMODE> DEVI void g_load(const GemmDesc& g, bf16x8 (&ar)[4], bf16x8 (&br)[2], int m0, int n0, int srow, int sc, int kt) {
#pragma unroll
  for (int i = 0; i < 4; ++i) ar[i] = load_a<AMODE>(g, m0 + srow + 64 * i, kt * 64 + sc * 8);
#pragma unroll
  for (int i = 0; i < 2; ++i) br[i] = *(const bf16x8*)(g.Bt + (size_t)(n0 + srow + 64 * i) * g.ldb + kt * 64 + sc * 8);
}
template <bool NORM> DEVI void g_write(char* Ab, const bf16x8 (&ar)[4], const bf16x8 (&br)[2], float (&ssq)[4], int srow, int sc) {
  char* Bb = Ab + 32768;
#pragma unroll
  for (int i = 0; i < 4; ++i) { *(bf16x8*)(Ab + swz(srow + 64 * i, sc)) = ar[i];
    if (NORM) { float x[8]; unpk8(__builtin_bit_cast(u32x4, ar[i]), x); float s = ssq[i];
#pragma unroll
      for (int q = 0; q < 8; ++q) s = fmaf(x[q], x[q], s);
      ssq[i] = s; } }
#pragma unroll
  for (int i = 0; i < 2; ++i) *(bf16x8*)(Bb + swz(srow + 64 * i, sc)) = br[i];
}

template <int AMODE, int SEG>
DEVI void gemm_core(const GemmDesc& g, int m0, int n0, char* lds) {
  const int tid = tidx(), lane = tid & 63, wid = tid >> 6;
  const int wm = wid >> 1, wn = wid & 1, r32 = lane & 31, hi = lane >> 5;
  const int srow = tid >> 3, sc = tid & 7;
  constexpr bool NORM = SEG != 0;
  float* rs = (float*)(lds + LDS_RS);
  f32x16 acc[2][2], acc2[2][2];
#pragma unroll
  for (int i = 0; i < 2; ++i)
#pragma unroll
    for (int j = 0; j < 2; ++j) { acc[i][j] = f32x16{}; acc2[i][j] = f32x16{}; }
  float ssq[4] = {0.f, 0.f, 0.f, 0.f};
  bf16x8 ar[4], br[2];
  g_load<AMODE>(g, ar, br, m0, n0, srow, sc, 0); g_write<NORM>(lds, ar, br, ssq, srow, sc); __syncthreads();
  int seg = 0;
#pragma unroll 1
  for (int kt = 0; kt < g.KT; ++kt) {
    const int cur = kt & 1;
    if (kt + 1 < g.KT) g_load<AMODE>(g, ar, br, m0, n0, srow, sc, kt + 1);
    { const char* Ab = lds + cur * 49152; const char* Bb = Ab + 32768;
#pragma unroll
      for (int k16 = 0; k16 < 4; ++k16) {
        bf16x8 a[2], b[2];
#pragma unroll
        for (int mt = 0; mt < 2; ++mt) a[mt] = *(const bf16x8*)(Ab + swz(wm * 64 + mt * 32 + r32, k16 * 2 + hi));
#pragma unroll
        for (int nt = 0; nt < 2; ++nt) b[nt] = *(const bf16x8*)(Bb + swz(wn * 64 + nt * 32 + r32, k16 * 2 + hi));
#pragma unroll
        for (int mt = 0; mt < 2; ++mt)
#pragma unroll
          for (int nt = 0; nt < 2; ++nt) {
            if (NORM) acc2[mt][nt] = __builtin_amdgcn_mfma_f32_32x32x16_bf16(a[mt], b[nt], acc2[mt][nt], 0, 0, 0);
            else acc[mt][nt] = __builtin_amdgcn_mfma_f32_32x32x16_bf16(a[mt], b[nt], acc[mt][nt], 0, 0, 0);
          }
      } }
    if (NORM) {
      int se; float inv;
      if (SEG == 1) { se = g.KT; inv = g.inv0; }
      else { se = seg == 0 ? 6 : (seg == 1 ? 12 : 16); inv = seg == 2 ? (1.f / 256.f) : (1.f / 384.f); }
      if (kt + 1 == se) {
#pragma unroll
        for (int i = 0; i < 4; ++i) { float s = ssq[i]; s += __shfl_xor(s, 1); s += __shfl_xor(s, 2); s += __shfl_xor(s, 4); if (sc == 0) rs[srow + 64 * i] = rsqrtf(s * inv + EPS); }
        __syncthreads();
#pragma unroll
        for (int mt = 0; mt < 2; ++mt)
#pragma unroll
          for (int r = 0; r < 16; ++r) { const float f = rs[wm * 64 + mt * 32 + crow(r, hi)];
#pragma unroll
            for (int nt = 0; nt < 2; ++nt) { acc[mt][nt][r] = fmaf(f, acc2[mt][nt][r], acc[mt][nt][r]); acc2[mt][nt][r] = 0.f; } }
        ssq[0] = ssq[1] = ssq[2] = ssq[3] = 0.f;
        ++seg;
      }
    }
    if (kt + 1 < g.KT) g_write<NORM>(lds + (cur ^ 1) * 49152, ar, br, ssq, srow, sc);
    __syncthreads();
  }
  float* C = (float*)lds;
#pragma unroll
  for (int mt = 0; mt < 2; ++mt)
#pragma unroll
    for (int nt = 0; nt < 2; ++nt)
#pragma unroll
      for (int r = 0; r < 16; ++r) C[(wm * 64 + mt * 32 + crow(r, hi)) * CLD + wn * 64 + nt * 32 + r32] = acc[mt][nt][r];
  __syncthreads();
}
template <int AMODE, int SEG, class Epi>
DEVI void gemm_tile(const GemmDesc& g, int m0, int n0, char* lds, const Epi& epi) {
  gemm_core<AMODE, SEG>(g, m0, n0, lds);
  epi((const float*)lds, m0, n0);
  __syncthreads();
}

DEVI GemmDesc gemm_desc(const u16* A, int lda, const u16* Bt, int ldb, int K) {
  GemmDesc g{}; g.A = A; g.lda = lda; g.Bt = Bt; g.ldb = ldb; g.KT = K / 64; g.inv0 = 1.f / (float)K; return g;
}


template <int HW> DEVI void rope8(float* v, const float* pp, int i0, float posf) {
  const bool first = i0 < HW; const int f0 = i0 & (HW - 1);
#pragma unroll
  for (int j = 0; j < 8; ++j) { float sn, cs; rope_sc(posf, HW == 32 ? (f0 + j) : 2 * (f0 + j), sn, cs); const float pv = pp[j]; v[j] = first ? v[j] * cs - pv * sn : v[j] * cs + pv * sn; }
}

struct EpiP1 { u16* proj; const int* pos;
  DEVI void operator()(const float* C, int m0, int n0) const {
    const int tid = tidx();
#pragma unroll 1
    for (int it = 0; it < 8; ++it) { const int item = it * NTHREADS + tid, row = item >> 4, c8 = (item & 15) * 8, gcol = n0 + c8, grow = m0 + row;
      float v[8]; ld8(C + row * CLD + c8, v);
      const bool r64 = gcol >= PC_SQ && gcol < PC_SV, r32g = gcol >= PC_KR && gcol < PC_KR + 32;
      if (r64) { const int i0 = gcol & 63; float pp[8]; ld8(C + row * CLD + c8 + (i0 < 32 ? 32 : -32), pp); rope8<32>(v, pp, i0, (float)pos[grow]); }
      else if (r32g) { const int i0 = gcol & 31; float pp[8]; ld8(C + row * CLD + c8 + (i0 < 16 ? 16 : -16), pp); rope8<16>(v, pp, i0, (float)pos[grow]); }
      *(u32x4*)(proj + (size_t)grow * INWP + gcol) = pk8(v);
    }
  }
};

struct EpiQ { u16* qm; const int* pos;
  DEVI void operator()(const float* C, int m0, int n0) const {
    const int tid = tidx();
#pragma unroll 1
    for (int it = 0; it < 8; ++it) { const int item = it * NTHREADS + tid, row = item >> 4, c8 = (item & 15) * 8, gcol = n0 + c8, grow = m0 + row;
      if (gcol >= 576) continue;
      const int head = gcol / 96, j0 = gcol - head * 96, b = grow >> 13, s = grow & (SEQ - 1);
      float v[8]; ld8(C + row * CLD + c8, v);
      u16* qrow = qm + ((size_t)(b * MLA_H + head) * SEQ + s) * MLA_QK;
      if (j0 >= 64) { const int i0 = j0 - 64; float pp[8]; ld8(C + row * CLD + c8 + (i0 < 16 ? 16 : -16), pp); rope8<16>(v, pp, i0, (float)pos[grow]);
#pragma unroll
        for (int j = 0; j < 8; ++j) { const int i = i0 + j; qrow[64 + (i < 16 ? 2 * i : 2 * (i - 16) + 1)] = f2bf(v[j]); } }
      else *(u32x4*)(qrow + j0) = pk8(v);
    }
  }
};

struct EpiKV { u16* km; u16* vm; const u16* proj;
  DEVI void operator()(const float* C, int m0, int n0) const {
    const int tid = tidx(), head = n0 >> 7;
#pragma unroll 1
    for (int it = 0; it < 8; ++it) { const int item = it * NTHREADS + tid, row = item >> 4, c8 = (item & 15) * 8, grow = m0 + row;
      const int b = grow >> 13, s = grow & (SEQ - 1);
      float v[8]; ld8(C + row * CLD + c8, v);
      const size_t tok = (size_t)(b * MLA_H + head) * SEQ + s;
      if (c8 < 64) *(u32x4*)(km + tok * MLA_QK + c8) = pk8(v);
      else *(u32x4*)(vm + tok * MLA_V + (c8 - 64)) = pk8(v);
    }
#pragma unroll 1
    for (int it = 0; it < 2; ++it) { const int item = it * NTHREADS + tid, row = item >> 2, c = (item & 3) * 8, grow = m0 + row;
      const int b = grow >> 13, s = grow & (SEQ - 1);
      *(u32x4*)(km + ((size_t)(b * MLA_H + head) * SEQ + s) * MLA_QK + 64 + c) = *(const u32x4*)(proj + (size_t)grow * INWP + PC_KR + c);
    }
  }
};

struct EpiLRU { const u16* proj; const float* cw; const float* cb; const float* ba; const float* bx; const float* lam; u16* le; u16* lb; int n, d;
  DEVI void operator()(const float* C, int m0, int) const {
    const int tid = tidx();
#pragma unroll 1
    for (int it = 0; it < 4; ++it) { const int item = it * NTHREADS + tid, j = item & 63, g8 = item >> 6;
      const int ch = n * 64 + j, grow0 = m0 + g8 * 8, s0 = grow0 & (SEQ - 1), b = grow0 >> 13;
      const float bav = ba[(d * 6 + n) * 64 + j], bxv = bx[(d * 6 + n) * 64 + j];
      const float cdec = -8.f * log1pf(__expf(-lam[d * LRU_W + ch]));
      float xin[11];
#pragma unroll
      for (int q = 0; q < 11; ++q) { const int ss = s0 - 1 + q; xin[q] = (ss >= 0 && ss < SEQ) ? bf2f(proj[(size_t)(grow0 - 1 + q) * INWP + PC_LX + ch]) : 0.f; }
      const float w0 = cw[ch], w1 = cw[LRU_W + ch], w2 = cw[2 * LRU_W + ch], w3 = cw[3 * LRU_W + ch], cbv = cb[ch];
      float ev[8], bv[8];
#pragma unroll
      for (int rr = 0; rr < 8; ++rr) {
        const float xf = cbv + w0 * xin[rr] + w1 * xin[rr + 1] + w2 * xin[rr + 2] + w3 * xin[rr + 3];
        const float r = sigmoidf_(C[(g8 * 8 + rr) * CLD + j] + bav), ig = sigmoidf_(C[(g8 * 8 + rr) * CLD + 64 + j] + bxv);
        const float a = __expf(cdec * r), e = 1.f - a;
        ev[rr] = e; bv[rr] = sqrtf(e * (2.f - e)) * ig * xf;
      }
      const size_t o = (((size_t)(d * NB + b) * (SEQ / 8) + (s0 >> 3)) * LRU_W + ch) * 8;
      *(u32x4*)(le + o) = pk8(ev); *(u32x4*)(lb + o) = pk8(bv);
    }
  }
};

struct EpiP4 { const float* xres; float* xout; u16* xg;
  DEVI void operator()(const float* C, int m0, int n0) const {
    const int tid = tidx();
#pragma unroll 1
    for (int it = 0; it < 8; ++it) { const int item = it * NTHREADS + tid, row = item >> 4, c8 = (item & 15) * 8, gcol = n0 + c8, grow = m0 + row;
      float v[8], x[8]; ld8(C + row * CLD + c8, v); ld8(xres + (size_t)grow * DM + gcol, x);
#pragma unroll
      for (int j = 0; j < 8; ++j) v[j] += x[j];
      *(f32x4*)(xout + (size_t)grow * DM + gcol) = (f32x4){v[0], v[1], v[2], v[3]}; *(f32x4*)(xout + (size_t)grow * DM + gcol + 4) = (f32x4){v[4], v[5], v[6], v[7]};
      *(u32x4*)(xg + (size_t)grow * DM + gcol) = pk8(v);
    }
  }
};

struct EpiBf16 { u16* o; int ldo;
  DEVI void operator()(const float* C, int m0, int n0) const {
    const int tid = tidx();
#pragma unroll 1
    for (int it = 0; it < 8; ++it) { const int item = it * NTHREADS + tid, row = item >> 4, c8 = (item & 15) * 8;
      float v[8]; ld8(C + row * CLD + c8, v);
      *(u32x4*)(o + (size_t)(m0 + row) * ldo + n0 + c8) = pk8(v);
    }
  }
};

DEVI void ce_desc(float& a, float& b) { const float mx = fmaxf(a, b), mn = fminf(a, b); a = mx; b = mn; }
struct EpiTop { float* top; int hj;
  DEVI void operator()(const float* C, int m0, int) const {
    const int tid = tidx(), row = tid >> 1, part = tid & 1;
    float l[16];
#pragma unroll
    for (int i = 0; i < 16; ++i) l[i] = -3.0e38f;
#pragma unroll 4
    for (int c = 0; c < 64; ++c) { const int col = part * 64 + ((c + row) & 63);
      float v = __uint_as_float((__float_as_uint(C[row * CLD + col]) & ~127u) | (unsigned)(127 - col));
#pragma unroll
      for (int i = 0; i < 16; ++i) { const float t = fmaxf(l[i], v); v = fminf(l[i], v); l[i] = t; } }
    float m[16];
#pragma unroll
    for (int i = 0; i < 16; ++i) m[i] = __shfl_xor(l[15 - i], 1);
#pragma unroll
    for (int i = 0; i < 16; ++i) m[i] = fmaxf(m[i], l[i]);
#pragma unroll
    for (int st = 8; st >= 1; st >>= 1)
#pragma unroll
      for (int i = 0; i < 16; ++i) if ((i & st) == 0) ce_desc(m[i], m[i + st]);
    if (part == 0) { float* o = top + ((size_t)(m0 + row) * 16 + hj) * 16;
#pragma unroll
      for (int i = 0; i < 4; ++i) *(f32x4*)(o + 4 * i) = (f32x4){m[4 * i], m[4 * i + 1], m[4 * i + 2], m[4 * i + 3]}; }
  }
};

#define KSWZ(row, colB) ((row) * 256 + ((colB) ^ (((row) & 15) << 4)))
#define SBAR() __builtin_amdgcn_sched_barrier(0)
constexpr int AT_SHM_V = 64 * 64 * 2, AT_SHM_K = 64 * 128 * 2;
constexpr int AT_LDS = 3 * AT_SHM_V + 2 * AT_SHM_K + 8 * 64 * 4;
constexpr float ATT_THR = 8.f;
DEVI unsigned cvtpk(float lo, float hi) { unsigned r; asm volatile("v_cvt_pk_bf16_f32 %0, %1, %2" : "=v"(r) : "v"(lo), "v"(hi)); return r; }
DEVI int v_st(int k, int c) { const int kk = (k & ~0xC) | ((k & 4) << 1) | ((k & 8) >> 1); return ((kk >> 3) * 2 + (c >> 5)) * 512 + ((kk & 7) * 32 + (c & 31)) * 2; }
DEVI int v_rd_base(int lane) { return ((lane & 3) << 3) | (((lane >> 2) & 3) << 6) | (((lane >> 4) & 1) << 5) | (((lane >> 5) & 1) << 8); }
constexpr int v_rd_off(int d0, int ks, int half) { return d0 * 512 + ks * 2048 + half * 1024; }
template <int OFF> DEVI s16x4 tr_read(int vb) { s16x4 r; asm volatile("ds_read_b64_tr_b16 %0, %1 offset:%2" : "=&v"(r) : "v"(vb), "i"(OFF) : "memory"); return r; }

template <bool MASK, bool FIRST>
DEVI void partialSM(f32x16& p0, f32x16& p1, float& m_reg, float& mn, float& alpha, int kpos0, int qpos, int hi) {
  constexpr float THRL = ATT_THR * 1.4426950408889634f;
  if (MASK) {
#pragma unroll
    for (int r = 0; r < 16; ++r) { const int k0 = kpos0 + crow(r, hi) - qpos; const int k1 = k0 + 32;
      if (k0 > 128 || k0 < -128) p0[r] = -1e30f;
      if (k1 > 128 || k1 < -128) p1[r] = -1e30f; }
  }
  if (FIRST) {
    float pmax = p0[0];
#pragma unroll
    for (int r = 1; r < 16; ++r) pmax = fmaxf(pmax, p0[r]);
#pragma unroll
    for (int r = 0; r < 16; ++r) pmax = fmaxf(pmax, p1[r]);
    { auto rr = __builtin_amdgcn_permlane32_swap(__float_as_uint(pmax), __float_as_uint(pmax), false, false);
      pmax = fmaxf(__uint_as_float(rr[0]), __uint_as_float(rr[1])); }
    if (__builtin_expect(__all(pmax - m_reg <= THRL), 1)) { mn = m_reg; alpha = 1.f; }
    else { mn = fmaxf(m_reg, pmax); alpha = __builtin_amdgcn_exp2f(m_reg - mn); m_reg = mn; }
#pragma unroll
    for (int r = 0; r < 16; ++r) p0[r] -= mn;
#pragma unroll
    for (int r = 0; r < 16; ++r) p1[r] -= mn;
#pragma unroll
    for (int r = 0; r < 16; ++r) p0[r] = __builtin_amdgcn_exp2f(p0[r]);
    return;
  }
#pragma unroll
  for (int r = 0; r < 16; ++r) p0[r] -= m_reg;
#pragma unroll
  for (int r = 0; r < 16; ++r) p1[r] -= m_reg;
  float tmax = p0[0];
#pragma unroll
  for (int r = 1; r < 16; ++r) tmax = fmaxf(tmax, p0[r]);
#pragma unroll
  for (int r = 0; r < 16; ++r) tmax = fmaxf(tmax, p1[r]);
#pragma unroll
  for (int r = 0; r < 16; ++r) p0[r] = __builtin_amdgcn_exp2f(p0[r]);
  { auto rr = __builtin_amdgcn_permlane32_swap(__float_as_uint(tmax), __float_as_uint(tmax), false, false);
    tmax = fmaxf(__uint_as_float(rr[0]), __uint_as_float(rr[1])); }
  mn = m_reg; alpha = 1.f;
  if (__builtin_expect(!__all(tmax <= THRL), 0)) {
    const float sh = fmaxf(tmax, 0.f);
    alpha = __builtin_amdgcn_exp2f(-sh); m_reg = m_reg + sh; mn = m_reg;
#pragma unroll
    for (int r = 0; r < 16; ++r) { p0[r] *= alpha; p1[r] -= sh; }
  }
}
DEVI void finishSM(f32x16& p0, f32x16& p1, float alpha, float& l_reg, bf16x8& pa0, bf16x8& pa1, bf16x8& pa2, bf16x8& pa3) {
#pragma unroll
  for (int r = 0; r < 16; ++r) p1[r] = __builtin_amdgcn_exp2f(p1[r]);
  float ps = 0;
#pragma unroll
  for (int r = 0; r < 16; ++r) ps += p0[r];
#pragma unroll
  for (int r = 0; r < 16; ++r) ps += p1[r];
  { auto rr = __builtin_amdgcn_permlane32_swap(__float_as_uint(ps), __float_as_uint(ps), false, false);
    ps = __uint_as_float(rr[0]) + __uint_as_float(rr[1]); }
  l_reg = l_reg * alpha + ps;
#define PK4(P, BASE, OUT) do { unsigned a0 = cvtpk(P[BASE + 0], P[BASE + 1]), a1 = cvtpk(P[BASE + 2], P[BASE + 3]);   \
    unsigned b0 = cvtpk(P[BASE + 4], P[BASE + 5]), b1 = cvtpk(P[BASE + 6], P[BASE + 7]);                              \
    auto r0 = __builtin_amdgcn_permlane32_swap(a0, b0, false, false); auto r1 = __builtin_amdgcn_permlane32_swap(a1, b1, false, false); \
    u32x4 w = {r0[0], r1[0], r0[1], r1[1]}; OUT = __builtin_bit_cast(bf16x8, w); } while (0)
  PK4(p0, 0, pa0); PK4(p0, 8, pa1); PK4(p1, 0, pa2); PK4(p1, 8, pa3);
#undef PK4
}
template <int ND0>
DEVI void qkt(f32x16& p0, f32x16& p1, const char* Ks, const bf16x8* qr, int r32, int hi) {
  bf16x8 k0[ND0], k1[ND0];
#pragma unroll
  for (int d0 = 0; d0 < ND0; ++d0) { const int cb = (d0 * 16 + hi * 8) * 2;
    k0[d0] = *(const bf16x8*)(Ks + KSWZ(r32, cb)); k1[d0] = *(const bf16x8*)(Ks + KSWZ(32 + r32, cb)); }
  p0 = f32x16{}; p1 = f32x16{};
#pragma unroll
  for (int d0 = 0; d0 < ND0; ++d0) {
    p0 = __builtin_amdgcn_mfma_f32_32x32x16_bf16(k0[d0], qr[d0], p0, 0, 0, 0);
    p1 = __builtin_amdgcn_mfma_f32_32x32x16_bf16(k1[d0], qr[d0], p1, 0, 0, 0); }
}
template <int D0> DEVI void pv_one(f32x16& od, int vb, bf16x8 pa0, bf16x8 pa1, bf16x8 pa2, bf16x8 pa3) {
  const s16x4 l0 = tr_read<v_rd_off(D0, 0, 0)>(vb), h0 = tr_read<v_rd_off(D0, 0, 1)>(vb), l1 = tr_read<v_rd_off(D0, 1, 0)>(vb), h1 = tr_read<v_rd_off(D0, 1, 1)>(vb);
  const s16x4 l2 = tr_read<v_rd_off(D0, 2, 0)>(vb), h2 = tr_read<v_rd_off(D0, 2, 1)>(vb), l3 = tr_read<v_rd_off(D0, 3, 0)>(vb), h3 = tr_read<v_rd_off(D0, 3, 1)>(vb);
  asm volatile("s_waitcnt lgkmcnt(0)" ::: "memory"); SBAR();
#define PK(L, H) (bf16x8){L[0], L[1], L[2], L[3], H[0], H[1], H[2], H[3]}
  od = __builtin_amdgcn_mfma_f32_32x32x16_bf16(pa0, PK(l0, h0), od, 0, 0, 0);
  od = __builtin_amdgcn_mfma_f32_32x32x16_bf16(pa1, PK(l1, h1), od, 0, 0, 0);
  od = __builtin_amdgcn_mfma_f32_32x32x16_bf16(pa2, PK(l2, h2), od, 0, 0, 0);
  od = __builtin_amdgcn_mfma_f32_32x32x16_bf16(pa3, PK(l3, h3), od, 0, 0, 0);
#undef PK
}
DEVI void pv_d0(f32x16* o, int vb, bf16x8 pa0, bf16x8 pa1, bf16x8 pa2, bf16x8 pa3) {
  const s16x4 a0 = tr_read<v_rd_off(0, 0, 0)>(vb), b0 = tr_read<v_rd_off(0, 0, 1)>(vb), a1 = tr_read<v_rd_off(0, 1, 0)>(vb), b1 = tr_read<v_rd_off(0, 1, 1)>(vb);
  const s16x4 a2 = tr_read<v_rd_off(0, 2, 0)>(vb), b2 = tr_read<v_rd_off(0, 2, 1)>(vb), a3 = tr_read<v_rd_off(0, 3, 0)>(vb), b3 = tr_read<v_rd_off(0, 3, 1)>(vb);
  const s16x4 c0 = tr_read<v_rd_off(1, 0, 0)>(vb), d0 = tr_read<v_rd_off(1, 0, 1)>(vb), c1 = tr_read<v_rd_off(1, 1, 0)>(vb), d1 = tr_read<v_rd_off(1, 1, 1)>(vb);
  const s16x4 c2 = tr_read<v_rd_off(1, 2, 0)>(vb), d2 = tr_read<v_rd_off(1, 2, 1)>(vb), c3 = tr_read<v_rd_off(1, 3, 0)>(vb), d3 = tr_read<v_rd_off(1, 3, 1)>(vb);
  asm volatile("s_waitcnt lgkmcnt(0)" ::: "memory"); SBAR();
#define PK(L, H) (bf16x8){L[0], L[1], L[2], L[3], H[0], H[1], H[2], H[3]}
  o[0] = __builtin_amdgcn_mfma_f32_32x32x16_bf16(pa0, PK(a0, b0), o[0], 0, 0, 0);
  o[1] = __builtin_amdgcn_mfma_f32_32x32x16_bf16(pa0, PK(c0, d0), o[1], 0, 0, 0);
  o[0] = __builtin_amdgcn_mfma_f32_32x32x16_bf16(pa1, PK(a1, b1), o[0], 0, 0, 0);
  o[1] = __builtin_amdgcn_mfma_f32_32x32x16_bf16(pa1, PK(c1, d1), o[1], 0, 0, 0);
  o[0] = __builtin_amdgcn_mfma_f32_32x32x16_bf16(pa2, PK(a2, b2), o[0], 0, 0, 0);
  o[1] = __builtin_amdgcn_mfma_f32_32x32x16_bf16(pa2, PK(c2, d2), o[1], 0, 0, 0);
  o[0] = __builtin_amdgcn_mfma_f32_32x32x16_bf16(pa3, PK(a3, b3), o[0], 0, 0, 0);
  o[1] = __builtin_amdgcn_mfma_f32_32x32x16_bf16(pa3, PK(c3, d3), o[1], 0, 0, 0);
#undef PK
}

template <int DQK, bool MASK>
DEVI void attn_body(const u16* Qw, const u16* Kh, int ldk, const u16* Vh, int ldv, int kt0, int NT, float m_init, float l_init,
                    int qpos, u16* Ow, char* lds, float qrope_pos = 0.f) {
  constexpr int ND0 = DQK / 16, NCK = DQK / 8;
  const int tid = tidx(), wid = __builtin_amdgcn_readfirstlane(tid >> 6), lane = tid & 63, r32 = lane & 31, hi = lane >> 5;
  char* K_lds = lds; char* V_lds = lds + 2 * AT_SHM_K;
  float* wsx = (float*)(lds + 2 * AT_SHM_K + 3 * AT_SHM_V) + wid * 64; float* li_l = wsx; float* al_l = wsx + 32;
  float m_reg = m_init, l_reg = l_init; f32x16 o[2] = {f32x16{}, f32x16{}}; bf16x8 qr[ND0];
#pragma unroll
  for (int d0 = 0; d0 < ND0; ++d0) qr[d0] = *(const bf16x8*)(Qw + d0 * 16);
  if (DQK == 96) {
#pragma unroll
    for (int d0 = 4; d0 < ND0; ++d0) { float v[8]; unpk8(__builtin_bit_cast(u32x4, qr[d0]), v);
#pragma unroll
      for (int q = 0; q < 4; ++q) { const int f = 2 * ((((d0 - 4) * 16 + hi * 8) >> 1) + q); float sn, cs; rope_sc(qrope_pos, f, sn, cs);
        const float x1 = v[2 * q], x2 = v[2 * q + 1]; v[2 * q] = x1 * cs - x2 * sn; v[2 * q + 1] = x2 * cs + x1 * sn; }
      qr[d0] = __builtin_bit_cast(bf16x8, pk8(v)); } }
  unsigned koff[2], voff;
#pragma unroll
  for (int i = 0; i < 2; ++i) { const int row = 4 * (wid + 8 * i) + (lane >> 4), ch = (lane & 15) ^ (row & 15); koff[i] = (unsigned)(row * ldk * 2 + (ch < NCK ? ch : 0) * 16); }
  { const int off = wid * 1024 + lane * 16, sub = off >> 9, kk = ((sub >> 1) << 3) | ((off & 511) >> 6), c = ((sub & 1) << 5) | ((off & 63) >> 1);
    const int k = (kk & ~0xC) | ((kk & 4) << 1) | ((kk & 8) >> 1); voff = (unsigned)(k * ldv * 2 + c * 2); }
  typedef __attribute__((address_space(3))) unsigned lds_u32;
#define DMA(tt_) do { const char* kb_ = (const char*)Kh + (size_t)(kt0 + (tt_)) * 64 * ldk * 2; const char* vb_ = (const char*)Vh + (size_t)(kt0 + (tt_)) * 64 * ldv * 2; \
    char* kd_ = K_lds + ((tt_) & 1) * AT_SHM_K + wid * 1024; char* vd_ = V_lds + ((tt_) % 3) * AT_SHM_V + wid * 1024; \
    __builtin_amdgcn_global_load_lds((const unsigned*)(kb_ + koff[0]), (lds_u32*)kd_, 16, 0, 0); \
    __builtin_amdgcn_global_load_lds((const unsigned*)(kb_ + koff[1]), (lds_u32*)(kd_ + 8192), 16, 0, 0); \
    __builtin_amdgcn_global_load_lds((const unsigned*)(vb_ + voff), (lds_u32*)vd_, 16, 0, 0); } while (0)
#define LANDED() do { asm volatile("s_waitcnt vmcnt(0)" ::: "memory"); __syncthreads(); } while (0)
#define RESC(a) do { if (__any((a) < 1.f)) { if (hi == 0) al_l[r32] = (a); asm volatile("s_waitcnt lgkmcnt(0)" ::: "memory"); \
    _Pragma("unroll") for (int d = 0; d < 2; ++d) _Pragma("unroll") for (int r = 0; r < 16; ++r) o[d][r] *= al_l[crow(r, hi)]; } } while (0)
  const int vb0 = (int)(uintptr_t)V_lds + v_rd_base(lane);
  f32x16 pA0, pA1, pB0, pB1; float mnA, mnB, alA, alB; bf16x8 pa0, pa1, pa2, pa3;
  DMA(0); LANDED();
  DMA(1);
  qkt<ND0>(pA0, pA1, K_lds, qr, r32, hi); partialSM<MASK, true>(pA0, pA1, m_reg, mnA, alA, kt0 * 64, qpos, hi);
  LANDED();
  int vprev = 0;
  for (int tt = 1; tt + 1 < NT; tt += 2) {
    const int v1 = vprev == 2 ? 0 : vprev + 1;
    DMA(tt + 1); SBAR();
    qkt<ND0>(pB0, pB1, K_lds + AT_SHM_K, qr, r32, hi);
    finishSM(pA0, pA1, alA, l_reg, pa0, pa1, pa2, pa3); SBAR();
    pv_d0(o, vb0 + vprev * AT_SHM_V, pa0, pa1, pa2, pa3); partialSM<MASK, false>(pB0, pB1, m_reg, mnB, alB, (kt0 + tt) * 64, qpos, hi);
    RESC(alB); LANDED();
    if (tt + 2 < NT) DMA(tt + 2);
    SBAR();
    qkt<ND0>(pA0, pA1, K_lds, qr, r32, hi);
    finishSM(pB0, pB1, alB, l_reg, pa0, pa1, pa2, pa3); SBAR();
    pv_d0(o, vb0 + v1 * AT_SHM_V, pa0, pa1, pa2, pa3); partialSM<MASK, false>(pA0, pA1, m_reg, mnA, alA, (kt0 + tt + 1) * 64, qpos, hi);
    RESC(alA); LANDED();
    vprev = v1 == 2 ? 0 : v1 + 1;
  }
  { const int v1 = vprev == 2 ? 0 : vprev + 1;
    SBAR(); qkt<ND0>(pB0, pB1, K_lds + AT_SHM_K, qr, r32, hi);
    finishSM(pA0, pA1, alA, l_reg, pa0, pa1, pa2, pa3); SBAR();
    pv_d0(o, vb0 + vprev * AT_SHM_V, pa0, pa1, pa2, pa3); partialSM<MASK, false>(pB0, pB1, m_reg, mnB, alB, (kt0 + NT - 1) * 64, qpos, hi);
    RESC(alB);
    finishSM(pB0, pB1, alB, l_reg, pa0, pa1, pa2, pa3); SBAR();
    pv_d0(o, vb0 + v1 * AT_SHM_V, pa0, pa1, pa2, pa3); }
  if (hi == 0) li_l[r32] = l_reg; asm volatile("s_waitcnt lgkmcnt(0)" ::: "memory");
  float rli[16];
#pragma unroll
  for (int r = 0; r < 16; ++r) rli[r] = __builtin_amdgcn_rcpf(li_l[crow(r, hi)]);
#pragma unroll
  for (int r = 0; r < 16; ++r) { const int orow = crow(r, hi);
#pragma unroll
    for (int d0 = 0; d0 < 2; ++d0) Ow[(size_t)orow * DM + d0 * 32 + r32] = f2bf(o[d0][r] * rli[r]); }
  __syncthreads();
#undef DMA
#undef LANDED
#undef RESC
}

constexpr int LCH = 64, NLCH = SEQ / LCH;
constexpr size_t WS_LP = 1 * MiB, WS_LH = 2560 * 1024;
constexpr size_t WS_LC = 473 * MiB;
constexpr size_t WS_NEED = 510 * MiB;
DEVI void lru_passA(const Params& p, int item, int lane) {
  const int cg = item % 6, c = (item / 6) % NLCH, b = (item / (6 * NLCH)) % NB, d = item / (6 * NLCH * NB);
  const size_t base = (((size_t)(d * NB + b) * (SEQ / 8) + c * 8) * LRU_W + cg * 64 + lane) * 8;
  const u16* E = (const u16*)(p.ws + WS_LE) + base; const u16* Bp = (const u16*)(p.ws + WS_LB) + base;
  u32x4 ev[8], bv[8];
#pragma unroll
  for (int g = 0; g < 8; ++g) { ev[g] = *(const u32x4*)(E + (size_t)g * LRU_W * 8); bv[g] = *(const u32x4*)(Bp + (size_t)g * LRU_W * 8); }
  float h = 0.f, P = 1.f;
#pragma unroll
  for (int gg = 0; gg < 8; ++gg) { const int g = d ? 7 - gg : gg; float e[8], bb[8]; unpk8(ev[g], e); unpk8(bv[g], bb);
#pragma unroll
    for (int rr = 0; rr < 8; ++rr) { const int r = d ? 7 - rr : rr; const float a = 1.f - e[r]; h = fmaf(a, h, bb[r]); P *= a; } }
  const size_t o = ((size_t)(d * NB + b) * NLCH + c) * LRU_W + cg * 64 + lane;
  ((float*)(p.ws + WS_LP))[o] = P; ((float*)(p.ws + WS_LH))[o] = h;
}

DEVI void lru_final(const Params& p, int item, char* lds) {
  const int tid = tidx(), wid = tid >> 6, lane = tid & 63;
  const int c = item % NLCH, b = item / NLCH;
  float* obuf = (float*)lds;
  if (wid < 6) {
    const int ch = wid * 64 + lane;
#pragma unroll
    for (int d = 0; d < 2; ++d) {
      const size_t co = ((size_t)(d * NB + b) * NLCH + c) * LRU_W + ch;
      float h = ((const float*)(p.ws + WS_LC))[co];
      const size_t base = (((size_t)(d * NB + b) * (SEQ / 8) + c * 8) * LRU_W + ch) * 8;
      const u16* E = (const u16*)(p.ws + WS_LE) + base; const u16* Bp = (const u16*)(p.ws + WS_LB) + base;
      u32x4 ev[8], bv[8];
#pragma unroll
      for (int g = 0; g < 8; ++g) { ev[g] = *(const u32x4*)(E + (size_t)g * LRU_W * 8); bv[g] = *(const u32x4*)(Bp + (size_t)g * LRU_W * 8); }
      if (d == 0) {
#pragma unroll
        for (int g = 0; g < 8; ++g) { float e[8], bb[8]; unpk8(ev[g], e); unpk8(bv[g], bb);
#pragma unroll
          for (int r = 0; r < 8; ++r) { h = fmaf(1.f - e[r], h, bb[r]); obuf[(g * 8 + r) * LRU_W + ch] = h; } }
      } else {
        const u16* gp = (const u16*)(p.ws + WS_R1) + ((size_t)b * SEQ + c * LCH) * INWP + PC_LG + ch;
#pragma unroll
        for (int g = 7; g >= 0; --g) { float e[8], bb[8]; unpk8(ev[g], e); unpk8(bv[g], bb);
#pragma unroll
          for (int r = 7; r >= 0; --r) { h = fmaf(1.f - e[r], h, bb[r]); const int tk = g * 8 + r;
            const float gt = bf2f(gp[(size_t)tk * INWP]); obuf[tk * LRU_W + ch] = (obuf[tk * LRU_W + ch] + h) * gelu_erf(gt); } }
      }
    }
  }
  __syncthreads();
  u16* mp = (u16*)(p.ws + WS_MIX) + ((size_t)b * SEQ + c * LCH) * DM + 384;
#pragma unroll 1
  for (int i = 0; i < 8; ++i) { const int tk = wid * 8 + i;
    float v[6]; float s = 0.f;
#pragma unroll
    for (int q = 0; q < 3; ++q) { const f32x2 t2 = *(const f32x2*)(obuf + tk * LRU_W + q * 128 + lane * 2); v[2 * q] = t2.x; v[2 * q + 1] = t2.y; s = fmaf(t2.x, t2.x, s); s = fmaf(t2.y, t2.y, s); }
    s = wave_sum(s);
    const float rs = rsqrtf(s * (1.f / 384.f) + EPS);
#pragma unroll
    for (int q = 0; q < 3; ++q) *(unsigned*)(mp + (size_t)tk * DM + q * 128 + lane * 2) = pk2(v[2 * q] * rs, v[2 * q + 1] * rs);
  }
  __syncthreads();
}

typedef unsigned char u8;
DEVI unsigned q8x4(const float* v, float s) {
  unsigned w = 0;
#pragma unroll
  for (int i = 0; i < 4; ++i) { int q = __float2int_rn(v[i] * s); q = q < -127 ? -127 : (q > 127 ? 127 : q); w |= ((unsigned)q & 255u) << (8 * i); }
  return w;
}
DEVI void peer_xn_pass(const Params& p, int layer, int vb, int nb) {
  const int tid = tidx(), wid = tid >> 6, lane = tid & 63; const u16* xg = (const u16*)(p.ws + WS_XG); const float* gf = p.norm_ffn + layer * DM;
  u8* xq = (u8*)(p.ws + WS_XQ); float* sxp = (float*)(p.ws + WS_SX);
  for (int t = vb * 8 + wid; t < T; t += nb * 8) {
    const u32x4* rp = (const u32x4*)(xg + (size_t)t * DM + lane * 16);
    float v[16]; unpk8(rp[0], v); unpk8(rp[1], v + 8);
    float s = 0.f;
#pragma unroll
    for (int i = 0; i < 16; ++i) s = fmaf(v[i], v[i], s);
    s = wave_sum(s);
    const float rs = rsqrtf(s * (1.f / DM) + EPS);
    float g[16]; ld8(gf + lane * 16, g); ld8(gf + lane * 16 + 8, g + 8);
    float mx = 0.f;
#pragma unroll
    for (int i = 0; i < 16; ++i) { v[i] *= rs * g[i]; mx = fmaxf(mx, fabsf(v[i])); }
#pragma unroll
    for (int o = 1; o < 64; o <<= 1) mx = fmaxf(mx, __shfl_xor(mx, o));
    const float sx = fmaxf(mx, 1e-20f) * (1.f / 127.f), isx = 1.f / sx;
    *(u32x4*)(xq + (size_t)t * DM + lane * 16) = (u32x4){q8x4(v, isx), q8x4(v + 4, isx), q8x4(v + 8, isx), q8x4(v + 12, isx)};
    if (lane == 0) sxp[t] = sx;
  }
}

DEVI void cvt16(u32x4 w, float* f) {
  f32x2 t;
  t = __builtin_amdgcn_cvt_pk_f32_fp8((int)w.x, false); f[0] = t.x; f[1] = t.y; t = __builtin_amdgcn_cvt_pk_f32_fp8((int)w.x, true); f[2] = t.x; f[3] = t.y;
  t = __builtin_amdgcn_cvt_pk_f32_fp8((int)w.y, false); f[4] = t.x; f[5] = t.y; t = __builtin_amdgcn_cvt_pk_f32_fp8((int)w.y, true); f[6] = t.x; f[7] = t.y;
  t = __builtin_amdgcn_cvt_pk_f32_fp8((int)w.z, false); f[8] = t.x; f[9] = t.y; t = __builtin_amdgcn_cvt_pk_f32_fp8((int)w.z, true); f[10] = t.x; f[11] = t.y;
  t = __builtin_amdgcn_cvt_pk_f32_fp8((int)w.w, false); f[12] = t.x; f[13] = t.y; t = __builtin_amdgcn_cvt_pk_f32_fp8((int)w.w, true); f[14] = t.x; f[15] = t.y;
}
DEVI unsigned enc4(float a, float b, float c, float d) { int w = 0; w = __builtin_amdgcn_cvt_pk_fp8_f32(a, b, w, false); w = __builtin_amdgcn_cvt_pk_fp8_f32(c, d, w, true); return (unsigned)w; }
#define EIDX_AT(i0, i1, i) ((((i) < 8 ? (i0) : (i1))[((i) & 7) >> 1] >> (((i) & 1) * 16)) & 0xffffu)
template <int CTRL> DEVI float dppf(float v) { return __uint_as_float((unsigned)__builtin_amdgcn_mov_dpp((int)__float_as_uint(v), CTRL, 0xF, 0xF, true)); }
DEVI f32x2 fma2(f32x2 a, f32x2 b, f32x2 c) { return __builtin_elementwise_fma(a, b, c); }
DEVI f32x2 cvt8lo(unsigned w) { return __builtin_amdgcn_cvt_pk_f32_fp8((int)w, false); }
DEVI f32x2 cvt8hi(unsigned w) { return __builtin_amdgcn_cvt_pk_f32_fp8((int)w, true); }
struct PeerIdx { u32x4 i0, i1; };
template <bool AXPY>
DEVI void peer_slice_phase(const Params& p, int s, int tbeg, int tstep, int lane, const float* xin, float* xout, bool last) {
  const int r = lane >> 3, j = lane & 7;
  const u8* eidxB = (const u8*)(p.ws + WS_EIDX); const unsigned eoff = (unsigned)r * 32u;
  const u8* TBs = (const u8*)(p.ws + (AXPY ? WS_VB : WS_UB)) + (size_t)s * NEXP * 128; const unsigned toff = 16u * (unsigned)j;
  const u8* xnB = (const u8*)(p.ws + WS_XQ) + s * 128; const unsigned xoff = 16u * (unsigned)j;
  const float* sxp = (const float*)(p.ws + WS_SX);
  const u8* ccB = (const u8*)(p.ws + WS_CC); const unsigned coff = (unsigned)r * 16u;
  const float* csp = (const float*)(p.ws + WS_CS);
  u16* pdB = (u16*)(p.ws + WS_PD) + (size_t)s * T * 128;
  const int ntok = (T - tbeg + tstep - 1) / tstep;
  if (ntok <= 0) return;
#define TOK(k) (tbeg + ((k) < ntok ? (k) : ntok - 1) * tstep)
#define LD_IDX(dst, k) do { const u8* b_ = eidxB + (size_t)TOK(k) * 256; dst.i0 = *(const u32x4*)(b_ + eoff); dst.i1 = *(const u32x4*)(b_ + eoff + 16u); } while (0)
#define LD_HALF(H, ix, h) do { _Pragma("unroll") for (int i = 0; i < 8; ++i) H[i] = *(const u32x4*)(TBs + (EIDX_AT(ix.i0, ix.i1, 8 * (h) + i) * 128u + toff)); } while (0)
#define LD_AUX(a, k) do { if (AXPY) { const u8* b_ = ccB + (size_t)TOK(k) * 128; a[0] = *(const u32x4*)(b_ + coff); a[1].x = __float_as_uint(csp[TOK(k)]); } \
    else { const u8* b_ = xnB + (size_t)TOK(k) * DM; a[0] = *(const u32x4*)(b_ + xoff); a[1].x = __float_as_uint(sxp[TOK(k)]); } } while (0)
  PeerIdx I0, I1, I2; u32x4 H0[8], H1[8], H2[8], X0[2], X1[2], X2[2];
  u32x4 xq4 = {0, 0, 0, 0}; float sxk = 0.f;
  int acc[16];
#define T_BEGIN(X) do { xq4 = X[0]; sxk = __uint_as_float(X[1].x); if (AXPY) { _Pragma("unroll") for (int q = 0; q < 16; ++q) acc[q] = 0; } } while (0)
#define COMP(H, h, k) do { if ((k) < ntok) { \
    if (!AXPY) { u16* o_ = pdB + (size_t)(tbeg + (k) * tstep) * 128 + r * 16 + 8 * (h); \
      _Pragma("unroll") for (int g = 0; g < 2; ++g) { float res[4]; \
        _Pragma("unroll") for (int ii = 0; ii < 4; ++ii) { const u32x4 w_ = H[4 * g + ii]; \
          int a_ = __builtin_amdgcn_sdot4((int)w_.x, (int)xq4.x, 0, false); a_ = __builtin_amdgcn_sdot4((int)w_.y, (int)xq4.y, a_, false); \
          a_ = __builtin_amdgcn_sdot4((int)w_.z, (int)xq4.z, a_, false); a_ = __builtin_amdgcn_sdot4((int)w_.w, (int)xq4.w, a_, false); \
          a_ += __builtin_amdgcn_mov_dpp(a_, 0xB1, 0xF, 0xF, true); a_ += __builtin_amdgcn_mov_dpp(a_, 0x4E, 0xF, 0xF, true); a_ += __builtin_amdgcn_mov_dpp(a_, 0x141, 0xF, 0xF, true); \
          res[ii] = (float)a_ * sxk; } \
        if (j == 0) *(u32x2*)(o_ + 4 * g) = (u32x2){pk2(res[0], res[1]), pk2(res[2], res[3])}; } } \
    else { _Pragma("unroll") for (int gi = 0; gi < 2; ++gi) { const int cv_ = (int)xq4[2 * (h) + gi];        \
        _Pragma("unroll") for (int dc = 0; dc < 4; ++dc) { const unsigned A_ = H[4 * gi][dc], B_ = H[4 * gi + 1][dc], C_ = H[4 * gi + 2][dc], D_ = H[4 * gi + 3][dc]; \
            \
          const unsigned X_ = __builtin_amdgcn_perm(B_, A_, 0x05010400u), Y_ = __builtin_amdgcn_perm(B_, A_, 0x07030602u), Z_ = __builtin_amdgcn_perm(D_, C_, 0x05010400u), W_ = __builtin_amdgcn_perm(D_, C_, 0x07030602u); \
          acc[4 * dc + 0] = __builtin_amdgcn_sdot4((int)__builtin_amdgcn_perm(Z_, X_, 0x05040100u), cv_, acc[4 * dc + 0], false); \
          acc[4 * dc + 1] = __builtin_amdgcn_sdot4((int)__builtin_amdgcn_perm(Z_, X_, 0x07060302u), cv_, acc[4 * dc + 1], false); \
          acc[4 * dc + 2] = __builtin_amdgcn_sdot4((int)__builtin_amdgcn_perm(W_, Y_, 0x05040100u), cv_, acc[4 * dc + 2], false); \
          acc[4 * dc + 3] = __builtin_amdgcn_sdot4((int)__builtin_amdgcn_perm(W_, Y_, 0x07060302u), cv_, acc[4 * dc + 3], false); } } } } } while (0)
  auto finalize = [&](int k) {
    if (!AXPY || k >= ntok) return;
    const int t = tbeg + k * tstep;
    int S[8];
#pragma unroll
    for (int q = 0; q < 8; ++q) { auto rr = __builtin_amdgcn_permlane32_swap((unsigned)acc[q], (unsigned)acc[q + 8], false, false); S[q] = (int)rr[0] + (int)rr[1]; }
    int Tq[4];
#pragma unroll
    for (int q = 0; q < 4; ++q) { auto rr = __builtin_amdgcn_permlane16_swap((unsigned)S[q], (unsigned)S[q + 4], false, false); Tq[q] = (int)rr[0] + (int)rr[1]; }
#pragma unroll
    for (int q = 0; q < 4; ++q) Tq[q] += __builtin_amdgcn_mov_dpp(Tq[q], 0x128, 0xF, 0xF, true);
    float ss = 0.f;
    if ((lane & 8) == 0) {
      const size_t o = (size_t)t * DM + s * 128 + 16 * j + ((lane >> 5) & 1) * 8 + ((lane >> 4) & 1) * 4;
      u32x2* xgp = (u32x2*)((u16*)(p.ws + WS_XG) + o); const u32x2 xb = *xgp;
      const f32x4 y = {fmaf((float)Tq[0], sxk, bflo(xb.x)), fmaf((float)Tq[1], sxk, bfhi(xb.x)), fmaf((float)Tq[2], sxk, bflo(xb.y)), fmaf((float)Tq[3], sxk, bfhi(xb.y))};
      *xgp = (u32x2){pk2(y.x, y.y), pk2(y.z, y.w)};
      ss = (y.x * y.x + y.y * y.y) + (y.z * y.z + y.w * y.w);
    }
    ss = wave_sum(ss); if (lane == 0) ((float*)(p.ws + WS_SSQ))[(size_t)t * 8 + s] = ss;
  };
  LD_IDX(I0, 0); LD_IDX(I1, 1); LD_IDX(I2, 2); LD_HALF(H0, I0, 0); LD_HALF(H1, I0, 1); LD_AUX(X0, 0);
#pragma unroll 2
  for (int k = 0; k < ntok; k += 3) {
    LD_HALF(H2, I1, 0); LD_IDX(I0, k + 3); LD_AUX(X1, k + 1);
    T_BEGIN(X0); COMP(H0, 0, k);
    LD_HALF(H0, I1, 1);
    COMP(H1, 1, k); finalize(k);
    LD_HALF(H1, I2, 0); LD_IDX(I1, k + 4); LD_AUX(X2, k + 2);
    T_BEGIN(X1); COMP(H2, 0, k + 1);
    LD_HALF(H2, I2, 1);
    COMP(H0, 1, k + 1); finalize(k + 1);
    LD_HALF(H0, I0, 0); LD_IDX(I2, k + 5); LD_AUX(X0, k + 3);
    T_BEGIN(X2); COMP(H1, 0, k + 2);
    LD_HALF(H1, I0, 1);
    COMP(H2, 1, k + 2); finalize(k + 2);
  }
#undef TOK
#undef LD_IDX
#undef LD_HALF
#undef LD_AUX
#undef T_BEGIN
#undef COMP
}

DEVI void lru_passB(const Params& p, int item, int lane) {
  const int cg = item % 6, b = (item / 6) % NB, d = item / (6 * NB);
  const size_t o = (size_t)(d * NB + b) * NLCH * LRU_W + cg * 64 + lane;
  const float* Pp = (const float*)(p.ws + WS_LP) + o; const float* Hp = (const float*)(p.ws + WS_LH) + o; float* Cp = (float*)(p.ws + WS_LC) + o;
  float h = 0.f;
#pragma unroll 1
  for (int c0 = 0; c0 < NLCH; c0 += 32) {
    float pv[32], hv[32];
#pragma unroll
    for (int i = 0; i < 32; ++i) { const int cc = d ? NLCH - 1 - (c0 + i) : c0 + i; pv[i] = Pp[(size_t)cc * LRU_W]; hv[i] = Hp[(size_t)cc * LRU_W]; }
#pragma unroll
    for (int i = 0; i < 32; ++i) { const int cc = d ? NLCH - 1 - (c0 + i) : c0 + i; Cp[(size_t)cc * LRU_W] = h; h = fmaf(pv[i], h, hv[i]); }
  }
}

DEVI void swa_item(const Params& p, int layer, int item, char* lds) {
  const int tid = tidx(), wid = tid >> 6, lane = tid & 63, r32 = lane & 31, hi = lane >> 5;
  const int g = item & 1, n = (item >> 1) & 63, b = item >> 7;
  const int hq = 2 * g + (wid >> 2), qrow = n * 128 + (wid & 3) * 32;
  const u16* proj = (const u16*)(p.ws + WS_R1);
  const u16* Qw = proj + (size_t)(b * SEQ + qrow + r32) * INWP + PC_SQ + hq * 64 + hi * 8;
  const u16* Kh = proj + (size_t)(b * SEQ) * INWP + PC_SK + g * 64;
  const u16* Vh = proj + (size_t)(b * SEQ) * INWP + PC_SV + g * 64;
  const int kt0 = (2 * n - 2) < 0 ? 0 : (2 * n - 2), kt1 = (2 * n + 4) > SEQ / 64 ? SEQ / 64 : (2 * n + 4);
  const float sink = p.swa_sink[layer * 4 + hq];
  u16* Ow = (u16*)(p.ws + WS_MIX) + (size_t)(b * SEQ + qrow) * DM + 768 + hq * 64;
  attn_body<64, true>(Qw, Kh, INWP, Vh, INWP, kt0, kt1 - kt0, sink * 1.4426950408889634f, 1.f, qrow + r32, Ow, lds);
}
DEVI void mla_item(const Params& p, int pair, int qb, char* lds) {
  const int tid = tidx(), wid = tid >> 6, lane = tid & 63, r32 = lane & 31, hi = lane >> 5;
  const int b = pair / MLA_H, h = pair - b * MLA_H;
  const u16* Qw = (const u16*)(p.ws + WS_QM) + ((size_t)pair * SEQ + qb * 256 + wid * 32 + r32) * MLA_QK + hi * 8;
  const u16* Kh = (const u16*)(p.ws + WS_KM) + (size_t)pair * SEQ * MLA_QK;
  const u16* Vh = (const u16*)(p.ws + WS_VM) + (size_t)pair * SEQ * MLA_V;
  u16* Ow = (u16*)(p.ws + WS_MIX) + (size_t)(b * SEQ + qb * 256 + wid * 32) * DM + h * 64;
  attn_body<96, false>(Qw, Kh, MLA_QK, Vh, MLA_V, 0, SEQ / 64, -1e30f, 0.f, 0, Ow, lds, (float)p.pos[b * SEQ + qb * 256 + wid * 32 + r32]);
}


namespace pg8 {
#define PG8_LAS __attribute__((address_space(3)))
constexpr int BM = 256, BK = 64, HALF = 128, HTB = HALF * BK * 2, NXCD = 8, WGM = 8;
DEVI int lds_byte(int r, int c) { const int st = (r >> 4) * 2 + (c >> 5), rr = r & 15, cc = c & 31, ob = rr * 64 + cc * 2; return st * 1024 + (ob ^ (((ob >> 9) & 1) << 5)); }
DEVI void stage_rc(int b, int& R, int& C) { const int st = b / 1024, sb = b % 1024, swz = sb ^ (((sb >> 9) & 1) << 5); R = (st >> 1) * 16 + swz / 64; C = (st & 1) * 32 + (swz % 64) / 2; }
DEVI int perm32(int rho) { const int n = rho >> 4, i = rho & 15; return 8 * (i >> 2) + 4 * n + (i & 3); }
struct Unit { int pm, pn; };
struct Gemm { const u16* A; const u16* Bt; int M, N, K, lda, ldb; };
struct StaticOrder {
  int nM, nN, nwg, G, c;
  DEVI void init(int M, int N, int G_, int c_) { nM = M / BM; nN = N / BM; nwg = nM * nN; G = G_; c = c_; }
  DEVI bool next(int i, Unit& u) const {
    const long L = (long)i * G + c; if (L >= nwg) return false;
    int wgid = (int)L; { const int q = nwg / NXCD, r = nwg % NXCD, xcd = wgid % NXCD, off = wgid / NXCD; wgid = (xcd < r ? xcd * (q + 1) : r * (q + 1) + (xcd - r) * q) + off; }
    const int nig = WGM * nN, gid = wgid / nig, fm = gid * WGM, gsz = (nM - fm) < WGM ? (nM - fm) : WGM;
    u.pm = fm + ((wgid % nig) % gsz); u.pn = (wgid % nig) / gsz; return true;
  }
};
template <class Epi>
DEVI void gemm_phase(PG8_LAS unsigned char* lds, const Gemm g, const StaticOrder& S, const Epi& E) {
  const int tid = tidx(), wid = __builtin_amdgcn_readfirstlane(tid >> 6), lane = tid & 63, wr = wid >> 2, wc = wid & 3, fr = lane & 15, fq = lane >> 4;
  const int K = g.K; int nt = K / BK; asm volatile("" : "+s"(nt));
  unsigned voffA[2], voffB[2];
#pragma unroll
  for (int i = 0; i < 2; ++i) { int R, C; stage_rc(tid * 16 + i * 8192, R, C); const int Rb = (R & ~31) + perm32(R & 31);
    voffA[i] = (unsigned)(R * g.lda + C) * 2u; voffB[i] = (unsigned)(Rb * g.ldb + C) * 2u; }
  const size_t kstep = (size_t)(BK * 2), hstepA = (size_t)HALF * g.lda * 2, hstepB = (size_t)HALF * g.ldb * 2, tstepA = 2 * hstepA, tstepB = 2 * hstepB;
  const unsigned ldsw = (unsigned)wid * 1024u;
  const int aoff = lds_byte(wr * 64 + fr, fq * 8), boff = lds_byte(wc * 32 + fr, fq * 8);
#define PG8_SA(b, h) (((b) * 2 + (h)) * HTB)
#define PG8_SB(b, h) ((4 + (b) * 2 + (h)) * HTB)
#define PG8_STAGE(bufoff, gbase, voff) do { _Pragma("unroll") for (int _i = 0; _i < 2; ++_i) \
    __builtin_amdgcn_global_load_lds((const unsigned*)((const char*)(gbase) + (voff)[_i]), (PG8_LAS unsigned*)(lds + (bufoff) + ldsw + _i * 8192), 16, 0, 0); } while (0)
#define PG8_LDA(dst, b, h) do { _Pragma("unroll") for (int m = 0; m < 4; ++m) _Pragma("unroll") for (int k = 0; k < 2; ++k) dst[m][k] = *(const PG8_LAS bf16x8*)(lds + PG8_SA(b, h) + aoff + m * 2048 + k * 1024); } while (0)
#define PG8_LDB(dst, b, h) do { _Pragma("unroll") for (int n = 0; n < 2; ++n) _Pragma("unroll") for (int k = 0; k < 2; ++k) dst[n][k] = *(const PG8_LAS bf16x8*)(lds + PG8_SB(b, h) + boff + n * 2048 + k * 1024); } while (0)
#define PG8_MMA(ai, bj, At, Bt) do { __builtin_amdgcn_s_setprio(1); _Pragma("unroll") for (int m = 0; m < 4; ++m) _Pragma("unroll") for (int n = 0; n < 2; ++n) _Pragma("unroll") for (int k = 0; k < 2; ++k) \
    acc[ai][bj][m][n] = __builtin_amdgcn_mfma_f32_16x16x32_bf16(Bt[n][k], At[m][k], acc[ai][bj][m][n], 0, 0, 0); __builtin_amdgcn_s_setprio(0); } while (0)
#define PG8_WAIT_V(n) asm volatile("s_waitcnt vmcnt(" #n ")" ::: "memory")
#define PG8_WAIT_L(n) asm volatile("s_waitcnt lgkmcnt(" #n ")" ::: "memory")
#define PG8_BAR __builtin_amdgcn_s_barrier()
#define PG8_SCHED __builtin_amdgcn_sched_barrier(0)
  Unit cur, nxt; int ui = 0;
  if (!S.next(0, cur)) return;
  f32x4 acc[2][2][4][2];
#pragma unroll
  for (int a = 0; a < 2; ++a)
#pragma unroll
    for (int b = 0; b < 2; ++b)
#pragma unroll
      for (int m = 0; m < 4; ++m)
#pragma unroll
        for (int n = 0; n < 2; ++n) acc[a][b][m][n] = (f32x4){0.f, 0.f, 0.f, 0.f};
  bf16x8 At[4][2], B0[2][2], B1[2][2];
  const char* cA = (const char*)g.A + (size_t)cur.pm * tstepA; const char* cB = (const char*)g.Bt + (size_t)cur.pn * tstepB;
  PG8_STAGE(PG8_SB(0, 0), cB, voffB); PG8_STAGE(PG8_SB(0, 1), cB + hstepB, voffB); PG8_STAGE(PG8_SA(0, 0), cA, voffA); PG8_STAGE(PG8_SA(0, 1), cA + hstepA, voffA);
  if (wr == 1) PG8_BAR;
  PG8_WAIT_V(2); PG8_BAR;
  PG8_STAGE(PG8_SB(1, 0), cB + kstep, voffB); PG8_STAGE(PG8_SA(1, 0), cA + kstep, voffA); PG8_STAGE(PG8_SB(1, 1), cB + hstepB + kstep, voffB);
  PG8_WAIT_V(6); PG8_BAR;
  for (;;) {
    const bool has_next = S.next(ui + 1, nxt);
    const char* nA = has_next ? (const char*)g.A + (size_t)nxt.pm * tstepA : cA; const char* nB = has_next ? (const char*)g.Bt + (size_t)nxt.pn * tstepB : cB;
#pragma unroll 1
    for (int t = 0; t < nt; t += 2) {
      const bool last = (t == nt - 2);
      const char* a1 = cA + (size_t)(t + 1) * kstep;
      const char* a2 = last ? nA : cA + (size_t)(t + 2) * kstep; const char* b2 = last ? nB : cB + (size_t)(t + 2) * kstep;
      const char* a3 = a2 + kstep; const char* b3 = b2 + kstep;
      PG8_LDB(B0, 0, 0); PG8_LDB(B1, 0, 1); PG8_SCHED; PG8_LDA(At, 0, 0); PG8_STAGE(PG8_SA(1, 1), a1 + hstepA, voffA);
      PG8_WAIT_V(8); PG8_WAIT_L(0); PG8_BAR; PG8_MMA(0, 0, At, B0); PG8_MMA(0, 1, At, B1); PG8_BAR; PG8_SCHED;
      PG8_LDA(At, 0, 1); PG8_STAGE(PG8_SB(0, 0), b2, voffB); PG8_STAGE(PG8_SB(0, 1), b2 + hstepB, voffB); PG8_STAGE(PG8_SA(0, 0), a2, voffA);
      PG8_WAIT_V(8); PG8_WAIT_L(0); PG8_BAR; PG8_MMA(1, 0, At, B0); PG8_MMA(1, 1, At, B1); PG8_BAR; PG8_SCHED;
      PG8_LDB(B0, 1, 0); PG8_LDB(B1, 1, 1); PG8_SCHED; PG8_LDA(At, 1, 0); PG8_STAGE(PG8_SA(0, 1), a2 + hstepA, voffA);
      PG8_WAIT_V(8); PG8_WAIT_L(0); PG8_BAR; PG8_MMA(0, 0, At, B0); PG8_MMA(0, 1, At, B1); PG8_BAR; PG8_SCHED;
      PG8_LDA(At, 1, 1); PG8_STAGE(PG8_SB(1, 0), b3, voffB); PG8_STAGE(PG8_SB(1, 1), b3 + hstepB, voffB); PG8_STAGE(PG8_SA(1, 0), a3, voffA);
      PG8_WAIT_V(8); PG8_WAIT_L(0); PG8_BAR; PG8_MMA(1, 0, At, B0); PG8_MMA(1, 1, At, B1); PG8_BAR; PG8_SCHED;
    }
    if (wr == 0) PG8_BAR;
    E(acc, cur, wr, wc, fr, fq);
    if (!has_next) break;
#pragma unroll
    for (int a = 0; a < 2; ++a)
#pragma unroll
      for (int b = 0; b < 2; ++b)
#pragma unroll
        for (int m = 0; m < 4; ++m)
#pragma unroll
          for (int n = 0; n < 2; ++n) acc[a][b][m][n] = (f32x4){0.f, 0.f, 0.f, 0.f};
    cur = nxt; cA = nA; cB = nB; ++ui;
    if (wr == 1) PG8_BAR;
  }
  PG8_WAIT_V(0);
  PG8_BAR;
#undef PG8_SA
#undef PG8_SB
#undef PG8_STAGE
#undef PG8_LDA
#undef PG8_LDB
#undef PG8_MMA
#undef PG8_WAIT_V
#undef PG8_WAIT_L
#undef PG8_BAR
#undef PG8_SCHED
}

DEVI float rs_from8(const float* s) { const f32x4 a = *(const f32x4*)s, b = *(const f32x4*)(s + 4); return rsqrtf((((a.x + a.y) + (a.z + a.w)) + ((b.x + b.y) + (b.z + b.w))) * (1.f / DM) + EPS); }
struct EpiProj { u16* proj; const int* pos; const float* ssq8; float* ssqq; float* ssqkv;
  DEVI void operator()(const f32x4 (&acc)[2][2][4][2], const Unit& u, int wr, int wc, int fr, int fq) const {
    const int row0 = u.pm * BM + wr * 64 + fr, col0 = u.pn * BM + wc * 32 + 8 * fq;
#pragma unroll
    for (int ai = 0; ai < 2; ++ai)
#pragma unroll
      for (int m = 0; m < 4; ++m) { const int row = row0 + ai * HALF + m * 16; const float rs = rs_from8(ssq8 + (size_t)row * 8); const float posf = (float)pos[row];
        float sq0 = 0.f, sq1 = 0.f;
#pragma unroll
        for (int bj = 0; bj < 2; ++bj) { const int gcol = col0 + bj * HALF;
          float v[8]; { const f32x4 a = acc[ai][bj][m][0] * rs, b = acc[ai][bj][m][1] * rs; v[0] = a.x; v[1] = a.y; v[2] = a.z; v[3] = a.w; v[4] = b.x; v[5] = b.y; v[6] = b.z; v[7] = b.w; }
          if (u.pn <= 1) { float s = 0.f;
#pragma unroll
            for (int q = 0; q < 8; ++q) s = fmaf(v[q], v[q], s);
            if (bj == 0) sq0 = s; else sq1 = s; }
          const bool r64 = gcol >= PC_SQ && gcol < PC_SV, r32g = gcol >= PC_KR && gcol < PC_KR + 32;
          if (gcol >= PC_SQ && gcol < PC_SK) {
#pragma unroll
            for (int q = 0; q < 8; ++q) v[q] *= 0.18033688f; }
          if (r64 || r32g) {
#pragma unroll
            for (int q = 0; q < 4; ++q) { const int f = r64 ? (((gcol + 2 * q) & 63) >> 1) : 2 * (((gcol + 2 * q) & 31) >> 1); float sn, cs; rope_sc(posf, f, sn, cs);
              const float x1 = v[2 * q], x2 = v[2 * q + 1]; v[2 * q] = x1 * cs - x2 * sn; v[2 * q + 1] = x2 * cs + x1 * sn; } }
          *(u32x4*)(proj + (size_t)row * INWP + gcol) = pk8(v); }
        if (u.pn <= 1) { float s = u.pn == 0 ? sq0 + sq1 : sq0; s += __shfl_xor(s, 16); s += __shfl_xor(s, 32);
          if (fq == 0) (u.pn == 0 ? ssqq : ssqkv)[(size_t)row * 4 + wc] = s; } }
  }
};
struct EpiQ2 { u16* qm; const float* ssqq;
  DEVI void operator()(const f32x4 (&acc)[2][2][4][2], const Unit& u, int wr, int wc, int fr, int fq) const {
    const int b = (u.pm * BM) >> 13, s0 = (u.pm * BM) & (SEQ - 1), lrow = wr * 64 + fr;
    const float* sq = ssqq + (size_t)(u.pm * BM) * 4 + lrow * 4;
    float rs[2][4];
#pragma unroll
    for (int ai = 0; ai < 2; ++ai)
#pragma unroll
      for (int m = 0; m < 4; ++m) { const f32x4 sp = *(const f32x4*)(sq + (ai * HALF + m * 16) * 4); rs[ai][m] = 0.14724444f * rsqrtf(((sp.x + sp.y) + (sp.z + sp.w)) * (1.f / 256.f) + EPS); }
#pragma unroll
    for (int bj = 0; bj < 2; ++bj) { const int gcol = u.pn * BM + bj * HALF + wc * 32 + 8 * fq;
      if (gcol < 576) { const int head = (gcol * 683) >> 16, j0 = gcol - head * 96;
        u16* base = qm + ((size_t)(b * MLA_H + head) * SEQ + s0) * MLA_QK + (unsigned)(lrow * MLA_QK + j0);
#pragma unroll
        for (int ai = 0; ai < 2; ++ai)
#pragma unroll
          for (int m = 0; m < 4; ++m) { const float r = rs[ai][m];
            float v[8]; { const f32x4 a = acc[ai][bj][m][0] * r, bb = acc[ai][bj][m][1] * r; v[0] = a.x; v[1] = a.y; v[2] = a.z; v[3] = a.w; v[4] = bb.x; v[5] = bb.y; v[6] = bb.z; v[7] = bb.w; }
            *(u32x4*)(base + (ai * HALF + m * 16) * MLA_QK) = pk8(v); } } }
  }
};
struct EpiKV2 { u16* km; u16* vm; const float* ssqkv;
  DEVI void operator()(const f32x4 (&acc)[2][2][4][2], const Unit& u, int wr, int wc, int fr, int fq) const {
    const int b = (u.pm * BM) >> 13, s0 = (u.pm * BM) & (SEQ - 1), lrow = wr * 64 + fr;
    const float* sq = ssqkv + (size_t)(u.pm * BM) * 4 + lrow * 4;
    float rs[2][4];
#pragma unroll
    for (int ai = 0; ai < 2; ++ai)
#pragma unroll
      for (int m = 0; m < 4; ++m) { const f32x4 sp = *(const f32x4*)(sq + (ai * HALF + m * 16) * 4); rs[ai][m] = rsqrtf(((sp.x + sp.y) + (sp.z + sp.w)) * (1.f / 128.f) + EPS); }
#pragma unroll
    for (int bj = 0; bj < 2; ++bj) { const int head = u.pn * 2 + bj, c = wc * 32 + 8 * fq;
      const size_t tok0 = (size_t)(b * MLA_H + head) * SEQ + s0;
      u16* base = c < 64 ? km + tok0 * MLA_QK + (unsigned)(lrow * MLA_QK + c) : vm + tok0 * MLA_V + (unsigned)(lrow * MLA_V + (c - 64));
      const int ld = c < 64 ? MLA_QK : MLA_V;
#pragma unroll
      for (int ai = 0; ai < 2; ++ai)
#pragma unroll
        for (int m = 0; m < 4; ++m) { const float r = rs[ai][m];
          float v[8]; { const f32x4 a = acc[ai][bj][m][0] * r, bb = acc[ai][bj][m][1] * r; v[0] = a.x; v[1] = a.y; v[2] = a.z; v[3] = a.w; v[4] = bb.x; v[5] = bb.y; v[6] = bb.z; v[7] = bb.w; }
          *(u32x4*)(base + (ai * HALF + m * 16) * ld) = pk8(v); } }
  }
};
struct EpiPQ { u16* O; const float* ssq16;
  DEVI void operator()(const f32x4 (&acc)[2][2][4][2], const Unit& u, int wr, int wc, int fr, int fq) const {
    const int row0 = u.pm * BM + wr * 64 + fr, col0 = u.pn * BM + wc * 32 + 8 * fq;
#pragma unroll
    for (int ai = 0; ai < 2; ++ai)
#pragma unroll
      for (int m = 0; m < 4; ++m) { const int row = row0 + ai * HALF + m * 16;
        const f32x4* sp = (const f32x4*)(ssq16 + (size_t)row * 16); const f32x4 s4 = (sp[0] + sp[1]) + (sp[2] + sp[3]);
        const float rs = rsqrtf(((s4.x + s4.y) + (s4.z + s4.w)) * (1.f / DM) + EPS);
#pragma unroll
        for (int bj = 0; bj < 2; ++bj) { float v[8]; { const f32x4 a = acc[ai][bj][m][0] * rs, b = acc[ai][bj][m][1] * rs; v[0] = a.x; v[1] = a.y; v[2] = a.z; v[3] = a.w; v[4] = b.x; v[5] = b.y; v[6] = b.z; v[7] = b.w; }
          *(u32x4*)(O + (size_t)row * 2048 + col0 + bj * HALF) = pk8(v); } }
  }
};
struct EpiRes { u16* xg; float* ssq16;
  DEVI void operator()(const f32x4 (&acc)[2][2][4][2], const Unit& u, int wr, int wc, int fr, int fq) const {
    const int row0 = u.pm * BM + wr * 64 + fr, col0 = u.pn * BM + wc * 32 + 8 * fq;
#pragma unroll
    for (int ai = 0; ai < 2; ++ai)
#pragma unroll
      for (int m = 0; m < 4; ++m) { const int row = row0 + ai * HALF + m * 16; float ss = 0.f;
#pragma unroll
        for (int bj = 0; bj < 2; ++bj) { const size_t o = (size_t)row * DM + col0 + bj * HALF;
          float x[8]; unpk8(*(const u32x4*)(xg + o), x);
          const f32x4 a = acc[ai][bj][m][0], b = acc[ai][bj][m][1];
          x[0] += a.x; x[1] += a.y; x[2] += a.z; x[3] += a.w; x[4] += b.x; x[5] += b.y; x[6] += b.z; x[7] += b.w;
#pragma unroll
          for (int q = 0; q < 8; ++q) ss = fmaf(x[q], x[q], ss);
          *(u32x4*)(xg + o) = pk8(x); }
        ss += __shfl_xor(ss, 16); ss += __shfl_xor(ss, 32);
        if (fq == 0) ssq16[(size_t)row * 16 + u.pn * 4 + wc] = ss; }
  }
};
}


DEVI void lru_gate_item(const Params& p, int l, int mt, int n, char* lds) {
  const int tid = tidx(), lane = tid & 63, wid = tid >> 6, wm = wid >> 1, wn = wid & 1, r32 = lane & 31, hi = lane >> 5;
  const int srow = tid >> 3, sc = tid & 7, m0 = mt * 256;
  const u16* PROJ = (const u16*)(p.ws + WS_R1);
  GemmDesc g{}; g.proj = PROJ; g.cw = p.conv_w + l * 4 * LRU_W; g.cb = p.conv_b + l * LRU_W; g.ch0 = n * 64;
  char* Ab = lds; char* Bb = lds + 32768;
  { bf16x8 ar[4], br[4];
#pragma unroll
    for (int i = 0; i < 4; ++i) ar[i] = load_a<1>(g, m0 + srow + 64 * i, sc * 8);
    const u16* W = (const u16*)(p.ws + WS_WLRU) + (size_t)((l * 6 + n) * 2) * 128 * 64;
#pragma unroll
    for (int i = 0; i < 4; ++i) br[i] = *(const bf16x8*)(W + (size_t)(srow + 64 * i) * 64 + sc * 8);
#pragma unroll
    for (int i = 0; i < 4; ++i) { *(bf16x8*)(Ab + swz(srow + 64 * i, sc)) = ar[i]; *(bf16x8*)(Bb + (i >> 1) * 16384 + swz(srow + 64 * (i & 1), sc)) = br[i]; } }
  __syncthreads();
  bf16x8 a[2][4];
#pragma unroll
  for (int t = 0; t < 2; ++t)
#pragma unroll
    for (int k = 0; k < 4; ++k) a[t][k] = *(const bf16x8*)(Ab + swz(wm * 64 + t * 32 + r32, k * 2 + hi));
  const int jl = 32 * wn + r32, ch = n * 64 + jl;
  float xf[2][16];
#pragma unroll
  for (int t = 0; t < 2; ++t)
#pragma unroll
    for (int r = 0; r < 16; ++r) { const int row = wm * 64 + t * 32 + crow(r, hi); xf[t][r] = bf2f(*(const u16*)(Ab + swz(row, jl >> 3) + (jl & 7) * 2)); }
  const int bidx = m0 >> 13, s0 = (m0 & (SEQ - 1)) + wm * 64;
#pragma unroll
  for (int d = 0; d < 2; ++d) {
    f32x16 acc[2][2] = {{f32x16{}, f32x16{}}, {f32x16{}, f32x16{}}};
#pragma unroll
    for (int k = 0; k < 4; ++k) { bf16x8 b[2];
#pragma unroll
      for (int q = 0; q < 2; ++q) b[q] = *(const bf16x8*)(Bb + d * 16384 + swz(wn * 64 + q * 32 + r32, k * 2 + hi));
#pragma unroll
      for (int t = 0; t < 2; ++t)
#pragma unroll
        for (int q = 0; q < 2; ++q) acc[t][q] = __builtin_amdgcn_mfma_f32_32x32x16_bf16(a[t][k], b[q], acc[t][q], 0, 0, 0); }
    const float bav = p.lru_ba[((l * 2 + d) * 6 + n) * 64 + jl], bxv = p.lru_bx[((l * 2 + d) * 6 + n) * 64 + jl];
    const float cdec2 = -8.f * 1.4426950408889634f * log1pf(__expf(-p.lru_lambda[(l * 2 + d) * LRU_W + ch]));
    u16* le = (u16*)(p.ws + WS_LE); u16* lb = (u16*)(p.ws + WS_LB);
    float runP[2][4], runH[2][4];
#pragma unroll
    for (int t = 0; t < 2; ++t)
#pragma unroll
      for (int rr = 0; rr < 4; ++rr) {
        float ev[4], bv[4];
#pragma unroll
        for (int q = 0; q < 4; ++q) { const int r = rr * 4 + q;
          const float rg = __builtin_amdgcn_rcpf(1.f + __builtin_amdgcn_exp2f(-1.4426950408889634f * (acc[t][0][r] + bav)));
          const float ig = __builtin_amdgcn_rcpf(1.f + __builtin_amdgcn_exp2f(-1.4426950408889634f * (acc[t][1][r] + bxv)));
          const float aa = __builtin_amdgcn_exp2f(cdec2 * rg), e = 1.f - aa; ev[q] = e; bv[q] = __builtin_amdgcn_sqrtf(e * (2.f - e)) * ig * xf[t][r]; }
        const size_t o = (((size_t)(d * NB + bidx) * (SEQ / 8) + ((s0 + 32 * t + 8 * rr) >> 3)) * LRU_W + ch) * 8 + 4 * hi;
        const u32x2 ew = {pk2(ev[0], ev[1]), pk2(ev[2], ev[3])}, bw = {pk2(bv[0], bv[1]), pk2(bv[2], bv[3])};
        *(u32x2*)(le + o) = ew; *(u32x2*)(lb + o) = bw;
        const float a0 = 1.f - bflo(ew.x), a1 = 1.f - bfhi(ew.x), a2 = 1.f - bflo(ew.y), a3 = 1.f - bfhi(ew.y);
        const float b0 = bflo(bw.x), b1 = bfhi(bw.x), b2 = bflo(bw.y), b3 = bfhi(bw.y);
        if (d == 0) { runP[t][rr] = (a0 * a1) * (a2 * a3); runH[t][rr] = fmaf(a3, fmaf(a2, fmaf(a1, b0, b1), b2), b3); }
        else { runP[t][rr] = (a0 * a1) * (a2 * a3); runH[t][rr] = fmaf(a0, fmaf(a1, fmaf(a2, b3, b2), b1), b0); } }
    { float Pc = 1.f, Hc = 0.f;
#pragma unroll
      for (int i = 0; i < 8; ++i) { const int ii = d == 0 ? i : 7 - i, t = ii >> 2, rr = ii & 3;
        auto rp = __builtin_amdgcn_permlane32_swap(__float_as_uint(runP[t][rr]), __float_as_uint(runP[t][rr]), false, false);
        auto rh = __builtin_amdgcn_permlane32_swap(__float_as_uint(runH[t][rr]), __float_as_uint(runH[t][rr]), false, false);
        const float P0 = __uint_as_float(rp[0]), P1 = __uint_as_float(rp[1]), H0 = __uint_as_float(rh[0]), H1 = __uint_as_float(rh[1]);
        if (d == 0) { Hc = fmaf(P0, Hc, H0); Pc *= P0; Hc = fmaf(P1, Hc, H1); Pc *= P1; }
        else { Hc = fmaf(P1, Hc, H1); Pc *= P1; Hc = fmaf(P0, Hc, H0); Pc *= P0; } }
      if (hi == 0) { const size_t o = ((size_t)(d * NB + bidx) * NLCH + (s0 >> 6)) * LRU_W + ch;
        ((float*)(p.ws + WS_LP))[o] = Pc; ((float*)(p.ws + WS_LH))[o] = Hc; } }
  }
  __syncthreads();
}


DEVI void sort16_desc(float (&v)[16]) {
#pragma unroll
  for (int k = 2; k <= 16; k <<= 1)
#pragma unroll
    for (int j = k >> 1; j > 0; j >>= 1)
#pragma unroll
      for (int i = 0; i < 16; ++i) { const int l = i ^ j; if (l > i) { const float a = v[i], b = v[l]; const bool desc = (i & k) == 0;
          v[i] = desc ? fmaxf(a, b) : fminf(a, b); v[l] = desc ? fminf(a, b) : fmaxf(a, b); } }
}
DEVI void merge16_desc(float (&l)[16], const float (&s)[16]) {
#pragma unroll
  for (int i = 0; i < 16; ++i) l[i] = fmaxf(l[i], s[15 - i]);
#pragma unroll
  for (int st = 8; st >= 1; st >>= 1)
#pragma unroll
    for (int i = 0; i < 16; ++i) if ((i & st) == 0) ce_desc(l[i], l[i + st]);
}
DEVI void pair_merge16(float (&l)[16]) {
  float o[16];
#pragma unroll
  for (int i = 0; i < 16; ++i) o[i] = __shfl_xor(l[i], 1);
  merge16_desc(l, o);
}
DEVI void top16_from_C(const float* C, int row, int part, float (&l)[16]) {
#pragma unroll
  for (int i = 0; i < 16; ++i) l[i] = -3.0e38f;
#pragma unroll 1
  for (int bt = 0; bt < 4; ++bt) { float s[16];
#pragma unroll
    for (int i = 0; i < 16; ++i) { const int col = part * 64 + ((bt * 16 + i + row) & 63);
      s[i] = __uint_as_float((__float_as_uint(C[row * CLD + col]) & ~127u) | (unsigned)(127 - col)); }
    sort16_desc(s);
    merge16_desc(l, s); }
  pair_merge16(l);
}
DEVI void peer_route_item(const Params& p, int l, int mt, int h, char* lds) {
  const int tid = tidx(), row = tid >> 1, part = tid & 1, m0 = mt * 256;
  const u16* PQ = (const u16*)(p.ws + WS_R1);
  float t1[16], t2[16];
#pragma unroll
  for (int j = 0; j < 2; ++j) {
    GemmDesc g{}; g.A = PQ + (h * 2 + j) * 128; g.lda = 2048; g.Bt = (const u16*)(p.ws + WS_SUBK) + (size_t)(l * 2 + j) * 128 * 128; g.ldb = 128; g.KT = 2;
    gemm_core<0, 0>(g, m0, 0, lds);
    if (j == 0) top16_from_C((const float*)lds, row, part, t1); else top16_from_C((const float*)lds, row, part, t2);
    __syncthreads(); }
  constexpr int CA[50] = {0, 0, 0, 0, 0, 0, 0, 0, 0, 0, 0, 0, 0, 0, 0, 0, 1, 1, 1, 1, 1, 1, 1, 1, 2, 2, 2, 2, 2, 3, 3, 3, 3, 4, 4, 4, 5, 5, 6, 6, 7, 7, 8, 9, 10, 11, 12, 13, 14, 15};
  constexpr int CB[50] = {0, 1, 2, 3, 4, 5, 6, 7, 8, 9, 10, 11, 12, 13, 14, 15, 0, 1, 2, 3, 4, 5, 6, 7, 0, 1, 2, 3, 4, 0, 1, 2, 3, 0, 1, 2, 0, 1, 0, 1, 0, 1, 0, 0, 0, 0, 0, 0, 0, 0};
  float lo[16], hi2[16];
#pragma unroll
  for (int k = 0; k < 32; ++k) { float v = -3.0e38f;
    if (k < 25) { const float v0 = __uint_as_float((__float_as_uint(t1[CA[2 * k]] + t2[CB[2 * k]]) & ~255u) | (unsigned)(255 - (CA[2 * k] * 16 + CB[2 * k])));
      const float v1 = __uint_as_float((__float_as_uint(t1[CA[2 * k + 1]] + t2[CB[2 * k + 1]]) & ~255u) | (unsigned)(255 - (CA[2 * k + 1] * 16 + CB[2 * k + 1])));
      v = part ? v1 : v0; }
    if (k < 16) lo[k] = v; else hi2[k - 16] = v; }
  sort16_desc(lo); sort16_desc(hi2); merge16_desc(lo, hi2); pair_merge16(lo);
  const float mx = __uint_as_float(__float_as_uint(lo[0]) & ~255u);
  float w[16], sum = 0.f;
#pragma unroll
  for (int i = 0; i < 16; ++i) { w[i] = __expf(__uint_as_float(__float_as_uint(lo[i]) & ~255u) - mx); sum += w[i]; }
  const float inv = 1.f / sum;
  unsigned char* my = (unsigned char*)lds + tid * 32;
#pragma unroll
  for (int i = 0; i < 16; ++i) { my[i] = (unsigned char)(127u - (__float_as_uint(t1[i]) & 127u)); my[16 + i] = (unsigned char)(127u - (__float_as_uint(t2[i]) & 127u)); }
  unsigned ev[8]; float gv[8];
  const unsigned pm = 0u - (unsigned)part;
#pragma unroll
  for (int i = 0; i < 8; ++i) { const unsigned xb = __float_as_uint(lo[i]) ^ ((__float_as_uint(lo[i]) ^ __float_as_uint(lo[8 + i])) & pm); const unsigned code = 255u - (xb & 255u);
    const unsigned wb = __float_as_uint(w[i]) ^ ((__float_as_uint(w[i]) ^ __float_as_uint(w[8 + i])) & pm);
    ev[i] = (unsigned)my[code >> 4] * 128u + (unsigned)my[16 + (code & 15)]; gv[i] = __uint_as_float(wb) * inv; }
  const size_t o = ((size_t)(m0 + row) * 8 + h) * 16 + part * 8;
  *(u32x4*)((u16*)(p.ws + WS_EIDX) + o) = (u32x4){ev[0] | (ev[1] << 16), ev[2] | (ev[3] << 16), ev[4] | (ev[5] << 16), ev[6] | (ev[7] << 16)};
  *(f32x4*)((float*)(p.ws + WS_EGATE) + o) = (f32x4){gv[0], gv[1], gv[2], gv[3]}; *(f32x4*)((float*)(p.ws + WS_EGATE) + o + 4) = (f32x4){gv[4], gv[5], gv[6], gv[7]};
  __syncthreads();
}

DEVI void peer_convert_tables(const Params& p, int l, size_t i0, size_t istep) {
  const float* us = p.peer_u + (size_t)l * NEXP * DM; const float* vs = p.peer_v + (size_t)l * NEXP * DM;
  u8* ub = (u8*)(p.ws + WS_UB); u8* vbf = (u8*)(p.ws + WS_VB);
  for (size_t i = i0; i < (size_t)NEXP * 64; i += istep) {
    const size_t e = i >> 6; const int c16 = (int)(i & 63), s = c16 >> 3, cc = (c16 & 7) * 16;
    float a[16], b[16]; ld8(us + i * 16, a); ld8(us + i * 16 + 8, a + 8); ld8(vs + i * 16, b); ld8(vs + i * 16 + 8, b + 8);
    const size_t o = ((size_t)s * NEXP + e) * 128 + cc;
    *(u32x4*)(ub + o) = (u32x4){q8x4(a, PEER_SU), q8x4(a + 4, PEER_SU), q8x4(a + 8, PEER_SU), q8x4(a + 12, PEER_SU)};
    *(u32x4*)(vbf + o) = (u32x4){q8x4(b, PEER_SV), q8x4(b + 4, PEER_SV), q8x4(b + 8, PEER_SV), q8x4(b + 12, PEER_SV)}; }
}

constexpr int PH_PER_LAYER = 10, N_PHASES = 2 + DEPTH * PH_PER_LAYER;
DEVI void run_phase(const Params& pin, int ph, int vb, int nb, char* lds) {
  const bool dry = ph >= 100; if (dry) ph -= 100;
  Params p = pin; { size_t z = 0; asm volatile("" : "+s"(z)); p.ws = pin.ws + z; p.out = pin.out + z; } asm volatile("" : "+s"(vb));
  const int tid = tidx(), wid = tid >> 6, lane = tid & 63;
#ifdef ONLY_SP
  if (ONLY_SP >= 0 && ph == 0) return;
#endif
  if (ph == 0) { phase0(p, vb, nb, lds); return; }
  if (ph == N_PHASES - 1) {
    const float* ssq = (const float*)(p.ws + WS_SSQ); const u16* xg = (const u16*)(p.ws + WS_XG);
    for (size_t i = (size_t)vb * NTHREADS + tid; i < (size_t)T * DM / 8; i += (size_t)nb * NTHREADS) {
      const size_t t = i >> 7; const int c = (int)(i & 127) * 8;
      float s8[8]; ld8(ssq + t * 8, s8); const float rs = rsqrtf((((s8[0] + s8[1]) + (s8[2] + s8[3])) + ((s8[4] + s8[5]) + (s8[6] + s8[7]))) * (1.f / DM) + EPS);
      float x[8], g[8]; unpk8(*(const u32x4*)(xg + i * 8), x); ld8(p.norm_final + c, g);
#pragma unroll
      for (int q = 0; q < 8; ++q) x[q] *= rs * g[q];
      *(f32x4*)(p.out + i * 8) = (f32x4){x[0], x[1], x[2], x[3]}; *(f32x4*)(p.out + i * 8 + 4) = (f32x4){x[4], x[5], x[6], x[7]}; }
    return; }
  const int l = (ph - 1) / PH_PER_LAYER, sp = (ph - 1) % PH_PER_LAYER;
  u16* const XG = (u16*)(p.ws + WS_XG); u16* const PROJ = (u16*)(p.ws + WS_R1); u16* const MIX = (u16*)(p.ws + WS_MIX);
  constexpr int NMT = T / 256;
#ifdef ONLY_SP
  if (sp != ONLY_SP) return;
#endif
  switch (sp) {
  case 0: {
    pg8::Gemm g{XG, (const u16*)(p.ws + WS_WIN) + (size_t)l * INWP * DM, T, INWP, DM, DM, DM}; pg8::StaticOrder S; S.init(T, INWP, nb, vb);
    pg8::EpiProj e{PROJ, p.pos, (const float*)(p.ws + WS_SSQ), (float*)(p.ws + WS_SSQQ), (float*)(p.ws + WS_SSQKV)};
    pg8::gemm_phase((PG8_LAS unsigned char*)lds, g, S, e);
    if (!dry) { if (nb == 256) { if (vb >= 128) peer_convert_tables(p, l, (size_t)(vb - 128) * NTHREADS + tid, (size_t)128 * NTHREADS); }
                else peer_convert_tables(p, l, (size_t)vb * NTHREADS + tid, (size_t)nb * NTHREADS); }
  } break;
  case 1: {
    { pg8::Gemm g{PROJ + PC_CQ, (const u16*)(p.ws + WS_WUQ) + (size_t)l * 768 * 256, T, 768, 256, INWP, 256}; pg8::StaticOrder S; S.init(T, 768, nb, vb);
      pg8::EpiQ2 e{(u16*)(p.ws + WS_QM), (const float*)(p.ws + WS_SSQQ)};
      pg8::gemm_phase((PG8_LAS unsigned char*)lds, g, S, e); }
    { pg8::Gemm g{PROJ + PC_CKV, (const u16*)(p.ws + WS_WUKV) + (size_t)l * 768 * 128, T, 768, 128, INWP, 128}; pg8::StaticOrder S; S.init(T, 768, nb, nb - 1 - vb);
      pg8::EpiKV2 e{(u16*)(p.ws + WS_KM), (u16*)(p.ws + WS_VM), (const float*)(p.ws + WS_SSQKV)};
      pg8::gemm_phase((PG8_LAS unsigned char*)lds, g, S, e); }
    for (int i = vb * NTHREADS + tid; i < T * MLA_H * 4; i += nb * NTHREADS) { const int c = (i & 3) * 8, h = (i >> 2) % MLA_H, row = i / (4 * MLA_H), b = row >> 13, s = row & (SEQ - 1);
      *(u32x4*)((u16*)(p.ws + WS_KM) + ((size_t)(b * MLA_H + h) * SEQ + s) * MLA_QK + 64 + c) = *(const u32x4*)(PROJ + (size_t)row * INWP + PC_KR + c); }
    for (int it = vb; it < NMT * 6; it += nb) lru_gate_item(p, l, it / 6, it % 6, lds);
    for (int it = vb; it < NB * 64 * 2; it += nb) swa_item(p, l, it, lds);
  } break;
  case 2: {
    { const int wi = vb * 8 + wid; if (wi < 48) lru_passB(p, wi, lane); __syncthreads(); }
    for (int k = 0; k * nb + vb < NB * MLA_H * 32; ++k) {
      int pair, qb;
      if (nb == 256) { pair = k * 8 + (vb & 7); qb = vb >> 3; } else { const int it = k * nb + vb; pair = it >> 5; qb = it & 31; }
      mla_item(p, pair, qb, lds);
    }
  } break;
  case 3: {
#ifndef NO_LRUF
    if (!dry) for (int it = vb; it < NB * NLCH; it += nb) lru_final(p, it, lds);
#endif
    for (int t = vb * 8 + wid; t < T; t += nb * 8) {
      u32x4* rp = (u32x4*)(MIX + (size_t)t * DM + lane * 16);
      float v[16]; unpk8(rp[0], v); unpk8(rp[1], v + 8);
      float s = 0.f;
#pragma unroll
      for (int q = 0; q < 16; ++q) s = fmaf(v[q], v[q], s);
      const int sg = lane < 24 ? 0 : (lane < 48 ? 1 : 2);
      const float s0 = wave_sum(sg == 0 ? s : 0.f), s2 = wave_sum(sg == 2 ? s : 0.f);
      const float rs = sg == 0 ? rsqrtf(s0 * (1.f / 384.f) + EPS) : rsqrtf(s2 * (1.f / 256.f) + EPS);
      if (sg != 1) {
#pragma unroll
        for (int q = 0; q < 16; ++q) v[q] *= rs;
        rp[0] = pk8(v); rp[1] = pk8(v + 8); } }
  } break;
  case 4: {
    { pg8::Gemm g{MIX, (const u16*)(p.ws + WS_WOUT) + (size_t)l * DM * DM, T, DM, DM, DM, DM}; pg8::StaticOrder S; S.init(T, DM, nb, vb);
      pg8::EpiRes e{dry ? (u16*)(p.ws + WS_R1) : XG, (float*)(p.ws + WS_SSQ16)};
      pg8::gemm_phase((PG8_LAS unsigned char*)lds, g, S, e); }
  } break;
  case 5: {
    pg8::Gemm g{XG, (const u16*)(p.ws + WS_WQ) + (size_t)l * 2048 * DM, T, 2048, DM, DM, DM}; pg8::StaticOrder S; S.init(T, 2048, nb, vb);
    pg8::EpiPQ e{PROJ, (const float*)(p.ws + WS_SSQ16)};
    pg8::gemm_phase((PG8_LAS unsigned char*)lds, g, S, e);
  } break;
  case 6: {
    for (int it = vb; it < NMT * 8; it += nb) peer_route_item(p, l, it >> 3, it & 7, lds);
    if (!dry) peer_xn_pass(p, l, vb, nb);
  } break;
  case 7: case 9: {
    const bool last = l == DEPTH - 1;
    float* xo = dry ? (float*)(p.ws + WS_PD) : p.out;
    int s0, s1, tb, ts;
    if ((nb & 7) == 0) { s0 = vb & 7; s1 = s0 + 1; tb = (vb >> 3) * 8 + wid; ts = (nb >> 3) * 8; } else { s0 = 0; s1 = 8; tb = vb * 8 + wid; ts = nb * 8; }
#pragma unroll 1
    for (int s = s0; s < s1; ++s) { if (sp == 7) peer_slice_phase<false>(p, s, tb, ts, lane, p.out, xo, last); else peer_slice_phase<true>(p, s, tb, ts, lane, p.out, xo, last); }
  } break;
  case 8: {
    const u16* pd = (const u16*)(p.ws + WS_PD); const float* eg = (const float*)(p.ws + WS_EGATE); u16* cc = (u16*)(p.ws + WS_CC); float* cs = (float*)(p.ws + WS_CS);
    for (int t = vb * 8 + wid; t < T; t += nb * 8) {
      f32x2 a = {0.f, 0.f};
#pragma unroll
      for (int s = 0; s < 8; ++s) { const unsigned w = *(const unsigned*)(pd + ((size_t)s * T + t) * 128 + 2 * lane); a.x += bflo(w); a.y += bfhi(w); }
      const f32x2 g = *(const f32x2*)(eg + (size_t)t * 128 + 2 * lane);
      const float c0 = gelu_erf(a.x * (1.f / PEER_SU)) * g.x, c1 = gelu_erf(a.y * (1.f / PEER_SU)) * g.y;
      float mx = fmaxf(fabsf(c0), fabsf(c1));
#pragma unroll
      for (int o = 1; o < 64; o <<= 1) mx = fmaxf(mx, __shfl_xor(mx, o));
      const float st = fmaxf(mx, 1e-30f) * (1.f / 127.f), ist = 1.f / st;
      int q0 = __float2int_rn(c0 * ist), q1 = __float2int_rn(c1 * ist);
      cc[(size_t)t * 64 + lane] = (u16)(((unsigned)q0 & 255u) | (((unsigned)q1 & 255u) << 8));
      if (lane == 0) cs[t] = st * (1.f / PEER_SV);
    }
  } break;
  }
}

#define XB_TMO      128
#define XB_XCNT(j)  (256  + 64 * (j))
#define XB_XSUB(j)  (1280 + 64 * (j))
#define XB_XGEN(j)  (2304 + 64 * (j))
#define XB_TOP      3328
#define XB_TOPGEN   3392
#define XCD_BAR_WORDS 3456
#define XB_SPIN_CAP (1u << 23)
DEVI unsigned xb_ld(unsigned* p) { return __hip_atomic_load(p, __ATOMIC_RELAXED, __HIP_MEMORY_SCOPE_AGENT); }
DEVI unsigned xb_add(unsigned* p, unsigned v) { return __hip_atomic_fetch_add(p, v, __ATOMIC_RELAXED, __HIP_MEMORY_SCOPE_AGENT); }
DEVI unsigned xb_xcc_id() { return (unsigned)__builtin_amdgcn_s_getreg((3 << 11) | 20) & 0xFu; }
#define XB_SPIN(cond, bar) do { unsigned _sp = 0; while (cond) { __builtin_amdgcn_s_sleep(1); \
    if ((++_sp & 255u) == 0u) { if (xb_ld(&(bar)[XB_TMO])) break; if (_sp > XB_SPIN_CAP) { atomicAdd(&(bar)[XB_TMO], 1u); break; } } } } while (0)
struct XcdBarrier { unsigned* bar; unsigned x; volatile unsigned* st; };
DEVI XcdBarrier xcd_barrier_post(unsigned* bar, volatile unsigned* st) {
  XcdBarrier b; b.bar = bar; b.x = xb_xcc_id(); b.st = st;
  if (threadIdx.x == 0) (void)xb_add(&bar[XB_XCNT(b.x)], 1u);
  return b;
}
DEVI void xcd_barrier_complete(unsigned* bar, unsigned x, unsigned& nloc, unsigned& nx) {
  const unsigned G = gridDim.x * gridDim.y * gridDim.z;
  unsigned sum, cnt, mine, sp = 0u;
  for (;;) {
    sum = 0u; cnt = 0u; mine = 0u;
#pragma unroll
    for (unsigned j = 0; j < 16; ++j) { const unsigned c = xb_ld(&bar[XB_XCNT(j)]); sum += c; cnt += (c > 0u) ? 1u : 0u; mine = (j == x) ? c : mine; }
    if (sum == G) break;
    __builtin_amdgcn_s_sleep(1);
    if ((++sp & 255u) == 0u) { if (xb_ld(&bar[XB_TMO])) break; if (sp > XB_SPIN_CAP) { atomicAdd(&bar[XB_TMO], 1u); break; } }
  }
  nloc = mine > 0u ? mine : 1u; nx = cnt > 0u ? cnt : 1u;
}
DEVI void xcd_barrier(const XcdBarrier& b) {
  asm volatile("s_waitcnt vmcnt(0)" ::: "memory");
  __syncthreads();
  if (threadIdx.x == 0) {
    unsigned* bar = b.bar;
    __builtin_amdgcn_s_waitcnt(0);
    unsigned nloc = b.st[0], nx = b.st[1];
    if (nloc == 0u) { xcd_barrier_complete(bar, b.x, nloc, nx); b.st[0] = nloc; b.st[1] = nx; }
    const unsigned old = xb_add(&bar[XB_XSUB(b.x)], 1u);
    const unsigned gen = old / nloc;
    if (old + 1u == (gen + 1u) * nloc) {
      __builtin_amdgcn_fence(__ATOMIC_RELEASE, "agent");
      asm volatile("s_waitcnt vmcnt(0)" ::: "memory");
      const unsigned og = xb_add(&bar[XB_TOP], 1u);
      const unsigned tg = og / nx;
      if (og + 1u == (tg + 1u) * nx) xb_add(&bar[XB_TOPGEN], 1u);
      else XB_SPIN(xb_ld(&bar[XB_TOPGEN]) == tg, bar);
      __builtin_amdgcn_fence(__ATOMIC_ACQUIRE, "agent");
      xb_add(&bar[XB_XGEN(b.x)], 1u);
      asm volatile("s_waitcnt vmcnt(0)" ::: "memory");
    } else {
      XB_SPIN(xb_ld(&bar[XB_XGEN(b.x)]) == gen, bar);
      __builtin_amdgcn_fence(__ATOMIC_ACQUIRE, "agent");
      asm volatile("s_waitcnt vmcnt(0)" ::: "memory");
    }
  }
  __syncthreads();
}

__global__ void __launch_bounds__(NTHREADS, 2) mega(Params p) {
  extern __shared__ __attribute__((aligned(16))) char smem[];
  cg::grid_group grid = cg::this_grid();
  const int nb = gridDim.x, vb = blockIdx.x;
  volatile unsigned* st = (volatile unsigned*)(smem + LDS_BYTES - 16);
  if (threadIdx.x == 0) { st[0] = 0u; st[1] = 0u; }
  __syncthreads();
  const XcdBarrier bar = xcd_barrier_post((unsigned*)p.ws, st);
#define GRID_BAR(first) do { if (first) grid.sync(); else xcd_barrier(bar); } while (0)
  for (int ph = p.ph_lo; ph < p.ph_hi; ++ph) {
#ifdef PROBE_DUP
    if (ph > 0 && ph < N_PHASES - 1 && ((PROBE_DUP >> ((ph - 1) % PH_PER_LAYER)) & 1)) { run_phase(p, ph + 100, vb, nb, smem); GRID_BAR(false); }
#endif
    run_phase(p, ph, vb, nb, smem);
    if (ph + 1 < p.ph_hi) GRID_BAR(ph == p.ph_lo);
  }
}

#ifndef N_LAUNCH_SPLIT
#define N_LAUNCH_SPLIT 0
#endif
extern "C" void kernel_launch(void* const* d_in, const int* in_sizes, int n_in, void* d_out, int out_size, void* d_ws, size_t ws_size, hipStream_t stream) {
  static int grid_blocks = 0;
  if (grid_blocks == 0) {
    if (n_in != 24 || out_size != T * DM || ws_size < WS_NEED) { fprintf(stderr, "kernel_launch: unexpected shapes n_in %d out %d ws %zu\n", n_in, out_size, ws_size); grid_blocks = -1; return; }
    int dev = 0, cus = 0, per_cu = 0;
    (void)hipGetDevice(&dev); (void)hipDeviceGetAttribute(&cus, hipDeviceAttributeMultiprocessorCount, dev);
    if (hipFuncSetAttribute((const void*)mega, hipFuncAttributeMaxDynamicSharedMemorySize, LDS_BYTES) != hipSuccess) { fprintf(stderr, "kernel_launch: hipFuncSetAttribute failed\n"); grid_blocks = -1; return; }
    if (hipOccupancyMaxActiveBlocksPerMultiprocessor(&per_cu, (const void*)mega, NTHREADS, LDS_BYTES) != hipSuccess || per_cu < 1) { fprintf(stderr, "kernel_launch: occupancy query failed (%d)\n", per_cu); grid_blocks = -1; return; }
    grid_blocks = cus * 1;
    fprintf(stderr, "kernel_launch: cus %d per_cu %d grid %d\n", cus, per_cu, grid_blocks);
  }
  if (grid_blocks < 0) return;
  if (hipMemsetAsync(d_ws, 0, 65536, stream) != hipSuccess) { fprintf(stderr, "kernel_launch: memset failed\n"); return; }
  Params p{};
  p.x = (const float*)d_in[0]; p.pos = (const int*)d_in[1]; p.norm_mix = (const float*)d_in[2]; p.w_in = (const float*)d_in[3]; p.q_norm = (const float*)d_in[4];
  p.w_uq = (const float*)d_in[5]; p.kv_norm = (const float*)d_in[6]; p.w_ukv = (const float*)d_in[7]; p.conv_w = (const float*)d_in[8]; p.conv_b = (const float*)d_in[9];
  p.lru_wa = (const float*)d_in[10]; p.lru_ba = (const float*)d_in[11]; p.lru_wx = (const float*)d_in[12]; p.lru_bx = (const float*)d_in[13]; p.lru_lambda = (const float*)d_in[14];
  p.swa_sink = (const float*)d_in[15]; p.grp_norm = (const float*)d_in[16]; p.w_out = (const float*)d_in[17]; p.norm_ffn = (const float*)d_in[18]; p.peer_wq = (const float*)d_in[19];
  p.peer_subkeys = (const float*)d_in[20]; p.peer_u = (const float*)d_in[21]; p.peer_v = (const float*)d_in[22]; p.norm_final = (const float*)d_in[23];
  p.out = (float*)d_out; p.ws = (unsigned char*)d_ws;
#if N_LAUNCH_SPLIT
  for (int ph = 0; ph < N_PHASES; ++ph) {
    p.ph_lo = ph; p.ph_hi = ph + 1;
    void* args[] = {&p};
    hipError_t e = hipLaunchCooperativeKernel((const void*)mega, dim3(grid_blocks), dim3(NTHREADS), args, LDS_BYTES, stream);
    if (e != hipSuccess) { fprintf(stderr, "kernel_launch: launch of phase %d failed: %s\n", ph, hipGetErrorString(e)); break; }
  }
#else
  p.ph_lo = 0; p.ph_hi = N_PHASES;
  void* args[] = {&p};
  hipError_t e = hipLaunchCooperativeKernel((const void*)mega, dim3(grid_blocks), dim3(NTHREADS), args, LDS_BYTES, stream);
  if (e != hipSuccess) fprintf(stderr, "kernel_launch: cooperative launch failed: %s (grid %d)\n", hipGetErrorString(e), grid_blocks);
#endif
}
```

```cpp
#include <hip/hip_runtime.h>
#include <hip/hip_cooperative_groups.h>
#include <cstdio>
#include <cstdint>
namespace cg = cooperative_groups;

#define DEVI __device__ __forceinline__
typedef unsigned short u16;
typedef short bf16x8 __attribute__((ext_vector_type(8)));
typedef short s16x4 __attribute__((ext_vector_type(4)));
typedef float f32x2 __attribute__((ext_vector_type(2)));
typedef float f32x4 __attribute__((ext_vector_type(4)));
typedef float f32x16 __attribute__((ext_vector_type(16)));
typedef unsigned u32x4 __attribute__((ext_vector_type(4)));
typedef unsigned u32x2 __attribute__((ext_vector_type(2)));
typedef __bf16 bf16x2_t __attribute__((ext_vector_type(2)));

constexpr int NB = 4, SEQ = 8192, T = NB * SEQ, DM = 1024, DEPTH = 2;
constexpr int MLA_H = 6, MLA_QK = 96, MLA_V = 64;
constexpr int LRU_W = 384;
constexpr int INW = 1696, INWP = 1792;
constexpr int PC_CQ = 0, PC_CKV = 256, PC_SQ = 384, PC_SK = 640, PC_SV = 768, PC_LX = 896, PC_LG = 1280, PC_KR = 1664;
constexpr int OC_CQ = 0, OC_CKV = 256, OC_KR = 384, OC_SQ = 416, OC_SK = 672, OC_SV = 800, OC_LX = 928, OC_LG = 1312;
constexpr int NEXP = 16384;
constexpr float EPS = 1e-6f;
constexpr int NTHREADS = 512;
constexpr int LDS_BYTES = 160 * 1024;

constexpr size_t MiB = 1u << 20;
constexpr size_t WS_CTL = 0;
constexpr size_t WS_WIN = 4 * MiB;
constexpr size_t WS_WQ = 11 * MiB;
constexpr size_t WS_WOUT = 19 * MiB;
constexpr size_t WS_WUQ = 23 * MiB;
constexpr size_t WS_WUKV = WS_WUQ + 2 * 768 * 256 * 2;
constexpr size_t WS_WLRU = WS_WUKV + 2 * 768 * 128 * 2;
constexpr size_t WS_SUBK = WS_WLRU + 2 * 6 * 2 * 128 * 64 * 2;
constexpr size_t WS_XG = 25 * MiB;
constexpr size_t WS_R1 = 89 * MiB;
constexpr size_t WS_QM = 217 * MiB;
constexpr size_t WS_KM = 253 * MiB;
constexpr size_t WS_VM = 289 * MiB;
constexpr size_t WS_LE = 313 * MiB;
constexpr size_t WS_LB = 361 * MiB;
constexpr size_t WS_MIX = 409 * MiB;
constexpr size_t WS_UB = 478 * MiB;
constexpr size_t WS_VB = 494 * MiB;
constexpr size_t WS_TOP = 281 * MiB;
constexpr size_t WS_EIDX = 313 * MiB;
constexpr size_t WS_EGATE = 329 * MiB;
constexpr size_t WS_CC = 345 * MiB;
constexpr size_t WS_SSQ = 361 * MiB;
constexpr size_t WS_SSQ16 = 363 * MiB;
constexpr size_t WS_SSQQ = 476 * MiB;
constexpr size_t WS_SSQKV = 477 * MiB;
constexpr size_t WS_PD = 89 * MiB;
constexpr float PEER_SU = 903.f, PEER_SV = 56.f;
constexpr size_t WS_CS = 349 * MiB;
constexpr size_t WS_XQ = 249 * MiB;
constexpr size_t WS_SX = 281 * MiB;
constexpr size_t WS_END = 473 * MiB;

__device__ const float ROPE_HI[32] = {1.591549367e-01f, 1.193493679e-01f, 8.949939907e-02f, 6.711508334e-02f, 5.032921210e-02f, 3.774158657e-02f, 2.830219641e-02f, 2.122365311e-02f, 1.591549441e-02f, 1.193493698e-02f, 8.949940093e-03f, 6.711508147e-03f, 5.032921210e-03f, 3.774158424e-03f, 2.830219688e-03f, 2.122365171e-03f, 1.591549488e-03f, 1.193493721e-03f, 8.949940093e-04f, 6.711508031e-04f, 5.032921326e-04f, 3.774158540e-04f, 2.830219455e-04f, 2.122365258e-04f, 1.591549371e-04f, 1.193493736e-04f, 8.949940093e-05f, 6.711508468e-05f, 5.032921035e-05f, 3.774158540e-05f, 2.830219637e-05f, 2.122365186e-05f};
__device__ const float ROPE_LO[32] = {6.420638243e-09f, 2.294664903e-09f, 2.542919653e-09f, -3.316028840e-10f, 5.173299289e-12f, -1.848551645e-09f, -5.826552019e-10f, -3.431038786e-10f, -1.029942243e-10f, 4.320196978e-11f, 6.802744479e-11f, 1.531042237e-10f, 5.173301024e-13f, 4.797548470e-11f, -1.048316434e-10f, 1.053879969e-10f, -5.686555046e-11f, -1.896286773e-11f, 6.802744999e-12f, 2.695195456e-11f, -1.158979943e-11f, -6.843983713e-12f, 1.279990003e-11f, 1.807650600e-12f, 5.954976963e-12f, -3.351478166e-12f, 6.802744674e-13f, -1.670379113e-12f, 1.751403167e-12f, -6.843983930e-13f, -5.389994549e-13f, 9.083608431e-13f};

DEVI int tidx() { int t = __builtin_amdgcn_workitem_id_x(); asm volatile("" : "+v"(t)); return t; }
DEVI float bf2f(unsigned h) { return __uint_as_float(h << 16); }
DEVI float bflo(unsigned w) { return __uint_as_float(w << 16); }
DEVI float bfhi(unsigned w) { return __uint_as_float(w & 0xffff0000u); }
DEVI unsigned pk2(float lo, float hi) { f32x2 v = {lo, hi}; bf16x2_t b = __builtin_convertvector(v, bf16x2_t); return __builtin_bit_cast(unsigned, b); }
DEVI u16 f2bf(float f) { return (u16)(pk2(f, 0.f) & 0xffffu); }
DEVI u32x4 pk8(const float* v) { u32x4 w; w.x = pk2(v[0], v[1]); w.y = pk2(v[2], v[3]); w.z = pk2(v[4], v[5]); w.w = pk2(v[6], v[7]); return w; }
DEVI void unpk8(u32x4 w, float* v) { v[0] = bflo(w.x); v[1] = bfhi(w.x); v[2] = bflo(w.y); v[3] = bfhi(w.y); v[4] = bflo(w.z); v[5] = bfhi(w.z); v[6] = bflo(w.w); v[7] = bfhi(w.w); }
DEVI void ld8(const float* p, float* v) { const f32x4 a = *(const f32x4*)p, b = *(const f32x4*)(p + 4); v[0] = a.x; v[1] = a.y; v[2] = a.z; v[3] = a.w; v[4] = b.x; v[5] = b.y; v[6] = b.z; v[7] = b.w; }
DEVI int crow(int r, int hi) { return (r & 3) + 8 * (r >> 2) + 4 * hi; }
template <int CTRL> DEVI float dppx(float v) { return __uint_as_float((unsigned)__builtin_amdgcn_mov_dpp((int)__float_as_uint(v), CTRL, 0xF, 0xF, true)); }
DEVI float wave_sum(float v) {
  v += dppx<0xB1>(v); v += dppx<0x4E>(v); v += dppx<0x141>(v); v += dppx<0x140>(v);
  { auto r = __builtin_amdgcn_permlane16_swap(__float_as_uint(v), __float_as_uint(v), false, false); v = __uint_as_float(r[0]) + __uint_as_float(r[1]); }
  { auto r = __builtin_amdgcn_permlane32_swap(__float_as_uint(v), __float_as_uint(v), false, false); v = __uint_as_float(r[0]) + __uint_as_float(r[1]); }
  return v;
}
DEVI float wave_max(float v) {
  v = fmaxf(v, dppx<0xB1>(v)); v = fmaxf(v, dppx<0x4E>(v)); v = fmaxf(v, dppx<0x141>(v)); v = fmaxf(v, dppx<0x140>(v));
  { auto r = __builtin_amdgcn_permlane16_swap(__float_as_uint(v), __float_as_uint(v), false, false); v = fmaxf(__uint_as_float(r[0]), __uint_as_float(r[1])); }
  { auto r = __builtin_amdgcn_permlane32_swap(__float_as_uint(v), __float_as_uint(v), false, false); v = fmaxf(__uint_as_float(r[0]), __uint_as_float(r[1])); }
  return v;
}
DEVI void rope_sc(float pos, int fidx, float& sn, float& cs) {
  const float chi = ROPE_HI[fidx], clo = ROPE_LO[fidx];
  const float t = pos * chi, e = fmaf(pos, chi, -t);
  float fr = t - rintf(t);
  fr = fr + (e + pos * clo);
  sn = __builtin_amdgcn_sinf(fr); cs = __builtin_amdgcn_cosf(fr);
}
DEVI float sigmoidf_(float x) { return 1.f / (1.f + __expf(-x)); }
DEVI void stwt16(void* p, u32x4 v) { __builtin_nontemporal_store(v, (u32x4*)p); }
DEVI void stwt8(void* p, u32x2 v) { asm volatile("global_store_dwordx2 %0, %1, off sc1\n\ts_nop 1" :: "v"(p), "v"(v) : "memory"); }
DEVI void stwt4(void* p, unsigned v) { asm volatile("global_store_dword %0, %1, off sc1\n\ts_nop 1" :: "v"(p), "v"(v) : "memory"); }
DEVI void stwt16n(void* p, u32x4 v) { asm volatile("global_store_dwordx4 %0, %1, off sc1\n\ts_nop 1" :: "v"(p), "v"(v)); }
DEVI void stwt8n(void* p, u32x2 v) { asm volatile("global_store_dwordx2 %0, %1, off sc1\n\ts_nop 1" :: "v"(p), "v"(v)); }
DEVI int dot4_0(unsigned a, int b) { int r; asm("v_dot4_i32_i8 %0, %1, %2, 0" : "=v"(r) : "v"(a), "v"(b)); return r; }
DEVI float gelu_erf(float v) {
  const float av = fabsf(v), t = __builtin_amdgcn_rcpf(fmaf(av, 0.2316418882f, 1.0f));
  float q = fmaf(t, 0.5307027145f, -0.7265760135f); q = fmaf(q, t, 0.7107068705f); q = fmaf(q, t, -0.142248368f); q = fmaf(q, t, 0.127414796f); q = q * t;
  const float e = __builtin_amdgcn_exp2f((v * v) * -0.72134752044f);
  const float m = v * (q * e);
  return v < 0.f ? m : v - m;
}

struct Params {
  const float* x; const int* pos; const float* norm_mix; const float* w_in; const float* q_norm; const float* w_uq; const float* kv_norm; const float* w_ukv;
  const float* conv_w; const float* conv_b; const float* lru_wa; const float* lru_ba; const float* lru_wx; const float* lru_bx; const float* lru_lambda;
  const float* swa_sink; const float* grp_norm; const float* w_out; const float* norm_ffn; const float* peer_wq; const float* peer_subkeys;
  const float* peer_u; const float* peer_v; const float* norm_final;
  float* out; unsigned char* ws;
  int ph_lo, ph_hi;
};

DEVI void tconv_item(const float* W, int ldw, int src_c0, u16* WT, int K, int dst_r0, const float* gain, float* scr, int kb, int nb, int lane, int pg = 0) {
  const int k0 = 64 * kb, n0 = 32 * nb;
#pragma unroll 8
  for (int i = 0; i < 32; ++i) { const int kk = 2 * i + (lane >> 5); float g = gain ? gain[k0 + kk] : 1.f; scr[kk * 33 + (lane & 31)] = g * W[(size_t)(k0 + kk) * ldw + src_c0 + n0 + (lane & 31)]; }
  __builtin_amdgcn_s_waitcnt(0xc07f); asm volatile("" ::: "memory");
  const int c = lane & 7;
#pragma unroll
  for (int j = 0; j < 4; ++j) { const int n = (lane >> 3) + 8 * j; const float* s = scr + (8 * c) * 33 + n;
    u32x4 o; o.x = pk2(s[0 * 33], s[1 * 33]); o.y = pk2(s[2 * 33], s[3 * 33]); o.z = pk2(s[4 * 33], s[5 * 33]); o.w = pk2(s[6 * 33], s[7 * 33]);
    int nn = n0 + n; if (pg > 0) { const int g = nn & ~(pg - 1), i = nn & (pg - 1), hw = pg >> 1; nn = g + (i < hw ? 2 * i : 2 * (i - hw) + 1); }
    else if (pg < 0) { const int j = nn % 96; if (j >= 64) { const int i = j - 64; nn = nn - i + (i < 16 ? 2 * i : 2 * (i - 16) + 1); } }
    *(u32x4*)(WT + (size_t)(dst_r0 + nn) * K + k0 + 8 * c) = o; }
  __builtin_amdgcn_s_waitcnt(0xc07f); asm volatile("" ::: "memory");
}

DEVI void p0_item(const Params& p, int it, float* scr, int lane) {
  const int l = it / 2552; int r = it - l * 2552;
  const float* win = p.w_in + (size_t)l * DM * INW; u16* wint = (u16*)(p.ws + WS_WIN) + (size_t)l * INWP * DM; const float* gm = p.norm_mix + l * DM;
#define SEG(W, ldw, sc0, ncols, WT, K, dr0, gain, pg) { const int nnb_ = (ncols) / 32, ni_ = ((K) / 64) * nnb_; if (r < ni_) { tconv_item(W, ldw, sc0, WT, K, dr0, gain, scr, r / nnb_, r % nnb_, lane, pg); return; } r -= ni_; }
  SEG(win, INW, OC_CQ, 256, wint, DM, PC_CQ, gm, 0)
  SEG(win, INW, OC_CKV, 128, wint, DM, PC_CKV, gm, 0)
  SEG(win, INW, OC_SQ, 256, wint, DM, PC_SQ, gm, 64)
  SEG(win, INW, OC_SK, 128, wint, DM, PC_SK, gm, 64)
  SEG(win, INW, OC_SV, 128, wint, DM, PC_SV, gm, 0)
  SEG(win, INW, OC_LX, 384, wint, DM, PC_LX, gm, 0)
  SEG(win, INW, OC_LG, 384, wint, DM, PC_LG, gm, 0)
  SEG(win, INW, OC_KR, 32, wint, DM, PC_KR, gm, 32)
  SEG(p.peer_wq + (size_t)l * DM * 2048, 2048, 0, 2048, (u16*)(p.ws + WS_WQ) + (size_t)l * 2048 * DM, DM, 0, p.norm_ffn + l * DM, 0)
  SEG(p.w_out + (size_t)l * DM * DM, DM, 0, DM, (u16*)(p.ws + WS_WOUT) + (size_t)l * DM * DM, DM, 0, p.grp_norm + l * DM, 0)
  SEG(p.w_uq + (size_t)l * 256 * 576, 576, 0, 576, (u16*)(p.ws + WS_WUQ) + (size_t)l * 768 * 256, 256, 0, p.q_norm + l * 256, -1)
  SEG(p.w_ukv + (size_t)l * 128 * 768, 768, 0, 768, (u16*)(p.ws + WS_WUKV) + (size_t)l * 768 * 128, 128, 0, p.kv_norm + l * 128, 0)
#undef SEG
  { const int nbk = r & 1, ax = (r >> 1) & 1, n = (r >> 2) % 6, d = (r >> 2) / 6;
    const float* W = (ax ? p.lru_wx : p.lru_wa) + ((size_t)(l * 2 + d) * 6 + n) * 4096;
    u16* WT = (u16*)(p.ws + WS_WLRU) + ((size_t)((l * 6 + n) * 2 + d)) * 128 * 64;
    tconv_item(W, 64, 0, WT, 64, 32 * nbk + 32 * ax, nullptr, scr, 0, nbk, lane); }
}

DEVI void phase0(const Params& p, int vb, int nb, char* lds) {
  const int tid = tidx(), lane = tid & 63, wid = tid >> 6;
  float* scr = (float*)(lds + wid * 16384);
  const int gw = vb * 8 + wid, ngw = nb * 8;
  for (int it = gw; it < DEPTH * 2552; it += ngw) p0_item(p, it, scr, lane);
  for (int i = vb * NTHREADS + tid; i < DEPTH * 96 * DM / 8; i += nb * NTHREADS) { const int l = i / (96 * DM / 8), r = i % (96 * DM / 8);
    *(u32x4*)((u16*)(p.ws + WS_WIN) + ((size_t)l * INWP + INW) * DM + (size_t)r * 8) = (u32x4){0, 0, 0, 0}; }
  for (int i = vb * NTHREADS + tid; i < DEPTH * 192 * 256 / 8; i += nb * NTHREADS) { const int l = i / (192 * 256 / 8), r = i % (192 * 256 / 8);
    *(u32x4*)((u16*)(p.ws + WS_WUQ) + ((size_t)l * 768 + 576) * 256 + (size_t)r * 8) = (u32x4){0, 0, 0, 0}; }
  for (int i = vb * NTHREADS + tid; i < DEPTH * 2 * 128 * 128 / 8; i += nb * NTHREADS) {
    float a[8]; ld8(p.peer_subkeys + (size_t)i * 8, a);
    *(u32x4*)((u16*)(p.ws + WS_SUBK) + (size_t)i * 8) = pk8(a); }
  { float* ssq = (float*)(p.ws + WS_SSQ); u16* xg = (u16*)(p.ws + WS_XG);
    for (int t = gw * 2; t < T; t += ngw * 2) {
      float a[2][16];
#pragma unroll
      for (int u = 0; u < 2; ++u) { ld8(p.x + (size_t)(t + u) * DM + lane * 16, a[u]); ld8(p.x + (size_t)(t + u) * DM + lane * 16 + 8, a[u] + 8); }
#pragma unroll
      for (int u = 0; u < 2; ++u) { float s = 0.f;
#pragma unroll
        for (int q = 0; q < 16; ++q) s = fmaf(a[u][q], a[u][q], s);
        s += __shfl_xor(s, 1); s += __shfl_xor(s, 2); s += __shfl_xor(s, 4);
        if ((lane & 7) == 0) ssq[(size_t)(t + u) * 8 + (lane >> 3)] = s;
        u32x4* o = (u32x4*)(xg + (size_t)(t + u) * DM + lane * 16); o[0] = pk8(a[u]); o[1] = pk8(a[u] + 8); } } }
}

DEVI int swz(int row, int c) { return row * 128 + ((c ^ ((row >> 1) & 7)) << 4); }
constexpr int CLD = 132;
constexpr int LDS_RS = 135168;

struct GemmDesc {
  const u16* A; int lda; const u16* Bt; int ldb; int KT;
  float inv0;
  const u16* proj; const float* cw; const float* cb; int ch0;
};

template <int AMODE> DEVI bf16x8 load_a(const GemmDesc& g, int row, int kcol) {
  if constexpr (AMODE == 0) {
    return *(const bf16x8*)(g.A + (size_t)row * g.lda + kcol);
  } else {
    const int s = row & (SEQ - 1), ch = g.ch0 + kcol;
    float a[8];
    { const f32x4 b0 = *(const f32x4*)(g.cb + ch), b1 = *(const f32x4*)(g.cb + ch + 4); a[0] = b0.x; a[1] = b0.y; a[2] = b0.z; a[3] = b0.w; a[4] = b1.x; a[5] = b1.y; a[6] = b1.z; a[7] = b1.w; }
    u32x4 xv[4];
#pragma unroll
    for (int tap = 0; tap < 4; ++tap) { const int ss = s - 1 + tap; const int rr = ((unsigned)ss < (unsigned)SEQ) ? row - 1 + tap : row;
      xv[tap] = *(const u32x4*)(g.proj + (size_t)rr * INWP + PC_LX + ch); }
#pragma unroll
    for (int tap = 0; tap < 4; ++tap) { const int ss = s - 1 + tap; const float m = ((unsigned)ss < (unsigned)SEQ) ? 1.f : 0.f;
      float x[8]; unpk8(xv[tap], x);
      const f32x4 w0 = *(const f32x4*)(g.cw + tap * LRU_W + ch) * m, w1 = *(const f32x4*)(g.cw + tap * LRU_W + ch + 4) * m;
      a[0] += w0.x * x[0]; a[1] += w0.y * x[1]; a[2] += w0.z * x[2]; a[3] += w0.w * x[3];
      a[4] += w1.x * x[4]; a[5] += w1.y * x[5]; a[6] += w1.z * x[6]; a[7] += w1.w * x[7]; }
    const u32x4 o = pk8(a);
    return __builtin_bit_cast(bf16x8, o);
  }
}

template <int AMODE> DEVI void g_load(const GemmDesc& g, bf16x8 (&ar)[4], bf16x8 (&br)[2], int m0, int n0, int srow, int sc, int kt) {
#pragma unroll
  for (int i = 0; i < 4; ++i) ar[i] = load_a<AMODE>(g, m0 + srow + 64 * i, kt * 64 + sc * 8);
#pragma unroll
  for (int i = 0; i < 2; ++i) br[i] = *(const bf16x8*)(g.Bt + (size_t)(n0 + srow + 64 * i) * g.ldb + kt * 64 + sc * 8);
}
template <bool NORM> DEVI void g_write(char* Ab, const bf16x8 (&ar)[4], const bf16x8 (&br)[2], float (&ssq)[4], int srow, int sc) {
  char* Bb = Ab + 32768;
#pragma unroll
  for (int i = 0; i < 4; ++i) { *(bf16x8*)(Ab + swz(srow + 64 * i, sc)) = ar[i];
    if (NORM) { float x[8]; unpk8(__builtin_bit_cast(u32x4, ar[i]), x); float s = ssq[i];
#pragma unroll
      for (int q = 0; q < 8; ++q) s = fmaf(x[q], x[q], s);
      ssq[i] = s; } }
#pragma unroll
  for (int i = 0; i < 2; ++i) *(bf16x8*)(Bb + swz(srow + 64 * i, sc)) = br[i];
}

template <int AMODE, int SEG>
DEVI void gemm_core(const GemmDesc& g, int m0, int n0, char* lds) {
  const int tid = tidx(), lane = tid & 63, wid = tid >> 6;
  const int wm = wid >> 1, wn = wid & 1, r32 = lane & 31, hi = lane >> 5;
  const int srow = tid >> 3, sc = tid & 7;
  constexpr bool NORM = SEG != 0;
  float* rs = (float*)(lds + LDS_RS);
  f32x16 acc[2][2], acc2[2][2];
#pragma unroll
  for (int i = 0; i < 2; ++i)
#pragma unroll
    for (int j = 0; j < 2; ++j) { acc[i][j] = f32x16{}; acc2[i][j] = f32x16{}; }
  float ssq[4] = {0.f, 0.f, 0.f, 0.f};
  bf16x8 ar[4], br[2];
  g_load<AMODE>(g, ar, br, m0, n0, srow, sc, 0); g_write<NORM>(lds, ar, br, ssq, srow, sc); __syncthreads();
  int seg = 0;
#pragma unroll 1
  for (int kt = 0; kt < g.KT; ++kt) {
    const int cur = kt & 1;
    if (kt + 1 < g.KT) g_load<AMODE>(g, ar, br, m0, n0, srow, sc, kt + 1);
    { const char* Ab = lds + cur * 49152; const char* Bb = Ab + 32768;
#pragma unroll
      for (int k16 = 0; k16 < 4; ++k16) {
        bf16x8 a[2], b[2];
#pragma unroll
        for (int mt = 0; mt < 2; ++mt) a[mt] = *(const bf16x8*)(Ab + swz(wm * 64 + mt * 32 + r32, k16 * 2 + hi));
#pragma unroll
        for (int nt = 0; nt < 2; ++nt) b[nt] = *(const bf16x8*)(Bb + swz(wn * 64 + nt * 32 + r32, k16 * 2 + hi));
#pragma unroll
        for (int mt = 0; mt < 2; ++mt)
#pragma unroll
          for (int nt = 0; nt < 2; ++nt) {
            if (NORM) acc2[mt][nt] = __builtin_amdgcn_mfma_f32_32x32x16_bf16(a[mt], b[nt], acc2[mt][nt], 0, 0, 0);
            else acc[mt][nt] = __builtin_amdgcn_mfma_f32_32x32x16_bf16(a[mt], b[nt], acc[mt][nt], 0, 0, 0);
          }
      } }
    if (NORM) {
      int se; float inv;
      if (SEG == 1) { se = g.KT; inv = g.inv0; }
      else { se = seg == 0 ? 6 : (seg == 1 ? 12 : 16); inv = seg == 2 ? (1.f / 256.f) : (1.f / 384.f); }
      if (kt + 1 == se) {
#pragma unroll
        for (int i = 0; i < 4; ++i) { float s = ssq[i]; s += __shfl_xor(s, 1); s += __shfl_xor(s, 2); s += __shfl_xor(s, 4); if (sc == 0) rs[srow + 64 * i] = rsqrtf(s * inv + EPS); }
        __syncthreads();
#pragma unroll
        for (int mt = 0; mt < 2; ++mt)
#pragma unroll
          for (int r = 0; r < 16; ++r) { const float f = rs[wm * 64 + mt * 32 + crow(r, hi)];
#pragma unroll
            for (int nt = 0; nt < 2; ++nt) { acc[mt][nt][r] = fmaf(f, acc2[mt][nt][r], acc[mt][nt][r]); acc2[mt][nt][r] = 0.f; } }
        ssq[0] = ssq[1] = ssq[2] = ssq[3] = 0.f;
        ++seg;
      }
    }
    if (kt + 1 < g.KT) g_write<NORM>(lds + (cur ^ 1) * 49152, ar, br, ssq, srow, sc);
    __syncthreads();
  }
  float* C = (float*)lds;
#pragma unroll
  for (int mt = 0; mt < 2; ++mt)
#pragma unroll
    for (int nt = 0; nt < 2; ++nt)
#pragma unroll
      for (int r = 0; r < 16; ++r) C[(wm * 64 + mt * 32 + crow(r, hi)) * CLD + wn * 64 + nt * 32 + r32] = acc[mt][nt][r];
  __syncthreads();
}
template <int AMODE, int SEG, class Epi>
DEVI void gemm_tile(const GemmDesc& g, int m0, int n0, char* lds, const Epi& epi) {
  gemm_core<AMODE, SEG>(g, m0, n0, lds);
  epi((const float*)lds, m0, n0);
  __syncthreads();
}

DEVI GemmDesc gemm_desc(const u16* A, int lda, const u16* Bt, int ldb, int K) {
  GemmDesc g{}; g.A = A; g.lda = lda; g.Bt = Bt; g.ldb = ldb; g.KT = K / 64; g.inv0 = 1.f / (float)K; return g;
}


template <int HW> DEVI void rope8(float* v, const float* pp, int i0, float posf) {
  const bool first = i0 < HW; const int f0 = i0 & (HW - 1);
#pragma unroll
  for (int j = 0; j < 8; ++j) { float sn, cs; rope_sc(posf, HW == 32 ? (f0 + j) : 2 * (f0 + j), sn, cs); const float pv = pp[j]; v[j] = first ? v[j] * cs - pv * sn : v[j] * cs + pv * sn; }
}

struct EpiP1 { u16* proj; const int* pos;
  DEVI void operator()(const float* C, int m0, int n0) const {
    const int tid = tidx();
#pragma unroll 1
    for (int it = 0; it < 8; ++it) { const int item = it * NTHREADS + tid, row = item >> 4, c8 = (item & 15) * 8, gcol = n0 + c8, grow = m0 + row;
      float v[8]; ld8(C + row * CLD + c8, v);
      const bool r64 = gcol >= PC_SQ && gcol < PC_SV, r32g = gcol >= PC_KR && gcol < PC_KR + 32;
      if (r64) { const int i0 = gcol & 63; float pp[8]; ld8(C + row * CLD + c8 + (i0 < 32 ? 32 : -32), pp); rope8<32>(v, pp, i0, (float)pos[grow]); }
      else if (r32g) { const int i0 = gcol & 31; float pp[8]; ld8(C + row * CLD + c8 + (i0 < 16 ? 16 : -16), pp); rope8<16>(v, pp, i0, (float)pos[grow]); }
      *(u32x4*)(proj + (size_t)grow * INWP + gcol) = pk8(v);
    }
  }
};

struct EpiQ { u16* qm; const int* pos;
  DEVI void operator()(const float* C, int m0, int n0) const {
    const int tid = tidx();
#pragma unroll 1
    for (int it = 0; it < 8; ++it) { const int item = it * NTHREADS + tid, row = item >> 4, c8 = (item & 15) * 8, gcol = n0 + c8, grow = m0 + row;
      if (gcol >= 576) continue;
      const int head = gcol / 96, j0 = gcol - head * 96, b = grow >> 13, s = grow & (SEQ - 1);
      float v[8]; ld8(C + row * CLD + c8, v);
      u16* qrow = qm + ((size_t)(b * MLA_H + head) * SEQ + s) * MLA_QK;
      if (j0 >= 64) { const int i0 = j0 - 64; float pp[8]; ld8(C + row * CLD + c8 + (i0 < 16 ? 16 : -16), pp); rope8<16>(v, pp, i0, (float)pos[grow]);
#pragma unroll
        for (int j = 0; j < 8; ++j) { const int i = i0 + j; qrow[64 + (i < 16 ? 2 * i : 2 * (i - 16) + 1)] = f2bf(v[j]); } }
      else *(u32x4*)(qrow + j0) = pk8(v);
    }
  }
};

struct EpiKV { u16* km; u16* vm; const u16* proj;
  DEVI void operator()(const float* C, int m0, int n0) const {
    const int tid = tidx(), head = n0 >> 7;
#pragma unroll 1
    for (int it = 0; it < 8; ++it) { const int item = it * NTHREADS + tid, row = item >> 4, c8 = (item & 15) * 8, grow = m0 + row;
      const int b = grow >> 13, s = grow & (SEQ - 1);
      float v[8]; ld8(C + row * CLD + c8, v);
      const size_t tok = (size_t)(b * MLA_H + head) * SEQ + s;
      if (c8 < 64) *(u32x4*)(km + tok * MLA_QK + c8) = pk8(v);
      else *(u32x4*)(vm + tok * MLA_V + (c8 - 64)) = pk8(v);
    }
#pragma unroll 1
    for (int it = 0; it < 2; ++it) { const int item = it * NTHREADS + tid, row = item >> 2, c = (item & 3) * 8, grow = m0 + row;
      const int b = grow >> 13, s = grow & (SEQ - 1);
      *(u32x4*)(km + ((size_t)(b * MLA_H + head) * SEQ + s) * MLA_QK + 64 + c) = *(const u32x4*)(proj + (size_t)grow * INWP + PC_KR + c);
    }
  }
};

struct EpiLRU { const u16* proj; const float* cw; const float* cb; const float* ba; const float* bx; const float* lam; u16* le; u16* lb; int n, d;
  DEVI void operator()(const float* C, int m0, int) const {
    const int tid = tidx();
#pragma unroll 1
    for (int it = 0; it < 4; ++it) { const int item = it * NTHREADS + tid, j = item & 63, g8 = item >> 6;
      const int ch = n * 64 + j, grow0 = m0 + g8 * 8, s0 = grow0 & (SEQ - 1), b = grow0 >> 13;
      const float bav = ba[(d * 6 + n) * 64 + j], bxv = bx[(d * 6 + n) * 64 + j];
      const float cdec = -8.f * log1pf(__expf(-lam[d * LRU_W + ch]));
      float xin[11];
#pragma unroll
      for (int q = 0; q < 11; ++q) { const int ss = s0 - 1 + q; xin[q] = (ss >= 0 && ss < SEQ) ? bf2f(proj[(size_t)(grow0 - 1 + q) * INWP + PC_LX + ch]) : 0.f; }
      const float w0 = cw[ch], w1 = cw[LRU_W + ch], w2 = cw[2 * LRU_W + ch], w3 = cw[3 * LRU_W + ch], cbv = cb[ch];
      float ev[8], bv[8];
#pragma unroll
      for (int rr = 0; rr < 8; ++rr) {
        const float xf = cbv + w0 * xin[rr] + w1 * xin[rr + 1] + w2 * xin[rr + 2] + w3 * xin[rr + 3];
        const float r = sigmoidf_(C[(g8 * 8 + rr) * CLD + j] + bav), ig = sigmoidf_(C[(g8 * 8 + rr) * CLD + 64 + j] + bxv);
        const float a = __expf(cdec * r), e = 1.f - a;
        ev[rr] = e; bv[rr] = sqrtf(e * (2.f - e)) * ig * xf;
      }
      const size_t o = (((size_t)(d * NB + b) * (SEQ / 8) + (s0 >> 3)) * LRU_W + ch) * 8;
      *(u32x4*)(le + o) = pk8(ev); *(u32x4*)(lb + o) = pk8(bv);
    }
  }
};

struct EpiP4 { const float* xres; float* xout; u16* xg;
  DEVI void operator()(const float* C, int m0, int n0) const {
    const int tid = tidx();
#pragma unroll 1
    for (int it = 0; it < 8; ++it) { const int item = it * NTHREADS + tid, row = item >> 4, c8 = (item & 15) * 8, gcol = n0 + c8, grow = m0 + row;
      float v[8], x[8]; ld8(C + row * CLD + c8, v); ld8(xres + (size_t)grow * DM + gcol, x);
#pragma unroll
      for (int j = 0; j < 8; ++j) v[j] += x[j];
      *(f32x4*)(xout + (size_t)grow * DM + gcol) = (f32x4){v[0], v[1], v[2], v[3]}; *(f32x4*)(xout + (size_t)grow * DM + gcol + 4) = (f32x4){v[4], v[5], v[6], v[7]};
      *(u32x4*)(xg + (size_t)grow * DM + gcol) = pk8(v);
    }
  }
};

struct EpiBf16 { u16* o; int ldo;
  DEVI void operator()(const float* C, int m0, int n0) const {
    const int tid = tidx();
#pragma unroll 1
    for (int it = 0; it < 8; ++it) { const int item = it * NTHREADS + tid, row = item >> 4, c8 = (item & 15) * 8;
      float v[8]; ld8(C + row * CLD + c8, v);
      *(u32x4*)(o + (size_t)(m0 + row) * ldo + n0 + c8) = pk8(v);
    }
  }
};

DEVI void ce_desc(float& a, float& b) { const float mx = fmaxf(a, b), mn = fminf(a, b); a = mx; b = mn; }
struct EpiTop { float* top; int hj;
  DEVI void operator()(const float* C, int m0, int) const {
    const int tid = tidx(), row = tid >> 1, part = tid & 1;
    float l[16];
#pragma unroll
    for (int i = 0; i < 16; ++i) l[i] = -3.0e38f;
#pragma unroll 4
    for (int c = 0; c < 64; ++c) { const int col = part * 64 + ((c + row) & 63);
      float v = __uint_as_float((__float_as_uint(C[row * CLD + col]) & ~127u) | (unsigned)(127 - col));
#pragma unroll
      for (int i = 0; i < 16; ++i) { const float t = fmaxf(l[i], v); v = fminf(l[i], v); l[i] = t; } }
    float m[16];
#pragma unroll
    for (int i = 0; i < 16; ++i) m[i] = __shfl_xor(l[15 - i], 1);
#pragma unroll
    for (int i = 0; i < 16; ++i) m[i] = fmaxf(m[i], l[i]);
#pragma unroll
    for (int st = 8; st >= 1; st >>= 1)
#pragma unroll
      for (int i = 0; i < 16; ++i) if ((i & st) == 0) ce_desc(m[i], m[i + st]);
    if (part == 0) { float* o = top + ((size_t)(m0 + row) * 16 + hj) * 16;
#pragma unroll
      for (int i = 0; i < 4; ++i) *(f32x4*)(o + 4 * i) = (f32x4){m[4 * i], m[4 * i + 1], m[4 * i + 2], m[4 * i + 3]}; }
  }
};

#define KSWZ(row, colB) ((row) * 256 + ((colB) ^ (((row) & 15) << 4)))
#define SBAR() __builtin_amdgcn_sched_barrier(0)
constexpr int AT_SHM_V = 64 * 64 * 2, AT_SHM_K = 64 * 128 * 2;
constexpr int AT_LDS = 3 * AT_SHM_V + 2 * AT_SHM_K + 8 * 64 * 4;
constexpr float ATT_THR = 8.f;
DEVI unsigned cvtpk(float lo, float hi) { unsigned r; asm volatile("v_cvt_pk_bf16_f32 %0, %1, %2" : "=v"(r) : "v"(lo), "v"(hi)); return r; }
DEVI int v_st(int k, int c) { const int kk = (k & ~0xC) | ((k & 4) << 1) | ((k & 8) >> 1); return ((kk >> 3) * 2 + (c >> 5)) * 512 + ((kk & 7) * 32 + (c & 31)) * 2; }
DEVI int v_rd_base(int lane) { return ((lane & 3) << 3) | (((lane >> 2) & 3) << 6) | (((lane >> 4) & 1) << 5) | (((lane >> 5) & 1) << 8); }
constexpr int v_rd_off(int d0, int ks, int half) { return d0 * 512 + ks * 2048 + half * 1024; }
template <int OFF> DEVI s16x4 tr_read(int vb) { s16x4 r; asm volatile("ds_read_b64_tr_b16 %0, %1 offset:%2" : "=&v"(r) : "v"(vb), "i"(OFF) : "memory"); return r; }

template <bool MASK, bool FIRST>
DEVI void partialSM(f32x16& p0, f32x16& p1, float& m_reg, float& mn, float& alpha, int kpos0, int qpos, int hi, f32x16& negm) {
  constexpr float THRL = ATT_THR * 1.4426950408889634f;
  if (MASK) {
#pragma unroll
    for (int r = 0; r < 16; ++r) { const int k0 = kpos0 + crow(r, hi) - qpos; const int k1 = k0 + 32;
      if (k0 > 128 || k0 < -128) p0[r] = -1e30f;
      if (k1 > 128 || k1 < -128) p1[r] = -1e30f; }
  }
  if (FIRST) {
    float pmax = p0[0];
#pragma unroll
    for (int r = 1; r < 16; ++r) pmax = fmaxf(pmax, p0[r]);
#pragma unroll
    for (int r = 0; r < 16; ++r) pmax = fmaxf(pmax, p1[r]);
    { auto rr = __builtin_amdgcn_permlane32_swap(__float_as_uint(pmax), __float_as_uint(pmax), false, false);
      pmax = fmaxf(__uint_as_float(rr[0]), __uint_as_float(rr[1])); }
    if (__builtin_expect(__all(pmax - m_reg <= THRL), 1)) { mn = m_reg; alpha = 1.f; }
    else { mn = fmaxf(m_reg, pmax); alpha = __builtin_amdgcn_exp2f(m_reg - mn); m_reg = mn; }
#pragma unroll
    for (int r = 0; r < 16; ++r) p0[r] -= mn;
#pragma unroll
    for (int r = 0; r < 16; ++r) p1[r] -= mn;
#pragma unroll
    for (int r = 0; r < 16; ++r) p0[r] = __builtin_amdgcn_exp2f(p0[r]);
#pragma unroll
    for (int r = 0; r < 16; ++r) negm[r] = -m_reg;
    asm volatile("" : "+v"(negm));
    return;
  }
  float tmax = p0[0];
#pragma unroll
  for (int r = 1; r < 16; ++r) tmax = fmaxf(tmax, p0[r]);
#pragma unroll
  for (int r = 0; r < 16; ++r) tmax = fmaxf(tmax, p1[r]);
#pragma unroll
  for (int r = 0; r < 16; ++r) p0[r] = __builtin_amdgcn_exp2f(p0[r]);
  { auto rr = __builtin_amdgcn_permlane32_swap(__float_as_uint(tmax), __float_as_uint(tmax), false, false);
    tmax = fmaxf(__uint_as_float(rr[0]), __uint_as_float(rr[1])); }
  mn = m_reg; alpha = 1.f;
  if (__builtin_expect(!__all(tmax <= THRL), 0)) {
    const float sh = fmaxf(tmax, 0.f);
    alpha = __builtin_amdgcn_exp2f(-sh); m_reg = m_reg + sh; mn = m_reg;
#pragma unroll
    for (int r = 0; r < 16; ++r) { p0[r] *= alpha; p1[r] -= sh; negm[r] = -m_reg; }
    asm volatile("" : "+v"(negm));
  }
}
DEVI void finishSM(f32x16& p0, f32x16& p1, float alpha, float& l_reg, bf16x8& pa0, bf16x8& pa1, bf16x8& pa2, bf16x8& pa3) {
#pragma unroll
  for (int r = 0; r < 16; ++r) p1[r] = __builtin_amdgcn_exp2f(p1[r]);
  float ps = 0;
#pragma unroll
  for (int r = 0; r < 16; ++r) ps += p0[r];
#pragma unroll
  for (int r = 0; r < 16; ++r) ps += p1[r];
  { auto rr = __builtin_amdgcn_permlane32_swap(__float_as_uint(ps), __float_as_uint(ps), false, false);
    ps = __uint_as_float(rr[0]) + __uint_as_float(rr[1]); }
  l_reg = l_reg * alpha + ps;
#define PK4(P, BASE, OUT) do { unsigned a0 = cvtpk(P[BASE + 0], P[BASE + 1]), a1 = cvtpk(P[BASE + 2], P[BASE + 3]);   \
    unsigned b0 = cvtpk(P[BASE + 4], P[BASE + 5]), b1 = cvtpk(P[BASE + 6], P[BASE + 7]);                              \
    auto r0 = __builtin_amdgcn_permlane32_swap(a0, b0, false, false); auto r1 = __builtin_amdgcn_permlane32_swap(a1, b1, false, false); \
    u32x4 w = {r0[0], r1[0], r0[1], r1[1]}; OUT = __builtin_bit_cast(bf16x8, w); } while (0)
  PK4(p0, 0, pa0); PK4(p0, 8, pa1); PK4(p1, 0, pa2); PK4(p1, 8, pa3);
#undef PK4
}
template <int ND0>
DEVI void qkt(f32x16& p0, f32x16& p1, const char* Ks, const bf16x8* qr, int r32, int hi, const f32x16& cinit) {
  bf16x8 k0[ND0], k1[ND0];
#pragma unroll
  for (int d0 = 0; d0 < ND0; ++d0) { const int cb = (d0 * 16 + hi * 8) * 2;
    k0[d0] = *(const bf16x8*)(Ks + KSWZ(r32, cb)); k1[d0] = *(const bf16x8*)(Ks + KSWZ(32 + r32, cb)); }
  p0 = cinit; p1 = cinit;
#pragma unroll
  for (int d0 = 0; d0 < ND0; ++d0) {
    p0 = __builtin_amdgcn_mfma_f32_32x32x16_bf16(k0[d0], qr[d0], p0, 0, 0, 0);
    p1 = __builtin_amdgcn_mfma_f32_32x32x16_bf16(k1[d0], qr[d0], p1, 0, 0, 0); }
}
template <int D0> DEVI void pv_one(f32x16& od, int vb, bf16x8 pa0, bf16x8 pa1, bf16x8 pa2, bf16x8 pa3) {
  const s16x4 l0 = tr_read<v_rd_off(D0, 0, 0)>(vb), h0 = tr_read<v_rd_off(D0, 0, 1)>(vb), l1 = tr_read<v_rd_off(D0, 1, 0)>(vb), h1 = tr_read<v_rd_off(D0, 1, 1)>(vb);
  const s16x4 l2 = tr_read<v_rd_off(D0, 2, 0)>(vb), h2 = tr_read<v_rd_off(D0, 2, 1)>(vb), l3 = tr_read<v_rd_off(D0, 3, 0)>(vb), h3 = tr_read<v_rd_off(D0, 3, 1)>(vb);
  asm volatile("s_waitcnt lgkmcnt(0)" ::: "memory"); SBAR();
#define PK(L, H) (bf16x8){L[0], L[1], L[2], L[3], H[0], H[1], H[2], H[3]}
  od = __builtin_amdgcn_mfma_f32_32x32x16_bf16(pa0, PK(l0, h0), od, 0, 0, 0);
  od = __builtin_amdgcn_mfma_f32_32x32x16_bf16(pa1, PK(l1, h1), od, 0, 0, 0);
  od = __builtin_amdgcn_mfma_f32_32x32x16_bf16(pa2, PK(l2, h2), od, 0, 0, 0);
  od = __builtin_amdgcn_mfma_f32_32x32x16_bf16(pa3, PK(l3, h3), od, 0, 0, 0);
#undef PK
}
DEVI void pv_d0(f32x16* o, int vb, bf16x8 pa0, bf16x8 pa1, bf16x8 pa2, bf16x8 pa3) {
  const s16x4 a0 = tr_read<v_rd_off(0, 0, 0)>(vb), b0 = tr_read<v_rd_off(0, 0, 1)>(vb), a1 = tr_read<v_rd_off(0, 1, 0)>(vb), b1 = tr_read<v_rd_off(0, 1, 1)>(vb);
  const s16x4 a2 = tr_read<v_rd_off(0, 2, 0)>(vb), b2 = tr_read<v_rd_off(0, 2, 1)>(vb), a3 = tr_read<v_rd_off(0, 3, 0)>(vb), b3 = tr_read<v_rd_off(0, 3, 1)>(vb);
  const s16x4 c0 = tr_read<v_rd_off(1, 0, 0)>(vb), d0 = tr_read<v_rd_off(1, 0, 1)>(vb), c1 = tr_read<v_rd_off(1, 1, 0)>(vb), d1 = tr_read<v_rd_off(1, 1, 1)>(vb);
  const s16x4 c2 = tr_read<v_rd_off(1, 2, 0)>(vb), d2 = tr_read<v_rd_off(1, 2, 1)>(vb), c3 = tr_read<v_rd_off(1, 3, 0)>(vb), d3 = tr_read<v_rd_off(1, 3, 1)>(vb);
  asm volatile("s_waitcnt lgkmcnt(0)" ::: "memory"); SBAR();
#define PK(L, H) (bf16x8){L[0], L[1], L[2], L[3], H[0], H[1], H[2], H[3]}
  o[0] = __builtin_amdgcn_mfma_f32_32x32x16_bf16(pa0, PK(a0, b0), o[0], 0, 0, 0);
  o[1] = __builtin_amdgcn_mfma_f32_32x32x16_bf16(pa0, PK(c0, d0), o[1], 0, 0, 0);
  o[0] = __builtin_amdgcn_mfma_f32_32x32x16_bf16(pa1, PK(a1, b1), o[0], 0, 0, 0);
  o[1] = __builtin_amdgcn_mfma_f32_32x32x16_bf16(pa1, PK(c1, d1), o[1], 0, 0, 0);
  o[0] = __builtin_amdgcn_mfma_f32_32x32x16_bf16(pa2, PK(a2, b2), o[0], 0, 0, 0);
  o[1] = __builtin_amdgcn_mfma_f32_32x32x16_bf16(pa2, PK(c2, d2), o[1], 0, 0, 0);
  o[0] = __builtin_amdgcn_mfma_f32_32x32x16_bf16(pa3, PK(a3, b3), o[0], 0, 0, 0);
  o[1] = __builtin_amdgcn_mfma_f32_32x32x16_bf16(pa3, PK(c3, d3), o[1], 0, 0, 0);
#undef PK
}

template <int DQK, bool MASK>
DEVI void attn_body(const u16* Qw, const u16* Kh, int ldk, const u16* Vh, int ldv, int kt0, int NT, float m_init, float l_init,
                    int qpos, u16* Ow, char* lds, float qrope_pos = 0.f) {
  constexpr int ND0 = DQK / 16, NCK = DQK / 8;
  const int tid = tidx(), wid = __builtin_amdgcn_readfirstlane(tid >> 6), lane = tid & 63, r32 = lane & 31, hi = lane >> 5;
  char* K_lds = lds; char* V_lds = lds + 2 * AT_SHM_K;
  float* wsx = (float*)(lds + 2 * AT_SHM_K + 3 * AT_SHM_V) + wid * 64; float* li_l = wsx; float* al_l = wsx + 32;
  float m_reg = m_init, l_reg = l_init; f32x16 o[2] = {f32x16{}, f32x16{}}; bf16x8 qr[ND0];
#pragma unroll
  for (int d0 = 0; d0 < ND0; ++d0) qr[d0] = *(const bf16x8*)(Qw + d0 * 16);
  if (DQK == 96) {
#pragma unroll
    for (int d0 = 4; d0 < ND0; ++d0) { float v[8]; unpk8(__builtin_bit_cast(u32x4, qr[d0]), v);
#pragma unroll
      for (int q = 0; q < 4; ++q) { const int f = 2 * ((((d0 - 4) * 16 + hi * 8) >> 1) + q); float sn, cs; rope_sc(qrope_pos, f, sn, cs);
        const float x1 = v[2 * q], x2 = v[2 * q + 1]; v[2 * q] = x1 * cs - x2 * sn; v[2 * q + 1] = x2 * cs + x1 * sn; }
      qr[d0] = __builtin_bit_cast(bf16x8, pk8(v)); } }
  unsigned koff[2], voff;
#pragma unroll
  for (int i = 0; i < 2; ++i) { const int row = 4 * (wid + 8 * i) + (lane >> 4), ch = (lane & 15) ^ (row & 15); koff[i] = (unsigned)(row * ldk * 2 + (ch < NCK ? ch : 0) * 16); }
  { const int off = wid * 1024 + lane * 16, sub = off >> 9, kk = ((sub >> 1) << 3) | ((off & 511) >> 6), c = ((sub & 1) << 5) | ((off & 63) >> 1);
    const int k = (kk & ~0xC) | ((kk & 4) << 1) | ((kk & 8) >> 1); voff = (unsigned)(k * ldv * 2 + c * 2); }
  typedef __attribute__((address_space(3))) unsigned lds_u32;
#define DMA(tt_) do { const char* kb_ = (const char*)Kh + (size_t)(kt0 + (tt_)) * 64 * ldk * 2; const char* vb_ = (const char*)Vh + (size_t)(kt0 + (tt_)) * 64 * ldv * 2; \
    char* kd_ = K_lds + ((tt_) & 1) * AT_SHM_K + wid * 1024; char* vd_ = V_lds + ((tt_) % 3) * AT_SHM_V + wid * 1024; \
    __builtin_amdgcn_global_load_lds((const unsigned*)(kb_ + koff[0]), (lds_u32*)kd_, 16, 0, 0); \
    __builtin_amdgcn_global_load_lds((const unsigned*)(kb_ + koff[1]), (lds_u32*)(kd_ + 8192), 16, 0, 0); \
    __builtin_amdgcn_global_load_lds((const unsigned*)(vb_ + voff), (lds_u32*)vd_, 16, 0, 0); } while (0)
#define LANDED() do { asm volatile("s_waitcnt vmcnt(0)" ::: "memory"); __syncthreads(); } while (0)
#define RESC(a) do { if (__any((a) < 1.f)) { if (hi == 0) al_l[r32] = (a); asm volatile("s_waitcnt lgkmcnt(0)" ::: "memory"); \
    _Pragma("unroll") for (int d = 0; d < 2; ++d) _Pragma("unroll") for (int r = 0; r < 16; ++r) o[d][r] *= al_l[crow(r, hi)]; } } while (0)
  const int vb0 = (int)(uintptr_t)V_lds + v_rd_base(lane);
  f32x16 pA0, pA1, pB0, pB1, negm; float mnA, mnB, alA, alB; bf16x8 pa0, pa1, pa2, pa3;
  DMA(0); DMA(1);
  asm volatile("s_waitcnt vmcnt(3) lgkmcnt(0)\n\ts_barrier" ::: "memory");
  qkt<ND0>(pA0, pA1, K_lds, qr, r32, hi, f32x16{}); partialSM<MASK, true>(pA0, pA1, m_reg, mnA, alA, kt0 * 64, qpos, hi, negm);
  LANDED();
  int vprev = 0;
  for (int tt = 1; tt + 1 < NT; tt += 2) {
    const int v1 = vprev == 2 ? 0 : vprev + 1;
    DMA(tt + 1); SBAR();
    qkt<ND0>(pB0, pB1, K_lds + AT_SHM_K, qr, r32, hi, negm);
    finishSM(pA0, pA1, alA, l_reg, pa0, pa1, pa2, pa3); SBAR();
    pv_d0(o, vb0 + vprev * AT_SHM_V, pa0, pa1, pa2, pa3); partialSM<MASK, false>(pB0, pB1, m_reg, mnB, alB, (kt0 + tt) * 64, qpos, hi, negm);
    RESC(alB); LANDED();
    if (tt + 2 < NT) DMA(tt + 2);
    SBAR();
    qkt<ND0>(pA0, pA1, K_lds, qr, r32, hi, negm);
    finishSM(pB0, pB1, alB, l_reg, pa0, pa1, pa2, pa3); SBAR();
    pv_d0(o, vb0 + v1 * AT_SHM_V, pa0, pa1, pa2, pa3); partialSM<MASK, false>(pA0, pA1, m_reg, mnA, alA, (kt0 + tt + 1) * 64, qpos, hi, negm);
    RESC(alA); LANDED();
    vprev = v1 == 2 ? 0 : v1 + 1;
  }
  { const int v1 = vprev == 2 ? 0 : vprev + 1;
    SBAR(); qkt<ND0>(pB0, pB1, K_lds + AT_SHM_K, qr, r32, hi, negm);
    finishSM(pA0, pA1, alA, l_reg, pa0, pa1, pa2, pa3); SBAR();
    pv_d0(o, vb0 + vprev * AT_SHM_V, pa0, pa1, pa2, pa3); partialSM<MASK, false>(pB0, pB1, m_reg, mnB, alB, (kt0 + NT - 1) * 64, qpos, hi, negm);
    RESC(alB);
    finishSM(pB0, pB1, alB, l_reg, pa0, pa1, pa2, pa3); SBAR();
    pv_d0(o, vb0 + v1 * AT_SHM_V, pa0, pa1, pa2, pa3); }
  if (hi == 0) li_l[r32] = l_reg; asm volatile("s_waitcnt lgkmcnt(0)" ::: "memory");
  float rli[16];
#pragma unroll
  for (int r = 0; r < 16; ++r) rli[r] = __builtin_amdgcn_rcpf(li_l[crow(r, hi)]);
#pragma unroll
  for (int r = 0; r < 16; ++r) { const int orow = crow(r, hi);
#pragma unroll
    for (int d0 = 0; d0 < 2; ++d0) Ow[(size_t)orow * DM + d0 * 32 + r32] = f2bf(o[d0][r] * rli[r]); }
  __syncthreads();
#undef DMA
#undef LANDED
#undef RESC
}

#define PINV(x) asm volatile("" : "+v"(x))
#define MF32(a, b, c) __builtin_amdgcn_mfma_f32_32x32x16_bf16(a, b, c, 0, 0, 0)
#define EX2(x) __builtin_amdgcn_exp2f(x)
#define MX3(a, b, c) __builtin_fmaxf(__builtin_fmaxf((a), (b)), (c))
constexpr int v2_off(int d0, int ks, int half) { return d0 * 4096 + ks * 1024 + half * 512; }
constexpr float MLA_PBOUND = 16384.f;
template <bool GL>
DEVI void mla_step(f32x16& C0, f32x16& C1, f32x16& P0, f32x16& P1, bf16x8* k0, bf16x8* k1, const char* Kn, int vb, const bf16x8* qr, f32x16& negm, f32x16* o,
                   float& l_reg, float& m_reg, float* al_l, int r32, int hi) {
  SBAR();
  float ps; unsigned a0, a1, b0, b1; bf16x8 pa0, pa1, pa2, pa3;
#define SW2(OUT) do { u32x4 w_ = {a0, a1, b0, b1}; OUT = __builtin_bit_cast(bf16x8, w_); PINV(OUT); } while (0)
  C0 = MF32(k0[0], qr[0], negm); P1[0] = EX2(P1[0]); P1[1] = EX2(P1[1]); ps = P0[0] + P0[1]; ps += P0[2]; ps += P0[3]; PINV(P1); PINV(ps); SBAR();
  C1 = MF32(k1[0], qr[0], negm); P1[2] = EX2(P1[2]); P1[3] = EX2(P1[3]); ps += P0[4]; ps += P0[5]; ps += P0[6]; ps += P0[7]; PINV(P1); PINV(ps); SBAR();
  C0 = MF32(k0[1], qr[1], C0);   P1[4] = EX2(P1[4]); P1[5] = EX2(P1[5]); ps += P0[8]; ps += P0[9]; ps += P0[10]; ps += P0[11]; PINV(P1); PINV(ps); SBAR();
  C1 = MF32(k1[1], qr[1], C1);   P1[6] = EX2(P1[6]); P1[7] = EX2(P1[7]); ps += P0[12]; ps += P0[13]; ps += P0[14]; ps += P0[15]; PINV(P1); PINV(ps); SBAR();
  C0 = MF32(k0[2], qr[2], C0);   P1[8] = EX2(P1[8]); P1[9] = EX2(P1[9]); a0 = cvtpk(P0[0], P0[1]); a1 = cvtpk(P0[2], P0[3]); b0 = cvtpk(P0[4], P0[5]); PINV(P1); SBAR();
  C1 = MF32(k1[2], qr[2], C1);   P1[10] = EX2(P1[10]); P1[11] = EX2(P1[11]); b1 = cvtpk(P0[6], P0[7]); SW2(pa0); PINV(P1); SBAR();
  C0 = MF32(k0[3], qr[3], C0);   P1[12] = EX2(P1[12]); P1[13] = EX2(P1[13]); a0 = cvtpk(P0[8], P0[9]); a1 = cvtpk(P0[10], P0[11]); b0 = cvtpk(P0[12], P0[13]); PINV(P1); SBAR();
  C1 = MF32(k1[3], qr[3], C1);   P1[14] = EX2(P1[14]); P1[15] = EX2(P1[15]); b1 = cvtpk(P0[14], P0[15]); SW2(pa1); PINV(P1); SBAR();
  C0 = MF32(k0[4], qr[4], C0);   ps += P1[0]; ps += P1[1]; ps += P1[2]; ps += P1[3]; PINV(ps);
  const s16x4 va0 = tr_read<v2_off(0, 0, 0)>(vb), vb0_ = tr_read<v2_off(0, 0, 1)>(vb), vc0 = tr_read<v2_off(1, 0, 0)>(vb), vd0 = tr_read<v2_off(1, 0, 1)>(vb); SBAR();
  C1 = MF32(k1[4], qr[4], C1);   ps += P1[4]; ps += P1[5]; ps += P1[6]; ps += P1[7]; PINV(ps);
  const s16x4 va1 = tr_read<v2_off(0, 1, 0)>(vb), vb1 = tr_read<v2_off(0, 1, 1)>(vb), vc1 = tr_read<v2_off(1, 1, 0)>(vb), vd1 = tr_read<v2_off(1, 1, 1)>(vb); SBAR();
  C0 = MF32(k0[5], qr[5], C0);   ps += P1[8]; ps += P1[9]; ps += P1[10]; ps += P1[11]; PINV(ps);
  const s16x4 va2 = tr_read<v2_off(0, 2, 0)>(vb), vb2 = tr_read<v2_off(0, 2, 1)>(vb), vc2 = tr_read<v2_off(1, 2, 0)>(vb), vd2 = tr_read<v2_off(1, 2, 1)>(vb); SBAR();
  C1 = MF32(k1[5], qr[5], C1);   ps += P1[12]; ps += P1[13]; ps += P1[14]; ps += P1[15]; PINV(ps);
  const s16x4 va3 = tr_read<v2_off(0, 3, 0)>(vb), vb3 = tr_read<v2_off(0, 3, 1)>(vb), vc3 = tr_read<v2_off(1, 3, 0)>(vb), vd3 = tr_read<v2_off(1, 3, 1)>(vb); SBAR();
  if (__builtin_expect(!__all(ps <= MLA_PBOUND), 0)) {
    float mx = MX3(P0[0], P0[1], P1[0]);
#pragma unroll
    for (int r = 1; r < 16; ++r) mx = MX3(mx, P0[r], P1[r]);
    { auto rr = __builtin_amdgcn_permlane32_swap(__float_as_uint(mx), __float_as_uint(mx), false, false); mx = fmaxf(__uint_as_float(rr[0]), __uint_as_float(rr[1])); }
    const float sh = fmaxf(__builtin_amdgcn_logf(mx), 0.f), al = __builtin_amdgcn_exp2f(-sh);
    m_reg += sh; l_reg *= al; ps *= al;
#pragma unroll
    for (int r = 0; r < 16; ++r) { P0[r] *= al; P1[r] *= al; C0[r] -= sh; C1[r] -= sh; negm[r] = -m_reg; }
    asm volatile("" : "+v"(negm));
#define PK4N(P, BASE) __builtin_bit_cast(bf16x8, (u32x4){cvtpk(P[BASE + 0], P[BASE + 1]), cvtpk(P[BASE + 2], P[BASE + 3]), cvtpk(P[BASE + 4], P[BASE + 5]), cvtpk(P[BASE + 6], P[BASE + 7])})
    pa0 = PK4N(P0, 0); pa1 = PK4N(P0, 8);
#undef PK4N
    if (hi == 0) al_l[r32] = al; asm volatile("s_waitcnt lgkmcnt(0)" ::: "memory");
#pragma unroll
    for (int r = 0; r < 16; ++r) { const float x = al_l[crow(r, hi)]; o[0][r] *= x; o[1][r] *= x; }
  }
  l_reg += ps;
  asm volatile("s_waitcnt lgkmcnt(0)" ::: "memory"); SBAR();
#define PK(L, H) (bf16x8){L[0], L[1], L[2], L[3], H[0], H[1], H[2], H[3]}
  o[0] = MF32(pa0, PK(va0, vb0_), o[0]); C0[0] = EX2(C0[0]); C0[1] = EX2(C0[1]); a0 = cvtpk(P1[0], P1[1]); a1 = cvtpk(P1[2], P1[3]); PINV(C0); SBAR();
  o[1] = MF32(pa0, PK(vc0, vd0), o[1]);  C0[2] = EX2(C0[2]); C0[3] = EX2(C0[3]); b0 = cvtpk(P1[4], P1[5]); b1 = cvtpk(P1[6], P1[7]); SW2(pa2); PINV(C0); SBAR();
  if (GL) { const int cb = (0 * 16 + hi * 8) * 2; k0[0] = *(const bf16x8*)(Kn + KSWZ(r32, cb)); k1[0] = *(const bf16x8*)(Kn + KSWZ(32 + r32, cb)); SBAR(); }
  o[0] = MF32(pa1, PK(va1, vb1), o[0]);  C0[4] = EX2(C0[4]); C0[5] = EX2(C0[5]); a0 = cvtpk(P1[8], P1[9]); a1 = cvtpk(P1[10], P1[11]); PINV(C0); SBAR();
  if (GL) { const int cb = (1 * 16 + hi * 8) * 2; k0[1] = *(const bf16x8*)(Kn + KSWZ(r32, cb)); k1[1] = *(const bf16x8*)(Kn + KSWZ(32 + r32, cb)); SBAR(); }
  o[1] = MF32(pa1, PK(vc1, vd1), o[1]);  C0[6] = EX2(C0[6]); C0[7] = EX2(C0[7]); b0 = cvtpk(P1[12], P1[13]); b1 = cvtpk(P1[14], P1[15]); SW2(pa3); PINV(C0); SBAR();
  if (GL) { const int cb = (2 * 16 + hi * 8) * 2; k0[2] = *(const bf16x8*)(Kn + KSWZ(r32, cb)); k1[2] = *(const bf16x8*)(Kn + KSWZ(32 + r32, cb)); SBAR(); }
  o[0] = MF32(pa2, PK(va2, vb2), o[0]);  C0[8] = EX2(C0[8]); C0[9] = EX2(C0[9]); PINV(C0); SBAR();
  if (GL) { const int cb = (3 * 16 + hi * 8) * 2; k0[3] = *(const bf16x8*)(Kn + KSWZ(r32, cb)); k1[3] = *(const bf16x8*)(Kn + KSWZ(32 + r32, cb)); SBAR(); }
  o[1] = MF32(pa2, PK(vc2, vd2), o[1]);  C0[10] = EX2(C0[10]); C0[11] = EX2(C0[11]); PINV(C0); SBAR();
  if (GL) { const int cb = (4 * 16 + hi * 8) * 2; k0[4] = *(const bf16x8*)(Kn + KSWZ(r32, cb)); k1[4] = *(const bf16x8*)(Kn + KSWZ(32 + r32, cb)); SBAR(); }
  o[0] = MF32(pa3, PK(va3, vb3), o[0]);  C0[12] = EX2(C0[12]); C0[13] = EX2(C0[13]); PINV(C0); SBAR();
  if (GL) { const int cb = (5 * 16 + hi * 8) * 2; k0[5] = *(const bf16x8*)(Kn + KSWZ(r32, cb)); k1[5] = *(const bf16x8*)(Kn + KSWZ(32 + r32, cb)); SBAR(); }
  o[1] = MF32(pa3, PK(vc3, vd3), o[1]);  C0[14] = EX2(C0[14]); C0[15] = EX2(C0[15]); PINV(C0); SBAR();
#undef PK
#undef SW2
}

DEVI void attn_mla(const u16* Qw, const u16* Kh, const u16* Vh, u16* Ow, char* lds, float qrope_pos) {
  constexpr int ND0 = 6, NCK = 12, NT = SEQ / 64, ldk = MLA_QK, ldv = MLA_V, kt0 = 0;
  const int tid = tidx(), wid = __builtin_amdgcn_readfirstlane(tid >> 6), lane = tid & 63, r32 = lane & 31, hi = lane >> 5;
  char* K_lds = lds; char* V_lds = lds + 2 * AT_SHM_K;
  float* wsx = (float*)(lds + 2 * AT_SHM_K + 3 * AT_SHM_V) + wid * 64; float* li_l = wsx; float* al_l = wsx + 32;
  float m_reg = -1e30f, l_reg = 0.f; f32x16 o[2] = {f32x16{}, f32x16{}}; bf16x8 qr[ND0];
#pragma unroll
  for (int d0 = 0; d0 < ND0; ++d0) qr[d0] = *(const bf16x8*)(Qw + d0 * 16);
#pragma unroll
  for (int d0 = 4; d0 < ND0; ++d0) { float v[8]; unpk8(__builtin_bit_cast(u32x4, qr[d0]), v);
#pragma unroll
    for (int q = 0; q < 4; ++q) { const int f = 2 * ((((d0 - 4) * 16 + hi * 8) >> 1) + q); float sn, cs; rope_sc(qrope_pos, f, sn, cs);
      const float x1 = v[2 * q], x2 = v[2 * q + 1]; v[2 * q] = x1 * cs - x2 * sn; v[2 * q + 1] = x2 * cs + x1 * sn; }
    qr[d0] = __builtin_bit_cast(bf16x8, pk8(v)); }
  unsigned koff[2], voff;
#pragma unroll
  for (int i = 0; i < 2; ++i) { const int row = 4 * (wid + 8 * i) + (lane >> 4), ch = (lane & 15) ^ (row & 15); koff[i] = (unsigned)(row * ldk * 2 + (ch < NCK ? ch : 0) * 16); }
  voff = (unsigned)((16 * (wid & 3) + (lane >> 2)) * ldv * 2 + ((wid >> 2) * 32 + (lane & 3) * 8) * 2);
  typedef __attribute__((address_space(3))) unsigned lds_u32;
#define DMA_K(tt_) do { const char* kb_ = (const char*)Kh + (size_t)(tt_) * 64 * ldk * 2; char* kd_ = K_lds + ((tt_) & 1) * AT_SHM_K + wid * 1024; \
    __builtin_amdgcn_global_load_lds((const unsigned*)(kb_ + koff[0]), (lds_u32*)kd_, 16, 0, 0); \
    __builtin_amdgcn_global_load_lds((const unsigned*)(kb_ + koff[1]), (lds_u32*)(kd_ + 8192), 16, 0, 0); } while (0)
#define DMA_V(tt_) do { const char* vb_ = (const char*)Vh + (size_t)(tt_) * 64 * ldv * 2; char* vd_ = V_lds + ((tt_) % 3) * AT_SHM_V + wid * 1024; \
    __builtin_amdgcn_global_load_lds((const unsigned*)(vb_ + voff), (lds_u32*)vd_, 16, 0, 0); } while (0)
#define LANDED() do { asm volatile("s_waitcnt vmcnt(0)" ::: "memory"); __syncthreads(); } while (0)
#define RESC(a) do { if (__any((a) < 1.f)) { if (hi == 0) al_l[r32] = (a); asm volatile("s_waitcnt lgkmcnt(0)" ::: "memory"); \
    _Pragma("unroll") for (int d = 0; d < 2; ++d) _Pragma("unroll") for (int r = 0; r < 16; ++r) o[d][r] *= al_l[crow(r, hi)]; } } while (0)
  const int vb0 = (int)(uintptr_t)V_lds + ((lane >> 4) & 1) * 32 + (lane & 3) * 8 + (4 * hi + ((lane & 15) >> 2)) * 64;
  f32x16 pA0, pA1, pB0, pB1, negm; float mnA, alA, alB; bf16x8 pa0, pa1, pa2, pa3;
  bf16x8 kf0[6], kf1[6];
#define KREAD(Ks_) do { _Pragma("unroll") for (int d0 = 0; d0 < 6; ++d0) { const int cb = (d0 * 16 + hi * 8) * 2; \
    kf0[d0] = *(const bf16x8*)((Ks_) + KSWZ(r32, cb)); kf1[d0] = *(const bf16x8*)((Ks_) + KSWZ(32 + r32, cb)); } } while (0)
  DMA_K(0); DMA_V(0); DMA_K(1); DMA_V(1);
  asm volatile("s_waitcnt vmcnt(3) lgkmcnt(0)\n\ts_barrier" ::: "memory");
  qkt<ND0>(pA0, pA1, K_lds, qr, r32, hi, f32x16{}); partialSM<false, true>(pA0, pA1, m_reg, mnA, alA, 0, 0, hi, negm);
  LANDED();
  DMA_K(2);
  KREAD(K_lds + AT_SHM_K);
  LANDED();
  DMA_K(3); DMA_V(2);
  int vprev = 0;
  for (int tt = 1; tt + 3 < NT; tt += 2) {
    const int v1 = vprev == 2 ? 0 : vprev + 1;
    mla_step<true>(pB0, pB1, pA0, pA1, kf0, kf1, K_lds, vb0 + vprev * AT_SHM_V, qr, negm, o, l_reg, m_reg, al_l, r32, hi);
    LANDED();
    DMA_K(tt + 3); DMA_V(tt + 2);
    mla_step<true>(pA0, pA1, pB0, pB1, kf0, kf1, K_lds + AT_SHM_K, vb0 + v1 * AT_SHM_V, qr, negm, o, l_reg, m_reg, al_l, r32, hi);
    LANDED();
    if (tt + 4 < NT) DMA_K(tt + 4);
    DMA_V(tt + 3);
    vprev = v1 == 2 ? 0 : v1 + 1;
  }
  {
    const int v1 = vprev == 2 ? 0 : vprev + 1, v2 = v1 == 2 ? 0 : v1 + 1;
    mla_step<true>(pB0, pB1, pA0, pA1, kf0, kf1, K_lds, vb0 + vprev * AT_SHM_V, qr, negm, o, l_reg, m_reg, al_l, r32, hi);
    LANDED();
    DMA_V(NT - 1);
    mla_step<true>(pA0, pA1, pB0, pB1, kf0, kf1, K_lds + AT_SHM_K, vb0 + v1 * AT_SHM_V, qr, negm, o, l_reg, m_reg, al_l, r32, hi);
    LANDED();
    mla_step<false>(pB0, pB1, pA0, pA1, kf0, kf1, K_lds, vb0 + v2 * AT_SHM_V, qr, negm, o, l_reg, m_reg, al_l, r32, hi);
    {
#pragma unroll
      for (int r = 0; r < 16; ++r) pB1[r] = EX2(pB1[r]);
      float ps = 0;
#pragma unroll
      for (int r = 0; r < 16; ++r) ps += pB0[r];
#pragma unroll
      for (int r = 0; r < 16; ++r) ps += pB1[r];
      if (__builtin_expect(!__all(ps <= MLA_PBOUND), 0)) {
        float mx = MX3(pB0[0], pB0[1], pB1[0]);
#pragma unroll
        for (int r = 1; r < 16; ++r) mx = MX3(mx, pB0[r], pB1[r]);
        { auto rr = __builtin_amdgcn_permlane32_swap(__float_as_uint(mx), __float_as_uint(mx), false, false); mx = fmaxf(__uint_as_float(rr[0]), __uint_as_float(rr[1])); }
        const float sh = fmaxf(__builtin_amdgcn_logf(mx), 0.f), al = __builtin_amdgcn_exp2f(-sh);
        l_reg *= al; ps *= al;
#pragma unroll
        for (int r = 0; r < 16; ++r) { pB0[r] *= al; pB1[r] *= al; }
        if (hi == 0) al_l[r32] = al; asm volatile("s_waitcnt lgkmcnt(0)" ::: "memory");
#pragma unroll
        for (int r = 0; r < 16; ++r) { const float x = al_l[crow(r, hi)]; o[0][r] *= x; o[1][r] *= x; }
      }
      l_reg += ps;
#define PK4N(P, BASE) __builtin_bit_cast(bf16x8, (u32x4){cvtpk(P[BASE + 0], P[BASE + 1]), cvtpk(P[BASE + 2], P[BASE + 3]), cvtpk(P[BASE + 4], P[BASE + 5]), cvtpk(P[BASE + 6], P[BASE + 7])})
      pa0 = PK4N(pB0, 0); pa1 = PK4N(pB0, 8); pa2 = PK4N(pB1, 0); pa3 = PK4N(pB1, 8);
#undef PK4N
      const int vb = vb0 + vprev * AT_SHM_V;
      const s16x4 a0 = tr_read<v2_off(0, 0, 0)>(vb), b0 = tr_read<v2_off(0, 0, 1)>(vb), a1 = tr_read<v2_off(0, 1, 0)>(vb), b1 = tr_read<v2_off(0, 1, 1)>(vb);
      const s16x4 a2 = tr_read<v2_off(0, 2, 0)>(vb), b2 = tr_read<v2_off(0, 2, 1)>(vb), a3 = tr_read<v2_off(0, 3, 0)>(vb), b3 = tr_read<v2_off(0, 3, 1)>(vb);
      const s16x4 c0 = tr_read<v2_off(1, 0, 0)>(vb), d0 = tr_read<v2_off(1, 0, 1)>(vb), c1 = tr_read<v2_off(1, 1, 0)>(vb), d1 = tr_read<v2_off(1, 1, 1)>(vb);
      const s16x4 c2 = tr_read<v2_off(1, 2, 0)>(vb), d2 = tr_read<v2_off(1, 2, 1)>(vb), c3 = tr_read<v2_off(1, 3, 0)>(vb), d3 = tr_read<v2_off(1, 3, 1)>(vb);
      asm volatile("s_waitcnt lgkmcnt(0)" ::: "memory"); SBAR();
#define PK(L, H) (bf16x8){L[0], L[1], L[2], L[3], H[0], H[1], H[2], H[3]}
      o[0] = MF32(pa0, PK(a0, b0), o[0]); o[1] = MF32(pa0, PK(c0, d0), o[1]); o[0] = MF32(pa1, PK(a1, b1), o[0]); o[1] = MF32(pa1, PK(c1, d1), o[1]);
      o[0] = MF32(pa2, PK(a2, b2), o[0]); o[1] = MF32(pa2, PK(c2, d2), o[1]); o[0] = MF32(pa3, PK(a3, b3), o[0]); o[1] = MF32(pa3, PK(c3, d3), o[1]);
#undef PK
    } }
#undef KREAD
  { auto rr = __builtin_amdgcn_permlane32_swap(__float_as_uint(l_reg), __float_as_uint(l_reg), false, false); l_reg = __uint_as_float(rr[0]) + __uint_as_float(rr[1]); }
  if (hi == 0) li_l[r32] = l_reg; asm volatile("s_waitcnt lgkmcnt(0)" ::: "memory");
  float rli[16];
#pragma unroll
  for (int r = 0; r < 16; ++r) rli[r] = __builtin_amdgcn_rcpf(li_l[crow(r, hi)]);
#pragma unroll
  for (int r = 0; r < 16; ++r) { const int orow = crow(r, hi);
#pragma unroll
    for (int d0 = 0; d0 < 2; ++d0) Ow[(size_t)orow * DM + d0 * 32 + r32] = f2bf(o[d0][r] * rli[r]); }
  __syncthreads();
#undef DMA_K
#undef DMA_V
#undef LANDED
#undef RESC
}

constexpr int LCH = 64, NLCH = SEQ / LCH;
constexpr size_t WS_LP = 1 * MiB, WS_LH = 2560 * 1024;
constexpr size_t WS_LC = 473 * MiB;
constexpr size_t WS_NEED = 510 * MiB;
DEVI void lru_passA(const Params& p, int item, int lane) {
  const int cg = item % 6, c = (item / 6) % NLCH, b = (item / (6 * NLCH)) % NB, d = item / (6 * NLCH * NB);
  const size_t base = (((size_t)(d * NB + b) * (SEQ / 8) + c * 8) * LRU_W + cg * 64 + lane) * 8;
  const u16* E = (const u16*)(p.ws + WS_LE) + base; const u16* Bp = (const u16*)(p.ws + WS_LB) + base;
  u32x4 ev[8], bv[8];
#pragma unroll
  for (int g = 0; g < 8; ++g) { ev[g] = *(const u32x4*)(E + (size_t)g * LRU_W * 8); bv[g] = *(const u32x4*)(Bp + (size_t)g * LRU_W * 8); }
  float h = 0.f, P = 1.f;
#pragma unroll
  for (int gg = 0; gg < 8; ++gg) { const int g = d ? 7 - gg : gg; float e[8], bb[8]; unpk8(ev[g], e); unpk8(bv[g], bb);
#pragma unroll
    for (int rr = 0; rr < 8; ++rr) { const int r = d ? 7 - rr : rr; const float a = 1.f - e[r]; h = fmaf(a, h, bb[r]); P *= a; } }
  const size_t o = ((size_t)(d * NB + b) * NLCH + c) * LRU_W + cg * 64 + lane;
  ((float*)(p.ws + WS_LP))[o] = P; ((float*)(p.ws + WS_LH))[o] = h;
}

DEVI void lru_final(const Params& p, int item, char* lds) {
  const int tid = tidx(), wid = tid >> 6, lane = tid & 63;
  const int c = item % NLCH, b = item / NLCH;
  float* obuf = (float*)lds;
  u16* gbuf = (u16*)(lds + 64 * LRU_W * 4);
  const int ch = wid * 64 + lane;
  u32x4 ev0[8], bv0[8], ev1[8], bv1[8]; float h0 = 0.f, h1 = 0.f;
  if (wid < 6) {
    const size_t co0 = ((size_t)(0 * NB + b) * NLCH + c) * LRU_W + ch, co1 = ((size_t)(1 * NB + b) * NLCH + c) * LRU_W + ch;
    h0 = ((const float*)(p.ws + WS_LC))[co0]; h1 = ((const float*)(p.ws + WS_LC))[co1];
    const size_t base0 = (((size_t)(0 * NB + b) * (SEQ / 8) + c * 8) * LRU_W + ch) * 8, base1 = (((size_t)(1 * NB + b) * (SEQ / 8) + c * 8) * LRU_W + ch) * 8;
    const u16* E = (const u16*)(p.ws + WS_LE); const u16* Bp = (const u16*)(p.ws + WS_LB);
#pragma unroll
    for (int g = 0; g < 8; ++g) { ev0[g] = *(const u32x4*)(E + base0 + (size_t)g * LRU_W * 8); bv0[g] = *(const u32x4*)(Bp + base0 + (size_t)g * LRU_W * 8);
      ev1[g] = *(const u32x4*)(E + base1 + (size_t)g * LRU_W * 8); bv1[g] = *(const u32x4*)(Bp + base1 + (size_t)g * LRU_W * 8); }
  }
  { const u16* gp = (const u16*)(p.ws + WS_R1) + ((size_t)b * SEQ + c * LCH) * INWP + PC_LG;
#pragma unroll
    for (int i = 0; i < 6; ++i) { const int id = tid + NTHREADS * i, tk = id / 48, c16 = id - tk * 48;
      float g[8]; unpk8(*(const u32x4*)(gp + (size_t)tk * INWP + c16 * 8), g);
#pragma unroll
      for (int q = 0; q < 8; ++q) g[q] = gelu_erf(g[q]);
      *(u32x4*)(gbuf + tk * LRU_W + c16 * 8) = pk8(g); } }
  __syncthreads();
  if (wid < 6) {
    { float h = h0;
#pragma unroll
      for (int g = 0; g < 8; ++g) { float e[8], bb[8]; unpk8(ev0[g], e); unpk8(bv0[g], bb);
#pragma unroll
        for (int r = 0; r < 8; ++r) { h = fmaf(1.f - e[r], h, bb[r]); obuf[(g * 8 + r) * LRU_W + ch] = h; } } }
    { float h = h1;
#pragma unroll
      for (int g = 7; g >= 0; --g) { float e[8], bb[8]; unpk8(ev1[g], e); unpk8(bv1[g], bb);
#pragma unroll
        for (int r = 7; r >= 0; --r) { h = fmaf(1.f - e[r], h, bb[r]); const int tk = g * 8 + r;
          obuf[tk * LRU_W + ch] = (obuf[tk * LRU_W + ch] + h) * bf2f(gbuf[tk * LRU_W + ch]); } } }
  }
  __syncthreads();
  u16* mp = (u16*)(p.ws + WS_MIX) + ((size_t)b * SEQ + c * LCH) * DM + 384;
#pragma unroll 1
  for (int i = 0; i < 8; ++i) { const int tk = wid * 8 + i;
    float v[6]; float s = 0.f;
#pragma unroll
    for (int q = 0; q < 3; ++q) { const f32x2 t2 = *(const f32x2*)(obuf + tk * LRU_W + q * 128 + lane * 2); v[2 * q] = t2.x; v[2 * q + 1] = t2.y; s = fmaf(t2.x, t2.x, s); s = fmaf(t2.y, t2.y, s); }
    s = wave_sum(s);
    const float rs = rsqrtf(s * (1.f / 384.f) + EPS);
#pragma unroll
    for (int q = 0; q < 3; ++q) *(unsigned*)(mp + (size_t)tk * DM + q * 128 + lane * 2) = pk2(v[2 * q] * rs, v[2 * q + 1] * rs);
  }
  __syncthreads();
}

typedef unsigned char u8;
DEVI unsigned q8x4(const float* v, float s) {
  unsigned w = 0;
#pragma unroll
  for (int i = 0; i < 4; ++i) { int q = __float2int_rn(v[i] * s); q = q < -127 ? -127 : (q > 127 ? 127 : q); w |= ((unsigned)q & 255u) << (8 * i); }
  return w;
}
DEVI void peer_xn_pass(const Params& p, int layer, int vb, int nb) {
  const int tid = tidx(), wid = tid >> 6, lane = tid & 63; const u16* xg = (const u16*)(p.ws + WS_XG); const float* gf = p.norm_ffn + layer * DM;
  u8* xq = (u8*)(p.ws + WS_XQ); float* sxp = (float*)(p.ws + WS_SX);
  for (int t = vb * 8 + wid; t < T; t += nb * 8) {
    const u32x4* rp = (const u32x4*)(xg + (size_t)t * DM + lane * 16);
    float v[16]; unpk8(rp[0], v); unpk8(rp[1], v + 8);
    float s = 0.f;
#pragma unroll
    for (int i = 0; i < 16; ++i) s = fmaf(v[i], v[i], s);
    s = wave_sum(s);
    const float rs = rsqrtf(s * (1.f / DM) + EPS);
    float g[16]; ld8(gf + lane * 16, g); ld8(gf + lane * 16 + 8, g + 8);
    float mx = 0.f;
#pragma unroll
    for (int i = 0; i < 16; ++i) { v[i] *= rs * g[i]; mx = fmaxf(mx, fabsf(v[i])); }
    mx = wave_max(mx);
    const float sx = fmaxf(mx, 1e-20f) * (1.f / 127.f), isx = 1.f / sx;
    stwt16n(xq + (size_t)t * DM + lane * 16, (u32x4){q8x4(v, isx), q8x4(v + 4, isx), q8x4(v + 8, isx), q8x4(v + 12, isx)});
    if (lane == 0) sxp[t] = sx;
  }
}

DEVI void cvt16(u32x4 w, float* f) {
  f32x2 t;
  t = __builtin_amdgcn_cvt_pk_f32_fp8((int)w.x, false); f[0] = t.x; f[1] = t.y; t = __builtin_amdgcn_cvt_pk_f32_fp8((int)w.x, true); f[2] = t.x; f[3] = t.y;
  t = __builtin_amdgcn_cvt_pk_f32_fp8((int)w.y, false); f[4] = t.x; f[5] = t.y; t = __builtin_amdgcn_cvt_pk_f32_fp8((int)w.y, true); f[6] = t.x; f[7] = t.y;
  t = __builtin_amdgcn_cvt_pk_f32_fp8((int)w.z, false); f[8] = t.x; f[9] = t.y; t = __builtin_amdgcn_cvt_pk_f32_fp8((int)w.z, true); f[10] = t.x; f[11] = t.y;
  t = __builtin_amdgcn_cvt_pk_f32_fp8((int)w.w, false); f[12] = t.x; f[13] = t.y; t = __builtin_amdgcn_cvt_pk_f32_fp8((int)w.w, true); f[14] = t.x; f[15] = t.y;
}
DEVI unsigned enc4(float a, float b, float c, float d) { int w = 0; w = __builtin_amdgcn_cvt_pk_fp8_f32(a, b, w, false); w = __builtin_amdgcn_cvt_pk_fp8_f32(c, d, w, true); return (unsigned)w; }
#define EIDX_AT(i0, i1, i) ((((i) < 8 ? (i0) : (i1))[((i) & 7) >> 1] >> (((i) & 1) * 16)) & 0xffffu)
template <int CTRL> DEVI float dppf(float v) { return __uint_as_float((unsigned)__builtin_amdgcn_mov_dpp((int)__float_as_uint(v), CTRL, 0xF, 0xF, true)); }
DEVI f32x2 fma2(f32x2 a, f32x2 b, f32x2 c) { return __builtin_elementwise_fma(a, b, c); }
DEVI f32x2 cvt8lo(unsigned w) { return __builtin_amdgcn_cvt_pk_f32_fp8((int)w, false); }
DEVI f32x2 cvt8hi(unsigned w) { return __builtin_amdgcn_cvt_pk_f32_fp8((int)w, true); }
struct PeerIdx { u32x4 i0, i1; };
template <bool AXPY>
DEVI void peer_slice_phase(const Params& p, int s, int tbeg, int tstep, int lane, const float* xin, float* xout, bool last) {
  const int r = lane >> 3, j = lane & 7;
  const u8* eidxB = (const u8*)(p.ws + WS_EIDX); const unsigned eoff = (unsigned)r * 32u;
  const u8* TBs = (const u8*)(p.ws + (AXPY ? WS_VB : WS_UB)) + (size_t)s * NEXP * 128; const unsigned toff = 16u * (unsigned)j;
  const u8* xnB = (const u8*)(p.ws + WS_XQ) + s * 128; const unsigned xoff = 16u * (unsigned)j;
  const float* sxp = (const float*)(p.ws + WS_SX);
  const u8* ccB = (const u8*)(p.ws + WS_CC); const unsigned coff = (unsigned)r * 16u;
  const float* csp = (const float*)(p.ws + WS_CS);
  const u16* xgB = (const u16*)(p.ws + WS_XG) + s * 128; const unsigned xgoff = 16u * (unsigned)(lane & 7) + ((lane >> 5) & 1) * 8u + ((lane >> 4) & 1) * 4u;
  u16* pdB = (u16*)(p.ws + WS_PD) + (size_t)s * T * 128;
  const int ntok = (T - tbeg + tstep - 1) / tstep;
  if (ntok <= 0) return;
#define TOK(k) (tbeg + ((k) < ntok ? (k) : ntok - 1) * tstep)
#define LD_IDX(dst, k) do { const u8* b_ = eidxB + (size_t)TOK(k) * 256; dst.i0 = *(const u32x4*)(b_ + eoff); dst.i1 = *(const u32x4*)(b_ + eoff + 16u); } while (0)
#define LD_HALF(H, ix, h) do { _Pragma("unroll") for (int i = 0; i < 8; ++i) H[i] = *(const u32x4*)(TBs + (EIDX_AT(ix.i0, ix.i1, 8 * (h) + i) * 128u + toff)); } while (0)
#define LD_AUX(a, k) do { if (AXPY) { const u8* b_ = ccB + (size_t)TOK(k) * 128; a[0] = *(const u32x4*)(b_ + coff); a[1].x = __float_as_uint(csp[TOK(k)]); \
      { const u32x2 xr_ = *(const u32x2*)(xgB + (size_t)TOK(k) * DM + xgoff); a[1].y = xr_.x; a[1].z = xr_.y; } }        \
    else { const u8* b_ = xnB + (size_t)TOK(k) * DM; a[0] = *(const u32x4*)(b_ + xoff); a[1].x = __float_as_uint(sxp[TOK(k)]); } } while (0)
  PeerIdx I0, I1, I2; u32x4 H0[8], H1[8], H2[8], X0[2], X1[2], X2[2];
  u32x4 xq4 = {0, 0, 0, 0}; float sxk = 0.f; u32x2 xres = {0, 0};
  int acc[16];
#define T_BEGIN(X) do { xq4 = X[0]; sxk = __uint_as_float(X[1].x); if (AXPY) { xres.x = X[1].y; xres.y = X[1].z; } } while (0)
#define COMP(H, h, k) do { if ((k) < ntok) { \
    if (!AXPY) { u16* o_ = pdB + (size_t)(tbeg + (k) * tstep) * 128 + 64 * (h) + r * 8;        \
      float res[8]; \
      _Pragma("unroll") for (int ii = 0; ii < 8; ++ii) { const u32x4 w_ = H[ii]; \
          int a_ = __builtin_amdgcn_sdot4((int)w_.x, (int)xq4.x, 0, false); a_ = __builtin_amdgcn_sdot4((int)w_.y, (int)xq4.y, a_, false); \
          a_ = __builtin_amdgcn_sdot4((int)w_.z, (int)xq4.z, a_, false); a_ = __builtin_amdgcn_sdot4((int)w_.w, (int)xq4.w, a_, false); \
          a_ += __builtin_amdgcn_mov_dpp(a_, 0xB1, 0xF, 0xF, true); a_ += __builtin_amdgcn_mov_dpp(a_, 0x4E, 0xF, 0xF, true); a_ += __builtin_amdgcn_mov_dpp(a_, 0x141, 0xF, 0xF, true); \
          res[ii] = (float)a_ * sxk; } \
        \
      { const unsigned p01 = pk2(res[0], res[1]), p23 = pk2(res[2], res[3]), p45 = pk2(res[4], res[5]), p67 = pk2(res[6], res[7]); \
        const unsigned lo_ = (j & 1) ? p23 : p01, hi_ = (j & 1) ? p67 : p45; const unsigned sel_ = (j & 2) ? hi_ : lo_; \
        if (j < 4) *(unsigned*)(o_ + 2 * j) = sel_; } } \
    else { _Pragma("unroll") for (int gi = 0; gi < 2; ++gi) { const int cv_ = (int)xq4[2 * (h) + gi];        \
        _Pragma("unroll") for (int dc = 0; dc < 4; ++dc) { const unsigned A_ = H[4 * gi][dc], B_ = H[4 * gi + 1][dc], C_ = H[4 * gi + 2][dc], D_ = H[4 * gi + 3][dc]; \
            \
          const unsigned X_ = __builtin_amdgcn_perm(B_, A_, 0x05010400u), Y_ = __builtin_amdgcn_perm(B_, A_, 0x07030602u), Z_ = __builtin_amdgcn_perm(D_, C_, 0x05010400u), W_ = __builtin_amdgcn_perm(D_, C_, 0x07030602u); \
          if ((h) == 0 && gi == 0) acc[4 * dc + 0] = dot4_0(__builtin_amdgcn_perm(Z_, X_, 0x05040100u), cv_); else acc[4 * dc + 0] = __builtin_amdgcn_sdot4((int)__builtin_amdgcn_perm(Z_, X_, 0x05040100u), cv_, acc[4 * dc + 0], false); \
          if ((h) == 0 && gi == 0) acc[4 * dc + 1] = dot4_0(__builtin_amdgcn_perm(Z_, X_, 0x07060302u), cv_); else acc[4 * dc + 1] = __builtin_amdgcn_sdot4((int)__builtin_amdgcn_perm(Z_, X_, 0x07060302u), cv_, acc[4 * dc + 1], false); \
          if ((h) == 0 && gi == 0) acc[4 * dc + 2] = dot4_0(__builtin_amdgcn_perm(W_, Y_, 0x05040100u), cv_); else acc[4 * dc + 2] = __builtin_amdgcn_sdot4((int)__builtin_amdgcn_perm(W_, Y_, 0x05040100u), cv_, acc[4 * dc + 2], false); \
          if ((h) == 0 && gi == 0) acc[4 * dc + 3] = dot4_0(__builtin_amdgcn_perm(W_, Y_, 0x07060302u), cv_); else acc[4 * dc + 3] = __builtin_amdgcn_sdot4((int)__builtin_amdgcn_perm(W_, Y_, 0x07060302u), cv_, acc[4 * dc + 3], false); } } } } } while (0)
  auto finalize = [&](int k) {
    if (!AXPY || k >= ntok) return;
    const int t = tbeg + k * tstep;
    int S[8];
    asm volatile("s_nop 1\n\tv_permlane32_swap_b32 %0, %8\n\tv_permlane32_swap_b32 %1, %9\n\tv_permlane32_swap_b32 %2, %10\n\tv_permlane32_swap_b32 %3, %11\n\t"
                 "v_permlane32_swap_b32 %4, %12\n\tv_permlane32_swap_b32 %5, %13\n\tv_permlane32_swap_b32 %6, %14\n\tv_permlane32_swap_b32 %7, %15\n\ts_nop 1"
                 : "+v"(acc[0]), "+v"(acc[1]), "+v"(acc[2]), "+v"(acc[3]), "+v"(acc[4]), "+v"(acc[5]), "+v"(acc[6]), "+v"(acc[7]),
                   "+v"(acc[8]), "+v"(acc[9]), "+v"(acc[10]), "+v"(acc[11]), "+v"(acc[12]), "+v"(acc[13]), "+v"(acc[14]), "+v"(acc[15]));
#pragma unroll
    for (int q = 0; q < 8; ++q) S[q] = acc[q] + acc[q + 8];
    asm volatile("s_nop 1\n\tv_permlane16_swap_b32 %0, %4\n\tv_permlane16_swap_b32 %1, %5\n\tv_permlane16_swap_b32 %2, %6\n\tv_permlane16_swap_b32 %3, %7\n\ts_nop 1"
                 : "+v"(S[0]), "+v"(S[1]), "+v"(S[2]), "+v"(S[3]), "+v"(S[4]), "+v"(S[5]), "+v"(S[6]), "+v"(S[7]));
    int Tq[4];
#pragma unroll
    for (int q = 0; q < 4; ++q) Tq[q] = S[q] + S[q + 4];
    asm volatile("s_nop 1\n\tv_add_u32_dpp %0, %0, %0 row_ror:8 row_mask:0xf bank_mask:0xf\n\tv_add_u32_dpp %1, %1, %1 row_ror:8 row_mask:0xf bank_mask:0xf\n\t"
                 "v_add_u32_dpp %2, %2, %2 row_ror:8 row_mask:0xf bank_mask:0xf\n\tv_add_u32_dpp %3, %3, %3 row_ror:8 row_mask:0xf bank_mask:0xf\n\ts_nop 1"
                 : "+v"(Tq[0]), "+v"(Tq[1]), "+v"(Tq[2]), "+v"(Tq[3]));
    float ss = 0.f;
    if ((lane & 8) == 0) {
      const size_t o = (size_t)t * DM + s * 128 + 16 * j + ((lane >> 5) & 1) * 8 + ((lane >> 4) & 1) * 4;
      u32x2* xgp = (u32x2*)((u16*)(p.ws + WS_XG) + o); const u32x2 xb = xres;
      const f32x4 y = {fmaf((float)Tq[0], sxk, bflo(xb.x)), fmaf((float)Tq[1], sxk, bfhi(xb.x)), fmaf((float)Tq[2], sxk, bflo(xb.y)), fmaf((float)Tq[3], sxk, bfhi(xb.y))};
      *xgp = (u32x2){pk2(y.x, y.y), pk2(y.z, y.w)};
      ss = (y.x * y.x + y.y * y.y) + (y.z * y.z + y.w * y.w);
    }
    ss = wave_sum(ss); if (lane == 0) ((float*)(p.ws + WS_SSQ))[(size_t)t * 8 + s] = ss;
  };
  LD_IDX(I0, 0); LD_IDX(I1, 1); LD_IDX(I2, 2); LD_HALF(H0, I0, 0); LD_HALF(H1, I0, 1); LD_AUX(X0, 0);
#pragma unroll 2
  for (int k = 0; k < ntok; k += 3) {
    LD_HALF(H2, I1, 0); LD_IDX(I0, k + 3); LD_AUX(X1, k + 1);
    T_BEGIN(X0); COMP(H0, 0, k);
    LD_HALF(H0, I1, 1);
    COMP(H1, 1, k); finalize(k);
    LD_HALF(H1, I2, 0); LD_IDX(I1, k + 4); LD_AUX(X2, k + 2);
    T_BEGIN(X1); COMP(H2, 0, k + 1);
    LD_HALF(H2, I2, 1);
    COMP(H0, 1, k + 1); finalize(k + 1);
    LD_HALF(H0, I0, 0); LD_IDX(I2, k + 5); LD_AUX(X0, k + 3);
    T_BEGIN(X2); COMP(H1, 0, k + 2);
    LD_HALF(H1, I0, 1);
    COMP(H2, 1, k + 2); finalize(k + 2);
  }
#undef TOK
#undef LD_IDX
#undef LD_HALF
#undef LD_AUX
#undef T_BEGIN
#undef COMP
}

DEVI void lru_passB(const Params& p, int item, int lane) {
  const int cg = item % 6, b = (item / 6) % NB, d = item / (6 * NB);
  const size_t o = (size_t)(d * NB + b) * NLCH * LRU_W + cg * 64 + lane;
  const float* Pp = (const float*)(p.ws + WS_LP) + o; const float* Hp = (const float*)(p.ws + WS_LH) + o; float* Cp = (float*)(p.ws + WS_LC) + o;
  float h = 0.f;
#pragma unroll 1
  for (int c0 = 0; c0 < NLCH; c0 += 32) {
    float pv[32], hv[32];
#pragma unroll
    for (int i = 0; i < 32; ++i) { const int cc = d ? NLCH - 1 - (c0 + i) : c0 + i; pv[i] = Pp[(size_t)cc * LRU_W]; hv[i] = Hp[(size_t)cc * LRU_W]; }
#pragma unroll
    for (int i = 0; i < 32; ++i) { const int cc = d ? NLCH - 1 - (c0 + i) : c0 + i; Cp[(size_t)cc * LRU_W] = h; h = fmaf(pv[i], h, hv[i]); }
  }
}

DEVI void swa_item(const Params& p, int layer, int item, char* lds) {
  const int tid = tidx(), wid = tid >> 6, lane = tid & 63, r32 = lane & 31, hi = lane >> 5;
  const int g = item & 1, n = (item >> 1) & 63, b = item >> 7;
  const int hq = 2 * g + (wid >> 2), qrow = n * 128 + (wid & 3) * 32;
  const u16* proj = (const u16*)(p.ws + WS_R1);
  const u16* Qw = proj + (size_t)(b * SEQ + qrow + r32) * INWP + PC_SQ + hq * 64 + hi * 8;
  const u16* Kh = proj + (size_t)(b * SEQ) * INWP + PC_SK + g * 64;
  const u16* Vh = proj + (size_t)(b * SEQ) * INWP + PC_SV + g * 64;
  const int kt0 = (2 * n - 2) < 0 ? 0 : (2 * n - 2), kt1 = (2 * n + 4) > SEQ / 64 ? SEQ / 64 : (2 * n + 4);
  const float sink = p.swa_sink[layer * 4 + hq];
  u16* Ow = (u16*)(p.ws + WS_MIX) + (size_t)(b * SEQ + qrow) * DM + 768 + hq * 64;
  attn_body<64, true>(Qw, Kh, INWP, Vh, INWP, kt0, kt1 - kt0, sink * 1.4426950408889634f, 1.f, qrow + r32, Ow, lds);
}
DEVI void mla_item(const Params& p, int pair, int qb, char* lds) {
  const int tid = tidx(), wid = tid >> 6, lane = tid & 63, r32 = lane & 31, hi = lane >> 5;
  const int b = pair / MLA_H, h = pair - b * MLA_H;
  const u16* Qw = (const u16*)(p.ws + WS_QM) + ((size_t)pair * SEQ + qb * 256 + wid * 32 + r32) * MLA_QK + hi * 8;
  const u16* Kh = (const u16*)(p.ws + WS_KM) + (size_t)pair * SEQ * MLA_QK;
  const u16* Vh = (const u16*)(p.ws + WS_VM) + (size_t)pair * SEQ * MLA_V;
  u16* Ow = (u16*)(p.ws + WS_MIX) + (size_t)(b * SEQ + qb * 256 + wid * 32) * DM + h * 64;
  attn_mla(Qw, Kh, Vh, Ow, lds, (float)p.pos[b * SEQ + qb * 256 + wid * 32 + r32]);
}


namespace pg8 {
#define PG8_LAS __attribute__((address_space(3)))
constexpr int BM = 256, BK = 64, HALF = 128, HTB = HALF * BK * 2, NXCD = 8, WGM = 8;
DEVI int lds_byte(int r, int c) { const int st = (r >> 4) * 2 + (c >> 5), rr = r & 15, cc = c & 31, ob = rr * 64 + cc * 2; return st * 1024 + (ob ^ (((ob >> 9) & 1) << 5)); }
DEVI void stage_rc(int b, int& R, int& C) { const int st = b / 1024, sb = b % 1024, swz = sb ^ (((sb >> 9) & 1) << 5); R = (st >> 1) * 16 + swz / 64; C = (st & 1) * 32 + (swz % 64) / 2; }
DEVI int perm32(int rho) { const int n = rho >> 4, i = rho & 15; return 8 * (i >> 2) + 4 * n + (i & 3); }
struct Unit { int pm, pn; };
struct Gemm { const u16* A; const u16* Bt; int M, N, K, lda, ldb; };
struct StaticOrder {
  int nM, nN, nwg, G, c;
  DEVI void init(int M, int N, int G_, int c_) { nM = M / BM; nN = N / BM; nwg = nM * nN; G = G_; c = c_; }
  DEVI bool next(int i, Unit& u) const {
    const long L = (long)i * G + c; if (L >= nwg) return false;
    int wgid = (int)L; { const int q = nwg / NXCD, r = nwg % NXCD, xcd = wgid % NXCD, off = wgid / NXCD; wgid = (xcd < r ? xcd * (q + 1) : r * (q + 1) + (xcd - r) * q) + off; }
    const int nig = WGM * nN, gid = wgid / nig, fm = gid * WGM, gsz = (nM - fm) < WGM ? (nM - fm) : WGM;
    u.pm = fm + ((wgid % nig) % gsz); u.pn = (wgid % nig) / gsz; return true;
  }
};
template <class Epi>
DEVI void gemm_phase(PG8_LAS unsigned char* lds, const Gemm g, const StaticOrder& S, const Epi& E) {
  const int tid = tidx(), wid = __builtin_amdgcn_readfirstlane(tid >> 6), lane = tid & 63, wr = wid >> 2, wc = wid & 3, fr = lane & 15, fq = lane >> 4;
  const int K = g.K; int nt = K / BK; asm volatile("" : "+s"(nt));
  unsigned voffA[2], voffB[2];
#pragma unroll
  for (int i = 0; i < 2; ++i) { int R, C; stage_rc(tid * 16 + i * 8192, R, C); const int Rb = (R & ~31) + perm32(R & 31);
    voffA[i] = (unsigned)(R * g.lda + C) * 2u; voffB[i] = (unsigned)(Rb * g.ldb + C) * 2u; }
  const size_t kstep = (size_t)(BK * 2), hstepA = (size_t)HALF * g.lda * 2, hstepB = (size_t)HALF * g.ldb * 2, tstepA = 2 * hstepA, tstepB = 2 * hstepB;
  const unsigned ldsw = (unsigned)wid * 1024u;
  const int aoff = lds_byte(wr * 64 + fr, fq * 8), boff = lds_byte(wc * 32 + fr, fq * 8);
#define PG8_SA(b, h) (((b) * 2 + (h)) * HTB)
#define PG8_SB(b, h) ((4 + (b) * 2 + (h)) * HTB)
#define PG8_STAGE(bufoff, gbase, voff) do { _Pragma("unroll") for (int _i = 0; _i < 2; ++_i) \
    __builtin_amdgcn_global_load_lds((const unsigned*)((const char*)(gbase) + (voff)[_i]), (PG8_LAS unsigned*)(lds + (bufoff) + ldsw + _i * 8192), 16, 0, 0); } while (0)
#define PG8_LDA(dst, b, h) do { _Pragma("unroll") for (int m = 0; m < 4; ++m) _Pragma("unroll") for (int k = 0; k < 2; ++k) dst[m][k] = *(const PG8_LAS bf16x8*)(lds + PG8_SA(b, h) + aoff + m * 2048 + k * 1024); } while (0)
#define PG8_LDB(dst, b, h) do { _Pragma("unroll") for (int n = 0; n < 2; ++n) _Pragma("unroll") for (int k = 0; k < 2; ++k) dst[n][k] = *(const PG8_LAS bf16x8*)(lds + PG8_SB(b, h) + boff + n * 2048 + k * 1024); } while (0)
#define PG8_MMA(ai, bj, At, Bt) do { __builtin_amdgcn_s_setprio(1); _Pragma("unroll") for (int m = 0; m < 4; ++m) _Pragma("unroll") for (int n = 0; n < 2; ++n) _Pragma("unroll") for (int k = 0; k < 2; ++k) \
    acc[ai][bj][m][n] = __builtin_amdgcn_mfma_f32_16x16x32_bf16(Bt[n][k], At[m][k], acc[ai][bj][m][n], 0, 0, 0); __builtin_amdgcn_s_setprio(0); } while (0)
#define PG8_WAIT_V(n) asm volatile("s_waitcnt vmcnt(" #n ")" ::: "memory")
#define PG8_WAIT_L(n) asm volatile("s_waitcnt lgkmcnt(" #n ")" ::: "memory")
#define PG8_BAR __builtin_amdgcn_s_barrier()
#define PG8_SCHED __builtin_amdgcn_sched_barrier(0)
  Unit cur, nxt; int ui = 0;
  if (!S.next(0, cur)) return;
  f32x4 acc[2][2][4][2];
#pragma unroll
  for (int a = 0; a < 2; ++a)
#pragma unroll
    for (int b = 0; b < 2; ++b)
#pragma unroll
      for (int m = 0; m < 4; ++m)
#pragma unroll
        for (int n = 0; n < 2; ++n) acc[a][b][m][n] = (f32x4){0.f, 0.f, 0.f, 0.f};
  bf16x8 At[4][2], B0[2][2], B1[2][2];
  const char* cA = (const char*)g.A + (size_t)cur.pm * tstepA; const char* cB = (const char*)g.Bt + (size_t)cur.pn * tstepB;
  PG8_STAGE(PG8_SB(0, 0), cB, voffB); PG8_STAGE(PG8_SB(0, 1), cB + hstepB, voffB); PG8_STAGE(PG8_SA(0, 0), cA, voffA); PG8_STAGE(PG8_SA(0, 1), cA + hstepA, voffA);
  if (wr == 1) PG8_BAR;
  PG8_WAIT_V(2); PG8_BAR;
  PG8_STAGE(PG8_SB(1, 0), cB + kstep, voffB); PG8_STAGE(PG8_SA(1, 0), cA + kstep, voffA); PG8_STAGE(PG8_SB(1, 1), cB + hstepB + kstep, voffB);
  PG8_WAIT_V(6); PG8_BAR;
  for (;;) {
    const bool has_next = S.next(ui + 1, nxt);
    const char* nA = has_next ? (const char*)g.A + (size_t)nxt.pm * tstepA : cA; const char* nB = has_next ? (const char*)g.Bt + (size_t)nxt.pn * tstepB : cB;
#pragma unroll 1
    for (int t = 0; t < nt; t += 2) {
      const bool last = (t == nt - 2);
      const char* a1 = cA + (size_t)(t + 1) * kstep;
      const char* a2 = last ? nA : cA + (size_t)(t + 2) * kstep; const char* b2 = last ? nB : cB + (size_t)(t + 2) * kstep;
      const char* a3 = a2 + kstep; const char* b3 = b2 + kstep;
      PG8_LDB(B0, 0, 0); PG8_LDB(B1, 0, 1); PG8_SCHED; PG8_LDA(At, 0, 0); PG8_STAGE(PG8_SA(1, 1), a1 + hstepA, voffA);
      PG8_WAIT_V(8); PG8_WAIT_L(0); PG8_BAR; PG8_MMA(0, 0, At, B0); PG8_MMA(0, 1, At, B1); PG8_BAR; PG8_SCHED;
      PG8_LDA(At, 0, 1); PG8_STAGE(PG8_SB(0, 0), b2, voffB); PG8_STAGE(PG8_SB(0, 1), b2 + hstepB, voffB); PG8_STAGE(PG8_SA(0, 0), a2, voffA);
      PG8_WAIT_V(8); PG8_WAIT_L(0); PG8_BAR; PG8_MMA(1, 0, At, B0); PG8_MMA(1, 1, At, B1); PG8_BAR; PG8_SCHED;
      PG8_LDB(B0, 1, 0); PG8_LDB(B1, 1, 1); PG8_SCHED; PG8_LDA(At, 1, 0); PG8_STAGE(PG8_SA(0, 1), a2 + hstepA, voffA);
      PG8_WAIT_V(8); PG8_WAIT_L(0); PG8_BAR; PG8_MMA(0, 0, At, B0); PG8_MMA(0, 1, At, B1); PG8_BAR; PG8_SCHED;
      PG8_LDA(At, 1, 1); PG8_STAGE(PG8_SB(1, 0), b3, voffB); PG8_STAGE(PG8_SB(1, 1), b3 + hstepB, voffB); PG8_STAGE(PG8_SA(1, 0), a3, voffA);
      PG8_WAIT_V(8); PG8_WAIT_L(0); PG8_BAR; PG8_MMA(1, 0, At, B0); PG8_MMA(1, 1, At, B1); PG8_BAR; PG8_SCHED;
    }
    if (wr == 0) PG8_BAR;
    E(acc, cur, wr, wc, fr, fq);
    if (!has_next) break;
#pragma unroll
    for (int a = 0; a < 2; ++a)
#pragma unroll
      for (int b = 0; b < 2; ++b)
#pragma unroll
        for (int m = 0; m < 4; ++m)
#pragma unroll
          for (int n = 0; n < 2; ++n) acc[a][b][m][n] = (f32x4){0.f, 0.f, 0.f, 0.f};
    cur = nxt; cA = nA; cB = nB; ++ui;
    if (wr == 1) PG8_BAR;
  }
  PG8_WAIT_V(0);
  PG8_BAR;
#undef PG8_SA
#undef PG8_SB
#undef PG8_STAGE
#undef PG8_LDA
#undef PG8_LDB
#undef PG8_MMA
#undef PG8_WAIT_V
#undef PG8_WAIT_L
#undef PG8_BAR
#undef PG8_SCHED
}

DEVI float rs_from8(const float* s) { const f32x4 a = *(const f32x4*)s, b = *(const f32x4*)(s + 4); return rsqrtf((((a.x + a.y) + (a.z + a.w)) + ((b.x + b.y) + (b.z + b.w))) * (1.f / DM) + EPS); }
struct EpiProj { u16* proj; const int* pos; const float* ssq8; float* ssqq; float* ssqkv;
  DEVI void operator()(const f32x4 (&acc)[2][2][4][2], const Unit& u, int wr, int wc, int fr, int fq) const {
    const int row0 = u.pm * BM + wr * 64 + fr, col0 = u.pn * BM + wc * 32 + 8 * fq;
#pragma unroll
    for (int ai = 0; ai < 2; ++ai)
#pragma unroll
      for (int m = 0; m < 4; ++m) { const int row = row0 + ai * HALF + m * 16; const float rs = rs_from8(ssq8 + (size_t)row * 8); const float posf = (float)pos[row];
        float sq0 = 0.f, sq1 = 0.f;
#pragma unroll
        for (int bj = 0; bj < 2; ++bj) { const int gcol = col0 + bj * HALF;
          float v[8]; { const f32x4 a = acc[ai][bj][m][0] * rs, b = acc[ai][bj][m][1] * rs; v[0] = a.x; v[1] = a.y; v[2] = a.z; v[3] = a.w; v[4] = b.x; v[5] = b.y; v[6] = b.z; v[7] = b.w; }
          if (u.pn <= 1) { float s = 0.f;
#pragma unroll
            for (int q = 0; q < 8; ++q) s = fmaf(v[q], v[q], s);
            if (bj == 0) sq0 = s; else sq1 = s; }
          const bool r64 = gcol >= PC_SQ && gcol < PC_SV, r32g = gcol >= PC_KR && gcol < PC_KR + 32;
          if (gcol >= PC_SQ && gcol < PC_SK) {
#pragma unroll
            for (int q = 0; q < 8; ++q) v[q] *= 0.18033688f; }
          if (r64 || r32g) {
#pragma unroll
            for (int q = 0; q < 4; ++q) { const int f = r64 ? (((gcol + 2 * q) & 63) >> 1) : 2 * (((gcol + 2 * q) & 31) >> 1); float sn, cs; rope_sc(posf, f, sn, cs);
              const float x1 = v[2 * q], x2 = v[2 * q + 1]; v[2 * q] = x1 * cs - x2 * sn; v[2 * q + 1] = x2 * cs + x1 * sn; } }
          stwt16(proj + (size_t)row * INWP + gcol, pk8(v)); }
        if (u.pn <= 1) { float s = u.pn == 0 ? sq0 + sq1 : sq0; s += __shfl_xor(s, 16); s += __shfl_xor(s, 32);
          if (fq == 0) (u.pn == 0 ? ssqq : ssqkv)[(size_t)row * 4 + wc] = s; } }
  }
};
struct EpiQ2 { u16* qm; const float* ssqq;
  DEVI void operator()(const f32x4 (&acc)[2][2][4][2], const Unit& u, int wr, int wc, int fr, int fq) const {
    const int b = (u.pm * BM) >> 13, s0 = (u.pm * BM) & (SEQ - 1), lrow = wr * 64 + fr;
    const float* sq = ssqq + (size_t)(u.pm * BM) * 4 + lrow * 4;
    float rs[2][4];
#pragma unroll
    for (int ai = 0; ai < 2; ++ai)
#pragma unroll
      for (int m = 0; m < 4; ++m) { const f32x4 sp = *(const f32x4*)(sq + (ai * HALF + m * 16) * 4); rs[ai][m] = 0.14724444f * rsqrtf(((sp.x + sp.y) + (sp.z + sp.w)) * (1.f / 256.f) + EPS); }
#pragma unroll
    for (int bj = 0; bj < 2; ++bj) { const int gcol = u.pn * BM + bj * HALF + wc * 32 + 8 * fq;
      if (gcol < 576) { const int head = (gcol * 683) >> 16, j0 = gcol - head * 96;
        u16* base = qm + ((size_t)(b * MLA_H + head) * SEQ + s0) * MLA_QK + (unsigned)(lrow * MLA_QK + j0);
#pragma unroll
        for (int ai = 0; ai < 2; ++ai)
#pragma unroll
          for (int m = 0; m < 4; ++m) { const float r = rs[ai][m];
            float v[8]; { const f32x4 a = acc[ai][bj][m][0] * r, bb = acc[ai][bj][m][1] * r; v[0] = a.x; v[1] = a.y; v[2] = a.z; v[3] = a.w; v[4] = bb.x; v[5] = bb.y; v[6] = bb.z; v[7] = bb.w; }
            stwt16(base + (ai * HALF + m * 16) * MLA_QK, pk8(v)); } } }
  }
};
struct EpiKV2 { u16* km; u16* vm; const float* ssqkv;
  DEVI void operator()(const f32x4 (&acc)[2][2][4][2], const Unit& u, int wr, int wc, int fr, int fq) const {
    const int b = (u.pm * BM) >> 13, s0 = (u.pm * BM) & (SEQ - 1), lrow = wr * 64 + fr;
    const float* sq = ssqkv + (size_t)(u.pm * BM) * 4 + lrow * 4;
    float rs[2][4];
#pragma unroll
    for (int ai = 0; ai < 2; ++ai)
#pragma unroll
      for (int m = 0; m < 4; ++m) { const f32x4 sp = *(const f32x4*)(sq + (ai * HALF + m * 16) * 4); rs[ai][m] = rsqrtf(((sp.x + sp.y) + (sp.z + sp.w)) * (1.f / 128.f) + EPS); }
#pragma unroll
    for (int bj = 0; bj < 2; ++bj) { const int head = u.pn * 2 + bj, c = wc * 32 + 8 * fq;
      const size_t tok0 = (size_t)(b * MLA_H + head) * SEQ + s0;
      u16* base = c < 64 ? km + tok0 * MLA_QK + (unsigned)(lrow * MLA_QK + c) : vm + tok0 * MLA_V + (unsigned)(lrow * MLA_V + (c - 64));
      const int ld = c < 64 ? MLA_QK : MLA_V;
#pragma unroll
      for (int ai = 0; ai < 2; ++ai)
#pragma unroll
        for (int m = 0; m < 4; ++m) { const float r = rs[ai][m];
          float v[8]; { const f32x4 a = acc[ai][bj][m][0] * r, bb = acc[ai][bj][m][1] * r; v[0] = a.x; v[1] = a.y; v[2] = a.z; v[3] = a.w; v[4] = bb.x; v[5] = bb.y; v[6] = bb.z; v[7] = bb.w; }
          stwt16(base + (ai * HALF + m * 16) * ld, pk8(v)); } }
  }
};
struct EpiPQ { u16* O; const float* ssq16;
  DEVI void operator()(const f32x4 (&acc)[2][2][4][2], const Unit& u, int wr, int wc, int fr, int fq) const {
    const int row0 = u.pm * BM + wr * 64 + fr, col0 = u.pn * BM + wc * 32 + 8 * fq;
#pragma unroll
    for (int ai = 0; ai < 2; ++ai)
#pragma unroll
      for (int m = 0; m < 4; ++m) { const int row = row0 + ai * HALF + m * 16;
        const f32x4* sp = (const f32x4*)(ssq16 + (size_t)row * 16); const f32x4 s4 = (sp[0] + sp[1]) + (sp[2] + sp[3]);
        const float rs = rsqrtf(((s4.x + s4.y) + (s4.z + s4.w)) * (1.f / DM) + EPS);
#pragma unroll
        for (int bj = 0; bj < 2; ++bj) { float v[8]; { const f32x4 a = acc[ai][bj][m][0] * rs, b = acc[ai][bj][m][1] * rs; v[0] = a.x; v[1] = a.y; v[2] = a.z; v[3] = a.w; v[4] = b.x; v[5] = b.y; v[6] = b.z; v[7] = b.w; }
          stwt16(O + (size_t)row * 2048 + col0 + bj * HALF, pk8(v)); } }
  }
};
struct EpiRes { u16* xg; float* ssq16;
  DEVI void operator()(const f32x4 (&acc)[2][2][4][2], const Unit& u, int wr, int wc, int fr, int fq) const {
    const int row0 = u.pm * BM + wr * 64 + fr, col0 = u.pn * BM + wc * 32 + 8 * fq;
#pragma unroll
    for (int ai = 0; ai < 2; ++ai)
#pragma unroll
      for (int m = 0; m < 4; ++m) { const int row = row0 + ai * HALF + m * 16; float ss = 0.f;
#pragma unroll
        for (int bj = 0; bj < 2; ++bj) { const size_t o = (size_t)row * DM + col0 + bj * HALF;
          float x[8]; unpk8(*(const u32x4*)(xg + o), x);
          const f32x4 a = acc[ai][bj][m][0], b = acc[ai][bj][m][1];
          x[0] += a.x; x[1] += a.y; x[2] += a.z; x[3] += a.w; x[4] += b.x; x[5] += b.y; x[6] += b.z; x[7] += b.w;
#pragma unroll
          for (int q = 0; q < 8; ++q) ss = fmaf(x[q], x[q], ss);
          stwt16(xg + o, pk8(x)); }
        ss += __shfl_xor(ss, 16); ss += __shfl_xor(ss, 32);
        if (fq == 0) ssq16[(size_t)row * 16 + u.pn * 4 + wc] = ss; }
  }
};
}


DEVI void lru_gate_item(const Params& p, int l, int mt, int n, char* lds) {
  const int tid = tidx(), lane = tid & 63, wid = tid >> 6, wm = wid >> 1, wn = wid & 1, r32 = lane & 31, hi = lane >> 5;
  const int srow = tid >> 3, sc = tid & 7, m0 = mt * 256;
  const u16* PROJ = (const u16*)(p.ws + WS_R1);
  GemmDesc g{}; g.proj = PROJ; g.cw = p.conv_w + l * 4 * LRU_W; g.cb = p.conv_b + l * LRU_W; g.ch0 = n * 64;
  char* Ab = lds; char* Bb = lds + 32768;
  { bf16x8 ar[4], br[4];
#pragma unroll
    for (int i = 0; i < 4; ++i) ar[i] = load_a<1>(g, m0 + srow + 64 * i, sc * 8);
    const u16* W = (const u16*)(p.ws + WS_WLRU) + (size_t)((l * 6 + n) * 2) * 128 * 64;
#pragma unroll
    for (int i = 0; i < 4; ++i) br[i] = *(const bf16x8*)(W + (size_t)(srow + 64 * i) * 64 + sc * 8);
#pragma unroll
    for (int i = 0; i < 4; ++i) { *(bf16x8*)(Ab + swz(srow + 64 * i, sc)) = ar[i]; *(bf16x8*)(Bb + (i >> 1) * 16384 + swz(srow + 64 * (i & 1), sc)) = br[i]; } }
  __syncthreads();
  bf16x8 a[2][4];
#pragma unroll
  for (int t = 0; t < 2; ++t)
#pragma unroll
    for (int k = 0; k < 4; ++k) a[t][k] = *(const bf16x8*)(Ab + swz(wm * 64 + t * 32 + r32, k * 2 + hi));
  const int jl = 32 * wn + r32, ch = n * 64 + jl;
  float xf[2][16];
#pragma unroll
  for (int t = 0; t < 2; ++t)
#pragma unroll
    for (int r = 0; r < 16; ++r) { const int row = wm * 64 + t * 32 + crow(r, hi); xf[t][r] = bf2f(*(const u16*)(Ab + swz(row, jl >> 3) + (jl & 7) * 2)); }
  const int bidx = m0 >> 13, s0 = (m0 & (SEQ - 1)) + wm * 64;
#pragma unroll
  for (int d = 0; d < 2; ++d) {
    f32x16 acc[2][2] = {{f32x16{}, f32x16{}}, {f32x16{}, f32x16{}}};
#pragma unroll
    for (int k = 0; k < 4; ++k) { bf16x8 b[2];
#pragma unroll
      for (int q = 0; q < 2; ++q) b[q] = *(const bf16x8*)(Bb + d * 16384 + swz(wn * 64 + q * 32 + r32, k * 2 + hi));
#pragma unroll
      for (int t = 0; t < 2; ++t)
#pragma unroll
        for (int q = 0; q < 2; ++q) acc[t][q] = __builtin_amdgcn_mfma_f32_32x32x16_bf16(a[t][k], b[q], acc[t][q], 0, 0, 0); }
    const float bav = p.lru_ba[((l * 2 + d) * 6 + n) * 64 + jl], bxv = p.lru_bx[((l * 2 + d) * 6 + n) * 64 + jl];
    const float cdec2 = -8.f * 1.4426950408889634f * log1pf(__expf(-p.lru_lambda[(l * 2 + d) * LRU_W + ch]));
    u16* le = (u16*)(p.ws + WS_LE); u16* lb = (u16*)(p.ws + WS_LB);
    float runP[2][4], runH[2][4];
#pragma unroll
    for (int t = 0; t < 2; ++t)
#pragma unroll
      for (int rr = 0; rr < 4; ++rr) {
        float ev[4], bv[4];
#pragma unroll
        for (int q = 0; q < 4; ++q) { const int r = rr * 4 + q;
          const float rg = __builtin_amdgcn_rcpf(1.f + __builtin_amdgcn_exp2f(-1.4426950408889634f * (acc[t][0][r] + bav)));
          const float ig = __builtin_amdgcn_rcpf(1.f + __builtin_amdgcn_exp2f(-1.4426950408889634f * (acc[t][1][r] + bxv)));
          const float aa = __builtin_amdgcn_exp2f(cdec2 * rg), e = 1.f - aa; ev[q] = e; bv[q] = __builtin_amdgcn_sqrtf(e * (2.f - e)) * ig * xf[t][r]; }
        const size_t o = (((size_t)(d * NB + bidx) * (SEQ / 8) + ((s0 + 32 * t + 8 * rr) >> 3)) * LRU_W + ch) * 8 + 4 * hi;
        const u32x2 ew = {pk2(ev[0], ev[1]), pk2(ev[2], ev[3])}, bw = {pk2(bv[0], bv[1]), pk2(bv[2], bv[3])};
        *(u32x2*)(le + o) = ew; *(u32x2*)(lb + o) = bw;
        const float a0 = 1.f - bflo(ew.x), a1 = 1.f - bfhi(ew.x), a2 = 1.f - bflo(ew.y), a3 = 1.f - bfhi(ew.y);
        const float b0 = bflo(bw.x), b1 = bfhi(bw.x), b2 = bflo(bw.y), b3 = bfhi(bw.y);
        if (d == 0) { runP[t][rr] = (a0 * a1) * (a2 * a3); runH[t][rr] = fmaf(a3, fmaf(a2, fmaf(a1, b0, b1), b2), b3); }
        else { runP[t][rr] = (a0 * a1) * (a2 * a3); runH[t][rr] = fmaf(a0, fmaf(a1, fmaf(a2, b3, b2), b1), b0); } }
    { float Pc = 1.f, Hc = 0.f;
#pragma unroll
      for (int i = 0; i < 8; ++i) { const int ii = d == 0 ? i : 7 - i, t = ii >> 2, rr = ii & 3;
        auto rp = __builtin_amdgcn_permlane32_swap(__float_as_uint(runP[t][rr]), __float_as_uint(runP[t][rr]), false, false);
        auto rh = __builtin_amdgcn_permlane32_swap(__float_as_uint(runH[t][rr]), __float_as_uint(runH[t][rr]), false, false);
        const float P0 = __uint_as_float(rp[0]), P1 = __uint_as_float(rp[1]), H0 = __uint_as_float(rh[0]), H1 = __uint_as_float(rh[1]);
        if (d == 0) { Hc = fmaf(P0, Hc, H0); Pc *= P0; Hc = fmaf(P1, Hc, H1); Pc *= P1; }
        else { Hc = fmaf(P1, Hc, H1); Pc *= P1; Hc = fmaf(P0, Hc, H0); Pc *= P0; } }
      if (hi == 0) { const size_t o = ((size_t)(d * NB + bidx) * NLCH + (s0 >> 6)) * LRU_W + ch;
        ((float*)(p.ws + WS_LP))[o] = Pc; ((float*)(p.ws + WS_LH))[o] = Hc; } }
  }
  __syncthreads();
}


DEVI void sort16_desc(float (&v)[16]) {
#pragma unroll
  for (int k = 2; k <= 16; k <<= 1)
#pragma unroll
    for (int j = k >> 1; j > 0; j >>= 1)
#pragma unroll
      for (int i = 0; i < 16; ++i) { const int l = i ^ j; if (l > i) { const float a = v[i], b = v[l]; const bool desc = (i & k) == 0;
          v[i] = desc ? fmaxf(a, b) : fminf(a, b); v[l] = desc ? fminf(a, b) : fmaxf(a, b); } }
}
DEVI void merge16_desc(float (&l)[16], const float (&s)[16]) {
#pragma unroll
  for (int i = 0; i < 16; ++i) l[i] = fmaxf(l[i], s[15 - i]);
#pragma unroll
  for (int st = 8; st >= 1; st >>= 1)
#pragma unroll
    for (int i = 0; i < 16; ++i) if ((i & st) == 0) ce_desc(l[i], l[i + st]);
}
DEVI void pair_merge16(float (&l)[16]) {
  float o[16];
#pragma unroll
  for (int i = 0; i < 16; ++i) o[i] = __shfl_xor(l[i], 1);
  merge16_desc(l, o);
}
DEVI void top16_from_C(const float* C, int row, int part, float (&l)[16]) {
#pragma unroll
  for (int i = 0; i < 16; ++i) l[i] = -3.0e38f;
#pragma unroll 1
  for (int bt = 0; bt < 4; ++bt) { float s[16];
#pragma unroll
    for (int i = 0; i < 16; ++i) { const int col = part * 64 + ((bt * 16 + i + row) & 63);
      s[i] = __uint_as_float((__float_as_uint(C[row * CLD + col]) & ~127u) | (unsigned)(127 - col)); }
    sort16_desc(s);
    merge16_desc(l, s); }
  pair_merge16(l);
}
DEVI void peer_route_finish(const Params& p, int mt, int h, const float (&t1)[16], const float (&t2)[16], char* lds) {
  const int tid = tidx(), row = tid >> 1, part = tid & 1, m0 = mt * 256;
  constexpr int CA[50] = {0, 0, 0, 0, 0, 0, 0, 0, 0, 0, 0, 0, 0, 0, 0, 0, 1, 1, 1, 1, 1, 1, 1, 1, 2, 2, 2, 2, 2, 3, 3, 3, 3, 4, 4, 4, 5, 5, 6, 6, 7, 7, 8, 9, 10, 11, 12, 13, 14, 15};
  constexpr int CB[50] = {0, 1, 2, 3, 4, 5, 6, 7, 8, 9, 10, 11, 12, 13, 14, 15, 0, 1, 2, 3, 4, 5, 6, 7, 0, 1, 2, 3, 4, 0, 1, 2, 3, 0, 1, 2, 0, 1, 0, 1, 0, 1, 0, 0, 0, 0, 0, 0, 0, 0};
  float lo[16], hi2[16];
#pragma unroll
  for (int k = 0; k < 32; ++k) { float v = -3.0e38f;
    if (k < 25) { const float v0 = __uint_as_float((__float_as_uint(t1[CA[2 * k]] + t2[CB[2 * k]]) & ~255u) | (unsigned)(255 - (CA[2 * k] * 16 + CB[2 * k])));
      const float v1 = __uint_as_float((__float_as_uint(t1[CA[2 * k + 1]] + t2[CB[2 * k + 1]]) & ~255u) | (unsigned)(255 - (CA[2 * k + 1] * 16 + CB[2 * k + 1])));
      v = part ? v1 : v0; }
    if (k < 16) lo[k] = v; else hi2[k - 16] = v; }
  sort16_desc(lo); sort16_desc(hi2); merge16_desc(lo, hi2); pair_merge16(lo);
  const float mx = __uint_as_float(__float_as_uint(lo[0]) & ~255u);
  float w[16], sum = 0.f;
#pragma unroll
  for (int i = 0; i < 16; ++i) { w[i] = __expf(__uint_as_float(__float_as_uint(lo[i]) & ~255u) - mx); sum += w[i]; }
  const float inv = 1.f / sum;
  unsigned char* my = (unsigned char*)lds + tid * 32;
#pragma unroll
  for (int i = 0; i < 16; ++i) { my[i] = (unsigned char)(127u - (__float_as_uint(t1[i]) & 127u)); my[16 + i] = (unsigned char)(127u - (__float_as_uint(t2[i]) & 127u)); }
  unsigned ev[8]; float gv[8];
  const unsigned pm = 0u - (unsigned)part;
#pragma unroll
  for (int i = 0; i < 8; ++i) { const unsigned xb = __float_as_uint(lo[i]) ^ ((__float_as_uint(lo[i]) ^ __float_as_uint(lo[8 + i])) & pm); const unsigned code = 255u - (xb & 255u);
    const unsigned wb = __float_as_uint(w[i]) ^ ((__float_as_uint(w[i]) ^ __float_as_uint(w[8 + i])) & pm);
    ev[i] = (unsigned)my[code >> 4] * 128u + (unsigned)my[16 + (code & 15)]; gv[i] = __uint_as_float(wb) * inv; }
  const size_t o = ((size_t)(m0 + row) * 8 + h) * 16 + part * 8;
  *(u32x4*)((u16*)(p.ws + WS_EIDX) + o) = (u32x4){ev[0] | (ev[1] << 16), ev[2] | (ev[3] << 16), ev[4] | (ev[5] << 16), ev[6] | (ev[7] << 16)};
  *(f32x4*)((float*)(p.ws + WS_EGATE) + o) = (f32x4){gv[0], gv[1], gv[2], gv[3]}; *(f32x4*)((float*)(p.ws + WS_EGATE) + o + 4) = (f32x4){gv[4], gv[5], gv[6], gv[7]};
  __syncthreads();
}


DEVI void peer_route_stream(const Params& p, int l, int vb, int nb, char* lds) {
  const int tid = tidx(), lane = tid & 63, wid = tid >> 6, wm = wid >> 1, wn = wid & 1, r32 = lane & 31, hi = lane >> 5, srow = tid >> 3, sc = tid & 7, row = tid >> 1, part = tid & 1;
  const u16* PQ = (const u16*)(p.ws + WS_R1); const u16* SK = (const u16*)(p.ws + WS_SUBK) + (size_t)l * 2 * 128 * 128;
  constexpr int NIT = (T / 256) * 8;
  if (vb >= NIT) return;
  bf16x8 a0[4], b0[2], a1[4], b1[2]; float ssq[4] = {0.f, 0.f, 0.f, 0.f};
#define RS_LOAD(it_, j_) do { GemmDesc g_{}; g_.A = PQ + (((it_) & 7) * 2 + (j_)) * 128; g_.lda = 2048; g_.Bt = SK + (size_t)(j_) * 128 * 128; g_.ldb = 128; g_.KT = 2; \
    g_load<0>(g_, a0, b0, ((it_) >> 3) * 256, 0, srow, sc, 0); g_load<0>(g_, a1, b1, ((it_) >> 3) * 256, 0, srow, sc, 1); } while (0)
#define RS_GEMM(NEXT_LOAD) do { \
    g_write<false>(lds, a0, b0, ssq, srow, sc); g_write<false>(lds + 49152, a1, b1, ssq, srow, sc); __syncthreads(); \
    NEXT_LOAD; \
    f32x16 acc[2][2]; _Pragma("unroll") for (int i_ = 0; i_ < 2; ++i_) _Pragma("unroll") for (int j_ = 0; j_ < 2; ++j_) acc[i_][j_] = f32x16{}; \
    _Pragma("unroll") for (int kt = 0; kt < 2; ++kt) { const char* Ab = lds + kt * 49152; const char* Bb = Ab + 32768; \
      _Pragma("unroll") for (int k16 = 0; k16 < 4; ++k16) { bf16x8 a[2], b[2]; \
        _Pragma("unroll") for (int mt_ = 0; mt_ < 2; ++mt_) a[mt_] = *(const bf16x8*)(Ab + swz(wm * 64 + mt_ * 32 + r32, k16 * 2 + hi)); \
        _Pragma("unroll") for (int nt_ = 0; nt_ < 2; ++nt_) b[nt_] = *(const bf16x8*)(Bb + swz(wn * 64 + nt_ * 32 + r32, k16 * 2 + hi)); \
        _Pragma("unroll") for (int mt_ = 0; mt_ < 2; ++mt_) _Pragma("unroll") for (int nt_ = 0; nt_ < 2; ++nt_) acc[mt_][nt_] = __builtin_amdgcn_mfma_f32_32x32x16_bf16(a[mt_], b[nt_], acc[mt_][nt_], 0, 0, 0); } } \
    __syncthreads(); \
    float* C = (float*)lds; \
    _Pragma("unroll") for (int mt_ = 0; mt_ < 2; ++mt_) _Pragma("unroll") for (int nt_ = 0; nt_ < 2; ++nt_) _Pragma("unroll") for (int r = 0; r < 16; ++r) \
      C[(wm * 64 + mt_ * 32 + crow(r, hi)) * CLD + wn * 64 + nt_ * 32 + r32] = acc[mt_][nt_][r]; \
    __syncthreads(); } while (0)
  RS_LOAD(vb, 0);
#pragma unroll 1
  for (int it = vb; it < NIT; it += nb) {
    float t1[16], t2[16];
    RS_GEMM(RS_LOAD(it, 1));
    top16_from_C((const float*)lds, row, part, t1); __syncthreads();
    RS_GEMM(if (it + nb < NIT) RS_LOAD(it + nb, 0));
    top16_from_C((const float*)lds, row, part, t2); __syncthreads();
    peer_route_finish(p, it >> 3, it & 7, t1, t2, lds);
  }
#undef RS_LOAD
#undef RS_GEMM
}

DEVI void peer_convert_tables(const Params& p, int l, size_t i0, size_t istep) {
  const float* us = p.peer_u + (size_t)l * NEXP * DM; const float* vs = p.peer_v + (size_t)l * NEXP * DM;
  u8* ub = (u8*)(p.ws + WS_UB); u8* vbf = (u8*)(p.ws + WS_VB);
  for (size_t i = i0; i < (size_t)NEXP * 64; i += istep) {
    const size_t e = i >> 6; const int c16 = (int)(i & 63), s = c16 >> 3, cc = (c16 & 7) * 16;
    float a[16], b[16]; ld8(us + i * 16, a); ld8(us + i * 16 + 8, a + 8); ld8(vs + i * 16, b); ld8(vs + i * 16 + 8, b + 8);
    const size_t o = ((size_t)s * NEXP + e) * 128 + cc;
    stwt16n(ub + o, (u32x4){q8x4(a, PEER_SU), q8x4(a + 4, PEER_SU), q8x4(a + 8, PEER_SU), q8x4(a + 12, PEER_SU)});
    stwt16n(vbf + o, (u32x4){q8x4(b, PEER_SV), q8x4(b + 4, PEER_SV), q8x4(b + 8, PEER_SV), q8x4(b + 12, PEER_SV)}); }
}

constexpr int PH_PER_LAYER = 10, N_PHASES = 2 + DEPTH * PH_PER_LAYER;
DEVI void run_phase(const Params& pin, int ph, int vb, int nb, char* lds) {
  const bool dry = ph >= 100; if (dry) ph -= 100;
  Params p = pin; { size_t z = 0; asm volatile("" : "+s"(z)); p.ws = pin.ws + z; p.out = pin.out + z; } asm volatile("" : "+s"(vb));
  const int tid = tidx(), wid = tid >> 6, lane = tid & 63;
#ifdef ONLY_SP
  if (ONLY_SP >= 0 && ph == 0) return;
#endif
  if (ph == 0) { phase0(p, vb, nb, lds); return; }
  if (ph == N_PHASES - 1) {
    const float* ssq = (const float*)(p.ws + WS_SSQ); const u16* xg = (const u16*)(p.ws + WS_XG);
    for (size_t i = (size_t)vb * NTHREADS + tid; i < (size_t)T * DM / 8; i += (size_t)nb * NTHREADS) {
      const size_t t = i >> 7; const int c = (int)(i & 127) * 8;
      float s8[8]; ld8(ssq + t * 8, s8); const float rs = rsqrtf((((s8[0] + s8[1]) + (s8[2] + s8[3])) + ((s8[4] + s8[5]) + (s8[6] + s8[7]))) * (1.f / DM) + EPS);
      float x[8], g[8]; unpk8(*(const u32x4*)(xg + i * 8), x); ld8(p.norm_final + c, g);
#pragma unroll
      for (int q = 0; q < 8; ++q) x[q] *= rs * g[q];
      *(f32x4*)(p.out + i * 8) = (f32x4){x[0], x[1], x[2], x[3]}; *(f32x4*)(p.out + i * 8 + 4) = (f32x4){x[4], x[5], x[6], x[7]}; }
    return; }
  const int l = (ph - 1) / PH_PER_LAYER, sp = (ph - 1) % PH_PER_LAYER;
  u16* const XG = (u16*)(p.ws + WS_XG); u16* const PROJ = (u16*)(p.ws + WS_R1); u16* const MIX = (u16*)(p.ws + WS_MIX);
  constexpr int NMT = T / 256;
#ifdef ONLY_SP
  if (sp != ONLY_SP) return;
#endif
  switch (sp) {
  case 0: {
    pg8::Gemm g{XG, (const u16*)(p.ws + WS_WIN) + (size_t)l * INWP * DM, T, INWP, DM, DM, DM}; pg8::StaticOrder S; S.init(T, INWP, nb, vb);
    pg8::EpiProj e{PROJ, p.pos, (const float*)(p.ws + WS_SSQ), (float*)(p.ws + WS_SSQQ), (float*)(p.ws + WS_SSQKV)};
    pg8::gemm_phase((PG8_LAS unsigned char*)lds, g, S, e);
    if (!dry) { if (nb == 256) { if (vb >= 128) peer_convert_tables(p, l, (size_t)(vb - 128) * NTHREADS + tid, (size_t)128 * NTHREADS); }
                else peer_convert_tables(p, l, (size_t)vb * NTHREADS + tid, (size_t)nb * NTHREADS); }
  } break;
  case 1: {
    { pg8::Gemm g{PROJ + PC_CQ, (const u16*)(p.ws + WS_WUQ) + (size_t)l * 768 * 256, T, 768, 256, INWP, 256}; pg8::StaticOrder S; S.init(T, 768, nb, vb);
      pg8::EpiQ2 e{(u16*)(p.ws + WS_QM), (const float*)(p.ws + WS_SSQQ)};
      pg8::gemm_phase((PG8_LAS unsigned char*)lds, g, S, e); }
    { pg8::Gemm g{PROJ + PC_CKV, (const u16*)(p.ws + WS_WUKV) + (size_t)l * 768 * 128, T, 768, 128, INWP, 128}; pg8::StaticOrder S; S.init(T, 768, nb, nb - 1 - vb);
      pg8::EpiKV2 e{(u16*)(p.ws + WS_KM), (u16*)(p.ws + WS_VM), (const float*)(p.ws + WS_SSQKV)};
      pg8::gemm_phase((PG8_LAS unsigned char*)lds, g, S, e); }
    for (int i = vb * NTHREADS + tid; i < T * MLA_H * 4; i += nb * NTHREADS) { const int c = (i & 3) * 8, h = (i >> 2) % MLA_H, row = i / (4 * MLA_H), b = row >> 13, s = row & (SEQ - 1);
      *(u32x4*)((u16*)(p.ws + WS_KM) + ((size_t)(b * MLA_H + h) * SEQ + s) * MLA_QK + 64 + c) = *(const u32x4*)(PROJ + (size_t)row * INWP + PC_KR + c); }
    for (int it = vb; it < NMT * 6; it += nb) lru_gate_item(p, l, it / 6, it % 6, lds);
    for (int it = vb; it < NB * 64 * 2; it += nb) swa_item(p, l, it, lds);
  } break;
  case 2: {
    { const int wi = vb * 8 + wid; if (wi < 48) lru_passB(p, wi, lane); __syncthreads(); }
    for (int k = 0; k * nb + vb < NB * MLA_H * 32; ++k) {
      int pair, qb;
      if (nb == 256) { pair = k * 8 + (vb & 7); qb = vb >> 3; } else { const int it = k * nb + vb; pair = it >> 5; qb = it & 31; }
      mla_item(p, pair, qb, lds);
    }
  } break;
  case 3: {
#ifndef NO_LRUF
    if (!dry) for (int it = vb; it < NB * NLCH; it += nb) lru_final(p, it, lds);
#endif
    for (int t = vb * 8 + wid; t < T; t += nb * 8) {
      u32x4* rp = (u32x4*)(MIX + (size_t)t * DM + lane * 16);
      float v[16]; unpk8(rp[0], v); unpk8(rp[1], v + 8);
      float s = 0.f;
#pragma unroll
      for (int q = 0; q < 16; ++q) s = fmaf(v[q], v[q], s);
      const int sg = lane < 24 ? 0 : (lane < 48 ? 1 : 2);
      const float s0 = wave_sum(sg == 0 ? s : 0.f), s2 = wave_sum(sg == 2 ? s : 0.f);
      const float rs = sg == 0 ? rsqrtf(s0 * (1.f / 384.f) + EPS) : rsqrtf(s2 * (1.f / 256.f) + EPS);
      if (sg != 1) {
#pragma unroll
        for (int q = 0; q < 16; ++q) v[q] *= rs;
        rp[0] = pk8(v); rp[1] = pk8(v + 8); } }
  } break;
  case 4: {
    { pg8::Gemm g{MIX, (const u16*)(p.ws + WS_WOUT) + (size_t)l * DM * DM, T, DM, DM, DM, DM}; pg8::StaticOrder S; S.init(T, DM, nb, vb);
      pg8::EpiRes e{dry ? (u16*)(p.ws + WS_R1) : XG, (float*)(p.ws + WS_SSQ16)};
      pg8::gemm_phase((PG8_LAS unsigned char*)lds, g, S, e); }
  } break;
  case 5: {
    pg8::Gemm g{XG, (const u16*)(p.ws + WS_WQ) + (size_t)l * 2048 * DM, T, 2048, DM, DM, DM}; pg8::StaticOrder S; S.init(T, 2048, nb, vb);
    pg8::EpiPQ e{PROJ, (const float*)(p.ws + WS_SSQ16)};
    pg8::gemm_phase((PG8_LAS unsigned char*)lds, g, S, e);
  } break;
  case 6: {
    peer_route_stream(p, l, vb, nb, lds);
    if (!dry) peer_xn_pass(p, l, vb, nb);
  } break;
  case 7: case 9: {
    const bool last = l == DEPTH - 1;
    float* xo = dry ? (float*)(p.ws + WS_PD) : p.out;
    int s0, s1, tb, ts;
    if ((nb & 7) == 0) { s0 = vb & 7; s1 = s0 + 1; tb = (vb >> 3) * 8 + wid; ts = (nb >> 3) * 8; } else { s0 = 0; s1 = 8; tb = vb * 8 + wid; ts = nb * 8; }
#pragma unroll 1
    for (int s = s0; s < s1; ++s) { if (sp == 7) peer_slice_phase<false>(p, s, tb, ts, lane, p.out, xo, last); else peer_slice_phase<true>(p, s, tb, ts, lane, p.out, xo, last); }
  } break;
  case 8: {
    const u16* pd = (const u16*)(p.ws + WS_PD); const float* eg = (const float*)(p.ws + WS_EGATE); u16* cc = (u16*)(p.ws + WS_CC); float* cs = (float*)(p.ws + WS_CS);
    const int hh = lane >> 5, l5 = lane & 31, e0 = 4 * l5, pdpos = ((e0 >> 3) & 1) * 64 + (e0 >> 4) * 8 + (e0 & 7);
    for (int t0 = (vb * 8 + wid) * 2; t0 < T; t0 += nb * 16) {
      const int t = t0 + hh;
      float a[4] = {0.f, 0.f, 0.f, 0.f};
#pragma unroll
      for (int s = 0; s < 8; ++s) { const u32x2 w = *(const u32x2*)(pd + ((size_t)s * T + t) * 128 + pdpos); a[0] += bflo(w.x); a[1] += bfhi(w.x); a[2] += bflo(w.y); a[3] += bfhi(w.y); }
      const f32x4 g = *(const f32x4*)(eg + (size_t)t * 128 + 4 * l5);
      float c[4]; c[0] = gelu_erf(a[0] * (1.f / PEER_SU)) * g.x; c[1] = gelu_erf(a[1] * (1.f / PEER_SU)) * g.y; c[2] = gelu_erf(a[2] * (1.f / PEER_SU)) * g.z; c[3] = gelu_erf(a[3] * (1.f / PEER_SU)) * g.w;
      float mx = fmaxf(fmaxf(fabsf(c[0]), fabsf(c[1])), fmaxf(fabsf(c[2]), fabsf(c[3])));
      mx = fmaxf(mx, dppx<0xB1>(mx)); mx = fmaxf(mx, dppx<0x4E>(mx)); mx = fmaxf(mx, dppx<0x141>(mx)); mx = fmaxf(mx, dppx<0x140>(mx));
      { auto r = __builtin_amdgcn_permlane16_swap(__float_as_uint(mx), __float_as_uint(mx), false, false); mx = fmaxf(__uint_as_float(r[0]), __uint_as_float(r[1])); }
      const float st = fmaxf(mx, 1e-30f) * (1.f / 127.f), ist = 1.f / st;
      const int q0 = __float2int_rn(c[0] * ist), q1 = __float2int_rn(c[1] * ist), q2 = __float2int_rn(c[2] * ist), q3 = __float2int_rn(c[3] * ist);
      ((unsigned*)cc)[(size_t)t * 32 + l5] = ((unsigned)q0 & 255u) | (((unsigned)q1 & 255u) << 8) | (((unsigned)q2 & 255u) << 16) | (((unsigned)q3 & 255u) << 24);
      if (l5 == 0) cs[t] = st * (1.f / PEER_SV);
    }
  } break;
  }
}

#define XB_TMO      128
#define XB_XCNT(j)  (256  + 64 * (j))
#define XB_XSUB(j)  (1280 + 64 * (j))
#define XB_XGEN(j)  (2304 + 64 * (j))
#define XB_TOP      3328
#define XB_TOPGEN   3392
#define XCD_BAR_WORDS 3456
#define XB_SPIN_CAP (1u << 23)
DEVI unsigned xb_ld(unsigned* p) { return __hip_atomic_load(p, __ATOMIC_RELAXED, __HIP_MEMORY_SCOPE_AGENT); }
DEVI unsigned xb_add(unsigned* p, unsigned v) { return __hip_atomic_fetch_add(p, v, __ATOMIC_RELAXED, __HIP_MEMORY_SCOPE_AGENT); }
DEVI unsigned xb_xcc_id() { return (unsigned)__builtin_amdgcn_s_getreg((3 << 11) | 20) & 0xFu; }
#define XB_SPIN(cond, bar) do { unsigned _sp = 0; while (cond) { __builtin_amdgcn_s_sleep(1); \
    if ((++_sp & 255u) == 0u) { if (xb_ld(&(bar)[XB_TMO])) break; if (_sp > XB_SPIN_CAP) { atomicAdd(&(bar)[XB_TMO], 1u); break; } } } } while (0)
struct XcdBarrier { unsigned* bar; unsigned x; volatile unsigned* st; };
DEVI XcdBarrier xcd_barrier_post(unsigned* bar, volatile unsigned* st) {
  XcdBarrier b; b.bar = bar; b.x = xb_xcc_id(); b.st = st;
  if (threadIdx.x == 0) (void)xb_add(&bar[XB_XCNT(b.x)], 1u);
  return b;
}
DEVI void xcd_barrier_complete(unsigned* bar, unsigned x, unsigned& nloc, unsigned& nx) {
  const unsigned G = gridDim.x * gridDim.y * gridDim.z;
  unsigned sum, cnt, mine, sp = 0u;
  for (;;) {
    sum = 0u; cnt = 0u; mine = 0u;
#pragma unroll
    for (unsigned j = 0; j < 16; ++j) { const unsigned c = xb_ld(&bar[XB_XCNT(j)]); sum += c; cnt += (c > 0u) ? 1u : 0u; mine = (j == x) ? c : mine; }
    if (sum == G) break;
    __builtin_amdgcn_s_sleep(1);
    if ((++sp & 255u) == 0u) { if (xb_ld(&bar[XB_TMO])) break; if (sp > XB_SPIN_CAP) { atomicAdd(&bar[XB_TMO], 1u); break; } }
  }
  nloc = mine > 0u ? mine : 1u; nx = cnt > 0u ? cnt : 1u;
}
DEVI void xcd_barrier(const XcdBarrier& b) {
  asm volatile("s_waitcnt vmcnt(0)" ::: "memory");
  __syncthreads();
  if (threadIdx.x == 0) {
    unsigned* bar = b.bar;
    __builtin_amdgcn_s_waitcnt(0);
    unsigned nloc = b.st[0], nx = b.st[1];
    if (nloc == 0u) { xcd_barrier_complete(bar, b.x, nloc, nx); b.st[0] = nloc; b.st[1] = nx; }
    const unsigned old = xb_add(&bar[XB_XSUB(b.x)], 1u);
    const unsigned gen = old / nloc;
    if (old + 1u == (gen + 1u) * nloc) {
      __builtin_amdgcn_fence(__ATOMIC_RELEASE, "agent");
      asm volatile("s_waitcnt vmcnt(0)" ::: "memory");
      const unsigned og = xb_add(&bar[XB_TOP], 1u);
      const unsigned tg = og / nx;
      if (og + 1u == (tg + 1u) * nx) xb_add(&bar[XB_TOPGEN], 1u);
      else XB_SPIN(xb_ld(&bar[XB_TOPGEN]) == tg, bar);
      __builtin_amdgcn_fence(__ATOMIC_ACQUIRE, "agent");
      xb_add(&bar[XB_XGEN(b.x)], 1u);
      asm volatile("s_waitcnt vmcnt(0)" ::: "memory");
    } else {
      XB_SPIN(xb_ld(&bar[XB_XGEN(b.x)]) == gen, bar);
      __builtin_amdgcn_fence(__ATOMIC_ACQUIRE, "agent");
      asm volatile("s_waitcnt vmcnt(0)" ::: "memory");
    }
  }
  __syncthreads();
}

#ifndef N_LAUNCH_SPLIT
#define N_LAUNCH_SPLIT 0
#endif
__global__ void __launch_bounds__(NTHREADS, 2) mega(Params p) {
  extern __shared__ __attribute__((aligned(16))) char smem[];
  cg::grid_group grid = cg::this_grid();
  const int nb = gridDim.x, vb = blockIdx.x;
  volatile unsigned* st = (volatile unsigned*)(smem + LDS_BYTES - 16);
  if (threadIdx.x == 0) { st[0] = 0u; st[1] = 0u; }
  __syncthreads();
  const XcdBarrier bar = xcd_barrier_post((unsigned*)p.ws, st);
#if N_LAUNCH_SPLIT
  for (int ph = p.ph_lo; ph < p.ph_hi; ++ph) {
    run_phase(p, ph, vb, nb, smem);
    if (ph + 1 < p.ph_hi) { if (ph == p.ph_lo) grid.sync(); else xcd_barrier(bar); }
  }
#else
  static_assert(N_PHASES == 22, "phase program below is written out for 22 phases");
#define PHX(PH) do { run_phase(p, PH, vb, nb, smem); xcd_barrier(bar); } while (0)
  run_phase(p, 0, vb, nb, smem); grid.sync();
  PHX(1); PHX(2); PHX(3); PHX(4); PHX(5); PHX(6); PHX(7); PHX(8); PHX(9); PHX(10);
  PHX(11); PHX(12); PHX(13); PHX(14); PHX(15); PHX(16); PHX(17); PHX(18); PHX(19); PHX(20);
  run_phase(p, 21, vb, nb, smem);
#undef PHX
#endif
}

extern "C" void kernel_launch(void* const* d_in, const int* in_sizes, int n_in, void* d_out, int out_size, void* d_ws, size_t ws_size, hipStream_t stream) {
  static int grid_blocks = 0;
  if (grid_blocks == 0) {
    if (n_in != 24 || out_size != T * DM || ws_size < WS_NEED) { fprintf(stderr, "kernel_launch: unexpected shapes n_in %d out %d ws %zu\n", n_in, out_size, ws_size); grid_blocks = -1; return; }
    int dev = 0, cus = 0, per_cu = 0;
    (void)hipGetDevice(&dev); (void)hipDeviceGetAttribute(&cus, hipDeviceAttributeMultiprocessorCount, dev);
    if (hipFuncSetAttribute((const void*)mega, hipFuncAttributeMaxDynamicSharedMemorySize, LDS_BYTES) != hipSuccess) { fprintf(stderr, "kernel_launch: hipFuncSetAttribute failed\n"); grid_blocks = -1; return; }
    if (hipOccupancyMaxActiveBlocksPerMultiprocessor(&per_cu, (const void*)mega, NTHREADS, LDS_BYTES) != hipSuccess || per_cu < 1) { fprintf(stderr, "kernel_launch: occupancy query failed (%d)\n", per_cu); grid_blocks = -1; return; }
    grid_blocks = cus * 1;
    fprintf(stderr, "kernel_launch: cus %d per_cu %d grid %d\n", cus, per_cu, grid_blocks);
  }
  if (grid_blocks < 0) return;
  if (hipMemsetAsync(d_ws, 0, 65536, stream) != hipSuccess) { fprintf(stderr, "kernel_launch: memset failed\n"); return; }
  Params p{};
  p.x = (const float*)d_in[0]; p.pos = (const int*)d_in[1]; p.norm_mix = (const float*)d_in[2]; p.w_in = (const float*)d_in[3]; p.q_norm = (const float*)d_in[4];
  p.w_uq = (const float*)d_in[5]; p.kv_norm = (const float*)d_in[6]; p.w_ukv = (const float*)d_in[7]; p.conv_w = (const float*)d_in[8]; p.conv_b = (const float*)d_in[9];
  p.lru_wa = (const float*)d_in[10]; p.lru_ba = (const float*)d_in[11]; p.lru_wx = (const float*)d_in[12]; p.lru_bx = (const float*)d_in[13]; p.lru_lambda = (const float*)d_in[14];
  p.swa_sink = (const float*)d_in[15]; p.grp_norm = (const float*)d_in[16]; p.w_out = (const float*)d_in[17]; p.norm_ffn = (const float*)d_in[18]; p.peer_wq = (const float*)d_in[19];
  p.peer_subkeys = (const float*)d_in[20]; p.peer_u = (const float*)d_in[21]; p.peer_v = (const float*)d_in[22]; p.norm_final = (const float*)d_in[23];
  p.out = (float*)d_out; p.ws = (unsigned char*)d_ws;
#if N_LAUNCH_SPLIT
  for (int ph = 0; ph < N_PHASES; ++ph) {
    p.ph_lo = ph; p.ph_hi = ph + 1;
    void* args[] = {&p};
    hipError_t e = hipLaunchCooperativeKernel((const void*)mega, dim3(grid_blocks), dim3(NTHREADS), args, LDS_BYTES, stream);
    if (e != hipSuccess) { fprintf(stderr, "kernel_launch: launch of phase %d failed: %s\n", ph, hipGetErrorString(e)); break; }
  }
#else
  p.ph_lo = 0; p.ph_hi = N_PHASES;
  void* args[] = {&p};
  hipError_t e = hipLaunchCooperativeKernel((const void*)mega, dim3(grid_blocks), dim3(NTHREADS), args, LDS_BYTES, stream);
  if (e != hipSuccess) fprintf(stderr, "kernel_launch: cooperative launch failed: %s (grid %d)\n", hipGetErrorString(e), grid_blocks);
#endif
}
```
